# Optimizing an MI355X kernel written in HIP

```python
import math
import jax
import jax.numpy as jnp
from jax import lax
import numpy as np


D_MODEL = 1024
BATCH = 8
SEQ = 2048
DEPTH = 2

GRID_W = 64
PLE_DIM = 256
N_EVEN = (DEPTH + 1) // 2
N_ODD = DEPTH // 2

NA_HEADS = 8
NA_HEAD_DIM = 64
NA_WIDTH = NA_HEADS * NA_HEAD_DIM
NA_WIN_ROWS_MAX = 8
NA_WIN_COLS = 16

HY_WIDTH = D_MODEL - NA_WIDTH
HY_ORDER = 2
HY_SHORT_K = 3
HY_EMB_DIM = 33
HY_FILTER_HIDDEN = 64
HY_FAST_DECAY_PCT = 0.3
HY_SLOW_DECAY_PCT = 1.5
HY_DECAY_TARGET = 1e-2
HY_FILTER_OUT = HY_ORDER * 2 * HY_WIDTH

AB_IN_WIDTH = 3 * NA_WIDTH + (HY_ORDER + 1) * HY_WIDTH

MLA_HEADS = 16
MLA_Q_LORA = 384
MLA_KV_LORA = 256
MLA_NOPE = 64
MLA_ROPE = 32
MLA_V = 64
MLA_IN_WIDTH = MLA_Q_LORA + MLA_KV_LORA + MLA_ROPE
ROPE_THETA = 10000.0
Q_BLOCK = 128

N_EXPERTS = 16
EC_CAPACITY_FACTOR = 2
D_FF_EXPERT = 2048

DN_ALPHA = (2 * DEPTH) ** 0.25
DN_BETA = (8 * DEPTH) ** -0.25
NORM_EPS = 1e-5
NEG_INF = -1e30

kernel_name = 'hybrid_na_hyena_mla_ec_encoder'


def layer_norm(x, g, b):
    xf = x.astype(jnp.float32)
    mu = jnp.mean(xf, axis=-1, keepdims=True)
    var = jnp.mean(jnp.square(xf - mu), axis=-1, keepdims=True)
    return ((xf - mu) * lax.rsqrt(var + NORM_EPS) * g + b).astype(x.dtype)


def rms_norm(x, g):
    xf = x.astype(jnp.float32)
    return (xf * lax.rsqrt(jnp.mean(jnp.square(xf), axis=-1, keepdims=True) + NORM_EPS) * g).astype(x.dtype)


def neighbourhood_attention(q, k, v, rpb):
    B, L, H, Dh = q.shape
    rows = L // GRID_W
    wr = min(NA_WIN_ROWS_MAX, rows)
    qg = q.reshape(B, rows, GRID_W, H, Dh)
    kg = k.reshape(B, rows, GRID_W, H, Dh)
    vg = v.reshape(B, rows, GRID_W, H, Dh)
    r = np.arange(rows)
    r0 = np.clip(r - wr // 2, 0, rows - wr)
    row_idx = r0[:, None] + np.arange(wr)[None, :]
    c = np.arange(GRID_W)
    c0 = np.clip(c - NA_WIN_COLS // 2, 0, GRID_W - NA_WIN_COLS)
    kc = np.arange(GRID_W)
    col_ok = (kc[None, :] >= c0[:, None]) & (kc[None, :] < c0[:, None] + NA_WIN_COLS)
    dr_idx = row_idx - r[:, None] + (NA_WIN_ROWS_MAX - 1)
    dc_idx = np.clip(kc[None, :] - c[:, None], -(NA_WIN_COLS - 1), NA_WIN_COLS - 1) + (NA_WIN_COLS - 1)
    kr = kg[:, row_idx]
    vr = vg[:, row_idx]
    s = jnp.einsum('brchd,brwkhd->bhrcwk', qg, kr).astype(jnp.float32) * (Dh ** -0.5)
    bias = rpb[:, dr_idx[:, None, :, None], dc_idx[None, :, None, :]].astype(jnp.float32)
    s = jnp.where(col_ok[None, None, None, :, None, :], s + bias[None], NEG_INF)
    sh = s.shape
    prob = jax.nn.softmax(s.reshape(sh[:4] + (wr * GRID_W,)), axis=-1).reshape(sh).astype(v.dtype)
    out = jnp.einsum('bhrcwk,brwkhd->brchd', prob, vr)
    return out.reshape(B, L, H * Dh)


def short_conv_centred(x, w, b):
    L = x.shape[1]
    pad = HY_SHORT_K // 2
    xp = jnp.pad(x, ((0, 0), (pad, pad), (0, 0)))
    y = b
    for j in range(HY_SHORT_K):
        y = y + xp[:, j:j + L] * w[j]
    return y


def hyena_filters(L, w1, b1, freq, w2, b2, w3):
    f32 = jnp.float32
    bands = (HY_EMB_DIM - 1) // 2
    t = jnp.linspace(0.0, 1.0, L, dtype=f32)[:, None]
    w = 2.0 * math.pi * jnp.arange(L, dtype=f32)[:, None] / L
    f = jnp.linspace(1e-4, bands - 1, bands, dtype=f32)[None, :]
    z = jnp.concatenate([t, jnp.cos(f * w), -jnp.sin(f * w)], axis=-1)
    h = jnp.sin(freq * (z @ w1 + b1))
    h = jnp.sin(freq * (h @ w2 + b2))
    h = (h @ w3).astype(f32).reshape(L, HY_ORDER, 2, HY_WIDTH)
    min_decay = math.log(HY_DECAY_TARGET) / HY_SLOW_DECAY_PCT
    max_decay = math.log(HY_DECAY_TARGET) / HY_FAST_DECAY_PCT
    deltas = jnp.abs(jnp.linspace(min_decay, max_decay, HY_WIDTH, dtype=f32))
    h = h * jnp.exp(-t * deltas)[:, None, None, :]
    k_fwd = h[:, :, 0]
    k_bwd = h[:, :, 1]
    K = jnp.concatenate([k_fwd, jnp.zeros((1, HY_ORDER, HY_WIDTH), f32), k_bwd[1:][::-1]], axis=0)
    return K * lax.rsqrt(jnp.sum(jnp.square(K), axis=0, keepdims=True) + 1e-12)


def long_conv_bidirectional(u, K, skip):
    L = u.shape[1]
    uf = jnp.fft.rfft(u.astype(jnp.float32), n=2 * L, axis=1)
    kf = jnp.fft.rfft(K, n=2 * L, axis=0)
    y = jnp.fft.irfft(uf * kf[None], n=2 * L, axis=1)[:, :L]
    return (y + u.astype(jnp.float32) * skip.astype(jnp.float32)).astype(u.dtype)


def na_hyena_mixer(x, w_in, rpb, conv_w, conv_b, f_w1, f_b1, f_freq, f_w2, f_b2, f_w3, skip, w_out):
    B, L, _ = x.shape
    h = x @ w_in
    qa, ka, va, hb = jnp.split(h, [NA_WIDTH, 2 * NA_WIDTH, 3 * NA_WIDTH], axis=-1)
    shp = (B, L, NA_HEADS, NA_HEAD_DIM)
    y_a = neighbourhood_attention(qa.reshape(shp), ka.reshape(shp), va.reshape(shp), rpb)
    hb = short_conv_centred(hb, conv_w, conv_b)
    parts = jnp.split(hb, HY_ORDER + 1, axis=-1)
    K = hyena_filters(L, f_w1, f_b1, f_freq, f_w2, f_b2, f_w3)
    z = parts[0]
    for o in range(HY_ORDER):
        z = parts[o + 1] * long_conv_bidirectional(z, K[:, o], skip[o])
    return jnp.concatenate([y_a, z], axis=-1) @ w_out


def rope_tables(L, dim):
    inv = 1.0 / (ROPE_THETA ** (jnp.arange(0, dim, 2, dtype=jnp.float32) / dim))
    ang = jnp.arange(L, dtype=jnp.float32)[:, None] * inv[None, :]
    return jnp.cos(ang), jnp.sin(ang)


def apply_rope(x, cos, sin):
    x1, x2 = jnp.split(x.astype(jnp.float32), 2, axis=-1)
    c = cos[None, :, None, :]
    s = sin[None, :, None, :]
    return jnp.concatenate([x1 * c - x2 * s, x1 * s + x2 * c], axis=-1).astype(x.dtype)


def dense_attention_blocked(q, k, v):
    B, L, H, Dq = q.shape
    nb = L // Q_BLOCK
    qb = q.reshape(B, nb, Q_BLOCK, H, Dq).transpose(1, 0, 2, 3, 4)
    scale = Dq ** -0.5

    def one_block(qi):
        s = jnp.einsum('bqhd,bkhd->bhqk', qi, k).astype(jnp.float32) * scale
        prob = jax.nn.softmax(s, axis=-1).astype(v.dtype)
        return jnp.einsum('bhqk,bkhd->bqhd', prob, v)

    out = lax.map(one_block, qb)
    return out.transpose(1, 0, 2, 3, 4).reshape(B, L, H * v.shape[-1])


def mla_mixer(x, w_in, q_norm_g, w_q_up, kv_norm_g, w_kv_up, w_out):
    B, L, _ = x.shape
    h = x @ w_in
    cq, ckv, k_rope = jnp.split(h, [MLA_Q_LORA, MLA_Q_LORA + MLA_KV_LORA], axis=-1)
    cos, sin = rope_tables(L, MLA_ROPE)
    q = (rms_norm(cq, q_norm_g) @ w_q_up).reshape(B, L, MLA_HEADS, MLA_NOPE + MLA_ROPE)
    q_nope, q_rope = jnp.split(q, [MLA_NOPE], axis=-1)
    q = jnp.concatenate([q_nope, apply_rope(q_rope, cos, sin)], axis=-1)
    kv = (rms_norm(ckv, kv_norm_g) @ w_kv_up).reshape(B, L, MLA_HEADS, MLA_NOPE + MLA_V)
    k_nope, v = jnp.split(kv, [MLA_NOPE], axis=-1)
    k_r = apply_rope(k_rope[:, :, None, :], cos, sin)
    k = jnp.concatenate([k_nope, jnp.broadcast_to(k_r, (B, L, MLA_HEADS, MLA_ROPE))], axis=-1)
    return dense_attention_blocked(q, k, v) @ w_out


def expert_choice_moe(x, w_router, w_gate, w_up, w_down):
    B, L, _ = x.shape
    cap = EC_CAPACITY_FACTOR * L // N_EXPERTS
    aff = jax.nn.softmax((x @ w_router).astype(jnp.float32), axis=-1)
    g, idx = lax.top_k(aff.transpose(0, 2, 1), cap)
    bidx = jnp.arange(B)[:, None, None]
    xe = x[bidx, idx]
    hg = jnp.einsum('becd,edf->becf', xe, w_gate)
    hu = jnp.einsum('becd,edf->becf', xe, w_up)
    ye = jnp.einsum('becf,efd->becd', jax.nn.silu(hg) * hu, w_down)
    ye = ye * g[..., None].astype(ye.dtype)
    return jnp.zeros_like(x).at[bidx, idx].add(ye)


def setup_inputs(seed: int = 0) -> dict:
    keys = iter(jax.random.split(jax.random.key(seed), 64))
    f32 = jnp.float32

    def nrm(shape, scale):
        return jax.random.normal(next(keys), shape, f32) * scale

    D = D_MODEL
    return {
        'x': nrm((BATCH, SEQ, D), 1.0),
        'p': nrm((DEPTH, BATCH, SEQ, PLE_DIM), 1.0),
        'ab_w_in': nrm((N_EVEN, D, AB_IN_WIDTH), D ** -0.5),
        'na_rpb': nrm((N_EVEN, NA_HEADS, 2 * NA_WIN_ROWS_MAX - 1, 2 * NA_WIN_COLS - 1), 0.02),
        'hy_conv_w': nrm((N_EVEN, HY_SHORT_K, (HY_ORDER + 1) * HY_WIDTH), HY_SHORT_K ** -0.5),
        'hy_conv_b': nrm((N_EVEN, (HY_ORDER + 1) * HY_WIDTH), 0.02),
        'hy_f_w1': nrm((N_EVEN, HY_EMB_DIM, HY_FILTER_HIDDEN), HY_EMB_DIM ** -0.5),
        'hy_f_b1': nrm((N_EVEN, HY_FILTER_HIDDEN), 0.02),
        'hy_f_freq': 1.0 + nrm((N_EVEN, HY_FILTER_HIDDEN), 0.02),
        'hy_f_w2': nrm((N_EVEN, HY_FILTER_HIDDEN, HY_FILTER_HIDDEN), HY_FILTER_HIDDEN ** -0.5),
        'hy_f_b2': nrm((N_EVEN, HY_FILTER_HIDDEN), 0.02),
        'hy_f_w3': nrm((N_EVEN, HY_FILTER_HIDDEN, HY_FILTER_OUT), HY_FILTER_HIDDEN ** -0.5),
        'hy_skip': nrm((N_EVEN, HY_ORDER, HY_WIDTH), 1.0),
        'ab_w_out': nrm((N_EVEN, NA_WIDTH + HY_WIDTH, D), DN_BETA * (NA_WIDTH + HY_WIDTH) ** -0.5),
        'mla_w_in': nrm((N_ODD, D, MLA_IN_WIDTH), D ** -0.5),
        'mla_q_norm': 1.0 + nrm((N_ODD, MLA_Q_LORA), 0.02),
        'mla_w_q_up': nrm((N_ODD, MLA_Q_LORA, MLA_HEADS * (MLA_NOPE + MLA_ROPE)), MLA_Q_LORA ** -0.5),
        'mla_kv_norm': 1.0 + nrm((N_ODD, MLA_KV_LORA), 0.02),
        'mla_w_kv_up': nrm((N_ODD, MLA_KV_LORA, MLA_HEADS * (MLA_NOPE + MLA_V)), MLA_KV_LORA ** -0.5),
        'mla_w_out': nrm((N_ODD, MLA_HEADS * MLA_V, D), DN_BETA * (MLA_HEADS * MLA_V) ** -0.5),
        'ln1_g': 1.0 + nrm((DEPTH, D), 0.02),
        'ln1_b': nrm((DEPTH, D), 0.02),
        'ln2_g': 1.0 + nrm((DEPTH, D), 0.02),
        'ln2_b': nrm((DEPTH, D), 0.02),
        'moe_router': nrm((DEPTH, D, N_EXPERTS), D ** -0.5),
        'moe_w_gate': nrm((DEPTH, N_EXPERTS, D, D_FF_EXPERT), D ** -0.5),
        'moe_w_up': nrm((DEPTH, N_EXPERTS, D, D_FF_EXPERT), D ** -0.5),
        'moe_w_down': nrm((DEPTH, N_EXPERTS, D_FF_EXPERT, D), DN_BETA * D_FF_EXPERT ** -0.5),
        'ple_gate': nrm((DEPTH, D, D), D ** -0.5),
        'ple_proj': nrm((DEPTH, PLE_DIM, D), PLE_DIM ** -0.5),
    }


def reference(x, p, ab_w_in, na_rpb, hy_conv_w, hy_conv_b, hy_f_w1, hy_f_b1, hy_f_freq, hy_f_w2, hy_f_b2, hy_f_w3, hy_skip, ab_w_out, mla_w_in, mla_q_norm, mla_w_q_up, mla_kv_norm, mla_w_kv_up, mla_w_out, ln1_g, ln1_b, ln2_g, ln2_b, moe_router, moe_w_gate, moe_w_up, moe_w_down, ple_gate, ple_proj):
    for i in range(DEPTH):
        j = i // 2
        if i % 2 == 0:
            m = na_hyena_mixer(x, ab_w_in[j], na_rpb[j], hy_conv_w[j], hy_conv_b[j], hy_f_w1[j], hy_f_b1[j],
                               hy_f_freq[j], hy_f_w2[j], hy_f_b2[j], hy_f_w3[j], hy_skip[j], ab_w_out[j])
        else:
            m = mla_mixer(x, mla_w_in[j], mla_q_norm[j], mla_w_q_up[j], mla_kv_norm[j], mla_w_kv_up[j], mla_w_out[j])
        x = layer_norm(DN_ALPHA * x + m, ln1_g[i], ln1_b[i])
        f = expert_choice_moe(x, moe_router[i], moe_w_gate[i], moe_w_up[i], moe_w_down[i])
        x = layer_norm(DN_ALPHA * x + f, ln2_g[i], ln2_b[i])
        x = x + jax.nn.sigmoid(x @ ple_gate[i]) * (p[i] @ ple_proj[i])
    return x
```

```cpp
#include <hip/hip_runtime.h>
#include <hip/hip_bf16.h>
#include <hip/hip_cooperative_groups.h>
#include <cstdio>
#include <cstring>
namespace cg = cooperative_groups;

typedef unsigned short u16;
using bf16x8 = __attribute__((ext_vector_type(8))) short;
using bf16x4 = __attribute__((ext_vector_type(4))) short;
using f32x4 = __attribute__((ext_vector_type(4))) float;
#define DEV __device__ __forceinline__

constexpr int TOK = 16384, DM = 1024, SEQ = 2048, NBATCH = 8;
constexpr int NEXP = 16, CAP = 256, DFF = 2048;
constexpr float DN_ALPHA = 1.4142135623730951f;
constexpr float LN_EPS = 1e-5f;

constexpr size_t W_ABIN = 0;
constexpr size_t W_ABOUT = W_ABIN + 3072ull * 1024 * 2;
constexpr size_t W_MLAIN = W_ABOUT + 1024ull * 1024 * 2;
constexpr size_t W_QUP = W_MLAIN + 768ull * 1024 * 2;
constexpr size_t W_KVUP = W_QUP + 1536ull * 384 * 2;
constexpr size_t W_MLAOUT = W_KVUP + 2048ull * 256 * 2;
constexpr size_t W_PLEG = W_MLAOUT + 1024ull * 1024 * 2;
constexpr size_t W_PLEP = W_PLEG + 2 * 1024ull * 1024 * 2;
constexpr size_t W_GU = W_PLEP + 2 * 1024ull * 256 * 2;
constexpr size_t W_DN = W_GU + 2 * 16ull * 4096 * 1024 * 2;
constexpr size_t REG_A = W_DN + 2 * 16ull * 1024 * 2048 * 2;
constexpr size_t REG_B = REG_A + 134217728ull;
constexpr size_t REG_C = REG_B + 134217728ull;
constexpr size_t REG_D = REG_C + 67108864ull;
constexpr size_t REG_E = REG_D + 67108864ull;
constexpr size_t REG_G = REG_E + 33554432ull;
constexpr size_t REG_X = REG_G + 67108864ull;
constexpr size_t REG_P = REG_X + 33554432ull;
constexpr size_t S_AFF = REG_P + 16777216ull;
constexpr size_t S_IDX = S_AFF + 1048576ull;
constexpr size_t S_GSEL = S_IDX + 131072ull;
constexpr size_t S_SLOT = S_GSEL + 131072ull;
constexpr size_t S_H2 = S_SLOT + 1048576ull;
constexpr size_t S_RG = S_H2 + 524288ull;
constexpr size_t WS_TOTAL = S_RG + 8388608ull;

struct ConvJob {
  const float* src; u16* dst;
  long sstride, dstride;
  int K, N;
  int rs, off;
  int rsh, padj;
  int ntn;
  int tpm;
  int tile0, ntiles;
};
constexpr int NJOBS = 16;

struct Params {
  const float* x; const float* p;
  const float* na_rpb; const float* hy_conv_w; const float* hy_conv_b;
  const float* hy_f_w1; const float* hy_f_b1; const float* hy_f_freq; const float* hy_f_w2; const float* hy_f_b2;
  const float* hy_f_w3; const float* hy_skip;
  const float* mla_q_norm; const float* mla_kv_norm;
  const float* ln1_g; const float* ln1_b; const float* ln2_g; const float* ln2_b;
  const float* moe_router;
  float* out; char* ws;
  int conv_total; int pad0;
  ConvJob jobs[NJOBS];
};

extern __shared__ __attribute__((aligned(16))) char smem[];

DEV u16 f2bf(float f) {
  unsigned u = __float_as_uint(f);
  u += 0x7fffu + ((u >> 16) & 1u);
  return (u16)(u >> 16);
}
DEV float bf2f(u16 h) { return __uint_as_float(((unsigned)h) << 16); }
DEV unsigned pack2(float a, float b) { return (unsigned)f2bf(a) | ((unsigned)f2bf(b) << 16); }
DEV float wave_sum(float v) {
#pragma unroll
  for (int o = 32; o > 0; o >>= 1) v += __shfl_xor(v, o);
  return v;
}
DEV int otid() { int t = threadIdx.x; asm volatile("" : "+v"(t)); return t; }
DEV int vstart() {
  int nb = gridDim.x, b = blockIdx.x;
  return (nb % 8 == 0) ? (b % 8) * (nb / 8) + b / 8 : b;
}

DEV int lds_byte(int r, int c) {
  int st = (r >> 4) * 2 + (c >> 5), rr = r & 15, cc = c & 31, ob = rr * 64 + cc * 2;
  return st * 1024 + (ob ^ (((ob >> 9) & 1) << 5));
}
DEV void stage_rc(int b, int& R, int& C) {
  int st = b / 1024, sb = b % 1024, swz = sb ^ (((sb >> 9) & 1) << 5);
  R = (st >> 1) * 16 + swz / 64; C = (st & 1) * 32 + (swz % 64) / 2;
}
#define GLDS16(g, l) __builtin_amdgcn_global_load_lds((const unsigned*)(g), (unsigned*)(l), 16, 0, 0)

typedef f32x4 Acc[4][4];

template <class AF, class EF>
DEV void gemm_tile(const u16* __restrict__ Abase, AF aoff, const u16* __restrict__ Bt, int K, EF epi) {
  const int tid = otid(), wid = tid >> 6, lane = tid & 63, wr = wid >> 1, wc = wid & 1, fr = lane & 15, fq = lane >> 4;
  unsigned ao[2][2], bo[2];
#pragma unroll
  for (int i = 0; i < 2; ++i) {
    int R, C; stage_rc(tid * 16 + i * 8192, R, C);
    ao[0][i] = aoff(R) + C;
    ao[1][i] = aoff(128 + R) + C;
    bo[i] = (unsigned)(R * K + C);
  }
  Acc acc;
#pragma unroll
  for (int m = 0; m < 4; ++m)
#pragma unroll
    for (int n = 0; n < 4; ++n) acc[m][n] = f32x4{0.f, 0.f, 0.f, 0.f};
  const int nt = K / 64;
  auto stage = [&](int buf, int kt) {
    char* base = smem + buf * 49152 + tid * 16;
#pragma unroll
    for (int i = 0; i < 2; ++i) {
      GLDS16(Abase + ao[0][i] + kt * 64, base + i * 8192);
      GLDS16(Abase + ao[1][i] + kt * 64, base + 16384 + i * 8192);
      GLDS16(Bt + bo[i] + kt * 64, base + 32768 + i * 8192);
    }
  };
  stage(0, 0);
#pragma unroll 1
  for (int t = 0; t < nt; ++t) {
    asm volatile("s_waitcnt vmcnt(0)" ::: "memory");
    __syncthreads();
    if (t + 1 < nt) stage((t + 1) & 1, t + 1);
    const char* sa = smem + (t & 1) * 49152 + (wr >> 1) * 16384;
    const char* sb = smem + (t & 1) * 49152 + 32768;
    bf16x8 Af[4][2], Bf[4][2];
#pragma unroll
    for (int m = 0; m < 4; ++m)
#pragma unroll
      for (int k = 0; k < 2; ++k)
        Af[m][k] = *reinterpret_cast<const bf16x8*>(sa + lds_byte((wr & 1) * 64 + m * 16 + fr, k * 32 + fq * 8));
#pragma unroll
    for (int n = 0; n < 4; ++n)
#pragma unroll
      for (int k = 0; k < 2; ++k)
        Bf[n][k] = *reinterpret_cast<const bf16x8*>(sb + lds_byte(wc * 64 + n * 16 + fr, k * 32 + fq * 8));
#pragma unroll
    for (int m = 0; m < 4; ++m)
#pragma unroll
      for (int n = 0; n < 4; ++n)
#pragma unroll
        for (int k = 0; k < 2; ++k)
          acc[m][n] = __builtin_amdgcn_mfma_f32_16x16x32_bf16(Af[m][k], Bf[n][k], acc[m][n], 0, 0, 0);
  }
  __syncthreads();
  epi(acc, wr, wc, fr, fq);
}
#define EPI_FOR _Pragma("unroll") for (int m = 0; m < 4; ++m) _Pragma("unroll") for (int n = 0; n < 4; ++n)
#define EPI_ROW0 (wr * 64 + m * 16 + fq * 4)
#define EPI_COL (wc * 64 + n * 16 + fr)

DEV void tile_mn(int v, int NT, int& mt, int& nt) {
  int mi = v & 7, rest = v >> 3;
  nt = rest % NT; mt = (rest / NT) * 8 + mi;
}

DEV void conv_tile(const ConvJob& J, int t) {
  const int tid = otid();
  int mat = t / J.tpm, tt = t % J.tpm;
  int kt = tt / J.ntn, nt = tt % J.ntn;
  const float* src = J.src + (long)mat * J.sstride;
  u16* dst = J.dst + (long)mat * J.dstride;
  const int kg = tid >> 6, ng = tid & 63;
  const int n = nt * 256 + ng * 4;
  float4 v[8];
#pragma unroll
  for (int j = 0; j < 8; ++j) {
    int k = kt * 64 + kg * 8 + j;
    if (n < J.N) v[j] = *reinterpret_cast<const float4*>(src + (long)k * J.N + n);
    else v[j] = make_float4(0.f, 0.f, 0.f, 0.f);
  }
#pragma unroll
  for (int i = 0; i < 4; ++i) {
    float e[8];
#pragma unroll
    for (int j = 0; j < 8; ++j) e[j] = (i == 0) ? v[j].x : (i == 1) ? v[j].y : (i == 2) ? v[j].z : v[j].w;
    uint4 pk;
    pk.x = pack2(e[0], e[1]); pk.y = pack2(e[2], e[3]); pk.z = pack2(e[4], e[5]); pk.w = pack2(e[6], e[7]);
    *reinterpret_cast<uint4*>(smem + (i * 64 + ng) * 144 + kg * 16) = pk;
  }
  __syncthreads();
#pragma unroll
  for (int u = 0; u < 4; ++u) {
    int q = tid + 512 * u;
    int nl = q >> 3, ch = q & 7;
    uint4 pk = *reinterpret_cast<const uint4*>(smem + ((nl & 3) * 64 + (nl >> 2)) * 144 + ch * 16);
    int nn = nt * 256 + nl;
    long drow = (long)(nn >> J.rsh) * J.rs + (nn & ((1 << J.rsh) - 1)) + J.off;
    *reinterpret_cast<uint4*>(dst + drow * J.K + kt * 64 + ch * 8) = pk;
  }
  __syncthreads();
}

DEV void phase_prep(const Params& p) {
  const int tid = otid(), nb = gridDim.x, bid = blockIdx.x;
  {
    float* zb = reinterpret_cast<float*>(smem);
    float* h1b = zb + 512;
    float* h2g = reinterpret_cast<float*>(p.ws + S_H2);
    const int w = tid >> 6, lane = tid & 63;
    for (int l0 = bid * 8; l0 < SEQ; l0 += nb * 8) {
      int l = l0 + w;
      float tt = (float)l / (float)(SEQ - 1);
      float ww = 6.283185307179586f * (float)l / (float)SEQ;
      float z = 0.f;
      if (lane == 0) z = tt;
      else if (lane <= 16) { float f = 1e-4f + (float)(lane - 1) * ((15.0f - 1e-4f) / 15.0f); z = cosf(f * ww); }
      else if (lane <= 32) { float f = 1e-4f + (float)(lane - 17) * ((15.0f - 1e-4f) / 15.0f); z = -sinf(f * ww); }
      zb[w * 64 + lane] = z;
      __syncthreads();
      float fr_ = p.hy_f_freq[lane];
      float a = p.hy_f_b1[lane];
      for (int k = 0; k < 33; ++k) a += zb[w * 64 + k] * p.hy_f_w1[k * 64 + lane];
      h1b[w * 64 + lane] = sinf(fr_ * a);
      __syncthreads();
      float a2 = p.hy_f_b2[lane];
      for (int k = 0; k < 64; ++k) a2 += h1b[w * 64 + k] * p.hy_f_w2[k * 64 + lane];
      h2g[l * 64 + lane] = sinf(fr_ * a2);
      __syncthreads();
    }
  }
  {
    u16* xb = reinterpret_cast<u16*>(p.ws + REG_X);
    const long n8 = (long)TOK * DM / 8;
    for (long i = (long)bid * 512 + tid; i < n8; i += (long)nb * 512) {
      float4 a = reinterpret_cast<const float4*>(p.x)[2 * i], b = reinterpret_cast<const float4*>(p.x)[2 * i + 1];
      uint4 pk; pk.x = pack2(a.x, a.y); pk.y = pack2(a.z, a.w); pk.z = pack2(b.x, b.y); pk.w = pack2(b.z, b.w);
      reinterpret_cast<uint4*>(xb)[i] = pk;
    }
    u16* pb = reinterpret_cast<u16*>(p.ws + REG_P);
    const long m8 = 2L * TOK * 256 / 8;
    for (long i = (long)bid * 512 + tid; i < m8; i += (long)nb * 512) {
      float4 a = reinterpret_cast<const float4*>(p.p)[2 * i], b = reinterpret_cast<const float4*>(p.p)[2 * i + 1];
      uint4 pk; pk.x = pack2(a.x, a.y); pk.y = pack2(a.z, a.w); pk.z = pack2(b.x, b.y); pk.w = pack2(b.z, b.w);
      reinterpret_cast<uint4*>(pb)[i] = pk;
    }
  }
  for (int t = bid; t < p.conv_total; t += nb) {
    int j = 0;
#pragma unroll 1
    for (int q = 1; q < NJOBS; ++q) if (t >= p.jobs[q].tile0 && p.jobs[q].ntiles > 0) j = q;
    conv_tile(p.jobs[j], t - p.jobs[j].tile0);
  }
}

DEV void filter_b(const Params& p, int cpair) {
  const int tid = otid();
  float* w3s = reinterpret_cast<float*>(smem);
  float* red = w3s + 512;
  float* nrm = red + 32;
  float* hb = nrm + 4;
  const float* h2g = reinterpret_cast<const float*>(p.ws + S_H2);
  {
    int ci = tid >> 6, k = tid & 63;
    int o = ci >> 2, d = (ci >> 1) & 1, cc = ci & 1;
    w3s[ci * 64 + k] = p.hy_f_w3[k * 2048 + o * 1024 + d * 512 + 2 * cpair + cc];
  }
  __syncthreads();
  const float min_decay = logf(1e-2f) / 1.5f, max_decay = logf(1e-2f) / 0.3f;
#pragma unroll 1
  for (int i = 0; i < 4; ++i) {
    int l = tid + 512 * i;
    float h2[64];
#pragma unroll
    for (int k = 0; k < 16; ++k) {
      float4 v = *reinterpret_cast<const float4*>(h2g + l * 64 + k * 4);
      h2[4 * k] = v.x; h2[4 * k + 1] = v.y; h2[4 * k + 2] = v.z; h2[4 * k + 3] = v.w;
    }
    float tt = (float)l / (float)(SEQ - 1);
#pragma unroll 1
    for (int ci = 0; ci < 8; ++ci) {
      float a = 0.f;
#pragma unroll
      for (int k = 0; k < 64; ++k) a += h2[k] * w3s[ci * 64 + k];
      int cc = ci & 1;
      int c = 2 * cpair + cc;
      float delta = fabsf(min_decay + (float)c * ((max_decay - min_decay) / 511.0f));
      a *= expf(-tt * delta);
      hb[ci * 2048 + l] = a;
    }
  }
  __syncthreads();
  {
    float ss[4];
#pragma unroll
    for (int oc = 0; oc < 4; ++oc) {
      int o = oc >> 1, cc = oc & 1;
      float a = 0.f;
      for (int l = tid; l < 2048; l += 512) {
        float f = hb[(o * 4 + 0 + cc) * 2048 + l];
        float b = (l > 0) ? hb[(o * 4 + 2 + cc) * 2048 + l] : 0.f;
        a += f * f + b * b;
      }
      ss[oc] = wave_sum(a);
    }
    if ((tid & 63) == 0) {
#pragma unroll
      for (int q = 0; q < 4; ++q) red[(tid >> 6) * 4 + q] = ss[q];
    }
  }
  __syncthreads();
  if (tid < 4) {
    float s = 0.f;
    for (int w = 0; w < 8; ++w) s += red[w * 4 + tid];
    nrm[tid] = rsqrtf(s + 1e-12f);
  }
  __syncthreads();
  u16* Rg = reinterpret_cast<u16*>(p.ws + S_RG);
  for (int q = tid; q < 4 * 4096; q += 512) {
    int oc = q >> 12, qq = q & 4095;
    int o = oc >> 1, cc = oc & 1;
    float v;
    if (qq == 0) v = 0.f;
    else if (qq <= 2048) v = hb[(o * 4 + 0 * 2 + cc) * 2048 + (2048 - qq)];
    else v = hb[(o * 4 + 1 * 2 + cc) * 2048 + (qq - 2048)];
    v *= nrm[oc];
    Rg[((long)o * 512 + 2 * cpair + cc) * 4096 + qq] = f2bf(v);
  }
  __syncthreads();
}

DEV void phase_abin(const Params& p) {
  const int nb = gridDim.x;
  for (int c = blockIdx.x; c < 256; c += nb) filter_b(p, c);
  const u16* xb = reinterpret_cast<const u16*>(p.ws + REG_X);
  const u16* wt = reinterpret_cast<const u16*>(p.ws + W_ABIN);
  u16* qk = reinterpret_cast<u16*>(p.ws + REG_B);
  u16* vht = reinterpret_cast<u16*>(p.ws + REG_B + 33554432ull);
  for (int v = vstart(); v < 64 * 24; v += nb) {
    int mt, nt; tile_mn(v, 24, mt, nt);
    const int brow = mt * 256, bcol = nt * 128;
    gemm_tile(xb + (long)brow * 1024, [&](int r) { return (unsigned)(r * 1024); }, wt + (long)bcol * 1024, 1024,
            [&](Acc& acc, int wr, int wc, int fr, int fq) {
              if (bcol < 1024) {
                const float sc = (bcol < 512) ? 0.125f : 1.0f;
                u16* dst = qk + (long)brow * 1024 + bcol;
                EPI_FOR {
#pragma unroll
                  for (int j = 0; j < 4; ++j) dst[(EPI_ROW0 + j) * 1024 + EPI_COL] = f2bf(acc[m][n][j] * sc);
                }
              } else {
                u16* dst = vht + (long)(bcol - 1024) * TOK + brow;
                EPI_FOR {
                  uint2 pk; pk.x = pack2(acc[m][n][0], acc[m][n][1]); pk.y = pack2(acc[m][n][2], acc[m][n][3]);
                  *reinterpret_cast<uint2*>(dst + (long)EPI_COL * TOK + EPI_ROW0) = pk;
                }
              }
            });
  }
}

DEV void na_unit(const Params& p, int u) {
  const int lane = otid() & 63, fr = lane & 15, fq = lane >> 4;
  const int g = u & 3, r = (u >> 2) & 31, h = (u >> 7) & 7, b = u >> 10;
  const int r0 = min(max(r - 4, 0), 24), cs = min(max(16 * g - 8, 0), 32);
  const u16* qk = reinterpret_cast<const u16*>(p.ws + REG_B);
  const u16* vht = reinterpret_cast<const u16*>(p.ws + REG_B + 33554432ull);
  u16* cat = reinterpret_cast<u16*>(p.ws + REG_A + 100663296ull);
  const int c = 16 * g + fr;
  const long tokq = (long)b * SEQ + r * 64 + c;
  bf16x8 qf[2];
#pragma unroll
  for (int ks = 0; ks < 2; ++ks) qf[ks] = *reinterpret_cast<const bf16x8*>(qk + tokq * 1024 + h * 64 + ks * 32 + fq * 8);
  f32x4 s[16];
#pragma unroll
  for (int kt = 0; kt < 16; ++kt) {
    const int w = kt >> 1, half = kt & 1;
    const long tokk = (long)b * SEQ + (r0 + w) * 64 + cs + 16 * half + fr;
    bf16x8 k0 = *reinterpret_cast<const bf16x8*>(qk + tokk * 1024 + 512 + h * 64 + fq * 8);
    bf16x8 k1 = *reinterpret_cast<const bf16x8*>(qk + tokk * 1024 + 512 + h * 64 + 32 + fq * 8);
    f32x4 a = {0.f, 0.f, 0.f, 0.f};
    a = __builtin_amdgcn_mfma_f32_16x16x32_bf16(k0, qf[0], a, 0, 0, 0);
    a = __builtin_amdgcn_mfma_f32_16x16x32_bf16(k1, qf[1], a, 0, 0, 0);
    s[kt] = a;
  }
  const int c0 = min(max(c - 8, 0), 48);
  const float* rpb = p.na_rpb + h * 15 * 31;
  float mx = -1e30f;
#pragma unroll
  for (int kt = 0; kt < 16; ++kt) {
    const int w = kt >> 1, half = kt & 1;
    const int dr = r0 + w - r + 7;
#pragma unroll
    for (int j = 0; j < 4; ++j) {
      int kc = cs + 16 * half + 4 * fq + j;
      bool valid = (kc >= c0) && (kc < c0 + 16);
      int dc = min(max(kc - c, -15), 15) + 15;
      float bias = rpb[dr * 31 + dc];
      float v = valid ? (s[kt][j] + bias) : -1e30f;
      s[kt][j] = v;
      mx = fmaxf(mx, v);
    }
  }
  mx = fmaxf(mx, __shfl_xor(mx, 16));
  mx = fmaxf(mx, __shfl_xor(mx, 32));
  float sum = 0.f;
#pragma unroll
  for (int kt = 0; kt < 16; ++kt)
#pragma unroll
    for (int j = 0; j < 4; ++j) { float e = __expf(s[kt][j] - mx); s[kt][j] = e; sum += e; }
  sum += __shfl_xor(sum, 16);
  sum += __shfl_xor(sum, 32);
  f32x4 o[4];
#pragma unroll
  for (int dt = 0; dt < 4; ++dt) o[dt] = f32x4{0.f, 0.f, 0.f, 0.f};
#pragma unroll
  for (int w = 0; w < 8; ++w) {
    union { bf16x8 v; unsigned u[4]; } pf;
    pf.u[0] = pack2(s[2 * w][0], s[2 * w][1]); pf.u[1] = pack2(s[2 * w][2], s[2 * w][3]);
    pf.u[2] = pack2(s[2 * w + 1][0], s[2 * w + 1][1]); pf.u[3] = pack2(s[2 * w + 1][2], s[2 * w + 1][3]);
    const long tk = (long)b * SEQ + (r0 + w) * 64 + cs + 4 * fq;
#pragma unroll
    for (int dt = 0; dt < 4; ++dt) {
      const u16* vp = vht + (long)(h * 64 + dt * 16 + fr) * TOK + tk;
      union { bf16x8 v; uint2 u[2]; } af;
      af.u[0] = *reinterpret_cast<const uint2*>(vp);
      af.u[1] = *reinterpret_cast<const uint2*>(vp + 16);
      o[dt] = __builtin_amdgcn_mfma_f32_16x16x32_bf16(af.v, pf.v, o[dt], 0, 0, 0);
    }
  }
  const float inv = 1.0f / sum;
#pragma unroll
  for (int dt = 0; dt < 4; ++dt) {
    uint2 pk; pk.x = pack2(o[dt][0] * inv, o[dt][1] * inv); pk.y = pack2(o[dt][2] * inv, o[dt][3] * inv);
    *reinterpret_cast<uint2*>(cat + tokq * 1024 + h * 64 + dt * 16 + 4 * fq) = pk;
  }
}

constexpr int UB_STRIDE = 2056;
constexpr int RC_STRIDE = 4128;
DEV float shortconv(const u16* hrow, const float* cw, float cb, int ch, int t) {
  float xm = (t > 0) ? bf2f(hrow[t - 1]) : 0.f;
  float x0 = bf2f(hrow[t]);
  float xp = (t < SEQ - 1) ? bf2f(hrow[t + 1]) : 0.f;
  return cb + xm * cw[ch] + x0 * cw[1536 + ch] + xp * cw[2 * 1536 + ch];
}
DEV void load_rc(const Params& p, int o, int c) {
  u16* rc = reinterpret_cast<u16*>(smem + 2 * NBATCH * UB_STRIDE * 2);
  const u16* Rg = reinterpret_cast<const u16*>(p.ws + S_RG) + ((long)o * 512 + c) * 4096;
  for (int i = otid(); i < 4096; i += 512) {
    u16 v = Rg[i];
#pragma unroll
    for (int m = 0; m < 4; ++m) if (i - m >= 0) rc[m * RC_STRIDE + i - m] = v;
  }
}
DEV void hyena_conv(const u16* ub, f32x4 (&acc)[16]) {
  const int lane = otid() & 63, wid = otid() >> 6, fr = lane & 15, fq = lane >> 4;
  const u16* rc = reinterpret_cast<const u16*>(smem + 2 * NBATCH * UB_STRIDE * 2);
  const int mcopy = (-fr) & 3;
  const u16* rbase = rc + mcopy * RC_STRIDE;
#pragma unroll
  for (int i = 0; i < 16; ++i) acc[i] = f32x4{0.f, 0.f, 0.f, 0.f};
  const u16* urow = ub + (fr & 7) * UB_STRIDE + fq * 8;
  const int tile0 = wid * 16;
  for (int kk = 0; kk < 64; ++kk) {
    bf16x8 bfr = *reinterpret_cast<const bf16x8*>(urow + kk * 32);
#pragma unroll
    for (int tt = 0; tt < 16; ++tt) {
      int idx0 = 32 * kk + 8 * fq - (16 * (tile0 + tt) + fr) + 2048 - mcopy;
      union { bf16x8 v; uint2 u[2]; } af;
      af.u[0] = *reinterpret_cast<const uint2*>(rbase + idx0);
      af.u[1] = *reinterpret_cast<const uint2*>(rbase + idx0 + 4);
      acc[tt] = __builtin_amdgcn_mfma_f32_16x16x32_bf16(af.v, bfr, acc[tt], 0, 0, 0);
    }
  }
}
DEV void hyena_unit(const Params& p, int c) {
  const int tid = otid(), lane = tid & 63, wid = tid >> 6, fr = lane & 15, fq = lane >> 4;
  u16* ub0 = reinterpret_cast<u16*>(smem);
  u16* ub1 = ub0 + NBATCH * UB_STRIDE;
  const u16* hbt = reinterpret_cast<const u16*>(p.ws + REG_B + 33554432ull) + 512L * TOK;
  u16* cat = reinterpret_cast<u16*>(p.ws + REG_A + 100663296ull);
  const float* cw = p.hy_conv_w;
  {
    const float cb = p.hy_conv_b[c];
    for (int i = tid; i < TOK; i += 512) {
      int b = i >> 11, t = i & 2047;
      float z = shortconv(hbt + (long)c * TOK + b * SEQ, cw, cb, c, t);
      ub0[b * UB_STRIDE + t] = f2bf(z);
    }
  }
  load_rc(p, 0, c);
  __syncthreads();
  f32x4 acc[16];
  hyena_conv(ub0, acc);
  if (fr < 8) {
    const int b = fr;
    const float skip = p.hy_skip[c];
    const float cb = p.hy_conv_b[512 + c];
    const u16* hrow = hbt + (long)(512 + c) * TOK + b * SEQ;
#pragma unroll
    for (int tt = 0; tt < 16; ++tt)
#pragma unroll
      for (int j = 0; j < 4; ++j) {
        int t = (wid * 16 + tt) * 16 + fq * 4 + j;
        float y = acc[tt][j] + bf2f(ub0[b * UB_STRIDE + t]) * skip;
        float x1 = shortconv(hrow, cw, cb, 512 + c, t);
        ub1[b * UB_STRIDE + t] = f2bf(x1 * y);
      }
  }
  __syncthreads();
  load_rc(p, 1, c);
  __syncthreads();
  hyena_conv(ub1, acc);
  if (fr < 8) {
    const int b = fr;
    const float skip = p.hy_skip[512 + c];
    const float cb = p.hy_conv_b[1024 + c];
    const u16* hrow = hbt + (long)(1024 + c) * TOK + b * SEQ;
#pragma unroll
    for (int tt = 0; tt < 16; ++tt)
#pragma unroll
      for (int j = 0; j < 4; ++j) {
        int t = (wid * 16 + tt) * 16 + fq * 4 + j;
        float y = acc[tt][j] + bf2f(ub1[b * UB_STRIDE + t]) * skip;
        float x2 = shortconv(hrow, cw, cb, 1024 + c, t);
        cat[((long)b * SEQ + t) * 1024 + 512 + c] = f2bf(x2 * y);
      }
  }
  __syncthreads();
}
DEV void phase_mix0(const Params& p) {
  const int nb = gridDim.x;
  for (int c = blockIdx.x; c < 512; c += nb) hyena_unit(p, c);
  const int wid = otid() >> 6;
  for (int u = blockIdx.x * 8 + wid; u < 8192; u += nb * 8) na_unit(p, u);
}

DEV void phase_outproj(const Params& p, const u16* A, const u16* wt, const float* xres) {
  const int nb = gridDim.x;
  float* pre1 = reinterpret_cast<float*>(p.ws + REG_C);
  for (int v = vstart(); v < 64 * 8; v += nb) {
    int mt, nt; tile_mn(v, 8, mt, nt);
    const int brow = mt * 256, bcol = nt * 128;
    gemm_tile(A + (long)brow * 1024, [&](int r) { return (unsigned)(r * 1024); }, wt + (long)bcol * 1024, 1024,
            [&](Acc& acc, int wr, int wc, int fr, int fq) {
              float* dst = pre1 + (long)brow * 1024 + bcol;
              const float* xr = xres + (long)brow * 1024 + bcol;
              EPI_FOR {
#pragma unroll
                for (int j = 0; j < 4; ++j) {
                  int o = (EPI_ROW0 + j) * 1024 + EPI_COL;
                  dst[o] = DN_ALPHA * xr[o] + acc[m][n][j];
                }
              }
            });
  }
}

DEV void phase_ln1_router(const Params& p, int layer) {
  const int tid = otid(), lane = tid & 63, wid = tid >> 6, nb = gridDim.x;
  float* wrT = reinterpret_cast<float*>(smem);
  const float* wr = p.moe_router + (long)layer * 1024 * 16;
  for (int i = tid; i < 16384; i += 512) { int c = i >> 4, e = i & 15; wrT[e * 1024 + c] = wr[i]; }
  __syncthreads();
  const float* pre1 = reinterpret_cast<const float*>(p.ws + REG_C);
  float* x1 = reinterpret_cast<float*>(p.ws + REG_D);
  u16* x1b = reinterpret_cast<u16*>(p.ws + REG_E);
  float* aff = reinterpret_cast<float*>(p.ws + S_AFF);
  const float* g = p.ln1_g + layer * 1024; const float* bb = p.ln1_b + layer * 1024;
  for (int tok = blockIdx.x * 8 + wid; tok < TOK; tok += nb * 8) {
    float4 v[4];
    float s = 0.f;
#pragma unroll
    for (int i = 0; i < 4; ++i) { v[i] = *reinterpret_cast<const float4*>(pre1 + (long)tok * 1024 + i * 256 + lane * 4); s += v[i].x + v[i].y + v[i].z + v[i].w; }
    float mu = wave_sum(s) * (1.0f / 1024.0f);
    float q = 0.f;
#pragma unroll
    for (int i = 0; i < 4; ++i) { v[i].x -= mu; v[i].y -= mu; v[i].z -= mu; v[i].w -= mu; q += v[i].x * v[i].x + v[i].y * v[i].y + v[i].z * v[i].z + v[i].w * v[i].w; }
    float rstd = rsqrtf(wave_sum(q) * (1.0f / 1024.0f) + LN_EPS);
    float4 y[4];
#pragma unroll
    for (int i = 0; i < 4; ++i) {
      int c = i * 256 + lane * 4;
      float4 gg = *reinterpret_cast<const float4*>(g + c), b4 = *reinterpret_cast<const float4*>(bb + c);
      y[i].x = v[i].x * rstd * gg.x + b4.x; y[i].y = v[i].y * rstd * gg.y + b4.y; y[i].z = v[i].z * rstd * gg.z + b4.z; y[i].w = v[i].w * rstd * gg.w + b4.w;
      *reinterpret_cast<float4*>(x1 + (long)tok * 1024 + c) = y[i];
      uint2 pk; pk.x = pack2(y[i].x, y[i].y); pk.y = pack2(y[i].z, y[i].w);
      *reinterpret_cast<uint2*>(x1b + (long)tok * 1024 + c) = pk;
    }
    float mine = 0.f;
#pragma unroll 1
    for (int e = 0; e < 16; ++e) {
      float a = 0.f;
#pragma unroll
      for (int i = 0; i < 4; ++i) {
        float4 w4 = *reinterpret_cast<const float4*>(wrT + e * 1024 + i * 256 + lane * 4);
        a += y[i].x * w4.x + y[i].y * w4.y + y[i].z * w4.z + y[i].w * w4.w;
      }
      a = wave_sum(a);
      if (lane == e) mine = a;
    }
    float mx = mine;
#pragma unroll
    for (int o = 8; o > 0; o >>= 1) mx = fmaxf(mx, __shfl_xor(mx, o));
    float ex = expf(mine - mx);
    float den = ex;
#pragma unroll
    for (int o = 8; o > 0; o >>= 1) den += __shfl_xor(den, o);
    if (lane < 16) {
      int b = tok >> 11, l = tok & 2047;
      aff[((long)b * 16 + lane) * SEQ + l] = ex / den;
    }
  }
}

DEV void phase_topk(const Params& p) {
  const int tid = otid(), nb = gridDim.x;
  float* a = reinterpret_cast<float*>(smem);
  const float* aff = reinterpret_cast<const float*>(p.ws + S_AFF);
  int* idx = reinterpret_cast<int*>(p.ws + S_IDX);
  float* gsel = reinterpret_cast<float*>(p.ws + S_GSEL);
  int* slot = reinterpret_cast<int*>(p.ws + S_SLOT);
  for (int u = blockIdx.x; u < 256; u += nb) {
    const int be = u >> 1, half = u & 1;
    const int b = be >> 4, e = be & 15;
    __syncthreads();
    for (int i = tid; i < SEQ; i += 512) a[i] = aff[(long)be * SEQ + i];
    __syncthreads();
    const int i0 = half * 1024 + tid, i1 = i0 + 512;
    const float v0 = a[i0], v1 = a[i1];
    int r0 = 0, r1 = 0;
    for (int j = 0; j < SEQ; j += 4) {
      float4 w = *reinterpret_cast<const float4*>(a + j);
      r0 += (w.x > v0) || (w.x == v0 && j < i0);
      r0 += (w.y > v0) || (w.y == v0 && j + 1 < i0);
      r0 += (w.z > v0) || (w.z == v0 && j + 2 < i0);
      r0 += (w.w > v0) || (w.w == v0 && j + 3 < i0);
      r1 += (w.x > v1) || (w.x == v1 && j < i1);
      r1 += (w.y > v1) || (w.y == v1 && j + 1 < i1);
      r1 += (w.z > v1) || (w.z == v1 && j + 2 < i1);
      r1 += (w.w > v1) || (w.w == v1 && j + 3 < i1);
    }
    if (r0 < CAP) { idx[be * CAP + r0] = i0; gsel[be * CAP + r0] = v0; }
    if (r1 < CAP) { idx[be * CAP + r1] = i1; gsel[be * CAP + r1] = v1; }
    slot[((long)b * SEQ + i0) * 16 + e] = (r0 < CAP) ? r0 : -1;
    slot[((long)b * SEQ + i1) * 16 + e] = (r1 < CAP) ? r1 : -1;
  }
}

DEV void phase_moe1(const Params& p, int layer) {
  const int nb = gridDim.x;
  const u16* x1b = reinterpret_cast<const u16*>(p.ws + REG_E);
  const u16* wgu = reinterpret_cast<const u16*>(p.ws + W_GU) + (long)layer * 16 * 4096 * 1024;
  const int* idx = reinterpret_cast<const int*>(p.ws + S_IDX);
  u16* H = reinterpret_cast<u16*>(p.ws + REG_A);
  for (int v = vstart(); v < 128 * 32; v += nb) {
    int mt, nt; tile_mn(v, 32, mt, nt);
    const int e = mt >> 3, b = mt & 7;
    const int* ix = idx + (b * 16 + e) * CAP;
    gemm_tile(x1b + (long)b * SEQ * 1024, [&](int r) { return (unsigned)(ix[r] * 1024); }, wgu + ((long)e * 4096 + nt * 128) * 1024, 1024,
            [&](Acc& acc, int wr, int wc, int fr, int fq) {
              u16* dst = H + ((long)(e * 8 + b) * CAP) * DFF + nt * 64;
#pragma unroll
              for (int m = 0; m < 4; ++m)
#pragma unroll
                for (int n2 = 0; n2 < 2; ++n2)
#pragma unroll
                  for (int j = 0; j < 4; ++j) {
                    int r = wr * 64 + m * 16 + fq * 4 + j;
                    int col = wc * 32 + n2 * 16 + fr;
                    float gte = acc[m][2 * n2][j], up = acc[m][2 * n2 + 1][j];
                    float hv = gte / (1.0f + __expf(-gte)) * up;
                    dst[r * DFF + col] = f2bf(hv);
                  }
            });
  }
}
DEV void phase_moe2(const Params& p, int layer) {
  const int nb = gridDim.x;
  const u16* H = reinterpret_cast<const u16*>(p.ws + REG_A);
  const u16* wd = reinterpret_cast<const u16*>(p.ws + W_DN) + (long)layer * 16 * 1024 * 2048;
  const float* gsel = reinterpret_cast<const float*>(p.ws + S_GSEL);
  float* Ye = reinterpret_cast<float*>(p.ws + REG_B);
  for (int v = vstart(); v < 128 * 8; v += nb) {
    int mt, nt; tile_mn(v, 8, mt, nt);
    const int e = mt >> 3, b = mt & 7;
    const long row0 = (long)(e * 8 + b) * CAP;
    const float* gs = gsel + (b * 16 + e) * CAP;
    gemm_tile(H + row0 * DFF, [&](int r) { return (unsigned)(r * DFF); }, wd + ((long)e * 1024 + nt * 128) * 2048, 2048,
            [&](Acc& acc, int wr, int wc, int fr, int fq) {
              float* dst = Ye + row0 * 1024 + nt * 128;
              EPI_FOR {
#pragma unroll
                for (int j = 0; j < 4; ++j) dst[(EPI_ROW0 + j) * 1024 + EPI_COL] = acc[m][n][j] * gs[EPI_ROW0 + j];
              }
            });
  }
}
DEV void phase_ln2(const Params& p, int layer) {
  const int tid = otid(), lane = tid & 63, wid = tid >> 6, nb = gridDim.x;
  const float* x1 = reinterpret_cast<const float*>(p.ws + REG_D);
  const float* Ye = reinterpret_cast<const float*>(p.ws + REG_B);
  const int* slot = reinterpret_cast<const int*>(p.ws + S_SLOT);
  float* x2 = reinterpret_cast<float*>(p.ws + REG_A);
  u16* x2b = reinterpret_cast<u16*>(p.ws + REG_A + 67108864ull);
  const float* g = p.ln2_g + layer * 1024; const float* bb = p.ln2_b + layer * 1024;
  for (int tok = blockIdx.x * 8 + wid; tok < TOK; tok += nb * 8) {
    const int b = tok >> 11;
    float4 v[4];
#pragma unroll
    for (int i = 0; i < 4; ++i) {
      float4 t = *reinterpret_cast<const float4*>(x1 + (long)tok * 1024 + i * 256 + lane * 4);
      v[i].x = DN_ALPHA * t.x; v[i].y = DN_ALPHA * t.y; v[i].z = DN_ALPHA * t.z; v[i].w = DN_ALPHA * t.w;
    }
    int myslot = (lane < 16) ? slot[(long)tok * 16 + lane] : -1;
    for (int e = 0; e < 16; ++e) {
      int s = __shfl(myslot, e);
      if (s >= 0) {
        const float* yr = Ye + ((long)(e * 8 + b) * CAP + s) * 1024;
#pragma unroll
        for (int i = 0; i < 4; ++i) {
          float4 t = *reinterpret_cast<const float4*>(yr + i * 256 + lane * 4);
          v[i].x += t.x; v[i].y += t.y; v[i].z += t.z; v[i].w += t.w;
        }
      }
    }
    float s = 0.f;
#pragma unroll
    for (int i = 0; i < 4; ++i) s += v[i].x + v[i].y + v[i].z + v[i].w;
    float mu = wave_sum(s) * (1.0f / 1024.0f);
    float q = 0.f;
#pragma unroll
    for (int i = 0; i < 4; ++i) { v[i].x -= mu; v[i].y -= mu; v[i].z -= mu; v[i].w -= mu; q += v[i].x * v[i].x + v[i].y * v[i].y + v[i].z * v[i].z + v[i].w * v[i].w; }
    float rstd = rsqrtf(wave_sum(q) * (1.0f / 1024.0f) + LN_EPS);
#pragma unroll
    for (int i = 0; i < 4; ++i) {
      int c = i * 256 + lane * 4;
      float4 gg = *reinterpret_cast<const float4*>(g + c), b4 = *reinterpret_cast<const float4*>(bb + c);
      float4 y;
      y.x = v[i].x * rstd * gg.x + b4.x; y.y = v[i].y * rstd * gg.y + b4.y; y.z = v[i].z * rstd * gg.z + b4.z; y.w = v[i].w * rstd * gg.w + b4.w;
      *reinterpret_cast<float4*>(x2 + (long)tok * 1024 + c) = y;
      uint2 pk; pk.x = pack2(y.x, y.y); pk.y = pack2(y.z, y.w);
      *reinterpret_cast<uint2*>(x2b + (long)tok * 1024 + c) = pk;
    }
  }
}
DEV void phase_ple(const Params& p, int layer, float* outf, u16* outb) {
  const int nb = gridDim.x;
  const float* x2 = reinterpret_cast<const float*>(p.ws + REG_A);
  const u16* x2b = reinterpret_cast<const u16*>(p.ws + REG_A + 67108864ull);
  const u16* pb = reinterpret_cast<const u16*>(p.ws + REG_P) + (long)layer * TOK * 256;
  const u16* wg = reinterpret_cast<const u16*>(p.ws + W_PLEG) + (long)layer * 1024 * 1024;
  const u16* wp = reinterpret_cast<const u16*>(p.ws + W_PLEP) + (long)layer * 1024 * 256;
  float* pp = reinterpret_cast<float*>(p.ws + REG_C);
  for (int v = vstart(); v < 64 * 8; v += nb) {
    int mt, nt; tile_mn(v, 8, mt, nt);
    const int brow = mt * 256, bcol = nt * 128;
    const long tbase = (long)brow * 1024 + bcol;
    gemm_tile(pb + (long)brow * 256, [&](int r) { return (unsigned)(r * 256); }, wp + (long)bcol * 256, 256,
            [&](Acc& acc, int wr, int wc, int fr, int fq) {
              float* dst = pp + tbase;
              EPI_FOR {
#pragma unroll
                for (int j = 0; j < 4; ++j) dst[(EPI_ROW0 + j) * 1024 + EPI_COL] = acc[m][n][j];
              }
            });
    gemm_tile(x2b + (long)brow * 1024, [&](int r) { return (unsigned)(r * 1024); }, wg + (long)bcol * 1024, 1024,
            [&](Acc& acc, int wr, int wc, int fr, int fq) {
              EPI_FOR {
#pragma unroll
                for (int j = 0; j < 4; ++j) {
                  long o = tbase + (EPI_ROW0 + j) * 1024 + EPI_COL;
                  float a = acc[m][n][j];
                  float val = x2[o] + pp[o] / (1.0f + __expf(-a));
                  outf[o] = val;
                  if (outb) outb[o] = f2bf(val);
                }
              }
            });
  }
}
DEV void phase_mla_in(const Params& p) {
  const int nb = gridDim.x;
  const u16* xb = reinterpret_cast<const u16*>(p.ws + REG_X);
  const u16* wt = reinterpret_cast<const u16*>(p.ws + W_MLAIN);
  float* hm = reinterpret_cast<float*>(p.ws + REG_B);
  for (int v = vstart(); v < 64 * 6; v += nb) {
    int mt, nt; tile_mn(v, 6, mt, nt);
    const int brow = mt * 256, bcol = nt * 128;
    gemm_tile(xb + (long)brow * 1024, [&](int r) { return (unsigned)(r * 1024); }, wt + (long)bcol * 1024, 1024,
            [&](Acc& acc, int wr, int wc, int fr, int fq) {
              float* dst = hm + (long)brow * 768 + bcol;
              EPI_FOR {
#pragma unroll
                for (int j = 0; j < 4; ++j) dst[(EPI_ROW0 + j) * 768 + EPI_COL] = acc[m][n][j];
              }
            });
  }
}
constexpr size_t MLA_Q = REG_A, MLA_K = REG_A + 50331648ull, MLA_VT = REG_A + 100663296ull;
constexpr size_t MLA_CQN = REG_B + 50331648ull, MLA_CKVN = MLA_CQN + 12582912ull, MLA_O = MLA_CKVN + 8388608ull;
DEV float rope_inv(int i) { return 1.0f / powf(10000.0f, (float)i / 16.0f); }
DEV void phase_mla_norm(const Params& p) {
  const int tid = otid(), lane = tid & 63, wid = tid >> 6, nb = gridDim.x;
  const float* hm = reinterpret_cast<const float*>(p.ws + REG_B);
  u16* cqn = reinterpret_cast<u16*>(p.ws + MLA_CQN);
  u16* ckvn = reinterpret_cast<u16*>(p.ws + MLA_CKVN);
  u16* Kb = reinterpret_cast<u16*>(p.ws + MLA_K);
  for (int tok = blockIdx.x * 8 + wid; tok < TOK; tok += nb * 8) {
    const float* row = hm + (long)tok * 768;
    float q[6], kv[4];
    float sq = 0.f, skv = 0.f;
#pragma unroll
    for (int i = 0; i < 6; ++i) { q[i] = row[i * 64 + lane]; sq += q[i] * q[i]; }
#pragma unroll
    for (int i = 0; i < 4; ++i) { kv[i] = row[384 + i * 64 + lane]; skv += kv[i] * kv[i]; }
    float rq = rsqrtf(wave_sum(sq) * (1.0f / 384.0f) + LN_EPS);
    float rkv = rsqrtf(wave_sum(skv) * (1.0f / 256.0f) + LN_EPS);
#pragma unroll
    for (int i = 0; i < 6; ++i) cqn[(long)tok * 384 + i * 64 + lane] = f2bf(q[i] * rq * p.mla_q_norm[i * 64 + lane]);
#pragma unroll
    for (int i = 0; i < 4; ++i) ckvn[(long)tok * 256 + i * 64 + lane] = f2bf(kv[i] * rkv * p.mla_kv_norm[i * 64 + lane]);
    const int b = tok >> 11, l = tok & 2047;
    float kr = (lane < 32) ? row[640 + lane] : 0.f;
    float x1 = __shfl(kr, lane & 15), x2 = __shfl(kr, (lane & 15) + 16);
    float sn, cs; sincosf((float)l * rope_inv(lane & 15), &sn, &cs);
    float r = (lane & 16) ? (x1 * sn + x2 * cs) : (x1 * cs - x2 * sn);
    u16 rb = f2bf(r);
    for (int hh = 0; hh < 16; hh += 2) {
      int h = hh + (lane >> 5);
      u16 val = (u16)__shfl((int)rb, lane & 31);
      Kb[(((long)b * 16 + h) * SEQ + l) * 96 + 64 + (lane & 31)] = val;
    }
  }
}
DEV void phase_mla_up(const Params& p) {
  const int nb = gridDim.x;
  const u16* cqn = reinterpret_cast<const u16*>(p.ws + MLA_CQN);
  const u16* ckvn = reinterpret_cast<const u16*>(p.ws + MLA_CKVN);
  const u16* wq = reinterpret_cast<const u16*>(p.ws + W_QUP);
  const u16* wkv = reinterpret_cast<const u16*>(p.ws + W_KVUP);
  u16* Qb = reinterpret_cast<u16*>(p.ws + MLA_Q);
  u16* Kb = reinterpret_cast<u16*>(p.ws + MLA_K);
  u16* VT = reinterpret_cast<u16*>(p.ws + MLA_VT);
  const float qscale = 0.10206207261596577f * 1.4426950408889634f;
  for (int v = vstart(); v < 64 * 12 + 64 * 16; v += nb) {
    if (v < 64 * 12) {
      int mt, nt; tile_mn(v, 12, mt, nt);
      const int brow = mt * 256, bcol = nt * 128;
      gemm_tile(cqn + (long)brow * 384, [&](int r) { return (unsigned)(r * 384); }, wq + (long)bcol * 384, 384,
              [&](Acc& acc, int wr, int wc, int fr, int fq) {
                const float inv = rope_inv(fr);
#pragma unroll
                for (int n2 = 0; n2 < 2; ++n2) {
                  const int c32 = (bcol + wc * 64 + n2 * 32) >> 5;
                  const int h = c32 / 3, part = c32 % 3;
#pragma unroll
                  for (int m = 0; m < 4; ++m)
#pragma unroll
                    for (int j = 0; j < 4; ++j) {
                      const int tok = brow + wr * 64 + m * 16 + fq * 4 + j;
                      const int b = tok >> 11, l = tok & 2047;
                      u16* qrow = Qb + (((long)b * 16 + h) * SEQ + l) * 96 + part * 32;
                      float a0 = acc[m][2 * n2][j], a1 = acc[m][2 * n2 + 1][j];
                      if (part == 2) {
                        float sn, cs; sincosf((float)l * inv, &sn, &cs);
                        float r0 = a0 * cs - a1 * sn, r1 = a0 * sn + a1 * cs;
                        a0 = r0; a1 = r1;
                      }
                      qrow[fr] = f2bf(a0 * qscale);
                      qrow[16 + fr] = f2bf(a1 * qscale);
                    }
                }
              });
    } else {
      int mt, nt; tile_mn(v - 64 * 12, 16, mt, nt);
      const int brow = mt * 256, bcol = nt * 128;
      gemm_tile(ckvn + (long)brow * 256, [&](int r) { return (unsigned)(r * 256); }, wkv + (long)bcol * 256, 256,
              [&](Acc& acc, int wr, int wc, int fr, int fq) {
                const int h = nt;
                EPI_FOR {
                  const int row = brow + EPI_ROW0, d = EPI_COL;
                  const int b = row >> 11, l = row & 2047;
                  if (d < 64) {
#pragma unroll
                    for (int j = 0; j < 4; ++j) Kb[(((long)b * 16 + h) * SEQ + l + j) * 96 + d] = f2bf(acc[m][n][j]);
                  } else {
                    uint2 pk; pk.x = pack2(acc[m][n][0], acc[m][n][1]); pk.y = pack2(acc[m][n][2], acc[m][n][3]);
                    *reinterpret_cast<uint2*>(VT + (((long)b * 16 + h) * 64 + (d - 64)) * SEQ + l) = pk;
                  }
                }
              });
    }
  }
}
constexpr int KST = 104, VST = 68;
DEV void mla_attn_unit(const Params& p, int u) {
  const int tid = otid(), lane = tid & 63, wid = tid >> 6, fr = lane & 15, fq = lane >> 4;
  const int qb = u & 7, bh = u >> 3;
  const u16* Qb = reinterpret_cast<const u16*>(p.ws + MLA_Q) + (long)bh * SEQ * 96;
  const u16* Kb = reinterpret_cast<const u16*>(p.ws + MLA_K) + (long)bh * SEQ * 96;
  const u16* VT = reinterpret_cast<const u16*>(p.ws + MLA_VT) + (long)bh * 64 * SEQ;
  u16* O = reinterpret_cast<u16*>(p.ws + MLA_O);
  u16* kl = reinterpret_cast<u16*>(smem);
  u16* vl = kl + 2 * 64 * KST;
  bf16x8 qf[2][3];
#pragma unroll
  for (int qt = 0; qt < 2; ++qt)
#pragma unroll
    for (int ks = 0; ks < 3; ++ks)
      qf[qt][ks] = *reinterpret_cast<const bf16x8*>(Qb + (long)(qb * 256 + wid * 32 + qt * 16 + fr) * 96 + ks * 32 + fq * 8);
  f32x4 o[4][2];
#pragma unroll
  for (int dt = 0; dt < 4; ++dt)
#pragma unroll
    for (int qt = 0; qt < 2; ++qt) o[dt][qt] = f32x4{0.f, 0.f, 0.f, 0.f};
  float mrun[2] = {-1e30f, -1e30f}, lrun[2] = {0.f, 0.f};
  const int kc0 = tid, kc1 = 512 + tid;
  const int vd = tid >> 3, vpart = tid & 7;
  uint4 kr0, kr1 = make_uint4(0, 0, 0, 0), vr;
  auto gload = [&](int t) {
    const u16* kt = Kb + (long)t * 64 * 96;
    kr0 = *reinterpret_cast<const uint4*>(kt + kc0 * 8);
    if (tid < 256) kr1 = *reinterpret_cast<const uint4*>(kt + kc1 * 8);
    vr = *reinterpret_cast<const uint4*>(VT + (long)vd * SEQ + t * 64 + vpart * 8);
  };
  auto lstore = [&](int buf) {
    u16* kd = kl + buf * 64 * KST; u16* vdst = vl + buf * 64 * VST;
    *reinterpret_cast<uint4*>(kd + (kc0 / 12) * KST + (kc0 % 12) * 8) = kr0;
    if (tid < 256) *reinterpret_cast<uint4*>(kd + (kc1 / 12) * KST + (kc1 % 12) * 8) = kr1;
    *reinterpret_cast<uint2*>(vdst + vd * VST + vpart * 8) = make_uint2(vr.x, vr.y);
    *reinterpret_cast<uint2*>(vdst + vd * VST + vpart * 8 + 4) = make_uint2(vr.z, vr.w);
  };
  __syncthreads();
  gload(0); lstore(0);
  __syncthreads();
  for (int t = 0; t < 32; ++t) {
    const int cur = t & 1;
    if (t + 1 < 32) gload(t + 1);
    const u16* kd = kl + cur * 64 * KST; const u16* vdl = vl + cur * 64 * VST;
    f32x4 s[4][2];
#pragma unroll
    for (int kt = 0; kt < 4; ++kt) {
      bf16x8 kf[3];
#pragma unroll
      for (int ks = 0; ks < 3; ++ks) kf[ks] = *reinterpret_cast<const bf16x8*>(kd + (kt * 16 + fr) * KST + ks * 32 + fq * 8);
#pragma unroll
      for (int qt = 0; qt < 2; ++qt) {
        f32x4 a = {0.f, 0.f, 0.f, 0.f};
#pragma unroll
        for (int ks = 0; ks < 3; ++ks) a = __builtin_amdgcn_mfma_f32_16x16x32_bf16(kf[ks], qf[qt][ks], a, 0, 0, 0);
        s[kt][qt] = a;
      }
    }
    bf16x8 pf[2][2];
#pragma unroll
    for (int qt = 0; qt < 2; ++qt) {
      float tm = -1e30f;
#pragma unroll
      for (int kt = 0; kt < 4; ++kt)
#pragma unroll
        for (int j = 0; j < 4; ++j) tm = fmaxf(tm, s[kt][qt][j]);
      tm = fmaxf(tm, __shfl_xor(tm, 16));
      tm = fmaxf(tm, __shfl_xor(tm, 32));
      const float mn = fmaxf(mrun[qt], tm);
      const float alpha = exp2f(mrun[qt] - mn);
      mrun[qt] = mn;
      float ls = 0.f;
#pragma unroll
      for (int kt = 0; kt < 4; ++kt)
#pragma unroll
        for (int j = 0; j < 4; ++j) { float e = exp2f(s[kt][qt][j] - mn); s[kt][qt][j] = e; ls += e; }
      lrun[qt] = lrun[qt] * alpha + ls;
#pragma unroll
      for (int dt = 0; dt < 4; ++dt) { o[dt][qt][0] *= alpha; o[dt][qt][1] *= alpha; o[dt][qt][2] *= alpha; o[dt][qt][3] *= alpha; }
#pragma unroll
      for (int k2 = 0; k2 < 2; ++k2) {
        union { bf16x8 v; unsigned u[4]; } t_;
        t_.u[0] = pack2(s[2 * k2][qt][0], s[2 * k2][qt][1]); t_.u[1] = pack2(s[2 * k2][qt][2], s[2 * k2][qt][3]);
        t_.u[2] = pack2(s[2 * k2 + 1][qt][0], s[2 * k2 + 1][qt][1]); t_.u[3] = pack2(s[2 * k2 + 1][qt][2], s[2 * k2 + 1][qt][3]);
        pf[k2][qt] = t_.v;
      }
    }
#pragma unroll
    for (int k2 = 0; k2 < 2; ++k2)
#pragma unroll
      for (int dt = 0; dt < 4; ++dt) {
        union { bf16x8 v; uint2 u[2]; } af;
        const u16* vp = vdl + (dt * 16 + fr) * VST + k2 * 32 + 4 * fq;
        af.u[0] = *reinterpret_cast<const uint2*>(vp);
        af.u[1] = *reinterpret_cast<const uint2*>(vp + 16);
#pragma unroll
        for (int qt = 0; qt < 2; ++qt) o[dt][qt] = __builtin_amdgcn_mfma_f32_16x16x32_bf16(af.v, pf[k2][qt], o[dt][qt], 0, 0, 0);
      }
    if (t + 1 < 32) lstore(cur ^ 1);
    __syncthreads();
  }
  const int b = bh >> 4, h = bh & 15;
#pragma unroll
  for (int qt = 0; qt < 2; ++qt) {
    float l = lrun[qt];
    l += __shfl_xor(l, 16);
    l += __shfl_xor(l, 32);
    const float inv = 1.0f / l;
    const long tok = (long)b * SEQ + qb * 256 + wid * 32 + qt * 16 + fr;
#pragma unroll
    for (int dt = 0; dt < 4; ++dt) {
      uint2 pk; pk.x = pack2(o[dt][qt][0] * inv, o[dt][qt][1] * inv); pk.y = pack2(o[dt][qt][2] * inv, o[dt][qt][3] * inv);
      *reinterpret_cast<uint2*>(O + tok * 1024 + h * 64 + dt * 16 + 4 * fq) = pk;
    }
  }
}
DEV void phase_mla_attn(const Params& p) {
  const int nb = gridDim.x;
  for (int u = blockIdx.x; u < NBATCH * 16 * 8; u += nb) mla_attn_unit(p, u);
}

#ifndef ONLY
#define ONLY -1
#endif
#define PH(n, ...) if (ONLY < 0 || ONLY == n) { __VA_ARGS__; }
__global__ void __launch_bounds__(512) mega(Params p) {
  cg::grid_group grid = cg::this_grid();
  PH(0, phase_prep(p)); grid.sync();
  PH(1, phase_abin(p)); grid.sync();
  PH(2, phase_mix0(p)); grid.sync();
  PH(3, phase_outproj(p, reinterpret_cast<const u16*>(p.ws + REG_A + 100663296ull), reinterpret_cast<const u16*>(p.ws + W_ABOUT), p.x)); grid.sync();
  for (int layer = 0; layer < 2; ++layer) {
    if (layer == 1) {
      PH(10, phase_mla_in(p)); grid.sync();
      PH(11, phase_mla_norm(p)); grid.sync();
      PH(12, phase_mla_up(p)); grid.sync();
      PH(13, phase_mla_attn(p)); grid.sync();
      PH(3, phase_outproj(p, reinterpret_cast<const u16*>(p.ws + MLA_O), reinterpret_cast<const u16*>(p.ws + W_MLAOUT), reinterpret_cast<const float*>(p.ws + REG_G))); grid.sync();
    }
    PH(4, phase_ln1_router(p, layer)); grid.sync();
    PH(5, phase_topk(p)); grid.sync();
    PH(6, phase_moe1(p, layer)); grid.sync();
    PH(7, phase_moe2(p, layer)); grid.sync();
    PH(8, phase_ln2(p, layer)); grid.sync();
    PH(9, phase_ple(p, layer, layer ? p.out : reinterpret_cast<float*>(p.ws + REG_G), layer ? nullptr : reinterpret_cast<u16*>(p.ws + REG_X))); grid.sync();
  }
}

static void add_job(Params& P, int& nj, int& tile, const float* src, u16* dst, int K, int N, int rsh, int rs, int off, int count, long sstride, long dstride) {
  ConvJob& J = P.jobs[nj++];
  J.src = src; J.dst = dst; J.sstride = sstride; J.dstride = dstride; J.K = K; J.N = N; J.rs = rs; J.off = off; J.rsh = rsh;
  J.ntn = (N + 255) / 256; J.tpm = (K / 64) * J.ntn; J.tile0 = tile; J.ntiles = J.tpm * count;
  tile += J.ntiles;
}

extern "C" void kernel_launch(void* const* d_in, const int* in_sizes, int n_in,
                              void* d_out, int out_size, void* d_ws, size_t ws_size,
                              hipStream_t stream) {
  constexpr size_t kDynLds = 131072;
  static int grid_blocks = 0;
  if (!grid_blocks) {
    int dev = 0, cus = 0, per_cu = 0;
    (void)hipGetDevice(&dev);
    (void)hipDeviceGetAttribute(&cus, hipDeviceAttributeMultiprocessorCount, dev);
    (void)hipFuncSetAttribute((const void*)mega, hipFuncAttributeMaxDynamicSharedMemorySize, (int)kDynLds);
    (void)hipOccupancyMaxActiveBlocksPerMultiprocessor(&per_cu, mega, 512, kDynLds);
    if (per_cu > 1) per_cu = 1;
    if (per_cu < 1) { fprintf(stderr, "occupancy query returned 0\n"); per_cu = 1; }
    grid_blocks = cus * per_cu;
    if (ws_size < WS_TOTAL) fprintf(stderr, "workspace too small: %zu < %zu\n", ws_size, (size_t)WS_TOTAL);
  }
  Params P;
  memset(&P, 0, sizeof(P));
  auto F = [&](int i) { return (const float*)d_in[i]; };
  char* ws = (char*)d_ws;
  P.x = F(0); P.p = F(1);
  P.na_rpb = F(3); P.hy_conv_w = F(4); P.hy_conv_b = F(5);
  P.hy_f_w1 = F(6); P.hy_f_b1 = F(7); P.hy_f_freq = F(8); P.hy_f_w2 = F(9); P.hy_f_b2 = F(10); P.hy_f_w3 = F(11); P.hy_skip = F(12);
  P.mla_q_norm = F(15); P.mla_kv_norm = F(17);
  P.ln1_g = F(20); P.ln1_b = F(21); P.ln2_g = F(22); P.ln2_b = F(23);
  P.moe_router = F(24);
  P.out = (float*)d_out; P.ws = ws;
  int nj = 0, tile = 0;
  add_job(P, nj, tile, F(2), (u16*)(ws + W_ABIN), 1024, 3072, 7, 128, 0, 1, 0, 0);
  add_job(P, nj, tile, F(13), (u16*)(ws + W_ABOUT), 1024, 1024, 7, 128, 0, 1, 0, 0);
  add_job(P, nj, tile, F(14), (u16*)(ws + W_MLAIN), 1024, 672, 7, 128, 0, 1, 0, 0);
  add_job(P, nj, tile, F(16), (u16*)(ws + W_QUP), 384, 1536, 7, 128, 0, 1, 0, 0);
  add_job(P, nj, tile, F(18), (u16*)(ws + W_KVUP), 256, 2048, 7, 128, 0, 1, 0, 0);
  add_job(P, nj, tile, F(19), (u16*)(ws + W_MLAOUT), 1024, 1024, 7, 128, 0, 1, 0, 0);
  add_job(P, nj, tile, F(28), (u16*)(ws + W_PLEG), 1024, 1024, 7, 128, 0, 2, 1024L * 1024, 1024L * 1024);
  add_job(P, nj, tile, F(29), (u16*)(ws + W_PLEP), 256, 1024, 7, 128, 0, 2, 256L * 1024, 1024L * 256);
  add_job(P, nj, tile, F(25), (u16*)(ws + W_GU), 1024, 2048, 4, 32, 0, 32, 1024L * 2048, 4096L * 1024);
  add_job(P, nj, tile, F(26), (u16*)(ws + W_GU), 1024, 2048, 4, 32, 16, 32, 1024L * 2048, 4096L * 1024);
  add_job(P, nj, tile, F(27), (u16*)(ws + W_DN), 2048, 1024, 7, 128, 0, 32, 2048L * 1024, 1024L * 2048);
  P.conv_total = tile;
  void* args[] = {&P};
  hipError_t e = hipLaunchCooperativeKernel((void*)mega, dim3(grid_blocks), dim3(512), args, kDynLds, stream);
  if (e != hipSuccess) fprintf(stderr, "cooperative launch failed: %s (grid %d)\n", hipGetErrorString(e), grid_blocks);
}
```

```cpp
#include <hip/hip_runtime.h>
#include <hip/hip_bf16.h>
#include <hip/hip_cooperative_groups.h>
#include <cstdio>
#include <cstring>
namespace cg = cooperative_groups;

typedef unsigned short u16;
using bf16x8 = __attribute__((ext_vector_type(8))) short;
using bf16x4 = __attribute__((ext_vector_type(4))) short;
using f32x4 = __attribute__((ext_vector_type(4))) float;
#define DEV __device__ __forceinline__

constexpr int TOK = 16384, DM = 1024, SEQ = 2048, NBATCH = 8;
constexpr int NEXP = 16, CAP = 256, DFF = 2048;
constexpr float DN_ALPHA = 1.4142135623730951f;
constexpr float LN_EPS = 1e-5f;

constexpr size_t W_ABIN = 0;
constexpr size_t W_ABOUT = W_ABIN + 3072ull * 1024 * 2;
constexpr size_t W_MLAIN = W_ABOUT + 1024ull * 1024 * 2;
constexpr size_t W_QUP = W_MLAIN + 768ull * 1024 * 2;
constexpr size_t W_KVUP = W_QUP + 1536ull * 384 * 2;
constexpr size_t W_MLAOUT = W_KVUP + 2048ull * 256 * 2;
constexpr size_t W_PLEG = W_MLAOUT + 1024ull * 1024 * 2;
constexpr size_t W_PLEP = W_PLEG + 2 * 1024ull * 1024 * 2;
constexpr size_t W_GU = W_PLEP + 2 * 1024ull * 256 * 2;
constexpr size_t W_DN = W_GU + 2 * 16ull * 4096 * 1024 * 2;
constexpr size_t REG_A = W_DN + 2 * 16ull * 1024 * 2048 * 2;
constexpr size_t REG_B = REG_A + 134217728ull;
constexpr size_t REG_C = REG_B + 134217728ull;
constexpr size_t REG_D = REG_C + 67108864ull;
constexpr size_t REG_E = REG_D + 67108864ull;
constexpr size_t REG_G = REG_E + 33554432ull;
constexpr size_t REG_X = REG_G + 67108864ull;
constexpr size_t REG_P = REG_X + 33554432ull;
constexpr size_t S_AFF = REG_P + 16777216ull;
constexpr size_t S_IDX = S_AFF + 1048576ull;
constexpr size_t S_GSEL = S_IDX + 131072ull;
constexpr size_t S_SLOT = S_GSEL + 131072ull;
constexpr size_t S_H2 = S_SLOT + 1048576ull;
constexpr size_t S_RG = S_H2 + 524288ull;
constexpr size_t S_BAR = S_RG + 8388608ull;
constexpr size_t WS_TOTAL = S_BAR + 16384ull;

struct ConvJob {
  const float* src; u16* dst;
  long sstride, dstride;
  int K, N;
  int rs, off;
  int rsh, padj;
  int ntn;
  int tpm;
  int tile0, ntiles;
};
constexpr int NJOBS = 16;

struct Params {
  const float* x; const float* p;
  const float* na_rpb; const float* hy_conv_w; const float* hy_conv_b;
  const float* hy_f_w1; const float* hy_f_b1; const float* hy_f_freq; const float* hy_f_w2; const float* hy_f_b2;
  const float* hy_f_w3; const float* hy_skip;
  const float* mla_q_norm; const float* mla_kv_norm;
  const float* ln1_g; const float* ln1_b; const float* ln2_g; const float* ln2_b;
  const float* moe_router;
  float* out; char* ws;
  int conv_total; int pad0;
  ConvJob jobs[NJOBS];
};

extern __shared__ __attribute__((aligned(16))) char smem[];

DEV u16 f2bf(float f) {
  unsigned u = __float_as_uint(f);
  u += 0x7fffu + ((u >> 16) & 1u);
  return (u16)(u >> 16);
}
DEV float bf2f(u16 h) { return __uint_as_float(((unsigned)h) << 16); }
DEV unsigned pack2(float a, float b) { return (unsigned)f2bf(a) | ((unsigned)f2bf(b) << 16); }
DEV float wave_sum(float v) {
#pragma unroll
  for (int o = 32; o > 0; o >>= 1) v += __shfl_xor(v, o);
  return v;
}
DEV int otid() { int t = threadIdx.x; asm volatile("" : "+v"(t)); return t; }
DEV int vstart() {
  int nb = gridDim.x, b = blockIdx.x;
  return (nb % 8 == 0) ? (b % 8) * (nb / 8) + b / 8 : b;
}


#define XB_TMO      128
#define XB_XCNT(j)  (256  + 64 * (j))
#define XB_XSUB(j)  (1280 + 64 * (j))
#define XB_XGEN(j)  (2304 + 64 * (j))
#define XB_TOP      3328
#define XB_TOPGEN   3392
#define XCD_BAR_WORDS 3456
#define XB_SPIN_CAP (1u << 18)
#define LAS __attribute__((address_space(3)))
DEV unsigned xb_ld(unsigned* p) { return __hip_atomic_load(p, __ATOMIC_RELAXED, __HIP_MEMORY_SCOPE_AGENT); }
DEV unsigned xb_add(unsigned* p, unsigned v) { return __hip_atomic_fetch_add(p, v, __ATOMIC_RELAXED, __HIP_MEMORY_SCOPE_AGENT); }
DEV unsigned xb_xcc_id() { return (unsigned)__builtin_amdgcn_s_getreg((3 << 11) | 20) & 0xFu; }
#define XB_SPIN(cond, bar) do { unsigned _sp = 0; while (cond) { __builtin_amdgcn_s_sleep(1); \
    if ((++_sp & 255u) == 0u) { if (xb_ld(&(bar)[XB_TMO])) break; if (_sp > XB_SPIN_CAP) { atomicAdd(&(bar)[XB_TMO], 1u); break; } } } } while (0)
struct XcdBarrier { unsigned* bar; unsigned x; volatile LAS unsigned* st; };
DEV XcdBarrier xcd_barrier_post(unsigned* bar, volatile LAS unsigned* st) {
  XcdBarrier b; b.bar = bar; b.x = xb_xcc_id(); b.st = st;
  if (threadIdx.x == 0) (void)xb_add(&bar[XB_XCNT(b.x)], 1u);
  return b;
}
DEV void xcd_barrier_complete(unsigned* bar, unsigned x, unsigned& nloc, unsigned& nx) {
  const unsigned G = gridDim.x * gridDim.y * gridDim.z;
  unsigned sum, cnt, mine, sp = 0u;
  for (;;) {
    sum = 0u; cnt = 0u; mine = 0u;
#pragma unroll
    for (unsigned j = 0; j < 16; ++j) { const unsigned c = xb_ld(&bar[XB_XCNT(j)]); sum += c; cnt += (c > 0u) ? 1u : 0u; mine = (j == x) ? c : mine; }
    if (sum == G) break;
    __builtin_amdgcn_s_sleep(1);
    if ((++sp & 255u) == 0u) { if (xb_ld(&bar[XB_TMO])) break; if (sp > XB_SPIN_CAP) { atomicAdd(&bar[XB_TMO], 1u); break; } }
  }
  nloc = mine > 0u ? mine : 1u; nx = cnt > 0u ? cnt : 1u;
}
DEV void xcd_barrier(const XcdBarrier& b) {
  asm volatile("s_waitcnt vmcnt(0)" ::: "memory");
  __syncthreads();
  if (threadIdx.x == 0) {
    unsigned* bar = b.bar;
    __builtin_amdgcn_s_waitcnt(0);
    unsigned nloc = b.st[0], nx = b.st[1];
    if (nloc == 0u) { xcd_barrier_complete(bar, b.x, nloc, nx); b.st[0] = nloc; b.st[1] = nx; }
    const unsigned old = xb_add(&bar[XB_XSUB(b.x)], 1u);
    const unsigned gen = old / nloc;
    if (old + 1u == (gen + 1u) * nloc) {
      __builtin_amdgcn_fence(__ATOMIC_RELEASE, "agent");
      asm volatile("s_waitcnt vmcnt(0)" ::: "memory");
      const unsigned og = xb_add(&bar[XB_TOP], 1u);
      const unsigned tg = og / nx;
      if (og + 1u == (tg + 1u) * nx) xb_add(&bar[XB_TOPGEN], 1u);
      else XB_SPIN(xb_ld(&bar[XB_TOPGEN]) == tg, bar);
      __builtin_amdgcn_fence(__ATOMIC_ACQUIRE, "agent");
      xb_add(&bar[XB_XGEN(b.x)], 1u);
      asm volatile("s_waitcnt vmcnt(0)" ::: "memory");
    } else {
      XB_SPIN(xb_ld(&bar[XB_XGEN(b.x)]) == gen, bar);
      __builtin_amdgcn_fence(__ATOMIC_ACQUIRE, "agent");
      asm volatile("s_waitcnt vmcnt(0)" ::: "memory");
    }
  }
  __syncthreads();
}

DEV int lds_byte(int r, int c) {
  int st = (r >> 4) * 2 + (c >> 5), rr = r & 15, cc = c & 31, ob = rr * 64 + cc * 2;
  return st * 1024 + (ob ^ (((ob >> 9) & 1) << 5));
}
DEV void stage_rc(int b, int& R, int& C) {
  int st = b / 1024, sb = b % 1024, swz = sb ^ (((sb >> 9) & 1) << 5);
  R = (st >> 1) * 16 + swz / 64; C = (st & 1) * 32 + (swz % 64) / 2;
}
#define GLDS16(g, l) __builtin_amdgcn_global_load_lds((const unsigned*)(g), (unsigned*)(l), 16, 0, 0)

typedef f32x4 Acc[4][4];

template <class AF, class EF>
DEV void gemm_tile(const u16* __restrict__ Abase, AF aoff, const u16* __restrict__ Bt, int K, EF epi) {
  const int tid = otid(), wid = tid >> 6, lane = tid & 63, wr = wid >> 1, wc = wid & 1, fr = lane & 15, fq = lane >> 4;
  unsigned ao[2][2], bo[2];
#pragma unroll
  for (int i = 0; i < 2; ++i) {
    int R, C; stage_rc(tid * 16 + i * 8192, R, C);
    ao[0][i] = aoff(R) + C;
    ao[1][i] = aoff(128 + R) + C;
    bo[i] = (unsigned)(R * K + C);
  }
  Acc acc;
#pragma unroll
  for (int m = 0; m < 4; ++m)
#pragma unroll
    for (int n = 0; n < 4; ++n) acc[m][n] = f32x4{0.f, 0.f, 0.f, 0.f};
  const int nt = K / 64;
  auto stage = [&](int buf, int kt) {
    char* base = smem + buf * 49152 + tid * 16;
#pragma unroll
    for (int i = 0; i < 2; ++i) {
      GLDS16(Abase + ao[0][i] + kt * 64, base + i * 8192);
      GLDS16(Abase + ao[1][i] + kt * 64, base + 16384 + i * 8192);
      GLDS16(Bt + bo[i] + kt * 64, base + 32768 + i * 8192);
    }
  };
  stage(0, 0);
#pragma unroll 1
  for (int t = 0; t < nt; ++t) {
    asm volatile("s_waitcnt vmcnt(0)" ::: "memory");
    __syncthreads();
    if (t + 1 < nt) stage((t + 1) & 1, t + 1);
    const char* sa = smem + (t & 1) * 49152 + (wr >> 1) * 16384;
    const char* sb = smem + (t & 1) * 49152 + 32768;
    bf16x8 Af[4][2], Bf[4][2];
#pragma unroll
    for (int m = 0; m < 4; ++m)
#pragma unroll
      for (int k = 0; k < 2; ++k)
        Af[m][k] = *reinterpret_cast<const bf16x8*>(sa + lds_byte((wr & 1) * 64 + m * 16 + fr, k * 32 + fq * 8));
#pragma unroll
    for (int n = 0; n < 4; ++n)
#pragma unroll
      for (int k = 0; k < 2; ++k)
        Bf[n][k] = *reinterpret_cast<const bf16x8*>(sb + lds_byte(wc * 64 + n * 16 + fr, k * 32 + fq * 8));
#pragma unroll
    for (int m = 0; m < 4; ++m)
#pragma unroll
      for (int n = 0; n < 4; ++n)
#pragma unroll
        for (int k = 0; k < 2; ++k)
          acc[m][n] = __builtin_amdgcn_mfma_f32_16x16x32_bf16(Af[m][k], Bf[n][k], acc[m][n], 0, 0, 0);
  }
  __syncthreads();
  epi(acc, wr, wc, fr, fq);
}
#define EPI_FOR _Pragma("unroll") for (int m = 0; m < 4; ++m) _Pragma("unroll") for (int n = 0; n < 4; ++n)
#define EPI_ROW0 (wr * 64 + m * 16 + fq * 4)
#define EPI_COL (wc * 64 + n * 16 + fr)

DEV void tile_mn(int v, int NT, int& mt, int& nt) {
  int mi = v & 7, rest = v >> 3;
  nt = rest % NT; mt = (rest / NT) * 8 + mi;
}

DEV void conv_tile(const ConvJob& J, int t) {
  const int tid = otid();
  int mat = t / J.tpm, tt = t % J.tpm;
  int kt = tt / J.ntn, nt = tt % J.ntn;
  const float* src = J.src + (long)mat * J.sstride;
  u16* dst = J.dst + (long)mat * J.dstride;
  const int kg = tid >> 6, ng = tid & 63;
  const int n = nt * 256 + ng * 4;
  float4 v[8];
#pragma unroll
  for (int j = 0; j < 8; ++j) {
    int k = kt * 64 + kg * 8 + j;
    if (n < J.N) v[j] = *reinterpret_cast<const float4*>(src + (long)k * J.N + n);
    else v[j] = make_float4(0.f, 0.f, 0.f, 0.f);
  }
#pragma unroll
  for (int i = 0; i < 4; ++i) {
    float e[8];
#pragma unroll
    for (int j = 0; j < 8; ++j) e[j] = (i == 0) ? v[j].x : (i == 1) ? v[j].y : (i == 2) ? v[j].z : v[j].w;
    uint4 pk;
    pk.x = pack2(e[0], e[1]); pk.y = pack2(e[2], e[3]); pk.z = pack2(e[4], e[5]); pk.w = pack2(e[6], e[7]);
    *reinterpret_cast<uint4*>(smem + (i * 64 + ng) * 144 + kg * 16) = pk;
  }
  __syncthreads();
#pragma unroll
  for (int u = 0; u < 4; ++u) {
    int q = tid + 512 * u;
    int nl = q >> 3, ch = q & 7;
    uint4 pk = *reinterpret_cast<const uint4*>(smem + ((nl & 3) * 64 + (nl >> 2)) * 144 + ch * 16);
    int nn = nt * 256 + nl;
    long drow = (long)(nn >> J.rsh) * J.rs + (nn & ((1 << J.rsh) - 1)) + J.off;
    *reinterpret_cast<uint4*>(dst + drow * J.K + kt * 64 + ch * 8) = pk;
  }
  __syncthreads();
}

DEV void phase_prep(const Params& p) {
  const int tid = otid(), nb = gridDim.x, bid = blockIdx.x;
  {
    float* zb = reinterpret_cast<float*>(smem);
    float* h1b = zb + 512;
    float* h2g = reinterpret_cast<float*>(p.ws + S_H2);
    const int w = tid >> 6, lane = tid & 63;
    for (int l0 = bid * 8; l0 < SEQ; l0 += nb * 8) {
      int l = l0 + w;
      float tt = (float)l / (float)(SEQ - 1);
      float ww = 6.283185307179586f * (float)l / (float)SEQ;
      float z = 0.f;
      if (lane == 0) z = tt;
      else if (lane <= 16) { float f = 1e-4f + (float)(lane - 1) * ((15.0f - 1e-4f) / 15.0f); z = cosf(f * ww); }
      else if (lane <= 32) { float f = 1e-4f + (float)(lane - 17) * ((15.0f - 1e-4f) / 15.0f); z = -sinf(f * ww); }
      zb[w * 64 + lane] = z;
      __syncthreads();
      float fr_ = p.hy_f_freq[lane];
      float a = p.hy_f_b1[lane];
      for (int k = 0; k < 33; ++k) a += zb[w * 64 + k] * p.hy_f_w1[k * 64 + lane];
      h1b[w * 64 + lane] = sinf(fr_ * a);
      __syncthreads();
      float a2 = p.hy_f_b2[lane];
      for (int k = 0; k < 64; ++k) a2 += h1b[w * 64 + k] * p.hy_f_w2[k * 64 + lane];
      h2g[l * 64 + lane] = sinf(fr_ * a2);
      __syncthreads();
    }
  }
  {
    u16* xb = reinterpret_cast<u16*>(p.ws + REG_X);
    const long n8 = (long)TOK * DM / 8;
    for (long i = (long)bid * 512 + tid; i < n8; i += (long)nb * 512) {
      float4 a = reinterpret_cast<const float4*>(p.x)[2 * i], b = reinterpret_cast<const float4*>(p.x)[2 * i + 1];
      uint4 pk; pk.x = pack2(a.x, a.y); pk.y = pack2(a.z, a.w); pk.z = pack2(b.x, b.y); pk.w = pack2(b.z, b.w);
      reinterpret_cast<uint4*>(xb)[i] = pk;
    }
    u16* pb = reinterpret_cast<u16*>(p.ws + REG_P);
    const long m8 = 2L * TOK * 256 / 8;
    for (long i = (long)bid * 512 + tid; i < m8; i += (long)nb * 512) {
      float4 a = reinterpret_cast<const float4*>(p.p)[2 * i], b = reinterpret_cast<const float4*>(p.p)[2 * i + 1];
      uint4 pk; pk.x = pack2(a.x, a.y); pk.y = pack2(a.z, a.w); pk.z = pack2(b.x, b.y); pk.w = pack2(b.z, b.w);
      reinterpret_cast<uint4*>(pb)[i] = pk;
    }
  }
  for (int t = bid; t < p.conv_total; t += nb) {
    int j = 0;
#pragma unroll 1
    for (int q = 1; q < NJOBS; ++q) if (t >= p.jobs[q].tile0 && p.jobs[q].ntiles > 0) j = q;
    conv_tile(p.jobs[j], t - p.jobs[j].tile0);
  }
}

DEV void filter_b(const Params& p, int cpair) {
  const int tid = otid();
  float* w3s = reinterpret_cast<float*>(smem);
  float* red = w3s + 512;
  float* nrm = red + 32;
  float* hb = nrm + 4;
  const float* h2g = reinterpret_cast<const float*>(p.ws + S_H2);
  {
    int ci = tid >> 6, k = tid & 63;
    int o = ci >> 2, d = (ci >> 1) & 1, cc = ci & 1;
    w3s[ci * 64 + k] = p.hy_f_w3[k * 2048 + o * 1024 + d * 512 + 2 * cpair + cc];
  }
  __syncthreads();
  const float min_decay = logf(1e-2f) / 1.5f, max_decay = logf(1e-2f) / 0.3f;
#pragma unroll 1
  for (int i = 0; i < 4; ++i) {
    int l = tid + 512 * i;
    float h2[64];
#pragma unroll
    for (int k = 0; k < 16; ++k) {
      float4 v = *reinterpret_cast<const float4*>(h2g + l * 64 + k * 4);
      h2[4 * k] = v.x; h2[4 * k + 1] = v.y; h2[4 * k + 2] = v.z; h2[4 * k + 3] = v.w;
    }
    float tt = (float)l / (float)(SEQ - 1);
#pragma unroll 1
    for (int ci = 0; ci < 8; ++ci) {
      float a = 0.f;
#pragma unroll
      for (int k = 0; k < 64; ++k) a += h2[k] * w3s[ci * 64 + k];
      int cc = ci & 1;
      int c = 2 * cpair + cc;
      float delta = fabsf(min_decay + (float)c * ((max_decay - min_decay) / 511.0f));
      a *= expf(-tt * delta);
      hb[ci * 2048 + l] = a;
    }
  }
  __syncthreads();
  {
    float ss[4];
#pragma unroll
    for (int oc = 0; oc < 4; ++oc) {
      int o = oc >> 1, cc = oc & 1;
      float a = 0.f;
      for (int l = tid; l < 2048; l += 512) {
        float f = hb[(o * 4 + 0 + cc) * 2048 + l];
        float b = (l > 0) ? hb[(o * 4 + 2 + cc) * 2048 + l] : 0.f;
        a += f * f + b * b;
      }
      ss[oc] = wave_sum(a);
    }
    if ((tid & 63) == 0) {
#pragma unroll
      for (int q = 0; q < 4; ++q) red[(tid >> 6) * 4 + q] = ss[q];
    }
  }
  __syncthreads();
  if (tid < 4) {
    float s = 0.f;
    for (int w = 0; w < 8; ++w) s += red[w * 4 + tid];
    nrm[tid] = rsqrtf(s + 1e-12f);
  }
  __syncthreads();
  u16* Rg = reinterpret_cast<u16*>(p.ws + S_RG);
  for (int q = tid; q < 4 * 4096; q += 512) {
    int oc = q >> 12, qq = q & 4095;
    int o = oc >> 1, cc = oc & 1;
    float v;
    if (qq == 0) v = 0.f;
    else if (qq <= 2048) v = hb[(o * 4 + 0 * 2 + cc) * 2048 + (2048 - qq)];
    else v = hb[(o * 4 + 1 * 2 + cc) * 2048 + (qq - 2048)];
    v *= nrm[oc];
    Rg[((long)o * 512 + 2 * cpair + cc) * 4096 + qq] = f2bf(v);
  }
  __syncthreads();
}

DEV void phase_abin(const Params& p) {
  const int nb = gridDim.x;
  for (int c = blockIdx.x; c < 256; c += nb) filter_b(p, c);
  const u16* xb = reinterpret_cast<const u16*>(p.ws + REG_X);
  const u16* wt = reinterpret_cast<const u16*>(p.ws + W_ABIN);
  u16* qk = reinterpret_cast<u16*>(p.ws + REG_B);
  u16* vht = reinterpret_cast<u16*>(p.ws + REG_B + 33554432ull);
  for (int v = vstart(); v < 64 * 24; v += nb) {
    int mt, nt; tile_mn(v, 24, mt, nt);
    const int brow = mt * 256, bcol = nt * 128;
    gemm_tile(xb + (long)brow * 1024, [&](int r) { return (unsigned)(r * 1024); }, wt + (long)bcol * 1024, 1024,
            [&](Acc& acc, int wr, int wc, int fr, int fq) {
              if (bcol < 1024) {
                const float sc = (bcol < 512) ? 0.125f : 1.0f;
                u16* dst = qk + (long)brow * 1024 + bcol;
                EPI_FOR {
#pragma unroll
                  for (int j = 0; j < 4; ++j) dst[(EPI_ROW0 + j) * 1024 + EPI_COL] = f2bf(acc[m][n][j] * sc);
                }
              } else {
                u16* dst = vht + (long)(bcol - 1024) * TOK + brow;
                EPI_FOR {
                  uint2 pk; pk.x = pack2(acc[m][n][0], acc[m][n][1]); pk.y = pack2(acc[m][n][2], acc[m][n][3]);
                  *reinterpret_cast<uint2*>(dst + (long)EPI_COL * TOK + EPI_ROW0) = pk;
                }
              }
            });
  }
}

DEV void na_unit(const Params& p, int u) {
  const int lane = otid() & 63, fr = lane & 15, fq = lane >> 4;
  const int g = u & 3, r = (u >> 2) & 31, h = (u >> 7) & 7, b = u >> 10;
  const int r0 = min(max(r - 4, 0), 24), cs = min(max(16 * g - 8, 0), 32);
  const u16* qk = reinterpret_cast<const u16*>(p.ws + REG_B);
  const u16* vht = reinterpret_cast<const u16*>(p.ws + REG_B + 33554432ull);
  u16* cat = reinterpret_cast<u16*>(p.ws + REG_A + 100663296ull);
  const int c = 16 * g + fr;
  const long tokq = (long)b * SEQ + r * 64 + c;
  bf16x8 qf[2];
#pragma unroll
  for (int ks = 0; ks < 2; ++ks) qf[ks] = *reinterpret_cast<const bf16x8*>(qk + tokq * 1024 + h * 64 + ks * 32 + fq * 8);
  f32x4 s[16];
#pragma unroll
  for (int kt = 0; kt < 16; ++kt) {
    const int w = kt >> 1, half = kt & 1;
    const long tokk = (long)b * SEQ + (r0 + w) * 64 + cs + 16 * half + fr;
    bf16x8 k0 = *reinterpret_cast<const bf16x8*>(qk + tokk * 1024 + 512 + h * 64 + fq * 8);
    bf16x8 k1 = *reinterpret_cast<const bf16x8*>(qk + tokk * 1024 + 512 + h * 64 + 32 + fq * 8);
    f32x4 a = {0.f, 0.f, 0.f, 0.f};
    a = __builtin_amdgcn_mfma_f32_16x16x32_bf16(k0, qf[0], a, 0, 0, 0);
    a = __builtin_amdgcn_mfma_f32_16x16x32_bf16(k1, qf[1], a, 0, 0, 0);
    s[kt] = a;
  }
  const int c0 = min(max(c - 8, 0), 48);
  const float* rpb = p.na_rpb + h * 15 * 31;
  float mx = -1e30f;
#pragma unroll
  for (int kt = 0; kt < 16; ++kt) {
    const int w = kt >> 1, half = kt & 1;
    const int dr = r0 + w - r + 7;
#pragma unroll
    for (int j = 0; j < 4; ++j) {
      int kc = cs + 16 * half + 4 * fq + j;
      bool valid = (kc >= c0) && (kc < c0 + 16);
      int dc = min(max(kc - c, -15), 15) + 15;
      float bias = rpb[dr * 31 + dc];
      float v = valid ? (s[kt][j] + bias) : -1e30f;
      s[kt][j] = v;
      mx = fmaxf(mx, v);
    }
  }
  mx = fmaxf(mx, __shfl_xor(mx, 16));
  mx = fmaxf(mx, __shfl_xor(mx, 32));
  float sum = 0.f;
#pragma unroll
  for (int kt = 0; kt < 16; ++kt)
#pragma unroll
    for (int j = 0; j < 4; ++j) { float e = __expf(s[kt][j] - mx); s[kt][j] = e; sum += e; }
  sum += __shfl_xor(sum, 16);
  sum += __shfl_xor(sum, 32);
  f32x4 o[4];
#pragma unroll
  for (int dt = 0; dt < 4; ++dt) o[dt] = f32x4{0.f, 0.f, 0.f, 0.f};
#pragma unroll
  for (int w = 0; w < 8; ++w) {
    union { bf16x8 v; unsigned u[4]; } pf;
    pf.u[0] = pack2(s[2 * w][0], s[2 * w][1]); pf.u[1] = pack2(s[2 * w][2], s[2 * w][3]);
    pf.u[2] = pack2(s[2 * w + 1][0], s[2 * w + 1][1]); pf.u[3] = pack2(s[2 * w + 1][2], s[2 * w + 1][3]);
    const long tk = (long)b * SEQ + (r0 + w) * 64 + cs + 4 * fq;
#pragma unroll
    for (int dt = 0; dt < 4; ++dt) {
      const u16* vp = vht + (long)(h * 64 + dt * 16 + fr) * TOK + tk;
      union { bf16x8 v; uint2 u[2]; } af;
      af.u[0] = *reinterpret_cast<const uint2*>(vp);
      af.u[1] = *reinterpret_cast<const uint2*>(vp + 16);
      o[dt] = __builtin_amdgcn_mfma_f32_16x16x32_bf16(af.v, pf.v, o[dt], 0, 0, 0);
    }
  }
  const float inv = 1.0f / sum;
#pragma unroll
  for (int dt = 0; dt < 4; ++dt) {
    uint2 pk; pk.x = pack2(o[dt][0] * inv, o[dt][1] * inv); pk.y = pack2(o[dt][2] * inv, o[dt][3] * inv);
    *reinterpret_cast<uint2*>(cat + tokq * 1024 + h * 64 + dt * 16 + 4 * fq) = pk;
  }
}

constexpr int UB_STRIDE = 2056;
constexpr int RC_STRIDE = 4128;
DEV float shortconv(const u16* hrow, const float* cw, float cb, int ch, int t) {
  float xm = (t > 0) ? bf2f(hrow[t - 1]) : 0.f;
  float x0 = bf2f(hrow[t]);
  float xp = (t < SEQ - 1) ? bf2f(hrow[t + 1]) : 0.f;
  return cb + xm * cw[ch] + x0 * cw[1536 + ch] + xp * cw[2 * 1536 + ch];
}
DEV void load_rc(const Params& p, int o, int c) {
  u16* rc = reinterpret_cast<u16*>(smem + 2 * NBATCH * UB_STRIDE * 2);
  const u16* Rg = reinterpret_cast<const u16*>(p.ws + S_RG) + ((long)o * 512 + c) * 4096;
  for (int i = otid(); i < 4096; i += 512) {
    u16 v = Rg[i];
#pragma unroll
    for (int m = 0; m < 4; ++m) if (i - m >= 0) rc[m * RC_STRIDE + i - m] = v;
  }
}
DEV void hyena_conv(const u16* ub, f32x4 (&acc)[16]) {
  const int lane = otid() & 63, wid = otid() >> 6, fr = lane & 15, fq = lane >> 4;
  const u16* rc = reinterpret_cast<const u16*>(smem + 2 * NBATCH * UB_STRIDE * 2);
  const int mcopy = (-fr) & 3;
  const u16* rbase = rc + mcopy * RC_STRIDE;
#pragma unroll
  for (int i = 0; i < 16; ++i) acc[i] = f32x4{0.f, 0.f, 0.f, 0.f};
  const u16* urow = ub + (fr & 7) * UB_STRIDE + fq * 8;
  const int tile0 = wid * 16;
  for (int kk = 0; kk < 64; ++kk) {
    bf16x8 bfr = *reinterpret_cast<const bf16x8*>(urow + kk * 32);
#pragma unroll
    for (int tt = 0; tt < 16; ++tt) {
      int idx0 = 32 * kk + 8 * fq - (16 * (tile0 + tt) + fr) + 2048 - mcopy;
      union { bf16x8 v; uint2 u[2]; } af;
      af.u[0] = *reinterpret_cast<const uint2*>(rbase + idx0);
      af.u[1] = *reinterpret_cast<const uint2*>(rbase + idx0 + 4);
      acc[tt] = __builtin_amdgcn_mfma_f32_16x16x32_bf16(af.v, bfr, acc[tt], 0, 0, 0);
    }
  }
}
DEV void hyena_unit(const Params& p, int c) {
  const int tid = otid(), lane = tid & 63, wid = tid >> 6, fr = lane & 15, fq = lane >> 4;
  u16* ub0 = reinterpret_cast<u16*>(smem);
  u16* ub1 = ub0 + NBATCH * UB_STRIDE;
  const u16* hbt = reinterpret_cast<const u16*>(p.ws + REG_B + 33554432ull) + 512L * TOK;
  u16* cat = reinterpret_cast<u16*>(p.ws + REG_A + 100663296ull);
  const float* cw = p.hy_conv_w;
  {
    const float cb = p.hy_conv_b[c];
    for (int i = tid; i < TOK; i += 512) {
      int b = i >> 11, t = i & 2047;
      float z = shortconv(hbt + (long)c * TOK + b * SEQ, cw, cb, c, t);
      ub0[b * UB_STRIDE + t] = f2bf(z);
    }
  }
  load_rc(p, 0, c);
  __syncthreads();
  f32x4 acc[16];
  hyena_conv(ub0, acc);
  if (fr < 8) {
    const int b = fr;
    const float skip = p.hy_skip[c];
    const float cb = p.hy_conv_b[512 + c];
    const u16* hrow = hbt + (long)(512 + c) * TOK + b * SEQ;
#pragma unroll
    for (int tt = 0; tt < 16; ++tt)
#pragma unroll
      for (int j = 0; j < 4; ++j) {
        int t = (wid * 16 + tt) * 16 + fq * 4 + j;
        float y = acc[tt][j] + bf2f(ub0[b * UB_STRIDE + t]) * skip;
        float x1 = shortconv(hrow, cw, cb, 512 + c, t);
        ub1[b * UB_STRIDE + t] = f2bf(x1 * y);
      }
  }
  __syncthreads();
  load_rc(p, 1, c);
  __syncthreads();
  hyena_conv(ub1, acc);
  if (fr < 8) {
    const int b = fr;
    const float skip = p.hy_skip[512 + c];
    const float cb = p.hy_conv_b[1024 + c];
    const u16* hrow = hbt + (long)(1024 + c) * TOK + b * SEQ;
#pragma unroll
    for (int tt = 0; tt < 16; ++tt)
#pragma unroll
      for (int j = 0; j < 4; ++j) {
        int t = (wid * 16 + tt) * 16 + fq * 4 + j;
        float y = acc[tt][j] + bf2f(ub1[b * UB_STRIDE + t]) * skip;
        float x2 = shortconv(hrow, cw, cb, 1024 + c, t);
        cat[((long)b * SEQ + t) * 1024 + 512 + c] = f2bf(x2 * y);
      }
  }
  __syncthreads();
}
DEV void phase_mix0(const Params& p) {
  const int nb = gridDim.x;
  for (int c = blockIdx.x; c < 512; c += nb) hyena_unit(p, c);
  const int wid = otid() >> 6;
  for (int u = blockIdx.x * 8 + wid; u < 8192; u += nb * 8) na_unit(p, u);
}

DEV void phase_outproj(const Params& p, const u16* A, const u16* wt, const float* xres) {
  const int nb = gridDim.x;
  float* pre1 = reinterpret_cast<float*>(p.ws + REG_C);
  for (int v = vstart(); v < 64 * 8; v += nb) {
    int mt, nt; tile_mn(v, 8, mt, nt);
    const int brow = mt * 256, bcol = nt * 128;
    gemm_tile(A + (long)brow * 1024, [&](int r) { return (unsigned)(r * 1024); }, wt + (long)bcol * 1024, 1024,
            [&](Acc& acc, int wr, int wc, int fr, int fq) {
              float* dst = pre1 + (long)brow * 1024 + bcol;
              const float* xr = xres + (long)brow * 1024 + bcol;
              EPI_FOR {
#pragma unroll
                for (int j = 0; j < 4; ++j) {
                  int o = (EPI_ROW0 + j) * 1024 + EPI_COL;
                  dst[o] = DN_ALPHA * xr[o] + acc[m][n][j];
                }
              }
            });
  }
}

DEV void phase_ln1_router(const Params& p, int layer) {
  const int tid = otid(), lane = tid & 63, wid = tid >> 6, nb = gridDim.x;
  float* wrT = reinterpret_cast<float*>(smem);
  const float* wr = p.moe_router + (long)layer * 1024 * 16;
  for (int i = tid; i < 16384; i += 512) { int c = i >> 4, e = i & 15; wrT[e * 1024 + c] = wr[i]; }
  __syncthreads();
  const float* pre1 = reinterpret_cast<const float*>(p.ws + REG_C);
  float* x1 = reinterpret_cast<float*>(p.ws + REG_D);
  u16* x1b = reinterpret_cast<u16*>(p.ws + REG_E);
  float* aff = reinterpret_cast<float*>(p.ws + S_AFF);
  const float* g = p.ln1_g + layer * 1024; const float* bb = p.ln1_b + layer * 1024;
  for (int tok = blockIdx.x * 8 + wid; tok < TOK; tok += nb * 8) {
    float4 v[4];
    float s = 0.f;
#pragma unroll
    for (int i = 0; i < 4; ++i) { v[i] = *reinterpret_cast<const float4*>(pre1 + (long)tok * 1024 + i * 256 + lane * 4); s += v[i].x + v[i].y + v[i].z + v[i].w; }
    float mu = wave_sum(s) * (1.0f / 1024.0f);
    float q = 0.f;
#pragma unroll
    for (int i = 0; i < 4; ++i) { v[i].x -= mu; v[i].y -= mu; v[i].z -= mu; v[i].w -= mu; q += v[i].x * v[i].x + v[i].y * v[i].y + v[i].z * v[i].z + v[i].w * v[i].w; }
    float rstd = rsqrtf(wave_sum(q) * (1.0f / 1024.0f) + LN_EPS);
    float4 y[4];
#pragma unroll
    for (int i = 0; i < 4; ++i) {
      int c = i * 256 + lane * 4;
      float4 gg = *reinterpret_cast<const float4*>(g + c), b4 = *reinterpret_cast<const float4*>(bb + c);
      y[i].x = v[i].x * rstd * gg.x + b4.x; y[i].y = v[i].y * rstd * gg.y + b4.y; y[i].z = v[i].z * rstd * gg.z + b4.z; y[i].w = v[i].w * rstd * gg.w + b4.w;
      *reinterpret_cast<float4*>(x1 + (long)tok * 1024 + c) = y[i];
      uint2 pk; pk.x = pack2(y[i].x, y[i].y); pk.y = pack2(y[i].z, y[i].w);
      *reinterpret_cast<uint2*>(x1b + (long)tok * 1024 + c) = pk;
    }
    float mine = 0.f;
#pragma unroll 1
    for (int e = 0; e < 16; ++e) {
      float a = 0.f;
#pragma unroll
      for (int i = 0; i < 4; ++i) {
        float4 w4 = *reinterpret_cast<const float4*>(wrT + e * 1024 + i * 256 + lane * 4);
        a += y[i].x * w4.x + y[i].y * w4.y + y[i].z * w4.z + y[i].w * w4.w;
      }
      a = wave_sum(a);
      if (lane == e) mine = a;
    }
    float mx = mine;
#pragma unroll
    for (int o = 8; o > 0; o >>= 1) mx = fmaxf(mx, __shfl_xor(mx, o));
    float ex = expf(mine - mx);
    float den = ex;
#pragma unroll
    for (int o = 8; o > 0; o >>= 1) den += __shfl_xor(den, o);
    if (lane < 16) {
      int b = tok >> 11, l = tok & 2047;
      aff[((long)b * 16 + lane) * SEQ + l] = ex / den;
    }
  }
}

DEV void phase_topk(const Params& p) {
  const int tid = otid(), nb = gridDim.x;
  float* a = reinterpret_cast<float*>(smem);
  const float* aff = reinterpret_cast<const float*>(p.ws + S_AFF);
  int* idx = reinterpret_cast<int*>(p.ws + S_IDX);
  float* gsel = reinterpret_cast<float*>(p.ws + S_GSEL);
  int* slot = reinterpret_cast<int*>(p.ws + S_SLOT);
  for (int u = blockIdx.x; u < 256; u += nb) {
    const int be = u >> 1, half = u & 1;
    const int b = be >> 4, e = be & 15;
    __syncthreads();
    for (int i = tid; i < SEQ; i += 512) a[i] = aff[(long)be * SEQ + i];
    __syncthreads();
    const int i0 = half * 1024 + tid, i1 = i0 + 512;
    const float v0 = a[i0], v1 = a[i1];
    int r0 = 0, r1 = 0;
    for (int j = 0; j < SEQ; j += 4) {
      float4 w = *reinterpret_cast<const float4*>(a + j);
      r0 += (w.x > v0) || (w.x == v0 && j < i0);
      r0 += (w.y > v0) || (w.y == v0 && j + 1 < i0);
      r0 += (w.z > v0) || (w.z == v0 && j + 2 < i0);
      r0 += (w.w > v0) || (w.w == v0 && j + 3 < i0);
      r1 += (w.x > v1) || (w.x == v1 && j < i1);
      r1 += (w.y > v1) || (w.y == v1 && j + 1 < i1);
      r1 += (w.z > v1) || (w.z == v1 && j + 2 < i1);
      r1 += (w.w > v1) || (w.w == v1 && j + 3 < i1);
    }
    if (r0 < CAP) { idx[be * CAP + r0] = i0; gsel[be * CAP + r0] = v0; }
    if (r1 < CAP) { idx[be * CAP + r1] = i1; gsel[be * CAP + r1] = v1; }
    slot[((long)b * SEQ + i0) * 16 + e] = (r0 < CAP) ? r0 : -1;
    slot[((long)b * SEQ + i1) * 16 + e] = (r1 < CAP) ? r1 : -1;
  }
}

DEV void phase_moe1(const Params& p, int layer) {
  const int nb = gridDim.x;
  const u16* x1b = reinterpret_cast<const u16*>(p.ws + REG_E);
  const u16* wgu = reinterpret_cast<const u16*>(p.ws + W_GU) + (long)layer * 16 * 4096 * 1024;
  const int* idx = reinterpret_cast<const int*>(p.ws + S_IDX);
  u16* H = reinterpret_cast<u16*>(p.ws + REG_A);
  for (int v = vstart(); v < 128 * 32; v += nb) {
    int mt, nt; tile_mn(v, 32, mt, nt);
    const int e = mt >> 3, b = mt & 7;
    const int* ix = idx + (b * 16 + e) * CAP;
    gemm_tile(x1b + (long)b * SEQ * 1024, [&](int r) { return (unsigned)(ix[r] * 1024); }, wgu + ((long)e * 4096 + nt * 128) * 1024, 1024,
            [&](Acc& acc, int wr, int wc, int fr, int fq) {
              u16* dst = H + ((long)(e * 8 + b) * CAP) * DFF + nt * 64;
#pragma unroll
              for (int m = 0; m < 4; ++m)
#pragma unroll
                for (int n2 = 0; n2 < 2; ++n2)
#pragma unroll
                  for (int j = 0; j < 4; ++j) {
                    int r = wr * 64 + m * 16 + fq * 4 + j;
                    int col = wc * 32 + n2 * 16 + fr;
                    float gte = acc[m][2 * n2][j], up = acc[m][2 * n2 + 1][j];
                    float hv = gte / (1.0f + __expf(-gte)) * up;
                    dst[r * DFF + col] = f2bf(hv);
                  }
            });
  }
}
DEV void phase_moe2(const Params& p, int layer) {
  const int nb = gridDim.x;
  const u16* H = reinterpret_cast<const u16*>(p.ws + REG_A);
  const u16* wd = reinterpret_cast<const u16*>(p.ws + W_DN) + (long)layer * 16 * 1024 * 2048;
  const float* gsel = reinterpret_cast<const float*>(p.ws + S_GSEL);
  float* Ye = reinterpret_cast<float*>(p.ws + REG_B);
  for (int v = vstart(); v < 128 * 8; v += nb) {
    int mt, nt; tile_mn(v, 8, mt, nt);
    const int e = mt >> 3, b = mt & 7;
    const long row0 = (long)(e * 8 + b) * CAP;
    const float* gs = gsel + (b * 16 + e) * CAP;
    gemm_tile(H + row0 * DFF, [&](int r) { return (unsigned)(r * DFF); }, wd + ((long)e * 1024 + nt * 128) * 2048, 2048,
            [&](Acc& acc, int wr, int wc, int fr, int fq) {
              float* dst = Ye + row0 * 1024 + nt * 128;
              EPI_FOR {
#pragma unroll
                for (int j = 0; j < 4; ++j) dst[(EPI_ROW0 + j) * 1024 + EPI_COL] = acc[m][n][j] * gs[EPI_ROW0 + j];
              }
            });
  }
}
DEV void phase_ln2(const Params& p, int layer) {
  const int tid = otid(), lane = tid & 63, wid = tid >> 6, nb = gridDim.x;
  const float* x1 = reinterpret_cast<const float*>(p.ws + REG_D);
  const float* Ye = reinterpret_cast<const float*>(p.ws + REG_B);
  const int* slot = reinterpret_cast<const int*>(p.ws + S_SLOT);
  float* x2 = reinterpret_cast<float*>(p.ws + REG_A);
  u16* x2b = reinterpret_cast<u16*>(p.ws + REG_A + 67108864ull);
  const float* g = p.ln2_g + layer * 1024; const float* bb = p.ln2_b + layer * 1024;
  for (int tok = blockIdx.x * 8 + wid; tok < TOK; tok += nb * 8) {
    const int b = tok >> 11;
    float4 v[4];
#pragma unroll
    for (int i = 0; i < 4; ++i) {
      float4 t = *reinterpret_cast<const float4*>(x1 + (long)tok * 1024 + i * 256 + lane * 4);
      v[i].x = DN_ALPHA * t.x; v[i].y = DN_ALPHA * t.y; v[i].z = DN_ALPHA * t.z; v[i].w = DN_ALPHA * t.w;
    }
    int myslot = (lane < 16) ? slot[(long)tok * 16 + lane] : -1;
    for (int e = 0; e < 16; ++e) {
      int s = __shfl(myslot, e);
      if (s >= 0) {
        const float* yr = Ye + ((long)(e * 8 + b) * CAP + s) * 1024;
#pragma unroll
        for (int i = 0; i < 4; ++i) {
          float4 t = *reinterpret_cast<const float4*>(yr + i * 256 + lane * 4);
          v[i].x += t.x; v[i].y += t.y; v[i].z += t.z; v[i].w += t.w;
        }
      }
    }
    float s = 0.f;
#pragma unroll
    for (int i = 0; i < 4; ++i) s += v[i].x + v[i].y + v[i].z + v[i].w;
    float mu = wave_sum(s) * (1.0f / 1024.0f);
    float q = 0.f;
#pragma unroll
    for (int i = 0; i < 4; ++i) { v[i].x -= mu; v[i].y -= mu; v[i].z -= mu; v[i].w -= mu; q += v[i].x * v[i].x + v[i].y * v[i].y + v[i].z * v[i].z + v[i].w * v[i].w; }
    float rstd = rsqrtf(wave_sum(q) * (1.0f / 1024.0f) + LN_EPS);
#pragma unroll
    for (int i = 0; i < 4; ++i) {
      int c = i * 256 + lane * 4;
      float4 gg = *reinterpret_cast<const float4*>(g + c), b4 = *reinterpret_cast<const float4*>(bb + c);
      float4 y;
      y.x = v[i].x * rstd * gg.x + b4.x; y.y = v[i].y * rstd * gg.y + b4.y; y.z = v[i].z * rstd * gg.z + b4.z; y.w = v[i].w * rstd * gg.w + b4.w;
      *reinterpret_cast<float4*>(x2 + (long)tok * 1024 + c) = y;
      uint2 pk; pk.x = pack2(y.x, y.y); pk.y = pack2(y.z, y.w);
      *reinterpret_cast<uint2*>(x2b + (long)tok * 1024 + c) = pk;
    }
  }
}
DEV void phase_ple(const Params& p, int layer, float* outf, u16* outb) {
  const int nb = gridDim.x;
  const float* x2 = reinterpret_cast<const float*>(p.ws + REG_A);
  const u16* x2b = reinterpret_cast<const u16*>(p.ws + REG_A + 67108864ull);
  const u16* pb = reinterpret_cast<const u16*>(p.ws + REG_P) + (long)layer * TOK * 256;
  const u16* wg = reinterpret_cast<const u16*>(p.ws + W_PLEG) + (long)layer * 1024 * 1024;
  const u16* wp = reinterpret_cast<const u16*>(p.ws + W_PLEP) + (long)layer * 1024 * 256;
  float* pp = reinterpret_cast<float*>(p.ws + REG_C);
  for (int v = vstart(); v < 64 * 8; v += nb) {
    int mt, nt; tile_mn(v, 8, mt, nt);
    const int brow = mt * 256, bcol = nt * 128;
    const long tbase = (long)brow * 1024 + bcol;
    gemm_tile(pb + (long)brow * 256, [&](int r) { return (unsigned)(r * 256); }, wp + (long)bcol * 256, 256,
            [&](Acc& acc, int wr, int wc, int fr, int fq) {
              float* dst = pp + tbase;
              EPI_FOR {
#pragma unroll
                for (int j = 0; j < 4; ++j) dst[(EPI_ROW0 + j) * 1024 + EPI_COL] = acc[m][n][j];
              }
            });
    gemm_tile(x2b + (long)brow * 1024, [&](int r) { return (unsigned)(r * 1024); }, wg + (long)bcol * 1024, 1024,
            [&](Acc& acc, int wr, int wc, int fr, int fq) {
              EPI_FOR {
#pragma unroll
                for (int j = 0; j < 4; ++j) {
                  long o = tbase + (EPI_ROW0 + j) * 1024 + EPI_COL;
                  float a = acc[m][n][j];
                  float val = x2[o] + pp[o] / (1.0f + __expf(-a));
                  outf[o] = val;
                  if (outb) outb[o] = f2bf(val);
                }
              }
            });
  }
}
DEV void phase_mla_in(const Params& p) {
  const int nb = gridDim.x;
  const u16* xb = reinterpret_cast<const u16*>(p.ws + REG_X);
  const u16* wt = reinterpret_cast<const u16*>(p.ws + W_MLAIN);
  float* hm = reinterpret_cast<float*>(p.ws + REG_B);
  for (int v = vstart(); v < 64 * 6; v += nb) {
    int mt, nt; tile_mn(v, 6, mt, nt);
    const int brow = mt * 256, bcol = nt * 128;
    gemm_tile(xb + (long)brow * 1024, [&](int r) { return (unsigned)(r * 1024); }, wt + (long)bcol * 1024, 1024,
            [&](Acc& acc, int wr, int wc, int fr, int fq) {
              float* dst = hm + (long)brow * 768 + bcol;
              EPI_FOR {
#pragma unroll
                for (int j = 0; j < 4; ++j) dst[(EPI_ROW0 + j) * 768 + EPI_COL] = acc[m][n][j];
              }
            });
  }
}
constexpr size_t MLA_Q = REG_A, MLA_K = REG_A + 50331648ull, MLA_VT = REG_A + 100663296ull;
constexpr size_t MLA_CQN = REG_B + 50331648ull, MLA_CKVN = MLA_CQN + 12582912ull, MLA_O = MLA_CKVN + 8388608ull;
DEV float rope_inv(int i) { return 1.0f / powf(10000.0f, (float)i / 16.0f); }
DEV void phase_mla_norm(const Params& p) {
  const int tid = otid(), lane = tid & 63, wid = tid >> 6, nb = gridDim.x;
  const float* hm = reinterpret_cast<const float*>(p.ws + REG_B);
  u16* cqn = reinterpret_cast<u16*>(p.ws + MLA_CQN);
  u16* ckvn = reinterpret_cast<u16*>(p.ws + MLA_CKVN);
  u16* Kb = reinterpret_cast<u16*>(p.ws + MLA_K);
  for (int tok = blockIdx.x * 8 + wid; tok < TOK; tok += nb * 8) {
    const float* row = hm + (long)tok * 768;
    float q[6], kv[4];
    float sq = 0.f, skv = 0.f;
#pragma unroll
    for (int i = 0; i < 6; ++i) { q[i] = row[i * 64 + lane]; sq += q[i] * q[i]; }
#pragma unroll
    for (int i = 0; i < 4; ++i) { kv[i] = row[384 + i * 64 + lane]; skv += kv[i] * kv[i]; }
    float rq = rsqrtf(wave_sum(sq) * (1.0f / 384.0f) + LN_EPS);
    float rkv = rsqrtf(wave_sum(skv) * (1.0f / 256.0f) + LN_EPS);
#pragma unroll
    for (int i = 0; i < 6; ++i) cqn[(long)tok * 384 + i * 64 + lane] = f2bf(q[i] * rq * p.mla_q_norm[i * 64 + lane]);
#pragma unroll
    for (int i = 0; i < 4; ++i) ckvn[(long)tok * 256 + i * 64 + lane] = f2bf(kv[i] * rkv * p.mla_kv_norm[i * 64 + lane]);
    const int b = tok >> 11, l = tok & 2047;
    float kr = (lane < 32) ? row[640 + lane] : 0.f;
    float x1 = __shfl(kr, lane & 15), x2 = __shfl(kr, (lane & 15) + 16);
    float sn, cs; sincosf((float)l * rope_inv(lane & 15), &sn, &cs);
    float r = (lane & 16) ? (x1 * sn + x2 * cs) : (x1 * cs - x2 * sn);
    u16 rb = f2bf(r);
    for (int hh = 0; hh < 16; hh += 2) {
      int h = hh + (lane >> 5);
      u16 val = (u16)__shfl((int)rb, lane & 31);
      Kb[(((long)b * 16 + h) * SEQ + l) * 96 + 64 + (lane & 31)] = val;
    }
  }
}
DEV void phase_mla_up(const Params& p) {
  const int nb = gridDim.x;
  const u16* cqn = reinterpret_cast<const u16*>(p.ws + MLA_CQN);
  const u16* ckvn = reinterpret_cast<const u16*>(p.ws + MLA_CKVN);
  const u16* wq = reinterpret_cast<const u16*>(p.ws + W_QUP);
  const u16* wkv = reinterpret_cast<const u16*>(p.ws + W_KVUP);
  u16* Qb = reinterpret_cast<u16*>(p.ws + MLA_Q);
  u16* Kb = reinterpret_cast<u16*>(p.ws + MLA_K);
  u16* VT = reinterpret_cast<u16*>(p.ws + MLA_VT);
  const float qscale = 0.10206207261596577f * 1.4426950408889634f;
  for (int v = vstart(); v < 64 * 12 + 64 * 16; v += nb) {
    if (v < 64 * 12) {
      int mt, nt; tile_mn(v, 12, mt, nt);
      const int brow = mt * 256, bcol = nt * 128;
      gemm_tile(cqn + (long)brow * 384, [&](int r) { return (unsigned)(r * 384); }, wq + (long)bcol * 384, 384,
              [&](Acc& acc, int wr, int wc, int fr, int fq) {
                const float inv = rope_inv(fr);
#pragma unroll
                for (int n2 = 0; n2 < 2; ++n2) {
                  const int c32 = (bcol + wc * 64 + n2 * 32) >> 5;
                  const int h = c32 / 3, part = c32 % 3;
#pragma unroll
                  for (int m = 0; m < 4; ++m)
#pragma unroll
                    for (int j = 0; j < 4; ++j) {
                      const int tok = brow + wr * 64 + m * 16 + fq * 4 + j;
                      const int b = tok >> 11, l = tok & 2047;
                      u16* qrow = Qb + (((long)b * 16 + h) * SEQ + l) * 96 + part * 32;
                      float a0 = acc[m][2 * n2][j], a1 = acc[m][2 * n2 + 1][j];
                      if (part == 2) {
                        float sn, cs; sincosf((float)l * inv, &sn, &cs);
                        float r0 = a0 * cs - a1 * sn, r1 = a0 * sn + a1 * cs;
                        a0 = r0; a1 = r1;
                      }
                      qrow[fr] = f2bf(a0 * qscale);
                      qrow[16 + fr] = f2bf(a1 * qscale);
                    }
                }
              });
    } else {
      int mt, nt; tile_mn(v - 64 * 12, 16, mt, nt);
      const int brow = mt * 256, bcol = nt * 128;
      gemm_tile(ckvn + (long)brow * 256, [&](int r) { return (unsigned)(r * 256); }, wkv + (long)bcol * 256, 256,
              [&](Acc& acc, int wr, int wc, int fr, int fq) {
                const int h = nt;
                EPI_FOR {
                  const int row = brow + EPI_ROW0, d = EPI_COL;
                  const int b = row >> 11, l = row & 2047;
                  if (d < 64) {
#pragma unroll
                    for (int j = 0; j < 4; ++j) Kb[(((long)b * 16 + h) * SEQ + l + j) * 96 + d] = f2bf(acc[m][n][j]);
                  } else {
                    uint2 pk; pk.x = pack2(acc[m][n][0], acc[m][n][1]); pk.y = pack2(acc[m][n][2], acc[m][n][3]);
                    *reinterpret_cast<uint2*>(VT + (((long)b * 16 + h) * 64 + (d - 64)) * SEQ + l) = pk;
                  }
                }
              });
    }
  }
}
constexpr int KST = 104, VST = 68;
DEV void mla_attn_unit(const Params& p, int u) {
  const int tid = otid(), lane = tid & 63, wid = tid >> 6, fr = lane & 15, fq = lane >> 4;
  const int qb = u & 7, bh = u >> 3;
  const u16* Qb = reinterpret_cast<const u16*>(p.ws + MLA_Q) + (long)bh * SEQ * 96;
  const u16* Kb = reinterpret_cast<const u16*>(p.ws + MLA_K) + (long)bh * SEQ * 96;
  const u16* VT = reinterpret_cast<const u16*>(p.ws + MLA_VT) + (long)bh * 64 * SEQ;
  u16* O = reinterpret_cast<u16*>(p.ws + MLA_O);
  u16* kl = reinterpret_cast<u16*>(smem);
  u16* vl = kl + 2 * 64 * KST;
  bf16x8 qf[2][3];
#pragma unroll
  for (int qt = 0; qt < 2; ++qt)
#pragma unroll
    for (int ks = 0; ks < 3; ++ks)
      qf[qt][ks] = *reinterpret_cast<const bf16x8*>(Qb + (long)(qb * 256 + wid * 32 + qt * 16 + fr) * 96 + ks * 32 + fq * 8);
  f32x4 o[4][2];
#pragma unroll
  for (int dt = 0; dt < 4; ++dt)
#pragma unroll
    for (int qt = 0; qt < 2; ++qt) o[dt][qt] = f32x4{0.f, 0.f, 0.f, 0.f};
  float mrun[2] = {-1e30f, -1e30f}, lrun[2] = {0.f, 0.f};
  const int kc0 = tid, kc1 = 512 + tid;
  const int vd = tid >> 3, vpart = tid & 7;
  uint4 kr0, kr1 = make_uint4(0, 0, 0, 0), vr;
  auto gload = [&](int t) {
    const u16* kt = Kb + (long)t * 64 * 96;
    kr0 = *reinterpret_cast<const uint4*>(kt + kc0 * 8);
    if (tid < 256) kr1 = *reinterpret_cast<const uint4*>(kt + kc1 * 8);
    vr = *reinterpret_cast<const uint4*>(VT + (long)vd * SEQ + t * 64 + vpart * 8);
  };
  auto lstore = [&](int buf) {
    u16* kd = kl + buf * 64 * KST; u16* vdst = vl + buf * 64 * VST;
    *reinterpret_cast<uint4*>(kd + (kc0 / 12) * KST + (kc0 % 12) * 8) = kr0;
    if (tid < 256) *reinterpret_cast<uint4*>(kd + (kc1 / 12) * KST + (kc1 % 12) * 8) = kr1;
    *reinterpret_cast<uint2*>(vdst + vd * VST + vpart * 8) = make_uint2(vr.x, vr.y);
    *reinterpret_cast<uint2*>(vdst + vd * VST + vpart * 8 + 4) = make_uint2(vr.z, vr.w);
  };
  __syncthreads();
  gload(0); lstore(0);
  __syncthreads();
  for (int t = 0; t < 32; ++t) {
    const int cur = t & 1;
    if (t + 1 < 32) gload(t + 1);
    const u16* kd = kl + cur * 64 * KST; const u16* vdl = vl + cur * 64 * VST;
    f32x4 s[4][2];
#pragma unroll
    for (int kt = 0; kt < 4; ++kt) {
      bf16x8 kf[3];
#pragma unroll
      for (int ks = 0; ks < 3; ++ks) kf[ks] = *reinterpret_cast<const bf16x8*>(kd + (kt * 16 + fr) * KST + ks * 32 + fq * 8);
#pragma unroll
      for (int qt = 0; qt < 2; ++qt) {
        f32x4 a = {0.f, 0.f, 0.f, 0.f};
#pragma unroll
        for (int ks = 0; ks < 3; ++ks) a = __builtin_amdgcn_mfma_f32_16x16x32_bf16(kf[ks], qf[qt][ks], a, 0, 0, 0);
        s[kt][qt] = a;
      }
    }
    bf16x8 pf[2][2];
#pragma unroll
    for (int qt = 0; qt < 2; ++qt) {
      float tm = -1e30f;
#pragma unroll
      for (int kt = 0; kt < 4; ++kt)
#pragma unroll
        for (int j = 0; j < 4; ++j) tm = fmaxf(tm, s[kt][qt][j]);
      tm = fmaxf(tm, __shfl_xor(tm, 16));
      tm = fmaxf(tm, __shfl_xor(tm, 32));
      const float mn = fmaxf(mrun[qt], tm);
      const float alpha = exp2f(mrun[qt] - mn);
      mrun[qt] = mn;
      float ls = 0.f;
#pragma unroll
      for (int kt = 0; kt < 4; ++kt)
#pragma unroll
        for (int j = 0; j < 4; ++j) { float e = exp2f(s[kt][qt][j] - mn); s[kt][qt][j] = e; ls += e; }
      lrun[qt] = lrun[qt] * alpha + ls;
#pragma unroll
      for (int dt = 0; dt < 4; ++dt) { o[dt][qt][0] *= alpha; o[dt][qt][1] *= alpha; o[dt][qt][2] *= alpha; o[dt][qt][3] *= alpha; }
#pragma unroll
      for (int k2 = 0; k2 < 2; ++k2) {
        union { bf16x8 v; unsigned u[4]; } t_;
        t_.u[0] = pack2(s[2 * k2][qt][0], s[2 * k2][qt][1]); t_.u[1] = pack2(s[2 * k2][qt][2], s[2 * k2][qt][3]);
        t_.u[2] = pack2(s[2 * k2 + 1][qt][0], s[2 * k2 + 1][qt][1]); t_.u[3] = pack2(s[2 * k2 + 1][qt][2], s[2 * k2 + 1][qt][3]);
        pf[k2][qt] = t_.v;
      }
    }
#pragma unroll
    for (int k2 = 0; k2 < 2; ++k2)
#pragma unroll
      for (int dt = 0; dt < 4; ++dt) {
        union { bf16x8 v; uint2 u[2]; } af;
        const u16* vp = vdl + (dt * 16 + fr) * VST + k2 * 32 + 4 * fq;
        af.u[0] = *reinterpret_cast<const uint2*>(vp);
        af.u[1] = *reinterpret_cast<const uint2*>(vp + 16);
#pragma unroll
        for (int qt = 0; qt < 2; ++qt) o[dt][qt] = __builtin_amdgcn_mfma_f32_16x16x32_bf16(af.v, pf[k2][qt], o[dt][qt], 0, 0, 0);
      }
    if (t + 1 < 32) lstore(cur ^ 1);
    __syncthreads();
  }
  const int b = bh >> 4, h = bh & 15;
#pragma unroll
  for (int qt = 0; qt < 2; ++qt) {
    float l = lrun[qt];
    l += __shfl_xor(l, 16);
    l += __shfl_xor(l, 32);
    const float inv = 1.0f / l;
    const long tok = (long)b * SEQ + qb * 256 + wid * 32 + qt * 16 + fr;
#pragma unroll
    for (int dt = 0; dt < 4; ++dt) {
      uint2 pk; pk.x = pack2(o[dt][qt][0] * inv, o[dt][qt][1] * inv); pk.y = pack2(o[dt][qt][2] * inv, o[dt][qt][3] * inv);
      *reinterpret_cast<uint2*>(O + tok * 1024 + h * 64 + dt * 16 + 4 * fq) = pk;
    }
  }
}
DEV void phase_mla_attn(const Params& p) {
  const int nb = gridDim.x;
  for (int u = blockIdx.x; u < NBATCH * 16 * 8; u += nb) mla_attn_unit(p, u);
}

#ifndef ONLY
#define ONLY -1
#endif
#define PH(n, ...) if (ONLY < 0 || ONLY == n) { __VA_ARGS__; }
constexpr int LDS_BAR_OFF = 131072;
__global__ void __launch_bounds__(512) mega(Params p) {
  cg::grid_group grid = cg::this_grid();
  unsigned* barw = reinterpret_cast<unsigned*>(p.ws + S_BAR);
  if (blockIdx.x == 0) for (int i = threadIdx.x; i < XCD_BAR_WORDS; i += 512) barw[i] = 0u;
  if (threadIdx.x == 0) *reinterpret_cast<uint4*>(smem + LDS_BAR_OFF) = make_uint4(0u, 0u, 0u, 0u);
  PH(0, phase_prep(p));
  grid.sync();
  XcdBarrier xb = xcd_barrier_post(barw, (volatile LAS unsigned*)(smem + LDS_BAR_OFF));
#define GSYNC() xcd_barrier(xb)
  PH(1, phase_abin(p)); GSYNC();
  PH(2, phase_mix0(p)); GSYNC();
  PH(3, phase_outproj(p, reinterpret_cast<const u16*>(p.ws + REG_A + 100663296ull), reinterpret_cast<const u16*>(p.ws + W_ABOUT), p.x)); GSYNC();
  for (int layer = 0; layer < 2; ++layer) {
    if (layer == 1) {
      PH(10, phase_mla_in(p)); GSYNC();
      PH(11, phase_mla_norm(p)); GSYNC();
      PH(12, phase_mla_up(p)); GSYNC();
      PH(13, phase_mla_attn(p)); GSYNC();
      PH(3, phase_outproj(p, reinterpret_cast<const u16*>(p.ws + MLA_O), reinterpret_cast<const u16*>(p.ws + W_MLAOUT), reinterpret_cast<const float*>(p.ws + REG_G))); GSYNC();
    }
    PH(4, phase_ln1_router(p, layer)); GSYNC();
    PH(5, phase_topk(p)); GSYNC();
    PH(6, phase_moe1(p, layer)); GSYNC();
    PH(7, phase_moe2(p, layer)); GSYNC();
    PH(8, phase_ln2(p, layer)); GSYNC();
    PH(9, phase_ple(p, layer, layer ? p.out : reinterpret_cast<float*>(p.ws + REG_G), layer ? nullptr : reinterpret_cast<u16*>(p.ws + REG_X)));
    if (layer == 0) GSYNC();
  }
}

static void add_job(Params& P, int& nj, int& tile, const float* src, u16* dst, int K, int N, int rsh, int rs, int off, int count, long sstride, long dstride) {
  ConvJob& J = P.jobs[nj++];
  J.src = src; J.dst = dst; J.sstride = sstride; J.dstride = dstride; J.K = K; J.N = N; J.rs = rs; J.off = off; J.rsh = rsh;
  J.ntn = (N + 255) / 256; J.tpm = (K / 64) * J.ntn; J.tile0 = tile; J.ntiles = J.tpm * count;
  tile += J.ntiles;
}

extern "C" void kernel_launch(void* const* d_in, const int* in_sizes, int n_in,
                              void* d_out, int out_size, void* d_ws, size_t ws_size,
                              hipStream_t stream) {
  constexpr size_t kDynLds = 131072 + 16;
  static int grid_blocks = 0;
  if (!grid_blocks) {
    int dev = 0, cus = 0, per_cu = 0;
    (void)hipGetDevice(&dev);
    (void)hipDeviceGetAttribute(&cus, hipDeviceAttributeMultiprocessorCount, dev);
    (void)hipFuncSetAttribute((const void*)mega, hipFuncAttributeMaxDynamicSharedMemorySize, (int)kDynLds);
    (void)hipOccupancyMaxActiveBlocksPerMultiprocessor(&per_cu, mega, 512, kDynLds);
    if (per_cu > 1) per_cu = 1;
    if (per_cu < 1) { fprintf(stderr, "occupancy query returned 0\n"); per_cu = 1; }
    grid_blocks = cus * per_cu;
    if (ws_size < WS_TOTAL) fprintf(stderr, "workspace too small: %zu < %zu\n", ws_size, (size_t)WS_TOTAL);
  }
  Params P;
  memset(&P, 0, sizeof(P));
  auto F = [&](int i) { return (const float*)d_in[i]; };
  char* ws = (char*)d_ws;
  P.x = F(0); P.p = F(1);
  P.na_rpb = F(3); P.hy_conv_w = F(4); P.hy_conv_b = F(5);
  P.hy_f_w1 = F(6); P.hy_f_b1 = F(7); P.hy_f_freq = F(8); P.hy_f_w2 = F(9); P.hy_f_b2 = F(10); P.hy_f_w3 = F(11); P.hy_skip = F(12);
  P.mla_q_norm = F(15); P.mla_kv_norm = F(17);
  P.ln1_g = F(20); P.ln1_b = F(21); P.ln2_g = F(22); P.ln2_b = F(23);
  P.moe_router = F(24);
  P.out = (float*)d_out; P.ws = ws;
  int nj = 0, tile = 0;
  add_job(P, nj, tile, F(2), (u16*)(ws + W_ABIN), 1024, 3072, 7, 128, 0, 1, 0, 0);
  add_job(P, nj, tile, F(13), (u16*)(ws + W_ABOUT), 1024, 1024, 7, 128, 0, 1, 0, 0);
  add_job(P, nj, tile, F(14), (u16*)(ws + W_MLAIN), 1024, 672, 7, 128, 0, 1, 0, 0);
  add_job(P, nj, tile, F(16), (u16*)(ws + W_QUP), 384, 1536, 7, 128, 0, 1, 0, 0);
  add_job(P, nj, tile, F(18), (u16*)(ws + W_KVUP), 256, 2048, 7, 128, 0, 1, 0, 0);
  add_job(P, nj, tile, F(19), (u16*)(ws + W_MLAOUT), 1024, 1024, 7, 128, 0, 1, 0, 0);
  add_job(P, nj, tile, F(28), (u16*)(ws + W_PLEG), 1024, 1024, 7, 128, 0, 2, 1024L * 1024, 1024L * 1024);
  add_job(P, nj, tile, F(29), (u16*)(ws + W_PLEP), 256, 1024, 7, 128, 0, 2, 256L * 1024, 1024L * 256);
  add_job(P, nj, tile, F(25), (u16*)(ws + W_GU), 1024, 2048, 4, 32, 0, 32, 1024L * 2048, 4096L * 1024);
  add_job(P, nj, tile, F(26), (u16*)(ws + W_GU), 1024, 2048, 4, 32, 16, 32, 1024L * 2048, 4096L * 1024);
  add_job(P, nj, tile, F(27), (u16*)(ws + W_DN), 2048, 1024, 7, 128, 0, 32, 2048L * 1024, 1024L * 2048);
  P.conv_total = tile;
  void* args[] = {&P};
  hipError_t e = hipLaunchCooperativeKernel((void*)mega, dim3(grid_blocks), dim3(512), args, kDynLds, stream);
  if (e != hipSuccess) fprintf(stderr, "cooperative launch failed: %s (grid %d)\n", hipGetErrorString(e), grid_blocks);
}
```

```cpp
#include <hip/hip_runtime.h>
#include <hip/hip_bf16.h>
#include <hip/hip_cooperative_groups.h>
#include <cstdio>
#include <cstring>
namespace cg = cooperative_groups;

typedef unsigned short u16;
using bf16x8 = __attribute__((ext_vector_type(8))) short;
using bf16x4 = __attribute__((ext_vector_type(4))) short;
using f32x4 = __attribute__((ext_vector_type(4))) float;
#define DEV __device__ __forceinline__

constexpr int TOK = 16384, DM = 1024, SEQ = 2048, NBATCH = 8;
constexpr int NEXP = 16, CAP = 256, DFF = 2048;
constexpr float DN_ALPHA = 1.4142135623730951f;
constexpr float LN_EPS = 1e-5f;

constexpr size_t W_ABIN = 0;
constexpr size_t W_ABOUT = W_ABIN + 3072ull * 1024 * 2;
constexpr size_t W_MLAIN = W_ABOUT + 1024ull * 1024 * 2;
constexpr size_t W_QUP = W_MLAIN + 768ull * 1024 * 2;
constexpr size_t W_KVUP = W_QUP + 1536ull * 384 * 2;
constexpr size_t W_MLAOUT = W_KVUP + 2048ull * 256 * 2;
constexpr size_t W_PLEG = W_MLAOUT + 1024ull * 1024 * 2;
constexpr size_t W_PLEP = W_PLEG + 2 * 1024ull * 1024 * 2;
constexpr size_t W_GU = W_PLEP + 2 * 1024ull * 256 * 2;
constexpr size_t W_DN = W_GU + 2 * 16ull * 4096 * 1024 * 2;
constexpr size_t REG_A = W_DN + 2 * 16ull * 1024 * 2048 * 2;
constexpr size_t REG_B = REG_A + 134217728ull;
constexpr size_t REG_C = REG_B + 134217728ull;
constexpr size_t REG_D = REG_C + 67108864ull;
constexpr size_t REG_E = REG_D + 67108864ull;
constexpr size_t REG_G = REG_E + 33554432ull;
constexpr size_t REG_X = REG_G + 67108864ull;
constexpr size_t REG_P = REG_X + 33554432ull;
constexpr size_t S_AFF = REG_P + 16777216ull;
constexpr size_t S_IDX = S_AFF + 1048576ull;
constexpr size_t S_GSEL = S_IDX + 131072ull;
constexpr size_t S_SLOT = S_GSEL + 131072ull;
constexpr size_t S_H2 = S_SLOT + 1048576ull;
constexpr size_t S_RG = S_H2 + 524288ull;
constexpr size_t S_BAR = S_RG + 8388608ull;
constexpr size_t WS_TOTAL = S_BAR + 16384ull;

struct ConvJob {
  const float* src; u16* dst;
  long sstride, dstride;
  int K, N;
  int rs, off;
  int rsh, sh2, off2, padj;
  int ntn;
  int tpm;
  int tile0, ntiles;
};
constexpr int NJOBS = 16;

struct Params {
  const float* x; const float* p;
  const float* na_rpb; const float* hy_conv_w; const float* hy_conv_b;
  const float* hy_f_w1; const float* hy_f_b1; const float* hy_f_freq; const float* hy_f_w2; const float* hy_f_b2;
  const float* hy_f_w3; const float* hy_skip;
  const float* mla_q_norm; const float* mla_kv_norm;
  const float* ln1_g; const float* ln1_b; const float* ln2_g; const float* ln2_b;
  const float* moe_router;
  float* out; char* ws;
  int conv_total; int pad0;
  ConvJob jobs[NJOBS];
};

extern __shared__ __attribute__((aligned(16))) char smem[];

DEV u16 f2bf(float f) {
  unsigned u = __float_as_uint(f);
  u += 0x7fffu + ((u >> 16) & 1u);
  return (u16)(u >> 16);
}
DEV float bf2f(u16 h) { return __uint_as_float(((unsigned)h) << 16); }
DEV unsigned pack2(float a, float b) { return (unsigned)f2bf(a) | ((unsigned)f2bf(b) << 16); }
DEV float wave_sum(float v) {
#pragma unroll
  for (int o = 32; o > 0; o >>= 1) v += __shfl_xor(v, o);
  return v;
}
DEV int otid() { int t = threadIdx.x; asm volatile("" : "+v"(t)); return t; }
DEV int vstart() {
  int nb = gridDim.x, b = blockIdx.x;
  return (nb % 8 == 0) ? (b % 8) * (nb / 8) + b / 8 : b;
}


#define XB_TMO      128
#define XB_XCNT(j)  (256  + 64 * (j))
#define XB_XSUB(j)  (1280 + 64 * (j))
#define XB_XGEN(j)  (2304 + 64 * (j))
#define XB_TOP      3328
#define XB_TOPGEN   3392
#define XCD_BAR_WORDS 3456
#define XB_SPIN_CAP (1u << 18)
#define LAS __attribute__((address_space(3)))
DEV unsigned xb_ld(unsigned* p) { return __hip_atomic_load(p, __ATOMIC_RELAXED, __HIP_MEMORY_SCOPE_AGENT); }
DEV unsigned xb_add(unsigned* p, unsigned v) { return __hip_atomic_fetch_add(p, v, __ATOMIC_RELAXED, __HIP_MEMORY_SCOPE_AGENT); }
DEV unsigned xb_xcc_id() { return (unsigned)__builtin_amdgcn_s_getreg((3 << 11) | 20) & 0xFu; }
#define XB_SPIN(cond, bar) do { unsigned _sp = 0; while (cond) { __builtin_amdgcn_s_sleep(1); \
    if ((++_sp & 255u) == 0u) { if (xb_ld(&(bar)[XB_TMO])) break; if (_sp > XB_SPIN_CAP) { atomicAdd(&(bar)[XB_TMO], 1u); break; } } } } while (0)
struct XcdBarrier { unsigned* bar; unsigned x; volatile LAS unsigned* st; };
DEV XcdBarrier xcd_barrier_post(unsigned* bar, volatile LAS unsigned* st) {
  XcdBarrier b; b.bar = bar; b.x = xb_xcc_id(); b.st = st;
  if (threadIdx.x == 0) (void)xb_add(&bar[XB_XCNT(b.x)], 1u);
  return b;
}
DEV void xcd_barrier_complete(unsigned* bar, unsigned x, unsigned& nloc, unsigned& nx) {
  const unsigned G = gridDim.x * gridDim.y * gridDim.z;
  unsigned sum, cnt, mine, sp = 0u;
  for (;;) {
    sum = 0u; cnt = 0u; mine = 0u;
#pragma unroll
    for (unsigned j = 0; j < 16; ++j) { const unsigned c = xb_ld(&bar[XB_XCNT(j)]); sum += c; cnt += (c > 0u) ? 1u : 0u; mine = (j == x) ? c : mine; }
    if (sum == G) break;
    __builtin_amdgcn_s_sleep(1);
    if ((++sp & 255u) == 0u) { if (xb_ld(&bar[XB_TMO])) break; if (sp > XB_SPIN_CAP) { atomicAdd(&bar[XB_TMO], 1u); break; } }
  }
  nloc = mine > 0u ? mine : 1u; nx = cnt > 0u ? cnt : 1u;
}
DEV void xcd_barrier(const XcdBarrier& b) {
  asm volatile("s_waitcnt vmcnt(0)" ::: "memory");
  __syncthreads();
  if (threadIdx.x == 0) {
    unsigned* bar = b.bar;
    __builtin_amdgcn_s_waitcnt(0);
    unsigned nloc = b.st[0], nx = b.st[1];
    if (nloc == 0u) { xcd_barrier_complete(bar, b.x, nloc, nx); b.st[0] = nloc; b.st[1] = nx; }
    const unsigned old = xb_add(&bar[XB_XSUB(b.x)], 1u);
    const unsigned gen = old / nloc;
    if (old + 1u == (gen + 1u) * nloc) {
      __builtin_amdgcn_fence(__ATOMIC_RELEASE, "agent");
      asm volatile("s_waitcnt vmcnt(0)" ::: "memory");
      const unsigned og = xb_add(&bar[XB_TOP], 1u);
      const unsigned tg = og / nx;
      if (og + 1u == (tg + 1u) * nx) xb_add(&bar[XB_TOPGEN], 1u);
      else XB_SPIN(xb_ld(&bar[XB_TOPGEN]) == tg, bar);
      __builtin_amdgcn_fence(__ATOMIC_ACQUIRE, "agent");
      xb_add(&bar[XB_XGEN(b.x)], 1u);
      asm volatile("s_waitcnt vmcnt(0)" ::: "memory");
    } else {
      XB_SPIN(xb_ld(&bar[XB_XGEN(b.x)]) == gen, bar);
      __builtin_amdgcn_fence(__ATOMIC_ACQUIRE, "agent");
      asm volatile("s_waitcnt vmcnt(0)" ::: "memory");
    }
  }
  __syncthreads();
}

DEV int lds_byte(int r, int c) {
  int st = (r >> 4) * 2 + (c >> 5), rr = r & 15, cc = c & 31, ob = rr * 64 + cc * 2;
  return st * 1024 + (ob ^ (((ob >> 9) & 1) << 5));
}
DEV void stage_rc(int b, int& R, int& C) {
  int st = b / 1024, sb = b % 1024, swz = sb ^ (((sb >> 9) & 1) << 5);
  R = (st >> 1) * 16 + swz / 64; C = (st & 1) * 32 + (swz % 64) / 2;
}
#define GLDS16(g, l) __builtin_amdgcn_global_load_lds((const unsigned*)(g), (unsigned*)(l), 16, 0, 0)

typedef f32x4 Acc8[2][2][4][2];
constexpr int G8_BM = 256, G8_BK = 64, G8_HALF = 128, G8_HTB = G8_HALF * G8_BK * 2, G8_NXCD = 8, G8_WGM = 8;
DEV int perm32(int rho) { const int n = rho >> 4, i = rho & 15; return 8 * (i >> 2) + 4 * n + (i & 3); }
struct Unit { int pm, pn; };
DEV bool unit_next(int i, int nM, int nN, Unit& u) {
  const int nwg = nM * nN;
  const long L = (long)i * gridDim.x + blockIdx.x; if (L >= nwg) return false;
  int wgid = (int)L; { const int q = nwg / G8_NXCD, r = nwg % G8_NXCD, xcd = wgid % G8_NXCD, off = wgid / G8_NXCD; wgid = (xcd < r ? xcd * (q + 1) : r * (q + 1) + (xcd - r) * q) + off; }
  const int nig = G8_WGM * nN, gid = wgid / nig, fm = gid * G8_WGM, gsz = (nM - fm) < G8_WGM ? (nM - fm) : G8_WGM;
  u.pm = fm + ((wgid % nig) % gsz); u.pn = (wgid % nig) / gsz; return true;
}
template <bool TR, bool PERM, class PF, class EF>
DEV void gemm_phase(const int K, const int nM, const int nN, PF ptrs, EF E) {
  LAS unsigned char* lds = (LAS unsigned char*)smem;
  const int tid = otid(), wid = __builtin_amdgcn_readfirstlane(tid >> 6), lane = tid & 63, wr = wid >> 2, wc = wid & 3, fr = lane & 15, fq = lane >> 4;
  const int nt = K / G8_BK;
  unsigned voffA[2], voffB[2];
#pragma unroll
  for (int i = 0; i < 2; ++i) { int R, C; stage_rc(tid * 16 + i * 8192, R, C); const int Rb = PERM ? ((R & ~31) + perm32(R & 31)) : R;
    voffA[i] = (unsigned)(R * K + C) * 2u; voffB[i] = (unsigned)(Rb * K + C) * 2u; }
  const size_t kstep = (size_t)(G8_BK * 2);
  const size_t hstep = (size_t)G8_HALF * K * 2;
  const unsigned ldsw = (unsigned)wid * 1024u;
  const int aoff = lds_byte(wr * 64 + fr, fq * 8), boff = lds_byte(wc * 32 + fr, fq * 8);
#define PG8_SA(b, h) (((b) * 2 + (h)) * G8_HTB)
#define PG8_SB(b, h) ((4 + (b) * 2 + (h)) * G8_HTB)
#define PG8_STAGE(bufoff, gbase, voff) do { _Pragma("unroll") for (int _i = 0; _i < 2; ++_i) \
    __builtin_amdgcn_global_load_lds((const unsigned*)((const char*)(gbase) + (voff)[_i]), (LAS unsigned*)(lds + (bufoff) + ldsw + _i * 8192), 16, 0, 0); } while (0)
#define PG8_LDA(dst, b, h) do { _Pragma("unroll") for (int m = 0; m < 4; ++m) _Pragma("unroll") for (int k = 0; k < 2; ++k) dst[m][k] = *(const LAS bf16x8*)(lds + PG8_SA(b, h) + aoff + m * 2048 + k * 1024); } while (0)
#define PG8_LDB(dst, b, h) do { _Pragma("unroll") for (int n = 0; n < 2; ++n) _Pragma("unroll") for (int k = 0; k < 2; ++k) dst[n][k] = *(const LAS bf16x8*)(lds + PG8_SB(b, h) + boff + n * 2048 + k * 1024); } while (0)
#define PG8_MMA(ai, bj, At, Bt) do { __builtin_amdgcn_s_setprio(1); _Pragma("unroll") for (int m = 0; m < 4; ++m) _Pragma("unroll") for (int n = 0; n < 2; ++n) _Pragma("unroll") for (int k = 0; k < 2; ++k) \
    acc[ai][bj][m][n] = TR ? __builtin_amdgcn_mfma_f32_16x16x32_bf16(Bt[n][k], At[m][k], acc[ai][bj][m][n], 0, 0, 0) \
                           : __builtin_amdgcn_mfma_f32_16x16x32_bf16(At[m][k], Bt[n][k], acc[ai][bj][m][n], 0, 0, 0); __builtin_amdgcn_s_setprio(0); } while (0)
#define PG8_WAIT_V(n) asm volatile("s_waitcnt vmcnt(" #n ")" ::: "memory")
#define PG8_WAIT_L(n) asm volatile("s_waitcnt lgkmcnt(" #n ")" ::: "memory")
#define PG8_BAR __builtin_amdgcn_s_barrier()
#define PG8_SCHED __builtin_amdgcn_sched_barrier(0)
  Unit cur, nxt; int ui = 0;
  if (!unit_next(0, nM, nN, cur)) return;
  Acc8 acc;
#pragma unroll
  for (int a = 0; a < 2; ++a)
#pragma unroll
    for (int b = 0; b < 2; ++b)
#pragma unroll
      for (int m = 0; m < 4; ++m)
#pragma unroll
        for (int n = 0; n < 2; ++n) acc[a][b][m][n] = f32x4{0.f, 0.f, 0.f, 0.f};
  bf16x8 At[4][2], B0[2][2], B1[2][2];
  const char* cA; const char* cB;
  ptrs(cur, cA, cB);
  PG8_STAGE(PG8_SB(0, 0), cB, voffB); PG8_STAGE(PG8_SA(0, 0), cA, voffA); PG8_STAGE(PG8_SB(0, 1), cB + hstep, voffB); PG8_STAGE(PG8_SA(0, 1), cA + hstep, voffA);
  if (wr == 1) PG8_BAR;
  PG8_WAIT_V(4); PG8_BAR;
  PG8_STAGE(PG8_SB(1, 0), cB + kstep, voffB); PG8_STAGE(PG8_SA(1, 0), cA + kstep, voffA); PG8_STAGE(PG8_SB(1, 1), cB + hstep + kstep, voffB);
  PG8_WAIT_V(6); PG8_BAR;
  for (;;) {
    const bool has_next = unit_next(ui + 1, nM, nN, nxt);
    const char* nA = cA; const char* nB = cB;
    if (has_next) ptrs(nxt, nA, nB);
#pragma unroll 1
    for (int t = 0; t < nt; t += 2) {
      const bool last = (t == nt - 2);
      const char* a1 = cA + (size_t)(t + 1) * kstep;
      const char* a2 = last ? nA : cA + (size_t)(t + 2) * kstep; const char* b2 = last ? nB : cB + (size_t)(t + 2) * kstep;
      const char* a3 = a2 + kstep; const char* b3 = b2 + kstep;
      PG8_LDB(B0, 0, 0); PG8_SCHED; PG8_LDA(At, 0, 0); PG8_STAGE(PG8_SA(1, 1), a1 + hstep, voffA);
      PG8_WAIT_L(8); PG8_BAR; PG8_WAIT_L(0); PG8_MMA(0, 0, At, B0); PG8_BAR; PG8_SCHED;
      PG8_LDB(B1, 0, 1); PG8_STAGE(PG8_SB(0, 0), b2, voffB);
      PG8_BAR; PG8_WAIT_L(0); PG8_MMA(0, 1, At, B1); PG8_BAR;
      PG8_LDA(At, 0, 1); PG8_STAGE(PG8_SA(0, 0), a2, voffA);
      PG8_BAR; PG8_WAIT_L(0); PG8_MMA(1, 0, At, B0); PG8_BAR; PG8_SCHED;
      PG8_STAGE(PG8_SB(0, 1), b2 + hstep, voffB);
      PG8_WAIT_V(6); PG8_BAR; PG8_MMA(1, 1, At, B1); PG8_BAR;
      PG8_LDB(B0, 1, 0); PG8_SCHED; PG8_LDA(At, 1, 0); PG8_STAGE(PG8_SA(0, 1), a2 + hstep, voffA);
      PG8_WAIT_L(8); PG8_BAR; PG8_WAIT_L(0); PG8_MMA(0, 0, At, B0); PG8_BAR; PG8_SCHED;
      PG8_LDB(B1, 1, 1); PG8_STAGE(PG8_SB(1, 0), b3, voffB);
      PG8_BAR; PG8_WAIT_L(0); PG8_MMA(0, 1, At, B1); PG8_BAR;
      PG8_LDA(At, 1, 1); PG8_STAGE(PG8_SA(1, 0), a3, voffA);
      PG8_BAR; PG8_WAIT_L(0); PG8_MMA(1, 0, At, B0); PG8_BAR; PG8_SCHED;
      PG8_STAGE(PG8_SB(1, 1), b3 + hstep, voffB);
      PG8_WAIT_V(6); PG8_BAR; PG8_MMA(1, 1, At, B1); PG8_BAR;
    }
    E(acc, cur, wr, wc, fr, fq);
    if (!has_next) break;
#pragma unroll
    for (int a = 0; a < 2; ++a)
#pragma unroll
      for (int b = 0; b < 2; ++b)
#pragma unroll
        for (int m = 0; m < 4; ++m)
#pragma unroll
          for (int n = 0; n < 2; ++n) acc[a][b][m][n] = f32x4{0.f, 0.f, 0.f, 0.f};
    cur = nxt; cA = nA; cB = nB; ++ui;
  }
  PG8_WAIT_V(0);
  if (wr == 0) PG8_BAR;
  PG8_BAR;
#undef PG8_SA
#undef PG8_SB
#undef PG8_STAGE
#undef PG8_LDA
#undef PG8_LDB
#undef PG8_MMA
#undef PG8_WAIT_V
#undef PG8_WAIT_L
#undef PG8_BAR
#undef PG8_SCHED
}
#define E8_FOR _Pragma("unroll") for (int ai = 0; ai < 2; ++ai) _Pragma("unroll") for (int m = 0; m < 4; ++m) _Pragma("unroll") for (int bj = 0; bj < 2; ++bj)
DEV unsigned cvt_pk_bf16(float lo, float hi) { unsigned r; asm volatile("v_cvt_pk_bf16_f32 %0, %1, %2" : "=v"(r) : "v"(lo), "v"(hi)); return r; }

DEV void conv_tile(const ConvJob& J, int t) {
  const int tid = otid();
  int mat = t / J.tpm, tt = t % J.tpm;
  int kt = tt / J.ntn, nt = tt % J.ntn;
  const float* src = J.src + (long)mat * J.sstride;
  u16* dst = J.dst + (long)mat * J.dstride;
  const int kg = tid >> 6, ng = tid & 63;
  const int n = nt * 256 + ng * 4;
  float4 v[8];
#pragma unroll
  for (int j = 0; j < 8; ++j) {
    int k = kt * 64 + kg * 8 + j;
    if (n < J.N) v[j] = *reinterpret_cast<const float4*>(src + (long)k * J.N + n);
    else v[j] = make_float4(0.f, 0.f, 0.f, 0.f);
  }
#pragma unroll
  for (int i = 0; i < 4; ++i) {
    float e[8];
#pragma unroll
    for (int j = 0; j < 8; ++j) e[j] = (i == 0) ? v[j].x : (i == 1) ? v[j].y : (i == 2) ? v[j].z : v[j].w;
    uint4 pk;
    pk.x = pack2(e[0], e[1]); pk.y = pack2(e[2], e[3]); pk.z = pack2(e[4], e[5]); pk.w = pack2(e[6], e[7]);
    *reinterpret_cast<uint4*>(smem + (i * 64 + ng) * 144 + kg * 16) = pk;
  }
  __syncthreads();
#pragma unroll
  for (int u = 0; u < 4; ++u) {
    int q = tid + 512 * u;
    int nl = q >> 3, ch = q & 7;
    uint4 pk = *reinterpret_cast<const uint4*>(smem + ((nl & 3) * 64 + (nl >> 2)) * 144 + ch * 16);
    int nn = nt * 256 + nl;
    const int qq = nn >> J.rsh;
    long drow = (long)(qq >> J.sh2) * J.rs + (qq & ((1 << J.sh2) - 1)) * J.off2 + (nn & ((1 << J.rsh) - 1)) + J.off;
    *reinterpret_cast<uint4*>(dst + drow * J.K + kt * 64 + ch * 8) = pk;
  }
  __syncthreads();
}

DEV void phase_prep(const Params& p) {
  const int tid = otid(), nb = gridDim.x, bid = blockIdx.x;
  {
    float* zb = reinterpret_cast<float*>(smem);
    float* h1b = zb + 512;
    float* h2g = reinterpret_cast<float*>(p.ws + S_H2);
    const int w = tid >> 6, lane = tid & 63;
    for (int l0 = bid * 8; l0 < SEQ; l0 += nb * 8) {
      int l = l0 + w;
      float tt = (float)l / (float)(SEQ - 1);
      float ww = 6.283185307179586f * (float)l / (float)SEQ;
      float z = 0.f;
      if (lane == 0) z = tt;
      else if (lane <= 16) { float f = 1e-4f + (float)(lane - 1) * ((15.0f - 1e-4f) / 15.0f); z = cosf(f * ww); }
      else if (lane <= 32) { float f = 1e-4f + (float)(lane - 17) * ((15.0f - 1e-4f) / 15.0f); z = -sinf(f * ww); }
      zb[w * 64 + lane] = z;
      __syncthreads();
      float fr_ = p.hy_f_freq[lane];
      float a = p.hy_f_b1[lane];
      for (int k = 0; k < 33; ++k) a += zb[w * 64 + k] * p.hy_f_w1[k * 64 + lane];
      h1b[w * 64 + lane] = sinf(fr_ * a);
      __syncthreads();
      float a2 = p.hy_f_b2[lane];
      for (int k = 0; k < 64; ++k) a2 += h1b[w * 64 + k] * p.hy_f_w2[k * 64 + lane];
      h2g[l * 64 + lane] = sinf(fr_ * a2);
      __syncthreads();
    }
  }
  {
    u16* xb = reinterpret_cast<u16*>(p.ws + REG_X);
    const long n8 = (long)TOK * DM / 8;
    for (long i = (long)bid * 512 + tid; i < n8; i += (long)nb * 512) {
      float4 a = reinterpret_cast<const float4*>(p.x)[2 * i], b = reinterpret_cast<const float4*>(p.x)[2 * i + 1];
      uint4 pk; pk.x = pack2(a.x, a.y); pk.y = pack2(a.z, a.w); pk.z = pack2(b.x, b.y); pk.w = pack2(b.z, b.w);
      reinterpret_cast<uint4*>(xb)[i] = pk;
    }
    u16* pb = reinterpret_cast<u16*>(p.ws + REG_P);
    const long m8 = 2L * TOK * 256 / 8;
    for (long i = (long)bid * 512 + tid; i < m8; i += (long)nb * 512) {
      float4 a = reinterpret_cast<const float4*>(p.p)[2 * i], b = reinterpret_cast<const float4*>(p.p)[2 * i + 1];
      uint4 pk; pk.x = pack2(a.x, a.y); pk.y = pack2(a.z, a.w); pk.z = pack2(b.x, b.y); pk.w = pack2(b.z, b.w);
      reinterpret_cast<uint4*>(pb)[i] = pk;
    }
  }
  for (int t = bid; t < p.conv_total; t += nb) {
    int j = 0;
#pragma unroll 1
    for (int q = 1; q < NJOBS; ++q) if (t >= p.jobs[q].tile0 && p.jobs[q].ntiles > 0) j = q;
    conv_tile(p.jobs[j], t - p.jobs[j].tile0);
  }
}

DEV void filter_b(const Params& p, int cpair) {
  const int tid = otid();
  float* w3s = reinterpret_cast<float*>(smem);
  float* red = w3s + 512;
  float* nrm = red + 32;
  float* hb = nrm + 4;
  const float* h2g = reinterpret_cast<const float*>(p.ws + S_H2);
  {
    int ci = tid >> 6, k = tid & 63;
    int o = ci >> 2, d = (ci >> 1) & 1, cc = ci & 1;
    w3s[ci * 64 + k] = p.hy_f_w3[k * 2048 + o * 1024 + d * 512 + 2 * cpair + cc];
  }
  __syncthreads();
  const float min_decay = logf(1e-2f) / 1.5f, max_decay = logf(1e-2f) / 0.3f;
#pragma unroll 1
  for (int i = 0; i < 4; ++i) {
    int l = tid + 512 * i;
    float h2[64];
#pragma unroll
    for (int k = 0; k < 16; ++k) {
      float4 v = *reinterpret_cast<const float4*>(h2g + l * 64 + k * 4);
      h2[4 * k] = v.x; h2[4 * k + 1] = v.y; h2[4 * k + 2] = v.z; h2[4 * k + 3] = v.w;
    }
    float tt = (float)l / (float)(SEQ - 1);
#pragma unroll 1
    for (int ci = 0; ci < 8; ++ci) {
      float a = 0.f;
#pragma unroll
      for (int k = 0; k < 64; ++k) a += h2[k] * w3s[ci * 64 + k];
      int cc = ci & 1;
      int c = 2 * cpair + cc;
      float delta = fabsf(min_decay + (float)c * ((max_decay - min_decay) / 511.0f));
      a *= expf(-tt * delta);
      hb[ci * 2048 + l] = a;
    }
  }
  __syncthreads();
  {
    float ss[4];
#pragma unroll
    for (int oc = 0; oc < 4; ++oc) {
      int o = oc >> 1, cc = oc & 1;
      float a = 0.f;
      for (int l = tid; l < 2048; l += 512) {
        float f = hb[(o * 4 + 0 + cc) * 2048 + l];
        float b = (l > 0) ? hb[(o * 4 + 2 + cc) * 2048 + l] : 0.f;
        a += f * f + b * b;
      }
      ss[oc] = wave_sum(a);
    }
    if ((tid & 63) == 0) {
#pragma unroll
      for (int q = 0; q < 4; ++q) red[(tid >> 6) * 4 + q] = ss[q];
    }
  }
  __syncthreads();
  if (tid < 4) {
    float s = 0.f;
    for (int w = 0; w < 8; ++w) s += red[w * 4 + tid];
    nrm[tid] = rsqrtf(s + 1e-12f);
  }
  __syncthreads();
  u16* Rg = reinterpret_cast<u16*>(p.ws + S_RG);
  for (int q = tid; q < 4 * 4096; q += 512) {
    int oc = q >> 12, qq = q & 4095;
    int o = oc >> 1, cc = oc & 1;
    float v;
    if (qq == 0) v = 0.f;
    else if (qq <= 2048) v = hb[(o * 4 + 0 * 2 + cc) * 2048 + (2048 - qq)];
    else v = hb[(o * 4 + 1 * 2 + cc) * 2048 + (qq - 2048)];
    v *= nrm[oc];
    Rg[((long)o * 512 + 2 * cpair + cc) * 4096 + qq] = f2bf(v);
  }
  __syncthreads();
}

DEV void phase_abin(const Params& p) {
  const int nb = gridDim.x;
  for (int c = blockIdx.x; c < 256; c += nb) filter_b(p, c);
  const u16* xb = reinterpret_cast<const u16*>(p.ws + REG_X);
  const u16* wt = reinterpret_cast<const u16*>(p.ws + W_ABIN);
  u16* qk = reinterpret_cast<u16*>(p.ws + REG_B);
  u16* vht = reinterpret_cast<u16*>(p.ws + REG_B + 33554432ull);
  gemm_phase<true, true>(1024, 64, 4, [&](const Unit& u, const char*& a, const char*& b) { a = (const char*)(xb) + (size_t)u.pm * 256 * (1024) * 2; b = (const char*)(wt) + (size_t)u.pn * 256 * (1024) * 2; },
      [&](Acc8& acc, const Unit& u, int wr, int wc, int fr, int fq) {
        const float sc = (u.pn < 2) ? 0.125f : 1.0f;
        u16* base = qk + (long)(u.pm * 256 + wr * 64 + fr) * 1024 + u.pn * 256 + wc * 32 + 8 * fq;
        E8_FOR {
          f32x4 v0 = acc[ai][bj][m][0], v1 = acc[ai][bj][m][1];
          uint4 pk;
          pk.x = cvt_pk_bf16(v0[0] * sc, v0[1] * sc); pk.y = cvt_pk_bf16(v0[2] * sc, v0[3] * sc);
          pk.z = cvt_pk_bf16(v1[0] * sc, v1[1] * sc); pk.w = cvt_pk_bf16(v1[2] * sc, v1[3] * sc);
          *reinterpret_cast<uint4*>(base + (ai * 128 + m * 16) * 1024 + bj * 128) = pk;
        }
      });
  gemm_phase<false, false>(1024, 64, 8, [&](const Unit& u, const char*& a, const char*& b) { a = (const char*)(xb) + (size_t)u.pm * 256 * (1024) * 2; b = (const char*)(wt + 1024 * 1024) + (size_t)u.pn * 256 * (1024) * 2; },
      [&](Acc8& acc, const Unit& u, int wr, int wc, int fr, int fq) {
        u16* base = vht + (long)(u.pn * 256 + wc * 32 + fr) * TOK + u.pm * 256 + wr * 64 + 4 * fq;
        E8_FOR {
#pragma unroll
          for (int n = 0; n < 2; ++n) {
            f32x4 v = acc[ai][bj][m][n];
            uint2 pk; pk.x = cvt_pk_bf16(v[0], v[1]); pk.y = cvt_pk_bf16(v[2], v[3]);
            *reinterpret_cast<uint2*>(base + (long)(bj * 128 + n * 16) * TOK + ai * 128 + m * 16) = pk;
          }
        }
      });
}

DEV void na_unit(const Params& p, int u) {
  const int lane = otid() & 63, fr = lane & 15, fq = lane >> 4;
  const int g = u & 3, r = (u >> 2) & 31, h = (u >> 7) & 7, b = u >> 10;
  const int r0 = min(max(r - 4, 0), 24), cs = min(max(16 * g - 8, 0), 32);
  const u16* qk = reinterpret_cast<const u16*>(p.ws + REG_B);
  const u16* vht = reinterpret_cast<const u16*>(p.ws + REG_B + 33554432ull);
  u16* cat = reinterpret_cast<u16*>(p.ws + REG_A + 100663296ull);
  const int c = 16 * g + fr;
  const long tokq = (long)b * SEQ + r * 64 + c;
  bf16x8 qf[2];
#pragma unroll
  for (int ks = 0; ks < 2; ++ks) qf[ks] = *reinterpret_cast<const bf16x8*>(qk + tokq * 1024 + h * 64 + ks * 32 + fq * 8);
  f32x4 s[16];
#pragma unroll
  for (int kt = 0; kt < 16; ++kt) {
    const int w = kt >> 1, half = kt & 1;
    const long tokk = (long)b * SEQ + (r0 + w) * 64 + cs + 16 * half + fr;
    bf16x8 k0 = *reinterpret_cast<const bf16x8*>(qk + tokk * 1024 + 512 + h * 64 + fq * 8);
    bf16x8 k1 = *reinterpret_cast<const bf16x8*>(qk + tokk * 1024 + 512 + h * 64 + 32 + fq * 8);
    f32x4 a = {0.f, 0.f, 0.f, 0.f};
    a = __builtin_amdgcn_mfma_f32_16x16x32_bf16(k0, qf[0], a, 0, 0, 0);
    a = __builtin_amdgcn_mfma_f32_16x16x32_bf16(k1, qf[1], a, 0, 0, 0);
    s[kt] = a;
  }
  const int c0 = min(max(c - 8, 0), 48);
  const float* rpb = p.na_rpb + h * 15 * 31;
  float mx = -1e30f;
#pragma unroll
  for (int kt = 0; kt < 16; ++kt) {
    const int w = kt >> 1, half = kt & 1;
    const int dr = r0 + w - r + 7;
#pragma unroll
    for (int j = 0; j < 4; ++j) {
      int kc = cs + 16 * half + 4 * fq + j;
      bool valid = (kc >= c0) && (kc < c0 + 16);
      int dc = min(max(kc - c, -15), 15) + 15;
      float bias = rpb[dr * 31 + dc];
      float v = valid ? (s[kt][j] + bias) : -1e30f;
      s[kt][j] = v;
      mx = fmaxf(mx, v);
    }
  }
  mx = fmaxf(mx, __shfl_xor(mx, 16));
  mx = fmaxf(mx, __shfl_xor(mx, 32));
  float sum = 0.f;
#pragma unroll
  for (int kt = 0; kt < 16; ++kt)
#pragma unroll
    for (int j = 0; j < 4; ++j) { float e = __expf(s[kt][j] - mx); s[kt][j] = e; sum += e; }
  sum += __shfl_xor(sum, 16);
  sum += __shfl_xor(sum, 32);
  f32x4 o[4];
#pragma unroll
  for (int dt = 0; dt < 4; ++dt) o[dt] = f32x4{0.f, 0.f, 0.f, 0.f};
#pragma unroll
  for (int w = 0; w < 8; ++w) {
    union { bf16x8 v; unsigned u[4]; } pf;
    pf.u[0] = pack2(s[2 * w][0], s[2 * w][1]); pf.u[1] = pack2(s[2 * w][2], s[2 * w][3]);
    pf.u[2] = pack2(s[2 * w + 1][0], s[2 * w + 1][1]); pf.u[3] = pack2(s[2 * w + 1][2], s[2 * w + 1][3]);
    const long tk = (long)b * SEQ + (r0 + w) * 64 + cs + 4 * fq;
#pragma unroll
    for (int dt = 0; dt < 4; ++dt) {
      const u16* vp = vht + (long)(h * 64 + dt * 16 + fr) * TOK + tk;
      union { bf16x8 v; uint2 u[2]; } af;
      af.u[0] = *reinterpret_cast<const uint2*>(vp);
      af.u[1] = *reinterpret_cast<const uint2*>(vp + 16);
      o[dt] = __builtin_amdgcn_mfma_f32_16x16x32_bf16(af.v, pf.v, o[dt], 0, 0, 0);
    }
  }
  const float inv = 1.0f / sum;
#pragma unroll
  for (int dt = 0; dt < 4; ++dt) {
    uint2 pk; pk.x = pack2(o[dt][0] * inv, o[dt][1] * inv); pk.y = pack2(o[dt][2] * inv, o[dt][3] * inv);
    *reinterpret_cast<uint2*>(cat + tokq * 1024 + h * 64 + dt * 16 + 4 * fq) = pk;
  }
}

constexpr int UB_STRIDE = 2056;
constexpr int RC_STRIDE = 4128;
DEV float shortconv(const u16* hrow, const float* cw, float cb, int ch, int t) {
  float xm = (t > 0) ? bf2f(hrow[t - 1]) : 0.f;
  float x0 = bf2f(hrow[t]);
  float xp = (t < SEQ - 1) ? bf2f(hrow[t + 1]) : 0.f;
  return cb + xm * cw[ch] + x0 * cw[1536 + ch] + xp * cw[2 * 1536 + ch];
}
DEV void load_rc(const Params& p, int o, int c) {
  u16* rc = reinterpret_cast<u16*>(smem + 2 * NBATCH * UB_STRIDE * 2);
  const u16* Rg = reinterpret_cast<const u16*>(p.ws + S_RG) + ((long)o * 512 + c) * 4096;
  for (int i = otid(); i < 4096; i += 512) {
    u16 v = Rg[i];
#pragma unroll
    for (int m = 0; m < 4; ++m) if (i - m >= 0) rc[m * RC_STRIDE + i - m] = v;
  }
}
DEV void hyena_conv(const u16* ub, f32x4 (&acc)[16]) {
  const int lane = otid() & 63, wid = otid() >> 6, fr = lane & 15, fq = lane >> 4;
  const u16* rc = reinterpret_cast<const u16*>(smem + 2 * NBATCH * UB_STRIDE * 2);
  const int mcopy = (-fr) & 3;
  const u16* rbase = rc + mcopy * RC_STRIDE;
#pragma unroll
  for (int i = 0; i < 16; ++i) acc[i] = f32x4{0.f, 0.f, 0.f, 0.f};
  const u16* urow = ub + (fr & 7) * UB_STRIDE + fq * 8;
  const int tile0 = wid * 16;
  for (int kk = 0; kk < 64; ++kk) {
    bf16x8 bfr = *reinterpret_cast<const bf16x8*>(urow + kk * 32);
#pragma unroll
    for (int tt = 0; tt < 16; ++tt) {
      int idx0 = 32 * kk + 8 * fq - (16 * (tile0 + tt) + fr) + 2048 - mcopy;
      union { bf16x8 v; uint2 u[2]; } af;
      af.u[0] = *reinterpret_cast<const uint2*>(rbase + idx0);
      af.u[1] = *reinterpret_cast<const uint2*>(rbase + idx0 + 4);
      acc[tt] = __builtin_amdgcn_mfma_f32_16x16x32_bf16(af.v, bfr, acc[tt], 0, 0, 0);
    }
  }
}
DEV void hyena_unit(const Params& p, int c) {
  const int tid = otid(), lane = tid & 63, wid = tid >> 6, fr = lane & 15, fq = lane >> 4;
  u16* ub0 = reinterpret_cast<u16*>(smem);
  u16* ub1 = ub0 + NBATCH * UB_STRIDE;
  const u16* hbt = reinterpret_cast<const u16*>(p.ws + REG_B + 33554432ull) + 512L * TOK;
  u16* cat = reinterpret_cast<u16*>(p.ws + REG_A + 100663296ull);
  const float* cw = p.hy_conv_w;
  {
    const float cb = p.hy_conv_b[c];
    for (int i = tid; i < TOK; i += 512) {
      int b = i >> 11, t = i & 2047;
      float z = shortconv(hbt + (long)c * TOK + b * SEQ, cw, cb, c, t);
      ub0[b * UB_STRIDE + t] = f2bf(z);
    }
  }
  load_rc(p, 0, c);
  __syncthreads();
  f32x4 acc[16];
  hyena_conv(ub0, acc);
  if (fr < 8) {
    const int b = fr;
    const float skip = p.hy_skip[c];
    const float cb = p.hy_conv_b[512 + c];
    const u16* hrow = hbt + (long)(512 + c) * TOK + b * SEQ;
#pragma unroll
    for (int tt = 0; tt < 16; ++tt)
#pragma unroll
      for (int j = 0; j < 4; ++j) {
        int t = (wid * 16 + tt) * 16 + fq * 4 + j;
        float y = acc[tt][j] + bf2f(ub0[b * UB_STRIDE + t]) * skip;
        float x1 = shortconv(hrow, cw, cb, 512 + c, t);
        ub1[b * UB_STRIDE + t] = f2bf(x1 * y);
      }
  }
  __syncthreads();
  load_rc(p, 1, c);
  __syncthreads();
  hyena_conv(ub1, acc);
  if (fr < 8) {
    const int b = fr;
    const float skip = p.hy_skip[512 + c];
    const float cb = p.hy_conv_b[1024 + c];
    const u16* hrow = hbt + (long)(1024 + c) * TOK + b * SEQ;
#pragma unroll
    for (int tt = 0; tt < 16; ++tt)
#pragma unroll
      for (int j = 0; j < 4; ++j) {
        int t = (wid * 16 + tt) * 16 + fq * 4 + j;
        float y = acc[tt][j] + bf2f(ub1[b * UB_STRIDE + t]) * skip;
        float x2 = shortconv(hrow, cw, cb, 1024 + c, t);
        cat[((long)b * SEQ + t) * 1024 + 512 + c] = f2bf(x2 * y);
      }
  }
  __syncthreads();
}
DEV void phase_mix0(const Params& p) {
  const int nb = gridDim.x;
  for (int c = blockIdx.x; c < 512; c += nb) hyena_unit(p, c);
  const int wid = otid() >> 6;
  for (int u = blockIdx.x * 8 + wid; u < 8192; u += nb * 8) na_unit(p, u);
}

DEV void phase_outproj(const Params& p, const u16* A, const u16* wt, const float* xres) {
  float* pre1 = reinterpret_cast<float*>(p.ws + REG_C);
  gemm_phase<true, false>(1024, 64, 4, [&](const Unit& u, const char*& a, const char*& b) { a = (const char*)(A) + (size_t)u.pm * 256 * (1024) * 2; b = (const char*)(wt) + (size_t)u.pn * 256 * (1024) * 2; },
      [&](Acc8& acc, const Unit& u, int wr, int wc, int fr, int fq) {
        const long o0 = (long)(u.pm * 256 + wr * 64 + fr) * 1024 + u.pn * 256 + wc * 32 + 4 * fq;
        E8_FOR {
#pragma unroll
          for (int n = 0; n < 2; ++n) {
            const long o = o0 + (ai * 128 + m * 16) * 1024 + bj * 128 + n * 16;
            f32x4 xr = *reinterpret_cast<const f32x4*>(xres + o);
            *reinterpret_cast<f32x4*>(pre1 + o) = xr * DN_ALPHA + acc[ai][bj][m][n];
          }
        }
      });
}

DEV void phase_ln1_router(const Params& p, int layer) {
  const int tid = otid(), lane = tid & 63, wid = tid >> 6, nb = gridDim.x;
  float* wrT = reinterpret_cast<float*>(smem);
  const float* wr = p.moe_router + (long)layer * 1024 * 16;
  for (int i = tid; i < 16384; i += 512) { int c = i >> 4, e = i & 15; wrT[e * 1024 + c] = wr[i]; }
  __syncthreads();
  const float* pre1 = reinterpret_cast<const float*>(p.ws + REG_C);
  float* x1 = reinterpret_cast<float*>(p.ws + REG_D);
  u16* x1b = reinterpret_cast<u16*>(p.ws + REG_E);
  float* aff = reinterpret_cast<float*>(p.ws + S_AFF);
  const float* g = p.ln1_g + layer * 1024; const float* bb = p.ln1_b + layer * 1024;
  for (int tok = blockIdx.x * 8 + wid; tok < TOK; tok += nb * 8) {
    float4 v[4];
    float s = 0.f;
#pragma unroll
    for (int i = 0; i < 4; ++i) { v[i] = *reinterpret_cast<const float4*>(pre1 + (long)tok * 1024 + i * 256 + lane * 4); s += v[i].x + v[i].y + v[i].z + v[i].w; }
    float mu = wave_sum(s) * (1.0f / 1024.0f);
    float q = 0.f;
#pragma unroll
    for (int i = 0; i < 4; ++i) { v[i].x -= mu; v[i].y -= mu; v[i].z -= mu; v[i].w -= mu; q += v[i].x * v[i].x + v[i].y * v[i].y + v[i].z * v[i].z + v[i].w * v[i].w; }
    float rstd = rsqrtf(wave_sum(q) * (1.0f / 1024.0f) + LN_EPS);
    float4 y[4];
#pragma unroll
    for (int i = 0; i < 4; ++i) {
      int c = i * 256 + lane * 4;
      float4 gg = *reinterpret_cast<const float4*>(g + c), b4 = *reinterpret_cast<const float4*>(bb + c);
      y[i].x = v[i].x * rstd * gg.x + b4.x; y[i].y = v[i].y * rstd * gg.y + b4.y; y[i].z = v[i].z * rstd * gg.z + b4.z; y[i].w = v[i].w * rstd * gg.w + b4.w;
      *reinterpret_cast<float4*>(x1 + (long)tok * 1024 + c) = y[i];
      uint2 pk; pk.x = pack2(y[i].x, y[i].y); pk.y = pack2(y[i].z, y[i].w);
      *reinterpret_cast<uint2*>(x1b + (long)tok * 1024 + c) = pk;
    }
    float mine = 0.f;
#pragma unroll 1
    for (int e = 0; e < 16; ++e) {
      float a = 0.f;
#pragma unroll
      for (int i = 0; i < 4; ++i) {
        float4 w4 = *reinterpret_cast<const float4*>(wrT + e * 1024 + i * 256 + lane * 4);
        a += y[i].x * w4.x + y[i].y * w4.y + y[i].z * w4.z + y[i].w * w4.w;
      }
      a = wave_sum(a);
      if (lane == e) mine = a;
    }
    float mx = mine;
#pragma unroll
    for (int o = 8; o > 0; o >>= 1) mx = fmaxf(mx, __shfl_xor(mx, o));
    float ex = expf(mine - mx);
    float den = ex;
#pragma unroll
    for (int o = 8; o > 0; o >>= 1) den += __shfl_xor(den, o);
    if (lane < 16) {
      int b = tok >> 11, l = tok & 2047;
      aff[((long)b * 16 + lane) * SEQ + l] = ex / den;
    }
  }
}

DEV void phase_topk(const Params& p) {
  const int tid = otid(), nb = gridDim.x, lane = tid & 63, wid = tid >> 6;
  float* a = reinterpret_cast<float*>(smem);
  int* rows = reinterpret_cast<int*>(smem + 8192);
  const float* aff = reinterpret_cast<const float*>(p.ws + S_AFF);
  float* gsel = reinterpret_cast<float*>(p.ws + S_GSEL);
  int* slot = reinterpret_cast<int*>(p.ws + S_SLOT);
  const u16* x1b = reinterpret_cast<const u16*>(p.ws + REG_E);
  u16* Xe = reinterpret_cast<u16*>(p.ws + REG_C);
  for (int u = blockIdx.x; u < 256; u += nb) {
    const int be = u >> 1, half = u & 1;
    const int b = be >> 4, e = be & 15;
    __syncthreads();
    for (int i = tid; i < SEQ; i += 512) a[i] = aff[(long)be * SEQ + i];
    if (tid < 256) rows[tid] = -1;
    __syncthreads();
    const int i0 = half * 1024 + tid, i1 = i0 + 512;
    const float v0 = a[i0], v1 = a[i1];
    int r0 = 0, r1 = 0;
    for (int j = 0; j < SEQ; j += 4) {
      float4 w = *reinterpret_cast<const float4*>(a + j);
      r0 += (w.x > v0) || (w.x == v0 && j < i0);
      r0 += (w.y > v0) || (w.y == v0 && j + 1 < i0);
      r0 += (w.z > v0) || (w.z == v0 && j + 2 < i0);
      r0 += (w.w > v0) || (w.w == v0 && j + 3 < i0);
      r1 += (w.x > v1) || (w.x == v1 && j < i1);
      r1 += (w.y > v1) || (w.y == v1 && j + 1 < i1);
      r1 += (w.z > v1) || (w.z == v1 && j + 2 < i1);
      r1 += (w.w > v1) || (w.w == v1 && j + 3 < i1);
    }
    if (r0 < CAP) { rows[r0] = i0; gsel[be * CAP + r0] = v0; }
    if (r1 < CAP) { rows[r1] = i1; gsel[be * CAP + r1] = v1; }
    slot[((long)b * SEQ + i0) * 16 + e] = (r0 < CAP) ? r0 : -1;
    slot[((long)b * SEQ + i1) * 16 + e] = (r1 < CAP) ? r1 : -1;
    __syncthreads();
    for (int s = wid; s < CAP; s += 8) {
      const int t = rows[s];
      if (t >= 0) {
        const uint4* src = reinterpret_cast<const uint4*>(x1b + ((long)b * SEQ + t) * 1024);
        uint4* dst = reinterpret_cast<uint4*>(Xe + ((long)(e * 8 + b) * CAP + s) * 1024);
        uint4 c0 = src[lane], c1 = src[64 + lane];
        dst[lane] = c0; dst[64 + lane] = c1;
      }
    }
  }
}

DEV void phase_moe1(const Params& p, int layer) {
  const u16* Xe = reinterpret_cast<const u16*>(p.ws + REG_C);
  const u16* wgu = reinterpret_cast<const u16*>(p.ws + W_GU) + (long)layer * 16 * 4096 * 1024;
  u16* H = reinterpret_cast<u16*>(p.ws + REG_A);
  gemm_phase<true, true>(1024, 128, 16,
      [&](const Unit& u, const char*& a, const char*& b) { a = (const char*)Xe + (size_t)u.pm * 256 * 1024 * 2; b = (const char*)wgu + ((size_t)(u.pm >> 3) * 4096 + (size_t)u.pn * 256) * 1024 * 2; },
      [&](Acc8& acc, const Unit& u, int wr, int wc, int fr, int fq) {
        u16* base = H + (long)(u.pm * 256 + wr * 64 + fr) * DFF + u.pn * 128 + wc * 32 + 8 * fq;
#pragma unroll
        for (int ai = 0; ai < 2; ++ai)
#pragma unroll
          for (int m = 0; m < 4; ++m) {
            float hv[8];
#pragma unroll
            for (int n = 0; n < 2; ++n)
#pragma unroll
              for (int j = 0; j < 4; ++j) {
                float gte = acc[ai][0][m][n][j], up = acc[ai][1][m][n][j];
                hv[n * 4 + j] = gte / (1.0f + __expf(-gte)) * up;
              }
            uint4 pk;
            pk.x = cvt_pk_bf16(hv[0], hv[1]); pk.y = cvt_pk_bf16(hv[2], hv[3]); pk.z = cvt_pk_bf16(hv[4], hv[5]); pk.w = cvt_pk_bf16(hv[6], hv[7]);
            *reinterpret_cast<uint4*>(base + (ai * 128 + m * 16) * DFF) = pk;
          }
      });
}
DEV void phase_moe2(const Params& p, int layer) {
  const u16* H = reinterpret_cast<const u16*>(p.ws + REG_A);
  const u16* wd = reinterpret_cast<const u16*>(p.ws + W_DN) + (long)layer * 16 * 1024 * 2048;
  const float* gsel = reinterpret_cast<const float*>(p.ws + S_GSEL);
  float* Ye = reinterpret_cast<float*>(p.ws + REG_B);
  gemm_phase<true, false>(2048, 128, 4,
      [&](const Unit& u, const char*& a, const char*& b) { a = (const char*)H + (size_t)u.pm * 256 * 2048 * 2; b = (const char*)wd + ((size_t)(u.pm >> 3) * 1024 + (size_t)u.pn * 256) * 2048 * 2; },
      [&](Acc8& acc, const Unit& u, int wr, int wc, int fr, int fq) {
        const int e = u.pm >> 3, b = u.pm & 7;
        const float* gs = gsel + (b * 16 + e) * CAP + wr * 64 + fr;
        float* base = Ye + (long)(u.pm * 256 + wr * 64 + fr) * 1024 + u.pn * 256 + wc * 32 + 4 * fq;
#pragma unroll
        for (int ai = 0; ai < 2; ++ai)
#pragma unroll
          for (int m = 0; m < 4; ++m) {
            const float g = gs[ai * 128 + m * 16];
#pragma unroll
            for (int bj = 0; bj < 2; ++bj)
#pragma unroll
              for (int n = 0; n < 2; ++n)
                *reinterpret_cast<f32x4*>(base + (ai * 128 + m * 16) * 1024 + bj * 128 + n * 16) = acc[ai][bj][m][n] * g;
          }
      });
}
DEV void phase_ln2(const Params& p, int layer) {
  const int tid = otid(), lane = tid & 63, wid = tid >> 6, nb = gridDim.x;
  const float* x1 = reinterpret_cast<const float*>(p.ws + REG_D);
  const float* Ye = reinterpret_cast<const float*>(p.ws + REG_B);
  const int* slot = reinterpret_cast<const int*>(p.ws + S_SLOT);
  float* x2 = reinterpret_cast<float*>(p.ws + REG_A);
  u16* x2b = reinterpret_cast<u16*>(p.ws + REG_A + 67108864ull);
  const float* g = p.ln2_g + layer * 1024; const float* bb = p.ln2_b + layer * 1024;
  for (int tok = blockIdx.x * 8 + wid; tok < TOK; tok += nb * 8) {
    const int b = tok >> 11;
    float4 v[4];
#pragma unroll
    for (int i = 0; i < 4; ++i) {
      float4 t = *reinterpret_cast<const float4*>(x1 + (long)tok * 1024 + i * 256 + lane * 4);
      v[i].x = DN_ALPHA * t.x; v[i].y = DN_ALPHA * t.y; v[i].z = DN_ALPHA * t.z; v[i].w = DN_ALPHA * t.w;
    }
    int myslot = (lane < 16) ? slot[(long)tok * 16 + lane] : -1;
    for (int e = 0; e < 16; ++e) {
      int s = __shfl(myslot, e);
      if (s >= 0) {
        const float* yr = Ye + ((long)(e * 8 + b) * CAP + s) * 1024;
#pragma unroll
        for (int i = 0; i < 4; ++i) {
          float4 t = *reinterpret_cast<const float4*>(yr + i * 256 + lane * 4);
          v[i].x += t.x; v[i].y += t.y; v[i].z += t.z; v[i].w += t.w;
        }
      }
    }
    float s = 0.f;
#pragma unroll
    for (int i = 0; i < 4; ++i) s += v[i].x + v[i].y + v[i].z + v[i].w;
    float mu = wave_sum(s) * (1.0f / 1024.0f);
    float q = 0.f;
#pragma unroll
    for (int i = 0; i < 4; ++i) { v[i].x -= mu; v[i].y -= mu; v[i].z -= mu; v[i].w -= mu; q += v[i].x * v[i].x + v[i].y * v[i].y + v[i].z * v[i].z + v[i].w * v[i].w; }
    float rstd = rsqrtf(wave_sum(q) * (1.0f / 1024.0f) + LN_EPS);
#pragma unroll
    for (int i = 0; i < 4; ++i) {
      int c = i * 256 + lane * 4;
      float4 gg = *reinterpret_cast<const float4*>(g + c), b4 = *reinterpret_cast<const float4*>(bb + c);
      float4 y;
      y.x = v[i].x * rstd * gg.x + b4.x; y.y = v[i].y * rstd * gg.y + b4.y; y.z = v[i].z * rstd * gg.z + b4.z; y.w = v[i].w * rstd * gg.w + b4.w;
      *reinterpret_cast<float4*>(x2 + (long)tok * 1024 + c) = y;
      uint2 pk; pk.x = pack2(y.x, y.y); pk.y = pack2(y.z, y.w);
      *reinterpret_cast<uint2*>(x2b + (long)tok * 1024 + c) = pk;
    }
  }
}
DEV void phase_ple(const Params& p, int layer, float* outf, u16* outb) {
  const float* x2 = reinterpret_cast<const float*>(p.ws + REG_A);
  const u16* x2b = reinterpret_cast<const u16*>(p.ws + REG_A + 67108864ull);
  const u16* pb = reinterpret_cast<const u16*>(p.ws + REG_P) + (long)layer * TOK * 256;
  const u16* wg = reinterpret_cast<const u16*>(p.ws + W_PLEG) + (long)layer * 1024 * 1024;
  const u16* wp = reinterpret_cast<const u16*>(p.ws + W_PLEP) + (long)layer * 1024 * 256;
  float* pp = reinterpret_cast<float*>(p.ws + REG_C);
  gemm_phase<true, false>(256, 64, 4, [&](const Unit& u, const char*& a, const char*& b) { a = (const char*)(pb) + (size_t)u.pm * 256 * (256) * 2; b = (const char*)(wp) + (size_t)u.pn * 256 * (256) * 2; },
      [&](Acc8& acc, const Unit& u, int wr, int wc, int fr, int fq) {
        const long o0 = (long)(u.pm * 256 + wr * 64 + fr) * 1024 + u.pn * 256 + wc * 32 + 4 * fq;
        E8_FOR {
#pragma unroll
          for (int n = 0; n < 2; ++n)
            *reinterpret_cast<f32x4*>(pp + o0 + (ai * 128 + m * 16) * 1024 + bj * 128 + n * 16) = acc[ai][bj][m][n];
        }
      });
  gemm_phase<true, false>(1024, 64, 4, [&](const Unit& u, const char*& a, const char*& b) { a = (const char*)(x2b) + (size_t)u.pm * 256 * (1024) * 2; b = (const char*)(wg) + (size_t)u.pn * 256 * (1024) * 2; },
      [&](Acc8& acc, const Unit& u, int wr, int wc, int fr, int fq) {
        const long o0 = (long)(u.pm * 256 + wr * 64 + fr) * 1024 + u.pn * 256 + wc * 32 + 4 * fq;
        E8_FOR {
#pragma unroll
          for (int n = 0; n < 2; ++n) {
            const long o = o0 + (ai * 128 + m * 16) * 1024 + bj * 128 + n * 16;
            f32x4 a = acc[ai][bj][m][n];
            f32x4 xv = *reinterpret_cast<const f32x4*>(x2 + o), pv = *reinterpret_cast<const f32x4*>(pp + o);
            f32x4 r;
#pragma unroll
            for (int j = 0; j < 4; ++j) r[j] = xv[j] + pv[j] / (1.0f + __expf(-a[j]));
            *reinterpret_cast<f32x4*>(outf + o) = r;
            if (outb) { uint2 pk; pk.x = cvt_pk_bf16(r[0], r[1]); pk.y = cvt_pk_bf16(r[2], r[3]); *reinterpret_cast<uint2*>(outb + o) = pk; }
          }
        }
      });
}
DEV void phase_mla_in(const Params& p) {
  const u16* xb = reinterpret_cast<const u16*>(p.ws + REG_X);
  const u16* wt = reinterpret_cast<const u16*>(p.ws + W_MLAIN);
  float* hm = reinterpret_cast<float*>(p.ws + REG_B);
  gemm_phase<true, false>(1024, 64, 3, [&](const Unit& u, const char*& a, const char*& b) { a = (const char*)(xb) + (size_t)u.pm * 256 * (1024) * 2; b = (const char*)(wt) + (size_t)u.pn * 256 * (1024) * 2; },
      [&](Acc8& acc, const Unit& u, int wr, int wc, int fr, int fq) {
        const long o0 = (long)(u.pm * 256 + wr * 64 + fr) * 768 + u.pn * 256 + wc * 32 + 4 * fq;
        E8_FOR {
#pragma unroll
          for (int n = 0; n < 2; ++n)
            *reinterpret_cast<f32x4*>(hm + o0 + (ai * 128 + m * 16) * 768 + bj * 128 + n * 16) = acc[ai][bj][m][n];
        }
      });
}
constexpr size_t MLA_Q = REG_A, MLA_K = REG_A + 50331648ull, MLA_VT = REG_A + 100663296ull;
constexpr size_t MLA_CQN = REG_B + 50331648ull, MLA_CKVN = MLA_CQN + 12582912ull, MLA_O = MLA_CKVN + 8388608ull;
DEV float rope_inv(int i) { return 1.0f / powf(10000.0f, (float)i / 16.0f); }
DEV void phase_mla_norm(const Params& p) {
  const int tid = otid(), lane = tid & 63, wid = tid >> 6, nb = gridDim.x;
  const float* hm = reinterpret_cast<const float*>(p.ws + REG_B);
  u16* cqn = reinterpret_cast<u16*>(p.ws + MLA_CQN);
  u16* ckvn = reinterpret_cast<u16*>(p.ws + MLA_CKVN);
  u16* Kb = reinterpret_cast<u16*>(p.ws + MLA_K);
  for (int tok = blockIdx.x * 8 + wid; tok < TOK; tok += nb * 8) {
    const float* row = hm + (long)tok * 768;
    float q[6], kv[4];
    float sq = 0.f, skv = 0.f;
#pragma unroll
    for (int i = 0; i < 6; ++i) { q[i] = row[i * 64 + lane]; sq += q[i] * q[i]; }
#pragma unroll
    for (int i = 0; i < 4; ++i) { kv[i] = row[384 + i * 64 + lane]; skv += kv[i] * kv[i]; }
    float rq = rsqrtf(wave_sum(sq) * (1.0f / 384.0f) + LN_EPS);
    float rkv = rsqrtf(wave_sum(skv) * (1.0f / 256.0f) + LN_EPS);
#pragma unroll
    for (int i = 0; i < 6; ++i) cqn[(long)tok * 384 + i * 64 + lane] = f2bf(q[i] * rq * p.mla_q_norm[i * 64 + lane]);
#pragma unroll
    for (int i = 0; i < 4; ++i) ckvn[(long)tok * 256 + i * 64 + lane] = f2bf(kv[i] * rkv * p.mla_kv_norm[i * 64 + lane]);
    const int b = tok >> 11, l = tok & 2047;
    float kr = (lane < 32) ? row[640 + lane] : 0.f;
    float x1 = __shfl(kr, lane & 15), x2 = __shfl(kr, (lane & 15) + 16);
    float sn, cs; sincosf((float)l * rope_inv(lane & 15), &sn, &cs);
    float r = (lane & 16) ? (x1 * sn + x2 * cs) : (x1 * cs - x2 * sn);
    u16 rb = f2bf(r);
    for (int hh = 0; hh < 16; hh += 2) {
      int h = hh + (lane >> 5);
      u16 val = (u16)__shfl((int)rb, lane & 31);
      Kb[(((long)b * 16 + h) * SEQ + l) * 96 + 64 + (lane & 31)] = val;
    }
  }
}
DEV void phase_mla_up(const Params& p) {
  const u16* cqn = reinterpret_cast<const u16*>(p.ws + MLA_CQN);
  const u16* ckvn = reinterpret_cast<const u16*>(p.ws + MLA_CKVN);
  const u16* wq = reinterpret_cast<const u16*>(p.ws + W_QUP);
  const u16* wkv = reinterpret_cast<const u16*>(p.ws + W_KVUP);
  u16* Qb = reinterpret_cast<u16*>(p.ws + MLA_Q);
  u16* Kb = reinterpret_cast<u16*>(p.ws + MLA_K);
  u16* VT = reinterpret_cast<u16*>(p.ws + MLA_VT);
  const float qscale = 0.10206207261596577f * 1.4426950408889634f;
  gemm_phase<true, false>(384, 64, 6, [&](const Unit& u, const char*& a, const char*& b) { a = (const char*)(cqn) + (size_t)u.pm * 256 * (384) * 2; b = (const char*)(wq) + (size_t)u.pn * 256 * (384) * 2; },
      [&](Acc8& acc, const Unit& u, int wr, int wc, int fr, int fq) {
#pragma unroll
        for (int bj = 0; bj < 2; ++bj) {
          const int c32 = (u.pn * 256 + bj * 128 + wc * 32) >> 5;
          const int h = c32 / 3, part = c32 % 3;
#pragma unroll
          for (int ai = 0; ai < 2; ++ai)
#pragma unroll
            for (int m = 0; m < 4; ++m) {
              const int tok = u.pm * 256 + ai * 128 + wr * 64 + m * 16 + fr;
              const int b = tok >> 11, l = tok & 2047;
              u16* qrow = Qb + (((long)b * 16 + h) * SEQ + l) * 96 + part * 32 + 4 * fq;
              f32x4 a0 = acc[ai][bj][m][0], a1 = acc[ai][bj][m][1];
              if (part == 2) {
#pragma unroll
                for (int j = 0; j < 4; ++j) {
                  float sn, cs; sincosf((float)l * rope_inv(4 * fq + j), &sn, &cs);
                  float r0 = a0[j] * cs - a1[j] * sn, r1 = a0[j] * sn + a1[j] * cs;
                  a0[j] = r0; a1[j] = r1;
                }
              }
              uint2 p0, p1;
              p0.x = cvt_pk_bf16(a0[0] * qscale, a0[1] * qscale); p0.y = cvt_pk_bf16(a0[2] * qscale, a0[3] * qscale);
              p1.x = cvt_pk_bf16(a1[0] * qscale, a1[1] * qscale); p1.y = cvt_pk_bf16(a1[2] * qscale, a1[3] * qscale);
              *reinterpret_cast<uint2*>(qrow) = p0;
              *reinterpret_cast<uint2*>(qrow + 16) = p1;
            }
        }
      });
  gemm_phase<true, true>(256, 64, 4, [&](const Unit& u, const char*& a, const char*& b) { a = (const char*)(ckvn) + (size_t)u.pm * 256 * (256) * 2; b = (const char*)(wkv) + (size_t)u.pn * 256 * (256) * 2; },
      [&](Acc8& acc, const Unit& u, int wr, int wc, int fr, int fq) {
        E8_FOR {
          const int tok = u.pm * 256 + ai * 128 + wr * 64 + m * 16 + fr;
          const int b = tok >> 11, l = tok & 2047;
          const int col = u.pn * 256 + bj * 128 + wc * 32 + 8 * fq;
          const int h = col >> 6, d = col & 63;
          f32x4 v0 = acc[ai][bj][m][0], v1 = acc[ai][bj][m][1];
          uint4 pk;
          pk.x = cvt_pk_bf16(v0[0], v0[1]); pk.y = cvt_pk_bf16(v0[2], v0[3]); pk.z = cvt_pk_bf16(v1[0], v1[1]); pk.w = cvt_pk_bf16(v1[2], v1[3]);
          *reinterpret_cast<uint4*>(Kb + (((long)b * 16 + h) * SEQ + l) * 96 + d) = pk;
        }
      });
  gemm_phase<false, false>(256, 64, 4, [&](const Unit& u, const char*& a, const char*& b) { a = (const char*)(ckvn) + (size_t)u.pm * 256 * (256) * 2; b = (const char*)(wkv + 1024 * 256) + (size_t)u.pn * 256 * (256) * 2; },
      [&](Acc8& acc, const Unit& u, int wr, int wc, int fr, int fq) {
        E8_FOR {
          const int tok = u.pm * 256 + ai * 128 + wr * 64 + m * 16 + 4 * fq;
          const int b = tok >> 11, l = tok & 2047;
#pragma unroll
          for (int n = 0; n < 2; ++n) {
            const int col = u.pn * 256 + bj * 128 + wc * 32 + n * 16 + fr;
            const int h = col >> 6, d = col & 63;
            f32x4 v = acc[ai][bj][m][n];
            uint2 pk; pk.x = cvt_pk_bf16(v[0], v[1]); pk.y = cvt_pk_bf16(v[2], v[3]);
            *reinterpret_cast<uint2*>(VT + (((long)b * 16 + h) * 64 + d) * SEQ + l) = pk;
          }
        }
      });
}
constexpr int KST = 104, VST = 68;
DEV void mla_attn_unit(const Params& p, int u) {
  const int tid = otid(), lane = tid & 63, wid = tid >> 6, fr = lane & 15, fq = lane >> 4;
  const int qb = u & 7, bh = u >> 3;
  const u16* Qb = reinterpret_cast<const u16*>(p.ws + MLA_Q) + (long)bh * SEQ * 96;
  const u16* Kb = reinterpret_cast<const u16*>(p.ws + MLA_K) + (long)bh * SEQ * 96;
  const u16* VT = reinterpret_cast<const u16*>(p.ws + MLA_VT) + (long)bh * 64 * SEQ;
  u16* O = reinterpret_cast<u16*>(p.ws + MLA_O);
  u16* kl = reinterpret_cast<u16*>(smem);
  u16* vl = kl + 2 * 64 * KST;
  bf16x8 qf[2][3];
#pragma unroll
  for (int qt = 0; qt < 2; ++qt)
#pragma unroll
    for (int ks = 0; ks < 3; ++ks)
      qf[qt][ks] = *reinterpret_cast<const bf16x8*>(Qb + (long)(qb * 256 + wid * 32 + qt * 16 + fr) * 96 + ks * 32 + fq * 8);
  f32x4 o[4][2];
#pragma unroll
  for (int dt = 0; dt < 4; ++dt)
#pragma unroll
    for (int qt = 0; qt < 2; ++qt) o[dt][qt] = f32x4{0.f, 0.f, 0.f, 0.f};
  float mrun[2] = {-1e30f, -1e30f}, lrun[2] = {0.f, 0.f};
  const int kc0 = tid, kc1 = 512 + tid;
  const int vd = tid >> 3, vpart = tid & 7;
  uint4 kr0, kr1 = make_uint4(0, 0, 0, 0), vr;
  auto gload = [&](int t) {
    const u16* kt = Kb + (long)t * 64 * 96;
    kr0 = *reinterpret_cast<const uint4*>(kt + kc0 * 8);
    if (tid < 256) kr1 = *reinterpret_cast<const uint4*>(kt + kc1 * 8);
    vr = *reinterpret_cast<const uint4*>(VT + (long)vd * SEQ + t * 64 + vpart * 8);
  };
  auto lstore = [&](int buf) {
    u16* kd = kl + buf * 64 * KST; u16* vdst = vl + buf * 64 * VST;
    *reinterpret_cast<uint4*>(kd + (kc0 / 12) * KST + (kc0 % 12) * 8) = kr0;
    if (tid < 256) *reinterpret_cast<uint4*>(kd + (kc1 / 12) * KST + (kc1 % 12) * 8) = kr1;
    *reinterpret_cast<uint2*>(vdst + vd * VST + vpart * 8) = make_uint2(vr.x, vr.y);
    *reinterpret_cast<uint2*>(vdst + vd * VST + vpart * 8 + 4) = make_uint2(vr.z, vr.w);
  };
  __syncthreads();
  gload(0); lstore(0);
  __syncthreads();
  for (int t = 0; t < 32; ++t) {
    const int cur = t & 1;
    if (t + 1 < 32) gload(t + 1);
    const u16* kd = kl + cur * 64 * KST; const u16* vdl = vl + cur * 64 * VST;
    f32x4 s[4][2];
#pragma unroll
    for (int kt = 0; kt < 4; ++kt) {
      bf16x8 kf[3];
#pragma unroll
      for (int ks = 0; ks < 3; ++ks) kf[ks] = *reinterpret_cast<const bf16x8*>(kd + (kt * 16 + fr) * KST + ks * 32 + fq * 8);
#pragma unroll
      for (int qt = 0; qt < 2; ++qt) {
        f32x4 a = {0.f, 0.f, 0.f, 0.f};
#pragma unroll
        for (int ks = 0; ks < 3; ++ks) a = __builtin_amdgcn_mfma_f32_16x16x32_bf16(kf[ks], qf[qt][ks], a, 0, 0, 0);
        s[kt][qt] = a;
      }
    }
    bf16x8 pf[2][2];
#pragma unroll
    for (int qt = 0; qt < 2; ++qt) {
      float tm = -1e30f;
#pragma unroll
      for (int kt = 0; kt < 4; ++kt)
#pragma unroll
        for (int j = 0; j < 4; ++j) tm = fmaxf(tm, s[kt][qt][j]);
      tm = fmaxf(tm, __shfl_xor(tm, 16));
      tm = fmaxf(tm, __shfl_xor(tm, 32));
      const float mn = fmaxf(mrun[qt], tm);
      const float alpha = exp2f(mrun[qt] - mn);
      mrun[qt] = mn;
      float ls = 0.f;
#pragma unroll
      for (int kt = 0; kt < 4; ++kt)
#pragma unroll
        for (int j = 0; j < 4; ++j) { float e = exp2f(s[kt][qt][j] - mn); s[kt][qt][j] = e; ls += e; }
      lrun[qt] = lrun[qt] * alpha + ls;
#pragma unroll
      for (int dt = 0; dt < 4; ++dt) { o[dt][qt][0] *= alpha; o[dt][qt][1] *= alpha; o[dt][qt][2] *= alpha; o[dt][qt][3] *= alpha; }
#pragma unroll
      for (int k2 = 0; k2 < 2; ++k2) {
        union { bf16x8 v; unsigned u[4]; } t_;
        t_.u[0] = pack2(s[2 * k2][qt][0], s[2 * k2][qt][1]); t_.u[1] = pack2(s[2 * k2][qt][2], s[2 * k2][qt][3]);
        t_.u[2] = pack2(s[2 * k2 + 1][qt][0], s[2 * k2 + 1][qt][1]); t_.u[3] = pack2(s[2 * k2 + 1][qt][2], s[2 * k2 + 1][qt][3]);
        pf[k2][qt] = t_.v;
      }
    }
#pragma unroll
    for (int k2 = 0; k2 < 2; ++k2)
#pragma unroll
      for (int dt = 0; dt < 4; ++dt) {
        union { bf16x8 v; uint2 u[2]; } af;
        const u16* vp = vdl + (dt * 16 + fr) * VST + k2 * 32 + 4 * fq;
        af.u[0] = *reinterpret_cast<const uint2*>(vp);
        af.u[1] = *reinterpret_cast<const uint2*>(vp + 16);
#pragma unroll
        for (int qt = 0; qt < 2; ++qt) o[dt][qt] = __builtin_amdgcn_mfma_f32_16x16x32_bf16(af.v, pf[k2][qt], o[dt][qt], 0, 0, 0);
      }
    if (t + 1 < 32) lstore(cur ^ 1);
    __syncthreads();
  }
  const int b = bh >> 4, h = bh & 15;
#pragma unroll
  for (int qt = 0; qt < 2; ++qt) {
    float l = lrun[qt];
    l += __shfl_xor(l, 16);
    l += __shfl_xor(l, 32);
    const float inv = 1.0f / l;
    const long tok = (long)b * SEQ + qb * 256 + wid * 32 + qt * 16 + fr;
#pragma unroll
    for (int dt = 0; dt < 4; ++dt) {
      uint2 pk; pk.x = pack2(o[dt][qt][0] * inv, o[dt][qt][1] * inv); pk.y = pack2(o[dt][qt][2] * inv, o[dt][qt][3] * inv);
      *reinterpret_cast<uint2*>(O + tok * 1024 + h * 64 + dt * 16 + 4 * fq) = pk;
    }
  }
}
DEV void phase_mla_attn(const Params& p) {
  const int nb = gridDim.x;
  for (int u = blockIdx.x; u < NBATCH * 16 * 8; u += nb) mla_attn_unit(p, u);
}

#ifndef ONLY
#define ONLY -1
#endif
#define PH(n, ...) if (ONLY < 0 || ONLY == n) { __VA_ARGS__; }
constexpr int LDS_BAR_OFF = 131072;
__global__ void __launch_bounds__(512) mega(Params p) {
  cg::grid_group grid = cg::this_grid();
  unsigned* barw = reinterpret_cast<unsigned*>(p.ws + S_BAR);
  if (blockIdx.x == 0) for (int i = threadIdx.x; i < XCD_BAR_WORDS; i += 512) barw[i] = 0u;
  if (threadIdx.x == 0) *reinterpret_cast<uint4*>(smem + LDS_BAR_OFF) = make_uint4(0u, 0u, 0u, 0u);
  PH(0, phase_prep(p));
  grid.sync();
  XcdBarrier xb = xcd_barrier_post(barw, (volatile LAS unsigned*)(smem + LDS_BAR_OFF));
#define GSYNC() xcd_barrier(xb)
  PH(1, phase_abin(p)); GSYNC();
  PH(2, phase_mix0(p)); GSYNC();
  PH(3, phase_outproj(p, reinterpret_cast<const u16*>(p.ws + REG_A + 100663296ull), reinterpret_cast<const u16*>(p.ws + W_ABOUT), p.x)); GSYNC();
  for (int layer = 0; layer < 2; ++layer) {
    if (layer == 1) {
      PH(10, phase_mla_in(p)); GSYNC();
      PH(11, phase_mla_norm(p)); GSYNC();
      PH(12, phase_mla_up(p)); GSYNC();
      PH(13, phase_mla_attn(p)); GSYNC();
      PH(3, phase_outproj(p, reinterpret_cast<const u16*>(p.ws + MLA_O), reinterpret_cast<const u16*>(p.ws + W_MLAOUT), reinterpret_cast<const float*>(p.ws + REG_G))); GSYNC();
    }
    PH(4, phase_ln1_router(p, layer)); GSYNC();
    PH(5, phase_topk(p)); GSYNC();
    PH(6, phase_moe1(p, layer)); GSYNC();
    PH(7, phase_moe2(p, layer)); GSYNC();
    PH(8, phase_ln2(p, layer)); GSYNC();
    PH(9, phase_ple(p, layer, layer ? p.out : reinterpret_cast<float*>(p.ws + REG_G), layer ? nullptr : reinterpret_cast<u16*>(p.ws + REG_X)));
    if (layer == 0) GSYNC();
  }
}

static void add_job(Params& P, int& nj, int& tile, const float* src, u16* dst, int K, int N, int rsh, int rs, int off, int count, long sstride, long dstride) {
  ConvJob& J = P.jobs[nj++];
  J.src = src; J.dst = dst; J.sstride = sstride; J.dstride = dstride; J.K = K; J.N = N; J.rs = rs; J.off = off; J.rsh = rsh;
  J.ntn = (N + 255) / 256; J.tpm = (K / 64) * J.ntn; J.tile0 = tile; J.ntiles = J.tpm * count;
  tile += J.ntiles;
}

extern "C" void kernel_launch(void* const* d_in, const int* in_sizes, int n_in,
                              void* d_out, int out_size, void* d_ws, size_t ws_size,
                              hipStream_t stream) {
  constexpr size_t kDynLds = 131072 + 16;
  static int grid_blocks = 0;
  if (!grid_blocks) {
    int dev = 0, cus = 0, per_cu = 0;
    (void)hipGetDevice(&dev);
    (void)hipDeviceGetAttribute(&cus, hipDeviceAttributeMultiprocessorCount, dev);
    (void)hipFuncSetAttribute((const void*)mega, hipFuncAttributeMaxDynamicSharedMemorySize, (int)kDynLds);
    (void)hipOccupancyMaxActiveBlocksPerMultiprocessor(&per_cu, mega, 512, kDynLds);
    if (per_cu > 1) per_cu = 1;
    if (per_cu < 1) { fprintf(stderr, "occupancy query returned 0\n"); per_cu = 1; }
    grid_blocks = cus * per_cu;
    if (ws_size < WS_TOTAL) fprintf(stderr, "workspace too small: %zu < %zu\n", ws_size, (size_t)WS_TOTAL);
  }
  Params P;
  memset(&P, 0, sizeof(P));
  auto F = [&](int i) { return (const float*)d_in[i]; };
  char* ws = (char*)d_ws;
  P.x = F(0); P.p = F(1);
  P.na_rpb = F(3); P.hy_conv_w = F(4); P.hy_conv_b = F(5);
  P.hy_f_w1 = F(6); P.hy_f_b1 = F(7); P.hy_f_freq = F(8); P.hy_f_w2 = F(9); P.hy_f_b2 = F(10); P.hy_f_w3 = F(11); P.hy_skip = F(12);
  P.mla_q_norm = F(15); P.mla_kv_norm = F(17);
  P.ln1_g = F(20); P.ln1_b = F(21); P.ln2_g = F(22); P.ln2_b = F(23);
  P.moe_router = F(24);
  P.out = (float*)d_out; P.ws = ws;
  int nj = 0, tile = 0;
  add_job(P, nj, tile, F(2), (u16*)(ws + W_ABIN), 1024, 3072, 7, 128, 0, 1, 0, 0);
  add_job(P, nj, tile, F(13), (u16*)(ws + W_ABOUT), 1024, 1024, 7, 128, 0, 1, 0, 0);
  add_job(P, nj, tile, F(14), (u16*)(ws + W_MLAIN), 1024, 672, 7, 128, 0, 1, 0, 0);
  add_job(P, nj, tile, F(16), (u16*)(ws + W_QUP), 384, 1536, 7, 128, 0, 1, 0, 0);
  add_job(P, nj, tile, F(18), (u16*)(ws + W_KVUP), 256, 2048, 6, 64, 0, 1, 0, 0);
  P.jobs[nj - 1].sh2 = 1; P.jobs[nj - 1].off2 = 1024;
  add_job(P, nj, tile, F(19), (u16*)(ws + W_MLAOUT), 1024, 1024, 7, 128, 0, 1, 0, 0);
  add_job(P, nj, tile, F(28), (u16*)(ws + W_PLEG), 1024, 1024, 7, 128, 0, 2, 1024L * 1024, 1024L * 1024);
  add_job(P, nj, tile, F(29), (u16*)(ws + W_PLEP), 256, 1024, 7, 128, 0, 2, 256L * 1024, 1024L * 256);
  add_job(P, nj, tile, F(25), (u16*)(ws + W_GU), 1024, 2048, 7, 256, 0, 32, 1024L * 2048, 4096L * 1024);
  add_job(P, nj, tile, F(26), (u16*)(ws + W_GU), 1024, 2048, 7, 256, 128, 32, 1024L * 2048, 4096L * 1024);
  add_job(P, nj, tile, F(27), (u16*)(ws + W_DN), 2048, 1024, 7, 128, 0, 32, 2048L * 1024, 1024L * 2048);
  P.conv_total = tile;
  void* args[] = {&P};
  hipError_t e = hipLaunchCooperativeKernel((void*)mega, dim3(grid_blocks), dim3(512), args, kDynLds, stream);
  if (e != hipSuccess) fprintf(stderr, "cooperative launch failed: %s (grid %d)\n", hipGetErrorString(e), grid_blocks);
}
```

```cpp
#include <hip/hip_runtime.h>
#include <hip/hip_bf16.h>
#include <hip/hip_cooperative_groups.h>
#include <cstdio>
#include <cstring>
namespace cg = cooperative_groups;

typedef unsigned short u16;
using bf16x8 = __attribute__((ext_vector_type(8))) short;
using bf16x4 = __attribute__((ext_vector_type(4))) short;
using f32x4 = __attribute__((ext_vector_type(4))) float;
#define DEV __device__ __forceinline__

constexpr int TOK = 16384, DM = 1024, SEQ = 2048, NBATCH = 8;
constexpr int NEXP = 16, CAP = 256, DFF = 2048;
constexpr float DN_ALPHA = 1.4142135623730951f;
constexpr float LN_EPS = 1e-5f;

constexpr size_t W_ABIN = 0;
constexpr size_t W_ABOUT = W_ABIN + 3072ull * 1024 * 2;
constexpr size_t W_MLAIN = W_ABOUT + 1024ull * 1024 * 2;
constexpr size_t W_QUP = W_MLAIN + 768ull * 1024 * 2;
constexpr size_t W_KVUP = W_QUP + 1536ull * 384 * 2;
constexpr size_t W_MLAOUT = W_KVUP + 2048ull * 256 * 2;
constexpr size_t W_PLEG = W_MLAOUT + 1024ull * 1024 * 2;
constexpr size_t W_PLEP = W_PLEG + 2 * 1024ull * 1024 * 2;
constexpr size_t W_GU = W_PLEP + 2 * 1024ull * 256 * 2;
constexpr size_t W_DN = W_GU + 2 * 16ull * 4096 * 1024 * 2;
constexpr size_t REG_A = W_DN + 2 * 16ull * 1024 * 2048 * 2;
constexpr size_t REG_B = REG_A + 134217728ull;
constexpr size_t REG_C = REG_B + 134217728ull;
constexpr size_t REG_D = REG_C + 67108864ull;
constexpr size_t REG_E = REG_D + 67108864ull;
constexpr size_t REG_G = REG_E + 33554432ull;
constexpr size_t REG_X = REG_G + 67108864ull;
constexpr size_t REG_P = REG_X + 33554432ull;
constexpr size_t S_AFF = REG_P + 16777216ull;
constexpr size_t S_IDX = S_AFF + 1048576ull;
constexpr size_t S_GSEL = S_IDX + 131072ull;
constexpr size_t S_SLOT = S_GSEL + 131072ull;
constexpr size_t S_H2 = S_SLOT + 1048576ull;
constexpr size_t S_RG = S_H2 + 524288ull;
constexpr size_t S_BAR = S_RG + 8388608ull;
constexpr size_t WS_TOTAL = S_BAR + 16384ull;

struct ConvJob {
  const float* src; u16* dst;
  long sstride, dstride;
  int K, N;
  int rs, off;
  int rsh, sh2, off2, padj;
  int ntn;
  int tpm;
  int tile0, ntiles;
};
constexpr int NJOBS = 16;

struct Params {
  const float* x; const float* p;
  const float* na_rpb; const float* hy_conv_w; const float* hy_conv_b;
  const float* hy_f_w1; const float* hy_f_b1; const float* hy_f_freq; const float* hy_f_w2; const float* hy_f_b2;
  const float* hy_f_w3; const float* hy_skip;
  const float* mla_q_norm; const float* mla_kv_norm;
  const float* ln1_g; const float* ln1_b; const float* ln2_g; const float* ln2_b;
  const float* moe_router;
  float* out; char* ws;
  int conv_total; int pad0;
  ConvJob jobs[NJOBS];
};

extern __shared__ __attribute__((aligned(16))) char smem[];

DEV u16 f2bf(float f) {
  unsigned u = __float_as_uint(f);
  u += 0x7fffu + ((u >> 16) & 1u);
  return (u16)(u >> 16);
}
DEV float bf2f(u16 h) { return __uint_as_float(((unsigned)h) << 16); }
DEV unsigned pack2(float a, float b) { return (unsigned)f2bf(a) | ((unsigned)f2bf(b) << 16); }
DEV float wave_sum(float v) {
#pragma unroll
  for (int o = 32; o > 0; o >>= 1) v += __shfl_xor(v, o);
  return v;
}
DEV int otid() { int t = threadIdx.x; asm volatile("" : "+v"(t)); return t; }
DEV int vstart() {
  int nb = gridDim.x, b = blockIdx.x;
  return (nb % 8 == 0) ? (b % 8) * (nb / 8) + b / 8 : b;
}


#define XB_TMO      128
#define XB_XCNT(j)  (256  + 64 * (j))
#define XB_XSUB(j)  (1280 + 64 * (j))
#define XB_XGEN(j)  (2304 + 64 * (j))
#define XB_TOP      3328
#define XB_TOPGEN   3392
#define XCD_BAR_WORDS 3456
#define XB_SPIN_CAP (1u << 18)
#define LAS __attribute__((address_space(3)))
DEV unsigned xb_ld(unsigned* p) { return __hip_atomic_load(p, __ATOMIC_RELAXED, __HIP_MEMORY_SCOPE_AGENT); }
DEV unsigned xb_add(unsigned* p, unsigned v) { return __hip_atomic_fetch_add(p, v, __ATOMIC_RELAXED, __HIP_MEMORY_SCOPE_AGENT); }
DEV unsigned xb_xcc_id() { return (unsigned)__builtin_amdgcn_s_getreg((3 << 11) | 20) & 0xFu; }
#define XB_SPIN(cond, bar) do { unsigned _sp = 0; while (cond) { __builtin_amdgcn_s_sleep(1); \
    if ((++_sp & 255u) == 0u) { if (xb_ld(&(bar)[XB_TMO])) break; if (_sp > XB_SPIN_CAP) { atomicAdd(&(bar)[XB_TMO], 1u); break; } } } } while (0)
struct XcdBarrier { unsigned* bar; unsigned x; volatile LAS unsigned* st; };
DEV XcdBarrier xcd_barrier_post(unsigned* bar, volatile LAS unsigned* st) {
  XcdBarrier b; b.bar = bar; b.x = xb_xcc_id(); b.st = st;
  if (threadIdx.x == 0) (void)xb_add(&bar[XB_XCNT(b.x)], 1u);
  return b;
}
DEV void xcd_barrier_complete(unsigned* bar, unsigned x, unsigned& nloc, unsigned& nx) {
  const unsigned G = gridDim.x * gridDim.y * gridDim.z;
  unsigned sum, cnt, mine, sp = 0u;
  for (;;) {
    sum = 0u; cnt = 0u; mine = 0u;
#pragma unroll
    for (unsigned j = 0; j < 16; ++j) { const unsigned c = xb_ld(&bar[XB_XCNT(j)]); sum += c; cnt += (c > 0u) ? 1u : 0u; mine = (j == x) ? c : mine; }
    if (sum == G) break;
    __builtin_amdgcn_s_sleep(1);
    if ((++sp & 255u) == 0u) { if (xb_ld(&bar[XB_TMO])) break; if (sp > XB_SPIN_CAP) { atomicAdd(&bar[XB_TMO], 1u); break; } }
  }
  nloc = mine > 0u ? mine : 1u; nx = cnt > 0u ? cnt : 1u;
}
DEV void xcd_barrier(const XcdBarrier& b) {
  asm volatile("s_waitcnt vmcnt(0)" ::: "memory");
  __syncthreads();
  if (threadIdx.x == 0) {
    unsigned* bar = b.bar;
    __builtin_amdgcn_s_waitcnt(0);
    unsigned nloc = b.st[0], nx = b.st[1];
    if (nloc == 0u) { xcd_barrier_complete(bar, b.x, nloc, nx); b.st[0] = nloc; b.st[1] = nx; }
    const unsigned old = xb_add(&bar[XB_XSUB(b.x)], 1u);
    const unsigned gen = old / nloc;
    if (old + 1u == (gen + 1u) * nloc) {
      __builtin_amdgcn_fence(__ATOMIC_RELEASE, "agent");
      asm volatile("s_waitcnt vmcnt(0)" ::: "memory");
      const unsigned og = xb_add(&bar[XB_TOP], 1u);
      const unsigned tg = og / nx;
      if (og + 1u == (tg + 1u) * nx) xb_add(&bar[XB_TOPGEN], 1u);
      else XB_SPIN(xb_ld(&bar[XB_TOPGEN]) == tg, bar);
      __builtin_amdgcn_fence(__ATOMIC_ACQUIRE, "agent");
      xb_add(&bar[XB_XGEN(b.x)], 1u);
      asm volatile("s_waitcnt vmcnt(0)" ::: "memory");
    } else {
      XB_SPIN(xb_ld(&bar[XB_XGEN(b.x)]) == gen, bar);
      __builtin_amdgcn_fence(__ATOMIC_ACQUIRE, "agent");
      asm volatile("s_waitcnt vmcnt(0)" ::: "memory");
    }
  }
  __syncthreads();
}

DEV int lds_byte(int r, int c) {
  int st = (r >> 4) * 2 + (c >> 5), rr = r & 15, cc = c & 31, ob = rr * 64 + cc * 2;
  return st * 1024 + (ob ^ (((ob >> 9) & 1) << 5));
}
DEV void stage_rc(int b, int& R, int& C) {
  int st = b / 1024, sb = b % 1024, swz = sb ^ (((sb >> 9) & 1) << 5);
  R = (st >> 1) * 16 + swz / 64; C = (st & 1) * 32 + (swz % 64) / 2;
}
#define GLDS16(g, l) __builtin_amdgcn_global_load_lds((const unsigned*)(g), (unsigned*)(l), 16, 0, 0)

typedef f32x4 Acc8[2][2][4][2];
constexpr int G8_BM = 256, G8_BK = 64, G8_HALF = 128, G8_HTB = G8_HALF * G8_BK * 2, G8_NXCD = 8, G8_WGM = 8;
DEV int perm32(int rho) { const int n = rho >> 4, i = rho & 15; return 8 * (i >> 2) + 4 * n + (i & 3); }
struct Unit { int pm, pn; };
DEV bool unit_next(int i, int nM, int nN, Unit& u) {
  const int nwg = nM * nN;
  const long L = (long)i * gridDim.x + blockIdx.x; if (L >= nwg) return false;
  int wgid = (int)L; { const int q = nwg / G8_NXCD, r = nwg % G8_NXCD, xcd = wgid % G8_NXCD, off = wgid / G8_NXCD; wgid = (xcd < r ? xcd * (q + 1) : r * (q + 1) + (xcd - r) * q) + off; }
  const int nig = G8_WGM * nN, gid = wgid / nig, fm = gid * G8_WGM, gsz = (nM - fm) < G8_WGM ? (nM - fm) : G8_WGM;
  u.pm = fm + ((wgid % nig) % gsz); u.pn = (wgid % nig) / gsz; return true;
}
template <bool TR, bool PERM, class PF, class EF>
DEV void gemm_phase(const int K, const int nM, const int nN, PF ptrs, EF E) {
  LAS unsigned char* lds = (LAS unsigned char*)smem;
  const int tid = otid(), wid = __builtin_amdgcn_readfirstlane(tid >> 6), lane = tid & 63, wr = wid >> 2, wc = wid & 3, fr = lane & 15, fq = lane >> 4;
  const int nt = K / G8_BK;
  unsigned voffA[2], voffB[2];
#pragma unroll
  for (int i = 0; i < 2; ++i) { int R, C; stage_rc(tid * 16 + i * 8192, R, C); const int Rb = PERM ? ((R & ~31) + perm32(R & 31)) : R;
    voffA[i] = (unsigned)(R * K + C) * 2u; voffB[i] = (unsigned)(Rb * K + C) * 2u; }
  const size_t kstep = (size_t)(G8_BK * 2);
  const size_t hstep = (size_t)G8_HALF * K * 2;
  const unsigned ldsw = (unsigned)wid * 1024u;
  const int aoff = lds_byte(wr * 64 + fr, fq * 8), boff = lds_byte(wc * 32 + fr, fq * 8);
#define PG8_SA(b, h) (((b) * 2 + (h)) * G8_HTB)
#define PG8_SB(b, h) ((4 + (b) * 2 + (h)) * G8_HTB)
#define PG8_STAGE(bufoff, gbase, voff) do { _Pragma("unroll") for (int _i = 0; _i < 2; ++_i) \
    __builtin_amdgcn_global_load_lds((const unsigned*)((const char*)(gbase) + (voff)[_i]), (LAS unsigned*)(lds + (bufoff) + ldsw + _i * 8192), 16, 0, 0); } while (0)
#define PG8_LDA(dst, b, h) do { _Pragma("unroll") for (int m = 0; m < 4; ++m) _Pragma("unroll") for (int k = 0; k < 2; ++k) dst[m][k] = *(const LAS bf16x8*)(lds + PG8_SA(b, h) + aoff + m * 2048 + k * 1024); } while (0)
#define PG8_LDB(dst, b, h) do { _Pragma("unroll") for (int n = 0; n < 2; ++n) _Pragma("unroll") for (int k = 0; k < 2; ++k) dst[n][k] = *(const LAS bf16x8*)(lds + PG8_SB(b, h) + boff + n * 2048 + k * 1024); } while (0)
#define PG8_MMA(ai, bj, At, Bt) do { __builtin_amdgcn_s_setprio(1); _Pragma("unroll") for (int m = 0; m < 4; ++m) _Pragma("unroll") for (int n = 0; n < 2; ++n) _Pragma("unroll") for (int k = 0; k < 2; ++k) \
    acc[ai][bj][m][n] = TR ? __builtin_amdgcn_mfma_f32_16x16x32_bf16(Bt[n][k], At[m][k], acc[ai][bj][m][n], 0, 0, 0) \
                           : __builtin_amdgcn_mfma_f32_16x16x32_bf16(At[m][k], Bt[n][k], acc[ai][bj][m][n], 0, 0, 0); __builtin_amdgcn_s_setprio(0); } while (0)
#define PG8_WAIT_V(n) asm volatile("s_waitcnt vmcnt(" #n ")" ::: "memory")
#define PG8_WAIT_L(n) asm volatile("s_waitcnt lgkmcnt(" #n ")" ::: "memory")
#define PG8_BAR __builtin_amdgcn_s_barrier()
#define PG8_SCHED __builtin_amdgcn_sched_barrier(0)
  Unit cur, nxt; int ui = 0;
  if (!unit_next(0, nM, nN, cur)) return;
  Acc8 acc;
#pragma unroll
  for (int a = 0; a < 2; ++a)
#pragma unroll
    for (int b = 0; b < 2; ++b)
#pragma unroll
      for (int m = 0; m < 4; ++m)
#pragma unroll
        for (int n = 0; n < 2; ++n) acc[a][b][m][n] = f32x4{0.f, 0.f, 0.f, 0.f};
  bf16x8 At[4][2], B0[2][2], B1[2][2];
  const char* cA; const char* cB;
  ptrs(cur, cA, cB);
  PG8_STAGE(PG8_SB(0, 0), cB, voffB); PG8_STAGE(PG8_SA(0, 0), cA, voffA); PG8_STAGE(PG8_SB(0, 1), cB + hstep, voffB); PG8_STAGE(PG8_SA(0, 1), cA + hstep, voffA);
  if (wr == 1) PG8_BAR;
  PG8_WAIT_V(4); PG8_BAR;
  PG8_STAGE(PG8_SB(1, 0), cB + kstep, voffB); PG8_STAGE(PG8_SA(1, 0), cA + kstep, voffA); PG8_STAGE(PG8_SB(1, 1), cB + hstep + kstep, voffB);
  PG8_WAIT_V(6); PG8_BAR;
  for (;;) {
    const bool has_next = unit_next(ui + 1, nM, nN, nxt);
    const char* nA = cA; const char* nB = cB;
    if (has_next) ptrs(nxt, nA, nB);
#pragma unroll 1
    for (int t = 0; t < nt; t += 2) {
      const bool last = (t == nt - 2);
      const char* a1 = cA + (size_t)(t + 1) * kstep;
      const char* a2 = last ? nA : cA + (size_t)(t + 2) * kstep; const char* b2 = last ? nB : cB + (size_t)(t + 2) * kstep;
      const char* a3 = a2 + kstep; const char* b3 = b2 + kstep;
      PG8_LDB(B0, 0, 0); PG8_SCHED; PG8_LDA(At, 0, 0); PG8_STAGE(PG8_SA(1, 1), a1 + hstep, voffA);
      PG8_WAIT_L(8); PG8_BAR; PG8_WAIT_L(0); PG8_MMA(0, 0, At, B0); PG8_BAR; PG8_SCHED;
      PG8_LDB(B1, 0, 1); PG8_STAGE(PG8_SB(0, 0), b2, voffB);
      PG8_BAR; PG8_WAIT_L(0); PG8_MMA(0, 1, At, B1); PG8_BAR;
      PG8_LDA(At, 0, 1); PG8_STAGE(PG8_SA(0, 0), a2, voffA);
      PG8_BAR; PG8_WAIT_L(0); PG8_MMA(1, 0, At, B0); PG8_BAR; PG8_SCHED;
      PG8_STAGE(PG8_SB(0, 1), b2 + hstep, voffB);
      PG8_WAIT_V(6); PG8_BAR; PG8_MMA(1, 1, At, B1); PG8_BAR;
      PG8_LDB(B0, 1, 0); PG8_SCHED; PG8_LDA(At, 1, 0); PG8_STAGE(PG8_SA(0, 1), a2 + hstep, voffA);
      PG8_WAIT_L(8); PG8_BAR; PG8_WAIT_L(0); PG8_MMA(0, 0, At, B0); PG8_BAR; PG8_SCHED;
      PG8_LDB(B1, 1, 1); PG8_STAGE(PG8_SB(1, 0), b3, voffB);
      PG8_BAR; PG8_WAIT_L(0); PG8_MMA(0, 1, At, B1); PG8_BAR;
      PG8_LDA(At, 1, 1); PG8_STAGE(PG8_SA(1, 0), a3, voffA);
      PG8_BAR; PG8_WAIT_L(0); PG8_MMA(1, 0, At, B0); PG8_BAR; PG8_SCHED;
      PG8_STAGE(PG8_SB(1, 1), b3 + hstep, voffB);
      PG8_WAIT_V(6); PG8_BAR; PG8_MMA(1, 1, At, B1); PG8_BAR;
    }
    E(acc, cur, wr, wc, fr, fq);
    if (!has_next) break;
#pragma unroll
    for (int a = 0; a < 2; ++a)
#pragma unroll
      for (int b = 0; b < 2; ++b)
#pragma unroll
        for (int m = 0; m < 4; ++m)
#pragma unroll
          for (int n = 0; n < 2; ++n) acc[a][b][m][n] = f32x4{0.f, 0.f, 0.f, 0.f};
    cur = nxt; cA = nA; cB = nB; ++ui;
  }
  PG8_WAIT_V(0);
  if (wr == 0) PG8_BAR;
  PG8_BAR;
#undef PG8_SA
#undef PG8_SB
#undef PG8_STAGE
#undef PG8_LDA
#undef PG8_LDB
#undef PG8_MMA
#undef PG8_WAIT_V
#undef PG8_WAIT_L
#undef PG8_BAR
#undef PG8_SCHED
}
#define E8_FOR _Pragma("unroll") for (int ai = 0; ai < 2; ++ai) _Pragma("unroll") for (int m = 0; m < 4; ++m) _Pragma("unroll") for (int bj = 0; bj < 2; ++bj)
DEV unsigned cvt_pk_bf16(float lo, float hi) { unsigned r; asm volatile("v_cvt_pk_bf16_f32 %0, %1, %2" : "=v"(r) : "v"(lo), "v"(hi)); return r; }

DEV void conv_tile(const ConvJob& J, int t) {
  const int tid = otid();
  int mat = t / J.tpm, tt = t % J.tpm;
  int kt = tt / J.ntn, nt = tt % J.ntn;
  const float* src = J.src + (long)mat * J.sstride;
  u16* dst = J.dst + (long)mat * J.dstride;
  const int kg = tid >> 6, ng = tid & 63;
  const int n = nt * 256 + ng * 4;
  float4 v[8];
#pragma unroll
  for (int j = 0; j < 8; ++j) {
    int k = kt * 64 + kg * 8 + j;
    if (n < J.N) v[j] = *reinterpret_cast<const float4*>(src + (long)k * J.N + n);
    else v[j] = make_float4(0.f, 0.f, 0.f, 0.f);
  }
#pragma unroll
  for (int i = 0; i < 4; ++i) {
    float e[8];
#pragma unroll
    for (int j = 0; j < 8; ++j) e[j] = (i == 0) ? v[j].x : (i == 1) ? v[j].y : (i == 2) ? v[j].z : v[j].w;
    uint4 pk;
    pk.x = pack2(e[0], e[1]); pk.y = pack2(e[2], e[3]); pk.z = pack2(e[4], e[5]); pk.w = pack2(e[6], e[7]);
    *reinterpret_cast<uint4*>(smem + (i * 64 + ng) * 144 + kg * 16) = pk;
  }
  __syncthreads();
#pragma unroll
  for (int u = 0; u < 4; ++u) {
    int q = tid + 512 * u;
    int nl = q >> 3, ch = q & 7;
    uint4 pk = *reinterpret_cast<const uint4*>(smem + ((nl & 3) * 64 + (nl >> 2)) * 144 + ch * 16);
    int nn = nt * 256 + nl;
    const int qq = nn >> J.rsh;
    long drow = (long)(qq >> J.sh2) * J.rs + (qq & ((1 << J.sh2) - 1)) * J.off2 + (nn & ((1 << J.rsh) - 1)) + J.off;
    *reinterpret_cast<uint4*>(dst + drow * J.K + kt * 64 + ch * 8) = pk;
  }
  __syncthreads();
}

DEV void phase_prep(const Params& p) {
  const int tid = otid(), nb = gridDim.x, bid = blockIdx.x;
  {
    float* zb = reinterpret_cast<float*>(smem);
    float* h1b = zb + 512;
    float* h2g = reinterpret_cast<float*>(p.ws + S_H2);
    const int w = tid >> 6, lane = tid & 63;
    for (int l0 = bid * 8; l0 < SEQ; l0 += nb * 8) {
      int l = l0 + w;
      float tt = (float)l / (float)(SEQ - 1);
      float ww = 6.283185307179586f * (float)l / (float)SEQ;
      float z = 0.f;
      if (lane == 0) z = tt;
      else if (lane <= 16) { float f = 1e-4f + (float)(lane - 1) * ((15.0f - 1e-4f) / 15.0f); z = cosf(f * ww); }
      else if (lane <= 32) { float f = 1e-4f + (float)(lane - 17) * ((15.0f - 1e-4f) / 15.0f); z = -sinf(f * ww); }
      zb[w * 64 + lane] = z;
      __syncthreads();
      float fr_ = p.hy_f_freq[lane];
      float a = p.hy_f_b1[lane];
      for (int k = 0; k < 33; ++k) a += zb[w * 64 + k] * p.hy_f_w1[k * 64 + lane];
      h1b[w * 64 + lane] = sinf(fr_ * a);
      __syncthreads();
      float a2 = p.hy_f_b2[lane];
      for (int k = 0; k < 64; ++k) a2 += h1b[w * 64 + k] * p.hy_f_w2[k * 64 + lane];
      h2g[l * 64 + lane] = sinf(fr_ * a2);
      __syncthreads();
    }
  }
  {
    u16* xb = reinterpret_cast<u16*>(p.ws + REG_X);
    const long n8 = (long)TOK * DM / 8;
    for (long i = (long)bid * 512 + tid; i < n8; i += (long)nb * 512) {
      float4 a = reinterpret_cast<const float4*>(p.x)[2 * i], b = reinterpret_cast<const float4*>(p.x)[2 * i + 1];
      uint4 pk; pk.x = pack2(a.x, a.y); pk.y = pack2(a.z, a.w); pk.z = pack2(b.x, b.y); pk.w = pack2(b.z, b.w);
      reinterpret_cast<uint4*>(xb)[i] = pk;
    }
    u16* pb = reinterpret_cast<u16*>(p.ws + REG_P);
    const long m8 = 2L * TOK * 256 / 8;
    for (long i = (long)bid * 512 + tid; i < m8; i += (long)nb * 512) {
      float4 a = reinterpret_cast<const float4*>(p.p)[2 * i], b = reinterpret_cast<const float4*>(p.p)[2 * i + 1];
      uint4 pk; pk.x = pack2(a.x, a.y); pk.y = pack2(a.z, a.w); pk.z = pack2(b.x, b.y); pk.w = pack2(b.z, b.w);
      reinterpret_cast<uint4*>(pb)[i] = pk;
    }
  }
  for (int t = bid; t < p.conv_total; t += nb) {
    int j = 0;
#pragma unroll 1
    for (int q = 1; q < NJOBS; ++q) if (t >= p.jobs[q].tile0 && p.jobs[q].ntiles > 0) j = q;
    conv_tile(p.jobs[j], t - p.jobs[j].tile0);
  }
}

DEV void filter_b(const Params& p, int cpair) {
  const int tid = otid();
  float* w3s = reinterpret_cast<float*>(smem);
  float* red = w3s + 512;
  float* nrm = red + 32;
  float* hb = nrm + 4;
  const float* h2g = reinterpret_cast<const float*>(p.ws + S_H2);
  {
    int ci = tid >> 6, k = tid & 63;
    int o = ci >> 2, d = (ci >> 1) & 1, cc = ci & 1;
    w3s[ci * 64 + k] = p.hy_f_w3[k * 2048 + o * 1024 + d * 512 + 2 * cpair + cc];
  }
  __syncthreads();
  const float min_decay = logf(1e-2f) / 1.5f, max_decay = logf(1e-2f) / 0.3f;
#pragma unroll 1
  for (int i = 0; i < 4; ++i) {
    int l = tid + 512 * i;
    float h2[64];
#pragma unroll
    for (int k = 0; k < 16; ++k) {
      float4 v = *reinterpret_cast<const float4*>(h2g + l * 64 + k * 4);
      h2[4 * k] = v.x; h2[4 * k + 1] = v.y; h2[4 * k + 2] = v.z; h2[4 * k + 3] = v.w;
    }
    float tt = (float)l / (float)(SEQ - 1);
#pragma unroll 1
    for (int ci = 0; ci < 8; ++ci) {
      float a = 0.f;
#pragma unroll
      for (int k = 0; k < 64; ++k) a += h2[k] * w3s[ci * 64 + k];
      int cc = ci & 1;
      int c = 2 * cpair + cc;
      float delta = fabsf(min_decay + (float)c * ((max_decay - min_decay) / 511.0f));
      a *= expf(-tt * delta);
      hb[ci * 2048 + l] = a;
    }
  }
  __syncthreads();
  {
    float ss[4];
#pragma unroll
    for (int oc = 0; oc < 4; ++oc) {
      int o = oc >> 1, cc = oc & 1;
      float a = 0.f;
      for (int l = tid; l < 2048; l += 512) {
        float f = hb[(o * 4 + 0 + cc) * 2048 + l];
        float b = (l > 0) ? hb[(o * 4 + 2 + cc) * 2048 + l] : 0.f;
        a += f * f + b * b;
      }
      ss[oc] = wave_sum(a);
    }
    if ((tid & 63) == 0) {
#pragma unroll
      for (int q = 0; q < 4; ++q) red[(tid >> 6) * 4 + q] = ss[q];
    }
  }
  __syncthreads();
  if (tid < 4) {
    float s = 0.f;
    for (int w = 0; w < 8; ++w) s += red[w * 4 + tid];
    nrm[tid] = rsqrtf(s + 1e-12f);
  }
  __syncthreads();
  u16* Rg = reinterpret_cast<u16*>(p.ws + S_RG);
  for (int q = tid; q < 4 * 4096; q += 512) {
    int oc = q >> 12, qq = q & 4095;
    int o = oc >> 1, cc = oc & 1;
    float v;
    if (qq == 0) v = 0.f;
    else if (qq <= 2048) v = hb[(o * 4 + 0 * 2 + cc) * 2048 + (2048 - qq)];
    else v = hb[(o * 4 + 1 * 2 + cc) * 2048 + (qq - 2048)];
    v *= nrm[oc];
    Rg[((long)o * 512 + 2 * cpair + cc) * 4096 + qq] = f2bf(v);
  }
  __syncthreads();
}

DEV void phase_abin(const Params& p) {
  const int nb = gridDim.x;
  for (int c = blockIdx.x; c < 256; c += nb) filter_b(p, c);
  const u16* xb = reinterpret_cast<const u16*>(p.ws + REG_X);
  const u16* wt = reinterpret_cast<const u16*>(p.ws + W_ABIN);
  u16* qk = reinterpret_cast<u16*>(p.ws + REG_B);
  u16* vht = reinterpret_cast<u16*>(p.ws + REG_B + 33554432ull);
  gemm_phase<true, true>(1024, 64, 4, [&](const Unit& u, const char*& a, const char*& b) { a = (const char*)(xb) + (size_t)u.pm * 256 * (1024) * 2; b = (const char*)(wt) + (size_t)u.pn * 256 * (1024) * 2; },
      [&](Acc8& acc, const Unit& u, int wr, int wc, int fr, int fq) {
        const float sc = (u.pn < 2) ? 0.125f : 1.0f;
        u16* base = qk + (long)(u.pm * 256 + wr * 64 + fr) * 1024 + u.pn * 256 + wc * 32 + 8 * fq;
        E8_FOR {
          f32x4 v0 = acc[ai][bj][m][0], v1 = acc[ai][bj][m][1];
          uint4 pk;
          pk.x = cvt_pk_bf16(v0[0] * sc, v0[1] * sc); pk.y = cvt_pk_bf16(v0[2] * sc, v0[3] * sc);
          pk.z = cvt_pk_bf16(v1[0] * sc, v1[1] * sc); pk.w = cvt_pk_bf16(v1[2] * sc, v1[3] * sc);
          *reinterpret_cast<uint4*>(base + (ai * 128 + m * 16) * 1024 + bj * 128) = pk;
        }
      });
  gemm_phase<false, false>(1024, 64, 8, [&](const Unit& u, const char*& a, const char*& b) { a = (const char*)(xb) + (size_t)u.pm * 256 * (1024) * 2; b = (const char*)(wt + 1024 * 1024) + (size_t)u.pn * 256 * (1024) * 2; },
      [&](Acc8& acc, const Unit& u, int wr, int wc, int fr, int fq) {
        u16* base = vht + (long)(u.pn * 256 + wc * 32 + fr) * TOK + u.pm * 256 + wr * 64 + 4 * fq;
        E8_FOR {
#pragma unroll
          for (int n = 0; n < 2; ++n) {
            f32x4 v = acc[ai][bj][m][n];
            uint2 pk; pk.x = cvt_pk_bf16(v[0], v[1]); pk.y = cvt_pk_bf16(v[2], v[3]);
            *reinterpret_cast<uint2*>(base + (long)(bj * 128 + n * 16) * TOK + ai * 128 + m * 16) = pk;
          }
        }
      });
}

DEV void na_unit(const Params& p, int u) {
  const int lane = otid() & 63, fr = lane & 15, fq = lane >> 4;
  const int g = u & 3, r = (u >> 2) & 31, h = (u >> 7) & 7, b = u >> 10;
  const int r0 = min(max(r - 4, 0), 24), cs = min(max(16 * g - 8, 0), 32);
  const u16* qk = reinterpret_cast<const u16*>(p.ws + REG_B);
  const u16* vht = reinterpret_cast<const u16*>(p.ws + REG_B + 33554432ull);
  u16* cat = reinterpret_cast<u16*>(p.ws + REG_A + 100663296ull);
  const int c = 16 * g + fr;
  const long tokq = (long)b * SEQ + r * 64 + c;
  bf16x8 qf[2];
#pragma unroll
  for (int ks = 0; ks < 2; ++ks) qf[ks] = *reinterpret_cast<const bf16x8*>(qk + tokq * 1024 + h * 64 + ks * 32 + fq * 8);
  f32x4 s[16];
#pragma unroll
  for (int kt = 0; kt < 16; ++kt) {
    const int w = kt >> 1, half = kt & 1;
    const long tokk = (long)b * SEQ + (r0 + w) * 64 + cs + 16 * half + fr;
    bf16x8 k0 = *reinterpret_cast<const bf16x8*>(qk + tokk * 1024 + 512 + h * 64 + fq * 8);
    bf16x8 k1 = *reinterpret_cast<const bf16x8*>(qk + tokk * 1024 + 512 + h * 64 + 32 + fq * 8);
    f32x4 a = {0.f, 0.f, 0.f, 0.f};
    a = __builtin_amdgcn_mfma_f32_16x16x32_bf16(k0, qf[0], a, 0, 0, 0);
    a = __builtin_amdgcn_mfma_f32_16x16x32_bf16(k1, qf[1], a, 0, 0, 0);
    s[kt] = a;
  }
  const int c0 = min(max(c - 8, 0), 48);
  const float* rpb = p.na_rpb + h * 15 * 31;
  float mx = -1e30f;
#pragma unroll
  for (int kt = 0; kt < 16; ++kt) {
    const int w = kt >> 1, half = kt & 1;
    const int dr = r0 + w - r + 7;
#pragma unroll
    for (int j = 0; j < 4; ++j) {
      int kc = cs + 16 * half + 4 * fq + j;
      bool valid = (kc >= c0) && (kc < c0 + 16);
      int dc = min(max(kc - c, -15), 15) + 15;
      float bias = rpb[dr * 31 + dc];
      float v = valid ? (s[kt][j] + bias) : -1e30f;
      s[kt][j] = v;
      mx = fmaxf(mx, v);
    }
  }
  mx = fmaxf(mx, __shfl_xor(mx, 16));
  mx = fmaxf(mx, __shfl_xor(mx, 32));
  float sum = 0.f;
#pragma unroll
  for (int kt = 0; kt < 16; ++kt)
#pragma unroll
    for (int j = 0; j < 4; ++j) { float e = __expf(s[kt][j] - mx); s[kt][j] = e; sum += e; }
  sum += __shfl_xor(sum, 16);
  sum += __shfl_xor(sum, 32);
  f32x4 o[4];
#pragma unroll
  for (int dt = 0; dt < 4; ++dt) o[dt] = f32x4{0.f, 0.f, 0.f, 0.f};
#pragma unroll
  for (int w = 0; w < 8; ++w) {
    union { bf16x8 v; unsigned u[4]; } pf;
    pf.u[0] = pack2(s[2 * w][0], s[2 * w][1]); pf.u[1] = pack2(s[2 * w][2], s[2 * w][3]);
    pf.u[2] = pack2(s[2 * w + 1][0], s[2 * w + 1][1]); pf.u[3] = pack2(s[2 * w + 1][2], s[2 * w + 1][3]);
    const long tk = (long)b * SEQ + (r0 + w) * 64 + cs + 4 * fq;
#pragma unroll
    for (int dt = 0; dt < 4; ++dt) {
      const u16* vp = vht + (long)(h * 64 + dt * 16 + fr) * TOK + tk;
      union { bf16x8 v; uint2 u[2]; } af;
      af.u[0] = *reinterpret_cast<const uint2*>(vp);
      af.u[1] = *reinterpret_cast<const uint2*>(vp + 16);
      o[dt] = __builtin_amdgcn_mfma_f32_16x16x32_bf16(af.v, pf.v, o[dt], 0, 0, 0);
    }
  }
  const float inv = 1.0f / sum;
#pragma unroll
  for (int dt = 0; dt < 4; ++dt) {
    uint2 pk; pk.x = pack2(o[dt][0] * inv, o[dt][1] * inv); pk.y = pack2(o[dt][2] * inv, o[dt][3] * inv);
    *reinterpret_cast<uint2*>(cat + tokq * 1024 + h * 64 + dt * 16 + 4 * fq) = pk;
  }
}

constexpr int UB_STRIDE = 2056;
constexpr int RC_STRIDE = 4120;
constexpr int HY_RC_OFF = 2 * NBATCH * UB_STRIDE * 2;
DEV float shortconv(const u16* hrow, const float* cw, float cb, int ch, int t) {
  float xm = (t > 0) ? bf2f(hrow[t - 1]) : 0.f;
  float x0 = bf2f(hrow[t]);
  float xp = (t < SEQ - 1) ? bf2f(hrow[t + 1]) : 0.f;
  return cb + xm * cw[ch] + x0 * cw[1536 + ch] + xp * cw[2 * 1536 + ch];
}
DEV void load_rc(const Params& p, int o, int c) {
  const int tid = otid();
  char* rc = smem + HY_RC_OFF;
  const u16* Rg = reinterpret_cast<const u16*>(p.ws + S_RG) + ((long)o * 512 + c) * 4096;
  const float skip = p.hy_skip[o * 512 + c];
  const int i0 = tid * 8;
  uint4 lo = *reinterpret_cast<const uint4*>(Rg + i0);
  uint4 hi = (tid < 511) ? *reinterpret_cast<const uint4*>(Rg + i0 + 8) : make_uint4(0u, 0u, 0u, 0u);
  unsigned w[8] = {lo.x, lo.y, lo.z, lo.w, hi.x, hi.y, hi.z, hi.w};
  if (tid == 256) w[0] = (w[0] & 0xffff0000u) | (unsigned)f2bf(bf2f((u16)(w[0] & 0xffffu)) + skip);
  if (tid == 255) w[4] = (w[4] & 0xffff0000u) | (unsigned)f2bf(bf2f((u16)(w[4] & 0xffffu)) + skip);
#pragma unroll
  for (int m = 0; m < 8; ++m) {
    uint4 o4;
    if (m & 1) {
      o4.x = __builtin_amdgcn_alignbyte(w[m / 2 + 1], w[m / 2], 2);
      o4.y = __builtin_amdgcn_alignbyte(w[m / 2 + 2], w[m / 2 + 1], 2);
      o4.z = __builtin_amdgcn_alignbyte(w[m / 2 + 3], w[m / 2 + 2], 2);
      o4.w = __builtin_amdgcn_alignbyte(w[m / 2 + 4], w[m / 2 + 3], 2);
    } else {
      o4.x = w[m / 2]; o4.y = w[m / 2 + 1]; o4.z = w[m / 2 + 2]; o4.w = w[m / 2 + 3];
    }
    *reinterpret_cast<uint4*>(rc + m * (RC_STRIDE * 2) + i0 * 2) = o4;
  }
}
DEV void hyena_conv(const u16* ub, f32x4 (&acc)[16]) {
  const int lane = otid() & 63, wid = __builtin_amdgcn_readfirstlane(otid() >> 6), fr = lane & 15, fq = lane >> 4;
  const int mcopy = (-wid) & 7;
  const u16* rbase = reinterpret_cast<const u16*>(smem + HY_RC_OFF) + mcopy * RC_STRIDE + (8 * fq - 8 * fr + 2048 - (wid + mcopy));
#pragma unroll
  for (int i = 0; i < 16; ++i) acc[i] = f32x4{0.f, 0.f, 0.f, 0.f};
  const u16* urow = ub + (fr & 7) * UB_STRIDE + fq * 8;
#pragma unroll 1
  for (int kk = 0; kk < 64; ++kk) {
    bf16x8 bfr = *reinterpret_cast<const bf16x8*>(urow + kk * 32);
    const u16* rk = rbase + 32 * kk;
#pragma unroll
    for (int T = 0; T < 16; ++T) {
      bf16x8 af = *reinterpret_cast<const bf16x8*>(rk - 128 * T);
      acc[T] = __builtin_amdgcn_mfma_f32_16x16x32_bf16(af, bfr, acc[T], 0, 0, 0);
    }
  }
}
DEV void shortconv_pass(const u16* __restrict__ hrow  , u16* ub, const float* cw, float cb, int ch) {
  const float w0 = cw[ch], w1 = cw[1536 + ch], w2 = cw[2 * 1536 + ch];
  for (int q = otid(); q < TOK / 8; q += 512) {
    const int i = q * 8, b = i >> 11, t = i & 2047;
    uint4 v = *reinterpret_cast<const uint4*>(hrow + i);
    float x[10];
    x[0] = (t > 0) ? bf2f(hrow[i - 1]) : 0.f;
    x[9] = (t + 8 < SEQ) ? bf2f(hrow[i + 8]) : 0.f;
    x[1] = __uint_as_float(v.x << 16); x[2] = __uint_as_float(v.x & 0xffff0000u);
    x[3] = __uint_as_float(v.y << 16); x[4] = __uint_as_float(v.y & 0xffff0000u);
    x[5] = __uint_as_float(v.z << 16); x[6] = __uint_as_float(v.z & 0xffff0000u);
    x[7] = __uint_as_float(v.w << 16); x[8] = __uint_as_float(v.w & 0xffff0000u);
    float y[8];
#pragma unroll
    for (int j = 0; j < 8; ++j) y[j] = cb + x[j] * w0 + x[j + 1] * w1 + x[j + 2] * w2;
    uint4 o4; o4.x = pack2(y[0], y[1]); o4.y = pack2(y[2], y[3]); o4.z = pack2(y[4], y[5]); o4.w = pack2(y[6], y[7]);
    *reinterpret_cast<uint4*>(ub + b * UB_STRIDE + t) = o4;
  }
}
DEV void hyena_unit(const Params& p, int c) {
  const int tid = otid(), lane = tid & 63, wid = tid >> 6, fr = lane & 15, fq = lane >> 4;
  u16* ubA = reinterpret_cast<u16*>(smem);
  u16* ubB = ubA + NBATCH * UB_STRIDE;
  const u16* hbt = reinterpret_cast<const u16*>(p.ws + REG_B + 33554432ull) + 512L * TOK;
  u16* zT = reinterpret_cast<u16*>(p.ws + REG_C);
  const float* cw = p.hy_conv_w;
  shortconv_pass(hbt + (long)c * TOK, ubA, cw, p.hy_conv_b[c], c);
  shortconv_pass(hbt + (long)(512 + c) * TOK, ubB, cw, p.hy_conv_b[512 + c], 512 + c);
  load_rc(p, 0, c);
  __syncthreads();
  f32x4 acc[16];
  hyena_conv(ubA, acc);
  if (fr < 8) {
#pragma unroll
    for (int T = 0; T < 16; ++T)
#pragma unroll
      for (int j = 0; j < 4; ++j) {
        const int t = 128 * T + wid + 8 * (4 * fq + j);
        u16* q = ubB + fr * UB_STRIDE + t;
        *q = f2bf(bf2f(*q) * acc[T][j]);
      }
  }
  __syncthreads();
  shortconv_pass(hbt + (long)(1024 + c) * TOK, ubA, cw, p.hy_conv_b[1024 + c], 1024 + c);
  load_rc(p, 1, c);
  __syncthreads();
  hyena_conv(ubB, acc);
  if (fr < 8) {
#pragma unroll
    for (int T = 0; T < 16; ++T)
#pragma unroll
      for (int j = 0; j < 4; ++j) {
        const int t = 128 * T + wid + 8 * (4 * fq + j);
        u16* q = ubA + fr * UB_STRIDE + t;
        *q = f2bf(bf2f(*q) * acc[T][j]);
      }
  }
  __syncthreads();
  for (int q = tid; q < TOK / 8; q += 512) {
    const int i = q * 8, b = i >> 11, t = i & 2047;
    *reinterpret_cast<uint4*>(zT + (long)c * TOK + i) = *reinterpret_cast<const uint4*>(ubA + b * UB_STRIDE + t);
  }
  __syncthreads();
}
DEV void phase_ztrans(const Params& p) {
  const int tid = otid();
  const u16* zT = reinterpret_cast<const u16*>(p.ws + REG_C);
  u16* cat = reinterpret_cast<u16*>(p.ws + REG_A + 100663296ull);
  u16* tile = reinterpret_cast<u16*>(smem);
  for (int tb = blockIdx.x; tb < TOK / 64; tb += gridDim.x) {
    __syncthreads();
    const u16* src = zT + (long)tid * TOK + tb * 64;
#pragma unroll
    for (int k = 0; k < 8; ++k) *reinterpret_cast<uint4*>(tile + tid * 72 + k * 8) = *reinterpret_cast<const uint4*>(src + k * 8);
    __syncthreads();
#pragma unroll
    for (int k = 0; k < 8; ++k) {
      const int q = tid + 512 * k;
      const int tk = q >> 6, ch8 = (q & 63) * 8;
      unsigned w[4];
#pragma unroll
      for (int j = 0; j < 4; ++j) w[j] = (unsigned)tile[(ch8 + 2 * j) * 72 + tk] | ((unsigned)tile[(ch8 + 2 * j + 1) * 72 + tk] << 16);
      *reinterpret_cast<uint4*>(cat + (long)(tb * 64 + tk) * 1024 + 512 + ch8) = make_uint4(w[0], w[1], w[2], w[3]);
    }
  }
}
DEV void phase_mix0(const Params& p) {
  const int nb = gridDim.x;
  for (int c = blockIdx.x; c < 512; c += nb) hyena_unit(p, c);
  const int wid = otid() >> 6;
  for (int u = blockIdx.x * 8 + wid; u < 8192; u += nb * 8) na_unit(p, u);
}

DEV void phase_outproj(const Params& p, const u16* A, const u16* wt, const float* xres) {
  float* pre1 = reinterpret_cast<float*>(p.ws + REG_C);
  gemm_phase<true, false>(1024, 64, 4, [&](const Unit& u, const char*& a, const char*& b) { a = (const char*)(A) + (size_t)u.pm * 256 * (1024) * 2; b = (const char*)(wt) + (size_t)u.pn * 256 * (1024) * 2; },
      [&](Acc8& acc, const Unit& u, int wr, int wc, int fr, int fq) {
        const long o0 = (long)(u.pm * 256 + wr * 64 + fr) * 1024 + u.pn * 256 + wc * 32 + 4 * fq;
        E8_FOR {
#pragma unroll
          for (int n = 0; n < 2; ++n) {
            const long o = o0 + (ai * 128 + m * 16) * 1024 + bj * 128 + n * 16;
            f32x4 xr = *reinterpret_cast<const f32x4*>(xres + o);
            *reinterpret_cast<f32x4*>(pre1 + o) = xr * DN_ALPHA + acc[ai][bj][m][n];
          }
        }
      });
}

DEV void phase_ln1_router(const Params& p, int layer) {
  const int tid = otid(), lane = tid & 63, wid = tid >> 6, nb = gridDim.x;
  float* wrT = reinterpret_cast<float*>(smem);
  const float* wr = p.moe_router + (long)layer * 1024 * 16;
  for (int i = tid; i < 16384; i += 512) { int c = i >> 4, e = i & 15; wrT[e * 1024 + c] = wr[i]; }
  __syncthreads();
  const float* pre1 = reinterpret_cast<const float*>(p.ws + REG_C);
  float* x1 = reinterpret_cast<float*>(p.ws + REG_D);
  u16* x1b = reinterpret_cast<u16*>(p.ws + REG_E);
  float* aff = reinterpret_cast<float*>(p.ws + S_AFF);
  const float* g = p.ln1_g + layer * 1024; const float* bb = p.ln1_b + layer * 1024;
  for (int tok = blockIdx.x * 8 + wid; tok < TOK; tok += nb * 8) {
    float4 v[4];
    float s = 0.f;
#pragma unroll
    for (int i = 0; i < 4; ++i) { v[i] = *reinterpret_cast<const float4*>(pre1 + (long)tok * 1024 + i * 256 + lane * 4); s += v[i].x + v[i].y + v[i].z + v[i].w; }
    float mu = wave_sum(s) * (1.0f / 1024.0f);
    float q = 0.f;
#pragma unroll
    for (int i = 0; i < 4; ++i) { v[i].x -= mu; v[i].y -= mu; v[i].z -= mu; v[i].w -= mu; q += v[i].x * v[i].x + v[i].y * v[i].y + v[i].z * v[i].z + v[i].w * v[i].w; }
    float rstd = rsqrtf(wave_sum(q) * (1.0f / 1024.0f) + LN_EPS);
    float4 y[4];
#pragma unroll
    for (int i = 0; i < 4; ++i) {
      int c = i * 256 + lane * 4;
      float4 gg = *reinterpret_cast<const float4*>(g + c), b4 = *reinterpret_cast<const float4*>(bb + c);
      y[i].x = v[i].x * rstd * gg.x + b4.x; y[i].y = v[i].y * rstd * gg.y + b4.y; y[i].z = v[i].z * rstd * gg.z + b4.z; y[i].w = v[i].w * rstd * gg.w + b4.w;
      *reinterpret_cast<float4*>(x1 + (long)tok * 1024 + c) = y[i];
      uint2 pk; pk.x = pack2(y[i].x, y[i].y); pk.y = pack2(y[i].z, y[i].w);
      *reinterpret_cast<uint2*>(x1b + (long)tok * 1024 + c) = pk;
    }
    float lg[16];
#pragma unroll
    for (int e = 0; e < 16; ++e) {
      float a = 0.f;
#pragma unroll
      for (int i = 0; i < 4; ++i) {
        float4 w4 = *reinterpret_cast<const float4*>(wrT + e * 1024 + i * 256 + lane * 4);
        a += y[i].x * w4.x + y[i].y * w4.y + y[i].z * w4.z + y[i].w * w4.w;
      }
      lg[e] = a;
      if (e & 1) asm volatile("" ::: "memory");
    }
#pragma unroll
    for (int s_ = 0; s_ < 4; ++s_) {
      const int bit = 1 << s_;
      const bool up = (lane & bit) != 0;
#pragma unroll
      for (int i = 0; i < (8 >> s_); ++i) {
        float lo = lg[2 * i], hi = lg[2 * i + 1];
        float snd = up ? lo : hi;
        float rcv = __shfl_xor(snd, bit);
        lg[i] = (up ? hi : lo) + rcv;
      }
    }
    float mine = lg[0];
    mine += __shfl_xor(mine, 16);
    mine += __shfl_xor(mine, 32);
    float mx = mine;
#pragma unroll
    for (int o = 8; o > 0; o >>= 1) mx = fmaxf(mx, __shfl_xor(mx, o));
    float ex = expf(mine - mx);
    float den = ex;
#pragma unroll
    for (int o = 8; o > 0; o >>= 1) den += __shfl_xor(den, o);
    if (lane < 16) {
      int b = tok >> 11, l = tok & 2047;
      aff[((long)b * 16 + lane) * SEQ + l] = ex / den;
    }
  }
}

DEV void phase_topk(const Params& p) {
  const int tid = otid(), nb = gridDim.x, lane = tid & 63, wid = tid >> 6;
  unsigned* key = reinterpret_cast<unsigned*>(smem);
  int* rows = reinterpret_cast<int*>(smem + 8192);
  unsigned* hist = reinterpret_cast<unsigned*>(smem + 9216);
  unsigned* wsum = reinterpret_cast<unsigned*>(smem + 10240);
  unsigned* bc = reinterpret_cast<unsigned*>(smem + 10304);
  const float* aff = reinterpret_cast<const float*>(p.ws + S_AFF);
  float* gsel = reinterpret_cast<float*>(p.ws + S_GSEL);
  int* slot = reinterpret_cast<int*>(p.ws + S_SLOT);
  const u16* x1b = reinterpret_cast<const u16*>(p.ws + REG_E);
  u16* Xe = reinterpret_cast<u16*>(p.ws + REG_C);
  for (int be = blockIdx.x; be < NBATCH * NEXP; be += nb) {
    const int b = be >> 4, e = be & 15;
    __syncthreads();
    const float4 av = *reinterpret_cast<const float4*>(aff + (long)be * SEQ + tid * 4);
    const unsigned k0 = __float_as_uint(av.x), k1 = __float_as_uint(av.y), k2 = __float_as_uint(av.z), k3 = __float_as_uint(av.w);
    unsigned prefix = 0u, need = CAP;
#pragma unroll 1
    for (int shift = 24; shift >= 0; shift -= 8) {
      if (tid < 256) hist[tid] = 0u;
      __syncthreads();
      const unsigned hs = (shift == 24) ? 0u : (unsigned)(shift + 8);
      if (shift == 24 || (k0 >> hs) == prefix) atomicAdd(&hist[(k0 >> shift) & 255u], 1u);
      if (shift == 24 || (k1 >> hs) == prefix) atomicAdd(&hist[(k1 >> shift) & 255u], 1u);
      if (shift == 24 || (k2 >> hs) == prefix) atomicAdd(&hist[(k2 >> shift) & 255u], 1u);
      if (shift == 24 || (k3 >> hs) == prefix) atomicAdd(&hist[(k3 >> shift) & 255u], 1u);
      __syncthreads();
      if (wid == 0) {
        unsigned h0 = hist[4 * lane], h1 = hist[4 * lane + 1], h2 = hist[4 * lane + 2], h3 = hist[4 * lane + 3];
        unsigned tot = h0 + h1 + h2 + h3;
        unsigned suf = tot;
#pragma unroll
        for (int o = 1; o < 64; o <<= 1) { unsigned t = __shfl_down(suf, o); if (lane + o < 64) suf += t; }
        const unsigned above = suf - tot;
        int d = -1; unsigned nabove = 0u;
        unsigned c3 = above + h3, c2 = c3 + h2, c1 = c2 + h1, c0 = c1 + h0;
        if (above < need && c0 >= need) {
          if (c3 >= need) { d = 4 * lane + 3; nabove = above; }
          else if (c2 >= need) { d = 4 * lane + 2; nabove = c3; }
          else if (c1 >= need) { d = 4 * lane + 1; nabove = c2; }
          else { d = 4 * lane; nabove = c1; }
          bc[0] = (prefix << 8) | (unsigned)d;
          bc[1] = need - nabove;
        }
      }
      __syncthreads();
      prefix = bc[0]; need = bc[1];
    }
    const unsigned tau = prefix;
    const unsigned e0 = (k0 == tau), e1 = (k1 == tau), e2 = (k2 == tau), e3 = (k3 == tau);
    unsigned eqs = e0 + e1 + e2 + e3;
    unsigned inc = eqs;
#pragma unroll
    for (int o = 1; o < 64; o <<= 1) { unsigned t = __shfl_up(inc, o); if (lane >= o) inc += t; }
    if (lane == 63) wsum[wid] = inc;
    __syncthreads();
    unsigned base = 0u;
#pragma unroll
    for (int w = 0; w < 8; ++w) if (w < wid) base += wsum[w];
    unsigned eqb = base + inc - eqs;
    const unsigned s0 = (k0 > tau) || (e0 && eqb < need); eqb += e0;
    const unsigned s1 = (k1 > tau) || (e1 && eqb < need); eqb += e1;
    const unsigned s2 = (k2 > tau) || (e2 && eqb < need); eqb += e2;
    const unsigned s3 = (k3 > tau) || (e3 && eqb < need);
    const unsigned sels = s0 + s1 + s2 + s3;
    unsigned inc2 = sels;
#pragma unroll
    for (int o = 1; o < 64; o <<= 1) { unsigned t = __shfl_up(inc2, o); if (lane >= o) inc2 += t; }
    if (lane == 63) wsum[8 + wid] = inc2;
    __syncthreads();
    unsigned base2 = 0u;
#pragma unroll
    for (int w = 0; w < 8; ++w) if (w < wid) base2 += wsum[8 + w];
    unsigned sl = base2 + inc2 - sels;
    const int tok0 = tid * 4;
    int sv[4];
    sv[0] = s0 ? (int)sl : -1; sl += s0;
    sv[1] = s1 ? (int)sl : -1; sl += s1;
    sv[2] = s2 ? (int)sl : -1; sl += s2;
    sv[3] = s3 ? (int)sl : -1;
    const float avv[4] = {av.x, av.y, av.z, av.w};
#pragma unroll
    for (int j = 0; j < 4; ++j) {
      slot[((long)b * SEQ + tok0 + j) * 16 + e] = sv[j];
      if (sv[j] >= 0) { rows[sv[j]] = tok0 + j; gsel[be * CAP + sv[j]] = avv[j]; }
    }
    __syncthreads();
    for (int s = wid; s < CAP; s += 8) {
      const int t = rows[s];
      const uint4* src = reinterpret_cast<const uint4*>(x1b + ((long)b * SEQ + t) * 1024);
      uint4* dst = reinterpret_cast<uint4*>(Xe + ((long)(e * 8 + b) * CAP + s) * 1024);
      uint4 c0 = src[lane], c1 = src[64 + lane];
      dst[lane] = c0; dst[64 + lane] = c1;
    }
  }
}

DEV void phase_moe1(const Params& p, int layer) {
  const u16* Xe = reinterpret_cast<const u16*>(p.ws + REG_C);
  const u16* wgu = reinterpret_cast<const u16*>(p.ws + W_GU) + (long)layer * 16 * 4096 * 1024;
  u16* H = reinterpret_cast<u16*>(p.ws + REG_A);
  gemm_phase<true, true>(1024, 128, 16,
      [&](const Unit& u, const char*& a, const char*& b) { a = (const char*)Xe + (size_t)u.pm * 256 * 1024 * 2; b = (const char*)wgu + ((size_t)(u.pm >> 3) * 4096 + (size_t)u.pn * 256) * 1024 * 2; },
      [&](Acc8& acc, const Unit& u, int wr, int wc, int fr, int fq) {
        u16* base = H + (long)(u.pm * 256 + wr * 64 + fr) * DFF + u.pn * 128 + wc * 32 + 8 * fq;
#pragma unroll
        for (int ai = 0; ai < 2; ++ai)
#pragma unroll
          for (int m = 0; m < 4; ++m) {
            float hv[8];
#pragma unroll
            for (int n = 0; n < 2; ++n)
#pragma unroll
              for (int j = 0; j < 4; ++j) {
                float gte = acc[ai][0][m][n][j], up = acc[ai][1][m][n][j];
                hv[n * 4 + j] = gte / (1.0f + __expf(-gte)) * up;
              }
            uint4 pk;
            pk.x = cvt_pk_bf16(hv[0], hv[1]); pk.y = cvt_pk_bf16(hv[2], hv[3]); pk.z = cvt_pk_bf16(hv[4], hv[5]); pk.w = cvt_pk_bf16(hv[6], hv[7]);
            *reinterpret_cast<uint4*>(base + (ai * 128 + m * 16) * DFF) = pk;
          }
      });
}
DEV void phase_moe2(const Params& p, int layer) {
  const u16* H = reinterpret_cast<const u16*>(p.ws + REG_A);
  const u16* wd = reinterpret_cast<const u16*>(p.ws + W_DN) + (long)layer * 16 * 1024 * 2048;
  const float* gsel = reinterpret_cast<const float*>(p.ws + S_GSEL);
  u16* Ye = reinterpret_cast<u16*>(p.ws + REG_B);
  gemm_phase<true, true>(2048, 128, 4,
      [&](const Unit& u, const char*& a, const char*& b) { a = (const char*)H + (size_t)u.pm * 256 * 2048 * 2; b = (const char*)wd + ((size_t)(u.pm >> 3) * 1024 + (size_t)u.pn * 256) * 2048 * 2; },
      [&](Acc8& acc, const Unit& u, int wr, int wc, int fr, int fq) {
        const int e = u.pm >> 3, b = u.pm & 7;
        const float* gs = gsel + (b * 16 + e) * CAP + wr * 64 + fr;
        u16* base = Ye + (long)(u.pm * 256 + wr * 64 + fr) * 1024 + u.pn * 256 + wc * 32 + 8 * fq;
#pragma unroll
        for (int ai = 0; ai < 2; ++ai)
#pragma unroll
          for (int m = 0; m < 4; ++m) {
            const float g = gs[ai * 128 + m * 16];
#pragma unroll
            for (int bj = 0; bj < 2; ++bj) {
              f32x4 v0 = acc[ai][bj][m][0] * g, v1 = acc[ai][bj][m][1] * g;
              uint4 pk;
              pk.x = cvt_pk_bf16(v0[0], v0[1]); pk.y = cvt_pk_bf16(v0[2], v0[3]); pk.z = cvt_pk_bf16(v1[0], v1[1]); pk.w = cvt_pk_bf16(v1[2], v1[3]);
              *reinterpret_cast<uint4*>(base + (ai * 128 + m * 16) * 1024 + bj * 128) = pk;
            }
          }
      });
}
DEV void phase_ln2(const Params& p, int layer) {
  const int tid = otid(), lane = tid & 63, wid = tid >> 6, nb = gridDim.x;
  const float* x1 = reinterpret_cast<const float*>(p.ws + REG_D);
  const u16* Ye = reinterpret_cast<const u16*>(p.ws + REG_B);
  const int* slot = reinterpret_cast<const int*>(p.ws + S_SLOT);
  float* x2 = reinterpret_cast<float*>(p.ws + REG_A);
  u16* x2b = reinterpret_cast<u16*>(p.ws + REG_A + 67108864ull);
  const float* g = p.ln2_g + layer * 1024; const float* bb = p.ln2_b + layer * 1024;
  for (int tok = blockIdx.x * 8 + wid; tok < TOK; tok += nb * 8) {
    const int b = tok >> 11;
    float4 v[4];
#pragma unroll
    for (int i = 0; i < 4; ++i) {
      float4 t = *reinterpret_cast<const float4*>(x1 + (long)tok * 1024 + i * 256 + lane * 4);
      v[i].x = DN_ALPHA * t.x; v[i].y = DN_ALPHA * t.y; v[i].z = DN_ALPHA * t.z; v[i].w = DN_ALPHA * t.w;
    }
    int myslot = (lane < 16) ? slot[(long)tok * 16 + lane] : -1;
    unsigned mask = (unsigned)__ballot(myslot >= 0);
    while (mask) {
      const int e = __builtin_ctz(mask);
      mask &= mask - 1;
      const int sidx = __builtin_amdgcn_readlane(myslot, e);
      const u16* yr = Ye + ((long)(e * 8 + b) * CAP + sidx) * 1024;
      uint2 t[4];
#pragma unroll
      for (int i = 0; i < 4; ++i) t[i] = *reinterpret_cast<const uint2*>(yr + i * 256 + lane * 4);
#pragma unroll
      for (int i = 0; i < 4; ++i) {
        v[i].x += __uint_as_float(t[i].x << 16); v[i].y += __uint_as_float(t[i].x & 0xffff0000u);
        v[i].z += __uint_as_float(t[i].y << 16); v[i].w += __uint_as_float(t[i].y & 0xffff0000u);
      }
    }
    float s = 0.f;
#pragma unroll
    for (int i = 0; i < 4; ++i) s += v[i].x + v[i].y + v[i].z + v[i].w;
    float mu = wave_sum(s) * (1.0f / 1024.0f);
    float q = 0.f;
#pragma unroll
    for (int i = 0; i < 4; ++i) { v[i].x -= mu; v[i].y -= mu; v[i].z -= mu; v[i].w -= mu; q += v[i].x * v[i].x + v[i].y * v[i].y + v[i].z * v[i].z + v[i].w * v[i].w; }
    float rstd = rsqrtf(wave_sum(q) * (1.0f / 1024.0f) + LN_EPS);
#pragma unroll
    for (int i = 0; i < 4; ++i) {
      int c = i * 256 + lane * 4;
      float4 gg = *reinterpret_cast<const float4*>(g + c), b4 = *reinterpret_cast<const float4*>(bb + c);
      float4 y;
      y.x = v[i].x * rstd * gg.x + b4.x; y.y = v[i].y * rstd * gg.y + b4.y; y.z = v[i].z * rstd * gg.z + b4.z; y.w = v[i].w * rstd * gg.w + b4.w;
      *reinterpret_cast<float4*>(x2 + (long)tok * 1024 + c) = y;
      uint2 pk; pk.x = pack2(y.x, y.y); pk.y = pack2(y.z, y.w);
      *reinterpret_cast<uint2*>(x2b + (long)tok * 1024 + c) = pk;
    }
  }
}
DEV void phase_ple(const Params& p, int layer, float* outf, u16* outb) {
  const float* x2 = reinterpret_cast<const float*>(p.ws + REG_A);
  const u16* x2b = reinterpret_cast<const u16*>(p.ws + REG_A + 67108864ull);
  const u16* pb = reinterpret_cast<const u16*>(p.ws + REG_P) + (long)layer * TOK * 256;
  const u16* wg = reinterpret_cast<const u16*>(p.ws + W_PLEG) + (long)layer * 1024 * 1024;
  const u16* wp = reinterpret_cast<const u16*>(p.ws + W_PLEP) + (long)layer * 1024 * 256;
  float* pp = reinterpret_cast<float*>(p.ws + REG_C);
  gemm_phase<true, false>(256, 64, 4, [&](const Unit& u, const char*& a, const char*& b) { a = (const char*)(pb) + (size_t)u.pm * 256 * (256) * 2; b = (const char*)(wp) + (size_t)u.pn * 256 * (256) * 2; },
      [&](Acc8& acc, const Unit& u, int wr, int wc, int fr, int fq) {
        const long o0 = (long)(u.pm * 256 + wr * 64 + fr) * 1024 + u.pn * 256 + wc * 32 + 4 * fq;
        E8_FOR {
#pragma unroll
          for (int n = 0; n < 2; ++n)
            *reinterpret_cast<f32x4*>(pp + o0 + (ai * 128 + m * 16) * 1024 + bj * 128 + n * 16) = acc[ai][bj][m][n];
        }
      });
  gemm_phase<true, false>(1024, 64, 4, [&](const Unit& u, const char*& a, const char*& b) { a = (const char*)(x2b) + (size_t)u.pm * 256 * (1024) * 2; b = (const char*)(wg) + (size_t)u.pn * 256 * (1024) * 2; },
      [&](Acc8& acc, const Unit& u, int wr, int wc, int fr, int fq) {
        const long o0 = (long)(u.pm * 256 + wr * 64 + fr) * 1024 + u.pn * 256 + wc * 32 + 4 * fq;
        E8_FOR {
#pragma unroll
          for (int n = 0; n < 2; ++n) {
            const long o = o0 + (ai * 128 + m * 16) * 1024 + bj * 128 + n * 16;
            f32x4 a = acc[ai][bj][m][n];
            f32x4 xv = *reinterpret_cast<const f32x4*>(x2 + o), pv = *reinterpret_cast<const f32x4*>(pp + o);
            f32x4 r;
#pragma unroll
            for (int j = 0; j < 4; ++j) r[j] = xv[j] + pv[j] / (1.0f + __expf(-a[j]));
            *reinterpret_cast<f32x4*>(outf + o) = r;
            if (outb) { uint2 pk; pk.x = cvt_pk_bf16(r[0], r[1]); pk.y = cvt_pk_bf16(r[2], r[3]); *reinterpret_cast<uint2*>(outb + o) = pk; }
          }
        }
      });
}
DEV void phase_mla_in(const Params& p) {
  const u16* xb = reinterpret_cast<const u16*>(p.ws + REG_X);
  const u16* wt = reinterpret_cast<const u16*>(p.ws + W_MLAIN);
  float* hm = reinterpret_cast<float*>(p.ws + REG_B);
  gemm_phase<true, false>(1024, 64, 3, [&](const Unit& u, const char*& a, const char*& b) { a = (const char*)(xb) + (size_t)u.pm * 256 * (1024) * 2; b = (const char*)(wt) + (size_t)u.pn * 256 * (1024) * 2; },
      [&](Acc8& acc, const Unit& u, int wr, int wc, int fr, int fq) {
        const long o0 = (long)(u.pm * 256 + wr * 64 + fr) * 768 + u.pn * 256 + wc * 32 + 4 * fq;
        E8_FOR {
#pragma unroll
          for (int n = 0; n < 2; ++n)
            *reinterpret_cast<f32x4*>(hm + o0 + (ai * 128 + m * 16) * 768 + bj * 128 + n * 16) = acc[ai][bj][m][n];
        }
      });
}
constexpr size_t MLA_Q = REG_A, MLA_K = REG_A + 50331648ull, MLA_VT = REG_A + 100663296ull;
constexpr size_t MLA_CQN = REG_B + 50331648ull, MLA_CKVN = MLA_CQN + 12582912ull, MLA_O = MLA_CKVN + 8388608ull;
DEV float rope_inv(int i) { return 1.0f / powf(10000.0f, (float)i / 16.0f); }
DEV void phase_mla_norm(const Params& p) {
  const int tid = otid(), lane = tid & 63, wid = tid >> 6, nb = gridDim.x;
  const float* hm = reinterpret_cast<const float*>(p.ws + REG_B);
  u16* cqn = reinterpret_cast<u16*>(p.ws + MLA_CQN);
  u16* ckvn = reinterpret_cast<u16*>(p.ws + MLA_CKVN);
  u16* Kb = reinterpret_cast<u16*>(p.ws + MLA_K);
  for (int tok = blockIdx.x * 8 + wid; tok < TOK; tok += nb * 8) {
    const float* row = hm + (long)tok * 768;
    float q[6], kv[4];
    float sq = 0.f, skv = 0.f;
#pragma unroll
    for (int i = 0; i < 6; ++i) { q[i] = row[i * 64 + lane]; sq += q[i] * q[i]; }
#pragma unroll
    for (int i = 0; i < 4; ++i) { kv[i] = row[384 + i * 64 + lane]; skv += kv[i] * kv[i]; }
    float rq = rsqrtf(wave_sum(sq) * (1.0f / 384.0f) + LN_EPS);
    float rkv = rsqrtf(wave_sum(skv) * (1.0f / 256.0f) + LN_EPS);
#pragma unroll
    for (int i = 0; i < 6; ++i) cqn[(long)tok * 384 + i * 64 + lane] = f2bf(q[i] * rq * p.mla_q_norm[i * 64 + lane]);
#pragma unroll
    for (int i = 0; i < 4; ++i) ckvn[(long)tok * 256 + i * 64 + lane] = f2bf(kv[i] * rkv * p.mla_kv_norm[i * 64 + lane]);
    const int b = tok >> 11, l = tok & 2047;
    float kr = (lane < 32) ? row[640 + lane] : 0.f;
    float x1 = __shfl(kr, lane & 15), x2 = __shfl(kr, (lane & 15) + 16);
    float sn, cs; sincosf((float)l * rope_inv(lane & 15), &sn, &cs);
    float r = (lane & 16) ? (x1 * sn + x2 * cs) : (x1 * cs - x2 * sn);
    u16 rb = f2bf(r);
    for (int hh = 0; hh < 16; hh += 2) {
      int h = hh + (lane >> 5);
      u16 val = (u16)__shfl((int)rb, lane & 31);
      Kb[(((long)b * 16 + h) * SEQ + l) * 96 + 64 + (lane & 31)] = val;
    }
  }
}
DEV void phase_mla_up(const Params& p) {
  const u16* cqn = reinterpret_cast<const u16*>(p.ws + MLA_CQN);
  const u16* ckvn = reinterpret_cast<const u16*>(p.ws + MLA_CKVN);
  const u16* wq = reinterpret_cast<const u16*>(p.ws + W_QUP);
  const u16* wkv = reinterpret_cast<const u16*>(p.ws + W_KVUP);
  u16* Qb = reinterpret_cast<u16*>(p.ws + MLA_Q);
  u16* Kb = reinterpret_cast<u16*>(p.ws + MLA_K);
  u16* VT = reinterpret_cast<u16*>(p.ws + MLA_VT);
  const float qscale = 0.10206207261596577f * 1.4426950408889634f;
  gemm_phase<true, false>(384, 64, 6, [&](const Unit& u, const char*& a, const char*& b) { a = (const char*)(cqn) + (size_t)u.pm * 256 * (384) * 2; b = (const char*)(wq) + (size_t)u.pn * 256 * (384) * 2; },
      [&](Acc8& acc, const Unit& u, int wr, int wc, int fr, int fq) {
#pragma unroll
        for (int bj = 0; bj < 2; ++bj) {
          const int c32 = (u.pn * 256 + bj * 128 + wc * 32) >> 5;
          const int h = c32 / 3, part = c32 % 3;
#pragma unroll
          for (int ai = 0; ai < 2; ++ai)
#pragma unroll
            for (int m = 0; m < 4; ++m) {
              const int tok = u.pm * 256 + ai * 128 + wr * 64 + m * 16 + fr;
              const int b = tok >> 11, l = tok & 2047;
              u16* qrow = Qb + (((long)b * 16 + h) * SEQ + l) * 96 + part * 32 + 4 * fq;
              f32x4 a0 = acc[ai][bj][m][0], a1 = acc[ai][bj][m][1];
              if (part == 2) {
#pragma unroll
                for (int j = 0; j < 4; ++j) {
                  float sn, cs; sincosf((float)l * rope_inv(4 * fq + j), &sn, &cs);
                  float r0 = a0[j] * cs - a1[j] * sn, r1 = a0[j] * sn + a1[j] * cs;
                  a0[j] = r0; a1[j] = r1;
                }
              }
              uint2 p0, p1;
              p0.x = cvt_pk_bf16(a0[0] * qscale, a0[1] * qscale); p0.y = cvt_pk_bf16(a0[2] * qscale, a0[3] * qscale);
              p1.x = cvt_pk_bf16(a1[0] * qscale, a1[1] * qscale); p1.y = cvt_pk_bf16(a1[2] * qscale, a1[3] * qscale);
              *reinterpret_cast<uint2*>(qrow) = p0;
              *reinterpret_cast<uint2*>(qrow + 16) = p1;
            }
        }
      });
  gemm_phase<true, true>(256, 64, 4, [&](const Unit& u, const char*& a, const char*& b) { a = (const char*)(ckvn) + (size_t)u.pm * 256 * (256) * 2; b = (const char*)(wkv) + (size_t)u.pn * 256 * (256) * 2; },
      [&](Acc8& acc, const Unit& u, int wr, int wc, int fr, int fq) {
        E8_FOR {
          const int tok = u.pm * 256 + ai * 128 + wr * 64 + m * 16 + fr;
          const int b = tok >> 11, l = tok & 2047;
          const int col = u.pn * 256 + bj * 128 + wc * 32 + 8 * fq;
          const int h = col >> 6, d = col & 63;
          f32x4 v0 = acc[ai][bj][m][0], v1 = acc[ai][bj][m][1];
          uint4 pk;
          pk.x = cvt_pk_bf16(v0[0], v0[1]); pk.y = cvt_pk_bf16(v0[2], v0[3]); pk.z = cvt_pk_bf16(v1[0], v1[1]); pk.w = cvt_pk_bf16(v1[2], v1[3]);
          *reinterpret_cast<uint4*>(Kb + (((long)b * 16 + h) * SEQ + l) * 96 + d) = pk;
        }
      });
  gemm_phase<false, false>(256, 64, 4, [&](const Unit& u, const char*& a, const char*& b) { a = (const char*)(ckvn) + (size_t)u.pm * 256 * (256) * 2; b = (const char*)(wkv + 1024 * 256) + (size_t)u.pn * 256 * (256) * 2; },
      [&](Acc8& acc, const Unit& u, int wr, int wc, int fr, int fq) {
        E8_FOR {
          const int tok = u.pm * 256 + ai * 128 + wr * 64 + m * 16 + 4 * fq;
          const int b = tok >> 11, l = tok & 2047;
#pragma unroll
          for (int n = 0; n < 2; ++n) {
            const int col = u.pn * 256 + bj * 128 + wc * 32 + n * 16 + fr;
            const int h = col >> 6, d = col & 63;
            f32x4 v = acc[ai][bj][m][n];
            uint2 pk; pk.x = cvt_pk_bf16(v[0], v[1]); pk.y = cvt_pk_bf16(v[2], v[3]);
            *reinterpret_cast<uint2*>(VT + (((long)b * 16 + h) * 64 + d) * SEQ + l) = pk;
          }
        }
      });
}
constexpr int KST = 104, VST = 68;
DEV void mla_attn_unit(const Params& p, int u) {
  const int tid = otid(), lane = tid & 63, wid = tid >> 6, fr = lane & 15, fq = lane >> 4;
  const int qb = u & 7, bh = u >> 3;
  const u16* Qb = reinterpret_cast<const u16*>(p.ws + MLA_Q) + (long)bh * SEQ * 96;
  const u16* Kb = reinterpret_cast<const u16*>(p.ws + MLA_K) + (long)bh * SEQ * 96;
  const u16* VT = reinterpret_cast<const u16*>(p.ws + MLA_VT) + (long)bh * 64 * SEQ;
  u16* O = reinterpret_cast<u16*>(p.ws + MLA_O);
  u16* kl = reinterpret_cast<u16*>(smem);
  u16* vl = kl + 2 * 64 * KST;
  bf16x8 qf[2][3];
#pragma unroll
  for (int qt = 0; qt < 2; ++qt)
#pragma unroll
    for (int ks = 0; ks < 3; ++ks)
      qf[qt][ks] = *reinterpret_cast<const bf16x8*>(Qb + (long)(qb * 256 + wid * 32 + qt * 16 + fr) * 96 + ks * 32 + fq * 8);
  f32x4 o[4][2];
#pragma unroll
  for (int dt = 0; dt < 4; ++dt)
#pragma unroll
    for (int qt = 0; qt < 2; ++qt) o[dt][qt] = f32x4{0.f, 0.f, 0.f, 0.f};
  float mrun[2] = {-1e30f, -1e30f}, lrun[2] = {0.f, 0.f};
  const int kc0 = tid, kc1 = 512 + tid;
  const int vd = tid >> 3, vpart = tid & 7;
  uint4 kr0, kr1 = make_uint4(0, 0, 0, 0), vr;
  auto gload = [&](int t) {
    const u16* kt = Kb + (long)t * 64 * 96;
    kr0 = *reinterpret_cast<const uint4*>(kt + kc0 * 8);
    if (tid < 256) kr1 = *reinterpret_cast<const uint4*>(kt + kc1 * 8);
    vr = *reinterpret_cast<const uint4*>(VT + (long)vd * SEQ + t * 64 + vpart * 8);
  };
  auto lstore = [&](int buf) {
    u16* kd = kl + buf * 64 * KST; u16* vdst = vl + buf * 64 * VST;
    *reinterpret_cast<uint4*>(kd + (kc0 / 12) * KST + (kc0 % 12) * 8) = kr0;
    if (tid < 256) *reinterpret_cast<uint4*>(kd + (kc1 / 12) * KST + (kc1 % 12) * 8) = kr1;
    *reinterpret_cast<uint2*>(vdst + vd * VST + vpart * 8) = make_uint2(vr.x, vr.y);
    *reinterpret_cast<uint2*>(vdst + vd * VST + vpart * 8 + 4) = make_uint2(vr.z, vr.w);
  };
  __syncthreads();
  gload(0); lstore(0);
  __syncthreads();
  for (int t = 0; t < 32; ++t) {
    const int cur = t & 1;
    if (t + 1 < 32) gload(t + 1);
    const u16* kd = kl + cur * 64 * KST; const u16* vdl = vl + cur * 64 * VST;
    f32x4 s[4][2];
#pragma unroll
    for (int kt = 0; kt < 4; ++kt) {
      bf16x8 kf[3];
#pragma unroll
      for (int ks = 0; ks < 3; ++ks) kf[ks] = *reinterpret_cast<const bf16x8*>(kd + (kt * 16 + fr) * KST + ks * 32 + fq * 8);
#pragma unroll
      for (int qt = 0; qt < 2; ++qt) {
        f32x4 a = {0.f, 0.f, 0.f, 0.f};
#pragma unroll
        for (int ks = 0; ks < 3; ++ks) a = __builtin_amdgcn_mfma_f32_16x16x32_bf16(kf[ks], qf[qt][ks], a, 0, 0, 0);
        s[kt][qt] = a;
      }
    }
    bf16x8 pf[2][2];
#pragma unroll
    for (int qt = 0; qt < 2; ++qt) {
      float tm = -1e30f;
#pragma unroll
      for (int kt = 0; kt < 4; ++kt)
#pragma unroll
        for (int j = 0; j < 4; ++j) tm = fmaxf(tm, s[kt][qt][j]);
      tm = fmaxf(tm, __shfl_xor(tm, 16));
      tm = fmaxf(tm, __shfl_xor(tm, 32));
      const float mn = fmaxf(mrun[qt], tm);
      const float alpha = exp2f(mrun[qt] - mn);
      mrun[qt] = mn;
      float ls = 0.f;
#pragma unroll
      for (int kt = 0; kt < 4; ++kt)
#pragma unroll
        for (int j = 0; j < 4; ++j) { float e = exp2f(s[kt][qt][j] - mn); s[kt][qt][j] = e; ls += e; }
      lrun[qt] = lrun[qt] * alpha + ls;
#pragma unroll
      for (int dt = 0; dt < 4; ++dt) { o[dt][qt][0] *= alpha; o[dt][qt][1] *= alpha; o[dt][qt][2] *= alpha; o[dt][qt][3] *= alpha; }
#pragma unroll
      for (int k2 = 0; k2 < 2; ++k2) {
        union { bf16x8 v; unsigned u[4]; } t_;
        t_.u[0] = pack2(s[2 * k2][qt][0], s[2 * k2][qt][1]); t_.u[1] = pack2(s[2 * k2][qt][2], s[2 * k2][qt][3]);
        t_.u[2] = pack2(s[2 * k2 + 1][qt][0], s[2 * k2 + 1][qt][1]); t_.u[3] = pack2(s[2 * k2 + 1][qt][2], s[2 * k2 + 1][qt][3]);
        pf[k2][qt] = t_.v;
      }
    }
#pragma unroll
    for (int k2 = 0; k2 < 2; ++k2)
#pragma unroll
      for (int dt = 0; dt < 4; ++dt) {
        union { bf16x8 v; uint2 u[2]; } af;
        const u16* vp = vdl + (dt * 16 + fr) * VST + k2 * 32 + 4 * fq;
        af.u[0] = *reinterpret_cast<const uint2*>(vp);
        af.u[1] = *reinterpret_cast<const uint2*>(vp + 16);
#pragma unroll
        for (int qt = 0; qt < 2; ++qt) o[dt][qt] = __builtin_amdgcn_mfma_f32_16x16x32_bf16(af.v, pf[k2][qt], o[dt][qt], 0, 0, 0);
      }
    if (t + 1 < 32) lstore(cur ^ 1);
    __syncthreads();
  }
  const int b = bh >> 4, h = bh & 15;
#pragma unroll
  for (int qt = 0; qt < 2; ++qt) {
    float l = lrun[qt];
    l += __shfl_xor(l, 16);
    l += __shfl_xor(l, 32);
    const float inv = 1.0f / l;
    const long tok = (long)b * SEQ + qb * 256 + wid * 32 + qt * 16 + fr;
#pragma unroll
    for (int dt = 0; dt < 4; ++dt) {
      uint2 pk; pk.x = pack2(o[dt][qt][0] * inv, o[dt][qt][1] * inv); pk.y = pack2(o[dt][qt][2] * inv, o[dt][qt][3] * inv);
      *reinterpret_cast<uint2*>(O + tok * 1024 + h * 64 + dt * 16 + 4 * fq) = pk;
    }
  }
}
DEV void phase_mla_attn(const Params& p) {
  const int nb = gridDim.x;
  for (int u = blockIdx.x; u < NBATCH * 16 * 8; u += nb) mla_attn_unit(p, u);
}

#ifndef ONLY
#define ONLY -1
#endif
#define PH(n, ...) if (ONLY < 0 || ONLY == n) { __VA_ARGS__; }
constexpr int LDS_BAR_OFF = 132096;
__global__ void __launch_bounds__(512) mega(Params p) {
  cg::grid_group grid = cg::this_grid();
  unsigned* barw = reinterpret_cast<unsigned*>(p.ws + S_BAR);
  if (blockIdx.x == 0) for (int i = threadIdx.x; i < XCD_BAR_WORDS; i += 512) barw[i] = 0u;
  if (threadIdx.x == 0) *reinterpret_cast<uint4*>(smem + LDS_BAR_OFF) = make_uint4(0u, 0u, 0u, 0u);
  PH(0, phase_prep(p));
  grid.sync();
  XcdBarrier xb = xcd_barrier_post(barw, (volatile LAS unsigned*)(smem + LDS_BAR_OFF));
#define GSYNC() xcd_barrier(xb)
  PH(1, phase_abin(p)); GSYNC();
  PH(2, phase_mix0(p)); GSYNC();
  PH(2, phase_ztrans(p)); GSYNC();
  PH(3, phase_outproj(p, reinterpret_cast<const u16*>(p.ws + REG_A + 100663296ull), reinterpret_cast<const u16*>(p.ws + W_ABOUT), p.x)); GSYNC();
  for (int layer = 0; layer < 2; ++layer) {
    if (layer == 1) {
      PH(10, phase_mla_in(p)); GSYNC();
      PH(11, phase_mla_norm(p)); GSYNC();
      PH(12, phase_mla_up(p)); GSYNC();
      PH(13, phase_mla_attn(p)); GSYNC();
      PH(3, phase_outproj(p, reinterpret_cast<const u16*>(p.ws + MLA_O), reinterpret_cast<const u16*>(p.ws + W_MLAOUT), reinterpret_cast<const float*>(p.ws + REG_G))); GSYNC();
    }
    PH(4, phase_ln1_router(p, layer)); GSYNC();
    PH(5, phase_topk(p)); GSYNC();
    PH(6, phase_moe1(p, layer)); GSYNC();
    PH(7, phase_moe2(p, layer)); GSYNC();
    PH(8, phase_ln2(p, layer)); GSYNC();
    PH(9, phase_ple(p, layer, layer ? p.out : reinterpret_cast<float*>(p.ws + REG_G), layer ? nullptr : reinterpret_cast<u16*>(p.ws + REG_X)));
    if (layer == 0) GSYNC();
  }
}

static void add_job(Params& P, int& nj, int& tile, const float* src, u16* dst, int K, int N, int rsh, int rs, int off, int count, long sstride, long dstride) {
  ConvJob& J = P.jobs[nj++];
  J.src = src; J.dst = dst; J.sstride = sstride; J.dstride = dstride; J.K = K; J.N = N; J.rs = rs; J.off = off; J.rsh = rsh;
  J.ntn = (N + 255) / 256; J.tpm = (K / 64) * J.ntn; J.tile0 = tile; J.ntiles = J.tpm * count;
  tile += J.ntiles;
}

extern "C" void kernel_launch(void* const* d_in, const int* in_sizes, int n_in,
                              void* d_out, int out_size, void* d_ws, size_t ws_size,
                              hipStream_t stream) {
  constexpr size_t kDynLds = 132096 + 16;
  static int grid_blocks = 0;
  if (!grid_blocks) {
    int dev = 0, cus = 0, per_cu = 0;
    (void)hipGetDevice(&dev);
    (void)hipDeviceGetAttribute(&cus, hipDeviceAttributeMultiprocessorCount, dev);
    (void)hipFuncSetAttribute((const void*)mega, hipFuncAttributeMaxDynamicSharedMemorySize, (int)kDynLds);
    (void)hipOccupancyMaxActiveBlocksPerMultiprocessor(&per_cu, mega, 512, kDynLds);
    if (per_cu > 1) per_cu = 1;
    if (per_cu < 1) { fprintf(stderr, "occupancy query returned 0\n"); per_cu = 1; }
    grid_blocks = cus * per_cu;
    if (ws_size < WS_TOTAL) fprintf(stderr, "workspace too small: %zu < %zu\n", ws_size, (size_t)WS_TOTAL);
  }
  Params P;
  memset(&P, 0, sizeof(P));
  auto F = [&](int i) { return (const float*)d_in[i]; };
  char* ws = (char*)d_ws;
  P.x = F(0); P.p = F(1);
  P.na_rpb = F(3); P.hy_conv_w = F(4); P.hy_conv_b = F(5);
  P.hy_f_w1 = F(6); P.hy_f_b1 = F(7); P.hy_f_freq = F(8); P.hy_f_w2 = F(9); P.hy_f_b2 = F(10); P.hy_f_w3 = F(11); P.hy_skip = F(12);
  P.mla_q_norm = F(15); P.mla_kv_norm = F(17);
  P.ln1_g = F(20); P.ln1_b = F(21); P.ln2_g = F(22); P.ln2_b = F(23);
  P.moe_router = F(24);
  P.out = (float*)d_out; P.ws = ws;
  int nj = 0, tile = 0;
  add_job(P, nj, tile, F(2), (u16*)(ws + W_ABIN), 1024, 3072, 7, 128, 0, 1, 0, 0);
  add_job(P, nj, tile, F(13), (u16*)(ws + W_ABOUT), 1024, 1024, 7, 128, 0, 1, 0, 0);
  add_job(P, nj, tile, F(14), (u16*)(ws + W_MLAIN), 1024, 672, 7, 128, 0, 1, 0, 0);
  add_job(P, nj, tile, F(16), (u16*)(ws + W_QUP), 384, 1536, 7, 128, 0, 1, 0, 0);
  add_job(P, nj, tile, F(18), (u16*)(ws + W_KVUP), 256, 2048, 6, 64, 0, 1, 0, 0);
  P.jobs[nj - 1].sh2 = 1; P.jobs[nj - 1].off2 = 1024;
  add_job(P, nj, tile, F(19), (u16*)(ws + W_MLAOUT), 1024, 1024, 7, 128, 0, 1, 0, 0);
  add_job(P, nj, tile, F(28), (u16*)(ws + W_PLEG), 1024, 1024, 7, 128, 0, 2, 1024L * 1024, 1024L * 1024);
  add_job(P, nj, tile, F(29), (u16*)(ws + W_PLEP), 256, 1024, 7, 128, 0, 2, 256L * 1024, 1024L * 256);
  add_job(P, nj, tile, F(25), (u16*)(ws + W_GU), 1024, 2048, 7, 256, 0, 32, 1024L * 2048, 4096L * 1024);
  add_job(P, nj, tile, F(26), (u16*)(ws + W_GU), 1024, 2048, 7, 256, 128, 32, 1024L * 2048, 4096L * 1024);
  add_job(P, nj, tile, F(27), (u16*)(ws + W_DN), 2048, 1024, 7, 128, 0, 32, 2048L * 1024, 1024L * 2048);
  P.conv_total = tile;
  void* args[] = {&P};
  hipError_t e = hipLaunchCooperativeKernel((void*)mega, dim3(grid_blocks), dim3(512), args, kDynLds, stream);
  if (e != hipSuccess) fprintf(stderr, "cooperative launch failed: %s (grid %d)\n", hipGetErrorString(e), grid_blocks);
}
```

```cpp
#include <hip/hip_runtime.h>
#include <hip/hip_bf16.h>
#include <hip/hip_cooperative_groups.h>
#include <cstdio>
#include <cstring>
namespace cg = cooperative_groups;

typedef unsigned short u16;
using bf16x8 = __attribute__((ext_vector_type(8))) short;
using bf16x4 = __attribute__((ext_vector_type(4))) short;
using f32x4 = __attribute__((ext_vector_type(4))) float;
#define DEV __device__ __forceinline__

constexpr int TOK = 16384, DM = 1024, SEQ = 2048, NBATCH = 8;
constexpr int NEXP = 16, CAP = 256, DFF = 2048;
constexpr float DN_ALPHA = 1.4142135623730951f;
constexpr float LN_EPS = 1e-5f;

constexpr size_t W_ABIN = 0;
constexpr size_t W_ABOUT = W_ABIN + 3072ull * 1024 * 2;
constexpr size_t W_MLAIN = W_ABOUT + 1024ull * 1024 * 2;
constexpr size_t W_QUP = W_MLAIN + 768ull * 1024 * 2;
constexpr size_t W_KVUP = W_QUP + 1536ull * 384 * 2;
constexpr size_t W_MLAOUT = W_KVUP + 2048ull * 256 * 2;
constexpr size_t W_PLEG = W_MLAOUT + 1024ull * 1024 * 2;
constexpr size_t W_PLEP = W_PLEG + 2 * 1024ull * 1024 * 2;
constexpr size_t W_GU = W_PLEP + 2 * 1024ull * 256 * 2;
constexpr size_t W_DN = W_GU + 2 * 16ull * 4096 * 1024 * 2;
constexpr size_t REG_A = W_DN + 2 * 16ull * 1024 * 2048 * 2;
constexpr size_t REG_B = REG_A + 134217728ull;
constexpr size_t REG_C = REG_B + 134217728ull;
constexpr size_t REG_D = REG_C + 67108864ull;
constexpr size_t REG_E = REG_D + 67108864ull;
constexpr size_t REG_G = REG_E + 33554432ull;
constexpr size_t REG_X = REG_G + 67108864ull;
constexpr size_t REG_P = REG_X + 33554432ull;
constexpr size_t S_AFF = REG_P + 16777216ull;
constexpr size_t S_IDX = S_AFF + 1048576ull;
constexpr size_t S_GSEL = S_IDX + 131072ull;
constexpr size_t S_SLOT = S_GSEL + 131072ull;
constexpr size_t S_H2 = S_SLOT + 1048576ull;
constexpr size_t S_RG = S_H2 + 524288ull;
constexpr size_t S_BAR = S_RG + 8388608ull;
constexpr size_t WS_TOTAL = S_BAR + 16384ull;

struct ConvJob {
  const float* src; u16* dst;
  long sstride, dstride;
  int K, N;
  int rs, off;
  int rsh, sh2, off2, padj;
  int ntn;
  int tpm;
  int tile0, ntiles;
};
constexpr int NJOBS = 16;

struct Params {
  const float* x; const float* p;
  const float* na_rpb; const float* hy_conv_w; const float* hy_conv_b;
  const float* hy_f_w1; const float* hy_f_b1; const float* hy_f_freq; const float* hy_f_w2; const float* hy_f_b2;
  const float* hy_f_w3; const float* hy_skip;
  const float* mla_q_norm; const float* mla_kv_norm;
  const float* ln1_g; const float* ln1_b; const float* ln2_g; const float* ln2_b;
  const float* moe_router;
  float* out; char* ws;
  int conv_total; int pad0;
  ConvJob jobs[NJOBS];
};

extern __shared__ __attribute__((aligned(16))) char smem[];

typedef __bf16 bf16x2_t __attribute__((ext_vector_type(2)));
typedef float f32x2_t __attribute__((ext_vector_type(2)));
DEV unsigned cvt_pk_bf16(float lo, float hi) { f32x2_t f = {lo, hi}; bf16x2_t b = __builtin_convertvector(f, bf16x2_t); return __builtin_bit_cast(unsigned, b); }
DEV u16 f2bf(float f) { return (u16)(cvt_pk_bf16(f, 0.f) & 0xffffu); }
DEV float bf2f(u16 h) { return __uint_as_float(((unsigned)h) << 16); }
DEV unsigned pack2(float a, float b) { return cvt_pk_bf16(a, b); }
DEV float wave_sum(float v) {
#pragma unroll
  for (int o = 32; o > 0; o >>= 1) v += __shfl_xor(v, o);
  return v;
}
DEV int otid() { int t = threadIdx.x; asm volatile("" : "+v"(t)); return t; }
DEV int vstart() {
  int nb = gridDim.x, b = blockIdx.x;
  return (nb % 8 == 0) ? (b % 8) * (nb / 8) + b / 8 : b;
}


#define XB_TMO      128
#define XB_XCNT(j)  (256  + 64 * (j))
#define XB_XSUB(j)  (1280 + 64 * (j))
#define XB_XGEN(j)  (2304 + 64 * (j))
#define XB_TOP      3328
#define XB_TOPGEN   3392
#define XCD_BAR_WORDS 3456
#define XB_SPIN_CAP (1u << 18)
#define LAS __attribute__((address_space(3)))
DEV unsigned xb_ld(unsigned* p) { return __hip_atomic_load(p, __ATOMIC_RELAXED, __HIP_MEMORY_SCOPE_AGENT); }
DEV unsigned xb_add(unsigned* p, unsigned v) { return __hip_atomic_fetch_add(p, v, __ATOMIC_RELAXED, __HIP_MEMORY_SCOPE_AGENT); }
DEV unsigned xb_xcc_id() { return (unsigned)__builtin_amdgcn_s_getreg((3 << 11) | 20) & 0xFu; }
#define XB_SPIN(cond, bar) do { unsigned _sp = 0; while (cond) { __builtin_amdgcn_s_sleep(1); \
    if ((++_sp & 255u) == 0u) { if (xb_ld(&(bar)[XB_TMO])) break; if (_sp > XB_SPIN_CAP) { atomicAdd(&(bar)[XB_TMO], 1u); break; } } } } while (0)
struct XcdBarrier { unsigned* bar; unsigned x; volatile LAS unsigned* st; };
DEV XcdBarrier xcd_barrier_post(unsigned* bar, volatile LAS unsigned* st) {
  XcdBarrier b; b.bar = bar; b.x = xb_xcc_id(); b.st = st;
  if (threadIdx.x == 0) (void)xb_add(&bar[XB_XCNT(b.x)], 1u);
  return b;
}
DEV void xcd_barrier_complete(unsigned* bar, unsigned x, unsigned& nloc, unsigned& nx) {
  const unsigned G = gridDim.x * gridDim.y * gridDim.z;
  unsigned sum, cnt, mine, sp = 0u;
  for (;;) {
    sum = 0u; cnt = 0u; mine = 0u;
#pragma unroll
    for (unsigned j = 0; j < 16; ++j) { const unsigned c = xb_ld(&bar[XB_XCNT(j)]); sum += c; cnt += (c > 0u) ? 1u : 0u; mine = (j == x) ? c : mine; }
    if (sum == G) break;
    __builtin_amdgcn_s_sleep(1);
    if ((++sp & 255u) == 0u) { if (xb_ld(&bar[XB_TMO])) break; if (sp > XB_SPIN_CAP) { atomicAdd(&bar[XB_TMO], 1u); break; } }
  }
  nloc = mine > 0u ? mine : 1u; nx = cnt > 0u ? cnt : 1u;
}
DEV void xcd_barrier(const XcdBarrier& b) {
  asm volatile("s_waitcnt vmcnt(0)" ::: "memory");
  __syncthreads();
  if (threadIdx.x == 0) {
    unsigned* bar = b.bar;
    __builtin_amdgcn_s_waitcnt(0);
    unsigned nloc = b.st[0], nx = b.st[1];
    if (nloc == 0u) { xcd_barrier_complete(bar, b.x, nloc, nx); b.st[0] = nloc; b.st[1] = nx; }
    const unsigned old = xb_add(&bar[XB_XSUB(b.x)], 1u);
    const unsigned gen = old / nloc;
    if (old + 1u == (gen + 1u) * nloc) {
      __builtin_amdgcn_fence(__ATOMIC_RELEASE, "agent");
      asm volatile("s_waitcnt vmcnt(0)" ::: "memory");
      const unsigned og = xb_add(&bar[XB_TOP], 1u);
      const unsigned tg = og / nx;
      if (og + 1u == (tg + 1u) * nx) xb_add(&bar[XB_TOPGEN], 1u);
      else XB_SPIN(xb_ld(&bar[XB_TOPGEN]) == tg, bar);
      __builtin_amdgcn_fence(__ATOMIC_ACQUIRE, "agent");
      xb_add(&bar[XB_XGEN(b.x)], 1u);
      asm volatile("s_waitcnt vmcnt(0)" ::: "memory");
    } else {
      XB_SPIN(xb_ld(&bar[XB_XGEN(b.x)]) == gen, bar);
      __builtin_amdgcn_fence(__ATOMIC_ACQUIRE, "agent");
      asm volatile("s_waitcnt vmcnt(0)" ::: "memory");
    }
  }
  __syncthreads();
}

DEV int lds_byte(int r, int c) {
  int st = (r >> 4) * 2 + (c >> 5), rr = r & 15, cc = c & 31, ob = rr * 64 + cc * 2;
  return st * 1024 + (ob ^ (((ob >> 9) & 1) << 5));
}
DEV void stage_rc(int b, int& R, int& C) {
  int st = b / 1024, sb = b % 1024, swz = sb ^ (((sb >> 9) & 1) << 5);
  R = (st >> 1) * 16 + swz / 64; C = (st & 1) * 32 + (swz % 64) / 2;
}
#define GLDS16(g, l) __builtin_amdgcn_global_load_lds((const unsigned*)(g), (unsigned*)(l), 16, 0, 0)

typedef f32x4 Acc8[2][2][4][2];
constexpr int G8_BM = 256, G8_BK = 64, G8_HALF = 128, G8_HTB = G8_HALF * G8_BK * 2, G8_NXCD = 8, G8_WGM = 8;
DEV int perm32(int rho) { const int n = rho >> 4, i = rho & 15; return 8 * (i >> 2) + 4 * n + (i & 3); }
struct Unit { int pm, pn; };
DEV bool unit_next(int i, int nM, int nN, Unit& u) {
  const int nwg = nM * nN;
  const long L = (long)i * gridDim.x + blockIdx.x; if (L >= nwg) return false;
  int wgid = (int)L; { const int q = nwg / G8_NXCD, r = nwg % G8_NXCD, xcd = wgid % G8_NXCD, off = wgid / G8_NXCD; wgid = (xcd < r ? xcd * (q + 1) : r * (q + 1) + (xcd - r) * q) + off; }
  const int nig = G8_WGM * nN, gid = wgid / nig, fm = gid * G8_WGM, gsz = (nM - fm) < G8_WGM ? (nM - fm) : G8_WGM;
  u.pm = fm + ((wgid % nig) % gsz); u.pn = (wgid % nig) / gsz; return true;
}
template <bool TR, bool PERM, class PF, class EF>
DEV void gemm_phase(const int K, const int nM, const int nN, PF ptrs, EF E) {
  LAS unsigned char* lds = (LAS unsigned char*)smem;
  const int tid = otid(), wid = __builtin_amdgcn_readfirstlane(tid >> 6), lane = tid & 63, wr = wid >> 2, wc = wid & 3, fr = lane & 15, fq = lane >> 4;
  const int nt = K / G8_BK;
  unsigned voffA[2], voffB[2];
#pragma unroll
  for (int i = 0; i < 2; ++i) { int R, C; stage_rc(tid * 16 + i * 8192, R, C); const int Rb = PERM ? ((R & ~31) + perm32(R & 31)) : R;
    voffA[i] = (unsigned)(R * K + C) * 2u; voffB[i] = (unsigned)(Rb * K + C) * 2u; }
  const size_t kstep = (size_t)(G8_BK * 2);
  const size_t hstep = (size_t)G8_HALF * K * 2;
  const unsigned ldsw = (unsigned)wid * 1024u;
  const int aoff = lds_byte(wr * 64 + fr, fq * 8), boff = lds_byte(wc * 32 + fr, fq * 8);
#define PG8_SA(b, h) (((b) * 2 + (h)) * G8_HTB)
#define PG8_SB(b, h) ((4 + (b) * 2 + (h)) * G8_HTB)
#define PG8_STAGE(bufoff, gbase, voff) do { _Pragma("unroll") for (int _i = 0; _i < 2; ++_i) \
    __builtin_amdgcn_global_load_lds((const unsigned*)((const char*)(gbase) + (voff)[_i]), (LAS unsigned*)(lds + (bufoff) + ldsw + _i * 8192), 16, 0, 0); } while (0)
#define PG8_LDA(dst, b, h) do { _Pragma("unroll") for (int m = 0; m < 4; ++m) _Pragma("unroll") for (int k = 0; k < 2; ++k) dst[m][k] = *(const LAS bf16x8*)(lds + PG8_SA(b, h) + aoff + m * 2048 + k * 1024); } while (0)
#define PG8_LDB(dst, b, h) do { _Pragma("unroll") for (int n = 0; n < 2; ++n) _Pragma("unroll") for (int k = 0; k < 2; ++k) dst[n][k] = *(const LAS bf16x8*)(lds + PG8_SB(b, h) + boff + n * 2048 + k * 1024); } while (0)
#define PG8_MMA(ai, bj, At, Bt) do { __builtin_amdgcn_s_setprio(1); _Pragma("unroll") for (int m = 0; m < 4; ++m) _Pragma("unroll") for (int n = 0; n < 2; ++n) _Pragma("unroll") for (int k = 0; k < 2; ++k) \
    acc[ai][bj][m][n] = TR ? __builtin_amdgcn_mfma_f32_16x16x32_bf16(Bt[n][k], At[m][k], acc[ai][bj][m][n], 0, 0, 0) \
                           : __builtin_amdgcn_mfma_f32_16x16x32_bf16(At[m][k], Bt[n][k], acc[ai][bj][m][n], 0, 0, 0); __builtin_amdgcn_s_setprio(0); } while (0)
#define PG8_WAIT_V(n) asm volatile("s_waitcnt vmcnt(" #n ")" ::: "memory")
#define PG8_WAIT_L(n) asm volatile("s_waitcnt lgkmcnt(" #n ")" ::: "memory")
#define PG8_BAR __builtin_amdgcn_s_barrier()
#define PG8_SCHED __builtin_amdgcn_sched_barrier(0)
  Unit cur, nxt; int ui = 0;
  if (!unit_next(0, nM, nN, cur)) return;
  Acc8 acc;
#pragma unroll
  for (int a = 0; a < 2; ++a)
#pragma unroll
    for (int b = 0; b < 2; ++b)
#pragma unroll
      for (int m = 0; m < 4; ++m)
#pragma unroll
        for (int n = 0; n < 2; ++n) acc[a][b][m][n] = f32x4{0.f, 0.f, 0.f, 0.f};
  bf16x8 At[4][2], B0[2][2], B1[2][2];
  const char* cA; const char* cB;
  ptrs(cur, cA, cB);
  PG8_STAGE(PG8_SB(0, 0), cB, voffB); PG8_STAGE(PG8_SA(0, 0), cA, voffA); PG8_STAGE(PG8_SB(0, 1), cB + hstep, voffB); PG8_STAGE(PG8_SA(0, 1), cA + hstep, voffA);
  if (wr == 1) PG8_BAR;
  PG8_WAIT_V(4); PG8_BAR;
  PG8_STAGE(PG8_SB(1, 0), cB + kstep, voffB); PG8_STAGE(PG8_SA(1, 0), cA + kstep, voffA); PG8_STAGE(PG8_SB(1, 1), cB + hstep + kstep, voffB);
  PG8_WAIT_V(6); PG8_BAR;
  for (;;) {
    const bool has_next = unit_next(ui + 1, nM, nN, nxt);
    const char* nA = cA; const char* nB = cB;
    if (has_next) ptrs(nxt, nA, nB);
#pragma unroll 1
    for (int t = 0; t < nt; t += 2) {
      const bool last = (t == nt - 2);
      const char* a1 = cA + (size_t)(t + 1) * kstep;
      const char* a2 = last ? nA : cA + (size_t)(t + 2) * kstep; const char* b2 = last ? nB : cB + (size_t)(t + 2) * kstep;
      const char* a3 = a2 + kstep; const char* b3 = b2 + kstep;
      PG8_LDB(B0, 0, 0); PG8_SCHED; PG8_LDA(At, 0, 0); PG8_STAGE(PG8_SA(1, 1), a1 + hstep, voffA);
      PG8_WAIT_L(8); PG8_BAR; PG8_WAIT_L(0); PG8_MMA(0, 0, At, B0); PG8_BAR; PG8_SCHED;
      PG8_LDB(B1, 0, 1); PG8_STAGE(PG8_SB(0, 0), b2, voffB);
      PG8_BAR; PG8_WAIT_L(0); PG8_MMA(0, 1, At, B1); PG8_BAR;
      PG8_LDA(At, 0, 1); PG8_STAGE(PG8_SA(0, 0), a2, voffA);
      PG8_BAR; PG8_WAIT_L(0); PG8_MMA(1, 0, At, B0); PG8_BAR; PG8_SCHED;
      PG8_STAGE(PG8_SB(0, 1), b2 + hstep, voffB);
      PG8_WAIT_V(6); PG8_BAR; PG8_MMA(1, 1, At, B1); PG8_BAR;
      PG8_LDB(B0, 1, 0); PG8_SCHED; PG8_LDA(At, 1, 0); PG8_STAGE(PG8_SA(0, 1), a2 + hstep, voffA);
      PG8_WAIT_L(8); PG8_BAR; PG8_WAIT_L(0); PG8_MMA(0, 0, At, B0); PG8_BAR; PG8_SCHED;
      PG8_LDB(B1, 1, 1); PG8_STAGE(PG8_SB(1, 0), b3, voffB);
      PG8_BAR; PG8_WAIT_L(0); PG8_MMA(0, 1, At, B1); PG8_BAR;
      PG8_LDA(At, 1, 1); PG8_STAGE(PG8_SA(1, 0), a3, voffA);
      PG8_BAR; PG8_WAIT_L(0); PG8_MMA(1, 0, At, B0); PG8_BAR; PG8_SCHED;
      PG8_STAGE(PG8_SB(1, 1), b3 + hstep, voffB);
      PG8_WAIT_V(6); PG8_BAR; PG8_MMA(1, 1, At, B1); PG8_BAR;
    }
    E(acc, cur, wr, wc, fr, fq);
    if (!has_next) break;
#pragma unroll
    for (int a = 0; a < 2; ++a)
#pragma unroll
      for (int b = 0; b < 2; ++b)
#pragma unroll
        for (int m = 0; m < 4; ++m)
#pragma unroll
          for (int n = 0; n < 2; ++n) acc[a][b][m][n] = f32x4{0.f, 0.f, 0.f, 0.f};
    cur = nxt; cA = nA; cB = nB; ++ui;
  }
  PG8_WAIT_V(0);
  if (wr == 0) PG8_BAR;
  PG8_BAR;
#undef PG8_SA
#undef PG8_SB
#undef PG8_STAGE
#undef PG8_LDA
#undef PG8_LDB
#undef PG8_MMA
#undef PG8_WAIT_V
#undef PG8_WAIT_L
#undef PG8_BAR
#undef PG8_SCHED
}
#define E8_FOR _Pragma("unroll") for (int ai = 0; ai < 2; ++ai) _Pragma("unroll") for (int m = 0; m < 4; ++m) _Pragma("unroll") for (int bj = 0; bj < 2; ++bj)

DEV void conv_tile(const ConvJob& J, int t) {
  const int tid = otid();
  int mat = t / J.tpm, tt = t % J.tpm;
  int kt = tt / J.ntn, nt = tt % J.ntn;
  const float* src = J.src + (long)mat * J.sstride;
  u16* dst = J.dst + (long)mat * J.dstride;
  const int kg = tid >> 6, ng = tid & 63;
  const int n = nt * 256 + ng * 4;
  float4 v[8];
#pragma unroll
  for (int j = 0; j < 8; ++j) {
    int k = kt * 64 + kg * 8 + j;
    if (n < J.N) v[j] = *reinterpret_cast<const float4*>(src + (long)k * J.N + n);
    else v[j] = make_float4(0.f, 0.f, 0.f, 0.f);
  }
#pragma unroll
  for (int i = 0; i < 4; ++i) {
    float e[8];
#pragma unroll
    for (int j = 0; j < 8; ++j) e[j] = (i == 0) ? v[j].x : (i == 1) ? v[j].y : (i == 2) ? v[j].z : v[j].w;
    uint4 pk;
    pk.x = pack2(e[0], e[1]); pk.y = pack2(e[2], e[3]); pk.z = pack2(e[4], e[5]); pk.w = pack2(e[6], e[7]);
    *reinterpret_cast<uint4*>(smem + (i * 64 + ng) * 144 + kg * 16) = pk;
  }
  __syncthreads();
#pragma unroll
  for (int u = 0; u < 4; ++u) {
    int q = tid + 512 * u;
    int nl = q >> 3, ch = q & 7;
    uint4 pk = *reinterpret_cast<const uint4*>(smem + ((nl & 3) * 64 + (nl >> 2)) * 144 + ch * 16);
    int nn = nt * 256 + nl;
    const int qq = nn >> J.rsh;
    long drow = (long)(qq >> J.sh2) * J.rs + (qq & ((1 << J.sh2) - 1)) * J.off2 + (nn & ((1 << J.rsh) - 1)) + J.off;
    *reinterpret_cast<uint4*>(dst + drow * J.K + kt * 64 + ch * 8) = pk;
  }
  __syncthreads();
}

DEV void phase_prep(const Params& p) {
  const int tid = otid(), nb = gridDim.x, bid = blockIdx.x;
  {
    float* zb = reinterpret_cast<float*>(smem);
    float* h1b = zb + 512;
    float* h2g = reinterpret_cast<float*>(p.ws + S_H2);
    const int w = tid >> 6, lane = tid & 63;
    for (int l0 = bid * 8; l0 < SEQ; l0 += nb * 8) {
      int l = l0 + w;
      float tt = (float)l / (float)(SEQ - 1);
      float ww = 6.283185307179586f * (float)l / (float)SEQ;
      float z = 0.f;
      if (lane == 0) z = tt;
      else if (lane <= 16) { float f = 1e-4f + (float)(lane - 1) * ((15.0f - 1e-4f) / 15.0f); z = cosf(f * ww); }
      else if (lane <= 32) { float f = 1e-4f + (float)(lane - 17) * ((15.0f - 1e-4f) / 15.0f); z = -sinf(f * ww); }
      zb[w * 64 + lane] = z;
      __syncthreads();
      float fr_ = p.hy_f_freq[lane];
      float a = p.hy_f_b1[lane];
      for (int k = 0; k < 33; ++k) a += zb[w * 64 + k] * p.hy_f_w1[k * 64 + lane];
      h1b[w * 64 + lane] = sinf(fr_ * a);
      __syncthreads();
      float a2 = p.hy_f_b2[lane];
      for (int k = 0; k < 64; ++k) a2 += h1b[w * 64 + k] * p.hy_f_w2[k * 64 + lane];
      h2g[l * 64 + lane] = sinf(fr_ * a2);
      __syncthreads();
    }
  }
  {
    u16* xb = reinterpret_cast<u16*>(p.ws + REG_X);
    const long n8 = (long)TOK * DM / 8;
    for (long i = (long)bid * 512 + tid; i < n8; i += (long)nb * 512) {
      float4 a = reinterpret_cast<const float4*>(p.x)[2 * i], b = reinterpret_cast<const float4*>(p.x)[2 * i + 1];
      uint4 pk; pk.x = pack2(a.x, a.y); pk.y = pack2(a.z, a.w); pk.z = pack2(b.x, b.y); pk.w = pack2(b.z, b.w);
      reinterpret_cast<uint4*>(xb)[i] = pk;
    }
    u16* pb = reinterpret_cast<u16*>(p.ws + REG_P);
    const long m8 = 2L * TOK * 256 / 8;
    for (long i = (long)bid * 512 + tid; i < m8; i += (long)nb * 512) {
      float4 a = reinterpret_cast<const float4*>(p.p)[2 * i], b = reinterpret_cast<const float4*>(p.p)[2 * i + 1];
      uint4 pk; pk.x = pack2(a.x, a.y); pk.y = pack2(a.z, a.w); pk.z = pack2(b.x, b.y); pk.w = pack2(b.z, b.w);
      reinterpret_cast<uint4*>(pb)[i] = pk;
    }
  }
  for (int t = bid; t < p.conv_total; t += nb) {
    int j = 0;
#pragma unroll 1
    for (int q = 1; q < NJOBS; ++q) if (t >= p.jobs[q].tile0 && p.jobs[q].ntiles > 0) j = q;
    conv_tile(p.jobs[j], t - p.jobs[j].tile0);
  }
}

DEV void filter_b(const Params& p, int cpair) {
  const int tid = otid();
  float* w3s = reinterpret_cast<float*>(smem);
  float* red = w3s + 512;
  float* nrm = red + 32;
  float* hb = nrm + 4;
  const float* h2g = reinterpret_cast<const float*>(p.ws + S_H2);
  {
    int ci = tid >> 6, k = tid & 63;
    int o = ci >> 2, d = (ci >> 1) & 1, cc = ci & 1;
    w3s[ci * 64 + k] = p.hy_f_w3[k * 2048 + o * 1024 + d * 512 + 2 * cpair + cc];
  }
  __syncthreads();
  const float min_decay = logf(1e-2f) / 1.5f, max_decay = logf(1e-2f) / 0.3f;
#pragma unroll 1
  for (int i = 0; i < 4; ++i) {
    int l = tid + 512 * i;
    float h2[64];
#pragma unroll
    for (int k = 0; k < 16; ++k) {
      float4 v = *reinterpret_cast<const float4*>(h2g + l * 64 + k * 4);
      h2[4 * k] = v.x; h2[4 * k + 1] = v.y; h2[4 * k + 2] = v.z; h2[4 * k + 3] = v.w;
    }
    float tt = (float)l / (float)(SEQ - 1);
#pragma unroll 1
    for (int ci = 0; ci < 8; ++ci) {
      float a = 0.f;
#pragma unroll
      for (int k = 0; k < 64; ++k) a += h2[k] * w3s[ci * 64 + k];
      int cc = ci & 1;
      int c = 2 * cpair + cc;
      float delta = fabsf(min_decay + (float)c * ((max_decay - min_decay) / 511.0f));
      a *= expf(-tt * delta);
      hb[ci * 2048 + l] = a;
    }
  }
  __syncthreads();
  {
    float ss[4];
#pragma unroll
    for (int oc = 0; oc < 4; ++oc) {
      int o = oc >> 1, cc = oc & 1;
      float a = 0.f;
      for (int l = tid; l < 2048; l += 512) {
        float f = hb[(o * 4 + 0 + cc) * 2048 + l];
        float b = (l > 0) ? hb[(o * 4 + 2 + cc) * 2048 + l] : 0.f;
        a += f * f + b * b;
      }
      ss[oc] = wave_sum(a);
    }
    if ((tid & 63) == 0) {
#pragma unroll
      for (int q = 0; q < 4; ++q) red[(tid >> 6) * 4 + q] = ss[q];
    }
  }
  __syncthreads();
  if (tid < 4) {
    float s = 0.f;
    for (int w = 0; w < 8; ++w) s += red[w * 4 + tid];
    nrm[tid] = rsqrtf(s + 1e-12f);
  }
  __syncthreads();
  u16* Rg = reinterpret_cast<u16*>(p.ws + S_RG);
  for (int q = tid; q < 4 * 4096; q += 512) {
    int oc = q >> 12, qq = q & 4095;
    int o = oc >> 1, cc = oc & 1;
    float v;
    if (qq == 0) v = 0.f;
    else if (qq <= 2048) v = hb[(o * 4 + 0 * 2 + cc) * 2048 + (2048 - qq)];
    else v = hb[(o * 4 + 1 * 2 + cc) * 2048 + (qq - 2048)];
    v *= nrm[oc];
    Rg[((long)o * 512 + 2 * cpair + cc) * 4096 + qq] = f2bf(v);
  }
  __syncthreads();
}

DEV void phase_abin(const Params& p) {
  const int nb = gridDim.x;
  for (int c = blockIdx.x; c < 256; c += nb) filter_b(p, c);
  const u16* xb = reinterpret_cast<const u16*>(p.ws + REG_X);
  const u16* wt = reinterpret_cast<const u16*>(p.ws + W_ABIN);
  u16* qk = reinterpret_cast<u16*>(p.ws + REG_B);
  u16* vht = reinterpret_cast<u16*>(p.ws + REG_B + 33554432ull);
  gemm_phase<true, true>(1024, 64, 4, [&](const Unit& u, const char*& a, const char*& b) { a = (const char*)(xb) + (size_t)u.pm * 256 * (1024) * 2; b = (const char*)(wt) + (size_t)u.pn * 256 * (1024) * 2; },
      [&](Acc8& acc, const Unit& u, int wr, int wc, int fr, int fq) {
        const float sc = (u.pn < 2) ? 0.125f : 1.0f;
        u16* base = qk + (long)(u.pm * 256 + wr * 64 + fr) * 1024 + u.pn * 256 + wc * 32 + 8 * fq;
        E8_FOR {
          f32x4 v0 = acc[ai][bj][m][0], v1 = acc[ai][bj][m][1];
          uint4 pk;
          pk.x = cvt_pk_bf16(v0[0] * sc, v0[1] * sc); pk.y = cvt_pk_bf16(v0[2] * sc, v0[3] * sc);
          pk.z = cvt_pk_bf16(v1[0] * sc, v1[1] * sc); pk.w = cvt_pk_bf16(v1[2] * sc, v1[3] * sc);
          *reinterpret_cast<uint4*>(base + (ai * 128 + m * 16) * 1024 + bj * 128) = pk;
        }
      });
  gemm_phase<false, false>(1024, 64, 8, [&](const Unit& u, const char*& a, const char*& b) { a = (const char*)(xb) + (size_t)u.pm * 256 * (1024) * 2; b = (const char*)(wt + 1024 * 1024) + (size_t)u.pn * 256 * (1024) * 2; },
      [&](Acc8& acc, const Unit& u, int wr, int wc, int fr, int fq) {
        u16* base = vht + (long)(u.pn * 256 + wc * 32 + fr) * TOK + u.pm * 256 + wr * 64 + 4 * fq;
        E8_FOR {
#pragma unroll
          for (int n = 0; n < 2; ++n) {
            f32x4 v = acc[ai][bj][m][n];
            uint2 pk; pk.x = cvt_pk_bf16(v[0], v[1]); pk.y = cvt_pk_bf16(v[2], v[3]);
            *reinterpret_cast<uint2*>(base + (long)(bj * 128 + n * 16) * TOK + ai * 128 + m * 16) = pk;
          }
        }
      });
}

constexpr int NA_VST = 580;
constexpr int NA_V_OFF = 576 * 128;
DEV void na_pair(const Params& p, int u) {
  const int tid = otid(), lane = tid & 63, wid = tid >> 6, fr = lane & 15, fq = lane >> 4;
  const int rp = u & 15, h = (u >> 4) & 7, b = u >> 7;
  const int rbase = min(max(2 * rp - 4, 0), 24);
  const int nrows = (rbase == 24) ? 8 : 9;
  const u16* qk = reinterpret_cast<const u16*>(p.ws + REG_B);
  const u16* vht = reinterpret_cast<const u16*>(p.ws + REG_B + 33554432ull);
  u16* cat = reinterpret_cast<u16*>(p.ws + REG_A + 100663296ull);
  char* kl = smem;
  u16* vl = reinterpret_cast<u16*>(smem + NA_V_OFF);
  const long tok0 = (long)b * SEQ + rbase * 64;
  __syncthreads();
#pragma unroll
  for (int i = 0; i < 9; ++i) {
    const int q = tid + 512 * i, key = q >> 3, ch = q & 7;
    if (key < nrows * 64) {
      uint4 v = *reinterpret_cast<const uint4*>(qk + (tok0 + key) * 1024 + 512 + h * 64 + ch * 8);
      *reinterpret_cast<uint4*>(kl + key * 128 + ((ch ^ ((key >> 1) & 7)) << 4)) = v;
    }
  }
#pragma unroll
  for (int i = 0; i < 9; ++i) {
    const int q = tid + 512 * i, d = q / 72, ch = q % 72;
    if (ch < nrows * 8) {
      uint4 v = *reinterpret_cast<const uint4*>(vht + (long)(h * 64 + d) * TOK + tok0 + ch * 8);
      u16* dst = vl + d * NA_VST + ch * 8;
      *reinterpret_cast<uint2*>(dst) = make_uint2(v.x, v.y);
      *reinterpret_cast<uint2*>(dst + 4) = make_uint2(v.z, v.w);
    }
  }
  __syncthreads();
  const int g = wid & 3, r = 2 * rp + (wid >> 2);
  const int r0 = min(max(r - 4, 0), 24), ro = r0 - rbase, cs = min(max(16 * g - 8, 0), 32);
  const int c = 16 * g + fr;
  const long tokq = (long)b * SEQ + r * 64 + c;
  bf16x8 qf[2];
#pragma unroll
  for (int ks = 0; ks < 2; ++ks) qf[ks] = *reinterpret_cast<const bf16x8*>(qk + tokq * 1024 + h * 64 + ks * 32 + fq * 8);
  f32x4 s[16];
#pragma unroll
  for (int kt = 0; kt < 16; ++kt) {
    const int w = kt >> 1, half = kt & 1;
    const int key = (ro + w) * 64 + cs + 16 * half + fr;
    const int sw = (key >> 1) & 7;
    bf16x8 k0 = *reinterpret_cast<const bf16x8*>(kl + key * 128 + ((fq ^ sw) << 4));
    bf16x8 k1 = *reinterpret_cast<const bf16x8*>(kl + key * 128 + (((4 + fq) ^ sw) << 4));
    f32x4 a = {0.f, 0.f, 0.f, 0.f};
    a = __builtin_amdgcn_mfma_f32_16x16x32_bf16(k0, qf[0], a, 0, 0, 0);
    a = __builtin_amdgcn_mfma_f32_16x16x32_bf16(k1, qf[1], a, 0, 0, 0);
    s[kt] = a;
  }
  const int c0 = min(max(c - 8, 0), 48);
  const float* rpb = p.na_rpb + h * 15 * 31;
  float mx = -1e30f;
#pragma unroll
  for (int kt = 0; kt < 16; ++kt) {
    const int w = kt >> 1, half = kt & 1;
    const int dr = r0 + w - r + 7;
#pragma unroll
    for (int j = 0; j < 4; ++j) {
      int kc = cs + 16 * half + 4 * fq + j;
      bool valid = (kc >= c0) && (kc < c0 + 16);
      int dc = min(max(kc - c, -15), 15) + 15;
      float bias = rpb[dr * 31 + dc];
      float v = valid ? (s[kt][j] + bias) : -1e30f;
      s[kt][j] = v;
      mx = fmaxf(mx, v);
    }
  }
  mx = fmaxf(mx, __shfl_xor(mx, 16));
  mx = fmaxf(mx, __shfl_xor(mx, 32));
  float sum = 0.f;
#pragma unroll
  for (int kt = 0; kt < 16; ++kt)
#pragma unroll
    for (int j = 0; j < 4; ++j) { float e = __expf(s[kt][j] - mx); s[kt][j] = e; sum += e; }
  sum += __shfl_xor(sum, 16);
  sum += __shfl_xor(sum, 32);
  f32x4 o[4];
#pragma unroll
  for (int dt = 0; dt < 4; ++dt) o[dt] = f32x4{0.f, 0.f, 0.f, 0.f};
#pragma unroll
  for (int w = 0; w < 8; ++w) {
    union { bf16x8 v; unsigned u[4]; } pf;
    pf.u[0] = cvt_pk_bf16(s[2 * w][0], s[2 * w][1]); pf.u[1] = cvt_pk_bf16(s[2 * w][2], s[2 * w][3]);
    pf.u[2] = cvt_pk_bf16(s[2 * w + 1][0], s[2 * w + 1][1]); pf.u[3] = cvt_pk_bf16(s[2 * w + 1][2], s[2 * w + 1][3]);
#pragma unroll
    for (int dt = 0; dt < 4; ++dt) {
      const u16* vp = vl + (dt * 16 + fr) * NA_VST + (ro + w) * 64 + cs + 4 * fq;
      union { bf16x8 v; uint2 u[2]; } af;
      af.u[0] = *reinterpret_cast<const uint2*>(vp);
      af.u[1] = *reinterpret_cast<const uint2*>(vp + 16);
      o[dt] = __builtin_amdgcn_mfma_f32_16x16x32_bf16(af.v, pf.v, o[dt], 0, 0, 0);
    }
  }
  const float inv = 1.0f / sum;
#pragma unroll
  for (int dt = 0; dt < 4; ++dt) {
    uint2 pk; pk.x = pack2(o[dt][0] * inv, o[dt][1] * inv); pk.y = pack2(o[dt][2] * inv, o[dt][3] * inv);
    *reinterpret_cast<uint2*>(cat + tokq * 1024 + h * 64 + dt * 16 + 4 * fq) = pk;
  }
}

constexpr int UB_STRIDE = 2056;
constexpr int RC_STRIDE = 4120;
constexpr int HY_RC_OFF = 2 * NBATCH * UB_STRIDE * 2;
DEV float shortconv(const u16* hrow, const float* cw, float cb, int ch, int t) {
  float xm = (t > 0) ? bf2f(hrow[t - 1]) : 0.f;
  float x0 = bf2f(hrow[t]);
  float xp = (t < SEQ - 1) ? bf2f(hrow[t + 1]) : 0.f;
  return cb + xm * cw[ch] + x0 * cw[1536 + ch] + xp * cw[2 * 1536 + ch];
}
DEV void load_rc(const Params& p, int o, int c) {
  const int tid = otid();
  char* rc = smem + HY_RC_OFF;
  const u16* Rg = reinterpret_cast<const u16*>(p.ws + S_RG) + ((long)o * 512 + c) * 4096;
  const float skip = p.hy_skip[o * 512 + c];
  const int i0 = tid * 8;
  uint4 lo = *reinterpret_cast<const uint4*>(Rg + i0);
  uint4 hi = (tid < 511) ? *reinterpret_cast<const uint4*>(Rg + i0 + 8) : make_uint4(0u, 0u, 0u, 0u);
  unsigned w[8] = {lo.x, lo.y, lo.z, lo.w, hi.x, hi.y, hi.z, hi.w};
  if (tid == 256) w[0] = (w[0] & 0xffff0000u) | (unsigned)f2bf(bf2f((u16)(w[0] & 0xffffu)) + skip);
  if (tid == 255) w[4] = (w[4] & 0xffff0000u) | (unsigned)f2bf(bf2f((u16)(w[4] & 0xffffu)) + skip);
#pragma unroll
  for (int m = 0; m < 8; ++m) {
    uint4 o4;
    if (m & 1) {
      o4.x = __builtin_amdgcn_alignbyte(w[m / 2 + 1], w[m / 2], 2);
      o4.y = __builtin_amdgcn_alignbyte(w[m / 2 + 2], w[m / 2 + 1], 2);
      o4.z = __builtin_amdgcn_alignbyte(w[m / 2 + 3], w[m / 2 + 2], 2);
      o4.w = __builtin_amdgcn_alignbyte(w[m / 2 + 4], w[m / 2 + 3], 2);
    } else {
      o4.x = w[m / 2]; o4.y = w[m / 2 + 1]; o4.z = w[m / 2 + 2]; o4.w = w[m / 2 + 3];
    }
    *reinterpret_cast<uint4*>(rc + m * (RC_STRIDE * 2) + i0 * 2) = o4;
  }
}
DEV void hyena_conv(const u16* ub, f32x4 (&acc)[16]) {
  const int lane = otid() & 63, wid = __builtin_amdgcn_readfirstlane(otid() >> 6), fr = lane & 15, fq = lane >> 4;
  const int mcopy = (-wid) & 7;
  const u16* rbase = reinterpret_cast<const u16*>(smem + HY_RC_OFF) + mcopy * RC_STRIDE + (8 * fq - 8 * fr + 2048 - (wid + mcopy));
#pragma unroll
  for (int i = 0; i < 16; ++i) acc[i] = f32x4{0.f, 0.f, 0.f, 0.f};
  const u16* urow = ub + (fr & 7) * UB_STRIDE + fq * 8;
#pragma unroll 1
  for (int kk = 0; kk < 64; ++kk) {
    bf16x8 bfr = *reinterpret_cast<const bf16x8*>(urow + kk * 32);
    const u16* rk = rbase + 32 * kk;
#pragma unroll
    for (int T = 0; T < 16; ++T) {
      bf16x8 af = *reinterpret_cast<const bf16x8*>(rk - 128 * T);
      acc[T] = __builtin_amdgcn_mfma_f32_16x16x32_bf16(af, bfr, acc[T], 0, 0, 0);
    }
  }
}
DEV void shortconv_pass(const u16* __restrict__ hrow  , u16* ub, const float* cw, float cb, int ch) {
  const float w0 = cw[ch], w1 = cw[1536 + ch], w2 = cw[2 * 1536 + ch];
  for (int q = otid(); q < TOK / 8; q += 512) {
    const int i = q * 8, b = i >> 11, t = i & 2047;
    uint4 v = *reinterpret_cast<const uint4*>(hrow + i);
    float x[10];
    x[0] = (t > 0) ? bf2f(hrow[i - 1]) : 0.f;
    x[9] = (t + 8 < SEQ) ? bf2f(hrow[i + 8]) : 0.f;
    x[1] = __uint_as_float(v.x << 16); x[2] = __uint_as_float(v.x & 0xffff0000u);
    x[3] = __uint_as_float(v.y << 16); x[4] = __uint_as_float(v.y & 0xffff0000u);
    x[5] = __uint_as_float(v.z << 16); x[6] = __uint_as_float(v.z & 0xffff0000u);
    x[7] = __uint_as_float(v.w << 16); x[8] = __uint_as_float(v.w & 0xffff0000u);
    float y[8];
#pragma unroll
    for (int j = 0; j < 8; ++j) y[j] = cb + x[j] * w0 + x[j + 1] * w1 + x[j + 2] * w2;
    uint4 o4; o4.x = pack2(y[0], y[1]); o4.y = pack2(y[2], y[3]); o4.z = pack2(y[4], y[5]); o4.w = pack2(y[6], y[7]);
    *reinterpret_cast<uint4*>(ub + b * UB_STRIDE + t) = o4;
  }
}
DEV void hyena_unit(const Params& p, int c) {
  const int tid = otid(), lane = tid & 63, wid = tid >> 6, fr = lane & 15, fq = lane >> 4;
  u16* ubA = reinterpret_cast<u16*>(smem);
  u16* ubB = ubA + NBATCH * UB_STRIDE;
  const u16* hbt = reinterpret_cast<const u16*>(p.ws + REG_B + 33554432ull) + 512L * TOK;
  u16* zT = reinterpret_cast<u16*>(p.ws + REG_C);
  const float* cw = p.hy_conv_w;
  shortconv_pass(hbt + (long)c * TOK, ubA, cw, p.hy_conv_b[c], c);
  shortconv_pass(hbt + (long)(512 + c) * TOK, ubB, cw, p.hy_conv_b[512 + c], 512 + c);
  load_rc(p, 0, c);
  __syncthreads();
  f32x4 acc[16];
  hyena_conv(ubA, acc);
  if (fr < 8) {
#pragma unroll
    for (int T = 0; T < 16; ++T)
#pragma unroll
      for (int j = 0; j < 4; ++j) {
        const int t = 128 * T + wid + 8 * (4 * fq + j);
        u16* q = ubB + fr * UB_STRIDE + t;
        *q = f2bf(bf2f(*q) * acc[T][j]);
      }
  }
  __syncthreads();
  shortconv_pass(hbt + (long)(1024 + c) * TOK, ubA, cw, p.hy_conv_b[1024 + c], 1024 + c);
  load_rc(p, 1, c);
  __syncthreads();
  hyena_conv(ubB, acc);
  if (fr < 8) {
#pragma unroll
    for (int T = 0; T < 16; ++T)
#pragma unroll
      for (int j = 0; j < 4; ++j) {
        const int t = 128 * T + wid + 8 * (4 * fq + j);
        u16* q = ubA + fr * UB_STRIDE + t;
        *q = f2bf(bf2f(*q) * acc[T][j]);
      }
  }
  __syncthreads();
  for (int q = tid; q < TOK / 8; q += 512) {
    const int i = q * 8, b = i >> 11, t = i & 2047;
    *reinterpret_cast<uint4*>(zT + (long)c * TOK + i) = *reinterpret_cast<const uint4*>(ubA + b * UB_STRIDE + t);
  }
  __syncthreads();
}
DEV void phase_ztrans(const Params& p) {
  const int tid = otid();
  const u16* zT = reinterpret_cast<const u16*>(p.ws + REG_C);
  u16* cat = reinterpret_cast<u16*>(p.ws + REG_A + 100663296ull);
  u16* tile = reinterpret_cast<u16*>(smem);
  for (int tb = blockIdx.x; tb < TOK / 64; tb += gridDim.x) {
    __syncthreads();
    const u16* src = zT + (long)tid * TOK + tb * 64;
#pragma unroll
    for (int k = 0; k < 8; ++k) *reinterpret_cast<uint4*>(tile + tid * 72 + k * 8) = *reinterpret_cast<const uint4*>(src + k * 8);
    __syncthreads();
#pragma unroll
    for (int k = 0; k < 8; ++k) {
      const int q = tid + 512 * k;
      const int tk = q >> 6, ch8 = (q & 63) * 8;
      unsigned w[4];
#pragma unroll
      for (int j = 0; j < 4; ++j) w[j] = (unsigned)tile[(ch8 + 2 * j) * 72 + tk] | ((unsigned)tile[(ch8 + 2 * j + 1) * 72 + tk] << 16);
      *reinterpret_cast<uint4*>(cat + (long)(tb * 64 + tk) * 1024 + 512 + ch8) = make_uint4(w[0], w[1], w[2], w[3]);
    }
  }
}
DEV void phase_mix0(const Params& p) {
  const int nb = gridDim.x;
  for (int c = blockIdx.x; c < 512; c += nb) hyena_unit(p, c);
  for (int u = blockIdx.x; u < 1024; u += nb) na_pair(p, u);
}

DEV void phase_outproj(const Params& p, const u16* A, const u16* wt, const float* xres) {
  float* pre1 = reinterpret_cast<float*>(p.ws + REG_C);
  gemm_phase<true, false>(1024, 64, 4, [&](const Unit& u, const char*& a, const char*& b) { a = (const char*)(A) + (size_t)u.pm * 256 * (1024) * 2; b = (const char*)(wt) + (size_t)u.pn * 256 * (1024) * 2; },
      [&](Acc8& acc, const Unit& u, int wr, int wc, int fr, int fq) {
        const long o0 = (long)(u.pm * 256 + wr * 64 + fr) * 1024 + u.pn * 256 + wc * 32 + 4 * fq;
        E8_FOR {
#pragma unroll
          for (int n = 0; n < 2; ++n) {
            const long o = o0 + (ai * 128 + m * 16) * 1024 + bj * 128 + n * 16;
            f32x4 xr = *reinterpret_cast<const f32x4*>(xres + o);
            *reinterpret_cast<f32x4*>(pre1 + o) = xr * DN_ALPHA + acc[ai][bj][m][n];
          }
        }
      });
}

DEV void phase_ln1_router(const Params& p, int layer) {
  const int tid = otid(), lane = tid & 63, wid = tid >> 6, nb = gridDim.x;
  float* wrT = reinterpret_cast<float*>(smem);
  const float* wr = p.moe_router + (long)layer * 1024 * 16;
  for (int i = tid; i < 16384; i += 512) { int c = i >> 4, e = i & 15; wrT[e * 1024 + c] = wr[i]; }
  __syncthreads();
  const float* pre1 = reinterpret_cast<const float*>(p.ws + REG_C);
  float* x1 = reinterpret_cast<float*>(p.ws + REG_D);
  u16* x1b = reinterpret_cast<u16*>(p.ws + REG_E);
  float* aff = reinterpret_cast<float*>(p.ws + S_AFF);
  const float* g = p.ln1_g + layer * 1024; const float* bb = p.ln1_b + layer * 1024;
  for (int tok = blockIdx.x * 8 + wid; tok < TOK; tok += nb * 8) {
    float4 v[4];
    float s = 0.f;
#pragma unroll
    for (int i = 0; i < 4; ++i) { v[i] = *reinterpret_cast<const float4*>(pre1 + (long)tok * 1024 + i * 256 + lane * 4); s += v[i].x + v[i].y + v[i].z + v[i].w; }
    float mu = wave_sum(s) * (1.0f / 1024.0f);
    float q = 0.f;
#pragma unroll
    for (int i = 0; i < 4; ++i) { v[i].x -= mu; v[i].y -= mu; v[i].z -= mu; v[i].w -= mu; q += v[i].x * v[i].x + v[i].y * v[i].y + v[i].z * v[i].z + v[i].w * v[i].w; }
    float rstd = rsqrtf(wave_sum(q) * (1.0f / 1024.0f) + LN_EPS);
    float4 y[4];
#pragma unroll
    for (int i = 0; i < 4; ++i) {
      int c = i * 256 + lane * 4;
      float4 gg = *reinterpret_cast<const float4*>(g + c), b4 = *reinterpret_cast<const float4*>(bb + c);
      y[i].x = v[i].x * rstd * gg.x + b4.x; y[i].y = v[i].y * rstd * gg.y + b4.y; y[i].z = v[i].z * rstd * gg.z + b4.z; y[i].w = v[i].w * rstd * gg.w + b4.w;
      *reinterpret_cast<float4*>(x1 + (long)tok * 1024 + c) = y[i];
      uint2 pk; pk.x = pack2(y[i].x, y[i].y); pk.y = pack2(y[i].z, y[i].w);
      *reinterpret_cast<uint2*>(x1b + (long)tok * 1024 + c) = pk;
    }
    float lg[16];
#pragma unroll
    for (int e = 0; e < 16; ++e) {
      float a = 0.f;
#pragma unroll
      for (int i = 0; i < 4; ++i) {
        float4 w4 = *reinterpret_cast<const float4*>(wrT + e * 1024 + i * 256 + lane * 4);
        a += y[i].x * w4.x + y[i].y * w4.y + y[i].z * w4.z + y[i].w * w4.w;
      }
      lg[e] = a;
      if (e & 1) asm volatile("" ::: "memory");
    }
#pragma unroll
    for (int s_ = 0; s_ < 4; ++s_) {
      const int bit = 1 << s_;
      const bool up = (lane & bit) != 0;
#pragma unroll
      for (int i = 0; i < (8 >> s_); ++i) {
        float lo = lg[2 * i], hi = lg[2 * i + 1];
        float snd = up ? lo : hi;
        float rcv = __shfl_xor(snd, bit);
        lg[i] = (up ? hi : lo) + rcv;
      }
    }
    float mine = lg[0];
    mine += __shfl_xor(mine, 16);
    mine += __shfl_xor(mine, 32);
    float mx = mine;
#pragma unroll
    for (int o = 8; o > 0; o >>= 1) mx = fmaxf(mx, __shfl_xor(mx, o));
    float ex = expf(mine - mx);
    float den = ex;
#pragma unroll
    for (int o = 8; o > 0; o >>= 1) den += __shfl_xor(den, o);
    if (lane < 16) {
      int b = tok >> 11, l = tok & 2047;
      aff[((long)b * 16 + lane) * SEQ + l] = ex / den;
    }
  }
}

DEV void phase_topk(const Params& p) {
  const int tid = otid(), nb = gridDim.x, lane = tid & 63, wid = tid >> 6;
  unsigned* key = reinterpret_cast<unsigned*>(smem);
  int* rows = reinterpret_cast<int*>(smem + 8192);
  unsigned* hist = reinterpret_cast<unsigned*>(smem + 9216);
  unsigned* wsum = reinterpret_cast<unsigned*>(smem + 10240);
  unsigned* bc = reinterpret_cast<unsigned*>(smem + 10304);
  const float* aff = reinterpret_cast<const float*>(p.ws + S_AFF);
  float* gsel = reinterpret_cast<float*>(p.ws + S_GSEL);
  int* slot = reinterpret_cast<int*>(p.ws + S_SLOT);
  const u16* x1b = reinterpret_cast<const u16*>(p.ws + REG_E);
  u16* Xe = reinterpret_cast<u16*>(p.ws + REG_C);
  for (int be = blockIdx.x; be < NBATCH * NEXP; be += nb) {
    const int b = be >> 4, e = be & 15;
    __syncthreads();
    const float4 av = *reinterpret_cast<const float4*>(aff + (long)be * SEQ + tid * 4);
    const unsigned k0 = __float_as_uint(av.x), k1 = __float_as_uint(av.y), k2 = __float_as_uint(av.z), k3 = __float_as_uint(av.w);
    unsigned prefix = 0u, need = CAP;
#pragma unroll 1
    for (int shift = 24; shift >= 0; shift -= 8) {
      if (tid < 256) hist[tid] = 0u;
      __syncthreads();
      const unsigned hs = (shift == 24) ? 0u : (unsigned)(shift + 8);
      if (shift == 24 || (k0 >> hs) == prefix) atomicAdd(&hist[(k0 >> shift) & 255u], 1u);
      if (shift == 24 || (k1 >> hs) == prefix) atomicAdd(&hist[(k1 >> shift) & 255u], 1u);
      if (shift == 24 || (k2 >> hs) == prefix) atomicAdd(&hist[(k2 >> shift) & 255u], 1u);
      if (shift == 24 || (k3 >> hs) == prefix) atomicAdd(&hist[(k3 >> shift) & 255u], 1u);
      __syncthreads();
      if (wid == 0) {
        unsigned h0 = hist[4 * lane], h1 = hist[4 * lane + 1], h2 = hist[4 * lane + 2], h3 = hist[4 * lane + 3];
        unsigned tot = h0 + h1 + h2 + h3;
        unsigned suf = tot;
#pragma unroll
        for (int o = 1; o < 64; o <<= 1) { unsigned t = __shfl_down(suf, o); if (lane + o < 64) suf += t; }
        const unsigned above = suf - tot;
        int d = -1; unsigned nabove = 0u;
        unsigned c3 = above + h3, c2 = c3 + h2, c1 = c2 + h1, c0 = c1 + h0;
        if (above < need && c0 >= need) {
          if (c3 >= need) { d = 4 * lane + 3; nabove = above; }
          else if (c2 >= need) { d = 4 * lane + 2; nabove = c3; }
          else if (c1 >= need) { d = 4 * lane + 1; nabove = c2; }
          else { d = 4 * lane; nabove = c1; }
          bc[0] = (prefix << 8) | (unsigned)d;
          bc[1] = need - nabove;
        }
      }
      __syncthreads();
      prefix = bc[0]; need = bc[1];
    }
    const unsigned tau = prefix;
    const unsigned e0 = (k0 == tau), e1 = (k1 == tau), e2 = (k2 == tau), e3 = (k3 == tau);
    unsigned eqs = e0 + e1 + e2 + e3;
    unsigned inc = eqs;
#pragma unroll
    for (int o = 1; o < 64; o <<= 1) { unsigned t = __shfl_up(inc, o); if (lane >= o) inc += t; }
    if (lane == 63) wsum[wid] = inc;
    __syncthreads();
    unsigned base = 0u;
#pragma unroll
    for (int w = 0; w < 8; ++w) if (w < wid) base += wsum[w];
    unsigned eqb = base + inc - eqs;
    const unsigned s0 = (k0 > tau) || (e0 && eqb < need); eqb += e0;
    const unsigned s1 = (k1 > tau) || (e1 && eqb < need); eqb += e1;
    const unsigned s2 = (k2 > tau) || (e2 && eqb < need); eqb += e2;
    const unsigned s3 = (k3 > tau) || (e3 && eqb < need);
    const unsigned sels = s0 + s1 + s2 + s3;
    unsigned inc2 = sels;
#pragma unroll
    for (int o = 1; o < 64; o <<= 1) { unsigned t = __shfl_up(inc2, o); if (lane >= o) inc2 += t; }
    if (lane == 63) wsum[8 + wid] = inc2;
    __syncthreads();
    unsigned base2 = 0u;
#pragma unroll
    for (int w = 0; w < 8; ++w) if (w < wid) base2 += wsum[8 + w];
    unsigned sl = base2 + inc2 - sels;
    const int tok0 = tid * 4;
    int sv[4];
    sv[0] = s0 ? (int)sl : -1; sl += s0;
    sv[1] = s1 ? (int)sl : -1; sl += s1;
    sv[2] = s2 ? (int)sl : -1; sl += s2;
    sv[3] = s3 ? (int)sl : -1;
    const float avv[4] = {av.x, av.y, av.z, av.w};
#pragma unroll
    for (int j = 0; j < 4; ++j) {
      slot[((long)b * SEQ + tok0 + j) * 16 + e] = sv[j];
      if (sv[j] >= 0) { rows[sv[j]] = tok0 + j; gsel[be * CAP + sv[j]] = avv[j]; }
    }
    __syncthreads();
    for (int s = wid; s < CAP; s += 8) {
      const int t = rows[s];
      const uint4* src = reinterpret_cast<const uint4*>(x1b + ((long)b * SEQ + t) * 1024);
      uint4* dst = reinterpret_cast<uint4*>(Xe + ((long)(e * 8 + b) * CAP + s) * 1024);
      uint4 c0 = src[lane], c1 = src[64 + lane];
      dst[lane] = c0; dst[64 + lane] = c1;
    }
  }
}

DEV void phase_moe1(const Params& p, int layer) {
  const u16* Xe = reinterpret_cast<const u16*>(p.ws + REG_C);
  const u16* wgu = reinterpret_cast<const u16*>(p.ws + W_GU) + (long)layer * 16 * 4096 * 1024;
  u16* H = reinterpret_cast<u16*>(p.ws + REG_A);
  gemm_phase<true, true>(1024, 128, 16,
      [&](const Unit& u, const char*& a, const char*& b) { a = (const char*)Xe + (size_t)u.pm * 256 * 1024 * 2; b = (const char*)wgu + ((size_t)(u.pm >> 3) * 4096 + (size_t)u.pn * 256) * 1024 * 2; },
      [&](Acc8& acc, const Unit& u, int wr, int wc, int fr, int fq) {
        u16* base = H + (long)(u.pm * 256 + wr * 64 + fr) * DFF + u.pn * 128 + wc * 32 + 8 * fq;
#pragma unroll
        for (int ai = 0; ai < 2; ++ai)
#pragma unroll
          for (int m = 0; m < 4; ++m) {
            float hv[8];
#pragma unroll
            for (int n = 0; n < 2; ++n)
#pragma unroll
              for (int j = 0; j < 4; ++j) {
                float gte = acc[ai][0][m][n][j], up = acc[ai][1][m][n][j];
                hv[n * 4 + j] = gte / (1.0f + __expf(-gte)) * up;
              }
            uint4 pk;
            pk.x = cvt_pk_bf16(hv[0], hv[1]); pk.y = cvt_pk_bf16(hv[2], hv[3]); pk.z = cvt_pk_bf16(hv[4], hv[5]); pk.w = cvt_pk_bf16(hv[6], hv[7]);
            *reinterpret_cast<uint4*>(base + (ai * 128 + m * 16) * DFF) = pk;
          }
      });
}
DEV void phase_moe2(const Params& p, int layer) {
  const u16* H = reinterpret_cast<const u16*>(p.ws + REG_A);
  const u16* wd = reinterpret_cast<const u16*>(p.ws + W_DN) + (long)layer * 16 * 1024 * 2048;
  const float* gsel = reinterpret_cast<const float*>(p.ws + S_GSEL);
  u16* Ye = reinterpret_cast<u16*>(p.ws + REG_B);
  gemm_phase<true, true>(2048, 128, 4,
      [&](const Unit& u, const char*& a, const char*& b) { a = (const char*)H + (size_t)u.pm * 256 * 2048 * 2; b = (const char*)wd + ((size_t)(u.pm >> 3) * 1024 + (size_t)u.pn * 256) * 2048 * 2; },
      [&](Acc8& acc, const Unit& u, int wr, int wc, int fr, int fq) {
        const int e = u.pm >> 3, b = u.pm & 7;
        const float* gs = gsel + (b * 16 + e) * CAP + wr * 64 + fr;
        u16* base = Ye + (long)(u.pm * 256 + wr * 64 + fr) * 1024 + u.pn * 256 + wc * 32 + 8 * fq;
#pragma unroll
        for (int ai = 0; ai < 2; ++ai)
#pragma unroll
          for (int m = 0; m < 4; ++m) {
            const float g = gs[ai * 128 + m * 16];
#pragma unroll
            for (int bj = 0; bj < 2; ++bj) {
              f32x4 v0 = acc[ai][bj][m][0] * g, v1 = acc[ai][bj][m][1] * g;
              uint4 pk;
              pk.x = cvt_pk_bf16(v0[0], v0[1]); pk.y = cvt_pk_bf16(v0[2], v0[3]); pk.z = cvt_pk_bf16(v1[0], v1[1]); pk.w = cvt_pk_bf16(v1[2], v1[3]);
              *reinterpret_cast<uint4*>(base + (ai * 128 + m * 16) * 1024 + bj * 128) = pk;
            }
          }
      });
}
DEV void phase_ln2(const Params& p, int layer) {
  const int tid = otid(), lane = tid & 63, wid = tid >> 6, nb = gridDim.x;
  const float* x1 = reinterpret_cast<const float*>(p.ws + REG_D);
  const u16* Ye = reinterpret_cast<const u16*>(p.ws + REG_B);
  const int* slot = reinterpret_cast<const int*>(p.ws + S_SLOT);
  float* x2 = reinterpret_cast<float*>(p.ws + REG_A);
  u16* x2b = reinterpret_cast<u16*>(p.ws + REG_A + 67108864ull);
  const float* g = p.ln2_g + layer * 1024; const float* bb = p.ln2_b + layer * 1024;
  for (int tok = blockIdx.x * 8 + wid; tok < TOK; tok += nb * 8) {
    const int b = tok >> 11;
    float4 v[4];
#pragma unroll
    for (int i = 0; i < 4; ++i) {
      float4 t = *reinterpret_cast<const float4*>(x1 + (long)tok * 1024 + i * 256 + lane * 4);
      v[i].x = DN_ALPHA * t.x; v[i].y = DN_ALPHA * t.y; v[i].z = DN_ALPHA * t.z; v[i].w = DN_ALPHA * t.w;
    }
    int myslot = (lane < 16) ? slot[(long)tok * 16 + lane] : -1;
    unsigned mask = (unsigned)__ballot(myslot >= 0);
    while (mask) {
      const int e = __builtin_ctz(mask);
      mask &= mask - 1;
      const int sidx = __builtin_amdgcn_readlane(myslot, e);
      const u16* yr = Ye + ((long)(e * 8 + b) * CAP + sidx) * 1024;
      uint2 t[4];
#pragma unroll
      for (int i = 0; i < 4; ++i) t[i] = *reinterpret_cast<const uint2*>(yr + i * 256 + lane * 4);
#pragma unroll
      for (int i = 0; i < 4; ++i) {
        v[i].x += __uint_as_float(t[i].x << 16); v[i].y += __uint_as_float(t[i].x & 0xffff0000u);
        v[i].z += __uint_as_float(t[i].y << 16); v[i].w += __uint_as_float(t[i].y & 0xffff0000u);
      }
    }
    float s = 0.f;
#pragma unroll
    for (int i = 0; i < 4; ++i) s += v[i].x + v[i].y + v[i].z + v[i].w;
    float mu = wave_sum(s) * (1.0f / 1024.0f);
    float q = 0.f;
#pragma unroll
    for (int i = 0; i < 4; ++i) { v[i].x -= mu; v[i].y -= mu; v[i].z -= mu; v[i].w -= mu; q += v[i].x * v[i].x + v[i].y * v[i].y + v[i].z * v[i].z + v[i].w * v[i].w; }
    float rstd = rsqrtf(wave_sum(q) * (1.0f / 1024.0f) + LN_EPS);
#pragma unroll
    for (int i = 0; i < 4; ++i) {
      int c = i * 256 + lane * 4;
      float4 gg = *reinterpret_cast<const float4*>(g + c), b4 = *reinterpret_cast<const float4*>(bb + c);
      float4 y;
      y.x = v[i].x * rstd * gg.x + b4.x; y.y = v[i].y * rstd * gg.y + b4.y; y.z = v[i].z * rstd * gg.z + b4.z; y.w = v[i].w * rstd * gg.w + b4.w;
      *reinterpret_cast<float4*>(x2 + (long)tok * 1024 + c) = y;
      uint2 pk; pk.x = pack2(y.x, y.y); pk.y = pack2(y.z, y.w);
      *reinterpret_cast<uint2*>(x2b + (long)tok * 1024 + c) = pk;
    }
  }
}
DEV void phase_ple(const Params& p, int layer, float* outf, u16* outb) {
  const float* x2 = reinterpret_cast<const float*>(p.ws + REG_A);
  const u16* x2b = reinterpret_cast<const u16*>(p.ws + REG_A + 67108864ull);
  const u16* pb = reinterpret_cast<const u16*>(p.ws + REG_P) + (long)layer * TOK * 256;
  const u16* wg = reinterpret_cast<const u16*>(p.ws + W_PLEG) + (long)layer * 1024 * 1024;
  const u16* wp = reinterpret_cast<const u16*>(p.ws + W_PLEP) + (long)layer * 1024 * 256;
  u16* pp = reinterpret_cast<u16*>(p.ws + REG_C);
  gemm_phase<true, false>(256, 64, 4, [&](const Unit& u, const char*& a, const char*& b) { a = (const char*)(pb) + (size_t)u.pm * 256 * (256) * 2; b = (const char*)(wp) + (size_t)u.pn * 256 * (256) * 2; },
      [&](Acc8& acc, const Unit& u, int wr, int wc, int fr, int fq) {
        const long o0 = (long)(u.pm * 256 + wr * 64 + fr) * 1024 + u.pn * 256 + wc * 32 + 4 * fq;
        E8_FOR {
#pragma unroll
          for (int n = 0; n < 2; ++n)
          {
            f32x4 v = acc[ai][bj][m][n];
            uint2 pk; pk.x = cvt_pk_bf16(v[0], v[1]); pk.y = cvt_pk_bf16(v[2], v[3]);
            *reinterpret_cast<uint2*>(pp + o0 + (ai * 128 + m * 16) * 1024 + bj * 128 + n * 16) = pk;
          }
        }
      });
  gemm_phase<true, false>(1024, 64, 4, [&](const Unit& u, const char*& a, const char*& b) { a = (const char*)(x2b) + (size_t)u.pm * 256 * (1024) * 2; b = (const char*)(wg) + (size_t)u.pn * 256 * (1024) * 2; },
      [&](Acc8& acc, const Unit& u, int wr, int wc, int fr, int fq) {
        const long o0 = (long)(u.pm * 256 + wr * 64 + fr) * 1024 + u.pn * 256 + wc * 32 + 4 * fq;
        E8_FOR {
#pragma unroll
          for (int n = 0; n < 2; ++n) {
            const long o = o0 + (ai * 128 + m * 16) * 1024 + bj * 128 + n * 16;
            f32x4 a = acc[ai][bj][m][n];
            f32x4 xv = *reinterpret_cast<const f32x4*>(x2 + o);
            const uint2 pq = *reinterpret_cast<const uint2*>(pp + o);
            f32x4 pv = {__uint_as_float(pq.x << 16), __uint_as_float(pq.x & 0xffff0000u), __uint_as_float(pq.y << 16), __uint_as_float(pq.y & 0xffff0000u)};
            f32x4 r;
#pragma unroll
            for (int j = 0; j < 4; ++j) r[j] = xv[j] + pv[j] / (1.0f + __expf(-a[j]));
            *reinterpret_cast<f32x4*>(outf + o) = r;
            if (outb) { uint2 pk; pk.x = cvt_pk_bf16(r[0], r[1]); pk.y = cvt_pk_bf16(r[2], r[3]); *reinterpret_cast<uint2*>(outb + o) = pk; }
          }
        }
      });
}
DEV void phase_mla_in(const Params& p) {
  const u16* xb = reinterpret_cast<const u16*>(p.ws + REG_X);
  const u16* wt = reinterpret_cast<const u16*>(p.ws + W_MLAIN);
  float* hm = reinterpret_cast<float*>(p.ws + REG_B);
  gemm_phase<true, false>(1024, 64, 3, [&](const Unit& u, const char*& a, const char*& b) { a = (const char*)(xb) + (size_t)u.pm * 256 * (1024) * 2; b = (const char*)(wt) + (size_t)u.pn * 256 * (1024) * 2; },
      [&](Acc8& acc, const Unit& u, int wr, int wc, int fr, int fq) {
        const long o0 = (long)(u.pm * 256 + wr * 64 + fr) * 768 + u.pn * 256 + wc * 32 + 4 * fq;
        E8_FOR {
#pragma unroll
          for (int n = 0; n < 2; ++n)
            *reinterpret_cast<f32x4*>(hm + o0 + (ai * 128 + m * 16) * 768 + bj * 128 + n * 16) = acc[ai][bj][m][n];
        }
      });
}
constexpr size_t MLA_Q = REG_A, MLA_K = REG_A + 50331648ull, MLA_VT = REG_A + 100663296ull;
constexpr size_t MLA_CQN = REG_B + 50331648ull, MLA_CKVN = MLA_CQN + 12582912ull, MLA_O = MLA_CKVN + 8388608ull;
DEV float rope_inv(int i) { return 1.0f / powf(10000.0f, (float)i / 16.0f); }
DEV void phase_mla_norm(const Params& p) {
  const int tid = otid(), lane = tid & 63, wid = tid >> 6, nb = gridDim.x;
  const float* hm = reinterpret_cast<const float*>(p.ws + REG_B);
  u16* cqn = reinterpret_cast<u16*>(p.ws + MLA_CQN);
  u16* ckvn = reinterpret_cast<u16*>(p.ws + MLA_CKVN);
  u16* Kb = reinterpret_cast<u16*>(p.ws + MLA_K);
  for (int tok = blockIdx.x * 8 + wid; tok < TOK; tok += nb * 8) {
    const float* row = hm + (long)tok * 768;
    float q[6], kv[4];
    float sq = 0.f, skv = 0.f;
#pragma unroll
    for (int i = 0; i < 6; ++i) { q[i] = row[i * 64 + lane]; sq += q[i] * q[i]; }
#pragma unroll
    for (int i = 0; i < 4; ++i) { kv[i] = row[384 + i * 64 + lane]; skv += kv[i] * kv[i]; }
    float rq = rsqrtf(wave_sum(sq) * (1.0f / 384.0f) + LN_EPS);
    float rkv = rsqrtf(wave_sum(skv) * (1.0f / 256.0f) + LN_EPS);
#pragma unroll
    for (int i = 0; i < 6; ++i) cqn[(long)tok * 384 + i * 64 + lane] = f2bf(q[i] * rq * p.mla_q_norm[i * 64 + lane]);
#pragma unroll
    for (int i = 0; i < 4; ++i) ckvn[(long)tok * 256 + i * 64 + lane] = f2bf(kv[i] * rkv * p.mla_kv_norm[i * 64 + lane]);
    const int b = tok >> 11, l = tok & 2047;
    float kr = (lane < 32) ? row[640 + lane] : 0.f;
    float x1 = __shfl(kr, lane & 15), x2 = __shfl(kr, (lane & 15) + 16);
    float sn, cs; sincosf((float)l * rope_inv(lane & 15), &sn, &cs);
    float r = (lane & 16) ? (x1 * sn + x2 * cs) : (x1 * cs - x2 * sn);
    u16 rb = f2bf(r);
    for (int hh = 0; hh < 16; hh += 2) {
      int h = hh + (lane >> 5);
      u16 val = (u16)__shfl((int)rb, lane & 31);
      Kb[(((long)b * 16 + h) * SEQ + l) * 96 + 64 + (lane & 31)] = val;
    }
  }
}
DEV void phase_mla_up(const Params& p) {
  const u16* cqn = reinterpret_cast<const u16*>(p.ws + MLA_CQN);
  const u16* ckvn = reinterpret_cast<const u16*>(p.ws + MLA_CKVN);
  const u16* wq = reinterpret_cast<const u16*>(p.ws + W_QUP);
  const u16* wkv = reinterpret_cast<const u16*>(p.ws + W_KVUP);
  u16* Qb = reinterpret_cast<u16*>(p.ws + MLA_Q);
  u16* Kb = reinterpret_cast<u16*>(p.ws + MLA_K);
  u16* VT = reinterpret_cast<u16*>(p.ws + MLA_VT);
  const float qscale = 0.10206207261596577f * 1.4426950408889634f;
  gemm_phase<true, false>(384, 64, 6, [&](const Unit& u, const char*& a, const char*& b) { a = (const char*)(cqn) + (size_t)u.pm * 256 * (384) * 2; b = (const char*)(wq) + (size_t)u.pn * 256 * (384) * 2; },
      [&](Acc8& acc, const Unit& u, int wr, int wc, int fr, int fq) {
#pragma unroll
        for (int bj = 0; bj < 2; ++bj) {
          const int c32 = (u.pn * 256 + bj * 128 + wc * 32) >> 5;
          const int h = c32 / 3, part = c32 % 3;
#pragma unroll
          for (int ai = 0; ai < 2; ++ai)
#pragma unroll
            for (int m = 0; m < 4; ++m) {
              const int tok = u.pm * 256 + ai * 128 + wr * 64 + m * 16 + fr;
              const int b = tok >> 11, l = tok & 2047;
              u16* qrow = Qb + (((long)b * 16 + h) * SEQ + l) * 96 + part * 32 + 4 * fq;
              f32x4 a0 = acc[ai][bj][m][0], a1 = acc[ai][bj][m][1];
              if (part == 2) {
#pragma unroll
                for (int j = 0; j < 4; ++j) {
                  float sn, cs; sincosf((float)l * rope_inv(4 * fq + j), &sn, &cs);
                  float r0 = a0[j] * cs - a1[j] * sn, r1 = a0[j] * sn + a1[j] * cs;
                  a0[j] = r0; a1[j] = r1;
                }
              }
              uint2 p0, p1;
              p0.x = cvt_pk_bf16(a0[0] * qscale, a0[1] * qscale); p0.y = cvt_pk_bf16(a0[2] * qscale, a0[3] * qscale);
              p1.x = cvt_pk_bf16(a1[0] * qscale, a1[1] * qscale); p1.y = cvt_pk_bf16(a1[2] * qscale, a1[3] * qscale);
              *reinterpret_cast<uint2*>(qrow) = p0;
              *reinterpret_cast<uint2*>(qrow + 16) = p1;
            }
        }
      });
  gemm_phase<true, true>(256, 64, 4, [&](const Unit& u, const char*& a, const char*& b) { a = (const char*)(ckvn) + (size_t)u.pm * 256 * (256) * 2; b = (const char*)(wkv) + (size_t)u.pn * 256 * (256) * 2; },
      [&](Acc8& acc, const Unit& u, int wr, int wc, int fr, int fq) {
        E8_FOR {
          const int tok = u.pm * 256 + ai * 128 + wr * 64 + m * 16 + fr;
          const int b = tok >> 11, l = tok & 2047;
          const int col = u.pn * 256 + bj * 128 + wc * 32 + 8 * fq;
          const int h = col >> 6, d = col & 63;
          f32x4 v0 = acc[ai][bj][m][0], v1 = acc[ai][bj][m][1];
          uint4 pk;
          pk.x = cvt_pk_bf16(v0[0], v0[1]); pk.y = cvt_pk_bf16(v0[2], v0[3]); pk.z = cvt_pk_bf16(v1[0], v1[1]); pk.w = cvt_pk_bf16(v1[2], v1[3]);
          *reinterpret_cast<uint4*>(Kb + (((long)b * 16 + h) * SEQ + l) * 96 + d) = pk;
        }
      });
  gemm_phase<false, false>(256, 64, 4, [&](const Unit& u, const char*& a, const char*& b) { a = (const char*)(ckvn) + (size_t)u.pm * 256 * (256) * 2; b = (const char*)(wkv + 1024 * 256) + (size_t)u.pn * 256 * (256) * 2; },
      [&](Acc8& acc, const Unit& u, int wr, int wc, int fr, int fq) {
        E8_FOR {
          const int tok = u.pm * 256 + ai * 128 + wr * 64 + m * 16 + 4 * fq;
          const int b = tok >> 11, l = tok & 2047;
#pragma unroll
          for (int n = 0; n < 2; ++n) {
            const int col = u.pn * 256 + bj * 128 + wc * 32 + n * 16 + fr;
            const int h = col >> 6, d = col & 63;
            f32x4 v = acc[ai][bj][m][n];
            uint2 pk; pk.x = cvt_pk_bf16(v[0], v[1]); pk.y = cvt_pk_bf16(v[2], v[3]);
            *reinterpret_cast<uint2*>(VT + (((long)b * 16 + h) * 64 + d) * SEQ + l) = pk;
          }
        }
      });
}
constexpr int KST = 104, VST = 68;
DEV void mla_attn_unit(const Params& p, int u) {
  const int tid = otid(), lane = tid & 63, wid = tid >> 6, fr = lane & 15, fq = lane >> 4;
  const int qb = u & 7, bh = u >> 3;
  const u16* Qb = reinterpret_cast<const u16*>(p.ws + MLA_Q) + (long)bh * SEQ * 96;
  const u16* Kb = reinterpret_cast<const u16*>(p.ws + MLA_K) + (long)bh * SEQ * 96;
  const u16* VT = reinterpret_cast<const u16*>(p.ws + MLA_VT) + (long)bh * 64 * SEQ;
  u16* O = reinterpret_cast<u16*>(p.ws + MLA_O);
  u16* kl = reinterpret_cast<u16*>(smem);
  u16* vl = kl + 2 * 64 * KST;
  bf16x8 qf[2][3];
#pragma unroll
  for (int qt = 0; qt < 2; ++qt)
#pragma unroll
    for (int ks = 0; ks < 3; ++ks)
      qf[qt][ks] = *reinterpret_cast<const bf16x8*>(Qb + (long)(qb * 256 + wid * 32 + qt * 16 + fr) * 96 + ks * 32 + fq * 8);
  f32x4 o[4][2];
#pragma unroll
  for (int dt = 0; dt < 4; ++dt)
#pragma unroll
    for (int qt = 0; qt < 2; ++qt) o[dt][qt] = f32x4{0.f, 0.f, 0.f, 0.f};
  float mrun[2] = {-1e30f, -1e30f}, lrun[2] = {0.f, 0.f};
  const int kc0 = tid, kc1 = 512 + tid;
  const int vd = tid >> 3, vpart = tid & 7;
  uint4 kr0, kr1 = make_uint4(0, 0, 0, 0), vr;
  auto gload = [&](int t) {
    const u16* kt = Kb + (long)t * 64 * 96;
    kr0 = *reinterpret_cast<const uint4*>(kt + kc0 * 8);
    if (tid < 256) kr1 = *reinterpret_cast<const uint4*>(kt + kc1 * 8);
    vr = *reinterpret_cast<const uint4*>(VT + (long)vd * SEQ + t * 64 + vpart * 8);
  };
  auto lstore = [&](int buf) {
    u16* kd = kl + buf * 64 * KST; u16* vdst = vl + buf * 64 * VST;
    *reinterpret_cast<uint4*>(kd + (kc0 / 12) * KST + (kc0 % 12) * 8) = kr0;
    if (tid < 256) *reinterpret_cast<uint4*>(kd + (kc1 / 12) * KST + (kc1 % 12) * 8) = kr1;
    *reinterpret_cast<uint2*>(vdst + vd * VST + vpart * 8) = make_uint2(vr.x, vr.y);
    *reinterpret_cast<uint2*>(vdst + vd * VST + vpart * 8 + 4) = make_uint2(vr.z, vr.w);
  };
  __syncthreads();
  gload(0); lstore(0);
  __syncthreads();
  for (int t = 0; t < 32; ++t) {
    const int cur = t & 1;
    if (t + 1 < 32) gload(t + 1);
    const u16* kd = kl + cur * 64 * KST; const u16* vdl = vl + cur * 64 * VST;
    f32x4 s[4][2];
#pragma unroll
    for (int kt = 0; kt < 4; ++kt) {
      bf16x8 kf[3];
#pragma unroll
      for (int ks = 0; ks < 3; ++ks) kf[ks] = *reinterpret_cast<const bf16x8*>(kd + (kt * 16 + fr) * KST + ks * 32 + fq * 8);
#pragma unroll
      for (int qt = 0; qt < 2; ++qt) {
        f32x4 a = {0.f, 0.f, 0.f, 0.f};
#pragma unroll
        for (int ks = 0; ks < 3; ++ks) a = __builtin_amdgcn_mfma_f32_16x16x32_bf16(kf[ks], qf[qt][ks], a, 0, 0, 0);
        s[kt][qt] = a;
      }
    }
    bf16x8 pf[2][2];
#pragma unroll
    for (int qt = 0; qt < 2; ++qt) {
      float tm = -1e30f;
#pragma unroll
      for (int kt = 0; kt < 4; ++kt)
#pragma unroll
        for (int j = 0; j < 4; ++j) tm = fmaxf(tm, s[kt][qt][j]);
      tm = fmaxf(tm, __shfl_xor(tm, 16));
      tm = fmaxf(tm, __shfl_xor(tm, 32));
      const float mn = fmaxf(mrun[qt], tm);
      const float alpha = __builtin_amdgcn_exp2f(mrun[qt] - mn);
      mrun[qt] = mn;
      float ls = 0.f;
#pragma unroll
      for (int kt = 0; kt < 4; ++kt)
#pragma unroll
        for (int j = 0; j < 4; ++j) { float e = __builtin_amdgcn_exp2f(s[kt][qt][j] - mn); s[kt][qt][j] = e; ls += e; }
      lrun[qt] = lrun[qt] * alpha + ls;
#pragma unroll
      for (int dt = 0; dt < 4; ++dt) { o[dt][qt][0] *= alpha; o[dt][qt][1] *= alpha; o[dt][qt][2] *= alpha; o[dt][qt][3] *= alpha; }
#pragma unroll
      for (int k2 = 0; k2 < 2; ++k2) {
        union { bf16x8 v; unsigned u[4]; } t_;
        t_.u[0] = cvt_pk_bf16(s[2 * k2][qt][0], s[2 * k2][qt][1]); t_.u[1] = cvt_pk_bf16(s[2 * k2][qt][2], s[2 * k2][qt][3]);
        t_.u[2] = cvt_pk_bf16(s[2 * k2 + 1][qt][0], s[2 * k2 + 1][qt][1]); t_.u[3] = cvt_pk_bf16(s[2 * k2 + 1][qt][2], s[2 * k2 + 1][qt][3]);
        pf[k2][qt] = t_.v;
      }
    }
#pragma unroll
    for (int k2 = 0; k2 < 2; ++k2)
#pragma unroll
      for (int dt = 0; dt < 4; ++dt) {
        union { bf16x8 v; uint2 u[2]; } af;
        const u16* vp = vdl + (dt * 16 + fr) * VST + k2 * 32 + 4 * fq;
        af.u[0] = *reinterpret_cast<const uint2*>(vp);
        af.u[1] = *reinterpret_cast<const uint2*>(vp + 16);
#pragma unroll
        for (int qt = 0; qt < 2; ++qt) o[dt][qt] = __builtin_amdgcn_mfma_f32_16x16x32_bf16(af.v, pf[k2][qt], o[dt][qt], 0, 0, 0);
      }
    if (t + 1 < 32) lstore(cur ^ 1);
    __syncthreads();
  }
  const int b = bh >> 4, h = bh & 15;
#pragma unroll
  for (int qt = 0; qt < 2; ++qt) {
    float l = lrun[qt];
    l += __shfl_xor(l, 16);
    l += __shfl_xor(l, 32);
    const float inv = 1.0f / l;
    const long tok = (long)b * SEQ + qb * 256 + wid * 32 + qt * 16 + fr;
#pragma unroll
    for (int dt = 0; dt < 4; ++dt) {
      uint2 pk; pk.x = pack2(o[dt][qt][0] * inv, o[dt][qt][1] * inv); pk.y = pack2(o[dt][qt][2] * inv, o[dt][qt][3] * inv);
      *reinterpret_cast<uint2*>(O + tok * 1024 + h * 64 + dt * 16 + 4 * fq) = pk;
    }
  }
}
DEV void phase_mla_attn(const Params& p) {
  const int nb = gridDim.x;
  for (int u = blockIdx.x; u < NBATCH * 16 * 8; u += nb) mla_attn_unit(p, u);
}

#ifndef ONLY
#define ONLY -1
#endif
#define PH(n, ...) if (ONLY < 0 || ONLY == n) { __VA_ARGS__; }
constexpr int LDS_BAR_OFF = 148480;
__global__ void __launch_bounds__(512) mega(Params p) {
  cg::grid_group grid = cg::this_grid();
  unsigned* barw = reinterpret_cast<unsigned*>(p.ws + S_BAR);
  if (blockIdx.x == 0) for (int i = threadIdx.x; i < XCD_BAR_WORDS; i += 512) barw[i] = 0u;
  if (threadIdx.x == 0) *reinterpret_cast<uint4*>(smem + LDS_BAR_OFF) = make_uint4(0u, 0u, 0u, 0u);
  PH(0, phase_prep(p));
  grid.sync();
  XcdBarrier xb = xcd_barrier_post(barw, (volatile LAS unsigned*)(smem + LDS_BAR_OFF));
#define GSYNC() xcd_barrier(xb)
  PH(1, phase_abin(p)); GSYNC();
  PH(2, phase_mix0(p)); GSYNC();
  PH(2, phase_ztrans(p)); GSYNC();
  PH(3, phase_outproj(p, reinterpret_cast<const u16*>(p.ws + REG_A + 100663296ull), reinterpret_cast<const u16*>(p.ws + W_ABOUT), p.x)); GSYNC();
  for (int layer = 0; layer < 2; ++layer) {
    if (layer == 1) {
      PH(10, phase_mla_in(p)); GSYNC();
      PH(11, phase_mla_norm(p)); GSYNC();
      PH(12, phase_mla_up(p)); GSYNC();
      PH(13, phase_mla_attn(p)); GSYNC();
      PH(3, phase_outproj(p, reinterpret_cast<const u16*>(p.ws + MLA_O), reinterpret_cast<const u16*>(p.ws + W_MLAOUT), reinterpret_cast<const float*>(p.ws + REG_G))); GSYNC();
    }
    PH(4, phase_ln1_router(p, layer)); GSYNC();
    PH(5, phase_topk(p)); GSYNC();
    PH(6, phase_moe1(p, layer)); GSYNC();
    PH(7, phase_moe2(p, layer)); GSYNC();
    PH(8, phase_ln2(p, layer)); GSYNC();
    PH(9, phase_ple(p, layer, layer ? p.out : reinterpret_cast<float*>(p.ws + REG_G), layer ? nullptr : reinterpret_cast<u16*>(p.ws + REG_X)));
    if (layer == 0) GSYNC();
  }
}

static void add_job(Params& P, int& nj, int& tile, const float* src, u16* dst, int K, int N, int rsh, int rs, int off, int count, long sstride, long dstride) {
  ConvJob& J = P.jobs[nj++];
  J.src = src; J.dst = dst; J.sstride = sstride; J.dstride = dstride; J.K = K; J.N = N; J.rs = rs; J.off = off; J.rsh = rsh;
  J.ntn = (N + 255) / 256; J.tpm = (K / 64) * J.ntn; J.tile0 = tile; J.ntiles = J.tpm * count;
  tile += J.ntiles;
}

extern "C" void kernel_launch(void* const* d_in, const int* in_sizes, int n_in,
                              void* d_out, int out_size, void* d_ws, size_t ws_size,
                              hipStream_t stream) {
  constexpr size_t kDynLds = 148480 + 16;
  static int grid_blocks = 0;
  if (!grid_blocks) {
    int dev = 0, cus = 0, per_cu = 0;
    (void)hipGetDevice(&dev);
    (void)hipDeviceGetAttribute(&cus, hipDeviceAttributeMultiprocessorCount, dev);
    (void)hipFuncSetAttribute((const void*)mega, hipFuncAttributeMaxDynamicSharedMemorySize, (int)kDynLds);
    (void)hipOccupancyMaxActiveBlocksPerMultiprocessor(&per_cu, mega, 512, kDynLds);
    if (per_cu > 1) per_cu = 1;
    if (per_cu < 1) { fprintf(stderr, "occupancy query returned 0\n"); per_cu = 1; }
    grid_blocks = cus * per_cu;
    if (ws_size < WS_TOTAL) fprintf(stderr, "workspace too small: %zu < %zu\n", ws_size, (size_t)WS_TOTAL);
  }
  Params P;
  memset(&P, 0, sizeof(P));
  auto F = [&](int i) { return (const float*)d_in[i]; };
  char* ws = (char*)d_ws;
  P.x = F(0); P.p = F(1);
  P.na_rpb = F(3); P.hy_conv_w = F(4); P.hy_conv_b = F(5);
  P.hy_f_w1 = F(6); P.hy_f_b1 = F(7); P.hy_f_freq = F(8); P.hy_f_w2 = F(9); P.hy_f_b2 = F(10); P.hy_f_w3 = F(11); P.hy_skip = F(12);
  P.mla_q_norm = F(15); P.mla_kv_norm = F(17);
  P.ln1_g = F(20); P.ln1_b = F(21); P.ln2_g = F(22); P.ln2_b = F(23);
  P.moe_router = F(24);
  P.out = (float*)d_out; P.ws = ws;
  int nj = 0, tile = 0;
  add_job(P, nj, tile, F(2), (u16*)(ws + W_ABIN), 1024, 3072, 7, 128, 0, 1, 0, 0);
  add_job(P, nj, tile, F(13), (u16*)(ws + W_ABOUT), 1024, 1024, 7, 128, 0, 1, 0, 0);
  add_job(P, nj, tile, F(14), (u16*)(ws + W_MLAIN), 1024, 672, 7, 128, 0, 1, 0, 0);
  add_job(P, nj, tile, F(16), (u16*)(ws + W_QUP), 384, 1536, 7, 128, 0, 1, 0, 0);
  add_job(P, nj, tile, F(18), (u16*)(ws + W_KVUP), 256, 2048, 6, 64, 0, 1, 0, 0);
  P.jobs[nj - 1].sh2 = 1; P.jobs[nj - 1].off2 = 1024;
  add_job(P, nj, tile, F(19), (u16*)(ws + W_MLAOUT), 1024, 1024, 7, 128, 0, 1, 0, 0);
  add_job(P, nj, tile, F(28), (u16*)(ws + W_PLEG), 1024, 1024, 7, 128, 0, 2, 1024L * 1024, 1024L * 1024);
  add_job(P, nj, tile, F(29), (u16*)(ws + W_PLEP), 256, 1024, 7, 128, 0, 2, 256L * 1024, 1024L * 256);
  add_job(P, nj, tile, F(25), (u16*)(ws + W_GU), 1024, 2048, 7, 256, 0, 32, 1024L * 2048, 4096L * 1024);
  add_job(P, nj, tile, F(26), (u16*)(ws + W_GU), 1024, 2048, 7, 256, 128, 32, 1024L * 2048, 4096L * 1024);
  add_job(P, nj, tile, F(27), (u16*)(ws + W_DN), 2048, 1024, 7, 128, 0, 32, 2048L * 1024, 1024L * 2048);
  P.conv_total = tile;
  void* args[] = {&P};
  hipError_t e = hipLaunchCooperativeKernel((void*)mega, dim3(grid_blocks), dim3(512), args, kDynLds, stream);
  if (e != hipSuccess) fprintf(stderr, "cooperative launch failed: %s (grid %d)\n", hipGetErrorString(e), grid_blocks);
}
```

```cpp
#include <hip/hip_runtime.h>
#include <hip/hip_bf16.h>
#include <hip/hip_cooperative_groups.h>
#include <cstdio>
#include <cstring>
namespace cg = cooperative_groups;

typedef unsigned short u16;
using bf16x8 = __attribute__((ext_vector_type(8))) short;
using bf16x4 = __attribute__((ext_vector_type(4))) short;
using f32x4 = __attribute__((ext_vector_type(4))) float;
#define DEV __device__ __forceinline__

constexpr int TOK = 16384, DM = 1024, SEQ = 2048, NBATCH = 8;
constexpr int NEXP = 16, CAP = 256, DFF = 2048;
constexpr float DN_ALPHA = 1.4142135623730951f;
constexpr float LN_EPS = 1e-5f;

constexpr size_t W_ABIN = 0;
constexpr size_t W_ABOUT = W_ABIN + 3072ull * 1024 * 2;
constexpr size_t W_MLAIN = W_ABOUT + 1024ull * 1024 * 2;
constexpr size_t W_QUP = W_MLAIN + 768ull * 1024 * 2;
constexpr size_t W_KVUP = W_QUP + 1536ull * 384 * 2;
constexpr size_t W_MLAOUT = W_KVUP + 2048ull * 256 * 2;
constexpr size_t W_PLEG = W_MLAOUT + 1024ull * 1024 * 2;
constexpr size_t W_PLEP = W_PLEG + 2 * 1024ull * 1024 * 2;
constexpr size_t W_GU = W_PLEP + 2 * 1024ull * 256 * 2;
constexpr size_t W_DN = W_GU + 2 * 16ull * 4096 * 1024 * 2;
constexpr size_t REG_A = W_DN + 2 * 16ull * 1024 * 2048 * 2;
constexpr size_t REG_B = REG_A + 134217728ull;
constexpr size_t REG_C = REG_B + 134217728ull;
constexpr size_t REG_D = REG_C + 67108864ull;
constexpr size_t REG_E = REG_D + 67108864ull;
constexpr size_t REG_G = REG_E + 33554432ull;
constexpr size_t REG_X = REG_G + 67108864ull;
constexpr size_t REG_P = REG_X + 33554432ull;
constexpr size_t S_AFF = REG_P + 16777216ull;
constexpr size_t S_IDX = S_AFF + 1048576ull;
constexpr size_t S_GSEL = S_IDX + 131072ull;
constexpr size_t S_SLOT = S_GSEL + 131072ull;
constexpr size_t S_H2 = S_SLOT + 1048576ull;
constexpr size_t S_RG = S_H2 + 524288ull;
constexpr size_t S_BAR = S_RG + 8388608ull;
constexpr size_t WS_TOTAL = S_BAR + 16384ull;

struct ConvJob {
  const float* src; u16* dst;
  long sstride, dstride;
  int K, N;
  int rs, off;
  int rsh, sh2, off2, f8;
  float fscale; int padk;
  int ntn;
  int tpm;
  int tile0, ntiles;
};
constexpr int NJOBS = 16;

struct Params {
  const float* x; const float* p;
  const float* na_rpb; const float* hy_conv_w; const float* hy_conv_b;
  const float* hy_f_w1; const float* hy_f_b1; const float* hy_f_freq; const float* hy_f_w2; const float* hy_f_b2;
  const float* hy_f_w3; const float* hy_skip;
  const float* mla_q_norm; const float* mla_kv_norm;
  const float* ln1_g; const float* ln1_b; const float* ln2_g; const float* ln2_b;
  const float* moe_router;
  float* out; char* ws;
  int conv_total; int pad0;
  ConvJob jobs[NJOBS];
};

extern __shared__ __attribute__((aligned(16))) char smem[];

typedef __bf16 bf16x2_t __attribute__((ext_vector_type(2)));
typedef float f32x2_t __attribute__((ext_vector_type(2)));
DEV unsigned cvt_pk_bf16(float lo, float hi) { f32x2_t f = {lo, hi}; bf16x2_t b = __builtin_convertvector(f, bf16x2_t); return __builtin_bit_cast(unsigned, b); }
DEV u16 f2bf(float f) { return (u16)(cvt_pk_bf16(f, 0.f) & 0xffffu); }
DEV float bf2f(u16 h) { return __uint_as_float(((unsigned)h) << 16); }
DEV unsigned pack2(float a, float b) { return cvt_pk_bf16(a, b); }
DEV unsigned pack4_f8(float a, float b, float c, float d) { int w = 0; w = __builtin_amdgcn_cvt_pk_fp8_f32(a, b, w, false); w = __builtin_amdgcn_cvt_pk_fp8_f32(c, d, w, true); return (unsigned)w; }
DEV float fsigmoid(float x) { return __builtin_amdgcn_rcpf(1.0f + __builtin_amdgcn_exp2f(-1.4426950408889634f * x)); }
DEV float wave_sum(float v) {
#pragma unroll
  for (int o = 32; o > 0; o >>= 1) v += __shfl_xor(v, o);
  return v;
}
DEV int otid() { int t = threadIdx.x; asm volatile("" : "+v"(t)); return t; }
DEV int vstart() {
  int nb = gridDim.x, b = blockIdx.x;
  return (nb % 8 == 0) ? (b % 8) * (nb / 8) + b / 8 : b;
}


#define XB_TMO      128
#define XB_XCNT(j)  (256  + 64 * (j))
#define XB_XSUB(j)  (1280 + 64 * (j))
#define XB_XGEN(j)  (2304 + 64 * (j))
#define XB_TOP      3328
#define XB_TOPGEN   3392
#define XCD_BAR_WORDS 3456
#define XB_SPIN_CAP (1u << 18)
#define LAS __attribute__((address_space(3)))
DEV unsigned xb_ld(unsigned* p) { return __hip_atomic_load(p, __ATOMIC_RELAXED, __HIP_MEMORY_SCOPE_AGENT); }
DEV unsigned xb_add(unsigned* p, unsigned v) { return __hip_atomic_fetch_add(p, v, __ATOMIC_RELAXED, __HIP_MEMORY_SCOPE_AGENT); }
DEV unsigned xb_xcc_id() { return (unsigned)__builtin_amdgcn_s_getreg((3 << 11) | 20) & 0xFu; }
#define XB_SPIN(cond, bar) do { unsigned _sp = 0; while (cond) { __builtin_amdgcn_s_sleep(1); \
    if ((++_sp & 255u) == 0u) { if (xb_ld(&(bar)[XB_TMO])) break; if (_sp > XB_SPIN_CAP) { atomicAdd(&(bar)[XB_TMO], 1u); break; } } } } while (0)
struct XcdBarrier { unsigned* bar; unsigned x; volatile LAS unsigned* st; };
DEV XcdBarrier xcd_barrier_post(unsigned* bar, volatile LAS unsigned* st) {
  XcdBarrier b; b.bar = bar; b.x = xb_xcc_id(); b.st = st;
  if (threadIdx.x == 0) (void)xb_add(&bar[XB_XCNT(b.x)], 1u);
  return b;
}
DEV void xcd_barrier_complete(unsigned* bar, unsigned x, unsigned& nloc, unsigned& nx) {
  const unsigned G = gridDim.x * gridDim.y * gridDim.z;
  unsigned sum, cnt, mine, sp = 0u;
  for (;;) {
    sum = 0u; cnt = 0u; mine = 0u;
#pragma unroll
    for (unsigned j = 0; j < 16; ++j) { const unsigned c = xb_ld(&bar[XB_XCNT(j)]); sum += c; cnt += (c > 0u) ? 1u : 0u; mine = (j == x) ? c : mine; }
    if (sum == G) break;
    __builtin_amdgcn_s_sleep(1);
    if ((++sp & 255u) == 0u) { if (xb_ld(&bar[XB_TMO])) break; if (sp > XB_SPIN_CAP) { atomicAdd(&bar[XB_TMO], 1u); break; } }
  }
  nloc = mine > 0u ? mine : 1u; nx = cnt > 0u ? cnt : 1u;
}
DEV void xcd_barrier(const XcdBarrier& b) {
  asm volatile("s_waitcnt vmcnt(0)" ::: "memory");
  __syncthreads();
  if (threadIdx.x == 0) {
    unsigned* bar = b.bar;
    __builtin_amdgcn_s_waitcnt(0);
    unsigned nloc = b.st[0], nx = b.st[1];
    if (nloc == 0u) { xcd_barrier_complete(bar, b.x, nloc, nx); b.st[0] = nloc; b.st[1] = nx; }
    const unsigned old = xb_add(&bar[XB_XSUB(b.x)], 1u);
    const unsigned gen = old / nloc;
    if (old + 1u == (gen + 1u) * nloc) {
      __builtin_amdgcn_fence(__ATOMIC_RELEASE, "agent");
      asm volatile("s_waitcnt vmcnt(0)" ::: "memory");
      const unsigned og = xb_add(&bar[XB_TOP], 1u);
      const unsigned tg = og / nx;
      if (og + 1u == (tg + 1u) * nx) xb_add(&bar[XB_TOPGEN], 1u);
      else XB_SPIN(xb_ld(&bar[XB_TOPGEN]) == tg, bar);
      __builtin_amdgcn_fence(__ATOMIC_ACQUIRE, "agent");
      xb_add(&bar[XB_XGEN(b.x)], 1u);
      asm volatile("s_waitcnt vmcnt(0)" ::: "memory");
    } else {
      XB_SPIN(xb_ld(&bar[XB_XGEN(b.x)]) == gen, bar);
      __builtin_amdgcn_fence(__ATOMIC_ACQUIRE, "agent");
      asm volatile("s_waitcnt vmcnt(0)" ::: "memory");
    }
  }
  __syncthreads();
}

DEV int lds_byte(int r, int c) {
  int st = (r >> 4) * 2 + (c >> 5), rr = r & 15, cc = c & 31, ob = rr * 64 + cc * 2;
  return st * 1024 + (ob ^ (((ob >> 9) & 1) << 5));
}
DEV void stage_rc(int b, int& R, int& C) {
  int st = b / 1024, sb = b % 1024, swz = sb ^ (((sb >> 9) & 1) << 5);
  R = (st >> 1) * 16 + swz / 64; C = (st & 1) * 32 + (swz % 64) / 2;
}
#define GLDS16(g, l) __builtin_amdgcn_global_load_lds((const unsigned*)(g), (unsigned*)(l), 16, 0, 0)

typedef f32x4 Acc8[2][2][4][2];
constexpr int G8_BM = 256, G8_BK = 64, G8_HALF = 128, G8_HTB = G8_HALF * G8_BK * 2, G8_NXCD = 8, G8_WGM = 8;
DEV int perm32(int rho) { const int n = rho >> 4, i = rho & 15; return 8 * (i >> 2) + 4 * n + (i & 3); }
struct Unit { int pm, pn; };
DEV bool unit_next(int i, int nM, int nN, Unit& u) {
  const int nwg = nM * nN;
  const long L = (long)i * gridDim.x + blockIdx.x; if (L >= nwg) return false;
  int wgid = (int)L; { const int q = nwg / G8_NXCD, r = nwg % G8_NXCD, xcd = wgid % G8_NXCD, off = wgid / G8_NXCD; wgid = (xcd < r ? xcd * (q + 1) : r * (q + 1) + (xcd - r) * q) + off; }
  const int nig = G8_WGM * nN, gid = wgid / nig, fm = gid * G8_WGM, gsz = (nM - fm) < G8_WGM ? (nM - fm) : G8_WGM;
  u.pm = fm + ((wgid % nig) % gsz); u.pn = (wgid % nig) / gsz; return true;
}
typedef int v4i_t __attribute__((ext_vector_type(4)));
typedef int v8i_t __attribute__((ext_vector_type(8)));
template <bool TR, bool PERM, bool F8, class PF, class EF>
DEV void gemm_phase(const int K, const int nM, const int nN, PF ptrs, EF E) {
  LAS unsigned char* lds = (LAS unsigned char*)smem;
  const int tid = otid(), wid = __builtin_amdgcn_readfirstlane(tid >> 6), lane = tid & 63, wr = wid >> 2, wc = wid & 3, fr = lane & 15, fq = lane >> 4;
  const int Kb = F8 ? K : 2 * K;
  const int nt = Kb / 128;
  unsigned voffA[2], voffB[2];
#pragma unroll
  for (int i = 0; i < 2; ++i) { int R, C; stage_rc(tid * 16 + i * 8192, R, C); const int Rb = PERM ? ((R & ~31) + perm32(R & 31)) : R;
    voffA[i] = (unsigned)(R * Kb + C * 2); voffB[i] = (unsigned)(Rb * Kb + C * 2); }
  const size_t kstep = (size_t)(G8_BK * 2);
  const size_t hstep = (size_t)G8_HALF * Kb;
  const unsigned ldsw = (unsigned)wid * 1024u;
  const int aoff = lds_byte(wr * 64 + fr, fq * 8), boff = lds_byte(wc * 32 + fr, fq * 8);
#define PG8_SA(b, h) (((b) * 2 + (h)) * G8_HTB)
#define PG8_SB(b, h) ((4 + (b) * 2 + (h)) * G8_HTB)
#define PG8_STAGE(bufoff, gbase, voff) do { _Pragma("unroll") for (int _i = 0; _i < 2; ++_i) { unsigned _vo = (voff)[_i]; asm volatile("" : "+v"(_vo)); \
    __builtin_amdgcn_global_load_lds((const unsigned*)((const char*)(gbase) + _vo), (LAS unsigned*)(lds + (bufoff) + ldsw + _i * 8192), 16, 0, 0); } } while (0)
#define PG8_LD16(off) (*(const LAS v4i_t*)(lds + (off)))
#define PG8_LDA(dst, b, h) do { if constexpr (F8) { _Pragma("unroll") for (int m = 0; m < 4; ++m) dst##8[m] = __builtin_shufflevector(PG8_LD16(PG8_SA(b, h) + aoff + m * 2048), PG8_LD16(PG8_SA(b, h) + aoff + m * 2048 + 1024), 0, 1, 2, 3, 4, 5, 6, 7); } \
    else { _Pragma("unroll") for (int m = 0; m < 4; ++m) _Pragma("unroll") for (int k = 0; k < 2; ++k) dst[m][k] = *(const LAS bf16x8*)(lds + PG8_SA(b, h) + aoff + m * 2048 + k * 1024); } } while (0)
#define PG8_LDB(dst, b, h) do { if constexpr (F8) { _Pragma("unroll") for (int n = 0; n < 2; ++n) dst##8[n] = __builtin_shufflevector(PG8_LD16(PG8_SB(b, h) + boff + n * 2048), PG8_LD16(PG8_SB(b, h) + boff + n * 2048 + 1024), 0, 1, 2, 3, 4, 5, 6, 7); } \
    else { _Pragma("unroll") for (int n = 0; n < 2; ++n) _Pragma("unroll") for (int k = 0; k < 2; ++k) dst[n][k] = *(const LAS bf16x8*)(lds + PG8_SB(b, h) + boff + n * 2048 + k * 1024); } } while (0)
#define PG8_MMA(ai, bj, At, Bt) do { __builtin_amdgcn_s_setprio(1); \
    if constexpr (F8) { _Pragma("unroll") for (int m = 0; m < 4; ++m) _Pragma("unroll") for (int n = 0; n < 2; ++n) \
        { if constexpr (TR) asm volatile("v_mfma_f32_16x16x128_f8f6f4 %0, %1, %2, %0" : "+v"(acc[ai][bj][m][n]) : "v"(Bt##8[n]), "v"(At##8[m])); \
          else asm volatile("v_mfma_f32_16x16x128_f8f6f4 %0, %1, %2, %0" : "+v"(acc[ai][bj][m][n]) : "v"(At##8[m]), "v"(Bt##8[n])); } } \
    else { _Pragma("unroll") for (int m = 0; m < 4; ++m) _Pragma("unroll") for (int n = 0; n < 2; ++n) _Pragma("unroll") for (int k = 0; k < 2; ++k) \
    acc[ai][bj][m][n] = TR ? __builtin_amdgcn_mfma_f32_16x16x32_bf16(Bt[n][k], At[m][k], acc[ai][bj][m][n], 0, 0, 0) \
                           : __builtin_amdgcn_mfma_f32_16x16x32_bf16(At[m][k], Bt[n][k], acc[ai][bj][m][n], 0, 0, 0); } __builtin_amdgcn_s_setprio(0); } while (0)
#define PG8_WAIT_V(n) asm volatile("s_waitcnt vmcnt(" #n ")" ::: "memory")
#define PG8_WAIT_L(n) asm volatile("s_waitcnt lgkmcnt(" #n ")" ::: "memory")
#define PG8_BAR __builtin_amdgcn_s_barrier()
#define PG8_SCHED __builtin_amdgcn_sched_barrier(0)
  Unit cur, nxt; int ui = 0;
  if (!unit_next(0, nM, nN, cur)) return;
  Acc8 acc;
#pragma unroll
  for (int a = 0; a < 2; ++a)
#pragma unroll
    for (int b = 0; b < 2; ++b)
#pragma unroll
      for (int m = 0; m < 4; ++m)
#pragma unroll
        for (int n = 0; n < 2; ++n) acc[a][b][m][n] = f32x4{0.f, 0.f, 0.f, 0.f};
  bf16x8 At[4][2], B0[2][2], B1[2][2];
  v8i_t At8[4], B08[2], B18[2];
  const char* cA; const char* cB;
  ptrs(cur, cA, cB);
  PG8_STAGE(PG8_SB(0, 0), cB, voffB); PG8_STAGE(PG8_SA(0, 0), cA, voffA); PG8_STAGE(PG8_SB(0, 1), cB + hstep, voffB); PG8_STAGE(PG8_SA(0, 1), cA + hstep, voffA);
  if (wr == 1) PG8_BAR;
  PG8_WAIT_V(4); PG8_BAR;
  PG8_STAGE(PG8_SB(1, 0), cB + kstep, voffB); PG8_STAGE(PG8_SA(1, 0), cA + kstep, voffA); PG8_STAGE(PG8_SB(1, 1), cB + hstep + kstep, voffB);
  PG8_WAIT_V(6); PG8_BAR;
  for (;;) {
    const bool has_next = unit_next(ui + 1, nM, nN, nxt);
    const char* nA = cA; const char* nB = cB;
    if (has_next) ptrs(nxt, nA, nB);
#pragma unroll 1
    for (int t = 0; t < nt; t += 2) {
      const bool last = (t == nt - 2);
      const char* a1 = cA + (size_t)(t + 1) * kstep;
      const char* a2 = last ? nA : cA + (size_t)(t + 2) * kstep; const char* b2 = last ? nB : cB + (size_t)(t + 2) * kstep;
      const char* a3 = a2 + kstep; const char* b3 = b2 + kstep;
      PG8_LDB(B0, 0, 0); PG8_SCHED; PG8_LDA(At, 0, 0); PG8_STAGE(PG8_SA(1, 1), a1 + hstep, voffA);
      PG8_WAIT_L(8); PG8_BAR; PG8_WAIT_L(0); PG8_MMA(0, 0, At, B0); PG8_BAR; PG8_SCHED;
      PG8_LDB(B1, 0, 1); PG8_STAGE(PG8_SB(0, 0), b2, voffB);
      PG8_BAR; PG8_WAIT_L(0); PG8_MMA(0, 1, At, B1); PG8_BAR;
      PG8_LDA(At, 0, 1); PG8_STAGE(PG8_SA(0, 0), a2, voffA);
      PG8_BAR; PG8_WAIT_L(0); PG8_MMA(1, 0, At, B0); PG8_BAR; PG8_SCHED;
      PG8_STAGE(PG8_SB(0, 1), b2 + hstep, voffB);
      PG8_WAIT_V(6); PG8_BAR; PG8_MMA(1, 1, At, B1); PG8_BAR;
      PG8_LDB(B0, 1, 0); PG8_SCHED; PG8_LDA(At, 1, 0); PG8_STAGE(PG8_SA(0, 1), a2 + hstep, voffA);
      PG8_WAIT_L(8); PG8_BAR; PG8_WAIT_L(0); PG8_MMA(0, 0, At, B0); PG8_BAR; PG8_SCHED;
      PG8_LDB(B1, 1, 1); PG8_STAGE(PG8_SB(1, 0), b3, voffB);
      PG8_BAR; PG8_WAIT_L(0); PG8_MMA(0, 1, At, B1); PG8_BAR;
      PG8_LDA(At, 1, 1); PG8_STAGE(PG8_SA(1, 0), a3, voffA);
      PG8_BAR; PG8_WAIT_L(0); PG8_MMA(1, 0, At, B0); PG8_BAR; PG8_SCHED;
      PG8_STAGE(PG8_SB(1, 1), b3 + hstep, voffB);
      PG8_WAIT_V(6); PG8_BAR; PG8_MMA(1, 1, At, B1); PG8_BAR;
    }
    if constexpr (F8) asm volatile("s_nop 15\n\ts_nop 15" ::: "memory");
    { const int l2 = otid() & 63; E(acc, cur, wr, wc, l2 & 15, l2 >> 4); }
    if (!has_next) break;
#pragma unroll
    for (int a = 0; a < 2; ++a)
#pragma unroll
      for (int b = 0; b < 2; ++b)
#pragma unroll
        for (int m = 0; m < 4; ++m)
#pragma unroll
          for (int n = 0; n < 2; ++n) acc[a][b][m][n] = f32x4{0.f, 0.f, 0.f, 0.f};
    cur = nxt; cA = nA; cB = nB; ++ui;
  }
  PG8_WAIT_V(0);
  if (wr == 0) PG8_BAR;
  PG8_BAR;
#undef PG8_SA
#undef PG8_SB
#undef PG8_STAGE
#undef PG8_LDA
#undef PG8_LD16
#undef PG8_LDB
#undef PG8_MMA
#undef PG8_WAIT_V
#undef PG8_WAIT_L
#undef PG8_BAR
#undef PG8_SCHED
}
#define E8_FOR _Pragma("unroll") for (int ai = 0; ai < 2; ++ai) _Pragma("unroll") for (int m = 0; m < 4; ++m) _Pragma("unroll") for (int bj = 0; bj < 2; ++bj)

DEV void conv_tile(const ConvJob& J, int t) {
  const int tid = otid();
  int mat = t / J.tpm, tt = t % J.tpm;
  int kt = tt / J.ntn, nt = tt % J.ntn;
  const float* src = J.src + (long)mat * J.sstride;
  u16* dst = J.dst + (long)mat * J.dstride;
  const int kg = tid >> 6, ng = tid & 63;
  const int n = nt * 256 + ng * 4;
  float4 v[8];
#pragma unroll
  for (int j = 0; j < 8; ++j) {
    int k = kt * 64 + kg * 8 + j;
    if (n < J.N) v[j] = *reinterpret_cast<const float4*>(src + (long)k * J.N + n);
    else v[j] = make_float4(0.f, 0.f, 0.f, 0.f);
  }
#pragma unroll
  for (int i = 0; i < 4; ++i) {
    float e[8];
#pragma unroll
    for (int j = 0; j < 8; ++j) e[j] = (i == 0) ? v[j].x : (i == 1) ? v[j].y : (i == 2) ? v[j].z : v[j].w;
    uint4 pk;
    pk.x = pack2(e[0], e[1]); pk.y = pack2(e[2], e[3]); pk.z = pack2(e[4], e[5]); pk.w = pack2(e[6], e[7]);
    *reinterpret_cast<uint4*>(smem + (i * 64 + ng) * 144 + kg * 16) = pk;
  }
  __syncthreads();
#pragma unroll
  for (int u = 0; u < 4; ++u) {
    int q = tid + 512 * u;
    int nl = q >> 3, ch = q & 7;
    uint4 pk = *reinterpret_cast<const uint4*>(smem + ((nl & 3) * 64 + (nl >> 2)) * 144 + ch * 16);
    int nn = nt * 256 + nl;
    const int qq = nn >> J.rsh;
    long drow = (long)(qq >> J.sh2) * J.rs + (qq & ((1 << J.sh2) - 1)) * J.off2 + (nn & ((1 << J.rsh) - 1)) + J.off;
    *reinterpret_cast<uint4*>(dst + drow * J.K + kt * 64 + ch * 8) = pk;
  }
  __syncthreads();
}

DEV void conv_tile_f8(const ConvJob& J, int t) {
  const int tid = otid();
  int mat = t / J.tpm, tt = t % J.tpm;
  int kt = tt / J.ntn, nt = tt % J.ntn;
  const float* src = J.src + (long)mat * J.sstride;
  unsigned char* dst = reinterpret_cast<unsigned char*>(J.dst) + (long)mat * J.dstride;
  const int kg = tid >> 5, ng = tid & 31;
  const int n = nt * 128 + ng * 4;
  const float sc = J.fscale;
  float4 v[8];
#pragma unroll
  for (int j = 0; j < 8; ++j) v[j] = *reinterpret_cast<const float4*>(src + (long)(kt * 128 + kg * 8 + j) * J.N + n);
#pragma unroll
  for (int i = 0; i < 4; ++i) {
    float e[8];
#pragma unroll
    for (int j = 0; j < 8; ++j) e[j] = ((i == 0) ? v[j].x : (i == 1) ? v[j].y : (i == 2) ? v[j].z : v[j].w) * sc;
    uint2 pk; pk.x = pack4_f8(e[0], e[1], e[2], e[3]); pk.y = pack4_f8(e[4], e[5], e[6], e[7]);
    *reinterpret_cast<uint2*>(smem + (i * 32 + ng) * 144 + kg * 8) = pk;
  }
  __syncthreads();
#pragma unroll
  for (int u = 0; u < 2; ++u) {
    int q = tid + 512 * u;
    int nl = q >> 3, ch = q & 7;
    uint4 pk = *reinterpret_cast<const uint4*>(smem + ((nl & 3) * 32 + (nl >> 2)) * 144 + ch * 16);
    int nn = nt * 128 + nl;
    const int qq = nn >> J.rsh;
    long drow = (long)(qq >> J.sh2) * J.rs + (qq & ((1 << J.sh2) - 1)) * J.off2 + (nn & ((1 << J.rsh) - 1)) + J.off;
    *reinterpret_cast<uint4*>(dst + drow * J.K + kt * 128 + ch * 16) = pk;
  }
  __syncthreads();
}

DEV void phase_prep(const Params& p) {
  const int tid = otid(), nb = gridDim.x, bid = blockIdx.x;
  {
    float* zb = reinterpret_cast<float*>(smem);
    float* h1b = zb + 512;
    float* h2g = reinterpret_cast<float*>(p.ws + S_H2);
    const int w = tid >> 6, lane = tid & 63;
    for (int l0 = bid * 8; l0 < SEQ; l0 += nb * 8) {
      int l = l0 + w;
      float tt = (float)l / (float)(SEQ - 1);
      float ww = 6.283185307179586f * (float)l / (float)SEQ;
      float z = 0.f;
      if (lane == 0) z = tt;
      else if (lane <= 16) { float f = 1e-4f + (float)(lane - 1) * ((15.0f - 1e-4f) / 15.0f); z = cosf(f * ww); }
      else if (lane <= 32) { float f = 1e-4f + (float)(lane - 17) * ((15.0f - 1e-4f) / 15.0f); z = -sinf(f * ww); }
      zb[w * 64 + lane] = z;
      __syncthreads();
      float fr_ = p.hy_f_freq[lane];
      float a = p.hy_f_b1[lane];
      for (int k = 0; k < 33; ++k) a += zb[w * 64 + k] * p.hy_f_w1[k * 64 + lane];
      h1b[w * 64 + lane] = sinf(fr_ * a);
      __syncthreads();
      float a2 = p.hy_f_b2[lane];
      for (int k = 0; k < 64; ++k) a2 += h1b[w * 64 + k] * p.hy_f_w2[k * 64 + lane];
      h2g[l * 64 + lane] = sinf(fr_ * a2);
      __syncthreads();
    }
  }
  {
    u16* xb = reinterpret_cast<u16*>(p.ws + REG_X);
    const long n8 = (long)TOK * DM / 8;
    for (long i = (long)bid * 512 + tid; i < n8; i += (long)nb * 512) {
      float4 a = reinterpret_cast<const float4*>(p.x)[2 * i], b = reinterpret_cast<const float4*>(p.x)[2 * i + 1];
      uint4 pk; pk.x = pack2(a.x, a.y); pk.y = pack2(a.z, a.w); pk.z = pack2(b.x, b.y); pk.w = pack2(b.z, b.w);
      reinterpret_cast<uint4*>(xb)[i] = pk;
    }
    u16* pb = reinterpret_cast<u16*>(p.ws + REG_P);
    const long m8 = 2L * TOK * 256 / 8;
    for (long i = (long)bid * 512 + tid; i < m8; i += (long)nb * 512) {
      float4 a = reinterpret_cast<const float4*>(p.p)[2 * i], b = reinterpret_cast<const float4*>(p.p)[2 * i + 1];
      uint4 pk; pk.x = pack2(a.x, a.y); pk.y = pack2(a.z, a.w); pk.z = pack2(b.x, b.y); pk.w = pack2(b.z, b.w);
      reinterpret_cast<uint4*>(pb)[i] = pk;
    }
  }
  for (int t = bid; t < p.conv_total; t += nb) {
    int j = 0;
#pragma unroll 1
    for (int q = 1; q < NJOBS; ++q) if (t >= p.jobs[q].tile0 && p.jobs[q].ntiles > 0) j = q;
    if (p.jobs[j].f8) conv_tile_f8(p.jobs[j], t - p.jobs[j].tile0); else conv_tile(p.jobs[j], t - p.jobs[j].tile0);
  }
}

DEV void filter_b(const Params& p, int cpair) {
  const int tid = otid();
  float* w3s = reinterpret_cast<float*>(smem);
  float* red = w3s + 512;
  float* nrm = red + 32;
  float* hb = nrm + 4;
  const float* h2g = reinterpret_cast<const float*>(p.ws + S_H2);
  {
    int ci = tid >> 6, k = tid & 63;
    int o = ci >> 2, d = (ci >> 1) & 1, cc = ci & 1;
    w3s[ci * 64 + k] = p.hy_f_w3[k * 2048 + o * 1024 + d * 512 + 2 * cpair + cc];
  }
  __syncthreads();
  const float min_decay = logf(1e-2f) / 1.5f, max_decay = logf(1e-2f) / 0.3f;
#pragma unroll 1
  for (int i = 0; i < 4; ++i) {
    int l = tid + 512 * i;
    float h2[64];
#pragma unroll
    for (int k = 0; k < 16; ++k) {
      float4 v = *reinterpret_cast<const float4*>(h2g + l * 64 + k * 4);
      h2[4 * k] = v.x; h2[4 * k + 1] = v.y; h2[4 * k + 2] = v.z; h2[4 * k + 3] = v.w;
    }
    float tt = (float)l / (float)(SEQ - 1);
#pragma unroll 1
    for (int ci = 0; ci < 8; ++ci) {
      float a = 0.f;
#pragma unroll
      for (int k = 0; k < 64; ++k) a += h2[k] * w3s[ci * 64 + k];
      int cc = ci & 1;
      int c = 2 * cpair + cc;
      float delta = fabsf(min_decay + (float)c * ((max_decay - min_decay) / 511.0f));
      a *= expf(-tt * delta);
      hb[ci * 2048 + l] = a;
    }
  }
  __syncthreads();
  {
    float ss[4];
#pragma unroll
    for (int oc = 0; oc < 4; ++oc) {
      int o = oc >> 1, cc = oc & 1;
      float a = 0.f;
      for (int l = tid; l < 2048; l += 512) {
        float f = hb[(o * 4 + 0 + cc) * 2048 + l];
        float b = (l > 0) ? hb[(o * 4 + 2 + cc) * 2048 + l] : 0.f;
        a += f * f + b * b;
      }
      ss[oc] = wave_sum(a);
    }
    if ((tid & 63) == 0) {
#pragma unroll
      for (int q = 0; q < 4; ++q) red[(tid >> 6) * 4 + q] = ss[q];
    }
  }
  __syncthreads();
  if (tid < 4) {
    float s = 0.f;
    for (int w = 0; w < 8; ++w) s += red[w * 4 + tid];
    nrm[tid] = rsqrtf(s + 1e-12f);
  }
  __syncthreads();
  u16* Rg = reinterpret_cast<u16*>(p.ws + S_RG);
  for (int q = tid; q < 4 * 4096; q += 512) {
    int oc = q >> 12, qq = q & 4095;
    int o = oc >> 1, cc = oc & 1;
    float v;
    if (qq == 0) v = 0.f;
    else if (qq <= 2048) v = hb[(o * 4 + 0 * 2 + cc) * 2048 + (2048 - qq)];
    else v = hb[(o * 4 + 1 * 2 + cc) * 2048 + (qq - 2048)];
    v *= nrm[oc];
    Rg[((long)o * 512 + 2 * cpair + cc) * 4096 + qq] = f2bf(v);
  }
  __syncthreads();
}

DEV void phase_abin(const Params& p) {
  const int nb = gridDim.x;
  for (int c = blockIdx.x; c < 256; c += nb) filter_b(p, c);
  const u16* xb = reinterpret_cast<const u16*>(p.ws + REG_X);
  const u16* wt = reinterpret_cast<const u16*>(p.ws + W_ABIN);
  u16* qk = reinterpret_cast<u16*>(p.ws + REG_B);
  u16* vht = reinterpret_cast<u16*>(p.ws + REG_B + 33554432ull);
  gemm_phase<true, true, false>(1024, 64, 4, [&](const Unit& u, const char*& a, const char*& b) { a = (const char*)(xb) + (size_t)u.pm * 256 * (1024) * 2; b = (const char*)(wt) + (size_t)u.pn * 256 * (1024) * 2; },
      [&](Acc8& acc, const Unit& u, int wr, int wc, int fr, int fq) {
        const float sc = (u.pn < 2) ? 0.125f : 1.0f;
        u16* base = qk + (long)(u.pm * 256 + wr * 64 + fr) * 1024 + u.pn * 256 + wc * 32 + 8 * fq;
        E8_FOR {
          f32x4 v0 = acc[ai][bj][m][0], v1 = acc[ai][bj][m][1];
          uint4 pk;
          pk.x = cvt_pk_bf16(v0[0] * sc, v0[1] * sc); pk.y = cvt_pk_bf16(v0[2] * sc, v0[3] * sc);
          pk.z = cvt_pk_bf16(v1[0] * sc, v1[1] * sc); pk.w = cvt_pk_bf16(v1[2] * sc, v1[3] * sc);
          *reinterpret_cast<uint4*>(base + (ai * 128 + m * 16) * 1024 + bj * 128) = pk;
        }
      });
  gemm_phase<false, false, false>(1024, 64, 8, [&](const Unit& u, const char*& a, const char*& b) { a = (const char*)(xb) + (size_t)u.pm * 256 * (1024) * 2; b = (const char*)(wt + 1024 * 1024) + (size_t)u.pn * 256 * (1024) * 2; },
      [&](Acc8& acc, const Unit& u, int wr, int wc, int fr, int fq) {
        u16* base = vht + (long)(u.pn * 256 + wc * 32 + fr) * TOK + u.pm * 256 + wr * 64 + 4 * fq;
        E8_FOR {
#pragma unroll
          for (int n = 0; n < 2; ++n) {
            f32x4 v = acc[ai][bj][m][n];
            uint2 pk; pk.x = cvt_pk_bf16(v[0], v[1]); pk.y = cvt_pk_bf16(v[2], v[3]);
            *reinterpret_cast<uint2*>(base + (long)(bj * 128 + n * 16) * TOK + ai * 128 + m * 16) = pk;
          }
        }
      });
}

constexpr int NA_VST = 580;
constexpr int NA_V_OFF = 576 * 128;
DEV void na_pair(const Params& p, int u) {
  const int tid = otid(), lane = tid & 63, wid = tid >> 6, fr = lane & 15, fq = lane >> 4;
  const int rp = u & 15, h = (u >> 4) & 7, b = u >> 7;
  const int rbase = min(max(2 * rp - 4, 0), 24);
  const int nrows = (rbase == 24) ? 8 : 9;
  const u16* qk = reinterpret_cast<const u16*>(p.ws + REG_B);
  const u16* vht = reinterpret_cast<const u16*>(p.ws + REG_B + 33554432ull);
  u16* cat = reinterpret_cast<u16*>(p.ws + REG_A + 100663296ull);
  char* kl = smem;
  u16* vl = reinterpret_cast<u16*>(smem + NA_V_OFF);
  const long tok0 = (long)b * SEQ + rbase * 64;
  __syncthreads();
#pragma unroll
  for (int i = 0; i < 9; ++i) {
    const int q = tid + 512 * i, key = q >> 3, ch = q & 7;
    if (key < nrows * 64) {
      uint4 v = *reinterpret_cast<const uint4*>(qk + (tok0 + key) * 1024 + 512 + h * 64 + ch * 8);
      *reinterpret_cast<uint4*>(kl + key * 128 + ((ch ^ ((key >> 1) & 7)) << 4)) = v;
    }
  }
#pragma unroll
  for (int i = 0; i < 9; ++i) {
    const int q = tid + 512 * i, d = q / 72, ch = q % 72;
    if (ch < nrows * 8) {
      uint4 v = *reinterpret_cast<const uint4*>(vht + (long)(h * 64 + d) * TOK + tok0 + ch * 8);
      u16* dst = vl + d * NA_VST + ch * 8;
      *reinterpret_cast<uint2*>(dst) = make_uint2(v.x, v.y);
      *reinterpret_cast<uint2*>(dst + 4) = make_uint2(v.z, v.w);
    }
  }
  __syncthreads();
  const int g = wid & 3, r = 2 * rp + (wid >> 2);
  const int r0 = min(max(r - 4, 0), 24), ro = r0 - rbase, cs = min(max(16 * g - 8, 0), 32);
  const int c = 16 * g + fr;
  const long tokq = (long)b * SEQ + r * 64 + c;
  bf16x8 qf[2];
#pragma unroll
  for (int ks = 0; ks < 2; ++ks) qf[ks] = *reinterpret_cast<const bf16x8*>(qk + tokq * 1024 + h * 64 + ks * 32 + fq * 8);
  f32x4 s[16];
#pragma unroll
  for (int kt = 0; kt < 16; ++kt) {
    const int w = kt >> 1, half = kt & 1;
    const int key = (ro + w) * 64 + cs + 16 * half + fr;
    const int sw = (key >> 1) & 7;
    bf16x8 k0 = *reinterpret_cast<const bf16x8*>(kl + key * 128 + ((fq ^ sw) << 4));
    bf16x8 k1 = *reinterpret_cast<const bf16x8*>(kl + key * 128 + (((4 + fq) ^ sw) << 4));
    f32x4 a = {0.f, 0.f, 0.f, 0.f};
    a = __builtin_amdgcn_mfma_f32_16x16x32_bf16(k0, qf[0], a, 0, 0, 0);
    a = __builtin_amdgcn_mfma_f32_16x16x32_bf16(k1, qf[1], a, 0, 0, 0);
    s[kt] = a;
  }
  const int c0 = min(max(c - 8, 0), 48);
  const float* rpb = p.na_rpb + h * 15 * 31;
  float mx = -1e30f;
#pragma unroll
  for (int kt = 0; kt < 16; ++kt) {
    const int w = kt >> 1, half = kt & 1;
    const int dr = r0 + w - r + 7;
#pragma unroll
    for (int j = 0; j < 4; ++j) {
      int kc = cs + 16 * half + 4 * fq + j;
      bool valid = (kc >= c0) && (kc < c0 + 16);
      int dc = min(max(kc - c, -15), 15) + 15;
      float bias = rpb[dr * 31 + dc];
      float v = valid ? (s[kt][j] + bias) : -1e30f;
      s[kt][j] = v;
      mx = fmaxf(mx, v);
    }
  }
  mx = fmaxf(mx, __shfl_xor(mx, 16));
  mx = fmaxf(mx, __shfl_xor(mx, 32));
  float sum = 0.f;
#pragma unroll
  for (int kt = 0; kt < 16; ++kt)
#pragma unroll
    for (int j = 0; j < 4; ++j) { float e = __expf(s[kt][j] - mx); s[kt][j] = e; sum += e; }
  sum += __shfl_xor(sum, 16);
  sum += __shfl_xor(sum, 32);
  f32x4 o[4];
#pragma unroll
  for (int dt = 0; dt < 4; ++dt) o[dt] = f32x4{0.f, 0.f, 0.f, 0.f};
#pragma unroll
  for (int w = 0; w < 8; ++w) {
    union { bf16x8 v; unsigned u[4]; } pf;
    pf.u[0] = cvt_pk_bf16(s[2 * w][0], s[2 * w][1]); pf.u[1] = cvt_pk_bf16(s[2 * w][2], s[2 * w][3]);
    pf.u[2] = cvt_pk_bf16(s[2 * w + 1][0], s[2 * w + 1][1]); pf.u[3] = cvt_pk_bf16(s[2 * w + 1][2], s[2 * w + 1][3]);
#pragma unroll
    for (int dt = 0; dt < 4; ++dt) {
      const u16* vp = vl + (dt * 16 + fr) * NA_VST + (ro + w) * 64 + cs + 4 * fq;
      union { bf16x8 v; uint2 u[2]; } af;
      af.u[0] = *reinterpret_cast<const uint2*>(vp);
      af.u[1] = *reinterpret_cast<const uint2*>(vp + 16);
      o[dt] = __builtin_amdgcn_mfma_f32_16x16x32_bf16(af.v, pf.v, o[dt], 0, 0, 0);
    }
  }
  const float inv = 1.0f / sum;
#pragma unroll
  for (int dt = 0; dt < 4; ++dt) {
    uint2 pk; pk.x = pack2(o[dt][0] * inv, o[dt][1] * inv); pk.y = pack2(o[dt][2] * inv, o[dt][3] * inv);
    *reinterpret_cast<uint2*>(cat + tokq * 1024 + h * 64 + dt * 16 + 4 * fq) = pk;
  }
}

constexpr int UB_STRIDE = 2056;
constexpr int RC_STRIDE = 4120;
constexpr int HY_RC_OFF = 2 * NBATCH * UB_STRIDE * 2;
DEV float shortconv(const u16* hrow, const float* cw, float cb, int ch, int t) {
  float xm = (t > 0) ? bf2f(hrow[t - 1]) : 0.f;
  float x0 = bf2f(hrow[t]);
  float xp = (t < SEQ - 1) ? bf2f(hrow[t + 1]) : 0.f;
  return cb + xm * cw[ch] + x0 * cw[1536 + ch] + xp * cw[2 * 1536 + ch];
}
DEV void load_rc(const Params& p, int o, int c) {
  const int tid = otid();
  char* rc = smem + HY_RC_OFF;
  const u16* Rg = reinterpret_cast<const u16*>(p.ws + S_RG) + ((long)o * 512 + c) * 4096;
  const float skip = p.hy_skip[o * 512 + c];
  const int i0 = tid * 8;
  uint4 lo = *reinterpret_cast<const uint4*>(Rg + i0);
  uint4 hi = (tid < 511) ? *reinterpret_cast<const uint4*>(Rg + i0 + 8) : make_uint4(0u, 0u, 0u, 0u);
  unsigned w[8] = {lo.x, lo.y, lo.z, lo.w, hi.x, hi.y, hi.z, hi.w};
  if (tid == 256) w[0] = (w[0] & 0xffff0000u) | (unsigned)f2bf(bf2f((u16)(w[0] & 0xffffu)) + skip);
  if (tid == 255) w[4] = (w[4] & 0xffff0000u) | (unsigned)f2bf(bf2f((u16)(w[4] & 0xffffu)) + skip);
#pragma unroll
  for (int m = 0; m < 8; ++m) {
    uint4 o4;
    if (m & 1) {
      o4.x = __builtin_amdgcn_alignbyte(w[m / 2 + 1], w[m / 2], 2);
      o4.y = __builtin_amdgcn_alignbyte(w[m / 2 + 2], w[m / 2 + 1], 2);
      o4.z = __builtin_amdgcn_alignbyte(w[m / 2 + 3], w[m / 2 + 2], 2);
      o4.w = __builtin_amdgcn_alignbyte(w[m / 2 + 4], w[m / 2 + 3], 2);
    } else {
      o4.x = w[m / 2]; o4.y = w[m / 2 + 1]; o4.z = w[m / 2 + 2]; o4.w = w[m / 2 + 3];
    }
    *reinterpret_cast<uint4*>(rc + m * (RC_STRIDE * 2) + i0 * 2) = o4;
  }
}
DEV void hyena_conv(const u16* ub, f32x4 (&acc)[16]) {
  const int lane = otid() & 63, wid = __builtin_amdgcn_readfirstlane(otid() >> 6), fr = lane & 15, fq = lane >> 4;
  const int mcopy = (-wid) & 7;
  const u16* rbase = reinterpret_cast<const u16*>(smem + HY_RC_OFF) + mcopy * RC_STRIDE + (8 * fq - 8 * fr + 2048 - (wid + mcopy));
#pragma unroll
  for (int i = 0; i < 16; ++i) acc[i] = f32x4{0.f, 0.f, 0.f, 0.f};
  const u16* urow = ub + (fr & 7) * UB_STRIDE + fq * 8;
#pragma unroll 1
  for (int kk = 0; kk < 64; ++kk) {
    bf16x8 bfr = *reinterpret_cast<const bf16x8*>(urow + kk * 32);
    const u16* rk = rbase + 32 * kk;
#pragma unroll
    for (int T = 0; T < 16; ++T) {
      bf16x8 af = *reinterpret_cast<const bf16x8*>(rk - 128 * T);
      acc[T] = __builtin_amdgcn_mfma_f32_16x16x32_bf16(af, bfr, acc[T], 0, 0, 0);
    }
  }
}
DEV void shortconv_pass(const u16* __restrict__ hrow  , u16* ub, const float* cw, float cb, int ch) {
  const float w0 = cw[ch], w1 = cw[1536 + ch], w2 = cw[2 * 1536 + ch];
  for (int q = otid(); q < TOK / 8; q += 512) {
    const int i = q * 8, b = i >> 11, t = i & 2047;
    uint4 v = *reinterpret_cast<const uint4*>(hrow + i);
    float x[10];
    x[0] = (t > 0) ? bf2f(hrow[i - 1]) : 0.f;
    x[9] = (t + 8 < SEQ) ? bf2f(hrow[i + 8]) : 0.f;
    x[1] = __uint_as_float(v.x << 16); x[2] = __uint_as_float(v.x & 0xffff0000u);
    x[3] = __uint_as_float(v.y << 16); x[4] = __uint_as_float(v.y & 0xffff0000u);
    x[5] = __uint_as_float(v.z << 16); x[6] = __uint_as_float(v.z & 0xffff0000u);
    x[7] = __uint_as_float(v.w << 16); x[8] = __uint_as_float(v.w & 0xffff0000u);
    float y[8];
#pragma unroll
    for (int j = 0; j < 8; ++j) y[j] = cb + x[j] * w0 + x[j + 1] * w1 + x[j + 2] * w2;
    uint4 o4; o4.x = pack2(y[0], y[1]); o4.y = pack2(y[2], y[3]); o4.z = pack2(y[4], y[5]); o4.w = pack2(y[6], y[7]);
    *reinterpret_cast<uint4*>(ub + b * UB_STRIDE + t) = o4;
  }
}
DEV void hyena_unit(const Params& p, int c) {
  const int tid = otid(), lane = tid & 63, wid = tid >> 6, fr = lane & 15, fq = lane >> 4;
  u16* ubA = reinterpret_cast<u16*>(smem);
  u16* ubB = ubA + NBATCH * UB_STRIDE;
  const u16* hbt = reinterpret_cast<const u16*>(p.ws + REG_B + 33554432ull) + 512L * TOK;
  u16* zT = reinterpret_cast<u16*>(p.ws + REG_C);
  const float* cw = p.hy_conv_w;
  shortconv_pass(hbt + (long)c * TOK, ubA, cw, p.hy_conv_b[c], c);
  shortconv_pass(hbt + (long)(512 + c) * TOK, ubB, cw, p.hy_conv_b[512 + c], 512 + c);
  load_rc(p, 0, c);
  __syncthreads();
  f32x4 acc[16];
  hyena_conv(ubA, acc);
  if (fr < 8) {
#pragma unroll
    for (int T = 0; T < 16; ++T)
#pragma unroll
      for (int j = 0; j < 4; ++j) {
        const int t = 128 * T + wid + 8 * (4 * fq + j);
        u16* q = ubB + fr * UB_STRIDE + t;
        *q = f2bf(bf2f(*q) * acc[T][j]);
      }
  }
  __syncthreads();
  shortconv_pass(hbt + (long)(1024 + c) * TOK, ubA, cw, p.hy_conv_b[1024 + c], 1024 + c);
  load_rc(p, 1, c);
  __syncthreads();
  hyena_conv(ubB, acc);
  if (fr < 8) {
#pragma unroll
    for (int T = 0; T < 16; ++T)
#pragma unroll
      for (int j = 0; j < 4; ++j) {
        const int t = 128 * T + wid + 8 * (4 * fq + j);
        u16* q = ubA + fr * UB_STRIDE + t;
        *q = f2bf(bf2f(*q) * acc[T][j]);
      }
  }
  __syncthreads();
  for (int q = tid; q < TOK / 8; q += 512) {
    const int i = q * 8, b = i >> 11, t = i & 2047;
    *reinterpret_cast<uint4*>(zT + (long)c * TOK + i) = *reinterpret_cast<const uint4*>(ubA + b * UB_STRIDE + t);
  }
  __syncthreads();
}
DEV void phase_ztrans(const Params& p) {
  const int tid = otid();
  const u16* zT = reinterpret_cast<const u16*>(p.ws + REG_C);
  u16* cat = reinterpret_cast<u16*>(p.ws + REG_A + 100663296ull);
  u16* tile = reinterpret_cast<u16*>(smem);
  for (int tb = blockIdx.x; tb < TOK / 64; tb += gridDim.x) {
    __syncthreads();
    const u16* src = zT + (long)tid * TOK + tb * 64;
#pragma unroll
    for (int k = 0; k < 8; ++k) *reinterpret_cast<uint4*>(tile + tid * 72 + k * 8) = *reinterpret_cast<const uint4*>(src + k * 8);
    __syncthreads();
#pragma unroll
    for (int k = 0; k < 8; ++k) {
      const int q = tid + 512 * k;
      const int tk = q >> 6, ch8 = (q & 63) * 8;
      unsigned w[4];
#pragma unroll
      for (int j = 0; j < 4; ++j) w[j] = (unsigned)tile[(ch8 + 2 * j) * 72 + tk] | ((unsigned)tile[(ch8 + 2 * j + 1) * 72 + tk] << 16);
      *reinterpret_cast<uint4*>(cat + (long)(tb * 64 + tk) * 1024 + 512 + ch8) = make_uint4(w[0], w[1], w[2], w[3]);
    }
  }
}
DEV void phase_mix0(const Params& p) {
  const int nb = gridDim.x;
  for (int c = blockIdx.x; c < 512; c += nb) hyena_unit(p, c);
  for (int u = blockIdx.x; u < 1024; u += nb) na_pair(p, u);
}

DEV void phase_outproj(const Params& p, const u16* A, const u16* wt, const float* xres) {
  float* pre1 = reinterpret_cast<float*>(p.ws + REG_C);
  gemm_phase<true, false, false>(1024, 64, 4, [&](const Unit& u, const char*& a, const char*& b) { a = (const char*)(A) + (size_t)u.pm * 256 * (1024) * 2; b = (const char*)(wt) + (size_t)u.pn * 256 * (1024) * 2; },
      [&](Acc8& acc, const Unit& u, int wr, int wc, int fr, int fq) {
        const long o0 = (long)(u.pm * 256 + wr * 64 + fr) * 1024 + u.pn * 256 + wc * 32 + 4 * fq;
        E8_FOR {
#pragma unroll
          for (int n = 0; n < 2; ++n) {
            const long o = o0 + (ai * 128 + m * 16) * 1024 + bj * 128 + n * 16;
            f32x4 xr = *reinterpret_cast<const f32x4*>(xres + o);
            *reinterpret_cast<f32x4*>(pre1 + o) = xr * DN_ALPHA + acc[ai][bj][m][n];
          }
        }
      });
}

DEV void phase_ln1_router(const Params& p, int layer) {
  const int tid = otid(), lane = tid & 63, wid = tid >> 6, nb = gridDim.x;
  float* wrT = reinterpret_cast<float*>(smem);
  const float* wr = p.moe_router + (long)layer * 1024 * 16;
  for (int i = tid; i < 16384; i += 512) { int c = i >> 4, e = i & 15; wrT[e * 1024 + c] = wr[i]; }
  __syncthreads();
  const float* pre1 = reinterpret_cast<const float*>(p.ws + REG_C);
  float* x1 = reinterpret_cast<float*>(p.ws + REG_D);
  unsigned char* x1q = reinterpret_cast<unsigned char*>(p.ws + REG_E);
  float* aff = reinterpret_cast<float*>(p.ws + S_AFF);
  const float* g = p.ln1_g + layer * 1024; const float* bb = p.ln1_b + layer * 1024;
  for (int tok = blockIdx.x * 8 + wid; tok < TOK; tok += nb * 8) {
    float4 v[4];
    float s = 0.f;
#pragma unroll
    for (int i = 0; i < 4; ++i) { v[i] = *reinterpret_cast<const float4*>(pre1 + (long)tok * 1024 + i * 256 + lane * 4); s += v[i].x + v[i].y + v[i].z + v[i].w; }
    float mu = wave_sum(s) * (1.0f / 1024.0f);
    float q = 0.f;
#pragma unroll
    for (int i = 0; i < 4; ++i) { v[i].x -= mu; v[i].y -= mu; v[i].z -= mu; v[i].w -= mu; q += v[i].x * v[i].x + v[i].y * v[i].y + v[i].z * v[i].z + v[i].w * v[i].w; }
    float rstd = rsqrtf(wave_sum(q) * (1.0f / 1024.0f) + LN_EPS);
    float4 y[4];
#pragma unroll
    for (int i = 0; i < 4; ++i) {
      int c = i * 256 + lane * 4;
      float4 gg = *reinterpret_cast<const float4*>(g + c), b4 = *reinterpret_cast<const float4*>(bb + c);
      y[i].x = v[i].x * rstd * gg.x + b4.x; y[i].y = v[i].y * rstd * gg.y + b4.y; y[i].z = v[i].z * rstd * gg.z + b4.z; y[i].w = v[i].w * rstd * gg.w + b4.w;
      *reinterpret_cast<float4*>(x1 + (long)tok * 1024 + c) = y[i];
      *reinterpret_cast<unsigned*>(x1q + (long)tok * 1024 + c) = pack4_f8(y[i].x, y[i].y, y[i].z, y[i].w);
    }
    float lg[16];
#pragma unroll
    for (int e = 0; e < 16; ++e) {
      float a = 0.f;
#pragma unroll
      for (int i = 0; i < 4; ++i) {
        float4 w4 = *reinterpret_cast<const float4*>(wrT + e * 1024 + i * 256 + lane * 4);
        a += y[i].x * w4.x + y[i].y * w4.y + y[i].z * w4.z + y[i].w * w4.w;
      }
      lg[e] = a;
      if (e & 1) asm volatile("" ::: "memory");
    }
#pragma unroll
    for (int s_ = 0; s_ < 4; ++s_) {
      const int bit = 1 << s_;
      const bool up = (lane & bit) != 0;
#pragma unroll
      for (int i = 0; i < (8 >> s_); ++i) {
        float lo = lg[2 * i], hi = lg[2 * i + 1];
        float snd = up ? lo : hi;
        float rcv = __shfl_xor(snd, bit);
        lg[i] = (up ? hi : lo) + rcv;
      }
    }
    float mine = lg[0];
    mine += __shfl_xor(mine, 16);
    mine += __shfl_xor(mine, 32);
    float mx = mine;
#pragma unroll
    for (int o = 8; o > 0; o >>= 1) mx = fmaxf(mx, __shfl_xor(mx, o));
    float ex = expf(mine - mx);
    float den = ex;
#pragma unroll
    for (int o = 8; o > 0; o >>= 1) den += __shfl_xor(den, o);
    if (lane < 16) {
      int b = tok >> 11, l = tok & 2047;
      aff[((long)b * 16 + lane) * SEQ + l] = ex / den;
    }
  }
}

DEV void phase_topk(const Params& p) {
  const int tid = otid(), nb = gridDim.x, lane = tid & 63, wid = tid >> 6;
  unsigned* key = reinterpret_cast<unsigned*>(smem);
  int* rows = reinterpret_cast<int*>(smem + 8192);
  unsigned* hist = reinterpret_cast<unsigned*>(smem + 9216);
  unsigned* wsum = reinterpret_cast<unsigned*>(smem + 10240);
  unsigned* bc = reinterpret_cast<unsigned*>(smem + 10304);
  const float* aff = reinterpret_cast<const float*>(p.ws + S_AFF);
  float* gsel = reinterpret_cast<float*>(p.ws + S_GSEL);
  int* slot = reinterpret_cast<int*>(p.ws + S_SLOT);
  const unsigned char* x1q = reinterpret_cast<const unsigned char*>(p.ws + REG_E);
  unsigned char* Xe = reinterpret_cast<unsigned char*>(p.ws + REG_C);
  for (int be = blockIdx.x; be < NBATCH * NEXP; be += nb) {
    const int b = be >> 4, e = be & 15;
    __syncthreads();
    const float4 av = *reinterpret_cast<const float4*>(aff + (long)be * SEQ + tid * 4);
    const unsigned k0 = __float_as_uint(av.x), k1 = __float_as_uint(av.y), k2 = __float_as_uint(av.z), k3 = __float_as_uint(av.w);
    unsigned prefix = 0u, need = CAP;
#pragma unroll 1
    for (int shift = 24; shift >= 0; shift -= 8) {
      if (tid < 256) hist[tid] = 0u;
      __syncthreads();
      const unsigned hs = (shift == 24) ? 0u : (unsigned)(shift + 8);
      if (shift == 24 || (k0 >> hs) == prefix) atomicAdd(&hist[(k0 >> shift) & 255u], 1u);
      if (shift == 24 || (k1 >> hs) == prefix) atomicAdd(&hist[(k1 >> shift) & 255u], 1u);
      if (shift == 24 || (k2 >> hs) == prefix) atomicAdd(&hist[(k2 >> shift) & 255u], 1u);
      if (shift == 24 || (k3 >> hs) == prefix) atomicAdd(&hist[(k3 >> shift) & 255u], 1u);
      __syncthreads();
      if (wid == 0) {
        unsigned h0 = hist[4 * lane], h1 = hist[4 * lane + 1], h2 = hist[4 * lane + 2], h3 = hist[4 * lane + 3];
        unsigned tot = h0 + h1 + h2 + h3;
        unsigned suf = tot;
#pragma unroll
        for (int o = 1; o < 64; o <<= 1) { unsigned t = __shfl_down(suf, o); if (lane + o < 64) suf += t; }
        const unsigned above = suf - tot;
        int d = -1; unsigned nabove = 0u;
        unsigned c3 = above + h3, c2 = c3 + h2, c1 = c2 + h1, c0 = c1 + h0;
        if (above < need && c0 >= need) {
          if (c3 >= need) { d = 4 * lane + 3; nabove = above; }
          else if (c2 >= need) { d = 4 * lane + 2; nabove = c3; }
          else if (c1 >= need) { d = 4 * lane + 1; nabove = c2; }
          else { d = 4 * lane; nabove = c1; }
          bc[0] = (prefix << 8) | (unsigned)d;
          bc[1] = need - nabove;
        }
      }
      __syncthreads();
      prefix = bc[0]; need = bc[1];
    }
    const unsigned tau = prefix;
    const unsigned e0 = (k0 == tau), e1 = (k1 == tau), e2 = (k2 == tau), e3 = (k3 == tau);
    unsigned eqs = e0 + e1 + e2 + e3;
    unsigned inc = eqs;
#pragma unroll
    for (int o = 1; o < 64; o <<= 1) { unsigned t = __shfl_up(inc, o); if (lane >= o) inc += t; }
    if (lane == 63) wsum[wid] = inc;
    __syncthreads();
    unsigned base = 0u;
#pragma unroll
    for (int w = 0; w < 8; ++w) if (w < wid) base += wsum[w];
    unsigned eqb = base + inc - eqs;
    const unsigned s0 = (k0 > tau) || (e0 && eqb < need); eqb += e0;
    const unsigned s1 = (k1 > tau) || (e1 && eqb < need); eqb += e1;
    const unsigned s2 = (k2 > tau) || (e2 && eqb < need); eqb += e2;
    const unsigned s3 = (k3 > tau) || (e3 && eqb < need);
    const unsigned sels = s0 + s1 + s2 + s3;
    unsigned inc2 = sels;
#pragma unroll
    for (int o = 1; o < 64; o <<= 1) { unsigned t = __shfl_up(inc2, o); if (lane >= o) inc2 += t; }
    if (lane == 63) wsum[8 + wid] = inc2;
    __syncthreads();
    unsigned base2 = 0u;
#pragma unroll
    for (int w = 0; w < 8; ++w) if (w < wid) base2 += wsum[8 + w];
    unsigned sl = base2 + inc2 - sels;
    const int tok0 = tid * 4;
    int sv[4];
    sv[0] = s0 ? (int)sl : -1; sl += s0;
    sv[1] = s1 ? (int)sl : -1; sl += s1;
    sv[2] = s2 ? (int)sl : -1; sl += s2;
    sv[3] = s3 ? (int)sl : -1;
    const float avv[4] = {av.x, av.y, av.z, av.w};
#pragma unroll
    for (int j = 0; j < 4; ++j) {
      slot[((long)b * SEQ + tok0 + j) * 16 + e] = sv[j];
      if (sv[j] >= 0) { rows[sv[j]] = tok0 + j; gsel[be * CAP + sv[j]] = avv[j]; }
    }
    __syncthreads();
    for (int s = wid; s < CAP; s += 8) {
      const int t = rows[s];
      const uint4* src = reinterpret_cast<const uint4*>(x1q + ((long)b * SEQ + t) * 1024);
      uint4* dst = reinterpret_cast<uint4*>(Xe + ((long)(e * 8 + b) * CAP + s) * 1024);
      dst[lane] = src[lane];
    }
  }
}

DEV void phase_moe1(const Params& p, int layer) {
  const unsigned char* Xe = reinterpret_cast<const unsigned char*>(p.ws + REG_C);
  const unsigned char* wgu = reinterpret_cast<const unsigned char*>(p.ws + W_GU) + (long)layer * 16 * 4096 * 1024;
  unsigned char* H = reinterpret_cast<unsigned char*>(p.ws + REG_A);
  gemm_phase<true, true, true>(1024, 128, 16,
      [&](const Unit& u, const char*& a, const char*& b) { a = (const char*)Xe + (size_t)u.pm * 256 * 1024; b = (const char*)wgu + ((size_t)(u.pm >> 3) * 4096 + (size_t)u.pn * 256) * 1024; },
      [&](Acc8& acc, const Unit& u, int wr, int wc, int fr, int fq) {
        unsigned char* base = H + (long)(u.pm * 256 + wr * 64 + fr) * DFF + u.pn * 128 + wc * 32 + 8 * fq;
#pragma unroll
        for (int ai = 0; ai < 2; ++ai)
#pragma unroll
          for (int m = 0; m < 4; ++m) {
            float hv[8];
#pragma unroll
            for (int n = 0; n < 2; ++n)
#pragma unroll
              for (int j = 0; j < 4; ++j) {
                float gte = acc[ai][0][m][n][j] * 0.03125f, up = acc[ai][1][m][n][j] * 0.03125f;
                hv[n * 4 + j] = gte * fsigmoid(gte) * up;
              }
            uint2 pk; pk.x = pack4_f8(hv[0], hv[1], hv[2], hv[3]); pk.y = pack4_f8(hv[4], hv[5], hv[6], hv[7]);
            *reinterpret_cast<uint2*>(base + (ai * 128 + m * 16) * DFF) = pk;
          }
      });
}
DEV void phase_moe2(const Params& p, int layer) {
  const unsigned char* H = reinterpret_cast<const unsigned char*>(p.ws + REG_A);
  const unsigned char* wd = reinterpret_cast<const unsigned char*>(p.ws + W_DN) + (long)layer * 16 * 1024 * 2048;
  const float* gsel = reinterpret_cast<const float*>(p.ws + S_GSEL);
  u16* Ye = reinterpret_cast<u16*>(p.ws + REG_B);
  gemm_phase<true, true, true>(2048, 128, 4,
      [&](const Unit& u, const char*& a, const char*& b) { a = (const char*)H + (size_t)u.pm * 256 * 2048; b = (const char*)wd + ((size_t)(u.pm >> 3) * 1024 + (size_t)u.pn * 256) * 2048; },
      [&](Acc8& acc, const Unit& u, int wr, int wc, int fr, int fq) {
        const int e = u.pm >> 3, b = u.pm & 7;
        const float* gs = gsel + (b * 16 + e) * CAP + wr * 64 + fr;
        u16* base = Ye + (long)(u.pm * 256 + wr * 64 + fr) * 1024 + u.pn * 256 + wc * 32 + 8 * fq;
#pragma unroll
        for (int ai = 0; ai < 2; ++ai)
#pragma unroll
          for (int m = 0; m < 4; ++m) {
            const float g = gs[ai * 128 + m * 16] * 0.015625f;
#pragma unroll
            for (int bj = 0; bj < 2; ++bj) {
              f32x4 v0 = acc[ai][bj][m][0] * g, v1 = acc[ai][bj][m][1] * g;
              uint4 pk;
              pk.x = cvt_pk_bf16(v0[0], v0[1]); pk.y = cvt_pk_bf16(v0[2], v0[3]); pk.z = cvt_pk_bf16(v1[0], v1[1]); pk.w = cvt_pk_bf16(v1[2], v1[3]);
              *reinterpret_cast<uint4*>(base + (ai * 128 + m * 16) * 1024 + bj * 128) = pk;
            }
          }
      });
}
DEV void phase_ln2(const Params& p, int layer) {
  const int tid = otid(), lane = tid & 63, wid = tid >> 6, nb = gridDim.x;
  const float* x1 = reinterpret_cast<const float*>(p.ws + REG_D);
  const u16* Ye = reinterpret_cast<const u16*>(p.ws + REG_B);
  const int* slot = reinterpret_cast<const int*>(p.ws + S_SLOT);
  float* x2 = reinterpret_cast<float*>(p.ws + REG_A);
  u16* x2b = reinterpret_cast<u16*>(p.ws + REG_A + 67108864ull);
  const float* g = p.ln2_g + layer * 1024; const float* bb = p.ln2_b + layer * 1024;
  for (int tok = blockIdx.x * 8 + wid; tok < TOK; tok += nb * 8) {
    const int b = tok >> 11;
    float4 v[4];
#pragma unroll
    for (int i = 0; i < 4; ++i) {
      float4 t = *reinterpret_cast<const float4*>(x1 + (long)tok * 1024 + i * 256 + lane * 4);
      v[i].x = DN_ALPHA * t.x; v[i].y = DN_ALPHA * t.y; v[i].z = DN_ALPHA * t.z; v[i].w = DN_ALPHA * t.w;
    }
    int myslot = (lane < 16) ? slot[(long)tok * 16 + lane] : -1;
    unsigned mask = (unsigned)__ballot(myslot >= 0);
    while (mask) {
      const int e = __builtin_ctz(mask);
      mask &= mask - 1;
      const int sidx = __builtin_amdgcn_readlane(myslot, e);
      const u16* yr = Ye + ((long)(e * 8 + b) * CAP + sidx) * 1024;
      uint2 t[4];
#pragma unroll
      for (int i = 0; i < 4; ++i) t[i] = *reinterpret_cast<const uint2*>(yr + i * 256 + lane * 4);
#pragma unroll
      for (int i = 0; i < 4; ++i) {
        v[i].x += __uint_as_float(t[i].x << 16); v[i].y += __uint_as_float(t[i].x & 0xffff0000u);
        v[i].z += __uint_as_float(t[i].y << 16); v[i].w += __uint_as_float(t[i].y & 0xffff0000u);
      }
    }
    float s = 0.f;
#pragma unroll
    for (int i = 0; i < 4; ++i) s += v[i].x + v[i].y + v[i].z + v[i].w;
    float mu = wave_sum(s) * (1.0f / 1024.0f);
    float q = 0.f;
#pragma unroll
    for (int i = 0; i < 4; ++i) { v[i].x -= mu; v[i].y -= mu; v[i].z -= mu; v[i].w -= mu; q += v[i].x * v[i].x + v[i].y * v[i].y + v[i].z * v[i].z + v[i].w * v[i].w; }
    float rstd = rsqrtf(wave_sum(q) * (1.0f / 1024.0f) + LN_EPS);
#pragma unroll
    for (int i = 0; i < 4; ++i) {
      int c = i * 256 + lane * 4;
      float4 gg = *reinterpret_cast<const float4*>(g + c), b4 = *reinterpret_cast<const float4*>(bb + c);
      float4 y;
      y.x = v[i].x * rstd * gg.x + b4.x; y.y = v[i].y * rstd * gg.y + b4.y; y.z = v[i].z * rstd * gg.z + b4.z; y.w = v[i].w * rstd * gg.w + b4.w;
      *reinterpret_cast<float4*>(x2 + (long)tok * 1024 + c) = y;
      uint2 pk; pk.x = pack2(y.x, y.y); pk.y = pack2(y.z, y.w);
      *reinterpret_cast<uint2*>(x2b + (long)tok * 1024 + c) = pk;
    }
  }
}
DEV void phase_ple(const Params& p, int layer, float* outf, u16* outb) {
  const float* x2 = reinterpret_cast<const float*>(p.ws + REG_A);
  const u16* x2b = reinterpret_cast<const u16*>(p.ws + REG_A + 67108864ull);
  const u16* pb = reinterpret_cast<const u16*>(p.ws + REG_P) + (long)layer * TOK * 256;
  const u16* wg = reinterpret_cast<const u16*>(p.ws + W_PLEG) + (long)layer * 1024 * 1024;
  const u16* wp = reinterpret_cast<const u16*>(p.ws + W_PLEP) + (long)layer * 1024 * 256;
  u16* pp = reinterpret_cast<u16*>(p.ws + REG_C);
  gemm_phase<true, false, false>(256, 64, 4, [&](const Unit& u, const char*& a, const char*& b) { a = (const char*)(pb) + (size_t)u.pm * 256 * (256) * 2; b = (const char*)(wp) + (size_t)u.pn * 256 * (256) * 2; },
      [&](Acc8& acc, const Unit& u, int wr, int wc, int fr, int fq) {
        const long o0 = (long)(u.pm * 256 + wr * 64 + fr) * 1024 + u.pn * 256 + wc * 32 + 4 * fq;
        E8_FOR {
#pragma unroll
          for (int n = 0; n < 2; ++n)
          {
            f32x4 v = acc[ai][bj][m][n];
            uint2 pk; pk.x = cvt_pk_bf16(v[0], v[1]); pk.y = cvt_pk_bf16(v[2], v[3]);
            *reinterpret_cast<uint2*>(pp + o0 + (ai * 128 + m * 16) * 1024 + bj * 128 + n * 16) = pk;
          }
        }
      });
  gemm_phase<true, false, false>(1024, 64, 4, [&](const Unit& u, const char*& a, const char*& b) { a = (const char*)(x2b) + (size_t)u.pm * 256 * (1024) * 2; b = (const char*)(wg) + (size_t)u.pn * 256 * (1024) * 2; },
      [&](Acc8& acc, const Unit& u, int wr, int wc, int fr, int fq) {
        const long o0 = (long)(u.pm * 256 + wr * 64 + fr) * 1024 + u.pn * 256 + wc * 32 + 4 * fq;
        E8_FOR {
#pragma unroll
          for (int n = 0; n < 2; ++n) {
            const long o = o0 + (ai * 128 + m * 16) * 1024 + bj * 128 + n * 16;
            f32x4 a = acc[ai][bj][m][n];
            f32x4 xv = *reinterpret_cast<const f32x4*>(x2 + o);
            const uint2 pq = *reinterpret_cast<const uint2*>(pp + o);
            f32x4 pv = {__uint_as_float(pq.x << 16), __uint_as_float(pq.x & 0xffff0000u), __uint_as_float(pq.y << 16), __uint_as_float(pq.y & 0xffff0000u)};
            f32x4 r;
#pragma unroll
            for (int j = 0; j < 4; ++j) r[j] = xv[j] + pv[j] * fsigmoid(a[j]);
            *reinterpret_cast<f32x4*>(outf + o) = r;
            if (outb) { uint2 pk; pk.x = cvt_pk_bf16(r[0], r[1]); pk.y = cvt_pk_bf16(r[2], r[3]); *reinterpret_cast<uint2*>(outb + o) = pk; }
          }
        }
      });
}
DEV void phase_mla_in(const Params& p) {
  const u16* xb = reinterpret_cast<const u16*>(p.ws + REG_X);
  const u16* wt = reinterpret_cast<const u16*>(p.ws + W_MLAIN);
  float* hm = reinterpret_cast<float*>(p.ws + REG_B);
  gemm_phase<true, false, false>(1024, 64, 3, [&](const Unit& u, const char*& a, const char*& b) { a = (const char*)(xb) + (size_t)u.pm * 256 * (1024) * 2; b = (const char*)(wt) + (size_t)u.pn * 256 * (1024) * 2; },
      [&](Acc8& acc, const Unit& u, int wr, int wc, int fr, int fq) {
        const long o0 = (long)(u.pm * 256 + wr * 64 + fr) * 768 + u.pn * 256 + wc * 32 + 4 * fq;
        E8_FOR {
#pragma unroll
          for (int n = 0; n < 2; ++n)
            *reinterpret_cast<f32x4*>(hm + o0 + (ai * 128 + m * 16) * 768 + bj * 128 + n * 16) = acc[ai][bj][m][n];
        }
      });
}
constexpr size_t MLA_Q = REG_A, MLA_K = REG_A + 50331648ull, MLA_VT = REG_A + 100663296ull;
constexpr size_t MLA_CQN = REG_B + 50331648ull, MLA_CKVN = MLA_CQN + 12582912ull, MLA_O = MLA_CKVN + 8388608ull;
DEV float rope_inv(int i) { return 1.0f / powf(10000.0f, (float)i / 16.0f); }
DEV void phase_mla_norm(const Params& p) {
  const int tid = otid(), lane = tid & 63, wid = tid >> 6, nb = gridDim.x;
  const float* hm = reinterpret_cast<const float*>(p.ws + REG_B);
  u16* cqn = reinterpret_cast<u16*>(p.ws + MLA_CQN);
  u16* ckvn = reinterpret_cast<u16*>(p.ws + MLA_CKVN);
  u16* Kb = reinterpret_cast<u16*>(p.ws + MLA_K);
  for (int tok = blockIdx.x * 8 + wid; tok < TOK; tok += nb * 8) {
    const float* row = hm + (long)tok * 768;
    float q[6], kv[4];
    float sq = 0.f, skv = 0.f;
#pragma unroll
    for (int i = 0; i < 6; ++i) { q[i] = row[i * 64 + lane]; sq += q[i] * q[i]; }
#pragma unroll
    for (int i = 0; i < 4; ++i) { kv[i] = row[384 + i * 64 + lane]; skv += kv[i] * kv[i]; }
    float rq = rsqrtf(wave_sum(sq) * (1.0f / 384.0f) + LN_EPS);
    float rkv = rsqrtf(wave_sum(skv) * (1.0f / 256.0f) + LN_EPS);
#pragma unroll
    for (int i = 0; i < 6; ++i) cqn[(long)tok * 384 + i * 64 + lane] = f2bf(q[i] * rq * p.mla_q_norm[i * 64 + lane]);
#pragma unroll
    for (int i = 0; i < 4; ++i) ckvn[(long)tok * 256 + i * 64 + lane] = f2bf(kv[i] * rkv * p.mla_kv_norm[i * 64 + lane]);
    const int b = tok >> 11, l = tok & 2047;
    float kr = (lane < 32) ? row[640 + lane] : 0.f;
    float x1 = __shfl(kr, lane & 15), x2 = __shfl(kr, (lane & 15) + 16);
    float sn, cs; sincosf((float)l * rope_inv(lane & 15), &sn, &cs);
    float r = (lane & 16) ? (x1 * sn + x2 * cs) : (x1 * cs - x2 * sn);
    u16 rb = f2bf(r);
    for (int hh = 0; hh < 16; hh += 2) {
      int h = hh + (lane >> 5);
      u16 val = (u16)__shfl((int)rb, lane & 31);
      Kb[(((long)b * 16 + h) * SEQ + l) * 96 + 64 + (lane & 31)] = val;
    }
  }
}
DEV void phase_mla_up(const Params& p) {
  const u16* cqn = reinterpret_cast<const u16*>(p.ws + MLA_CQN);
  const u16* ckvn = reinterpret_cast<const u16*>(p.ws + MLA_CKVN);
  const u16* wq = reinterpret_cast<const u16*>(p.ws + W_QUP);
  const u16* wkv = reinterpret_cast<const u16*>(p.ws + W_KVUP);
  u16* Qb = reinterpret_cast<u16*>(p.ws + MLA_Q);
  u16* Kb = reinterpret_cast<u16*>(p.ws + MLA_K);
  u16* VT = reinterpret_cast<u16*>(p.ws + MLA_VT);
  const float qscale = 0.10206207261596577f * 1.4426950408889634f;
  gemm_phase<true, false, false>(384, 64, 6, [&](const Unit& u, const char*& a, const char*& b) { a = (const char*)(cqn) + (size_t)u.pm * 256 * (384) * 2; b = (const char*)(wq) + (size_t)u.pn * 256 * (384) * 2; },
      [&](Acc8& acc, const Unit& u, int wr, int wc, int fr, int fq) {
#pragma unroll
        for (int bj = 0; bj < 2; ++bj) {
          const int c32 = (u.pn * 256 + bj * 128 + wc * 32) >> 5;
          const int h = c32 / 3, part = c32 % 3;
#pragma unroll
          for (int ai = 0; ai < 2; ++ai)
#pragma unroll
            for (int m = 0; m < 4; ++m) {
              const int tok = u.pm * 256 + ai * 128 + wr * 64 + m * 16 + fr;
              const int b = tok >> 11, l = tok & 2047;
              u16* qrow = Qb + (((long)b * 16 + h) * SEQ + l) * 96 + part * 32 + 4 * fq;
              f32x4 a0 = acc[ai][bj][m][0], a1 = acc[ai][bj][m][1];
              if (part == 2) {
#pragma unroll
                for (int j = 0; j < 4; ++j) {
                  float sn, cs; sincosf((float)l * rope_inv(4 * fq + j), &sn, &cs);
                  float r0 = a0[j] * cs - a1[j] * sn, r1 = a0[j] * sn + a1[j] * cs;
                  a0[j] = r0; a1[j] = r1;
                }
              }
              uint2 p0, p1;
              p0.x = cvt_pk_bf16(a0[0] * qscale, a0[1] * qscale); p0.y = cvt_pk_bf16(a0[2] * qscale, a0[3] * qscale);
              p1.x = cvt_pk_bf16(a1[0] * qscale, a1[1] * qscale); p1.y = cvt_pk_bf16(a1[2] * qscale, a1[3] * qscale);
              *reinterpret_cast<uint2*>(qrow) = p0;
              *reinterpret_cast<uint2*>(qrow + 16) = p1;
            }
        }
      });
  gemm_phase<true, true, false>(256, 64, 4, [&](const Unit& u, const char*& a, const char*& b) { a = (const char*)(ckvn) + (size_t)u.pm * 256 * (256) * 2; b = (const char*)(wkv) + (size_t)u.pn * 256 * (256) * 2; },
      [&](Acc8& acc, const Unit& u, int wr, int wc, int fr, int fq) {
        E8_FOR {
          const int tok = u.pm * 256 + ai * 128 + wr * 64 + m * 16 + fr;
          const int b = tok >> 11, l = tok & 2047;
          const int col = u.pn * 256 + bj * 128 + wc * 32 + 8 * fq;
          const int h = col >> 6, d = col & 63;
          f32x4 v0 = acc[ai][bj][m][0], v1 = acc[ai][bj][m][1];
          uint4 pk;
          pk.x = cvt_pk_bf16(v0[0], v0[1]); pk.y = cvt_pk_bf16(v0[2], v0[3]); pk.z = cvt_pk_bf16(v1[0], v1[1]); pk.w = cvt_pk_bf16(v1[2], v1[3]);
          *reinterpret_cast<uint4*>(Kb + (((long)b * 16 + h) * SEQ + l) * 96 + d) = pk;
        }
      });
  gemm_phase<false, false, false>(256, 64, 4, [&](const Unit& u, const char*& a, const char*& b) { a = (const char*)(ckvn) + (size_t)u.pm * 256 * (256) * 2; b = (const char*)(wkv + 1024 * 256) + (size_t)u.pn * 256 * (256) * 2; },
      [&](Acc8& acc, const Unit& u, int wr, int wc, int fr, int fq) {
        E8_FOR {
          const int tok = u.pm * 256 + ai * 128 + wr * 64 + m * 16 + 4 * fq;
          const int b = tok >> 11, l = tok & 2047;
#pragma unroll
          for (int n = 0; n < 2; ++n) {
            const int col = u.pn * 256 + bj * 128 + wc * 32 + n * 16 + fr;
            const int h = col >> 6, d = col & 63;
            f32x4 v = acc[ai][bj][m][n];
            uint2 pk; pk.x = cvt_pk_bf16(v[0], v[1]); pk.y = cvt_pk_bf16(v[2], v[3]);
            *reinterpret_cast<uint2*>(VT + (((long)b * 16 + h) * 64 + d) * SEQ + l) = pk;
          }
        }
      });
}
DEV int kswz(int key) { return (((key >> 3) & 3) << 2) | (key & 3); }
DEV void mla_attn_unit(const Params& p, int u) {
  const int tid = otid(), lane = tid & 63, wid = tid >> 6, fr = lane & 15, fq = lane >> 4;
  const int qb = u & 7, bh = u >> 3;
  const u16* Qb = reinterpret_cast<const u16*>(p.ws + MLA_Q) + (long)bh * SEQ * 96;
  const u16* Kb = reinterpret_cast<const u16*>(p.ws + MLA_K) + (long)bh * SEQ * 96;
  const u16* VT = reinterpret_cast<const u16*>(p.ws + MLA_VT) + (long)bh * 64 * SEQ;
  u16* O = reinterpret_cast<u16*>(p.ws + MLA_O);
  char* kl = smem;
  char* vl = smem + 32768;
  bf16x8 qf[2][3];
#pragma unroll
  for (int qt = 0; qt < 2; ++qt)
#pragma unroll
    for (int ks = 0; ks < 3; ++ks)
      qf[qt][ks] = *reinterpret_cast<const bf16x8*>(Qb + (long)(qb * 256 + wid * 32 + qt * 16 + fr) * 96 + ks * 32 + fq * 8);
  f32x4 o[4][2];
#pragma unroll
  for (int dt = 0; dt < 4; ++dt)
#pragma unroll
    for (int qt = 0; qt < 2; ++qt) o[dt][qt] = f32x4{0.f, 0.f, 0.f, 0.f};
  float mrun[2] = {-1e30f, -1e30f}, lrun[2] = {0.f, 0.f};
  const int kc0 = tid, kc1 = 512 + tid;
  const int vd = tid >> 3, vpart = tid & 7;
  const int kw0 = (kc0 / 12) * 256 + (((kc0 % 12) ^ kswz(kc0 / 12)) << 4);
  const int kw1 = (kc1 / 12) * 256 + (((kc1 % 12) ^ kswz(kc1 / 12)) << 4);
  const int vw = vd * 128 + ((vpart ^ ((vd >> 1) & 7)) << 4);
  uint4 kr0, kr1 = make_uint4(0, 0, 0, 0), vr;
  auto gload = [&](int t) {
    const u16* kt = Kb + (long)t * 64 * 96;
    kr0 = *reinterpret_cast<const uint4*>(kt + kc0 * 8);
    if (tid < 256) kr1 = *reinterpret_cast<const uint4*>(kt + kc1 * 8);
    vr = *reinterpret_cast<const uint4*>(VT + (long)vd * SEQ + t * 64 + vpart * 8);
  };
  auto lstore = [&](int buf) {
    *reinterpret_cast<uint4*>(kl + buf * 16384 + kw0) = kr0;
    if (tid < 256) *reinterpret_cast<uint4*>(kl + buf * 16384 + kw1) = kr1;
    *reinterpret_cast<uint4*>(vl + buf * 8192 + vw) = vr;
  };
  const int krow = 8 * (fr >> 2) + (fr & 3);
  const int kf_ = kswz(krow);
  __syncthreads();
  gload(0); lstore(0);
  __syncthreads();
  for (int t = 0; t < 32; ++t) {
    const int cur = t & 1;
    if (t + 1 < 32) gload(t + 1);
    const char* kd = kl + cur * 16384; const char* vdl = vl + cur * 8192;
    f32x4 s[4][2];
#pragma unroll
    for (int kt = 0; kt < 4; ++kt) {
      const int key = 32 * (kt >> 1) + 4 * (kt & 1) + krow;
      bf16x8 kf[3];
#pragma unroll
      for (int ks = 0; ks < 3; ++ks) kf[ks] = *reinterpret_cast<const bf16x8*>(kd + key * 256 + (((ks * 4 + fq) ^ kf_) << 4));
#pragma unroll
      for (int qt = 0; qt < 2; ++qt) {
        f32x4 a = {0.f, 0.f, 0.f, 0.f};
#pragma unroll
        for (int ks = 0; ks < 3; ++ks) a = __builtin_amdgcn_mfma_f32_16x16x32_bf16(kf[ks], qf[qt][ks], a, 0, 0, 0);
        s[kt][qt] = a;
      }
    }
    bf16x8 pf[2][2];
#pragma unroll
    for (int qt = 0; qt < 2; ++qt) {
      float tm = -1e30f;
#pragma unroll
      for (int kt = 0; kt < 4; ++kt)
#pragma unroll
        for (int j = 0; j < 4; ++j) tm = fmaxf(tm, s[kt][qt][j]);
      tm = fmaxf(tm, __shfl_xor(tm, 16));
      tm = fmaxf(tm, __shfl_xor(tm, 32));
      const float mn = fmaxf(mrun[qt], tm);
      const float alpha = __builtin_amdgcn_exp2f(mrun[qt] - mn);
      mrun[qt] = mn;
      float ls = 0.f;
#pragma unroll
      for (int kt = 0; kt < 4; ++kt)
#pragma unroll
        for (int j = 0; j < 4; ++j) { float e = __builtin_amdgcn_exp2f(s[kt][qt][j] - mn); s[kt][qt][j] = e; ls += e; }
      lrun[qt] = lrun[qt] * alpha + ls;
#pragma unroll
      for (int dt = 0; dt < 4; ++dt) { o[dt][qt][0] *= alpha; o[dt][qt][1] *= alpha; o[dt][qt][2] *= alpha; o[dt][qt][3] *= alpha; }
#pragma unroll
      for (int k2 = 0; k2 < 2; ++k2) {
        union { bf16x8 v; unsigned u[4]; } t_;
        t_.u[0] = cvt_pk_bf16(s[2 * k2][qt][0], s[2 * k2][qt][1]); t_.u[1] = cvt_pk_bf16(s[2 * k2][qt][2], s[2 * k2][qt][3]);
        t_.u[2] = cvt_pk_bf16(s[2 * k2 + 1][qt][0], s[2 * k2 + 1][qt][1]); t_.u[3] = cvt_pk_bf16(s[2 * k2 + 1][qt][2], s[2 * k2 + 1][qt][3]);
        pf[k2][qt] = t_.v;
      }
    }
#pragma unroll
    for (int k2 = 0; k2 < 2; ++k2)
#pragma unroll
      for (int dt = 0; dt < 4; ++dt) {
        const int dim = dt * 16 + fr;
        bf16x8 af = *reinterpret_cast<const bf16x8*>(vdl + dim * 128 + (((k2 * 4 + fq) ^ ((dim >> 1) & 7)) << 4));
#pragma unroll
        for (int qt = 0; qt < 2; ++qt) o[dt][qt] = __builtin_amdgcn_mfma_f32_16x16x32_bf16(af, pf[k2][qt], o[dt][qt], 0, 0, 0);
      }
    if (t + 1 < 32) lstore(cur ^ 1);
    __syncthreads();
  }
  const int b = bh >> 4, h = bh & 15;
#pragma unroll
  for (int qt = 0; qt < 2; ++qt) {
    float l = lrun[qt];
    l += __shfl_xor(l, 16);
    l += __shfl_xor(l, 32);
    const float inv = 1.0f / l;
    const long tok = (long)b * SEQ + qb * 256 + wid * 32 + qt * 16 + fr;
#pragma unroll
    for (int dt = 0; dt < 4; ++dt) {
      uint2 pk; pk.x = pack2(o[dt][qt][0] * inv, o[dt][qt][1] * inv); pk.y = pack2(o[dt][qt][2] * inv, o[dt][qt][3] * inv);
      *reinterpret_cast<uint2*>(O + tok * 1024 + h * 64 + dt * 16 + 4 * fq) = pk;
    }
  }
}
DEV void phase_mla_attn(const Params& p) {
  const int nb = gridDim.x;
  for (int u = blockIdx.x; u < NBATCH * 16 * 8; u += nb) mla_attn_unit(p, u);
}

#ifndef ONLY
#define ONLY -1
#endif
#define PH(n, ...) if (ONLY < 0 || ONLY == n) { __VA_ARGS__; }
constexpr int LDS_BAR_OFF = 148480;
__global__ void __launch_bounds__(512) mega(Params p) {
  cg::grid_group grid = cg::this_grid();
  unsigned* barw = reinterpret_cast<unsigned*>(p.ws + S_BAR);
  if (blockIdx.x == 0) for (int i = threadIdx.x; i < XCD_BAR_WORDS; i += 512) barw[i] = 0u;
  if (threadIdx.x == 0) *reinterpret_cast<uint4*>(smem + LDS_BAR_OFF) = make_uint4(0u, 0u, 0u, 0u);
  PH(0, phase_prep(p));
  grid.sync();
  (void)xcd_barrier_post(barw, (volatile LAS unsigned*)(smem + LDS_BAR_OFF));
#define GSYNC() do { XcdBarrier xb_; xb_.bar = reinterpret_cast<unsigned*>(p.ws + S_BAR); xb_.x = xb_xcc_id(); xb_.st = (volatile LAS unsigned*)(smem + LDS_BAR_OFF); xcd_barrier(xb_); } while (0)
  PH(1, phase_abin(p)); GSYNC();
  PH(2, phase_mix0(p)); GSYNC();
  PH(2, phase_ztrans(p)); GSYNC();
  PH(3, phase_outproj(p, reinterpret_cast<const u16*>(p.ws + REG_A + 100663296ull), reinterpret_cast<const u16*>(p.ws + W_ABOUT), p.x)); GSYNC();
  for (int layer = 0; layer < 2; ++layer) {
    if (layer == 1) {
      PH(10, phase_mla_in(p)); GSYNC();
      PH(11, phase_mla_norm(p)); GSYNC();
      PH(12, phase_mla_up(p)); GSYNC();
      PH(13, phase_mla_attn(p)); GSYNC();
      PH(3, phase_outproj(p, reinterpret_cast<const u16*>(p.ws + MLA_O), reinterpret_cast<const u16*>(p.ws + W_MLAOUT), reinterpret_cast<const float*>(p.ws + REG_G))); GSYNC();
    }
    PH(4, phase_ln1_router(p, layer)); GSYNC();
    PH(5, phase_topk(p)); GSYNC();
    PH(6, phase_moe1(p, layer)); GSYNC();
    PH(7, phase_moe2(p, layer)); GSYNC();
    PH(8, phase_ln2(p, layer)); GSYNC();
    PH(9, phase_ple(p, layer, layer ? p.out : reinterpret_cast<float*>(p.ws + REG_G), layer ? nullptr : reinterpret_cast<u16*>(p.ws + REG_X)));
    if (layer == 0) GSYNC();
  }
}

static void add_job(Params& P, int& nj, int& tile, const float* src, u16* dst, int K, int N, int rsh, int rs, int off, int count, long sstride, long dstride, int f8 = 0, float fscale = 1.0f) {
  ConvJob& J = P.jobs[nj++];
  J.src = src; J.dst = dst; J.sstride = sstride; J.dstride = dstride; J.K = K; J.N = N; J.rs = rs; J.off = off; J.rsh = rsh;
  J.f8 = f8; J.fscale = fscale;
  if (f8) { J.ntn = N / 128; J.tpm = (K / 128) * J.ntn; } else { J.ntn = (N + 255) / 256; J.tpm = (K / 64) * J.ntn; }
  J.tile0 = tile; J.ntiles = J.tpm * count;
  tile += J.ntiles;
}

extern "C" void kernel_launch(void* const* d_in, const int* in_sizes, int n_in,
                              void* d_out, int out_size, void* d_ws, size_t ws_size,
                              hipStream_t stream) {
  constexpr size_t kDynLds = 148480 + 16;
  static int grid_blocks = 0;
  if (!grid_blocks) {
    int dev = 0, cus = 0, per_cu = 0;
    (void)hipGetDevice(&dev);
    (void)hipDeviceGetAttribute(&cus, hipDeviceAttributeMultiprocessorCount, dev);
    (void)hipFuncSetAttribute((const void*)mega, hipFuncAttributeMaxDynamicSharedMemorySize, (int)kDynLds);
    (void)hipOccupancyMaxActiveBlocksPerMultiprocessor(&per_cu, mega, 512, kDynLds);
    if (per_cu > 1) per_cu = 1;
    if (per_cu < 1) { fprintf(stderr, "occupancy query returned 0\n"); per_cu = 1; }
    grid_blocks = cus * per_cu;
    if (ws_size < WS_TOTAL) fprintf(stderr, "workspace too small: %zu < %zu\n", ws_size, (size_t)WS_TOTAL);
  }
  Params P;
  memset(&P, 0, sizeof(P));
  auto F = [&](int i) { return (const float*)d_in[i]; };
  char* ws = (char*)d_ws;
  P.x = F(0); P.p = F(1);
  P.na_rpb = F(3); P.hy_conv_w = F(4); P.hy_conv_b = F(5);
  P.hy_f_w1 = F(6); P.hy_f_b1 = F(7); P.hy_f_freq = F(8); P.hy_f_w2 = F(9); P.hy_f_b2 = F(10); P.hy_f_w3 = F(11); P.hy_skip = F(12);
  P.mla_q_norm = F(15); P.mla_kv_norm = F(17);
  P.ln1_g = F(20); P.ln1_b = F(21); P.ln2_g = F(22); P.ln2_b = F(23);
  P.moe_router = F(24);
  P.out = (float*)d_out; P.ws = ws;
  int nj = 0, tile = 0;
  add_job(P, nj, tile, F(2), (u16*)(ws + W_ABIN), 1024, 3072, 7, 128, 0, 1, 0, 0);
  add_job(P, nj, tile, F(13), (u16*)(ws + W_ABOUT), 1024, 1024, 7, 128, 0, 1, 0, 0);
  add_job(P, nj, tile, F(14), (u16*)(ws + W_MLAIN), 1024, 672, 7, 128, 0, 1, 0, 0);
  add_job(P, nj, tile, F(16), (u16*)(ws + W_QUP), 384, 1536, 7, 128, 0, 1, 0, 0);
  add_job(P, nj, tile, F(18), (u16*)(ws + W_KVUP), 256, 2048, 6, 64, 0, 1, 0, 0);
  P.jobs[nj - 1].sh2 = 1; P.jobs[nj - 1].off2 = 1024;
  add_job(P, nj, tile, F(19), (u16*)(ws + W_MLAOUT), 1024, 1024, 7, 128, 0, 1, 0, 0);
  add_job(P, nj, tile, F(28), (u16*)(ws + W_PLEG), 1024, 1024, 7, 128, 0, 2, 1024L * 1024, 1024L * 1024);
  add_job(P, nj, tile, F(29), (u16*)(ws + W_PLEP), 256, 1024, 7, 128, 0, 2, 256L * 1024, 1024L * 256);
  add_job(P, nj, tile, F(25), (u16*)(ws + W_GU), 1024, 2048, 7, 256, 0, 32, 1024L * 2048, 4096L * 1024, 1, 32.0f);
  add_job(P, nj, tile, F(26), (u16*)(ws + W_GU), 1024, 2048, 7, 256, 128, 32, 1024L * 2048, 4096L * 1024, 1, 32.0f);
  add_job(P, nj, tile, F(27), (u16*)(ws + W_DN), 2048, 1024, 7, 128, 0, 32, 2048L * 1024, 1024L * 2048, 1, 64.0f);
  P.conv_total = tile;
  void* args[] = {&P};
  hipError_t e = hipLaunchCooperativeKernel((void*)mega, dim3(grid_blocks), dim3(512), args, kDynLds, stream);
  if (e != hipSuccess) fprintf(stderr, "cooperative launch failed: %s (grid %d)\n", hipGetErrorString(e), grid_blocks);
}
```

```cpp
#include <hip/hip_runtime.h>
#include <hip/hip_bf16.h>
#include <hip/hip_cooperative_groups.h>
#include <cstdio>
#include <cstring>
namespace cg = cooperative_groups;

typedef unsigned short u16;
using bf16x8 = __attribute__((ext_vector_type(8))) short;
using bf16x4 = __attribute__((ext_vector_type(4))) short;
using f32x4 = __attribute__((ext_vector_type(4))) float;
#define DEV __device__ __forceinline__

constexpr int TOK = 16384, DM = 1024, SEQ = 2048, NBATCH = 8;
constexpr int NEXP = 16, CAP = 256, DFF = 2048;
constexpr float DN_ALPHA = 1.4142135623730951f;
constexpr float LN_EPS = 1e-5f;

constexpr size_t W_ABIN = 0;
constexpr size_t W_ABOUT = W_ABIN + 3072ull * 1024 * 2;
constexpr size_t W_MLAIN = W_ABOUT + 1024ull * 1024 * 2;
constexpr size_t W_QUP = W_MLAIN + 768ull * 1024 * 2;
constexpr size_t W_KVUP = W_QUP + 1536ull * 384 * 2;
constexpr size_t W_MLAOUT = W_KVUP + 2048ull * 256 * 2;
constexpr size_t W_PLEG = W_MLAOUT + 1024ull * 1024 * 2;
constexpr size_t W_PLEP = W_PLEG + 2 * 1024ull * 1024 * 2;
constexpr size_t W_GU = W_PLEP + 2 * 1024ull * 256 * 2;
constexpr size_t W_DN = W_GU + 2 * 16ull * 4096 * 1024 * 2;
constexpr size_t REG_A = W_DN + 2 * 16ull * 1024 * 2048 * 2;
constexpr size_t REG_B = REG_A + 134217728ull;
constexpr size_t REG_C = REG_B + 134217728ull;
constexpr size_t REG_D = REG_C + 67108864ull;
constexpr size_t REG_E = REG_D + 67108864ull;
constexpr size_t REG_G = REG_E + 33554432ull;
constexpr size_t REG_X = REG_G + 67108864ull;
constexpr size_t REG_P = REG_X + 33554432ull;
constexpr size_t S_AFF = REG_P + 16777216ull;
constexpr size_t S_IDX = S_AFF + 1048576ull;
constexpr size_t S_GSEL = S_IDX + 131072ull;
constexpr size_t S_SLOT = S_GSEL + 131072ull;
constexpr size_t S_H2 = S_SLOT + 1048576ull;
constexpr size_t S_RG = S_H2 + 524288ull;
constexpr size_t S_BAR = S_RG + 8388608ull;
constexpr size_t WS_TOTAL = S_BAR + 16384ull;

struct ConvJob {
  const float* src; u16* dst;
  long sstride, dstride;
  int K, N;
  int rs, off;
  int rsh, sh2, off2, f8;
  float fscale; int padk;
  int ntn;
  int tpm;
  int tile0, ntiles;
};
constexpr int NJOBS = 16;

struct Params {
  const float* x; const float* p;
  const float* na_rpb; const float* hy_conv_w; const float* hy_conv_b;
  const float* hy_f_w1; const float* hy_f_b1; const float* hy_f_freq; const float* hy_f_w2; const float* hy_f_b2;
  const float* hy_f_w3; const float* hy_skip;
  const float* mla_q_norm; const float* mla_kv_norm;
  const float* ln1_g; const float* ln1_b; const float* ln2_g; const float* ln2_b;
  const float* moe_router;
  float* out; char* ws;
  int conv_total; int pad0;
  ConvJob jobs[NJOBS];
};

extern __shared__ __attribute__((aligned(16))) char smem[];

typedef __bf16 bf16x2_t __attribute__((ext_vector_type(2)));
typedef float f32x2_t __attribute__((ext_vector_type(2)));
DEV unsigned cvt_pk_bf16(float lo, float hi) { f32x2_t f = {lo, hi}; bf16x2_t b = __builtin_convertvector(f, bf16x2_t); return __builtin_bit_cast(unsigned, b); }
DEV u16 f2bf(float f) { return (u16)(cvt_pk_bf16(f, 0.f) & 0xffffu); }
DEV float bf2f(u16 h) { return __uint_as_float(((unsigned)h) << 16); }
DEV unsigned pack2(float a, float b) { return cvt_pk_bf16(a, b); }
DEV unsigned pack4_f8(float a, float b, float c, float d) { int w = 0; w = __builtin_amdgcn_cvt_pk_fp8_f32(a, b, w, false); w = __builtin_amdgcn_cvt_pk_fp8_f32(c, d, w, true); return (unsigned)w; }
DEV float fsigmoid(float x) { return __builtin_amdgcn_rcpf(1.0f + __builtin_amdgcn_exp2f(-1.4426950408889634f * x)); }
DEV float wave_sum(float v) {
#pragma unroll
  for (int o = 32; o > 0; o >>= 1) v += __shfl_xor(v, o);
  return v;
}
DEV int otid() { int t = threadIdx.x; asm volatile("" : "+v"(t)); return t; }
DEV int vstart() {
  int nb = gridDim.x, b = blockIdx.x;
  return (nb % 8 == 0) ? (b % 8) * (nb / 8) + b / 8 : b;
}


#define XB_TMO      128
#define XB_XCNT(j)  (256  + 64 * (j))
#define XB_XSUB(j)  (1280 + 64 * (j))
#define XB_XGEN(j)  (2304 + 64 * (j))
#define XB_TOP      3328
#define XB_TOPGEN   3392
#define XCD_BAR_WORDS 3456
#define XB_SPIN_CAP (1u << 18)
#define LAS __attribute__((address_space(3)))
DEV unsigned xb_ld(unsigned* p) { return __hip_atomic_load(p, __ATOMIC_RELAXED, __HIP_MEMORY_SCOPE_AGENT); }
DEV unsigned xb_add(unsigned* p, unsigned v) { return __hip_atomic_fetch_add(p, v, __ATOMIC_RELAXED, __HIP_MEMORY_SCOPE_AGENT); }
DEV unsigned xb_xcc_id() { return (unsigned)__builtin_amdgcn_s_getreg((3 << 11) | 20) & 0xFu; }
#define XB_SPIN(cond, bar) do { unsigned _sp = 0; while (cond) { __builtin_amdgcn_s_sleep(1); \
    if ((++_sp & 255u) == 0u) { if (xb_ld(&(bar)[XB_TMO])) break; if (_sp > XB_SPIN_CAP) { atomicAdd(&(bar)[XB_TMO], 1u); break; } } } } while (0)
struct XcdBarrier { unsigned* bar; unsigned x; volatile LAS unsigned* st; };
DEV XcdBarrier xcd_barrier_post(unsigned* bar, volatile LAS unsigned* st) {
  XcdBarrier b; b.bar = bar; b.x = xb_xcc_id(); b.st = st;
  if (threadIdx.x == 0) (void)xb_add(&bar[XB_XCNT(b.x)], 1u);
  return b;
}
DEV void xcd_barrier_complete(unsigned* bar, unsigned x, unsigned& nloc, unsigned& nx) {
  const unsigned G = gridDim.x * gridDim.y * gridDim.z;
  unsigned sum, cnt, mine, sp = 0u;
  for (;;) {
    sum = 0u; cnt = 0u; mine = 0u;
#pragma unroll
    for (unsigned j = 0; j < 16; ++j) { const unsigned c = xb_ld(&bar[XB_XCNT(j)]); sum += c; cnt += (c > 0u) ? 1u : 0u; mine = (j == x) ? c : mine; }
    if (sum == G) break;
    __builtin_amdgcn_s_sleep(1);
    if ((++sp & 255u) == 0u) { if (xb_ld(&bar[XB_TMO])) break; if (sp > XB_SPIN_CAP) { atomicAdd(&bar[XB_TMO], 1u); break; } }
  }
  nloc = mine > 0u ? mine : 1u; nx = cnt > 0u ? cnt : 1u;
}
DEV void xcd_barrier(const XcdBarrier& b) {
  asm volatile("s_waitcnt vmcnt(0)" ::: "memory");
  __syncthreads();
  if (threadIdx.x == 0) {
    unsigned* bar = b.bar;
    __builtin_amdgcn_s_waitcnt(0);
    unsigned nloc = b.st[0], nx = b.st[1];
    if (nloc == 0u) { xcd_barrier_complete(bar, b.x, nloc, nx); b.st[0] = nloc; b.st[1] = nx; }
    const unsigned old = xb_add(&bar[XB_XSUB(b.x)], 1u);
    const unsigned gen = old / nloc;
    if (old + 1u == (gen + 1u) * nloc) {
      __builtin_amdgcn_fence(__ATOMIC_RELEASE, "agent");
      asm volatile("s_waitcnt vmcnt(0)" ::: "memory");
      const unsigned og = xb_add(&bar[XB_TOP], 1u);
      const unsigned tg = og / nx;
      if (og + 1u == (tg + 1u) * nx) xb_add(&bar[XB_TOPGEN], 1u);
      else XB_SPIN(xb_ld(&bar[XB_TOPGEN]) == tg, bar);
      __builtin_amdgcn_fence(__ATOMIC_ACQUIRE, "agent");
      xb_add(&bar[XB_XGEN(b.x)], 1u);
      asm volatile("s_waitcnt vmcnt(0)" ::: "memory");
    } else {
      XB_SPIN(xb_ld(&bar[XB_XGEN(b.x)]) == gen, bar);
      __builtin_amdgcn_fence(__ATOMIC_ACQUIRE, "agent");
      asm volatile("s_waitcnt vmcnt(0)" ::: "memory");
    }
  }
  __syncthreads();
}

DEV int lds_byte(int r, int c) {
  int st = (r >> 4) * 2 + (c >> 5), rr = r & 15, cc = c & 31, ob = rr * 64 + cc * 2;
  return st * 1024 + (ob ^ (((ob >> 9) & 1) << 5));
}
DEV void stage_rc(int b, int& R, int& C) {
  int st = b / 1024, sb = b % 1024, swz = sb ^ (((sb >> 9) & 1) << 5);
  R = (st >> 1) * 16 + swz / 64; C = (st & 1) * 32 + (swz % 64) / 2;
}
#define GLDS16(g, l) __builtin_amdgcn_global_load_lds((const unsigned*)(g), (unsigned*)(l), 16, 0, 0)

typedef f32x4 Acc8[2][2][4][2];
constexpr int G8_BM = 256, G8_BK = 64, G8_HALF = 128, G8_HTB = G8_HALF * G8_BK * 2, G8_NXCD = 8, G8_WGM = 8;
DEV int perm32(int rho) { const int n = rho >> 4, i = rho & 15; return 8 * (i >> 2) + 4 * n + (i & 3); }
struct Unit { int pm, pn; };
DEV bool unit_next(int i, int nM, int nN, Unit& u) {
  const int nwg = nM * nN;
  const long L = (long)i * gridDim.x + blockIdx.x; if (L >= nwg) return false;
  int wgid = (int)L; { const int q = nwg / G8_NXCD, r = nwg % G8_NXCD, xcd = wgid % G8_NXCD, off = wgid / G8_NXCD; wgid = (xcd < r ? xcd * (q + 1) : r * (q + 1) + (xcd - r) * q) + off; }
  const int nig = G8_WGM * nN, gid = wgid / nig, fm = gid * G8_WGM, gsz = (nM - fm) < G8_WGM ? (nM - fm) : G8_WGM;
  u.pm = fm + ((wgid % nig) % gsz); u.pn = (wgid % nig) / gsz; return true;
}
typedef int v4i_t __attribute__((ext_vector_type(4)));
typedef int v8i_t __attribute__((ext_vector_type(8)));
template <bool TR, bool PERM, bool F8, class PF, class EF>
DEV void gemm_phase(const int K, const int nM, const int nN, PF ptrs, EF E) {
  LAS unsigned char* lds = (LAS unsigned char*)smem;
  const int tid = otid(), wid = __builtin_amdgcn_readfirstlane(tid >> 6), lane = tid & 63, wr = wid >> 2, wc = wid & 3, fr = lane & 15, fq = lane >> 4;
  const int Kb = F8 ? K : 2 * K;
  const int nt = Kb / 128;
  unsigned voffA[2], voffB[2];
#pragma unroll
  for (int i = 0; i < 2; ++i) { int R, C; stage_rc(tid * 16 + i * 8192, R, C); const int Rb = PERM ? ((R & ~31) + perm32(R & 31)) : R;
    voffA[i] = (unsigned)(R * Kb + C * 2); voffB[i] = (unsigned)(Rb * Kb + C * 2); }
  const size_t kstep = (size_t)(G8_BK * 2);
  const size_t hstep = (size_t)G8_HALF * Kb;
  const unsigned ldsw = (unsigned)wid * 1024u;
  const int aoff = lds_byte(wr * 64 + fr, fq * 8), boff = lds_byte(wc * 32 + fr, fq * 8);
#define PG8_SA(b, h) (((b) * 2 + (h)) * G8_HTB)
#define PG8_SB(b, h) ((4 + (b) * 2 + (h)) * G8_HTB)
#define PG8_STAGE(bufoff, gbase, voff) do { _Pragma("unroll") for (int _i = 0; _i < 2; ++_i) { unsigned _vo = (voff)[_i]; asm volatile("" : "+v"(_vo)); \
    __builtin_amdgcn_global_load_lds((const unsigned*)((const char*)(gbase) + _vo), (LAS unsigned*)(lds + (bufoff) + ldsw + _i * 8192), 16, 0, 0); } } while (0)
#define PG8_LD16(off) (*(const LAS v4i_t*)(lds + (off)))
#define PG8_LDA(dst, b, h) do { if constexpr (F8) { _Pragma("unroll") for (int m = 0; m < 4; ++m) dst##8[m] = __builtin_shufflevector(PG8_LD16(PG8_SA(b, h) + aoff + m * 2048), PG8_LD16(PG8_SA(b, h) + aoff + m * 2048 + 1024), 0, 1, 2, 3, 4, 5, 6, 7); } \
    else { _Pragma("unroll") for (int m = 0; m < 4; ++m) _Pragma("unroll") for (int k = 0; k < 2; ++k) dst[m][k] = *(const LAS bf16x8*)(lds + PG8_SA(b, h) + aoff + m * 2048 + k * 1024); } } while (0)
#define PG8_LDB(dst, b, h) do { if constexpr (F8) { _Pragma("unroll") for (int n = 0; n < 2; ++n) dst##8[n] = __builtin_shufflevector(PG8_LD16(PG8_SB(b, h) + boff + n * 2048), PG8_LD16(PG8_SB(b, h) + boff + n * 2048 + 1024), 0, 1, 2, 3, 4, 5, 6, 7); } \
    else { _Pragma("unroll") for (int n = 0; n < 2; ++n) _Pragma("unroll") for (int k = 0; k < 2; ++k) dst[n][k] = *(const LAS bf16x8*)(lds + PG8_SB(b, h) + boff + n * 2048 + k * 1024); } } while (0)
#define PG8_MMA(ai, bj, At, Bt) do { __builtin_amdgcn_s_setprio(1); \
    if constexpr (F8) { _Pragma("unroll") for (int m = 0; m < 4; ++m) _Pragma("unroll") for (int n = 0; n < 2; ++n) \
        { if constexpr (TR) asm volatile("v_mfma_f32_16x16x128_f8f6f4 %0, %1, %2, %0" : "+v"(acc[ai][bj][m][n]) : "v"(Bt##8[n]), "v"(At##8[m])); \
          else asm volatile("v_mfma_f32_16x16x128_f8f6f4 %0, %1, %2, %0" : "+v"(acc[ai][bj][m][n]) : "v"(At##8[m]), "v"(Bt##8[n])); } } \
    else { _Pragma("unroll") for (int m = 0; m < 4; ++m) _Pragma("unroll") for (int n = 0; n < 2; ++n) _Pragma("unroll") for (int k = 0; k < 2; ++k) \
    acc[ai][bj][m][n] = TR ? __builtin_amdgcn_mfma_f32_16x16x32_bf16(Bt[n][k], At[m][k], acc[ai][bj][m][n], 0, 0, 0) \
                           : __builtin_amdgcn_mfma_f32_16x16x32_bf16(At[m][k], Bt[n][k], acc[ai][bj][m][n], 0, 0, 0); } __builtin_amdgcn_s_setprio(0); } while (0)
#define PG8_WAIT_V(n) asm volatile("s_waitcnt vmcnt(" #n ")" ::: "memory")
#define PG8_WAIT_L(n) asm volatile("s_waitcnt lgkmcnt(" #n ")" ::: "memory")
#define PG8_BAR __builtin_amdgcn_s_barrier()
#define PG8_SCHED __builtin_amdgcn_sched_barrier(0)
  Unit cur, nxt; int ui = 0;
  if (!unit_next(0, nM, nN, cur)) return;
  Acc8 acc;
#pragma unroll
  for (int a = 0; a < 2; ++a)
#pragma unroll
    for (int b = 0; b < 2; ++b)
#pragma unroll
      for (int m = 0; m < 4; ++m)
#pragma unroll
        for (int n = 0; n < 2; ++n) acc[a][b][m][n] = f32x4{0.f, 0.f, 0.f, 0.f};
  bf16x8 At[4][2], B0[2][2], B1[2][2];
  v8i_t At8[4], B08[2], B18[2];
  const char* cA; const char* cB;
  ptrs(cur, cA, cB);
  PG8_STAGE(PG8_SB(0, 0), cB, voffB); PG8_STAGE(PG8_SA(0, 0), cA, voffA); PG8_STAGE(PG8_SB(0, 1), cB + hstep, voffB); PG8_STAGE(PG8_SA(0, 1), cA + hstep, voffA);
  if (wr == 1) PG8_BAR;
  PG8_WAIT_V(4); PG8_BAR;
  PG8_STAGE(PG8_SB(1, 0), cB + kstep, voffB); PG8_STAGE(PG8_SA(1, 0), cA + kstep, voffA); PG8_STAGE(PG8_SB(1, 1), cB + hstep + kstep, voffB);
  PG8_WAIT_V(6); PG8_BAR;
  for (;;) {
    const bool has_next = unit_next(ui + 1, nM, nN, nxt);
    const char* nA = cA; const char* nB = cB;
    if (has_next) ptrs(nxt, nA, nB);
#pragma unroll 1
    for (int t = 0; t < nt; t += 2) {
      const bool last = (t == nt - 2);
      const char* a1 = cA + (size_t)(t + 1) * kstep;
      const char* a2 = last ? nA : cA + (size_t)(t + 2) * kstep; const char* b2 = last ? nB : cB + (size_t)(t + 2) * kstep;
      const char* a3 = a2 + kstep; const char* b3 = b2 + kstep;
      PG8_LDB(B0, 0, 0); PG8_SCHED; PG8_LDA(At, 0, 0); PG8_STAGE(PG8_SA(1, 1), a1 + hstep, voffA);
      PG8_WAIT_L(8); PG8_BAR; PG8_WAIT_L(0); PG8_MMA(0, 0, At, B0); PG8_BAR; PG8_SCHED;
      PG8_LDB(B1, 0, 1); PG8_STAGE(PG8_SB(0, 0), b2, voffB);
      PG8_BAR; PG8_WAIT_L(0); PG8_MMA(0, 1, At, B1); PG8_BAR;
      PG8_LDA(At, 0, 1); PG8_STAGE(PG8_SA(0, 0), a2, voffA);
      PG8_BAR; PG8_WAIT_L(0); PG8_MMA(1, 0, At, B0); PG8_BAR; PG8_SCHED;
      PG8_STAGE(PG8_SB(0, 1), b2 + hstep, voffB);
      PG8_WAIT_V(6); PG8_BAR; PG8_MMA(1, 1, At, B1); PG8_BAR;
      PG8_LDB(B0, 1, 0); PG8_SCHED; PG8_LDA(At, 1, 0); PG8_STAGE(PG8_SA(0, 1), a2 + hstep, voffA);
      PG8_WAIT_L(8); PG8_BAR; PG8_WAIT_L(0); PG8_MMA(0, 0, At, B0); PG8_BAR; PG8_SCHED;
      PG8_LDB(B1, 1, 1); PG8_STAGE(PG8_SB(1, 0), b3, voffB);
      PG8_BAR; PG8_WAIT_L(0); PG8_MMA(0, 1, At, B1); PG8_BAR;
      PG8_LDA(At, 1, 1); PG8_STAGE(PG8_SA(1, 0), a3, voffA);
      PG8_BAR; PG8_WAIT_L(0); PG8_MMA(1, 0, At, B0); PG8_BAR; PG8_SCHED;
      PG8_STAGE(PG8_SB(1, 1), b3 + hstep, voffB);
      PG8_WAIT_V(6); PG8_BAR; PG8_MMA(1, 1, At, B1); PG8_BAR;
    }
    if constexpr (F8) asm volatile("s_nop 15\n\ts_nop 15" ::: "memory");
    { const int l2 = otid() & 63; E(acc, cur, wr, wc, l2 & 15, l2 >> 4); }
    if (!has_next) break;
#pragma unroll
    for (int a = 0; a < 2; ++a)
#pragma unroll
      for (int b = 0; b < 2; ++b)
#pragma unroll
        for (int m = 0; m < 4; ++m)
#pragma unroll
          for (int n = 0; n < 2; ++n) acc[a][b][m][n] = f32x4{0.f, 0.f, 0.f, 0.f};
    cur = nxt; cA = nA; cB = nB; ++ui;
  }
  PG8_WAIT_V(0);
  if (wr == 0) PG8_BAR;
  PG8_BAR;
#undef PG8_SA
#undef PG8_SB
#undef PG8_STAGE
#undef PG8_LDA
#undef PG8_LD16
#undef PG8_LDB
#undef PG8_MMA
#undef PG8_WAIT_V
#undef PG8_WAIT_L
#undef PG8_BAR
#undef PG8_SCHED
}
#define E8_FOR _Pragma("unroll") for (int ai = 0; ai < 2; ++ai) _Pragma("unroll") for (int m = 0; m < 4; ++m) _Pragma("unroll") for (int bj = 0; bj < 2; ++bj)

DEV void conv_tile(const ConvJob& J, int t) {
  const int tid = otid();
  int mat = t / J.tpm, tt = t % J.tpm;
  int kt = tt / J.ntn, nt = tt % J.ntn;
  const float* src = J.src + (long)mat * J.sstride;
  u16* dst = J.dst + (long)mat * J.dstride;
  const int kg = tid >> 6, ng = tid & 63;
  const int n = nt * 256 + ng * 4;
  float4 v[8];
#pragma unroll
  for (int j = 0; j < 8; ++j) {
    int k = kt * 64 + kg * 8 + j;
    if (n < J.N) v[j] = *reinterpret_cast<const float4*>(src + (long)k * J.N + n);
    else v[j] = make_float4(0.f, 0.f, 0.f, 0.f);
  }
#pragma unroll
  for (int i = 0; i < 4; ++i) {
    float e[8];
#pragma unroll
    for (int j = 0; j < 8; ++j) e[j] = (i == 0) ? v[j].x : (i == 1) ? v[j].y : (i == 2) ? v[j].z : v[j].w;
    uint4 pk;
    pk.x = pack2(e[0], e[1]); pk.y = pack2(e[2], e[3]); pk.z = pack2(e[4], e[5]); pk.w = pack2(e[6], e[7]);
    *reinterpret_cast<uint4*>(smem + (i * 64 + ng) * 144 + kg * 16) = pk;
  }
  __syncthreads();
#pragma unroll
  for (int u = 0; u < 4; ++u) {
    int q = tid + 512 * u;
    int nl = q >> 3, ch = q & 7;
    uint4 pk = *reinterpret_cast<const uint4*>(smem + ((nl & 3) * 64 + (nl >> 2)) * 144 + ch * 16);
    int nn = nt * 256 + nl;
    const int qq = nn >> J.rsh;
    long drow = (long)(qq >> J.sh2) * J.rs + (qq & ((1 << J.sh2) - 1)) * J.off2 + (nn & ((1 << J.rsh) - 1)) + J.off;
    *reinterpret_cast<uint4*>(dst + drow * J.K + kt * 64 + ch * 8) = pk;
  }
  __syncthreads();
}

DEV void conv_tile_f8(const ConvJob& J, int t) {
  const int tid = otid();
  int mat = t / J.tpm, tt = t % J.tpm;
  int kt = tt / J.ntn, nt = tt % J.ntn;
  const float* src = J.src + (long)mat * J.sstride;
  unsigned char* dst = reinterpret_cast<unsigned char*>(J.dst) + (long)mat * J.dstride;
  const int kg = tid >> 5, ng = tid & 31;
  const int n = nt * 128 + ng * 4;
  const float sc = J.fscale;
  float4 v[8];
#pragma unroll
  for (int j = 0; j < 8; ++j) v[j] = *reinterpret_cast<const float4*>(src + (long)(kt * 128 + kg * 8 + j) * J.N + n);
#pragma unroll
  for (int i = 0; i < 4; ++i) {
    float e[8];
#pragma unroll
    for (int j = 0; j < 8; ++j) e[j] = ((i == 0) ? v[j].x : (i == 1) ? v[j].y : (i == 2) ? v[j].z : v[j].w) * sc;
    uint2 pk; pk.x = pack4_f8(e[0], e[1], e[2], e[3]); pk.y = pack4_f8(e[4], e[5], e[6], e[7]);
    *reinterpret_cast<uint2*>(smem + (i * 32 + ng) * 144 + kg * 8) = pk;
  }
  __syncthreads();
#pragma unroll
  for (int u = 0; u < 2; ++u) {
    int q = tid + 512 * u;
    int nl = q >> 3, ch = q & 7;
    uint4 pk = *reinterpret_cast<const uint4*>(smem + ((nl & 3) * 32 + (nl >> 2)) * 144 + ch * 16);
    int nn = nt * 128 + nl;
    const int qq = nn >> J.rsh;
    long drow = (long)(qq >> J.sh2) * J.rs + (qq & ((1 << J.sh2) - 1)) * J.off2 + (nn & ((1 << J.rsh) - 1)) + J.off;
    *reinterpret_cast<uint4*>(dst + drow * J.K + kt * 128 + ch * 16) = pk;
  }
  __syncthreads();
}

DEV void phase_prep(const Params& p) {
  const int tid = otid(), nb = gridDim.x, bid = blockIdx.x;
  {
    float* zb = reinterpret_cast<float*>(smem);
    float* h1b = zb + 512;
    float* h2g = reinterpret_cast<float*>(p.ws + S_H2);
    const int w = tid >> 6, lane = tid & 63;
    for (int l0 = bid * 8; l0 < SEQ; l0 += nb * 8) {
      int l = l0 + w;
      float tt = (float)l / (float)(SEQ - 1);
      float ww = 6.283185307179586f * (float)l / (float)SEQ;
      float z = 0.f;
      if (lane == 0) z = tt;
      else if (lane <= 16) { float f = 1e-4f + (float)(lane - 1) * ((15.0f - 1e-4f) / 15.0f); z = cosf(f * ww); }
      else if (lane <= 32) { float f = 1e-4f + (float)(lane - 17) * ((15.0f - 1e-4f) / 15.0f); z = -sinf(f * ww); }
      zb[w * 64 + lane] = z;
      __syncthreads();
      float fr_ = p.hy_f_freq[lane];
      float a = p.hy_f_b1[lane];
      for (int k = 0; k < 33; ++k) a += zb[w * 64 + k] * p.hy_f_w1[k * 64 + lane];
      h1b[w * 64 + lane] = sinf(fr_ * a);
      __syncthreads();
      float a2 = p.hy_f_b2[lane];
      for (int k = 0; k < 64; ++k) a2 += h1b[w * 64 + k] * p.hy_f_w2[k * 64 + lane];
      h2g[l * 64 + lane] = sinf(fr_ * a2);
      __syncthreads();
    }
  }
  {
    u16* xb = reinterpret_cast<u16*>(p.ws + REG_X);
    const long n8 = (long)TOK * DM / 8;
    for (long i = (long)bid * 512 + tid; i < n8; i += (long)nb * 512) {
      float4 a = reinterpret_cast<const float4*>(p.x)[2 * i], b = reinterpret_cast<const float4*>(p.x)[2 * i + 1];
      uint4 pk; pk.x = pack2(a.x, a.y); pk.y = pack2(a.z, a.w); pk.z = pack2(b.x, b.y); pk.w = pack2(b.z, b.w);
      reinterpret_cast<uint4*>(xb)[i] = pk;
    }
    u16* pb = reinterpret_cast<u16*>(p.ws + REG_P);
    const long m8 = 2L * TOK * 256 / 8;
    for (long i = (long)bid * 512 + tid; i < m8; i += (long)nb * 512) {
      float4 a = reinterpret_cast<const float4*>(p.p)[2 * i], b = reinterpret_cast<const float4*>(p.p)[2 * i + 1];
      uint4 pk; pk.x = pack2(a.x, a.y); pk.y = pack2(a.z, a.w); pk.z = pack2(b.x, b.y); pk.w = pack2(b.z, b.w);
      reinterpret_cast<uint4*>(pb)[i] = pk;
    }
  }
  for (int t = bid; t < p.conv_total; t += nb) {
    int j = 0;
#pragma unroll 1
    for (int q = 1; q < NJOBS; ++q) if (t >= p.jobs[q].tile0 && p.jobs[q].ntiles > 0) j = q;
    if (p.jobs[j].f8) conv_tile_f8(p.jobs[j], t - p.jobs[j].tile0); else conv_tile(p.jobs[j], t - p.jobs[j].tile0);
  }
}

DEV void filter_b(const Params& p, int cpair) {
  const int tid = otid();
  float* w3s = reinterpret_cast<float*>(smem);
  float* red = w3s + 512;
  float* nrm = red + 32;
  float* hb = nrm + 4;
  const float* h2g = reinterpret_cast<const float*>(p.ws + S_H2);
  {
    int ci = tid >> 6, k = tid & 63;
    int o = ci >> 2, d = (ci >> 1) & 1, cc = ci & 1;
    w3s[ci * 64 + k] = p.hy_f_w3[k * 2048 + o * 1024 + d * 512 + 2 * cpair + cc];
  }
  __syncthreads();
  const float min_decay = logf(1e-2f) / 1.5f, max_decay = logf(1e-2f) / 0.3f;
#pragma unroll 1
  for (int i = 0; i < 4; ++i) {
    int l = tid + 512 * i;
    float h2[64];
#pragma unroll
    for (int k = 0; k < 16; ++k) {
      float4 v = *reinterpret_cast<const float4*>(h2g + l * 64 + k * 4);
      h2[4 * k] = v.x; h2[4 * k + 1] = v.y; h2[4 * k + 2] = v.z; h2[4 * k + 3] = v.w;
    }
    float tt = (float)l / (float)(SEQ - 1);
#pragma unroll 1
    for (int ci = 0; ci < 8; ++ci) {
      float a = 0.f;
#pragma unroll
      for (int k = 0; k < 64; ++k) a += h2[k] * w3s[ci * 64 + k];
      int cc = ci & 1;
      int c = 2 * cpair + cc;
      float delta = fabsf(min_decay + (float)c * ((max_decay - min_decay) / 511.0f));
      a *= expf(-tt * delta);
      hb[ci * 2048 + l] = a;
    }
  }
  __syncthreads();
  {
    float ss[4];
#pragma unroll
    for (int oc = 0; oc < 4; ++oc) {
      int o = oc >> 1, cc = oc & 1;
      float a = 0.f;
      for (int l = tid; l < 2048; l += 512) {
        float f = hb[(o * 4 + 0 + cc) * 2048 + l];
        float b = (l > 0) ? hb[(o * 4 + 2 + cc) * 2048 + l] : 0.f;
        a += f * f + b * b;
      }
      ss[oc] = wave_sum(a);
    }
    if ((tid & 63) == 0) {
#pragma unroll
      for (int q = 0; q < 4; ++q) red[(tid >> 6) * 4 + q] = ss[q];
    }
  }
  __syncthreads();
  if (tid < 4) {
    float s = 0.f;
    for (int w = 0; w < 8; ++w) s += red[w * 4 + tid];
    nrm[tid] = rsqrtf(s + 1e-12f);
  }
  __syncthreads();
  u16* Rg = reinterpret_cast<u16*>(p.ws + S_RG);
  for (int q = tid; q < 4 * 4096; q += 512) {
    int oc = q >> 12, qq = q & 4095;
    int o = oc >> 1, cc = oc & 1;
    float v;
    if (qq == 0) v = 0.f;
    else if (qq <= 2048) v = hb[(o * 4 + 0 * 2 + cc) * 2048 + (2048 - qq)];
    else v = hb[(o * 4 + 1 * 2 + cc) * 2048 + (qq - 2048)];
    v *= nrm[oc];
    Rg[((long)o * 512 + 2 * cpair + cc) * 4096 + qq] = f2bf(v);
  }
  __syncthreads();
}

DEV void phase_abin(const Params& p) {
  const int nb = gridDim.x;
  for (int c = blockIdx.x; c < 256; c += nb) filter_b(p, c);
  const u16* xb = reinterpret_cast<const u16*>(p.ws + REG_X);
  const u16* wt = reinterpret_cast<const u16*>(p.ws + W_ABIN);
  u16* qk = reinterpret_cast<u16*>(p.ws + REG_B);
  u16* vht = reinterpret_cast<u16*>(p.ws + REG_B + 33554432ull);
  gemm_phase<true, true, false>(1024, 64, 4, [&](const Unit& u, const char*& a, const char*& b) { a = (const char*)(xb) + (size_t)u.pm * 256 * (1024) * 2; b = (const char*)(wt) + (size_t)u.pn * 256 * (1024) * 2; },
      [&](Acc8& acc, const Unit& u, int wr, int wc, int fr, int fq) {
        const float sc = (u.pn < 2) ? 0.125f : 1.0f;
        u16* base = qk + (long)(u.pm * 256 + wr * 64 + fr) * 1024 + u.pn * 256 + wc * 32 + 8 * fq;
        E8_FOR {
          f32x4 v0 = acc[ai][bj][m][0], v1 = acc[ai][bj][m][1];
          uint4 pk;
          pk.x = cvt_pk_bf16(v0[0] * sc, v0[1] * sc); pk.y = cvt_pk_bf16(v0[2] * sc, v0[3] * sc);
          pk.z = cvt_pk_bf16(v1[0] * sc, v1[1] * sc); pk.w = cvt_pk_bf16(v1[2] * sc, v1[3] * sc);
          *reinterpret_cast<uint4*>(base + (ai * 128 + m * 16) * 1024 + bj * 128) = pk;
        }
      });
  gemm_phase<false, false, false>(1024, 64, 8, [&](const Unit& u, const char*& a, const char*& b) { a = (const char*)(xb) + (size_t)u.pm * 256 * (1024) * 2; b = (const char*)(wt + 1024 * 1024) + (size_t)u.pn * 256 * (1024) * 2; },
      [&](Acc8& acc, const Unit& u, int wr, int wc, int fr, int fq) {
        u16* base = vht + (long)(u.pn * 256 + wc * 32 + fr) * TOK + u.pm * 256 + wr * 64 + 4 * fq;
        E8_FOR {
#pragma unroll
          for (int n = 0; n < 2; ++n) {
            f32x4 v = acc[ai][bj][m][n];
            uint2 pk; pk.x = cvt_pk_bf16(v[0], v[1]); pk.y = cvt_pk_bf16(v[2], v[3]);
            *reinterpret_cast<uint2*>(base + (long)(bj * 128 + n * 16) * TOK + ai * 128 + m * 16) = pk;
          }
        }
      });
}

constexpr int NA_VST = 580;
constexpr int NA_V_OFF = 576 * 128;
DEV void na_pair(const Params& p, int u) {
  const int tid = otid(), lane = tid & 63, wid = tid >> 6, fr = lane & 15, fq = lane >> 4;
  const int rp = u & 15, h = (u >> 4) & 7, b = u >> 7;
  const int rbase = min(max(2 * rp - 4, 0), 24);
  const int nrows = (rbase == 24) ? 8 : 9;
  const u16* qk = reinterpret_cast<const u16*>(p.ws + REG_B);
  const u16* vht = reinterpret_cast<const u16*>(p.ws + REG_B + 33554432ull);
  u16* cat = reinterpret_cast<u16*>(p.ws + REG_A + 100663296ull);
  char* kl = smem;
  u16* vl = reinterpret_cast<u16*>(smem + NA_V_OFF);
  const long tok0 = (long)b * SEQ + rbase * 64;
  __syncthreads();
#pragma unroll
  for (int i = 0; i < 9; ++i) {
    const int q = tid + 512 * i, key = q >> 3, ch = q & 7;
    if (key < nrows * 64) {
      uint4 v = *reinterpret_cast<const uint4*>(qk + (tok0 + key) * 1024 + 512 + h * 64 + ch * 8);
      *reinterpret_cast<uint4*>(kl + key * 128 + ((ch ^ ((key >> 1) & 7)) << 4)) = v;
    }
  }
#pragma unroll
  for (int i = 0; i < 9; ++i) {
    const int q = tid + 512 * i, d = q / 72, ch = q % 72;
    if (ch < nrows * 8) {
      uint4 v = *reinterpret_cast<const uint4*>(vht + (long)(h * 64 + d) * TOK + tok0 + ch * 8);
      u16* dst = vl + d * NA_VST + ch * 8;
      *reinterpret_cast<uint2*>(dst) = make_uint2(v.x, v.y);
      *reinterpret_cast<uint2*>(dst + 4) = make_uint2(v.z, v.w);
    }
  }
  __syncthreads();
  const int g = wid & 3, r = 2 * rp + (wid >> 2);
  const int r0 = min(max(r - 4, 0), 24), ro = r0 - rbase, cs = min(max(16 * g - 8, 0), 32);
  const int c = 16 * g + fr;
  const long tokq = (long)b * SEQ + r * 64 + c;
  bf16x8 qf[2];
#pragma unroll
  for (int ks = 0; ks < 2; ++ks) qf[ks] = *reinterpret_cast<const bf16x8*>(qk + tokq * 1024 + h * 64 + ks * 32 + fq * 8);
  f32x4 s[16];
#pragma unroll
  for (int kt = 0; kt < 16; ++kt) {
    const int w = kt >> 1, half = kt & 1;
    const int key = (ro + w) * 64 + cs + 16 * half + fr;
    const int sw = (key >> 1) & 7;
    bf16x8 k0 = *reinterpret_cast<const bf16x8*>(kl + key * 128 + ((fq ^ sw) << 4));
    bf16x8 k1 = *reinterpret_cast<const bf16x8*>(kl + key * 128 + (((4 + fq) ^ sw) << 4));
    f32x4 a = {0.f, 0.f, 0.f, 0.f};
    a = __builtin_amdgcn_mfma_f32_16x16x32_bf16(k0, qf[0], a, 0, 0, 0);
    a = __builtin_amdgcn_mfma_f32_16x16x32_bf16(k1, qf[1], a, 0, 0, 0);
    s[kt] = a;
  }
  const int c0 = min(max(c - 8, 0), 48);
  const float* rpb = p.na_rpb + h * 15 * 31;
  float mx = -1e30f;
#pragma unroll
  for (int kt = 0; kt < 16; ++kt) {
    const int w = kt >> 1, half = kt & 1;
    const int dr = r0 + w - r + 7;
#pragma unroll
    for (int j = 0; j < 4; ++j) {
      int kc = cs + 16 * half + 4 * fq + j;
      bool valid = (kc >= c0) && (kc < c0 + 16);
      int dc = min(max(kc - c, -15), 15) + 15;
      float bias = rpb[dr * 31 + dc];
      float v = valid ? (s[kt][j] + bias) : -1e30f;
      s[kt][j] = v;
      mx = fmaxf(mx, v);
    }
  }
  mx = fmaxf(mx, __shfl_xor(mx, 16));
  mx = fmaxf(mx, __shfl_xor(mx, 32));
  float sum = 0.f;
#pragma unroll
  for (int kt = 0; kt < 16; ++kt)
#pragma unroll
    for (int j = 0; j < 4; ++j) { float e = __expf(s[kt][j] - mx); s[kt][j] = e; sum += e; }
  sum += __shfl_xor(sum, 16);
  sum += __shfl_xor(sum, 32);
  f32x4 o[4];
#pragma unroll
  for (int dt = 0; dt < 4; ++dt) o[dt] = f32x4{0.f, 0.f, 0.f, 0.f};
#pragma unroll
  for (int w = 0; w < 8; ++w) {
    union { bf16x8 v; unsigned u[4]; } pf;
    pf.u[0] = cvt_pk_bf16(s[2 * w][0], s[2 * w][1]); pf.u[1] = cvt_pk_bf16(s[2 * w][2], s[2 * w][3]);
    pf.u[2] = cvt_pk_bf16(s[2 * w + 1][0], s[2 * w + 1][1]); pf.u[3] = cvt_pk_bf16(s[2 * w + 1][2], s[2 * w + 1][3]);
#pragma unroll
    for (int dt = 0; dt < 4; ++dt) {
      const u16* vp = vl + (dt * 16 + fr) * NA_VST + (ro + w) * 64 + cs + 4 * fq;
      union { bf16x8 v; uint2 u[2]; } af;
      af.u[0] = *reinterpret_cast<const uint2*>(vp);
      af.u[1] = *reinterpret_cast<const uint2*>(vp + 16);
      o[dt] = __builtin_amdgcn_mfma_f32_16x16x32_bf16(af.v, pf.v, o[dt], 0, 0, 0);
    }
  }
  const float inv = 1.0f / sum;
#pragma unroll
  for (int dt = 0; dt < 4; ++dt) {
    uint2 pk; pk.x = pack2(o[dt][0] * inv, o[dt][1] * inv); pk.y = pack2(o[dt][2] * inv, o[dt][3] * inv);
    *reinterpret_cast<uint2*>(cat + tokq * 1024 + h * 64 + dt * 16 + 4 * fq) = pk;
  }
}

constexpr int UB_STRIDE = 2056;
constexpr int RC_STRIDE = 4120;
constexpr int HY_RC_OFF = 2 * NBATCH * UB_STRIDE * 2;
DEV float shortconv(const u16* hrow, const float* cw, float cb, int ch, int t) {
  float xm = (t > 0) ? bf2f(hrow[t - 1]) : 0.f;
  float x0 = bf2f(hrow[t]);
  float xp = (t < SEQ - 1) ? bf2f(hrow[t + 1]) : 0.f;
  return cb + xm * cw[ch] + x0 * cw[1536 + ch] + xp * cw[2 * 1536 + ch];
}
DEV void load_rc(const Params& p, int o, int c) {
  const int tid = otid();
  char* rc = smem + HY_RC_OFF;
  const u16* Rg = reinterpret_cast<const u16*>(p.ws + S_RG) + ((long)o * 512 + c) * 4096;
  const float skip = p.hy_skip[o * 512 + c];
  const int i0 = tid * 8;
  uint4 lo = *reinterpret_cast<const uint4*>(Rg + i0);
  uint4 hi = (tid < 511) ? *reinterpret_cast<const uint4*>(Rg + i0 + 8) : make_uint4(0u, 0u, 0u, 0u);
  unsigned w[8] = {lo.x, lo.y, lo.z, lo.w, hi.x, hi.y, hi.z, hi.w};
  if (tid == 256) w[0] = (w[0] & 0xffff0000u) | (unsigned)f2bf(bf2f((u16)(w[0] & 0xffffu)) + skip);
  if (tid == 255) w[4] = (w[4] & 0xffff0000u) | (unsigned)f2bf(bf2f((u16)(w[4] & 0xffffu)) + skip);
#pragma unroll
  for (int m = 0; m < 8; ++m) {
    uint4 o4;
    if (m & 1) {
      o4.x = __builtin_amdgcn_alignbyte(w[m / 2 + 1], w[m / 2], 2);
      o4.y = __builtin_amdgcn_alignbyte(w[m / 2 + 2], w[m / 2 + 1], 2);
      o4.z = __builtin_amdgcn_alignbyte(w[m / 2 + 3], w[m / 2 + 2], 2);
      o4.w = __builtin_amdgcn_alignbyte(w[m / 2 + 4], w[m / 2 + 3], 2);
    } else {
      o4.x = w[m / 2]; o4.y = w[m / 2 + 1]; o4.z = w[m / 2 + 2]; o4.w = w[m / 2 + 3];
    }
    *reinterpret_cast<uint4*>(rc + m * (RC_STRIDE * 2) + i0 * 2) = o4;
  }
}
DEV void hyena_conv(const u16* ub, f32x4 (&acc)[16]) {
  const int lane = otid() & 63, wid = __builtin_amdgcn_readfirstlane(otid() >> 6), fr = lane & 15, fq = lane >> 4;
  const int mcopy = (-wid) & 7;
  const u16* rbase = reinterpret_cast<const u16*>(smem + HY_RC_OFF) + mcopy * RC_STRIDE + (8 * fq - 8 * fr + 2048 - (wid + mcopy));
#pragma unroll
  for (int i = 0; i < 16; ++i) acc[i] = f32x4{0.f, 0.f, 0.f, 0.f};
  const u16* urow = ub + (fr & 7) * UB_STRIDE + fq * 8;
#pragma unroll 1
  for (int kk = 0; kk < 64; ++kk) {
    bf16x8 bfr = *reinterpret_cast<const bf16x8*>(urow + kk * 32);
    const u16* rk = rbase + 32 * kk;
#pragma unroll
    for (int T = 0; T < 16; ++T) {
      bf16x8 af = *reinterpret_cast<const bf16x8*>(rk - 128 * T);
      acc[T] = __builtin_amdgcn_mfma_f32_16x16x32_bf16(af, bfr, acc[T], 0, 0, 0);
    }
  }
}
DEV void shortconv_pass(const u16* __restrict__ hrow  , u16* ub, const float* cw, float cb, int ch) {
  const float w0 = cw[ch], w1 = cw[1536 + ch], w2 = cw[2 * 1536 + ch];
  for (int q = otid(); q < TOK / 8; q += 512) {
    const int i = q * 8, b = i >> 11, t = i & 2047;
    uint4 v = *reinterpret_cast<const uint4*>(hrow + i);
    float x[10];
    x[0] = (t > 0) ? bf2f(hrow[i - 1]) : 0.f;
    x[9] = (t + 8 < SEQ) ? bf2f(hrow[i + 8]) : 0.f;
    x[1] = __uint_as_float(v.x << 16); x[2] = __uint_as_float(v.x & 0xffff0000u);
    x[3] = __uint_as_float(v.y << 16); x[4] = __uint_as_float(v.y & 0xffff0000u);
    x[5] = __uint_as_float(v.z << 16); x[6] = __uint_as_float(v.z & 0xffff0000u);
    x[7] = __uint_as_float(v.w << 16); x[8] = __uint_as_float(v.w & 0xffff0000u);
    float y[8];
#pragma unroll
    for (int j = 0; j < 8; ++j) y[j] = cb + x[j] * w0 + x[j + 1] * w1 + x[j + 2] * w2;
    uint4 o4; o4.x = pack2(y[0], y[1]); o4.y = pack2(y[2], y[3]); o4.z = pack2(y[4], y[5]); o4.w = pack2(y[6], y[7]);
    *reinterpret_cast<uint4*>(ub + b * UB_STRIDE + t) = o4;
  }
}
DEV void hyena_unit(const Params& p, int c) {
  const int tid = otid(), lane = tid & 63, wid = tid >> 6, fr = lane & 15, fq = lane >> 4;
  u16* ubA = reinterpret_cast<u16*>(smem);
  u16* ubB = ubA + NBATCH * UB_STRIDE;
  const u16* hbt = reinterpret_cast<const u16*>(p.ws + REG_B + 33554432ull) + 512L * TOK;
  u16* zT = reinterpret_cast<u16*>(p.ws + REG_C);
  const float* cw = p.hy_conv_w;
  shortconv_pass(hbt + (long)c * TOK, ubA, cw, p.hy_conv_b[c], c);
  shortconv_pass(hbt + (long)(512 + c) * TOK, ubB, cw, p.hy_conv_b[512 + c], 512 + c);
  load_rc(p, 0, c);
  __syncthreads();
  f32x4 acc[16];
  hyena_conv(ubA, acc);
  if (fr < 8) {
#pragma unroll
    for (int T = 0; T < 16; ++T)
#pragma unroll
      for (int j = 0; j < 4; ++j) {
        const int t = 128 * T + wid + 8 * (4 * fq + j);
        u16* q = ubB + fr * UB_STRIDE + t;
        *q = f2bf(bf2f(*q) * acc[T][j]);
      }
  }
  __syncthreads();
  shortconv_pass(hbt + (long)(1024 + c) * TOK, ubA, cw, p.hy_conv_b[1024 + c], 1024 + c);
  load_rc(p, 1, c);
  __syncthreads();
  hyena_conv(ubB, acc);
  if (fr < 8) {
#pragma unroll
    for (int T = 0; T < 16; ++T)
#pragma unroll
      for (int j = 0; j < 4; ++j) {
        const int t = 128 * T + wid + 8 * (4 * fq + j);
        u16* q = ubA + fr * UB_STRIDE + t;
        *q = f2bf(bf2f(*q) * acc[T][j]);
      }
  }
  __syncthreads();
  for (int q = tid; q < TOK / 8; q += 512) {
    const int i = q * 8, b = i >> 11, t = i & 2047;
    *reinterpret_cast<uint4*>(zT + (long)c * TOK + i) = *reinterpret_cast<const uint4*>(ubA + b * UB_STRIDE + t);
  }
  __syncthreads();
}
DEV void phase_ztrans(const Params& p) {
  const int tid = otid();
  const u16* zT = reinterpret_cast<const u16*>(p.ws + REG_C);
  u16* cat = reinterpret_cast<u16*>(p.ws + REG_A + 100663296ull);
  u16* tile = reinterpret_cast<u16*>(smem);
  for (int tb = blockIdx.x; tb < TOK / 64; tb += gridDim.x) {
    __syncthreads();
    const u16* src = zT + (long)tid * TOK + tb * 64;
#pragma unroll
    for (int k = 0; k < 8; ++k) *reinterpret_cast<uint4*>(tile + tid * 72 + k * 8) = *reinterpret_cast<const uint4*>(src + k * 8);
    __syncthreads();
#pragma unroll
    for (int k = 0; k < 8; ++k) {
      const int q = tid + 512 * k;
      const int tk = q >> 6, ch8 = (q & 63) * 8;
      unsigned w[4];
#pragma unroll
      for (int j = 0; j < 4; ++j) w[j] = (unsigned)tile[(ch8 + 2 * j) * 72 + tk] | ((unsigned)tile[(ch8 + 2 * j + 1) * 72 + tk] << 16);
      *reinterpret_cast<uint4*>(cat + (long)(tb * 64 + tk) * 1024 + 512 + ch8) = make_uint4(w[0], w[1], w[2], w[3]);
    }
  }
}
DEV void phase_mix0(const Params& p) {
  const int nb = gridDim.x;
  for (int c = blockIdx.x; c < 512; c += nb) hyena_unit(p, c);
  for (int u = blockIdx.x; u < 1024; u += nb) na_pair(p, u);
}

DEV void phase_outproj(const Params& p, const u16* A, const u16* wt, const float* xres) {
  float* pre1 = reinterpret_cast<float*>(p.ws + REG_C);
  gemm_phase<true, false, false>(1024, 64, 4, [&](const Unit& u, const char*& a, const char*& b) { a = (const char*)(A) + (size_t)u.pm * 256 * (1024) * 2; b = (const char*)(wt) + (size_t)u.pn * 256 * (1024) * 2; },
      [&](Acc8& acc, const Unit& u, int wr, int wc, int fr, int fq) {
        const long o0 = (long)(u.pm * 256 + wr * 64 + fr) * 1024 + u.pn * 256 + wc * 32 + 4 * fq;
        E8_FOR {
#pragma unroll
          for (int n = 0; n < 2; ++n) {
            const long o = o0 + (ai * 128 + m * 16) * 1024 + bj * 128 + n * 16;
            f32x4 xr = *reinterpret_cast<const f32x4*>(xres + o);
            *reinterpret_cast<f32x4*>(pre1 + o) = xr * DN_ALPHA + acc[ai][bj][m][n];
          }
        }
      });
}

DEV void phase_ln1_router(const Params& p, int layer) {
  const int tid = otid(), lane = tid & 63, wid = tid >> 6, nb = gridDim.x;
  float* wrT = reinterpret_cast<float*>(smem);
  const float* wr = p.moe_router + (long)layer * 1024 * 16;
  for (int i = tid; i < 16384; i += 512) { int c = i >> 4, e = i & 15; wrT[e * 1024 + c] = wr[i]; }
  __syncthreads();
  const float* pre1 = reinterpret_cast<const float*>(p.ws + REG_C);
  float* x1 = reinterpret_cast<float*>(p.ws + REG_D);
  unsigned char* x1q = reinterpret_cast<unsigned char*>(p.ws + REG_E);
  float* aff = reinterpret_cast<float*>(p.ws + S_AFF);
  const float* g = p.ln1_g + layer * 1024; const float* bb = p.ln1_b + layer * 1024;
  for (int tok = blockIdx.x * 8 + wid; tok < TOK; tok += nb * 8) {
    float4 v[4];
    float s = 0.f;
#pragma unroll
    for (int i = 0; i < 4; ++i) { v[i] = *reinterpret_cast<const float4*>(pre1 + (long)tok * 1024 + i * 256 + lane * 4); s += v[i].x + v[i].y + v[i].z + v[i].w; }
    float mu = wave_sum(s) * (1.0f / 1024.0f);
    float q = 0.f;
#pragma unroll
    for (int i = 0; i < 4; ++i) { v[i].x -= mu; v[i].y -= mu; v[i].z -= mu; v[i].w -= mu; q += v[i].x * v[i].x + v[i].y * v[i].y + v[i].z * v[i].z + v[i].w * v[i].w; }
    float rstd = rsqrtf(wave_sum(q) * (1.0f / 1024.0f) + LN_EPS);
    float4 y[4];
#pragma unroll
    for (int i = 0; i < 4; ++i) {
      int c = i * 256 + lane * 4;
      float4 gg = *reinterpret_cast<const float4*>(g + c), b4 = *reinterpret_cast<const float4*>(bb + c);
      y[i].x = v[i].x * rstd * gg.x + b4.x; y[i].y = v[i].y * rstd * gg.y + b4.y; y[i].z = v[i].z * rstd * gg.z + b4.z; y[i].w = v[i].w * rstd * gg.w + b4.w;
      *reinterpret_cast<float4*>(x1 + (long)tok * 1024 + c) = y[i];
      *reinterpret_cast<unsigned*>(x1q + (long)tok * 1024 + c) = pack4_f8(y[i].x, y[i].y, y[i].z, y[i].w);
    }
    float lg[16];
#pragma unroll
    for (int e = 0; e < 16; ++e) {
      float a = 0.f;
#pragma unroll
      for (int i = 0; i < 4; ++i) {
        float4 w4 = *reinterpret_cast<const float4*>(wrT + e * 1024 + i * 256 + lane * 4);
        a += y[i].x * w4.x + y[i].y * w4.y + y[i].z * w4.z + y[i].w * w4.w;
      }
      lg[e] = a;
      if (e & 1) asm volatile("" ::: "memory");
    }
#pragma unroll
    for (int s_ = 0; s_ < 4; ++s_) {
      const int bit = 1 << s_;
      const bool up = (lane & bit) != 0;
#pragma unroll
      for (int i = 0; i < (8 >> s_); ++i) {
        float lo = lg[2 * i], hi = lg[2 * i + 1];
        float snd = up ? lo : hi;
        float rcv = __shfl_xor(snd, bit);
        lg[i] = (up ? hi : lo) + rcv;
      }
    }
    float mine = lg[0];
    mine += __shfl_xor(mine, 16);
    mine += __shfl_xor(mine, 32);
    float mx = mine;
#pragma unroll
    for (int o = 8; o > 0; o >>= 1) mx = fmaxf(mx, __shfl_xor(mx, o));
    float ex = expf(mine - mx);
    float den = ex;
#pragma unroll
    for (int o = 8; o > 0; o >>= 1) den += __shfl_xor(den, o);
    if (lane < 16) {
      int b = tok >> 11, l = tok & 2047;
      aff[((long)b * 16 + lane) * SEQ + l] = ex / den;
    }
  }
}

DEV void phase_topk(const Params& p) {
  const int tid = otid(), nb = gridDim.x, lane = tid & 63, wid = tid >> 6;
  unsigned* key = reinterpret_cast<unsigned*>(smem);
  int* rows = reinterpret_cast<int*>(smem + 8192);
  unsigned* hist = reinterpret_cast<unsigned*>(smem + 9216);
  unsigned* wsum = reinterpret_cast<unsigned*>(smem + 10240);
  unsigned* bc = reinterpret_cast<unsigned*>(smem + 10304);
  const float* aff = reinterpret_cast<const float*>(p.ws + S_AFF);
  float* gsel = reinterpret_cast<float*>(p.ws + S_GSEL);
  int* slot = reinterpret_cast<int*>(p.ws + S_SLOT);
  const unsigned char* x1q = reinterpret_cast<const unsigned char*>(p.ws + REG_E);
  unsigned char* Xe = reinterpret_cast<unsigned char*>(p.ws + REG_C);
  for (int be = blockIdx.x; be < NBATCH * NEXP; be += nb) {
    const int b = be >> 4, e = be & 15;
    __syncthreads();
    const float4 av = *reinterpret_cast<const float4*>(aff + (long)be * SEQ + tid * 4);
    const unsigned k0 = __float_as_uint(av.x), k1 = __float_as_uint(av.y), k2 = __float_as_uint(av.z), k3 = __float_as_uint(av.w);
    unsigned prefix = 0u, need = CAP;
#pragma unroll 1
    for (int shift = 24; shift >= 0; shift -= 8) {
      if (tid < 256) hist[tid] = 0u;
      __syncthreads();
      const unsigned hs = (shift == 24) ? 0u : (unsigned)(shift + 8);
      if (shift == 24 || (k0 >> hs) == prefix) atomicAdd(&hist[(k0 >> shift) & 255u], 1u);
      if (shift == 24 || (k1 >> hs) == prefix) atomicAdd(&hist[(k1 >> shift) & 255u], 1u);
      if (shift == 24 || (k2 >> hs) == prefix) atomicAdd(&hist[(k2 >> shift) & 255u], 1u);
      if (shift == 24 || (k3 >> hs) == prefix) atomicAdd(&hist[(k3 >> shift) & 255u], 1u);
      __syncthreads();
      if (wid == 0) {
        unsigned h0 = hist[4 * lane], h1 = hist[4 * lane + 1], h2 = hist[4 * lane + 2], h3 = hist[4 * lane + 3];
        unsigned tot = h0 + h1 + h2 + h3;
        unsigned suf = tot;
#pragma unroll
        for (int o = 1; o < 64; o <<= 1) { unsigned t = __shfl_down(suf, o); if (lane + o < 64) suf += t; }
        const unsigned above = suf - tot;
        int d = -1; unsigned nabove = 0u;
        unsigned c3 = above + h3, c2 = c3 + h2, c1 = c2 + h1, c0 = c1 + h0;
        if (above < need && c0 >= need) {
          if (c3 >= need) { d = 4 * lane + 3; nabove = above; }
          else if (c2 >= need) { d = 4 * lane + 2; nabove = c3; }
          else if (c1 >= need) { d = 4 * lane + 1; nabove = c2; }
          else { d = 4 * lane; nabove = c1; }
          bc[0] = (prefix << 8) | (unsigned)d;
          bc[1] = need - nabove;
        }
      }
      __syncthreads();
      prefix = bc[0]; need = bc[1];
    }
    const unsigned tau = prefix;
    const unsigned e0 = (k0 == tau), e1 = (k1 == tau), e2 = (k2 == tau), e3 = (k3 == tau);
    unsigned eqs = e0 + e1 + e2 + e3;
    unsigned inc = eqs;
#pragma unroll
    for (int o = 1; o < 64; o <<= 1) { unsigned t = __shfl_up(inc, o); if (lane >= o) inc += t; }
    if (lane == 63) wsum[wid] = inc;
    __syncthreads();
    unsigned base = 0u;
#pragma unroll
    for (int w = 0; w < 8; ++w) if (w < wid) base += wsum[w];
    unsigned eqb = base + inc - eqs;
    const unsigned s0 = (k0 > tau) || (e0 && eqb < need); eqb += e0;
    const unsigned s1 = (k1 > tau) || (e1 && eqb < need); eqb += e1;
    const unsigned s2 = (k2 > tau) || (e2 && eqb < need); eqb += e2;
    const unsigned s3 = (k3 > tau) || (e3 && eqb < need);
    const unsigned sels = s0 + s1 + s2 + s3;
    unsigned inc2 = sels;
#pragma unroll
    for (int o = 1; o < 64; o <<= 1) { unsigned t = __shfl_up(inc2, o); if (lane >= o) inc2 += t; }
    if (lane == 63) wsum[8 + wid] = inc2;
    __syncthreads();
    unsigned base2 = 0u;
#pragma unroll
    for (int w = 0; w < 8; ++w) if (w < wid) base2 += wsum[8 + w];
    unsigned sl = base2 + inc2 - sels;
    const int tok0 = tid * 4;
    int sv[4];
    sv[0] = s0 ? (int)sl : -1; sl += s0;
    sv[1] = s1 ? (int)sl : -1; sl += s1;
    sv[2] = s2 ? (int)sl : -1; sl += s2;
    sv[3] = s3 ? (int)sl : -1;
    const float avv[4] = {av.x, av.y, av.z, av.w};
#pragma unroll
    for (int j = 0; j < 4; ++j) {
      slot[((long)b * SEQ + tok0 + j) * 16 + e] = sv[j];
      if (sv[j] >= 0) { rows[sv[j]] = tok0 + j; gsel[be * CAP + sv[j]] = avv[j]; }
    }
    __syncthreads();
    for (int s = wid; s < CAP; s += 8) {
      const int t = rows[s];
      const uint4* src = reinterpret_cast<const uint4*>(x1q + ((long)b * SEQ + t) * 1024);
      uint4* dst = reinterpret_cast<uint4*>(Xe + ((long)(e * 8 + b) * CAP + s) * 1024);
      dst[lane] = src[lane];
    }
  }
}

DEV void phase_moe1(const Params& p, int layer) {
  const unsigned char* Xe = reinterpret_cast<const unsigned char*>(p.ws + REG_C);
  const unsigned char* wgu = reinterpret_cast<const unsigned char*>(p.ws + W_GU) + (long)layer * 16 * 4096 * 1024;
  unsigned char* H = reinterpret_cast<unsigned char*>(p.ws + REG_A);
  gemm_phase<true, true, true>(1024, 128, 16,
      [&](const Unit& u, const char*& a, const char*& b) { a = (const char*)Xe + (size_t)u.pm * 256 * 1024; b = (const char*)wgu + ((size_t)(u.pm >> 3) * 4096 + (size_t)u.pn * 256) * 1024; },
      [&](Acc8& acc, const Unit& u, int wr, int wc, int fr, int fq) {
        unsigned char* base = H + (long)(u.pm * 256 + wr * 64 + fr) * DFF + u.pn * 128 + wc * 32 + 8 * fq;
#pragma unroll
        for (int ai = 0; ai < 2; ++ai)
#pragma unroll
          for (int m = 0; m < 4; ++m) {
            float hv[8];
#pragma unroll
            for (int n = 0; n < 2; ++n)
#pragma unroll
              for (int j = 0; j < 4; ++j) {
                float gte = acc[ai][0][m][n][j] * 0.03125f, up = acc[ai][1][m][n][j] * 0.03125f;
                hv[n * 4 + j] = gte * fsigmoid(gte) * up;
              }
            uint2 pk; pk.x = pack4_f8(hv[0], hv[1], hv[2], hv[3]); pk.y = pack4_f8(hv[4], hv[5], hv[6], hv[7]);
            *reinterpret_cast<uint2*>(base + (ai * 128 + m * 16) * DFF) = pk;
          }
      });
}
DEV void phase_moe2(const Params& p, int layer) {
  const unsigned char* H = reinterpret_cast<const unsigned char*>(p.ws + REG_A);
  const unsigned char* wd = reinterpret_cast<const unsigned char*>(p.ws + W_DN) + (long)layer * 16 * 1024 * 2048;
  const float* gsel = reinterpret_cast<const float*>(p.ws + S_GSEL);
  u16* Ye = reinterpret_cast<u16*>(p.ws + REG_B);
  gemm_phase<true, true, true>(2048, 128, 4,
      [&](const Unit& u, const char*& a, const char*& b) { a = (const char*)H + (size_t)u.pm * 256 * 2048; b = (const char*)wd + ((size_t)(u.pm >> 3) * 1024 + (size_t)u.pn * 256) * 2048; },
      [&](Acc8& acc, const Unit& u, int wr, int wc, int fr, int fq) {
        const int e = u.pm >> 3, b = u.pm & 7;
        const float* gs = gsel + (b * 16 + e) * CAP + wr * 64 + fr;
        u16* base = Ye + (long)(u.pm * 256 + wr * 64 + fr) * 1024 + u.pn * 256 + wc * 32 + 8 * fq;
#pragma unroll
        for (int ai = 0; ai < 2; ++ai)
#pragma unroll
          for (int m = 0; m < 4; ++m) {
            const float g = gs[ai * 128 + m * 16] * 0.015625f;
#pragma unroll
            for (int bj = 0; bj < 2; ++bj) {
              f32x4 v0 = acc[ai][bj][m][0] * g, v1 = acc[ai][bj][m][1] * g;
              uint4 pk;
              pk.x = cvt_pk_bf16(v0[0], v0[1]); pk.y = cvt_pk_bf16(v0[2], v0[3]); pk.z = cvt_pk_bf16(v1[0], v1[1]); pk.w = cvt_pk_bf16(v1[2], v1[3]);
              *reinterpret_cast<uint4*>(base + (ai * 128 + m * 16) * 1024 + bj * 128) = pk;
            }
          }
      });
}
DEV void phase_ln2(const Params& p, int layer) {
  const int tid = otid(), lane = tid & 63, wid = tid >> 6, nb = gridDim.x;
  const float* x1 = reinterpret_cast<const float*>(p.ws + REG_D);
  const u16* Ye = reinterpret_cast<const u16*>(p.ws + REG_B);
  const int* slot = reinterpret_cast<const int*>(p.ws + S_SLOT);
  float* x2 = reinterpret_cast<float*>(p.ws + REG_A);
  u16* x2b = reinterpret_cast<u16*>(p.ws + REG_A + 67108864ull);
  const float* g = p.ln2_g + layer * 1024; const float* bb = p.ln2_b + layer * 1024;
  for (int tok = blockIdx.x * 8 + wid; tok < TOK; tok += nb * 8) {
    const int b = tok >> 11;
    float4 v[4];
#pragma unroll
    for (int i = 0; i < 4; ++i) {
      float4 t = *reinterpret_cast<const float4*>(x1 + (long)tok * 1024 + i * 256 + lane * 4);
      v[i].x = DN_ALPHA * t.x; v[i].y = DN_ALPHA * t.y; v[i].z = DN_ALPHA * t.z; v[i].w = DN_ALPHA * t.w;
    }
    int myslot = (lane < 16) ? slot[(long)tok * 16 + lane] : -1;
    unsigned mask = (unsigned)__ballot(myslot >= 0);
    while (mask) {
      const int e = __builtin_ctz(mask);
      mask &= mask - 1;
      const int sidx = __builtin_amdgcn_readlane(myslot, e);
      const u16* yr = Ye + ((long)(e * 8 + b) * CAP + sidx) * 1024;
      uint2 t[4];
#pragma unroll
      for (int i = 0; i < 4; ++i) t[i] = *reinterpret_cast<const uint2*>(yr + i * 256 + lane * 4);
#pragma unroll
      for (int i = 0; i < 4; ++i) {
        v[i].x += __uint_as_float(t[i].x << 16); v[i].y += __uint_as_float(t[i].x & 0xffff0000u);
        v[i].z += __uint_as_float(t[i].y << 16); v[i].w += __uint_as_float(t[i].y & 0xffff0000u);
      }
    }
    float s = 0.f;
#pragma unroll
    for (int i = 0; i < 4; ++i) s += v[i].x + v[i].y + v[i].z + v[i].w;
    float mu = wave_sum(s) * (1.0f / 1024.0f);
    float q = 0.f;
#pragma unroll
    for (int i = 0; i < 4; ++i) { v[i].x -= mu; v[i].y -= mu; v[i].z -= mu; v[i].w -= mu; q += v[i].x * v[i].x + v[i].y * v[i].y + v[i].z * v[i].z + v[i].w * v[i].w; }
    float rstd = rsqrtf(wave_sum(q) * (1.0f / 1024.0f) + LN_EPS);
#pragma unroll
    for (int i = 0; i < 4; ++i) {
      int c = i * 256 + lane * 4;
      float4 gg = *reinterpret_cast<const float4*>(g + c), b4 = *reinterpret_cast<const float4*>(bb + c);
      float4 y;
      y.x = v[i].x * rstd * gg.x + b4.x; y.y = v[i].y * rstd * gg.y + b4.y; y.z = v[i].z * rstd * gg.z + b4.z; y.w = v[i].w * rstd * gg.w + b4.w;
      *reinterpret_cast<float4*>(x2 + (long)tok * 1024 + c) = y;
      uint2 pk; pk.x = pack2(y.x, y.y); pk.y = pack2(y.z, y.w);
      *reinterpret_cast<uint2*>(x2b + (long)tok * 1024 + c) = pk;
    }
  }
}
DEV void phase_ple(const Params& p, int layer, float* outf, u16* outb) {
  const float* x2 = reinterpret_cast<const float*>(p.ws + REG_A);
  const u16* x2b = reinterpret_cast<const u16*>(p.ws + REG_A + 67108864ull);
  const u16* pb = reinterpret_cast<const u16*>(p.ws + REG_P) + (long)layer * TOK * 256;
  const u16* wg = reinterpret_cast<const u16*>(p.ws + W_PLEG) + (long)layer * 1024 * 1024;
  const u16* wp = reinterpret_cast<const u16*>(p.ws + W_PLEP) + (long)layer * 1024 * 256;
  u16* pp = reinterpret_cast<u16*>(p.ws + REG_C);
  gemm_phase<true, false, false>(256, 64, 4, [&](const Unit& u, const char*& a, const char*& b) { a = (const char*)(pb) + (size_t)u.pm * 256 * (256) * 2; b = (const char*)(wp) + (size_t)u.pn * 256 * (256) * 2; },
      [&](Acc8& acc, const Unit& u, int wr, int wc, int fr, int fq) {
        const long o0 = (long)(u.pm * 256 + wr * 64 + fr) * 1024 + u.pn * 256 + wc * 32 + 4 * fq;
        E8_FOR {
#pragma unroll
          for (int n = 0; n < 2; ++n)
          {
            f32x4 v = acc[ai][bj][m][n];
            uint2 pk; pk.x = cvt_pk_bf16(v[0], v[1]); pk.y = cvt_pk_bf16(v[2], v[3]);
            *reinterpret_cast<uint2*>(pp + o0 + (ai * 128 + m * 16) * 1024 + bj * 128 + n * 16) = pk;
          }
        }
      });
  gemm_phase<true, false, false>(1024, 64, 4, [&](const Unit& u, const char*& a, const char*& b) { a = (const char*)(x2b) + (size_t)u.pm * 256 * (1024) * 2; b = (const char*)(wg) + (size_t)u.pn * 256 * (1024) * 2; },
      [&](Acc8& acc, const Unit& u, int wr, int wc, int fr, int fq) {
        const long o0 = (long)(u.pm * 256 + wr * 64 + fr) * 1024 + u.pn * 256 + wc * 32 + 4 * fq;
        E8_FOR {
#pragma unroll
          for (int n = 0; n < 2; ++n) {
            const long o = o0 + (ai * 128 + m * 16) * 1024 + bj * 128 + n * 16;
            f32x4 a = acc[ai][bj][m][n];
            f32x4 xv = *reinterpret_cast<const f32x4*>(x2 + o);
            const uint2 pq = *reinterpret_cast<const uint2*>(pp + o);
            f32x4 pv = {__uint_as_float(pq.x << 16), __uint_as_float(pq.x & 0xffff0000u), __uint_as_float(pq.y << 16), __uint_as_float(pq.y & 0xffff0000u)};
            f32x4 r;
#pragma unroll
            for (int j = 0; j < 4; ++j) r[j] = xv[j] + pv[j] * fsigmoid(a[j]);
            *reinterpret_cast<f32x4*>(outf + o) = r;
            if (outb) { uint2 pk; pk.x = cvt_pk_bf16(r[0], r[1]); pk.y = cvt_pk_bf16(r[2], r[3]); *reinterpret_cast<uint2*>(outb + o) = pk; }
          }
        }
      });
}
DEV void phase_mla_in(const Params& p) {
  const u16* xb = reinterpret_cast<const u16*>(p.ws + REG_X);
  const u16* wt = reinterpret_cast<const u16*>(p.ws + W_MLAIN);
  float* hm = reinterpret_cast<float*>(p.ws + REG_B);
  gemm_phase<true, false, false>(1024, 64, 3, [&](const Unit& u, const char*& a, const char*& b) { a = (const char*)(xb) + (size_t)u.pm * 256 * (1024) * 2; b = (const char*)(wt) + (size_t)u.pn * 256 * (1024) * 2; },
      [&](Acc8& acc, const Unit& u, int wr, int wc, int fr, int fq) {
        const long o0 = (long)(u.pm * 256 + wr * 64 + fr) * 768 + u.pn * 256 + wc * 32 + 4 * fq;
        E8_FOR {
#pragma unroll
          for (int n = 0; n < 2; ++n)
            *reinterpret_cast<f32x4*>(hm + o0 + (ai * 128 + m * 16) * 768 + bj * 128 + n * 16) = acc[ai][bj][m][n];
        }
      });
}
constexpr size_t MLA_Q = REG_A, MLA_K = REG_A + 50331648ull, MLA_VT = REG_A + 100663296ull;
constexpr size_t MLA_CQN = REG_B + 50331648ull, MLA_CKVN = MLA_CQN + 12582912ull, MLA_O = MLA_CKVN + 8388608ull;
DEV float rope_inv(int i) { return 1.0f / powf(10000.0f, (float)i / 16.0f); }
DEV void phase_mla_norm(const Params& p) {
  const int tid = otid(), lane = tid & 63, wid = tid >> 6, nb = gridDim.x;
  const float* hm = reinterpret_cast<const float*>(p.ws + REG_B);
  u16* cqn = reinterpret_cast<u16*>(p.ws + MLA_CQN);
  u16* ckvn = reinterpret_cast<u16*>(p.ws + MLA_CKVN);
  u16* Kb = reinterpret_cast<u16*>(p.ws + MLA_K);
  for (int tok = blockIdx.x * 8 + wid; tok < TOK; tok += nb * 8) {
    const float* row = hm + (long)tok * 768;
    float q[6], kv[4];
    float sq = 0.f, skv = 0.f;
#pragma unroll
    for (int i = 0; i < 6; ++i) { q[i] = row[i * 64 + lane]; sq += q[i] * q[i]; }
#pragma unroll
    for (int i = 0; i < 4; ++i) { kv[i] = row[384 + i * 64 + lane]; skv += kv[i] * kv[i]; }
    float rq = rsqrtf(wave_sum(sq) * (1.0f / 384.0f) + LN_EPS);
    float rkv = rsqrtf(wave_sum(skv) * (1.0f / 256.0f) + LN_EPS);
#pragma unroll
    for (int i = 0; i < 6; ++i) cqn[(long)tok * 384 + i * 64 + lane] = f2bf(q[i] * rq * p.mla_q_norm[i * 64 + lane]);
#pragma unroll
    for (int i = 0; i < 4; ++i) ckvn[(long)tok * 256 + i * 64 + lane] = f2bf(kv[i] * rkv * p.mla_kv_norm[i * 64 + lane]);
    const int b = tok >> 11, l = tok & 2047;
    float kr = (lane < 32) ? row[640 + lane] : 0.f;
    float x1 = __shfl(kr, lane & 15), x2 = __shfl(kr, (lane & 15) + 16);
    float sn, cs; sincosf((float)l * rope_inv(lane & 15), &sn, &cs);
    float r = (lane & 16) ? (x1 * sn + x2 * cs) : (x1 * cs - x2 * sn);
    u16 rb = f2bf(r);
    for (int hh = 0; hh < 16; hh += 2) {
      int h = hh + (lane >> 5);
      u16 val = (u16)__shfl((int)rb, lane & 31);
      Kb[(((long)b * 16 + h) * SEQ + l) * 96 + 64 + (lane & 31)] = val;
    }
  }
}
DEV void phase_mla_up(const Params& p) {
  const u16* cqn = reinterpret_cast<const u16*>(p.ws + MLA_CQN);
  const u16* ckvn = reinterpret_cast<const u16*>(p.ws + MLA_CKVN);
  const u16* wq = reinterpret_cast<const u16*>(p.ws + W_QUP);
  const u16* wkv = reinterpret_cast<const u16*>(p.ws + W_KVUP);
  u16* Qb = reinterpret_cast<u16*>(p.ws + MLA_Q);
  u16* Kb = reinterpret_cast<u16*>(p.ws + MLA_K);
  u16* VT = reinterpret_cast<u16*>(p.ws + MLA_VT);
  const float qscale = 0.10206207261596577f * 1.4426950408889634f;
  gemm_phase<true, false, false>(384, 64, 6, [&](const Unit& u, const char*& a, const char*& b) { a = (const char*)(cqn) + (size_t)u.pm * 256 * (384) * 2; b = (const char*)(wq) + (size_t)u.pn * 256 * (384) * 2; },
      [&](Acc8& acc, const Unit& u, int wr, int wc, int fr, int fq) {
#pragma unroll
        for (int bj = 0; bj < 2; ++bj) {
          const int c32 = (u.pn * 256 + bj * 128 + wc * 32) >> 5;
          const int h = c32 / 3, part = c32 % 3;
#pragma unroll
          for (int ai = 0; ai < 2; ++ai)
#pragma unroll
            for (int m = 0; m < 4; ++m) {
              const int tok = u.pm * 256 + ai * 128 + wr * 64 + m * 16 + fr;
              const int b = tok >> 11, l = tok & 2047;
              u16* qrow = Qb + (((long)b * 16 + h) * SEQ + l) * 96 + part * 32 + 4 * fq;
              f32x4 a0 = acc[ai][bj][m][0], a1 = acc[ai][bj][m][1];
              if (part == 2) {
#pragma unroll
                for (int j = 0; j < 4; ++j) {
                  float sn, cs; sincosf((float)l * rope_inv(4 * fq + j), &sn, &cs);
                  float r0 = a0[j] * cs - a1[j] * sn, r1 = a0[j] * sn + a1[j] * cs;
                  a0[j] = r0; a1[j] = r1;
                }
              }
              uint2 p0, p1;
              p0.x = cvt_pk_bf16(a0[0] * qscale, a0[1] * qscale); p0.y = cvt_pk_bf16(a0[2] * qscale, a0[3] * qscale);
              p1.x = cvt_pk_bf16(a1[0] * qscale, a1[1] * qscale); p1.y = cvt_pk_bf16(a1[2] * qscale, a1[3] * qscale);
              *reinterpret_cast<uint2*>(qrow) = p0;
              *reinterpret_cast<uint2*>(qrow + 16) = p1;
            }
        }
      });
  gemm_phase<true, true, false>(256, 64, 4, [&](const Unit& u, const char*& a, const char*& b) { a = (const char*)(ckvn) + (size_t)u.pm * 256 * (256) * 2; b = (const char*)(wkv) + (size_t)u.pn * 256 * (256) * 2; },
      [&](Acc8& acc, const Unit& u, int wr, int wc, int fr, int fq) {
        E8_FOR {
          const int tok = u.pm * 256 + ai * 128 + wr * 64 + m * 16 + fr;
          const int b = tok >> 11, l = tok & 2047;
          const int col = u.pn * 256 + bj * 128 + wc * 32 + 8 * fq;
          const int h = col >> 6, d = col & 63;
          f32x4 v0 = acc[ai][bj][m][0], v1 = acc[ai][bj][m][1];
          uint4 pk;
          pk.x = cvt_pk_bf16(v0[0], v0[1]); pk.y = cvt_pk_bf16(v0[2], v0[3]); pk.z = cvt_pk_bf16(v1[0], v1[1]); pk.w = cvt_pk_bf16(v1[2], v1[3]);
          *reinterpret_cast<uint4*>(Kb + (((long)b * 16 + h) * SEQ + l) * 96 + d) = pk;
        }
      });
  gemm_phase<false, false, false>(256, 64, 4, [&](const Unit& u, const char*& a, const char*& b) { a = (const char*)(ckvn) + (size_t)u.pm * 256 * (256) * 2; b = (const char*)(wkv + 1024 * 256) + (size_t)u.pn * 256 * (256) * 2; },
      [&](Acc8& acc, const Unit& u, int wr, int wc, int fr, int fq) {
        E8_FOR {
          const int tok = u.pm * 256 + ai * 128 + wr * 64 + m * 16 + 4 * fq;
          const int b = tok >> 11, l = tok & 2047;
#pragma unroll
          for (int n = 0; n < 2; ++n) {
            const int col = u.pn * 256 + bj * 128 + wc * 32 + n * 16 + fr;
            const int h = col >> 6, d = col & 63;
            f32x4 v = acc[ai][bj][m][n];
            uint2 pk; pk.x = cvt_pk_bf16(v[0], v[1]); pk.y = cvt_pk_bf16(v[2], v[3]);
            *reinterpret_cast<uint2*>(VT + (((long)b * 16 + h) * 64 + d) * SEQ + l) = pk;
          }
        }
      });
}
#ifndef ATT_THR
#define ATT_THR 8.0f
#endif
DEV int kswz(int key) { return (((key >> 3) & 3) << 2) | (key & 3); }
DEV void mla_attn_unit(const Params& p, int u) {
  const int tid = otid(), lane = tid & 63, wid = tid >> 6, fr = lane & 15, fq = lane >> 4;
  const int qb = u & 7, bh = u >> 3;
  const u16* Qb = reinterpret_cast<const u16*>(p.ws + MLA_Q) + (long)bh * SEQ * 96;
  const u16* Kb = reinterpret_cast<const u16*>(p.ws + MLA_K) + (long)bh * SEQ * 96;
  const u16* VT = reinterpret_cast<const u16*>(p.ws + MLA_VT) + (long)bh * 64 * SEQ;
  u16* O = reinterpret_cast<u16*>(p.ws + MLA_O);
  char* kl = smem;
  char* vl = smem + 32768;
  bf16x8 qf[2][3];
#pragma unroll
  for (int qt = 0; qt < 2; ++qt)
#pragma unroll
    for (int ks = 0; ks < 3; ++ks)
      qf[qt][ks] = *reinterpret_cast<const bf16x8*>(Qb + (long)(qb * 256 + wid * 32 + qt * 16 + fr) * 96 + ks * 32 + fq * 8);
  f32x4 o[4][2];
#pragma unroll
  for (int dt = 0; dt < 4; ++dt)
#pragma unroll
    for (int qt = 0; qt < 2; ++qt) o[dt][qt] = f32x4{0.f, 0.f, 0.f, 0.f};
  float mrun[2], lrun[2] = {0.f, 0.f}, rcur[2], rnxt[2] = {0.f, 0.f};
  const int kc0 = tid, kc1 = 512 + tid;
  const int vd = tid >> 3, vpart = tid & 7;
  const int kw0 = (kc0 / 12) * 256 + (((kc0 % 12) ^ kswz(kc0 / 12)) << 4);
  const int kw1 = (kc1 / 12) * 256 + (((kc1 % 12) ^ kswz(kc1 / 12)) << 4);
  const int vw = vd * 128 + ((vpart ^ ((vd >> 1) & 7)) << 4);
  struct Stg { uint4 k0, k1, v; };
  Stg sa, sb;
  sa.k1 = make_uint4(0, 0, 0, 0); sb.k1 = make_uint4(0, 0, 0, 0);
  auto gloadK = [&](Stg& r, int t) {
    const u16* kt = Kb + (long)t * 64 * 96;
    r.k0 = *reinterpret_cast<const uint4*>(kt + kc0 * 8);
    if (tid < 256) r.k1 = *reinterpret_cast<const uint4*>(kt + kc1 * 8);
  };
  auto gloadV = [&](Stg& r, int t) { r.v = *reinterpret_cast<const uint4*>(VT + (long)vd * SEQ + t * 64 + vpart * 8); };
  auto lstoreK = [&](const Stg& r, int buf) {
    *reinterpret_cast<uint4*>(kl + buf * 16384 + kw0) = r.k0;
    if (tid < 256) *reinterpret_cast<uint4*>(kl + buf * 16384 + kw1) = r.k1;
  };
  auto lstoreV = [&](const Stg& r, int buf) { *reinterpret_cast<uint4*>(vl + buf * 8192 + vw) = r.v; };
  const int krow = 8 * (fr >> 2) + (fr & 3);
  const int kf_ = kswz(krow);
  auto qk_tile = [&](const char* kd, f32x4 (&s)[4][2], const float (&ref)[2]) {
#pragma unroll
    for (int kt = 0; kt < 4; ++kt) {
      const int key = 32 * (kt >> 1) + 4 * (kt & 1) + krow;
      bf16x8 kf[3];
#pragma unroll
      for (int ks = 0; ks < 3; ++ks) kf[ks] = *reinterpret_cast<const bf16x8*>(kd + key * 256 + (((ks * 4 + fq) ^ kf_) << 4));
#pragma unroll
      for (int qt = 0; qt < 2; ++qt) {
        f32x4 a = {-ref[qt], -ref[qt], -ref[qt], -ref[qt]};
#pragma unroll
        for (int ks = 0; ks < 3; ++ks) a = __builtin_amdgcn_mfma_f32_16x16x32_bf16(kf[ks], qf[qt][ks], a, 0, 0, 0);
        s[kt][qt] = a;
      }
    }
  };
  __syncthreads();
  gloadK(sa, 0); gloadV(sa, 0); lstoreK(sa, 0); lstoreV(sa, 0);
  gloadK(sa, 1); lstoreK(sa, 1);
  gloadK(sa, 2); gloadV(sa, 1);
  __syncthreads();
  f32x4 sc[4][2], sn[4][2];
  {
    const float zero2[2] = {0.f, 0.f};
    qk_tile(kl, sc, zero2);
#pragma unroll
    for (int qt = 0; qt < 2; ++qt) {
      float tm = -1e30f;
#pragma unroll
      for (int kt = 0; kt < 4; ++kt)
#pragma unroll
        for (int j = 0; j < 4; ++j) tm = fmaxf(tm, sc[kt][qt][j]);
      tm = fmaxf(tm, __shfl_xor(tm, 16));
      tm = fmaxf(tm, __shfl_xor(tm, 32));
      mrun[qt] = tm; rcur[qt] = tm;
#pragma unroll
      for (int kt = 0; kt < 4; ++kt)
#pragma unroll
        for (int j = 0; j < 4; ++j) sc[kt][qt][j] -= tm;
    }
  }
  __syncthreads();
#pragma unroll 1
  for (int t2 = 0; t2 < 32; t2 += 2) {
    { const int t = t2, cur = 0;

    if (t + 3 < 32) gloadK(sb, t + 3);
    if (t + 2 < 32) gloadV(sb, t + 2);
    if (t + 1 < 32) { rnxt[0] = mrun[0]; rnxt[1] = mrun[1]; qk_tile(kl + (cur ^ 1) * 16384, sn, rnxt); }
    bf16x8 pf[2][2];
#pragma unroll
    for (int qt = 0; qt < 2; ++qt) {
      float lm = sc[0][qt][0];
#pragma unroll
      for (int kt = 0; kt < 4; ++kt)
#pragma unroll
        for (int j = 0; j < 4; ++j) lm = fmaxf(lm, sc[kt][qt][j]);
      const bool slow = (lm > ATT_THR) || (rcur[qt] != mrun[qt]);
      if (__any(slow)) {
        const float dl = rcur[qt] - mrun[qt];
        float tm = lm + dl;
        tm = fmaxf(tm, __shfl_xor(tm, 16));
        tm = fmaxf(tm, __shfl_xor(tm, 32));
        const float inc = fmaxf(tm, 0.f);
        const float alpha = __builtin_amdgcn_exp2f(-inc);
        mrun[qt] += inc;
        lrun[qt] *= alpha;
#pragma unroll
        for (int dt = 0; dt < 4; ++dt) { o[dt][qt][0] *= alpha; o[dt][qt][1] *= alpha; o[dt][qt][2] *= alpha; o[dt][qt][3] *= alpha; }
        const float sh = dl - inc;
#pragma unroll
        for (int kt = 0; kt < 4; ++kt)
#pragma unroll
          for (int j = 0; j < 4; ++j) sc[kt][qt][j] += sh;
      }
      float ls = 0.f;
#pragma unroll
      for (int kt = 0; kt < 4; ++kt)
#pragma unroll
        for (int j = 0; j < 4; ++j) { float e = __builtin_amdgcn_exp2f(sc[kt][qt][j]); sc[kt][qt][j] = e; ls += e; }
      lrun[qt] += ls;
#pragma unroll
      for (int k2 = 0; k2 < 2; ++k2) {
        union { bf16x8 v; unsigned u[4]; } t_;
        t_.u[0] = cvt_pk_bf16(sc[2 * k2][qt][0], sc[2 * k2][qt][1]); t_.u[1] = cvt_pk_bf16(sc[2 * k2][qt][2], sc[2 * k2][qt][3]);
        t_.u[2] = cvt_pk_bf16(sc[2 * k2 + 1][qt][0], sc[2 * k2 + 1][qt][1]); t_.u[3] = cvt_pk_bf16(sc[2 * k2 + 1][qt][2], sc[2 * k2 + 1][qt][3]);
        pf[k2][qt] = t_.v;
      }
    }
    const char* vdl = vl + cur * 8192;
#pragma unroll
    for (int k2 = 0; k2 < 2; ++k2)
#pragma unroll
      for (int dt = 0; dt < 4; ++dt) {
        const int dim = dt * 16 + fr;
        bf16x8 af = *reinterpret_cast<const bf16x8*>(vdl + dim * 128 + (((k2 * 4 + fq) ^ ((dim >> 1) & 7)) << 4));
#pragma unroll
        for (int qt = 0; qt < 2; ++qt) o[dt][qt] = __builtin_amdgcn_mfma_f32_16x16x32_bf16(af, pf[k2][qt], o[dt][qt], 0, 0, 0);
      }
    if (t + 2 < 32) lstoreK(sa, cur);
    if (t + 1 < 32) lstoreV(sa, cur ^ 1);
    __syncthreads();
#pragma unroll
    for (int kt = 0; kt < 4; ++kt)
#pragma unroll
      for (int qt = 0; qt < 2; ++qt) sc[kt][qt] = sn[kt][qt];
    rcur[0] = rnxt[0]; rcur[1] = rnxt[1];
      }
    { const int t = t2 + 1, cur = 1;

    if (t + 3 < 32) gloadK(sa, t + 3);
    if (t + 2 < 32) gloadV(sa, t + 2);
    if (t + 1 < 32) { rnxt[0] = mrun[0]; rnxt[1] = mrun[1]; qk_tile(kl + (cur ^ 1) * 16384, sn, rnxt); }
    bf16x8 pf[2][2];
#pragma unroll
    for (int qt = 0; qt < 2; ++qt) {
      float lm = sc[0][qt][0];
#pragma unroll
      for (int kt = 0; kt < 4; ++kt)
#pragma unroll
        for (int j = 0; j < 4; ++j) lm = fmaxf(lm, sc[kt][qt][j]);
      const bool slow = (lm > ATT_THR) || (rcur[qt] != mrun[qt]);
      if (__any(slow)) {
        const float dl = rcur[qt] - mrun[qt];
        float tm = lm + dl;
        tm = fmaxf(tm, __shfl_xor(tm, 16));
        tm = fmaxf(tm, __shfl_xor(tm, 32));
        const float inc = fmaxf(tm, 0.f);
        const float alpha = __builtin_amdgcn_exp2f(-inc);
        mrun[qt] += inc;
        lrun[qt] *= alpha;
#pragma unroll
        for (int dt = 0; dt < 4; ++dt) { o[dt][qt][0] *= alpha; o[dt][qt][1] *= alpha; o[dt][qt][2] *= alpha; o[dt][qt][3] *= alpha; }
        const float sh = dl - inc;
#pragma unroll
        for (int kt = 0; kt < 4; ++kt)
#pragma unroll
          for (int j = 0; j < 4; ++j) sc[kt][qt][j] += sh;
      }
      float ls = 0.f;
#pragma unroll
      for (int kt = 0; kt < 4; ++kt)
#pragma unroll
        for (int j = 0; j < 4; ++j) { float e = __builtin_amdgcn_exp2f(sc[kt][qt][j]); sc[kt][qt][j] = e; ls += e; }
      lrun[qt] += ls;
#pragma unroll
      for (int k2 = 0; k2 < 2; ++k2) {
        union { bf16x8 v; unsigned u[4]; } t_;
        t_.u[0] = cvt_pk_bf16(sc[2 * k2][qt][0], sc[2 * k2][qt][1]); t_.u[1] = cvt_pk_bf16(sc[2 * k2][qt][2], sc[2 * k2][qt][3]);
        t_.u[2] = cvt_pk_bf16(sc[2 * k2 + 1][qt][0], sc[2 * k2 + 1][qt][1]); t_.u[3] = cvt_pk_bf16(sc[2 * k2 + 1][qt][2], sc[2 * k2 + 1][qt][3]);
        pf[k2][qt] = t_.v;
      }
    }
    const char* vdl = vl + cur * 8192;
#pragma unroll
    for (int k2 = 0; k2 < 2; ++k2)
#pragma unroll
      for (int dt = 0; dt < 4; ++dt) {
        const int dim = dt * 16 + fr;
        bf16x8 af = *reinterpret_cast<const bf16x8*>(vdl + dim * 128 + (((k2 * 4 + fq) ^ ((dim >> 1) & 7)) << 4));
#pragma unroll
        for (int qt = 0; qt < 2; ++qt) o[dt][qt] = __builtin_amdgcn_mfma_f32_16x16x32_bf16(af, pf[k2][qt], o[dt][qt], 0, 0, 0);
      }
    if (t + 2 < 32) lstoreK(sb, cur);
    if (t + 1 < 32) lstoreV(sb, cur ^ 1);
    __syncthreads();
#pragma unroll
    for (int kt = 0; kt < 4; ++kt)
#pragma unroll
      for (int qt = 0; qt < 2; ++qt) sc[kt][qt] = sn[kt][qt];
    rcur[0] = rnxt[0]; rcur[1] = rnxt[1];
      }
  }
  const int b = bh >> 4, h = bh & 15;
#pragma unroll
  for (int qt = 0; qt < 2; ++qt) {
    float l = lrun[qt];
    l += __shfl_xor(l, 16);
    l += __shfl_xor(l, 32);
    const float inv = 1.0f / l;
    const long tok = (long)b * SEQ + qb * 256 + wid * 32 + qt * 16 + fr;
#pragma unroll
    for (int dt = 0; dt < 4; ++dt) {
      uint2 pk; pk.x = pack2(o[dt][qt][0] * inv, o[dt][qt][1] * inv); pk.y = pack2(o[dt][qt][2] * inv, o[dt][qt][3] * inv);
      *reinterpret_cast<uint2*>(O + tok * 1024 + h * 64 + dt * 16 + 4 * fq) = pk;
    }
  }
}
DEV void phase_mla_attn(const Params& p) {
  const int nb = gridDim.x;
  for (int u = blockIdx.x; u < NBATCH * 16 * 8; u += nb) mla_attn_unit(p, u);
}

#ifndef ONLY
#define ONLY -1
#endif
#define PH(n, ...) if (ONLY < 0 || ONLY == n) { __VA_ARGS__; }
constexpr int LDS_BAR_OFF = 148480;
__global__ void __launch_bounds__(512) mega(Params p) {
  cg::grid_group grid = cg::this_grid();
  unsigned* barw = reinterpret_cast<unsigned*>(p.ws + S_BAR);
  if (blockIdx.x == 0) for (int i = threadIdx.x; i < XCD_BAR_WORDS; i += 512) barw[i] = 0u;
  if (threadIdx.x == 0) *reinterpret_cast<uint4*>(smem + LDS_BAR_OFF) = make_uint4(0u, 0u, 0u, 0u);
  PH(0, phase_prep(p));
  grid.sync();
  (void)xcd_barrier_post(barw, (volatile LAS unsigned*)(smem + LDS_BAR_OFF));
#define GSYNC() do { XcdBarrier xb_; xb_.bar = reinterpret_cast<unsigned*>(p.ws + S_BAR); xb_.x = xb_xcc_id(); xb_.st = (volatile LAS unsigned*)(smem + LDS_BAR_OFF); xcd_barrier(xb_); } while (0)
  PH(1, phase_abin(p)); GSYNC();
  PH(2, phase_mix0(p)); GSYNC();
  PH(2, phase_ztrans(p)); GSYNC();
  PH(3, phase_outproj(p, reinterpret_cast<const u16*>(p.ws + REG_A + 100663296ull), reinterpret_cast<const u16*>(p.ws + W_ABOUT), p.x)); GSYNC();
  for (int layer = 0; layer < 2; ++layer) {
    if (layer == 1) {
      PH(10, phase_mla_in(p)); GSYNC();
      PH(11, phase_mla_norm(p)); GSYNC();
      PH(12, phase_mla_up(p)); GSYNC();
      PH(13, phase_mla_attn(p)); GSYNC();
      PH(3, phase_outproj(p, reinterpret_cast<const u16*>(p.ws + MLA_O), reinterpret_cast<const u16*>(p.ws + W_MLAOUT), reinterpret_cast<const float*>(p.ws + REG_G))); GSYNC();
    }
    PH(4, phase_ln1_router(p, layer)); GSYNC();
    PH(5, phase_topk(p)); GSYNC();
    PH(6, phase_moe1(p, layer)); GSYNC();
    PH(7, phase_moe2(p, layer)); GSYNC();
    PH(8, phase_ln2(p, layer)); GSYNC();
    PH(9, phase_ple(p, layer, layer ? p.out : reinterpret_cast<float*>(p.ws + REG_G), layer ? nullptr : reinterpret_cast<u16*>(p.ws + REG_X)));
    if (layer == 0) GSYNC();
  }
}

static void add_job(Params& P, int& nj, int& tile, const float* src, u16* dst, int K, int N, int rsh, int rs, int off, int count, long sstride, long dstride, int f8 = 0, float fscale = 1.0f) {
  ConvJob& J = P.jobs[nj++];
  J.src = src; J.dst = dst; J.sstride = sstride; J.dstride = dstride; J.K = K; J.N = N; J.rs = rs; J.off = off; J.rsh = rsh;
  J.f8 = f8; J.fscale = fscale;
  if (f8) { J.ntn = N / 128; J.tpm = (K / 128) * J.ntn; } else { J.ntn = (N + 255) / 256; J.tpm = (K / 64) * J.ntn; }
  J.tile0 = tile; J.ntiles = J.tpm * count;
  tile += J.ntiles;
}

extern "C" void kernel_launch(void* const* d_in, const int* in_sizes, int n_in,
                              void* d_out, int out_size, void* d_ws, size_t ws_size,
                              hipStream_t stream) {
  constexpr size_t kDynLds = 148480 + 16;
  static int grid_blocks = 0;
  if (!grid_blocks) {
    int dev = 0, cus = 0, per_cu = 0;
    (void)hipGetDevice(&dev);
    (void)hipDeviceGetAttribute(&cus, hipDeviceAttributeMultiprocessorCount, dev);
    (void)hipFuncSetAttribute((const void*)mega, hipFuncAttributeMaxDynamicSharedMemorySize, (int)kDynLds);
    (void)hipOccupancyMaxActiveBlocksPerMultiprocessor(&per_cu, mega, 512, kDynLds);
    if (per_cu > 1) per_cu = 1;
    if (per_cu < 1) { fprintf(stderr, "occupancy query returned 0\n"); per_cu = 1; }
    grid_blocks = cus * per_cu;
    if (ws_size < WS_TOTAL) fprintf(stderr, "workspace too small: %zu < %zu\n", ws_size, (size_t)WS_TOTAL);
  }
  Params P;
  memset(&P, 0, sizeof(P));
  auto F = [&](int i) { return (const float*)d_in[i]; };
  char* ws = (char*)d_ws;
  P.x = F(0); P.p = F(1);
  P.na_rpb = F(3); P.hy_conv_w = F(4); P.hy_conv_b = F(5);
  P.hy_f_w1 = F(6); P.hy_f_b1 = F(7); P.hy_f_freq = F(8); P.hy_f_w2 = F(9); P.hy_f_b2 = F(10); P.hy_f_w3 = F(11); P.hy_skip = F(12);
  P.mla_q_norm = F(15); P.mla_kv_norm = F(17);
  P.ln1_g = F(20); P.ln1_b = F(21); P.ln2_g = F(22); P.ln2_b = F(23);
  P.moe_router = F(24);
  P.out = (float*)d_out; P.ws = ws;
  int nj = 0, tile = 0;
  add_job(P, nj, tile, F(2), (u16*)(ws + W_ABIN), 1024, 3072, 7, 128, 0, 1, 0, 0);
  add_job(P, nj, tile, F(13), (u16*)(ws + W_ABOUT), 1024, 1024, 7, 128, 0, 1, 0, 0);
  add_job(P, nj, tile, F(14), (u16*)(ws + W_MLAIN), 1024, 672, 7, 128, 0, 1, 0, 0);
  add_job(P, nj, tile, F(16), (u16*)(ws + W_QUP), 384, 1536, 7, 128, 0, 1, 0, 0);
  add_job(P, nj, tile, F(18), (u16*)(ws + W_KVUP), 256, 2048, 6, 64, 0, 1, 0, 0);
  P.jobs[nj - 1].sh2 = 1; P.jobs[nj - 1].off2 = 1024;
  add_job(P, nj, tile, F(19), (u16*)(ws + W_MLAOUT), 1024, 1024, 7, 128, 0, 1, 0, 0);
  add_job(P, nj, tile, F(28), (u16*)(ws + W_PLEG), 1024, 1024, 7, 128, 0, 2, 1024L * 1024, 1024L * 1024);
  add_job(P, nj, tile, F(29), (u16*)(ws + W_PLEP), 256, 1024, 7, 128, 0, 2, 256L * 1024, 1024L * 256);
  add_job(P, nj, tile, F(25), (u16*)(ws + W_GU), 1024, 2048, 7, 256, 0, 32, 1024L * 2048, 4096L * 1024, 1, 32.0f);
  add_job(P, nj, tile, F(26), (u16*)(ws + W_GU), 1024, 2048, 7, 256, 128, 32, 1024L * 2048, 4096L * 1024, 1, 32.0f);
  add_job(P, nj, tile, F(27), (u16*)(ws + W_DN), 2048, 1024, 7, 128, 0, 32, 2048L * 1024, 1024L * 2048, 1, 64.0f);
  P.conv_total = tile;
  void* args[] = {&P};
  hipError_t e = hipLaunchCooperativeKernel((void*)mega, dim3(grid_blocks), dim3(512), args, kDynLds, stream);
  if (e != hipSuccess) fprintf(stderr, "cooperative launch failed: %s (grid %d)\n", hipGetErrorString(e), grid_blocks);
}
```

```cpp
#include <hip/hip_runtime.h>
#include <hip/hip_bf16.h>
#include <hip/hip_cooperative_groups.h>
#include <cstdio>
#include <cstring>
namespace cg = cooperative_groups;

typedef unsigned short u16;
using bf16x8 = __attribute__((ext_vector_type(8))) short;
using bf16x4 = __attribute__((ext_vector_type(4))) short;
using f32x4 = __attribute__((ext_vector_type(4))) float;
#define DEV __device__ __forceinline__

constexpr int TOK = 16384, DM = 1024, SEQ = 2048, NBATCH = 8;
constexpr int NEXP = 16, CAP = 256, DFF = 2048;
constexpr float DN_ALPHA = 1.4142135623730951f;
constexpr float LN_EPS = 1e-5f;

constexpr size_t W_ABIN = 0;
constexpr size_t W_ABOUT = W_ABIN + 3072ull * 1024 * 2;
constexpr size_t W_MLAIN = W_ABOUT + 1024ull * 1024 * 2;
constexpr size_t W_QUP = W_MLAIN + 768ull * 1024 * 2;
constexpr size_t W_KVUP = W_QUP + 1536ull * 384 * 2;
constexpr size_t W_MLAOUT = W_KVUP + 2048ull * 256 * 2;
constexpr size_t W_PLEG = W_MLAOUT + 1024ull * 1024 * 2;
constexpr size_t W_PLEP = W_PLEG + 2 * 1024ull * 1024 * 2;
constexpr size_t W_GU = W_PLEP + 2 * 1024ull * 256 * 2;
constexpr size_t W_DN = W_GU + 2 * 16ull * 4096 * 1024 * 2;
constexpr size_t REG_A = W_DN + 2 * 16ull * 1024 * 2048 * 2;
constexpr size_t REG_B = REG_A + 134217728ull;
constexpr size_t REG_C = REG_B + 134217728ull;
constexpr size_t REG_D = REG_C + 67108864ull;
constexpr size_t REG_E = REG_D + 67108864ull;
constexpr size_t REG_G = REG_E + 33554432ull;
constexpr size_t REG_X = REG_G + 67108864ull;
constexpr size_t REG_P = REG_X + 33554432ull;
constexpr size_t S_AFF = REG_P + 16777216ull;
constexpr size_t S_IDX = S_AFF + 1048576ull;
constexpr size_t S_GSEL = S_IDX + 131072ull;
constexpr size_t S_SLOT = S_GSEL + 131072ull;
constexpr size_t S_H2 = S_SLOT + 1048576ull;
constexpr size_t S_RG = S_H2 + 524288ull;
constexpr size_t S_ROPE = S_RG + 8388608ull;
constexpr size_t S_BAR = S_ROPE + 262144ull;
constexpr size_t WS_TOTAL = S_BAR + 16384ull;

struct ConvJob {
  const float* src; u16* dst;
  long sstride, dstride;
  int K, N;
  int rs, off;
  int rsh, sh2, off2, f8;
  float fscale; int padk;
  int ntn;
  int tpm;
  int tile0, ntiles;
};
constexpr int NJOBS = 16;

struct Params {
  const float* x; const float* p;
  const float* na_rpb; const float* hy_conv_w; const float* hy_conv_b;
  const float* hy_f_w1; const float* hy_f_b1; const float* hy_f_freq; const float* hy_f_w2; const float* hy_f_b2;
  const float* hy_f_w3; const float* hy_skip;
  const float* mla_q_norm; const float* mla_kv_norm;
  const float* ln1_g; const float* ln1_b; const float* ln2_g; const float* ln2_b;
  const float* moe_router;
  float* out; char* ws;
  int conv_total; int pad0;
  ConvJob jobs[NJOBS];
};

extern __shared__ __attribute__((aligned(16))) char smem[];

typedef __bf16 bf16x2_t __attribute__((ext_vector_type(2)));
typedef float f32x2_t __attribute__((ext_vector_type(2)));
DEV unsigned cvt_pk_bf16(float lo, float hi) { f32x2_t f = {lo, hi}; bf16x2_t b = __builtin_convertvector(f, bf16x2_t); return __builtin_bit_cast(unsigned, b); }
DEV u16 f2bf(float f) { return (u16)(cvt_pk_bf16(f, 0.f) & 0xffffu); }
DEV float bf2f(u16 h) { return __uint_as_float(((unsigned)h) << 16); }
DEV unsigned pack2(float a, float b) { return cvt_pk_bf16(a, b); }
DEV unsigned pack4_f8(float a, float b, float c, float d) { int w = 0; w = __builtin_amdgcn_cvt_pk_fp8_f32(a, b, w, false); w = __builtin_amdgcn_cvt_pk_fp8_f32(c, d, w, true); return (unsigned)w; }
DEV float4 bf4_to_f4(uint2 t) { return make_float4(__uint_as_float(t.x << 16), __uint_as_float(t.x & 0xffff0000u), __uint_as_float(t.y << 16), __uint_as_float(t.y & 0xffff0000u)); }
DEV float fsigmoid(float x) { return __builtin_amdgcn_rcpf(1.0f + __builtin_amdgcn_exp2f(-1.4426950408889634f * x)); }
DEV float wave_sum(float v) {
#pragma unroll
  for (int o = 32; o > 0; o >>= 1) v += __shfl_xor(v, o);
  return v;
}
DEV int otid() { int t = threadIdx.x; asm volatile("" : "+v"(t)); return t; }
DEV int vstart() {
  int nb = gridDim.x, b = blockIdx.x;
  return (nb % 8 == 0) ? (b % 8) * (nb / 8) + b / 8 : b;
}


#define XB_TMO      128
#define XB_XCNT(j)  (256  + 64 * (j))
#define XB_XSUB(j)  (1280 + 64 * (j))
#define XB_XGEN(j)  (2304 + 64 * (j))
#define XB_TOP      3328
#define XB_TOPGEN   3392
#define XCD_BAR_WORDS 3456
#define XB_SPIN_CAP (1u << 18)
#define LAS __attribute__((address_space(3)))
DEV unsigned xb_ld(unsigned* p) { return __hip_atomic_load(p, __ATOMIC_RELAXED, __HIP_MEMORY_SCOPE_AGENT); }
DEV unsigned xb_add(unsigned* p, unsigned v) { return __hip_atomic_fetch_add(p, v, __ATOMIC_RELAXED, __HIP_MEMORY_SCOPE_AGENT); }
DEV unsigned xb_xcc_id() { return (unsigned)__builtin_amdgcn_s_getreg((3 << 11) | 20) & 0xFu; }
#define XB_SPIN(cond, bar) do { unsigned _sp = 0; while (cond) { __builtin_amdgcn_s_sleep(1); \
    if ((++_sp & 255u) == 0u) { if (xb_ld(&(bar)[XB_TMO])) break; if (_sp > XB_SPIN_CAP) { atomicAdd(&(bar)[XB_TMO], 1u); break; } } } } while (0)
struct XcdBarrier { unsigned* bar; unsigned x; volatile LAS unsigned* st; };
DEV XcdBarrier xcd_barrier_post(unsigned* bar, volatile LAS unsigned* st) {
  XcdBarrier b; b.bar = bar; b.x = xb_xcc_id(); b.st = st;
  if (threadIdx.x == 0) (void)xb_add(&bar[XB_XCNT(b.x)], 1u);
  return b;
}
DEV void xcd_barrier_complete(unsigned* bar, unsigned x, unsigned& nloc, unsigned& nx) {
  const unsigned G = gridDim.x * gridDim.y * gridDim.z;
  unsigned sum, cnt, mine, sp = 0u;
  for (;;) {
    sum = 0u; cnt = 0u; mine = 0u;
#pragma unroll
    for (unsigned j = 0; j < 16; ++j) { const unsigned c = xb_ld(&bar[XB_XCNT(j)]); sum += c; cnt += (c > 0u) ? 1u : 0u; mine = (j == x) ? c : mine; }
    if (sum == G) break;
    __builtin_amdgcn_s_sleep(1);
    if ((++sp & 255u) == 0u) { if (xb_ld(&bar[XB_TMO])) break; if (sp > XB_SPIN_CAP) { atomicAdd(&bar[XB_TMO], 1u); break; } }
  }
  nloc = mine > 0u ? mine : 1u; nx = cnt > 0u ? cnt : 1u;
}
DEV void xcd_barrier(const XcdBarrier& b) {
  asm volatile("s_waitcnt vmcnt(0)" ::: "memory");
  __syncthreads();
  if (threadIdx.x == 0) {
    unsigned* bar = b.bar;
    __builtin_amdgcn_s_waitcnt(0);
    unsigned nloc = b.st[0], nx = b.st[1];
    if (nloc == 0u) { xcd_barrier_complete(bar, b.x, nloc, nx); b.st[0] = nloc; b.st[1] = nx; }
    const unsigned old = xb_add(&bar[XB_XSUB(b.x)], 1u);
    const unsigned gen = old / nloc;
    if (old + 1u == (gen + 1u) * nloc) {
      __builtin_amdgcn_fence(__ATOMIC_RELEASE, "agent");
      asm volatile("s_waitcnt vmcnt(0)" ::: "memory");
      const unsigned og = xb_add(&bar[XB_TOP], 1u);
      const unsigned tg = og / nx;
      if (og + 1u == (tg + 1u) * nx) xb_add(&bar[XB_TOPGEN], 1u);
      else XB_SPIN(xb_ld(&bar[XB_TOPGEN]) == tg, bar);
      __builtin_amdgcn_fence(__ATOMIC_ACQUIRE, "agent");
      xb_add(&bar[XB_XGEN(b.x)], 1u);
      asm volatile("s_waitcnt vmcnt(0)" ::: "memory");
    } else {
      XB_SPIN(xb_ld(&bar[XB_XGEN(b.x)]) == gen, bar);
      __builtin_amdgcn_fence(__ATOMIC_ACQUIRE, "agent");
      asm volatile("s_waitcnt vmcnt(0)" ::: "memory");
    }
  }
  __syncthreads();
}

DEV int lds_byte(int r, int c) {
  int st = (r >> 4) * 2 + (c >> 5), rr = r & 15, cc = c & 31, ob = rr * 64 + cc * 2;
  return st * 1024 + (ob ^ (((ob >> 9) & 1) << 5));
}
DEV void stage_rc(int b, int& R, int& C) {
  int st = b / 1024, sb = b % 1024, swz = sb ^ (((sb >> 9) & 1) << 5);
  R = (st >> 1) * 16 + swz / 64; C = (st & 1) * 32 + (swz % 64) / 2;
}
#define GLDS16(g, l) __builtin_amdgcn_global_load_lds((const unsigned*)(g), (unsigned*)(l), 16, 0, 0)

typedef f32x4 Acc8[2][2][4][2];
constexpr int G8_BM = 256, G8_BK = 64, G8_HALF = 128, G8_HTB = G8_HALF * G8_BK * 2, G8_NXCD = 8, G8_WGM = 8;
DEV int perm32(int rho) { const int n = rho >> 4, i = rho & 15; return 8 * (i >> 2) + 4 * n + (i & 3); }
struct Unit { int pm, pn; };
DEV bool unit_next(int i, int nM, int nN, Unit& u) {
  const int nwg = nM * nN;
  const long L = (long)i * gridDim.x + blockIdx.x; if (L >= nwg) return false;
  int wgid = (int)L; { const int q = nwg / G8_NXCD, r = nwg % G8_NXCD, xcd = wgid % G8_NXCD, off = wgid / G8_NXCD; wgid = (xcd < r ? xcd * (q + 1) : r * (q + 1) + (xcd - r) * q) + off; }
  const int nig = G8_WGM * nN, gid = wgid / nig, fm = gid * G8_WGM, gsz = (nM - fm) < G8_WGM ? (nM - fm) : G8_WGM;
  u.pm = fm + ((wgid % nig) % gsz); u.pn = (wgid % nig) / gsz; return true;
}
typedef int v4i_t __attribute__((ext_vector_type(4)));
typedef int v8i_t __attribute__((ext_vector_type(8)));
template <bool TR, bool PERM, bool F8, class PF, class EF>
DEV void gemm_phase(const int K, const int nM, const int nN, PF ptrs, EF E) {
  LAS unsigned char* lds = (LAS unsigned char*)smem;
  const int tid = otid(), wid = __builtin_amdgcn_readfirstlane(tid >> 6), lane = tid & 63, wr = wid >> 2, wc = wid & 3, fr = lane & 15, fq = lane >> 4;
  const int Kb = F8 ? K : 2 * K;
  const int nt = Kb / 128;
  unsigned voffA[2], voffB[2];
#pragma unroll
  for (int i = 0; i < 2; ++i) { int R, C; stage_rc(tid * 16 + i * 8192, R, C); const int Rb = PERM ? ((R & ~31) + perm32(R & 31)) : R;
    voffA[i] = (unsigned)(R * Kb + C * 2); voffB[i] = (unsigned)(Rb * Kb + C * 2); }
  const size_t kstep = (size_t)(G8_BK * 2);
  const size_t hstep = (size_t)G8_HALF * Kb;
  const unsigned ldsw = (unsigned)wid * 1024u;
  const int aoff = lds_byte(wr * 64 + fr, fq * 8), boff = lds_byte(wc * 32 + fr, fq * 8);
#define PG8_SA(b, h) (((b) * 2 + (h)) * G8_HTB)
#define PG8_SB(b, h) ((4 + (b) * 2 + (h)) * G8_HTB)
#define PG8_STAGE(bufoff, gbase, voff) do { _Pragma("unroll") for (int _i = 0; _i < 2; ++_i) { unsigned _vo = (voff)[_i]; asm volatile("" : "+v"(_vo)); \
    __builtin_amdgcn_global_load_lds((const unsigned*)((const char*)(gbase) + _vo), (LAS unsigned*)(lds + (bufoff) + ldsw + _i * 8192), 16, 0, 0); } } while (0)
#define PG8_LD16(off) (*(const LAS v4i_t*)(lds + (off)))
#define PG8_LDA(dst, b, h) do { if constexpr (F8) { _Pragma("unroll") for (int m = 0; m < 4; ++m) dst##8[m] = __builtin_shufflevector(PG8_LD16(PG8_SA(b, h) + aoff + m * 2048), PG8_LD16(PG8_SA(b, h) + aoff + m * 2048 + 1024), 0, 1, 2, 3, 4, 5, 6, 7); } \
    else { _Pragma("unroll") for (int m = 0; m < 4; ++m) _Pragma("unroll") for (int k = 0; k < 2; ++k) dst[m][k] = *(const LAS bf16x8*)(lds + PG8_SA(b, h) + aoff + m * 2048 + k * 1024); } } while (0)
#define PG8_LDB(dst, b, h) do { if constexpr (F8) { _Pragma("unroll") for (int n = 0; n < 2; ++n) dst##8[n] = __builtin_shufflevector(PG8_LD16(PG8_SB(b, h) + boff + n * 2048), PG8_LD16(PG8_SB(b, h) + boff + n * 2048 + 1024), 0, 1, 2, 3, 4, 5, 6, 7); } \
    else { _Pragma("unroll") for (int n = 0; n < 2; ++n) _Pragma("unroll") for (int k = 0; k < 2; ++k) dst[n][k] = *(const LAS bf16x8*)(lds + PG8_SB(b, h) + boff + n * 2048 + k * 1024); } } while (0)
#define PG8_MMA(ai, bj, At, Bt) do { __builtin_amdgcn_s_setprio(1); \
    if constexpr (F8) { _Pragma("unroll") for (int m = 0; m < 4; ++m) _Pragma("unroll") for (int n = 0; n < 2; ++n) \
        { if constexpr (TR) asm volatile("v_mfma_f32_16x16x128_f8f6f4 %0, %1, %2, %0" : "+v"(acc[ai][bj][m][n]) : "v"(Bt##8[n]), "v"(At##8[m])); \
          else asm volatile("v_mfma_f32_16x16x128_f8f6f4 %0, %1, %2, %0" : "+v"(acc[ai][bj][m][n]) : "v"(At##8[m]), "v"(Bt##8[n])); } } \
    else { _Pragma("unroll") for (int m = 0; m < 4; ++m) _Pragma("unroll") for (int n = 0; n < 2; ++n) _Pragma("unroll") for (int k = 0; k < 2; ++k) \
    acc[ai][bj][m][n] = TR ? __builtin_amdgcn_mfma_f32_16x16x32_bf16(Bt[n][k], At[m][k], acc[ai][bj][m][n], 0, 0, 0) \
                           : __builtin_amdgcn_mfma_f32_16x16x32_bf16(At[m][k], Bt[n][k], acc[ai][bj][m][n], 0, 0, 0); } __builtin_amdgcn_s_setprio(0); } while (0)
#define PG8_WAIT_V(n) asm volatile("s_waitcnt vmcnt(" #n ")" ::: "memory")
#define PG8_WAIT_L(n) asm volatile("s_waitcnt lgkmcnt(" #n ")" ::: "memory")
#define PG8_BAR __builtin_amdgcn_s_barrier()
#define PG8_SCHED __builtin_amdgcn_sched_barrier(0)
  Unit cur, nxt; int ui = 0;
  if (!unit_next(0, nM, nN, cur)) return;
  Acc8 acc;
#pragma unroll
  for (int a = 0; a < 2; ++a)
#pragma unroll
    for (int b = 0; b < 2; ++b)
#pragma unroll
      for (int m = 0; m < 4; ++m)
#pragma unroll
        for (int n = 0; n < 2; ++n) acc[a][b][m][n] = f32x4{0.f, 0.f, 0.f, 0.f};
  bf16x8 At[4][2], B0[2][2], B1[2][2];
  v8i_t At8[4], B08[2], B18[2];
  const char* cA; const char* cB;
  ptrs(cur, cA, cB);
  PG8_STAGE(PG8_SB(0, 0), cB, voffB); PG8_STAGE(PG8_SA(0, 0), cA, voffA); PG8_STAGE(PG8_SB(0, 1), cB + hstep, voffB); PG8_STAGE(PG8_SA(0, 1), cA + hstep, voffA);
  if (wr == 1) PG8_BAR;
  PG8_WAIT_V(4); PG8_BAR;
  PG8_STAGE(PG8_SB(1, 0), cB + kstep, voffB); PG8_STAGE(PG8_SA(1, 0), cA + kstep, voffA); PG8_STAGE(PG8_SB(1, 1), cB + hstep + kstep, voffB);
  PG8_WAIT_V(6); PG8_BAR;
  for (;;) {
    const bool has_next = unit_next(ui + 1, nM, nN, nxt);
    const char* nA = cA; const char* nB = cB;
    if (has_next) ptrs(nxt, nA, nB);
#pragma unroll 1
    for (int t = 0; t < nt; t += 2) {
      const bool last = (t == nt - 2);
      const char* a1 = cA + (size_t)(t + 1) * kstep;
      const char* a2 = last ? nA : cA + (size_t)(t + 2) * kstep; const char* b2 = last ? nB : cB + (size_t)(t + 2) * kstep;
      const char* a3 = a2 + kstep; const char* b3 = b2 + kstep;
      PG8_LDB(B0, 0, 0); PG8_SCHED; PG8_LDA(At, 0, 0); PG8_STAGE(PG8_SA(1, 1), a1 + hstep, voffA);
      PG8_WAIT_L(8); PG8_BAR; PG8_WAIT_L(0); PG8_MMA(0, 0, At, B0); PG8_BAR; PG8_SCHED;
      PG8_LDB(B1, 0, 1); PG8_STAGE(PG8_SB(0, 0), b2, voffB);
      PG8_BAR; PG8_WAIT_L(0); PG8_MMA(0, 1, At, B1); PG8_BAR;
      PG8_LDA(At, 0, 1); PG8_STAGE(PG8_SA(0, 0), a2, voffA);
      PG8_BAR; PG8_WAIT_L(0); PG8_MMA(1, 0, At, B0); PG8_BAR; PG8_SCHED;
      PG8_STAGE(PG8_SB(0, 1), b2 + hstep, voffB);
      PG8_WAIT_V(6); PG8_BAR; PG8_MMA(1, 1, At, B1); PG8_BAR;
      PG8_LDB(B0, 1, 0); PG8_SCHED; PG8_LDA(At, 1, 0); PG8_STAGE(PG8_SA(0, 1), a2 + hstep, voffA);
      PG8_WAIT_L(8); PG8_BAR; PG8_WAIT_L(0); PG8_MMA(0, 0, At, B0); PG8_BAR; PG8_SCHED;
      PG8_LDB(B1, 1, 1); PG8_STAGE(PG8_SB(1, 0), b3, voffB);
      PG8_BAR; PG8_WAIT_L(0); PG8_MMA(0, 1, At, B1); PG8_BAR;
      PG8_LDA(At, 1, 1); PG8_STAGE(PG8_SA(1, 0), a3, voffA);
      PG8_BAR; PG8_WAIT_L(0); PG8_MMA(1, 0, At, B0); PG8_BAR; PG8_SCHED;
      PG8_STAGE(PG8_SB(1, 1), b3 + hstep, voffB);
      PG8_WAIT_V(6); PG8_BAR; PG8_MMA(1, 1, At, B1); PG8_BAR;
    }
    if constexpr (F8) asm volatile("s_nop 15\n\ts_nop 15" ::: "memory");
    { const int l2 = otid() & 63; E(acc, cur, wr, wc, l2 & 15, l2 >> 4); }
    if (!has_next) break;
#pragma unroll
    for (int a = 0; a < 2; ++a)
#pragma unroll
      for (int b = 0; b < 2; ++b)
#pragma unroll
        for (int m = 0; m < 4; ++m)
#pragma unroll
          for (int n = 0; n < 2; ++n) acc[a][b][m][n] = f32x4{0.f, 0.f, 0.f, 0.f};
    cur = nxt; cA = nA; cB = nB; ++ui;
  }
  PG8_WAIT_V(0);
  if (wr == 0) PG8_BAR;
  PG8_BAR;
#undef PG8_SA
#undef PG8_SB
#undef PG8_STAGE
#undef PG8_LDA
#undef PG8_LD16
#undef PG8_LDB
#undef PG8_MMA
#undef PG8_WAIT_V
#undef PG8_WAIT_L
#undef PG8_BAR
#undef PG8_SCHED
}
#define E8_FOR _Pragma("unroll") for (int ai = 0; ai < 2; ++ai) _Pragma("unroll") for (int m = 0; m < 4; ++m) _Pragma("unroll") for (int bj = 0; bj < 2; ++bj)

DEV void conv_tile(const ConvJob& J, int t) {
  const int tid = otid();
  int mat = t / J.tpm, tt = t % J.tpm;
  int kt = tt / J.ntn, nt = tt % J.ntn;
  const float* src = J.src + (long)mat * J.sstride;
  u16* dst = J.dst + (long)mat * J.dstride;
  const int kg = tid >> 6, ng = tid & 63;
  const int n = nt * 256 + ng * 4;
  float4 v[8];
#pragma unroll
  for (int j = 0; j < 8; ++j) {
    int k = kt * 64 + kg * 8 + j;
    if (n < J.N) v[j] = *reinterpret_cast<const float4*>(src + (long)k * J.N + n);
    else v[j] = make_float4(0.f, 0.f, 0.f, 0.f);
  }
#pragma unroll
  for (int i = 0; i < 4; ++i) {
    float e[8];
#pragma unroll
    for (int j = 0; j < 8; ++j) e[j] = (i == 0) ? v[j].x : (i == 1) ? v[j].y : (i == 2) ? v[j].z : v[j].w;
    uint4 pk;
    pk.x = pack2(e[0], e[1]); pk.y = pack2(e[2], e[3]); pk.z = pack2(e[4], e[5]); pk.w = pack2(e[6], e[7]);
    *reinterpret_cast<uint4*>(smem + (i * 64 + ng) * 144 + kg * 16) = pk;
  }
  __syncthreads();
#pragma unroll
  for (int u = 0; u < 4; ++u) {
    int q = tid + 512 * u;
    int nl = q >> 3, ch = q & 7;
    uint4 pk = *reinterpret_cast<const uint4*>(smem + ((nl & 3) * 64 + (nl >> 2)) * 144 + ch * 16);
    int nn = nt * 256 + nl;
    const int qq = nn >> J.rsh;
    long drow = (long)(qq >> J.sh2) * J.rs + (qq & ((1 << J.sh2) - 1)) * J.off2 + (nn & ((1 << J.rsh) - 1)) + J.off;
    *reinterpret_cast<uint4*>(dst + drow * J.K + kt * 64 + ch * 8) = pk;
  }
  __syncthreads();
}

DEV void conv_tile_f8(const ConvJob& J, int t) {
  const int tid = otid();
  int mat = t / J.tpm, tt = t % J.tpm;
  int kt = tt / J.ntn, nt = tt % J.ntn;
  const float* src = J.src + (long)mat * J.sstride;
  unsigned char* dst = reinterpret_cast<unsigned char*>(J.dst) + (long)mat * J.dstride;
  const int kg = tid >> 5, ng = tid & 31;
  const int n = nt * 128 + ng * 4;
  const float sc = J.fscale;
  float4 v[8];
#pragma unroll
  for (int j = 0; j < 8; ++j) v[j] = *reinterpret_cast<const float4*>(src + (long)(kt * 128 + kg * 8 + j) * J.N + n);
#pragma unroll
  for (int i = 0; i < 4; ++i) {
    float e[8];
#pragma unroll
    for (int j = 0; j < 8; ++j) e[j] = ((i == 0) ? v[j].x : (i == 1) ? v[j].y : (i == 2) ? v[j].z : v[j].w) * sc;
    uint2 pk; pk.x = pack4_f8(e[0], e[1], e[2], e[3]); pk.y = pack4_f8(e[4], e[5], e[6], e[7]);
    *reinterpret_cast<uint2*>(smem + (i * 32 + ng) * 144 + kg * 8) = pk;
  }
  __syncthreads();
#pragma unroll
  for (int u = 0; u < 2; ++u) {
    int q = tid + 512 * u;
    int nl = q >> 3, ch = q & 7;
    uint4 pk = *reinterpret_cast<const uint4*>(smem + ((nl & 3) * 32 + (nl >> 2)) * 144 + ch * 16);
    int nn = nt * 128 + nl;
    const int qq = nn >> J.rsh;
    long drow = (long)(qq >> J.sh2) * J.rs + (qq & ((1 << J.sh2) - 1)) * J.off2 + (nn & ((1 << J.rsh) - 1)) + J.off;
    *reinterpret_cast<uint4*>(dst + drow * J.K + kt * 128 + ch * 16) = pk;
  }
  __syncthreads();
}

DEV void phase_prep(const Params& p) {
  const int tid = otid(), nb = gridDim.x, bid = blockIdx.x;
  {
    float* zb = reinterpret_cast<float*>(smem);
    float* h1b = zb + 512;
    float* h2g = reinterpret_cast<float*>(p.ws + S_H2);
    const int w = tid >> 6, lane = tid & 63;
    for (int l0 = bid * 8; l0 < SEQ; l0 += nb * 8) {
      int l = l0 + w;
      float tt = (float)l / (float)(SEQ - 1);
      float ww = 6.283185307179586f * (float)l / (float)SEQ;
      float z = 0.f;
      if (lane == 0) z = tt;
      else if (lane <= 16) { float f = 1e-4f + (float)(lane - 1) * ((15.0f - 1e-4f) / 15.0f); z = cosf(f * ww); }
      else if (lane <= 32) { float f = 1e-4f + (float)(lane - 17) * ((15.0f - 1e-4f) / 15.0f); z = -sinf(f * ww); }
      zb[w * 64 + lane] = z;
      __syncthreads();
      float fr_ = p.hy_f_freq[lane];
      float a = p.hy_f_b1[lane];
      for (int k = 0; k < 33; ++k) a += zb[w * 64 + k] * p.hy_f_w1[k * 64 + lane];
      h1b[w * 64 + lane] = sinf(fr_ * a);
      __syncthreads();
      float a2 = p.hy_f_b2[lane];
      for (int k = 0; k < 64; ++k) a2 += h1b[w * 64 + k] * p.hy_f_w2[k * 64 + lane];
      h2g[l * 64 + lane] = sinf(fr_ * a2);
      __syncthreads();
    }
  }
  {
    float2* rt = reinterpret_cast<float2*>(p.ws + S_ROPE);
    for (int i = bid * 512 + tid; i < SEQ * 16; i += nb * 512) {
      const int l = i >> 4, k = i & 15;
      float sn, cs; sincosf((float)l * (1.0f / powf(10000.0f, (float)k / 16.0f)), &sn, &cs);
      rt[i] = make_float2(cs, sn);
    }
  }
  {
    u16* xb = reinterpret_cast<u16*>(p.ws + REG_X);
    const long n8 = (long)TOK * DM / 8;
    for (long i = (long)bid * 512 + tid; i < n8; i += (long)nb * 512) {
      float4 a = reinterpret_cast<const float4*>(p.x)[2 * i], b = reinterpret_cast<const float4*>(p.x)[2 * i + 1];
      uint4 pk; pk.x = pack2(a.x, a.y); pk.y = pack2(a.z, a.w); pk.z = pack2(b.x, b.y); pk.w = pack2(b.z, b.w);
      reinterpret_cast<uint4*>(xb)[i] = pk;
    }
    u16* pb = reinterpret_cast<u16*>(p.ws + REG_P);
    const long m8 = 2L * TOK * 256 / 8;
    for (long i = (long)bid * 512 + tid; i < m8; i += (long)nb * 512) {
      float4 a = reinterpret_cast<const float4*>(p.p)[2 * i], b = reinterpret_cast<const float4*>(p.p)[2 * i + 1];
      uint4 pk; pk.x = pack2(a.x, a.y); pk.y = pack2(a.z, a.w); pk.z = pack2(b.x, b.y); pk.w = pack2(b.z, b.w);
      reinterpret_cast<uint4*>(pb)[i] = pk;
    }
  }
  for (int t = bid; t < p.conv_total; t += nb) {
    int j = 0;
#pragma unroll 1
    for (int q = 1; q < NJOBS; ++q) if (t >= p.jobs[q].tile0 && p.jobs[q].ntiles > 0) j = q;
    if (p.jobs[j].f8) conv_tile_f8(p.jobs[j], t - p.jobs[j].tile0); else conv_tile(p.jobs[j], t - p.jobs[j].tile0);
  }
}

DEV void filter_b(const Params& p, int cpair) {
  const int tid = otid();
  float* w3s = reinterpret_cast<float*>(smem);
  float* red = w3s + 512;
  float* nrm = red + 32;
  float* hb = nrm + 4;
  const float* h2g = reinterpret_cast<const float*>(p.ws + S_H2);
  {
    int ci = tid >> 6, k = tid & 63;
    int o = ci >> 2, d = (ci >> 1) & 1, cc = ci & 1;
    w3s[ci * 64 + k] = p.hy_f_w3[k * 2048 + o * 1024 + d * 512 + 2 * cpair + cc];
  }
  __syncthreads();
  const float min_decay = logf(1e-2f) / 1.5f, max_decay = logf(1e-2f) / 0.3f;
#pragma unroll 1
  for (int i = 0; i < 4; ++i) {
    int l = tid + 512 * i;
    float h2[64];
#pragma unroll
    for (int k = 0; k < 16; ++k) {
      float4 v = *reinterpret_cast<const float4*>(h2g + l * 64 + k * 4);
      h2[4 * k] = v.x; h2[4 * k + 1] = v.y; h2[4 * k + 2] = v.z; h2[4 * k + 3] = v.w;
    }
    float tt = (float)l / (float)(SEQ - 1);
#pragma unroll 1
    for (int ci = 0; ci < 8; ++ci) {
      float a = 0.f;
#pragma unroll
      for (int k = 0; k < 64; ++k) a += h2[k] * w3s[ci * 64 + k];
      int cc = ci & 1;
      int c = 2 * cpair + cc;
      float delta = fabsf(min_decay + (float)c * ((max_decay - min_decay) / 511.0f));
      a *= expf(-tt * delta);
      hb[ci * 2048 + l] = a;
    }
  }
  __syncthreads();
  {
    float ss[4];
#pragma unroll
    for (int oc = 0; oc < 4; ++oc) {
      int o = oc >> 1, cc = oc & 1;
      float a = 0.f;
      for (int l = tid; l < 2048; l += 512) {
        float f = hb[(o * 4 + 0 + cc) * 2048 + l];
        float b = (l > 0) ? hb[(o * 4 + 2 + cc) * 2048 + l] : 0.f;
        a += f * f + b * b;
      }
      ss[oc] = wave_sum(a);
    }
    if ((tid & 63) == 0) {
#pragma unroll
      for (int q = 0; q < 4; ++q) red[(tid >> 6) * 4 + q] = ss[q];
    }
  }
  __syncthreads();
  if (tid < 4) {
    float s = 0.f;
    for (int w = 0; w < 8; ++w) s += red[w * 4 + tid];
    nrm[tid] = rsqrtf(s + 1e-12f);
  }
  __syncthreads();
  u16* Rg = reinterpret_cast<u16*>(p.ws + S_RG);
  for (int q = tid; q < 4 * 4096; q += 512) {
    int oc = q >> 12, qq = q & 4095;
    int o = oc >> 1, cc = oc & 1;
    float v;
    if (qq == 0) v = 0.f;
    else if (qq <= 2048) v = hb[(o * 4 + 0 * 2 + cc) * 2048 + (2048 - qq)];
    else v = hb[(o * 4 + 1 * 2 + cc) * 2048 + (qq - 2048)];
    v *= nrm[oc];
    Rg[((long)o * 512 + 2 * cpair + cc) * 4096 + qq] = f2bf(v);
  }
  __syncthreads();
}

DEV void phase_abin(const Params& p) {
  const int nb = gridDim.x;
  for (int c = blockIdx.x; c < 256; c += nb) filter_b(p, c);
  const u16* xb = reinterpret_cast<const u16*>(p.ws + REG_X);
  const u16* wt = reinterpret_cast<const u16*>(p.ws + W_ABIN);
  u16* qk = reinterpret_cast<u16*>(p.ws + REG_B);
  u16* vht = reinterpret_cast<u16*>(p.ws + REG_B + 33554432ull);
  gemm_phase<true, true, false>(1024, 64, 4, [&](const Unit& u, const char*& a, const char*& b) { a = (const char*)(xb) + (size_t)u.pm * 256 * (1024) * 2; b = (const char*)(wt) + (size_t)u.pn * 256 * (1024) * 2; },
      [&](Acc8& acc, const Unit& u, int wr, int wc, int fr, int fq) {
        const float sc = (u.pn < 2) ? 0.125f : 1.0f;
        u16* base = qk + (long)(u.pm * 256 + wr * 64 + fr) * 1024 + u.pn * 256 + wc * 32 + 8 * fq;
        E8_FOR {
          f32x4 v0 = acc[ai][bj][m][0], v1 = acc[ai][bj][m][1];
          uint4 pk;
          pk.x = cvt_pk_bf16(v0[0] * sc, v0[1] * sc); pk.y = cvt_pk_bf16(v0[2] * sc, v0[3] * sc);
          pk.z = cvt_pk_bf16(v1[0] * sc, v1[1] * sc); pk.w = cvt_pk_bf16(v1[2] * sc, v1[3] * sc);
          *reinterpret_cast<uint4*>(base + (ai * 128 + m * 16) * 1024 + bj * 128) = pk;
        }
      });
  gemm_phase<false, false, false>(1024, 64, 8, [&](const Unit& u, const char*& a, const char*& b) { a = (const char*)(xb) + (size_t)u.pm * 256 * (1024) * 2; b = (const char*)(wt + 1024 * 1024) + (size_t)u.pn * 256 * (1024) * 2; },
      [&](Acc8& acc, const Unit& u, int wr, int wc, int fr, int fq) {
        u16* base = vht + (long)(u.pn * 256 + wc * 32 + fr) * TOK + u.pm * 256 + wr * 64 + 4 * fq;
        E8_FOR {
#pragma unroll
          for (int n = 0; n < 2; ++n) {
            f32x4 v = acc[ai][bj][m][n];
            uint2 pk; pk.x = cvt_pk_bf16(v[0], v[1]); pk.y = cvt_pk_bf16(v[2], v[3]);
            *reinterpret_cast<uint2*>(base + (long)(bj * 128 + n * 16) * TOK + ai * 128 + m * 16) = pk;
          }
        }
      });
}

constexpr int NA_VST = 580;
constexpr int NA_V_OFF = 576 * 128;
DEV void na_pair(const Params& p, int u) {
  const int tid = otid(), lane = tid & 63, wid = tid >> 6, fr = lane & 15, fq = lane >> 4;
  const int rp = u & 15, h = (u >> 4) & 7, b = u >> 7;
  const int rbase = min(max(2 * rp - 4, 0), 24);
  const int nrows = (rbase == 24) ? 8 : 9;
  const u16* qk = reinterpret_cast<const u16*>(p.ws + REG_B);
  const u16* vht = reinterpret_cast<const u16*>(p.ws + REG_B + 33554432ull);
  u16* cat = reinterpret_cast<u16*>(p.ws + REG_A + 100663296ull);
  char* kl = smem;
  u16* vl = reinterpret_cast<u16*>(smem + NA_V_OFF);
  const long tok0 = (long)b * SEQ + rbase * 64;
  __syncthreads();
#pragma unroll
  for (int i = 0; i < 9; ++i) {
    const int q = tid + 512 * i, key = q >> 3, ch = q & 7;
    if (key < nrows * 64) {
      uint4 v = *reinterpret_cast<const uint4*>(qk + (tok0 + key) * 1024 + 512 + h * 64 + ch * 8);
      *reinterpret_cast<uint4*>(kl + key * 128 + ((ch ^ ((key >> 1) & 7)) << 4)) = v;
    }
  }
#pragma unroll
  for (int i = 0; i < 9; ++i) {
    const int q = tid + 512 * i, d = q / 72, ch = q % 72;
    if (ch < nrows * 8) {
      uint4 v = *reinterpret_cast<const uint4*>(vht + (long)(h * 64 + d) * TOK + tok0 + ch * 8);
      u16* dst = vl + d * NA_VST + ch * 8;
      *reinterpret_cast<uint2*>(dst) = make_uint2(v.x, v.y);
      *reinterpret_cast<uint2*>(dst + 4) = make_uint2(v.z, v.w);
    }
  }
  __syncthreads();
  const int g = wid & 3, r = 2 * rp + (wid >> 2);
  const int r0 = min(max(r - 4, 0), 24), ro = r0 - rbase, cs = min(max(16 * g - 8, 0), 32);
  const int c = 16 * g + fr;
  const long tokq = (long)b * SEQ + r * 64 + c;
  bf16x8 qf[2];
#pragma unroll
  for (int ks = 0; ks < 2; ++ks) qf[ks] = *reinterpret_cast<const bf16x8*>(qk + tokq * 1024 + h * 64 + ks * 32 + fq * 8);
  f32x4 s[16];
#pragma unroll
  for (int kt = 0; kt < 16; ++kt) {
    const int w = kt >> 1, half = kt & 1;
    const int key = (ro + w) * 64 + cs + 16 * half + fr;
    const int sw = (key >> 1) & 7;
    bf16x8 k0 = *reinterpret_cast<const bf16x8*>(kl + key * 128 + ((fq ^ sw) << 4));
    bf16x8 k1 = *reinterpret_cast<const bf16x8*>(kl + key * 128 + (((4 + fq) ^ sw) << 4));
    f32x4 a = {0.f, 0.f, 0.f, 0.f};
    a = __builtin_amdgcn_mfma_f32_16x16x32_bf16(k0, qf[0], a, 0, 0, 0);
    a = __builtin_amdgcn_mfma_f32_16x16x32_bf16(k1, qf[1], a, 0, 0, 0);
    s[kt] = a;
  }
  const int c0 = min(max(c - 8, 0), 48);
  const float* rpb = p.na_rpb + h * 15 * 31;
  float mx = -1e30f;
#pragma unroll
  for (int kt = 0; kt < 16; ++kt) {
    const int w = kt >> 1, half = kt & 1;
    const int dr = r0 + w - r + 7;
#pragma unroll
    for (int j = 0; j < 4; ++j) {
      int kc = cs + 16 * half + 4 * fq + j;
      bool valid = (kc >= c0) && (kc < c0 + 16);
      int dc = min(max(kc - c, -15), 15) + 15;
      float bias = rpb[dr * 31 + dc];
      float v = valid ? (s[kt][j] + bias) : -1e30f;
      s[kt][j] = v;
      mx = fmaxf(mx, v);
    }
  }
  mx = fmaxf(mx, __shfl_xor(mx, 16));
  mx = fmaxf(mx, __shfl_xor(mx, 32));
  float sum = 0.f;
#pragma unroll
  for (int kt = 0; kt < 16; ++kt)
#pragma unroll
    for (int j = 0; j < 4; ++j) { float e = __expf(s[kt][j] - mx); s[kt][j] = e; sum += e; }
  sum += __shfl_xor(sum, 16);
  sum += __shfl_xor(sum, 32);
  f32x4 o[4];
#pragma unroll
  for (int dt = 0; dt < 4; ++dt) o[dt] = f32x4{0.f, 0.f, 0.f, 0.f};
#pragma unroll
  for (int w = 0; w < 8; ++w) {
    union { bf16x8 v; unsigned u[4]; } pf;
    pf.u[0] = cvt_pk_bf16(s[2 * w][0], s[2 * w][1]); pf.u[1] = cvt_pk_bf16(s[2 * w][2], s[2 * w][3]);
    pf.u[2] = cvt_pk_bf16(s[2 * w + 1][0], s[2 * w + 1][1]); pf.u[3] = cvt_pk_bf16(s[2 * w + 1][2], s[2 * w + 1][3]);
#pragma unroll
    for (int dt = 0; dt < 4; ++dt) {
      const u16* vp = vl + (dt * 16 + fr) * NA_VST + (ro + w) * 64 + cs + 4 * fq;
      union { bf16x8 v; uint2 u[2]; } af;
      af.u[0] = *reinterpret_cast<const uint2*>(vp);
      af.u[1] = *reinterpret_cast<const uint2*>(vp + 16);
      o[dt] = __builtin_amdgcn_mfma_f32_16x16x32_bf16(af.v, pf.v, o[dt], 0, 0, 0);
    }
  }
  const float inv = 1.0f / sum;
#pragma unroll
  for (int dt = 0; dt < 4; ++dt) {
    uint2 pk; pk.x = pack2(o[dt][0] * inv, o[dt][1] * inv); pk.y = pack2(o[dt][2] * inv, o[dt][3] * inv);
    *reinterpret_cast<uint2*>(cat + tokq * 1024 + h * 64 + dt * 16 + 4 * fq) = pk;
  }
}

constexpr int UB_STRIDE = 2056;
constexpr int RC_STRIDE = 4120;
constexpr int HY_RC_OFF = 2 * NBATCH * UB_STRIDE * 2;
DEV float shortconv(const u16* hrow, const float* cw, float cb, int ch, int t) {
  float xm = (t > 0) ? bf2f(hrow[t - 1]) : 0.f;
  float x0 = bf2f(hrow[t]);
  float xp = (t < SEQ - 1) ? bf2f(hrow[t + 1]) : 0.f;
  return cb + xm * cw[ch] + x0 * cw[1536 + ch] + xp * cw[2 * 1536 + ch];
}
DEV void load_rc(const Params& p, int o, int c) {
  const int tid = otid();
  char* rc = smem + HY_RC_OFF;
  const u16* Rg = reinterpret_cast<const u16*>(p.ws + S_RG) + ((long)o * 512 + c) * 4096;
  const float skip = p.hy_skip[o * 512 + c];
  const int i0 = tid * 8;
  uint4 lo = *reinterpret_cast<const uint4*>(Rg + i0);
  uint4 hi = (tid < 511) ? *reinterpret_cast<const uint4*>(Rg + i0 + 8) : make_uint4(0u, 0u, 0u, 0u);
  unsigned w[8] = {lo.x, lo.y, lo.z, lo.w, hi.x, hi.y, hi.z, hi.w};
  if (tid == 256) w[0] = (w[0] & 0xffff0000u) | (unsigned)f2bf(bf2f((u16)(w[0] & 0xffffu)) + skip);
  if (tid == 255) w[4] = (w[4] & 0xffff0000u) | (unsigned)f2bf(bf2f((u16)(w[4] & 0xffffu)) + skip);
#pragma unroll
  for (int m = 0; m < 8; ++m) {
    uint4 o4;
    if (m & 1) {
      o4.x = __builtin_amdgcn_alignbyte(w[m / 2 + 1], w[m / 2], 2);
      o4.y = __builtin_amdgcn_alignbyte(w[m / 2 + 2], w[m / 2 + 1], 2);
      o4.z = __builtin_amdgcn_alignbyte(w[m / 2 + 3], w[m / 2 + 2], 2);
      o4.w = __builtin_amdgcn_alignbyte(w[m / 2 + 4], w[m / 2 + 3], 2);
    } else {
      o4.x = w[m / 2]; o4.y = w[m / 2 + 1]; o4.z = w[m / 2 + 2]; o4.w = w[m / 2 + 3];
    }
    *reinterpret_cast<uint4*>(rc + m * (RC_STRIDE * 2) + i0 * 2) = o4;
  }
}
DEV void hyena_conv(const u16* ub, f32x4 (&acc)[16]) {
  const int lane = otid() & 63, wid = __builtin_amdgcn_readfirstlane(otid() >> 6), fr = lane & 15, fq = lane >> 4;
  const int mcopy = (-wid) & 7;
  const u16* rbase = reinterpret_cast<const u16*>(smem + HY_RC_OFF) + mcopy * RC_STRIDE + (8 * fq - 8 * fr + 2048 - (wid + mcopy));
#pragma unroll
  for (int i = 0; i < 16; ++i) acc[i] = f32x4{0.f, 0.f, 0.f, 0.f};
  const u16* urow = ub + (fr & 7) * UB_STRIDE + fq * 8;
#pragma unroll 1
  for (int kk = 0; kk < 64; ++kk) {
    bf16x8 bfr = *reinterpret_cast<const bf16x8*>(urow + kk * 32);
    const u16* rk = rbase + 32 * kk;
#pragma unroll
    for (int T = 0; T < 16; ++T) {
      bf16x8 af = *reinterpret_cast<const bf16x8*>(rk - 128 * T);
      acc[T] = __builtin_amdgcn_mfma_f32_16x16x32_bf16(af, bfr, acc[T], 0, 0, 0);
    }
  }
}
DEV void shortconv_pass(const u16* __restrict__ hrow  , u16* ub, const float* cw, float cb, int ch) {
  const float w0 = cw[ch], w1 = cw[1536 + ch], w2 = cw[2 * 1536 + ch];
  for (int q = otid(); q < TOK / 8; q += 512) {
    const int i = q * 8, b = i >> 11, t = i & 2047;
    uint4 v = *reinterpret_cast<const uint4*>(hrow + i);
    float x[10];
    x[0] = (t > 0) ? bf2f(hrow[i - 1]) : 0.f;
    x[9] = (t + 8 < SEQ) ? bf2f(hrow[i + 8]) : 0.f;
    x[1] = __uint_as_float(v.x << 16); x[2] = __uint_as_float(v.x & 0xffff0000u);
    x[3] = __uint_as_float(v.y << 16); x[4] = __uint_as_float(v.y & 0xffff0000u);
    x[5] = __uint_as_float(v.z << 16); x[6] = __uint_as_float(v.z & 0xffff0000u);
    x[7] = __uint_as_float(v.w << 16); x[8] = __uint_as_float(v.w & 0xffff0000u);
    float y[8];
#pragma unroll
    for (int j = 0; j < 8; ++j) y[j] = cb + x[j] * w0 + x[j + 1] * w1 + x[j + 2] * w2;
    uint4 o4; o4.x = pack2(y[0], y[1]); o4.y = pack2(y[2], y[3]); o4.z = pack2(y[4], y[5]); o4.w = pack2(y[6], y[7]);
    *reinterpret_cast<uint4*>(ub + b * UB_STRIDE + t) = o4;
  }
}
DEV void hyena_unit(const Params& p, int c) {
  const int tid = otid(), lane = tid & 63, wid = tid >> 6, fr = lane & 15, fq = lane >> 4;
  u16* ubA = reinterpret_cast<u16*>(smem);
  u16* ubB = ubA + NBATCH * UB_STRIDE;
  const u16* hbt = reinterpret_cast<const u16*>(p.ws + REG_B + 33554432ull) + 512L * TOK;
  u16* zT = reinterpret_cast<u16*>(p.ws + REG_C);
  const float* cw = p.hy_conv_w;
  shortconv_pass(hbt + (long)c * TOK, ubA, cw, p.hy_conv_b[c], c);
  shortconv_pass(hbt + (long)(512 + c) * TOK, ubB, cw, p.hy_conv_b[512 + c], 512 + c);
  load_rc(p, 0, c);
  __syncthreads();
  f32x4 acc[16];
  hyena_conv(ubA, acc);
  if (fr < 8) {
#pragma unroll
    for (int T = 0; T < 16; ++T)
#pragma unroll
      for (int j = 0; j < 4; ++j) {
        const int t = 128 * T + wid + 8 * (4 * fq + j);
        u16* q = ubB + fr * UB_STRIDE + t;
        *q = f2bf(bf2f(*q) * acc[T][j]);
      }
  }
  __syncthreads();
  shortconv_pass(hbt + (long)(1024 + c) * TOK, ubA, cw, p.hy_conv_b[1024 + c], 1024 + c);
  load_rc(p, 1, c);
  __syncthreads();
  hyena_conv(ubB, acc);
  if (fr < 8) {
#pragma unroll
    for (int T = 0; T < 16; ++T)
#pragma unroll
      for (int j = 0; j < 4; ++j) {
        const int t = 128 * T + wid + 8 * (4 * fq + j);
        u16* q = ubA + fr * UB_STRIDE + t;
        *q = f2bf(bf2f(*q) * acc[T][j]);
      }
  }
  __syncthreads();
  for (int q = tid; q < TOK / 8; q += 512) {
    const int i = q * 8, b = i >> 11, t = i & 2047;
    *reinterpret_cast<uint4*>(zT + (long)c * TOK + i) = *reinterpret_cast<const uint4*>(ubA + b * UB_STRIDE + t);
  }
  __syncthreads();
}
DEV void phase_ztrans(const Params& p) {
  const int tid = otid();
  const u16* zT = reinterpret_cast<const u16*>(p.ws + REG_C);
  u16* cat = reinterpret_cast<u16*>(p.ws + REG_A + 100663296ull);
  u16* tile = reinterpret_cast<u16*>(smem);
  for (int tb = blockIdx.x; tb < TOK / 64; tb += gridDim.x) {
    __syncthreads();
    const u16* src = zT + (long)tid * TOK + tb * 64;
#pragma unroll
    for (int k = 0; k < 8; ++k) *reinterpret_cast<uint4*>(tile + tid * 72 + k * 8) = *reinterpret_cast<const uint4*>(src + k * 8);
    __syncthreads();
#pragma unroll
    for (int k = 0; k < 8; ++k) {
      const int q = tid + 512 * k;
      const int tk = q >> 6, ch8 = (q & 63) * 8;
      unsigned w[4];
#pragma unroll
      for (int j = 0; j < 4; ++j) w[j] = (unsigned)tile[(ch8 + 2 * j) * 72 + tk] | ((unsigned)tile[(ch8 + 2 * j + 1) * 72 + tk] << 16);
      *reinterpret_cast<uint4*>(cat + (long)(tb * 64 + tk) * 1024 + 512 + ch8) = make_uint4(w[0], w[1], w[2], w[3]);
    }
  }
}
DEV void phase_mix0(const Params& p) {
  const int nb = gridDim.x;
  for (int c = blockIdx.x; c < 512; c += nb) hyena_unit(p, c);
  for (int u = vstart(); u < 1024; u += nb) na_pair(p, u);
}

DEV void phase_outproj(const Params& p, const u16* A, const u16* wt) {
  u16* pre1 = reinterpret_cast<u16*>(p.ws + REG_C);
  const u16* xres = reinterpret_cast<const u16*>(p.ws + REG_X);
  gemm_phase<true, true, false>(1024, 64, 4, [&](const Unit& u, const char*& a, const char*& b) { a = (const char*)(A) + (size_t)u.pm * 256 * (1024) * 2; b = (const char*)(wt) + (size_t)u.pn * 256 * (1024) * 2; },
      [&](Acc8& acc, const Unit& u, int wr, int wc, int fr, int fq) {
        const long o0 = (long)(u.pm * 256 + wr * 64 + fr) * 1024 + u.pn * 256 + wc * 32 + 8 * fq;
        E8_FOR {
          const long o = o0 + (ai * 128 + m * 16) * 1024 + bj * 128;
          const uint4 xr = *reinterpret_cast<const uint4*>(xres + o);
          const float4 x0 = bf4_to_f4(make_uint2(xr.x, xr.y)), x1 = bf4_to_f4(make_uint2(xr.z, xr.w));
          f32x4 v0 = acc[ai][bj][m][0], v1 = acc[ai][bj][m][1];
          uint4 pk;
          pk.x = cvt_pk_bf16(DN_ALPHA * x0.x + v0[0], DN_ALPHA * x0.y + v0[1]); pk.y = cvt_pk_bf16(DN_ALPHA * x0.z + v0[2], DN_ALPHA * x0.w + v0[3]);
          pk.z = cvt_pk_bf16(DN_ALPHA * x1.x + v1[0], DN_ALPHA * x1.y + v1[1]); pk.w = cvt_pk_bf16(DN_ALPHA * x1.z + v1[2], DN_ALPHA * x1.w + v1[3]);
          *reinterpret_cast<uint4*>(pre1 + o) = pk;
        }
      });
}

DEV void phase_ln1_router(const Params& p, int layer) {
  const int tid = otid(), lane = tid & 63, wid = tid >> 6, nb = gridDim.x;
  float* wrT = reinterpret_cast<float*>(smem);
  const float* wr = p.moe_router + (long)layer * 1024 * 16;
  for (int i = tid; i < 16384; i += 512) { int c = i >> 4, e = i & 15; wrT[e * 1024 + c] = wr[i]; }
  __syncthreads();
  const u16* pre1 = reinterpret_cast<const u16*>(p.ws + REG_C);
  u16* x1 = reinterpret_cast<u16*>(p.ws + REG_D);
  unsigned char* x1q = reinterpret_cast<unsigned char*>(p.ws + REG_E);
  float* aff = reinterpret_cast<float*>(p.ws + S_AFF);
  const float* g = p.ln1_g + layer * 1024; const float* bb = p.ln1_b + layer * 1024;
  for (int tok = blockIdx.x * 8 + wid; tok < TOK; tok += nb * 8) {
    float4 v[4];
    float s = 0.f;
#pragma unroll
    for (int i = 0; i < 4; ++i) { v[i] = bf4_to_f4(*reinterpret_cast<const uint2*>(pre1 + (long)tok * 1024 + i * 256 + lane * 4)); s += v[i].x + v[i].y + v[i].z + v[i].w; }
    float mu = wave_sum(s) * (1.0f / 1024.0f);
    float q = 0.f;
#pragma unroll
    for (int i = 0; i < 4; ++i) { v[i].x -= mu; v[i].y -= mu; v[i].z -= mu; v[i].w -= mu; q += v[i].x * v[i].x + v[i].y * v[i].y + v[i].z * v[i].z + v[i].w * v[i].w; }
    float rstd = rsqrtf(wave_sum(q) * (1.0f / 1024.0f) + LN_EPS);
    float4 y[4];
#pragma unroll
    for (int i = 0; i < 4; ++i) {
      int c = i * 256 + lane * 4;
      float4 gg = *reinterpret_cast<const float4*>(g + c), b4 = *reinterpret_cast<const float4*>(bb + c);
      y[i].x = v[i].x * rstd * gg.x + b4.x; y[i].y = v[i].y * rstd * gg.y + b4.y; y[i].z = v[i].z * rstd * gg.z + b4.z; y[i].w = v[i].w * rstd * gg.w + b4.w;
      { uint2 pk; pk.x = pack2(y[i].x, y[i].y); pk.y = pack2(y[i].z, y[i].w); *reinterpret_cast<uint2*>(x1 + (long)tok * 1024 + c) = pk; }
      *reinterpret_cast<unsigned*>(x1q + (long)tok * 1024 + c) = pack4_f8(y[i].x, y[i].y, y[i].z, y[i].w);
    }
    float lg[16];
#pragma unroll
    for (int e = 0; e < 16; ++e) {
      float a = 0.f;
#pragma unroll
      for (int i = 0; i < 4; ++i) {
        float4 w4 = *reinterpret_cast<const float4*>(wrT + e * 1024 + i * 256 + lane * 4);
        a += y[i].x * w4.x + y[i].y * w4.y + y[i].z * w4.z + y[i].w * w4.w;
      }
      lg[e] = a;
      if (e & 1) asm volatile("" ::: "memory");
    }
#pragma unroll
    for (int s_ = 0; s_ < 4; ++s_) {
      const int bit = 1 << s_;
      const bool up = (lane & bit) != 0;
#pragma unroll
      for (int i = 0; i < (8 >> s_); ++i) {
        float lo = lg[2 * i], hi = lg[2 * i + 1];
        float snd = up ? lo : hi;
        float rcv = __shfl_xor(snd, bit);
        lg[i] = (up ? hi : lo) + rcv;
      }
    }
    float mine = lg[0];
    mine += __shfl_xor(mine, 16);
    mine += __shfl_xor(mine, 32);
    float mx = mine;
#pragma unroll
    for (int o = 8; o > 0; o >>= 1) mx = fmaxf(mx, __shfl_xor(mx, o));
    float ex = expf(mine - mx);
    float den = ex;
#pragma unroll
    for (int o = 8; o > 0; o >>= 1) den += __shfl_xor(den, o);
    if (lane < 16) {
      int b = tok >> 11, l = tok & 2047;
      aff[((long)b * 16 + lane) * SEQ + l] = ex / den;
    }
  }
}

DEV void phase_topk(const Params& p) {
  const int tid = otid(), nb = gridDim.x, lane = tid & 63, wid = tid >> 6;
  unsigned* key = reinterpret_cast<unsigned*>(smem);
  int* rows = reinterpret_cast<int*>(smem + 8192);
  unsigned* hist = reinterpret_cast<unsigned*>(smem + 9216);
  unsigned* wsum = reinterpret_cast<unsigned*>(smem + 10240);
  unsigned* bc = reinterpret_cast<unsigned*>(smem + 10304);
  const float* aff = reinterpret_cast<const float*>(p.ws + S_AFF);
  float* gsel = reinterpret_cast<float*>(p.ws + S_GSEL);
  int* slot = reinterpret_cast<int*>(p.ws + S_SLOT);
  const unsigned char* x1q = reinterpret_cast<const unsigned char*>(p.ws + REG_E);
  unsigned char* Xe = reinterpret_cast<unsigned char*>(p.ws + REG_C);
  for (int be = blockIdx.x; be < NBATCH * NEXP; be += nb) {
    const int b = be >> 4, e = be & 15;
    __syncthreads();
    const float4 av = *reinterpret_cast<const float4*>(aff + (long)be * SEQ + tid * 4);
    const unsigned k0 = __float_as_uint(av.x), k1 = __float_as_uint(av.y), k2 = __float_as_uint(av.z), k3 = __float_as_uint(av.w);
    unsigned prefix = 0u, need = CAP;
#pragma unroll 1
    for (int shift = 24; shift >= 0; shift -= 8) {
      if (tid < 256) hist[tid] = 0u;
      __syncthreads();
      const unsigned hs = (shift == 24) ? 0u : (unsigned)(shift + 8);
      if (shift == 24 || (k0 >> hs) == prefix) atomicAdd(&hist[(k0 >> shift) & 255u], 1u);
      if (shift == 24 || (k1 >> hs) == prefix) atomicAdd(&hist[(k1 >> shift) & 255u], 1u);
      if (shift == 24 || (k2 >> hs) == prefix) atomicAdd(&hist[(k2 >> shift) & 255u], 1u);
      if (shift == 24 || (k3 >> hs) == prefix) atomicAdd(&hist[(k3 >> shift) & 255u], 1u);
      __syncthreads();
      if (wid == 0) {
        unsigned h0 = hist[4 * lane], h1 = hist[4 * lane + 1], h2 = hist[4 * lane + 2], h3 = hist[4 * lane + 3];
        unsigned tot = h0 + h1 + h2 + h3;
        unsigned suf = tot;
#pragma unroll
        for (int o = 1; o < 64; o <<= 1) { unsigned t = __shfl_down(suf, o); if (lane + o < 64) suf += t; }
        const unsigned above = suf - tot;
        int d = -1; unsigned nabove = 0u;
        unsigned c3 = above + h3, c2 = c3 + h2, c1 = c2 + h1, c0 = c1 + h0;
        if (above < need && c0 >= need) {
          if (c3 >= need) { d = 4 * lane + 3; nabove = above; }
          else if (c2 >= need) { d = 4 * lane + 2; nabove = c3; }
          else if (c1 >= need) { d = 4 * lane + 1; nabove = c2; }
          else { d = 4 * lane; nabove = c1; }
          bc[0] = (prefix << 8) | (unsigned)d;
          bc[1] = need - nabove;
        }
      }
      __syncthreads();
      prefix = bc[0]; need = bc[1];
    }
    const unsigned tau = prefix;
    const unsigned e0 = (k0 == tau), e1 = (k1 == tau), e2 = (k2 == tau), e3 = (k3 == tau);
    unsigned eqs = e0 + e1 + e2 + e3;
    unsigned inc = eqs;
#pragma unroll
    for (int o = 1; o < 64; o <<= 1) { unsigned t = __shfl_up(inc, o); if (lane >= o) inc += t; }
    if (lane == 63) wsum[wid] = inc;
    __syncthreads();
    unsigned base = 0u;
#pragma unroll
    for (int w = 0; w < 8; ++w) if (w < wid) base += wsum[w];
    unsigned eqb = base + inc - eqs;
    const unsigned s0 = (k0 > tau) || (e0 && eqb < need); eqb += e0;
    const unsigned s1 = (k1 > tau) || (e1 && eqb < need); eqb += e1;
    const unsigned s2 = (k2 > tau) || (e2 && eqb < need); eqb += e2;
    const unsigned s3 = (k3 > tau) || (e3 && eqb < need);
    const unsigned sels = s0 + s1 + s2 + s3;
    unsigned inc2 = sels;
#pragma unroll
    for (int o = 1; o < 64; o <<= 1) { unsigned t = __shfl_up(inc2, o); if (lane >= o) inc2 += t; }
    if (lane == 63) wsum[8 + wid] = inc2;
    __syncthreads();
    unsigned base2 = 0u;
#pragma unroll
    for (int w = 0; w < 8; ++w) if (w < wid) base2 += wsum[8 + w];
    unsigned sl = base2 + inc2 - sels;
    const int tok0 = tid * 4;
    int sv[4];
    sv[0] = s0 ? (int)sl : -1; sl += s0;
    sv[1] = s1 ? (int)sl : -1; sl += s1;
    sv[2] = s2 ? (int)sl : -1; sl += s2;
    sv[3] = s3 ? (int)sl : -1;
    const float avv[4] = {av.x, av.y, av.z, av.w};
#pragma unroll
    for (int j = 0; j < 4; ++j) {
      slot[((long)b * SEQ + tok0 + j) * 16 + e] = sv[j];
      if (sv[j] >= 0) { rows[sv[j]] = tok0 + j; gsel[be * CAP + sv[j]] = avv[j]; }
    }
    __syncthreads();
    for (int s = wid; s < CAP; s += 8) {
      const int t = rows[s];
      const uint4* src = reinterpret_cast<const uint4*>(x1q + ((long)b * SEQ + t) * 1024);
      uint4* dst = reinterpret_cast<uint4*>(Xe + ((long)(e * 8 + b) * CAP + s) * 1024);
      dst[lane] = src[lane];
    }
  }
}

DEV void phase_moe1(const Params& p, int layer) {
  const unsigned char* Xe = reinterpret_cast<const unsigned char*>(p.ws + REG_C);
  const unsigned char* wgu = reinterpret_cast<const unsigned char*>(p.ws + W_GU) + (long)layer * 16 * 4096 * 1024;
  unsigned char* H = reinterpret_cast<unsigned char*>(p.ws + REG_A);
  gemm_phase<true, true, true>(1024, 128, 16,
      [&](const Unit& u, const char*& a, const char*& b) { a = (const char*)Xe + (size_t)u.pm * 256 * 1024; b = (const char*)wgu + ((size_t)(u.pm >> 3) * 4096 + (size_t)u.pn * 256) * 1024; },
      [&](Acc8& acc, const Unit& u, int wr, int wc, int fr, int fq) {
        unsigned char* base = H + (long)(u.pm * 256 + wr * 64 + fr) * DFF + u.pn * 128 + wc * 32 + 8 * fq;
#pragma unroll
        for (int ai = 0; ai < 2; ++ai)
#pragma unroll
          for (int m = 0; m < 4; ++m) {
            float hv[8];
#pragma unroll
            for (int n = 0; n < 2; ++n)
#pragma unroll
              for (int j = 0; j < 4; ++j) {
                float gte = acc[ai][0][m][n][j] * 0.03125f, up = acc[ai][1][m][n][j] * 0.03125f;
                hv[n * 4 + j] = gte * fsigmoid(gte) * up;
              }
            uint2 pk; pk.x = pack4_f8(hv[0], hv[1], hv[2], hv[3]); pk.y = pack4_f8(hv[4], hv[5], hv[6], hv[7]);
            *reinterpret_cast<uint2*>(base + (ai * 128 + m * 16) * DFF) = pk;
          }
      });
}
DEV void phase_moe2(const Params& p, int layer) {
  const unsigned char* H = reinterpret_cast<const unsigned char*>(p.ws + REG_A);
  const unsigned char* wd = reinterpret_cast<const unsigned char*>(p.ws + W_DN) + (long)layer * 16 * 1024 * 2048;
  const float* gsel = reinterpret_cast<const float*>(p.ws + S_GSEL);
  u16* Ye = reinterpret_cast<u16*>(p.ws + REG_B);
  gemm_phase<true, true, true>(2048, 128, 4,
      [&](const Unit& u, const char*& a, const char*& b) { a = (const char*)H + (size_t)u.pm * 256 * 2048; b = (const char*)wd + ((size_t)(u.pm >> 3) * 1024 + (size_t)u.pn * 256) * 2048; },
      [&](Acc8& acc, const Unit& u, int wr, int wc, int fr, int fq) {
        const int e = u.pm >> 3, b = u.pm & 7;
        const float* gs = gsel + (b * 16 + e) * CAP + wr * 64 + fr;
        u16* base = Ye + (long)(u.pm * 256 + wr * 64 + fr) * 1024 + u.pn * 256 + wc * 32 + 8 * fq;
#pragma unroll
        for (int ai = 0; ai < 2; ++ai)
#pragma unroll
          for (int m = 0; m < 4; ++m) {
            const float g = gs[ai * 128 + m * 16] * 0.015625f;
#pragma unroll
            for (int bj = 0; bj < 2; ++bj) {
              f32x4 v0 = acc[ai][bj][m][0] * g, v1 = acc[ai][bj][m][1] * g;
              uint4 pk;
              pk.x = cvt_pk_bf16(v0[0], v0[1]); pk.y = cvt_pk_bf16(v0[2], v0[3]); pk.z = cvt_pk_bf16(v1[0], v1[1]); pk.w = cvt_pk_bf16(v1[2], v1[3]);
              *reinterpret_cast<uint4*>(base + (ai * 128 + m * 16) * 1024 + bj * 128) = pk;
            }
          }
      });
}
DEV void phase_ln2(const Params& p, int layer) {
  const int tid = otid(), lane = tid & 63, wid = tid >> 6, nb = gridDim.x;
  const u16* x1 = reinterpret_cast<const u16*>(p.ws + REG_D);
  const u16* Ye = reinterpret_cast<const u16*>(p.ws + REG_B);
  const int* slot = reinterpret_cast<const int*>(p.ws + S_SLOT);
  u16* x2b = reinterpret_cast<u16*>(p.ws + REG_A + 67108864ull);
  const float* g = p.ln2_g + layer * 1024; const float* bb = p.ln2_b + layer * 1024;
  for (int tok = blockIdx.x * 8 + wid; tok < TOK; tok += nb * 8) {
    const int b = tok >> 11;
    float4 v[4];
#pragma unroll
    for (int i = 0; i < 4; ++i) {
      float4 t = bf4_to_f4(*reinterpret_cast<const uint2*>(x1 + (long)tok * 1024 + i * 256 + lane * 4));
      v[i].x = DN_ALPHA * t.x; v[i].y = DN_ALPHA * t.y; v[i].z = DN_ALPHA * t.z; v[i].w = DN_ALPHA * t.w;
    }
    int myslot = (lane < 16) ? slot[(long)tok * 16 + lane] : -1;
    unsigned mask = (unsigned)__ballot(myslot >= 0);
    while (mask) {
      const int e = __builtin_ctz(mask);
      mask &= mask - 1;
      const int sidx = __builtin_amdgcn_readlane(myslot, e);
      const u16* yr = Ye + ((long)(e * 8 + b) * CAP + sidx) * 1024;
      uint2 t[4];
#pragma unroll
      for (int i = 0; i < 4; ++i) t[i] = *reinterpret_cast<const uint2*>(yr + i * 256 + lane * 4);
#pragma unroll
      for (int i = 0; i < 4; ++i) {
        v[i].x += __uint_as_float(t[i].x << 16); v[i].y += __uint_as_float(t[i].x & 0xffff0000u);
        v[i].z += __uint_as_float(t[i].y << 16); v[i].w += __uint_as_float(t[i].y & 0xffff0000u);
      }
    }
    float s = 0.f;
#pragma unroll
    for (int i = 0; i < 4; ++i) s += v[i].x + v[i].y + v[i].z + v[i].w;
    float mu = wave_sum(s) * (1.0f / 1024.0f);
    float q = 0.f;
#pragma unroll
    for (int i = 0; i < 4; ++i) { v[i].x -= mu; v[i].y -= mu; v[i].z -= mu; v[i].w -= mu; q += v[i].x * v[i].x + v[i].y * v[i].y + v[i].z * v[i].z + v[i].w * v[i].w; }
    float rstd = rsqrtf(wave_sum(q) * (1.0f / 1024.0f) + LN_EPS);
#pragma unroll
    for (int i = 0; i < 4; ++i) {
      int c = i * 256 + lane * 4;
      float4 gg = *reinterpret_cast<const float4*>(g + c), b4 = *reinterpret_cast<const float4*>(bb + c);
      float4 y;
      y.x = v[i].x * rstd * gg.x + b4.x; y.y = v[i].y * rstd * gg.y + b4.y; y.z = v[i].z * rstd * gg.z + b4.z; y.w = v[i].w * rstd * gg.w + b4.w;
      uint2 pk; pk.x = pack2(y.x, y.y); pk.y = pack2(y.z, y.w);
      *reinterpret_cast<uint2*>(x2b + (long)tok * 1024 + c) = pk;
    }
  }
}
DEV void phase_ple(const Params& p, int layer, float* outf, u16* outb) {
  const u16* x2b = reinterpret_cast<const u16*>(p.ws + REG_A + 67108864ull);
  const u16* pb = reinterpret_cast<const u16*>(p.ws + REG_P) + (long)layer * TOK * 256;
  const u16* wg = reinterpret_cast<const u16*>(p.ws + W_PLEG) + (long)layer * 1024 * 1024;
  const u16* wp = reinterpret_cast<const u16*>(p.ws + W_PLEP) + (long)layer * 1024 * 256;
  u16* pp = reinterpret_cast<u16*>(p.ws + REG_C);
  gemm_phase<true, false, false>(256, 64, 4, [&](const Unit& u, const char*& a, const char*& b) { a = (const char*)(pb) + (size_t)u.pm * 256 * (256) * 2; b = (const char*)(wp) + (size_t)u.pn * 256 * (256) * 2; },
      [&](Acc8& acc, const Unit& u, int wr, int wc, int fr, int fq) {
        const long o0 = (long)(u.pm * 256 + wr * 64 + fr) * 1024 + u.pn * 256 + wc * 32 + 4 * fq;
        E8_FOR {
#pragma unroll
          for (int n = 0; n < 2; ++n)
          {
            f32x4 v = acc[ai][bj][m][n];
            uint2 pk; pk.x = cvt_pk_bf16(v[0], v[1]); pk.y = cvt_pk_bf16(v[2], v[3]);
            *reinterpret_cast<uint2*>(pp + o0 + (ai * 128 + m * 16) * 1024 + bj * 128 + n * 16) = pk;
          }
        }
      });
  gemm_phase<true, false, false>(1024, 64, 4, [&](const Unit& u, const char*& a, const char*& b) { a = (const char*)(x2b) + (size_t)u.pm * 256 * (1024) * 2; b = (const char*)(wg) + (size_t)u.pn * 256 * (1024) * 2; },
      [&](Acc8& acc, const Unit& u, int wr, int wc, int fr, int fq) {
        const long o0 = (long)(u.pm * 256 + wr * 64 + fr) * 1024 + u.pn * 256 + wc * 32 + 4 * fq;
        E8_FOR {
#pragma unroll
          for (int n = 0; n < 2; ++n) {
            const long o = o0 + (ai * 128 + m * 16) * 1024 + bj * 128 + n * 16;
            f32x4 a = acc[ai][bj][m][n];
            const float4 xq = bf4_to_f4(*reinterpret_cast<const uint2*>(x2b + o));
            f32x4 xv = {xq.x, xq.y, xq.z, xq.w};
            const uint2 pq = *reinterpret_cast<const uint2*>(pp + o);
            f32x4 pv = {__uint_as_float(pq.x << 16), __uint_as_float(pq.x & 0xffff0000u), __uint_as_float(pq.y << 16), __uint_as_float(pq.y & 0xffff0000u)};
            f32x4 r;
#pragma unroll
            for (int j = 0; j < 4; ++j) r[j] = xv[j] + pv[j] * fsigmoid(a[j]);
            if (outf) *reinterpret_cast<f32x4*>(outf + o) = r;
            if (outb) { uint2 pk; pk.x = cvt_pk_bf16(r[0], r[1]); pk.y = cvt_pk_bf16(r[2], r[3]); *reinterpret_cast<uint2*>(outb + o) = pk; }
          }
        }
      });
}
DEV void phase_mla_in(const Params& p) {
  const u16* xb = reinterpret_cast<const u16*>(p.ws + REG_X);
  const u16* wt = reinterpret_cast<const u16*>(p.ws + W_MLAIN);
  float* hm = reinterpret_cast<float*>(p.ws + REG_B);
  gemm_phase<true, false, false>(1024, 64, 3, [&](const Unit& u, const char*& a, const char*& b) { a = (const char*)(xb) + (size_t)u.pm * 256 * (1024) * 2; b = (const char*)(wt) + (size_t)u.pn * 256 * (1024) * 2; },
      [&](Acc8& acc, const Unit& u, int wr, int wc, int fr, int fq) {
        const long o0 = (long)(u.pm * 256 + wr * 64 + fr) * 768 + u.pn * 256 + wc * 32 + 4 * fq;
        E8_FOR {
#pragma unroll
          for (int n = 0; n < 2; ++n)
            *reinterpret_cast<f32x4*>(hm + o0 + (ai * 128 + m * 16) * 768 + bj * 128 + n * 16) = acc[ai][bj][m][n];
        }
      });
}
constexpr size_t MLA_Q = REG_A, MLA_K = REG_A + 50331648ull, MLA_VT = REG_A + 100663296ull;
constexpr size_t MLA_CQN = REG_B + 50331648ull, MLA_CKVN = MLA_CQN + 12582912ull, MLA_O = MLA_CKVN + 8388608ull;
DEV float rope_inv(int i) { return 1.0f / powf(10000.0f, (float)i / 16.0f); }
DEV void phase_mla_norm(const Params& p) {
  const int tid = otid(), lane = tid & 63, wid = tid >> 6, nb = gridDim.x;
  const float* hm = reinterpret_cast<const float*>(p.ws + REG_B);
  u16* cqn = reinterpret_cast<u16*>(p.ws + MLA_CQN);
  u16* ckvn = reinterpret_cast<u16*>(p.ws + MLA_CKVN);
  u16* Kb = reinterpret_cast<u16*>(p.ws + MLA_K);
  for (int tok = blockIdx.x * 8 + wid; tok < TOK; tok += nb * 8) {
    const float* row = hm + (long)tok * 768;
    float q[6], kv[4];
    float sq = 0.f, skv = 0.f;
#pragma unroll
    for (int i = 0; i < 6; ++i) { q[i] = row[i * 64 + lane]; sq += q[i] * q[i]; }
#pragma unroll
    for (int i = 0; i < 4; ++i) { kv[i] = row[384 + i * 64 + lane]; skv += kv[i] * kv[i]; }
    float rq = rsqrtf(wave_sum(sq) * (1.0f / 384.0f) + LN_EPS);
    float rkv = rsqrtf(wave_sum(skv) * (1.0f / 256.0f) + LN_EPS);
#pragma unroll
    for (int i = 0; i < 6; ++i) cqn[(long)tok * 384 + i * 64 + lane] = f2bf(q[i] * rq * p.mla_q_norm[i * 64 + lane]);
#pragma unroll
    for (int i = 0; i < 4; ++i) ckvn[(long)tok * 256 + i * 64 + lane] = f2bf(kv[i] * rkv * p.mla_kv_norm[i * 64 + lane]);
    const int b = tok >> 11, l = tok & 2047;
    float kr = (lane < 32) ? row[640 + lane] : 0.f;
    float x1 = __shfl(kr, lane & 15), x2 = __shfl(kr, (lane & 15) + 16);
    const float2 cssn = reinterpret_cast<const float2*>(p.ws + S_ROPE)[l * 16 + (lane & 15)];
    const float cs = cssn.x, sn = cssn.y;
    float r = (lane & 16) ? (x1 * sn + x2 * cs) : (x1 * cs - x2 * sn);
    u16 rb = f2bf(r);
    for (int hh = 0; hh < 16; hh += 2) {
      int h = hh + (lane >> 5);
      u16 val = (u16)__shfl((int)rb, lane & 31);
      Kb[(((long)b * 16 + h) * SEQ + l) * 96 + 64 + (lane & 31)] = val;
    }
  }
}
DEV void phase_mla_up(const Params& p) {
  const u16* cqn = reinterpret_cast<const u16*>(p.ws + MLA_CQN);
  const u16* ckvn = reinterpret_cast<const u16*>(p.ws + MLA_CKVN);
  const u16* wq = reinterpret_cast<const u16*>(p.ws + W_QUP);
  const u16* wkv = reinterpret_cast<const u16*>(p.ws + W_KVUP);
  u16* Qb = reinterpret_cast<u16*>(p.ws + MLA_Q);
  u16* Kb = reinterpret_cast<u16*>(p.ws + MLA_K);
  u16* VT = reinterpret_cast<u16*>(p.ws + MLA_VT);
  const float qscale = 0.10206207261596577f * 1.4426950408889634f;
  gemm_phase<true, false, false>(384, 64, 6, [&](const Unit& u, const char*& a, const char*& b) { a = (const char*)(cqn) + (size_t)u.pm * 256 * (384) * 2; b = (const char*)(wq) + (size_t)u.pn * 256 * (384) * 2; },
      [&](Acc8& acc, const Unit& u, int wr, int wc, int fr, int fq) {
#pragma unroll
        for (int bj = 0; bj < 2; ++bj) {
          const int c32 = (u.pn * 256 + bj * 128 + wc * 32) >> 5;
          const int h = c32 / 3, part = c32 % 3;
#pragma unroll
          for (int ai = 0; ai < 2; ++ai)
#pragma unroll
            for (int m = 0; m < 4; ++m) {
              const int tok = u.pm * 256 + ai * 128 + wr * 64 + m * 16 + fr;
              const int b = tok >> 11, l = tok & 2047;
              u16* qrow = Qb + (((long)b * 16 + h) * SEQ + l) * 96 + part * 32 + 4 * fq;
              f32x4 a0 = acc[ai][bj][m][0], a1 = acc[ai][bj][m][1];
              if (part == 2) {
#pragma unroll
                for (int j = 0; j < 4; ++j) {
                  const float2 cssn = reinterpret_cast<const float2*>(p.ws + S_ROPE)[l * 16 + 4 * fq + j];
                  const float cs = cssn.x, sn = cssn.y;
                  float r0 = a0[j] * cs - a1[j] * sn, r1 = a0[j] * sn + a1[j] * cs;
                  a0[j] = r0; a1[j] = r1;
                }
              }
              uint2 p0, p1;
              p0.x = cvt_pk_bf16(a0[0] * qscale, a0[1] * qscale); p0.y = cvt_pk_bf16(a0[2] * qscale, a0[3] * qscale);
              p1.x = cvt_pk_bf16(a1[0] * qscale, a1[1] * qscale); p1.y = cvt_pk_bf16(a1[2] * qscale, a1[3] * qscale);
              *reinterpret_cast<uint2*>(qrow) = p0;
              *reinterpret_cast<uint2*>(qrow + 16) = p1;
            }
        }
      });
  gemm_phase<true, true, false>(256, 64, 4, [&](const Unit& u, const char*& a, const char*& b) { a = (const char*)(ckvn) + (size_t)u.pm * 256 * (256) * 2; b = (const char*)(wkv) + (size_t)u.pn * 256 * (256) * 2; },
      [&](Acc8& acc, const Unit& u, int wr, int wc, int fr, int fq) {
        E8_FOR {
          const int tok = u.pm * 256 + ai * 128 + wr * 64 + m * 16 + fr;
          const int b = tok >> 11, l = tok & 2047;
          const int col = u.pn * 256 + bj * 128 + wc * 32 + 8 * fq;
          const int h = col >> 6, d = col & 63;
          f32x4 v0 = acc[ai][bj][m][0], v1 = acc[ai][bj][m][1];
          uint4 pk;
          pk.x = cvt_pk_bf16(v0[0], v0[1]); pk.y = cvt_pk_bf16(v0[2], v0[3]); pk.z = cvt_pk_bf16(v1[0], v1[1]); pk.w = cvt_pk_bf16(v1[2], v1[3]);
          *reinterpret_cast<uint4*>(Kb + (((long)b * 16 + h) * SEQ + l) * 96 + d) = pk;
        }
      });
  gemm_phase<false, false, false>(256, 64, 4, [&](const Unit& u, const char*& a, const char*& b) { a = (const char*)(ckvn) + (size_t)u.pm * 256 * (256) * 2; b = (const char*)(wkv + 1024 * 256) + (size_t)u.pn * 256 * (256) * 2; },
      [&](Acc8& acc, const Unit& u, int wr, int wc, int fr, int fq) {
        E8_FOR {
          const int tok = u.pm * 256 + ai * 128 + wr * 64 + m * 16 + 4 * fq;
          const int b = tok >> 11, l = tok & 2047;
#pragma unroll
          for (int n = 0; n < 2; ++n) {
            const int col = u.pn * 256 + bj * 128 + wc * 32 + n * 16 + fr;
            const int h = col >> 6, d = col & 63;
            f32x4 v = acc[ai][bj][m][n];
            uint2 pk; pk.x = cvt_pk_bf16(v[0], v[1]); pk.y = cvt_pk_bf16(v[2], v[3]);
            *reinterpret_cast<uint2*>(VT + (((long)b * 16 + h) * 64 + d) * SEQ + l) = pk;
          }
        }
      });
}
#ifndef ATT_THR
#define ATT_THR 8.0f
#endif
DEV int kswz(int key) { return (((key >> 3) & 3) << 2) | (key & 3); }
DEV void mla_attn_unit(const Params& p, int u) {
  const int tid = otid(), lane = tid & 63, wid = tid >> 6, fr = lane & 15, fq = lane >> 4;
  const int qb = u & 7, bh = u >> 3;
  const u16* Qb = reinterpret_cast<const u16*>(p.ws + MLA_Q) + (long)bh * SEQ * 96;
  const u16* Kb = reinterpret_cast<const u16*>(p.ws + MLA_K) + (long)bh * SEQ * 96;
  const u16* VT = reinterpret_cast<const u16*>(p.ws + MLA_VT) + (long)bh * 64 * SEQ;
  u16* O = reinterpret_cast<u16*>(p.ws + MLA_O);
  char* kl = smem;
  char* vl = smem + 32768;
  bf16x8 qf[2][3];
#pragma unroll
  for (int qt = 0; qt < 2; ++qt)
#pragma unroll
    for (int ks = 0; ks < 3; ++ks)
      qf[qt][ks] = *reinterpret_cast<const bf16x8*>(Qb + (long)(qb * 256 + wid * 32 + qt * 16 + fr) * 96 + ks * 32 + fq * 8);
  f32x4 o[4][2];
#pragma unroll
  for (int dt = 0; dt < 4; ++dt)
#pragma unroll
    for (int qt = 0; qt < 2; ++qt) o[dt][qt] = f32x4{0.f, 0.f, 0.f, 0.f};
  float mrun[2], lrun[2] = {0.f, 0.f}, rcur[2], rnxt[2] = {0.f, 0.f};
  const int kc0 = tid, kc1 = 512 + tid;
  const int vd = tid >> 3, vpart = tid & 7;
  const int kw0 = (kc0 / 12) * 256 + (((kc0 % 12) ^ kswz(kc0 / 12)) << 4);
  const int kw1 = (kc1 / 12) * 256 + (((kc1 % 12) ^ kswz(kc1 / 12)) << 4);
  const int vw = vd * 128 + ((vpart ^ ((vd >> 1) & 7)) << 4);
  struct Stg { uint4 k0, k1, v; };
  Stg sa, sb;
  sa.k1 = make_uint4(0, 0, 0, 0); sb.k1 = make_uint4(0, 0, 0, 0);
  auto gloadK = [&](Stg& r, int t) {
    const u16* kt = Kb + (long)t * 64 * 96;
    r.k0 = *reinterpret_cast<const uint4*>(kt + kc0 * 8);
    if (tid < 256) r.k1 = *reinterpret_cast<const uint4*>(kt + kc1 * 8);
  };
  auto gloadV = [&](Stg& r, int t) { r.v = *reinterpret_cast<const uint4*>(VT + (long)vd * SEQ + t * 64 + vpart * 8); };
  auto lstoreK = [&](const Stg& r, int buf) {
    *reinterpret_cast<uint4*>(kl + buf * 16384 + kw0) = r.k0;
    if (tid < 256) *reinterpret_cast<uint4*>(kl + buf * 16384 + kw1) = r.k1;
  };
  auto lstoreV = [&](const Stg& r, int buf) { *reinterpret_cast<uint4*>(vl + buf * 8192 + vw) = r.v; };
  const int krow = 8 * (fr >> 2) + (fr & 3);
  const int kf_ = kswz(krow);
  auto qk_tile = [&](const char* kd, f32x4 (&s)[4][2], const float (&ref)[2]) {
#pragma unroll
    for (int kt = 0; kt < 4; ++kt) {
      const int key = 32 * (kt >> 1) + 4 * (kt & 1) + krow;
      bf16x8 kf[3];
#pragma unroll
      for (int ks = 0; ks < 3; ++ks) kf[ks] = *reinterpret_cast<const bf16x8*>(kd + key * 256 + (((ks * 4 + fq) ^ kf_) << 4));
#pragma unroll
      for (int qt = 0; qt < 2; ++qt) {
        f32x4 a = {-ref[qt], -ref[qt], -ref[qt], -ref[qt]};
#pragma unroll
        for (int ks = 0; ks < 3; ++ks) a = __builtin_amdgcn_mfma_f32_16x16x32_bf16(kf[ks], qf[qt][ks], a, 0, 0, 0);
        s[kt][qt] = a;
      }
    }
  };
  __syncthreads();
  gloadK(sa, 0); gloadV(sa, 0); lstoreK(sa, 0); lstoreV(sa, 0);
  gloadK(sa, 1); lstoreK(sa, 1);
  gloadK(sa, 2); gloadV(sa, 1);
  __syncthreads();
  f32x4 sc[4][2], sn[4][2];
  {
    const float zero2[2] = {0.f, 0.f};
    qk_tile(kl, sc, zero2);
#pragma unroll
    for (int qt = 0; qt < 2; ++qt) {
      float tm = -1e30f;
#pragma unroll
      for (int kt = 0; kt < 4; ++kt)
#pragma unroll
        for (int j = 0; j < 4; ++j) tm = fmaxf(tm, sc[kt][qt][j]);
      tm = fmaxf(tm, __shfl_xor(tm, 16));
      tm = fmaxf(tm, __shfl_xor(tm, 32));
      mrun[qt] = tm; rcur[qt] = tm;
#pragma unroll
      for (int kt = 0; kt < 4; ++kt)
#pragma unroll
        for (int j = 0; j < 4; ++j) sc[kt][qt][j] -= tm;
    }
  }
  __syncthreads();
#pragma unroll 1
  for (int t2 = 0; t2 < 32; t2 += 2) {
    { const int t = t2, cur = 0;

    if (t + 3 < 32) gloadK(sb, t + 3);
    if (t + 2 < 32) gloadV(sb, t + 2);
    if (t + 1 < 32) { rnxt[0] = mrun[0]; rnxt[1] = mrun[1]; qk_tile(kl + (cur ^ 1) * 16384, sn, rnxt); }
    bf16x8 pf[2][2];
#pragma unroll
    for (int qt = 0; qt < 2; ++qt) {
      float lm = sc[0][qt][0];
#pragma unroll
      for (int kt = 0; kt < 4; ++kt)
#pragma unroll
        for (int j = 0; j < 4; ++j) lm = fmaxf(lm, sc[kt][qt][j]);
      const bool slow = (lm > ATT_THR) || (rcur[qt] != mrun[qt]);
      if (__any(slow)) {
        const float dl = rcur[qt] - mrun[qt];
        float tm = lm + dl;
        tm = fmaxf(tm, __shfl_xor(tm, 16));
        tm = fmaxf(tm, __shfl_xor(tm, 32));
        const float inc = fmaxf(tm, 0.f);
        const float alpha = __builtin_amdgcn_exp2f(-inc);
        mrun[qt] += inc;
        lrun[qt] *= alpha;
#pragma unroll
        for (int dt = 0; dt < 4; ++dt) { o[dt][qt][0] *= alpha; o[dt][qt][1] *= alpha; o[dt][qt][2] *= alpha; o[dt][qt][3] *= alpha; }
        const float sh = dl - inc;
#pragma unroll
        for (int kt = 0; kt < 4; ++kt)
#pragma unroll
          for (int j = 0; j < 4; ++j) sc[kt][qt][j] += sh;
      }
      float ls = 0.f;
#pragma unroll
      for (int kt = 0; kt < 4; ++kt)
#pragma unroll
        for (int j = 0; j < 4; ++j) { float e = __builtin_amdgcn_exp2f(sc[kt][qt][j]); sc[kt][qt][j] = e; ls += e; }
      lrun[qt] += ls;
#pragma unroll
      for (int k2 = 0; k2 < 2; ++k2) {
        union { bf16x8 v; unsigned u[4]; } t_;
        t_.u[0] = cvt_pk_bf16(sc[2 * k2][qt][0], sc[2 * k2][qt][1]); t_.u[1] = cvt_pk_bf16(sc[2 * k2][qt][2], sc[2 * k2][qt][3]);
        t_.u[2] = cvt_pk_bf16(sc[2 * k2 + 1][qt][0], sc[2 * k2 + 1][qt][1]); t_.u[3] = cvt_pk_bf16(sc[2 * k2 + 1][qt][2], sc[2 * k2 + 1][qt][3]);
        pf[k2][qt] = t_.v;
      }
    }
    const char* vdl = vl + cur * 8192;
#pragma unroll
    for (int k2 = 0; k2 < 2; ++k2)
#pragma unroll
      for (int dt = 0; dt < 4; ++dt) {
        const int dim = dt * 16 + fr;
        bf16x8 af = *reinterpret_cast<const bf16x8*>(vdl + dim * 128 + (((k2 * 4 + fq) ^ ((dim >> 1) & 7)) << 4));
#pragma unroll
        for (int qt = 0; qt < 2; ++qt) o[dt][qt] = __builtin_amdgcn_mfma_f32_16x16x32_bf16(af, pf[k2][qt], o[dt][qt], 0, 0, 0);
      }
    if (t + 2 < 32) lstoreK(sa, cur);
    if (t + 1 < 32) lstoreV(sa, cur ^ 1);
    __syncthreads();
#pragma unroll
    for (int kt = 0; kt < 4; ++kt)
#pragma unroll
      for (int qt = 0; qt < 2; ++qt) sc[kt][qt] = sn[kt][qt];
    rcur[0] = rnxt[0]; rcur[1] = rnxt[1];
      }
    { const int t = t2 + 1, cur = 1;

    if (t + 3 < 32) gloadK(sa, t + 3);
    if (t + 2 < 32) gloadV(sa, t + 2);
    if (t + 1 < 32) { rnxt[0] = mrun[0]; rnxt[1] = mrun[1]; qk_tile(kl + (cur ^ 1) * 16384, sn, rnxt); }
    bf16x8 pf[2][2];
#pragma unroll
    for (int qt = 0; qt < 2; ++qt) {
      float lm = sc[0][qt][0];
#pragma unroll
      for (int kt = 0; kt < 4; ++kt)
#pragma unroll
        for (int j = 0; j < 4; ++j) lm = fmaxf(lm, sc[kt][qt][j]);
      const bool slow = (lm > ATT_THR) || (rcur[qt] != mrun[qt]);
      if (__any(slow)) {
        const float dl = rcur[qt] - mrun[qt];
        float tm = lm + dl;
        tm = fmaxf(tm, __shfl_xor(tm, 16));
        tm = fmaxf(tm, __shfl_xor(tm, 32));
        const float inc = fmaxf(tm, 0.f);
        const float alpha = __builtin_amdgcn_exp2f(-inc);
        mrun[qt] += inc;
        lrun[qt] *= alpha;
#pragma unroll
        for (int dt = 0; dt < 4; ++dt) { o[dt][qt][0] *= alpha; o[dt][qt][1] *= alpha; o[dt][qt][2] *= alpha; o[dt][qt][3] *= alpha; }
        const float sh = dl - inc;
#pragma unroll
        for (int kt = 0; kt < 4; ++kt)
#pragma unroll
          for (int j = 0; j < 4; ++j) sc[kt][qt][j] += sh;
      }
      float ls = 0.f;
#pragma unroll
      for (int kt = 0; kt < 4; ++kt)
#pragma unroll
        for (int j = 0; j < 4; ++j) { float e = __builtin_amdgcn_exp2f(sc[kt][qt][j]); sc[kt][qt][j] = e; ls += e; }
      lrun[qt] += ls;
#pragma unroll
      for (int k2 = 0; k2 < 2; ++k2) {
        union { bf16x8 v; unsigned u[4]; } t_;
        t_.u[0] = cvt_pk_bf16(sc[2 * k2][qt][0], sc[2 * k2][qt][1]); t_.u[1] = cvt_pk_bf16(sc[2 * k2][qt][2], sc[2 * k2][qt][3]);
        t_.u[2] = cvt_pk_bf16(sc[2 * k2 + 1][qt][0], sc[2 * k2 + 1][qt][1]); t_.u[3] = cvt_pk_bf16(sc[2 * k2 + 1][qt][2], sc[2 * k2 + 1][qt][3]);
        pf[k2][qt] = t_.v;
      }
    }
    const char* vdl = vl + cur * 8192;
#pragma unroll
    for (int k2 = 0; k2 < 2; ++k2)
#pragma unroll
      for (int dt = 0; dt < 4; ++dt) {
        const int dim = dt * 16 + fr;
        bf16x8 af = *reinterpret_cast<const bf16x8*>(vdl + dim * 128 + (((k2 * 4 + fq) ^ ((dim >> 1) & 7)) << 4));
#pragma unroll
        for (int qt = 0; qt < 2; ++qt) o[dt][qt] = __builtin_amdgcn_mfma_f32_16x16x32_bf16(af, pf[k2][qt], o[dt][qt], 0, 0, 0);
      }
    if (t + 2 < 32) lstoreK(sb, cur);
    if (t + 1 < 32) lstoreV(sb, cur ^ 1);
    __syncthreads();
#pragma unroll
    for (int kt = 0; kt < 4; ++kt)
#pragma unroll
      for (int qt = 0; qt < 2; ++qt) sc[kt][qt] = sn[kt][qt];
    rcur[0] = rnxt[0]; rcur[1] = rnxt[1];
      }
  }
  const int b = bh >> 4, h = bh & 15;
#pragma unroll
  for (int qt = 0; qt < 2; ++qt) {
    float l = lrun[qt];
    l += __shfl_xor(l, 16);
    l += __shfl_xor(l, 32);
    const float inv = 1.0f / l;
    const long tok = (long)b * SEQ + qb * 256 + wid * 32 + qt * 16 + fr;
#pragma unroll
    for (int dt = 0; dt < 4; ++dt) {
      uint2 pk; pk.x = pack2(o[dt][qt][0] * inv, o[dt][qt][1] * inv); pk.y = pack2(o[dt][qt][2] * inv, o[dt][qt][3] * inv);
      *reinterpret_cast<uint2*>(O + tok * 1024 + h * 64 + dt * 16 + 4 * fq) = pk;
    }
  }
}
DEV void phase_mla_attn(const Params& p) {
  const int nb = gridDim.x;
  for (int u = vstart(); u < NBATCH * 16 * 8; u += nb) mla_attn_unit(p, u);
}

#ifndef ONLY
#define ONLY -1
#endif
#define PH(n, ...) if (ONLY < 0 || ONLY == n) { __VA_ARGS__; }
constexpr int LDS_BAR_OFF = 148480;
__global__ void __launch_bounds__(512) mega(Params p) {
  cg::grid_group grid = cg::this_grid();
  unsigned* barw = reinterpret_cast<unsigned*>(p.ws + S_BAR);
  if (blockIdx.x == 0) for (int i = threadIdx.x; i < XCD_BAR_WORDS; i += 512) barw[i] = 0u;
  if (threadIdx.x == 0) *reinterpret_cast<uint4*>(smem + LDS_BAR_OFF) = make_uint4(0u, 0u, 0u, 0u);
  PH(0, phase_prep(p));
  grid.sync();
  (void)xcd_barrier_post(barw, (volatile LAS unsigned*)(smem + LDS_BAR_OFF));
#define GSYNC() do { XcdBarrier xb_; xb_.bar = reinterpret_cast<unsigned*>(p.ws + S_BAR); xb_.x = xb_xcc_id(); xb_.st = (volatile LAS unsigned*)(smem + LDS_BAR_OFF); xcd_barrier(xb_); } while (0)
  PH(1, phase_abin(p)); GSYNC();
  PH(2, phase_mix0(p)); GSYNC();
  PH(2, phase_ztrans(p)); GSYNC();
  PH(3, phase_outproj(p, reinterpret_cast<const u16*>(p.ws + REG_A + 100663296ull), reinterpret_cast<const u16*>(p.ws + W_ABOUT))); GSYNC();
  for (int layer = 0; layer < 2; ++layer) {
    if (layer == 1) {
      PH(10, phase_mla_in(p)); GSYNC();
      PH(11, phase_mla_norm(p)); GSYNC();
      PH(12, phase_mla_up(p)); GSYNC();
      PH(13, phase_mla_attn(p)); GSYNC();
      PH(3, phase_outproj(p, reinterpret_cast<const u16*>(p.ws + MLA_O), reinterpret_cast<const u16*>(p.ws + W_MLAOUT))); GSYNC();
    }
    PH(4, phase_ln1_router(p, layer)); GSYNC();
    PH(5, phase_topk(p)); GSYNC();
    PH(6, phase_moe1(p, layer)); GSYNC();
    PH(7, phase_moe2(p, layer)); GSYNC();
    PH(8, phase_ln2(p, layer)); GSYNC();
    PH(9, phase_ple(p, layer, layer ? p.out : nullptr, layer ? nullptr : reinterpret_cast<u16*>(p.ws + REG_X)));
    if (layer == 0) GSYNC();
  }
}

static void add_job(Params& P, int& nj, int& tile, const float* src, u16* dst, int K, int N, int rsh, int rs, int off, int count, long sstride, long dstride, int f8 = 0, float fscale = 1.0f) {
  ConvJob& J = P.jobs[nj++];
  J.src = src; J.dst = dst; J.sstride = sstride; J.dstride = dstride; J.K = K; J.N = N; J.rs = rs; J.off = off; J.rsh = rsh;
  J.f8 = f8; J.fscale = fscale;
  if (f8) { J.ntn = N / 128; J.tpm = (K / 128) * J.ntn; } else { J.ntn = (N + 255) / 256; J.tpm = (K / 64) * J.ntn; }
  J.tile0 = tile; J.ntiles = J.tpm * count;
  tile += J.ntiles;
}

extern "C" void kernel_launch(void* const* d_in, const int* in_sizes, int n_in,
                              void* d_out, int out_size, void* d_ws, size_t ws_size,
                              hipStream_t stream) {
  constexpr size_t kDynLds = 148480 + 16;
  static int grid_blocks = 0;
  if (!grid_blocks) {
    int dev = 0, cus = 0, per_cu = 0;
    (void)hipGetDevice(&dev);
    (void)hipDeviceGetAttribute(&cus, hipDeviceAttributeMultiprocessorCount, dev);
    (void)hipFuncSetAttribute((const void*)mega, hipFuncAttributeMaxDynamicSharedMemorySize, (int)kDynLds);
    (void)hipOccupancyMaxActiveBlocksPerMultiprocessor(&per_cu, mega, 512, kDynLds);
    if (per_cu > 1) per_cu = 1;
    if (per_cu < 1) { fprintf(stderr, "occupancy query returned 0\n"); per_cu = 1; }
    grid_blocks = cus * per_cu;
    if (ws_size < WS_TOTAL) fprintf(stderr, "workspace too small: %zu < %zu\n", ws_size, (size_t)WS_TOTAL);
  }
  Params P;
  memset(&P, 0, sizeof(P));
  auto F = [&](int i) { return (const float*)d_in[i]; };
  char* ws = (char*)d_ws;
  P.x = F(0); P.p = F(1);
  P.na_rpb = F(3); P.hy_conv_w = F(4); P.hy_conv_b = F(5);
  P.hy_f_w1 = F(6); P.hy_f_b1 = F(7); P.hy_f_freq = F(8); P.hy_f_w2 = F(9); P.hy_f_b2 = F(10); P.hy_f_w3 = F(11); P.hy_skip = F(12);
  P.mla_q_norm = F(15); P.mla_kv_norm = F(17);
  P.ln1_g = F(20); P.ln1_b = F(21); P.ln2_g = F(22); P.ln2_b = F(23);
  P.moe_router = F(24);
  P.out = (float*)d_out; P.ws = ws;
  int nj = 0, tile = 0;
  add_job(P, nj, tile, F(2), (u16*)(ws + W_ABIN), 1024, 3072, 7, 128, 0, 1, 0, 0);
  add_job(P, nj, tile, F(13), (u16*)(ws + W_ABOUT), 1024, 1024, 7, 128, 0, 1, 0, 0);
  add_job(P, nj, tile, F(14), (u16*)(ws + W_MLAIN), 1024, 672, 7, 128, 0, 1, 0, 0);
  add_job(P, nj, tile, F(16), (u16*)(ws + W_QUP), 384, 1536, 7, 128, 0, 1, 0, 0);
  add_job(P, nj, tile, F(18), (u16*)(ws + W_KVUP), 256, 2048, 6, 64, 0, 1, 0, 0);
  P.jobs[nj - 1].sh2 = 1; P.jobs[nj - 1].off2 = 1024;
  add_job(P, nj, tile, F(19), (u16*)(ws + W_MLAOUT), 1024, 1024, 7, 128, 0, 1, 0, 0);
  add_job(P, nj, tile, F(28), (u16*)(ws + W_PLEG), 1024, 1024, 7, 128, 0, 2, 1024L * 1024, 1024L * 1024);
  add_job(P, nj, tile, F(29), (u16*)(ws + W_PLEP), 256, 1024, 7, 128, 0, 2, 256L * 1024, 1024L * 256);
  add_job(P, nj, tile, F(25), (u16*)(ws + W_GU), 1024, 2048, 7, 256, 0, 32, 1024L * 2048, 4096L * 1024, 1, 32.0f);
  add_job(P, nj, tile, F(26), (u16*)(ws + W_GU), 1024, 2048, 7, 256, 128, 32, 1024L * 2048, 4096L * 1024, 1, 32.0f);
  add_job(P, nj, tile, F(27), (u16*)(ws + W_DN), 2048, 1024, 7, 128, 0, 32, 2048L * 1024, 1024L * 2048, 1, 64.0f);
  P.conv_total = tile;
  void* args[] = {&P};
  hipError_t e = hipLaunchCooperativeKernel((void*)mega, dim3(grid_blocks), dim3(512), args, kDynLds, stream);
  if (e != hipSuccess) fprintf(stderr, "cooperative launch failed: %s (grid %d)\n", hipGetErrorString(e), grid_blocks);
}
```

```cpp
#include <hip/hip_runtime.h>
#include <hip/hip_bf16.h>
#include <hip/hip_cooperative_groups.h>
#include <cstdio>
#include <cstring>
namespace cg = cooperative_groups;

typedef unsigned short u16;
using bf16x8 = __attribute__((ext_vector_type(8))) short;
using bf16x4 = __attribute__((ext_vector_type(4))) short;
using f32x4 = __attribute__((ext_vector_type(4))) float;
#define DEV __device__ __forceinline__

constexpr int TOK = 16384, DM = 1024, SEQ = 2048, NBATCH = 8;
constexpr int NEXP = 16, CAP = 256, DFF = 2048;
constexpr float DN_ALPHA = 1.4142135623730951f;
constexpr float LN_EPS = 1e-5f;

constexpr size_t W_ABIN = 0;
constexpr size_t W_ABOUT = W_ABIN + 3072ull * 1024 * 2;
constexpr size_t W_MLAIN = W_ABOUT + 1024ull * 1024 * 2;
constexpr size_t W_QUP = W_MLAIN + 768ull * 1024 * 2;
constexpr size_t W_KVUP = W_QUP + 1536ull * 384 * 2;
constexpr size_t W_MLAOUT = W_KVUP + 2048ull * 256 * 2;
constexpr size_t W_PLEG = W_MLAOUT + 1024ull * 1024 * 2;
constexpr size_t W_PLEP = W_PLEG + 2 * 1024ull * 1024 * 2;
constexpr size_t W_GU = W_PLEP + 2 * 1024ull * 256 * 2;
constexpr size_t W_DN = W_GU + 2 * 16ull * 4096 * 1024 * 2;
constexpr size_t REG_A = W_DN + 2 * 16ull * 1024 * 2048 * 2;
constexpr size_t REG_B = REG_A + 134217728ull;
constexpr size_t REG_C = REG_B + 134217728ull;
constexpr size_t REG_D = REG_C + 67108864ull;
constexpr size_t REG_E = REG_D + 67108864ull;
constexpr size_t REG_G = REG_E + 33554432ull;
constexpr size_t REG_X = REG_G + 67108864ull;
constexpr size_t REG_P = REG_X + 33554432ull;
constexpr size_t S_AFF = REG_P + 16777216ull;
constexpr size_t S_IDX = S_AFF + 1048576ull;
constexpr size_t S_GSEL = S_IDX + 131072ull;
constexpr size_t S_SLOT = S_GSEL + 131072ull;
constexpr size_t S_H2 = S_SLOT + 1048576ull;
constexpr size_t S_RG = S_H2 + 524288ull;
constexpr size_t S_ROPE = S_RG + 8388608ull;
constexpr size_t S_BAR = S_ROPE + 262144ull;
constexpr size_t WS_TOTAL = S_BAR + 16384ull;

struct ConvJob {
  const float* src; u16* dst;
  long sstride, dstride;
  int K, N;
  int rs, off;
  int rsh, sh2, off2, f8;
  float fscale; int padk;
  int ntn;
  int tpm;
  int tile0, ntiles;
};
constexpr int NJOBS = 16;

struct Params {
  const float* x; const float* p;
  const float* na_rpb; const float* hy_conv_w; const float* hy_conv_b;
  const float* hy_f_w1; const float* hy_f_b1; const float* hy_f_freq; const float* hy_f_w2; const float* hy_f_b2;
  const float* hy_f_w3; const float* hy_skip;
  const float* mla_q_norm; const float* mla_kv_norm;
  const float* ln1_g; const float* ln1_b; const float* ln2_g; const float* ln2_b;
  const float* moe_router;
  float* out; char* ws;
  int conv_total; int pad0;
  ConvJob jobs[NJOBS];
};

extern __shared__ __attribute__((aligned(16))) char smem[];

typedef __bf16 bf16x2_t __attribute__((ext_vector_type(2)));
typedef float f32x2_t __attribute__((ext_vector_type(2)));
DEV unsigned cvt_pk_bf16(float lo, float hi) { f32x2_t f = {lo, hi}; bf16x2_t b = __builtin_convertvector(f, bf16x2_t); return __builtin_bit_cast(unsigned, b); }
DEV u16 f2bf(float f) { return (u16)(cvt_pk_bf16(f, 0.f) & 0xffffu); }
DEV float bf2f(u16 h) { return __uint_as_float(((unsigned)h) << 16); }
DEV unsigned pack2(float a, float b) { return cvt_pk_bf16(a, b); }
DEV unsigned pack4_f8(float a, float b, float c, float d) { int w = 0; w = __builtin_amdgcn_cvt_pk_fp8_f32(a, b, w, false); w = __builtin_amdgcn_cvt_pk_fp8_f32(c, d, w, true); return (unsigned)w; }
DEV float4 bf4_to_f4(uint2 t) { return make_float4(__uint_as_float(t.x << 16), __uint_as_float(t.x & 0xffff0000u), __uint_as_float(t.y << 16), __uint_as_float(t.y & 0xffff0000u)); }
DEV float fsigmoid(float x) { return __builtin_amdgcn_rcpf(1.0f + __builtin_amdgcn_exp2f(-1.4426950408889634f * x)); }
DEV float wave_sum(float v) {
#pragma unroll
  for (int o = 32; o > 0; o >>= 1) v += __shfl_xor(v, o);
  return v;
}
DEV int otid() { int t = threadIdx.x; asm volatile("" : "+v"(t)); return t; }
DEV int vstart() {
  int nb = gridDim.x, b = blockIdx.x;
  return (nb % 8 == 0) ? (b % 8) * (nb / 8) + b / 8 : b;
}


#define XB_TMO      128
#define XB_XCNT(j)  (256  + 64 * (j))
#define XB_XSUB(j)  (1280 + 64 * (j))
#define XB_XGEN(j)  (2304 + 64 * (j))
#define XB_TOP      3328
#define XB_TOPGEN   3392
#define XCD_BAR_WORDS 3456
#define XB_SPIN_CAP (1u << 18)
#define LAS __attribute__((address_space(3)))
DEV unsigned xb_ld(unsigned* p) { return __hip_atomic_load(p, __ATOMIC_RELAXED, __HIP_MEMORY_SCOPE_AGENT); }
DEV unsigned xb_add(unsigned* p, unsigned v) { return __hip_atomic_fetch_add(p, v, __ATOMIC_RELAXED, __HIP_MEMORY_SCOPE_AGENT); }
DEV unsigned xb_xcc_id() { return (unsigned)__builtin_amdgcn_s_getreg((3 << 11) | 20) & 0xFu; }
#define XB_SPIN(cond, bar) do { unsigned _sp = 0; while (cond) { __builtin_amdgcn_s_sleep(1); \
    if ((++_sp & 255u) == 0u) { if (xb_ld(&(bar)[XB_TMO])) break; if (_sp > XB_SPIN_CAP) { atomicAdd(&(bar)[XB_TMO], 1u); break; } } } } while (0)
struct XcdBarrier { unsigned* bar; unsigned x; volatile LAS unsigned* st; };
DEV XcdBarrier xcd_barrier_post(unsigned* bar, volatile LAS unsigned* st) {
  XcdBarrier b; b.bar = bar; b.x = xb_xcc_id(); b.st = st;
  if (threadIdx.x == 0) (void)xb_add(&bar[XB_XCNT(b.x)], 1u);
  return b;
}
DEV void xcd_barrier_complete(unsigned* bar, unsigned x, unsigned& nloc, unsigned& nx) {
  const unsigned G = gridDim.x * gridDim.y * gridDim.z;
  unsigned sum, cnt, mine, sp = 0u;
  for (;;) {
    sum = 0u; cnt = 0u; mine = 0u;
#pragma unroll
    for (unsigned j = 0; j < 16; ++j) { const unsigned c = xb_ld(&bar[XB_XCNT(j)]); sum += c; cnt += (c > 0u) ? 1u : 0u; mine = (j == x) ? c : mine; }
    if (sum == G) break;
    __builtin_amdgcn_s_sleep(1);
    if ((++sp & 255u) == 0u) { if (xb_ld(&bar[XB_TMO])) break; if (sp > XB_SPIN_CAP) { atomicAdd(&bar[XB_TMO], 1u); break; } }
  }
  nloc = mine > 0u ? mine : 1u; nx = cnt > 0u ? cnt : 1u;
}
DEV void xcd_barrier(const XcdBarrier& b) {
  asm volatile("s_waitcnt vmcnt(0)" ::: "memory");
  __syncthreads();
  if (threadIdx.x == 0) {
    unsigned* bar = b.bar;
    __builtin_amdgcn_s_waitcnt(0);
    unsigned nloc = b.st[0], nx = b.st[1];
    if (nloc == 0u) { xcd_barrier_complete(bar, b.x, nloc, nx); b.st[0] = nloc; b.st[1] = nx; }
    const unsigned old = xb_add(&bar[XB_XSUB(b.x)], 1u);
    const unsigned gen = old / nloc;
    if (old + 1u == (gen + 1u) * nloc) {
      __builtin_amdgcn_fence(__ATOMIC_RELEASE, "agent");
      asm volatile("s_waitcnt vmcnt(0)" ::: "memory");
      const unsigned og = xb_add(&bar[XB_TOP], 1u);
      const unsigned tg = og / nx;
      if (og + 1u == (tg + 1u) * nx) xb_add(&bar[XB_TOPGEN], 1u);
      else XB_SPIN(xb_ld(&bar[XB_TOPGEN]) == tg, bar);
      __builtin_amdgcn_fence(__ATOMIC_ACQUIRE, "agent");
      xb_add(&bar[XB_XGEN(b.x)], 1u);
      asm volatile("s_waitcnt vmcnt(0)" ::: "memory");
    } else {
      XB_SPIN(xb_ld(&bar[XB_XGEN(b.x)]) == gen, bar);
      __builtin_amdgcn_fence(__ATOMIC_ACQUIRE, "agent");
      asm volatile("s_waitcnt vmcnt(0)" ::: "memory");
    }
  }
  __syncthreads();
}

DEV int lds_byte(int r, int c) {
  int st = (r >> 4) * 2 + (c >> 5), rr = r & 15, cc = c & 31, ob = rr * 64 + cc * 2;
  return st * 1024 + (ob ^ (((ob >> 9) & 1) << 5));
}
DEV void stage_rc(int b, int& R, int& C) {
  int st = b / 1024, sb = b % 1024, swz = sb ^ (((sb >> 9) & 1) << 5);
  R = (st >> 1) * 16 + swz / 64; C = (st & 1) * 32 + (swz % 64) / 2;
}
#define GLDS16(g, l) __builtin_amdgcn_global_load_lds((const unsigned*)(g), (unsigned*)(l), 16, 0, 0)

typedef f32x4 Acc8[2][2][4][2];
constexpr int G8_BM = 256, G8_BK = 64, G8_HALF = 128, G8_HTB = G8_HALF * G8_BK * 2, G8_NXCD = 8, G8_WGM = 8;
DEV int perm32(int rho) { const int n = rho >> 4, i = rho & 15; return 8 * (i >> 2) + 4 * n + (i & 3); }
struct Unit { int pm, pn; };
DEV bool unit_next(int i, int nM, int nN, Unit& u) {
  const int nwg = nM * nN;
  const long L = (long)i * gridDim.x + blockIdx.x; if (L >= nwg) return false;
  int wgid = (int)L; { const int q = nwg / G8_NXCD, r = nwg % G8_NXCD, xcd = wgid % G8_NXCD, off = wgid / G8_NXCD; wgid = (xcd < r ? xcd * (q + 1) : r * (q + 1) + (xcd - r) * q) + off; }
  const int nig = G8_WGM * nN, gid = wgid / nig, fm = gid * G8_WGM, gsz = (nM - fm) < G8_WGM ? (nM - fm) : G8_WGM;
  u.pm = fm + ((wgid % nig) % gsz); u.pn = (wgid % nig) / gsz; return true;
}
typedef int v4i_t __attribute__((ext_vector_type(4)));
typedef int v8i_t __attribute__((ext_vector_type(8)));
template <bool TR, bool PERM, bool F8, class PF, class EF>
DEV void gemm_phase(const int K, const int nM, const int nN, PF ptrs, EF E) {
  LAS unsigned char* lds = (LAS unsigned char*)smem;
  const int tid = otid(), wid = __builtin_amdgcn_readfirstlane(tid >> 6), lane = tid & 63, wr = wid >> 2, wc = wid & 3, fr = lane & 15, fq = lane >> 4;
  const int Kb = F8 ? K : 2 * K;
  const int nt = Kb / 128;
  unsigned voffA[2], voffB[2];
#pragma unroll
  for (int i = 0; i < 2; ++i) { int R, C; stage_rc(tid * 16 + i * 8192, R, C); const int Rb = PERM ? ((R & ~31) + perm32(R & 31)) : R;
    voffA[i] = (unsigned)(R * Kb + C * 2); voffB[i] = (unsigned)(Rb * Kb + C * 2); }
  const size_t kstep = (size_t)(G8_BK * 2);
  const size_t hstep = (size_t)G8_HALF * Kb;
  const unsigned ldsw = (unsigned)wid * 1024u;
  const int aoff = lds_byte(wr * 64 + fr, fq * 8), boff = lds_byte(wc * 32 + fr, fq * 8);
#define PG8_SA(b, h) (((b) * 2 + (h)) * G8_HTB)
#define PG8_SB(b, h) ((4 + (b) * 2 + (h)) * G8_HTB)
#define PG8_STAGE(bufoff, gbase, voff) do { _Pragma("unroll") for (int _i = 0; _i < 2; ++_i) { unsigned _vo = (voff)[_i]; asm volatile("" : "+v"(_vo)); \
    __builtin_amdgcn_global_load_lds((const unsigned*)((const char*)(gbase) + _vo), (LAS unsigned*)(lds + (bufoff) + ldsw + _i * 8192), 16, 0, 0); } } while (0)
#define PG8_LD16(off) (*(const LAS v4i_t*)(lds + (off)))
#define PG8_LDA(dst, b, h) do { if constexpr (F8) { _Pragma("unroll") for (int m = 0; m < 4; ++m) dst##8[m] = __builtin_shufflevector(PG8_LD16(PG8_SA(b, h) + aoff + m * 2048), PG8_LD16(PG8_SA(b, h) + aoff + m * 2048 + 1024), 0, 1, 2, 3, 4, 5, 6, 7); } \
    else { _Pragma("unroll") for (int m = 0; m < 4; ++m) _Pragma("unroll") for (int k = 0; k < 2; ++k) dst[m][k] = *(const LAS bf16x8*)(lds + PG8_SA(b, h) + aoff + m * 2048 + k * 1024); } } while (0)
#define PG8_LDB(dst, b, h) do { if constexpr (F8) { _Pragma("unroll") for (int n = 0; n < 2; ++n) dst##8[n] = __builtin_shufflevector(PG8_LD16(PG8_SB(b, h) + boff + n * 2048), PG8_LD16(PG8_SB(b, h) + boff + n * 2048 + 1024), 0, 1, 2, 3, 4, 5, 6, 7); } \
    else { _Pragma("unroll") for (int n = 0; n < 2; ++n) _Pragma("unroll") for (int k = 0; k < 2; ++k) dst[n][k] = *(const LAS bf16x8*)(lds + PG8_SB(b, h) + boff + n * 2048 + k * 1024); } } while (0)
#define PG8_MMA(ai, bj, At, Bt) do { __builtin_amdgcn_s_setprio(1); \
    if constexpr (F8) { _Pragma("unroll") for (int m = 0; m < 4; ++m) _Pragma("unroll") for (int n = 0; n < 2; ++n) \
        { if constexpr (TR) asm volatile("v_mfma_f32_16x16x128_f8f6f4 %0, %1, %2, %0" : "+v"(acc[ai][bj][m][n]) : "v"(Bt##8[n]), "v"(At##8[m])); \
          else asm volatile("v_mfma_f32_16x16x128_f8f6f4 %0, %1, %2, %0" : "+v"(acc[ai][bj][m][n]) : "v"(At##8[m]), "v"(Bt##8[n])); } } \
    else { _Pragma("unroll") for (int m = 0; m < 4; ++m) _Pragma("unroll") for (int n = 0; n < 2; ++n) _Pragma("unroll") for (int k = 0; k < 2; ++k) \
    acc[ai][bj][m][n] = TR ? __builtin_amdgcn_mfma_f32_16x16x32_bf16(Bt[n][k], At[m][k], acc[ai][bj][m][n], 0, 0, 0) \
                           : __builtin_amdgcn_mfma_f32_16x16x32_bf16(At[m][k], Bt[n][k], acc[ai][bj][m][n], 0, 0, 0); } __builtin_amdgcn_s_setprio(0); } while (0)
#define PG8_WAIT_V(n) asm volatile("s_waitcnt vmcnt(" #n ")" ::: "memory")
#define PG8_WAIT_L(n) asm volatile("s_waitcnt lgkmcnt(" #n ")" ::: "memory")
#define PG8_BAR __builtin_amdgcn_s_barrier()
#define PG8_SCHED __builtin_amdgcn_sched_barrier(0)
  Unit cur, nxt; int ui = 0;
  if (!unit_next(0, nM, nN, cur)) return;
  Acc8 acc;
#pragma unroll
  for (int a = 0; a < 2; ++a)
#pragma unroll
    for (int b = 0; b < 2; ++b)
#pragma unroll
      for (int m = 0; m < 4; ++m)
#pragma unroll
        for (int n = 0; n < 2; ++n) acc[a][b][m][n] = f32x4{0.f, 0.f, 0.f, 0.f};
  bf16x8 At[4][2], B0[2][2], B1[2][2];
  v8i_t At8[4], B08[2], B18[2];
  const char* cA; const char* cB;
  ptrs(cur, cA, cB);
  PG8_STAGE(PG8_SB(0, 0), cB, voffB); PG8_STAGE(PG8_SA(0, 0), cA, voffA); PG8_STAGE(PG8_SB(0, 1), cB + hstep, voffB); PG8_STAGE(PG8_SA(0, 1), cA + hstep, voffA);
  if (wr == 1) PG8_BAR;
  PG8_WAIT_V(4); PG8_BAR;
  PG8_STAGE(PG8_SB(1, 0), cB + kstep, voffB); PG8_STAGE(PG8_SA(1, 0), cA + kstep, voffA); PG8_STAGE(PG8_SB(1, 1), cB + hstep + kstep, voffB);
  PG8_WAIT_V(6); PG8_BAR;
  for (;;) {
    const bool has_next = unit_next(ui + 1, nM, nN, nxt);
    const char* nA = cA; const char* nB = cB;
    if (has_next) ptrs(nxt, nA, nB);
#pragma unroll 1
    for (int t = 0; t < nt; t += 2) {
      const bool last = (t == nt - 2);
      const char* a1 = cA + (size_t)(t + 1) * kstep;
      const char* a2 = last ? nA : cA + (size_t)(t + 2) * kstep; const char* b2 = last ? nB : cB + (size_t)(t + 2) * kstep;
      const char* a3 = a2 + kstep; const char* b3 = b2 + kstep;
      PG8_LDB(B0, 0, 0); PG8_SCHED; PG8_LDA(At, 0, 0); PG8_STAGE(PG8_SA(1, 1), a1 + hstep, voffA);
      PG8_WAIT_L(8); PG8_BAR; PG8_WAIT_L(0); PG8_MMA(0, 0, At, B0); PG8_BAR; PG8_SCHED;
      PG8_LDB(B1, 0, 1); PG8_STAGE(PG8_SB(0, 0), b2, voffB);
      PG8_BAR; PG8_WAIT_L(0); PG8_MMA(0, 1, At, B1); PG8_BAR;
      PG8_LDA(At, 0, 1); PG8_STAGE(PG8_SA(0, 0), a2, voffA);
      PG8_BAR; PG8_WAIT_L(0); PG8_MMA(1, 0, At, B0); PG8_BAR; PG8_SCHED;
      PG8_STAGE(PG8_SB(0, 1), b2 + hstep, voffB);
      PG8_WAIT_V(6); PG8_BAR; PG8_MMA(1, 1, At, B1); PG8_BAR;
      PG8_LDB(B0, 1, 0); PG8_SCHED; PG8_LDA(At, 1, 0); PG8_STAGE(PG8_SA(0, 1), a2 + hstep, voffA);
      PG8_WAIT_L(8); PG8_BAR; PG8_WAIT_L(0); PG8_MMA(0, 0, At, B0); PG8_BAR; PG8_SCHED;
      PG8_LDB(B1, 1, 1); PG8_STAGE(PG8_SB(1, 0), b3, voffB);
      PG8_BAR; PG8_WAIT_L(0); PG8_MMA(0, 1, At, B1); PG8_BAR;
      PG8_LDA(At, 1, 1); PG8_STAGE(PG8_SA(1, 0), a3, voffA);
      PG8_BAR; PG8_WAIT_L(0); PG8_MMA(1, 0, At, B0); PG8_BAR; PG8_SCHED;
      PG8_STAGE(PG8_SB(1, 1), b3 + hstep, voffB);
      PG8_WAIT_V(6); PG8_BAR; PG8_MMA(1, 1, At, B1); PG8_BAR;
    }
    if constexpr (F8) asm volatile("s_nop 15\n\ts_nop 15" ::: "memory");
    { const int l2 = otid() & 63; E(acc, cur, wr, wc, l2 & 15, l2 >> 4); }
    if (!has_next) break;
#pragma unroll
    for (int a = 0; a < 2; ++a)
#pragma unroll
      for (int b = 0; b < 2; ++b)
#pragma unroll
        for (int m = 0; m < 4; ++m)
#pragma unroll
          for (int n = 0; n < 2; ++n) acc[a][b][m][n] = f32x4{0.f, 0.f, 0.f, 0.f};
    cur = nxt; cA = nA; cB = nB; ++ui;
  }
  PG8_WAIT_V(0);
  if (wr == 0) PG8_BAR;
  PG8_BAR;
#undef PG8_SA
#undef PG8_SB
#undef PG8_STAGE
#undef PG8_LDA
#undef PG8_LD16
#undef PG8_LDB
#undef PG8_MMA
#undef PG8_WAIT_V
#undef PG8_WAIT_L
#undef PG8_BAR
#undef PG8_SCHED
}
#define E8_FOR _Pragma("unroll") for (int ai = 0; ai < 2; ++ai) _Pragma("unroll") for (int m = 0; m < 4; ++m) _Pragma("unroll") for (int bj = 0; bj < 2; ++bj)

DEV void conv_tile(const ConvJob& J, int t) {
  const int tid = otid();
  int mat = t / J.tpm, tt = t % J.tpm;
  int kt = tt / J.ntn, nt = tt % J.ntn;
  const float* src = J.src + (long)mat * J.sstride;
  u16* dst = J.dst + (long)mat * J.dstride;
  const int kg = tid >> 6, ng = tid & 63;
  const int n = nt * 256 + ng * 4;
  float4 v[8];
#pragma unroll
  for (int j = 0; j < 8; ++j) {
    int k = kt * 64 + kg * 8 + j;
    if (n < J.N) v[j] = *reinterpret_cast<const float4*>(src + (long)k * J.N + n);
    else v[j] = make_float4(0.f, 0.f, 0.f, 0.f);
  }
#pragma unroll
  for (int i = 0; i < 4; ++i) {
    float e[8];
#pragma unroll
    for (int j = 0; j < 8; ++j) e[j] = (i == 0) ? v[j].x : (i == 1) ? v[j].y : (i == 2) ? v[j].z : v[j].w;
    uint4 pk;
    pk.x = pack2(e[0], e[1]); pk.y = pack2(e[2], e[3]); pk.z = pack2(e[4], e[5]); pk.w = pack2(e[6], e[7]);
    *reinterpret_cast<uint4*>(smem + (i * 64 + ng) * 144 + kg * 16) = pk;
  }
  __syncthreads();
#pragma unroll
  for (int u = 0; u < 4; ++u) {
    int q = tid + 512 * u;
    int nl = q >> 3, ch = q & 7;
    uint4 pk = *reinterpret_cast<const uint4*>(smem + ((nl & 3) * 64 + (nl >> 2)) * 144 + ch * 16);
    int nn = nt * 256 + nl;
    const int qq = nn >> J.rsh;
    long drow = (long)(qq >> J.sh2) * J.rs + (qq & ((1 << J.sh2) - 1)) * J.off2 + (nn & ((1 << J.rsh) - 1)) + J.off;
    *reinterpret_cast<uint4*>(dst + drow * J.K + kt * 64 + ch * 8) = pk;
  }
  __syncthreads();
}

DEV void conv_tile_f8(const ConvJob& J, int t) {
  const int tid = otid();
  int mat = t / J.tpm, tt = t % J.tpm;
  int kt = tt / J.ntn, nt = tt % J.ntn;
  const float* src = J.src + (long)mat * J.sstride;
  unsigned char* dst = reinterpret_cast<unsigned char*>(J.dst) + (long)mat * J.dstride;
  const int kg = tid >> 5, ng = tid & 31;
  const int n = nt * 128 + ng * 4;
  const float sc = J.fscale;
  float4 v[8];
#pragma unroll
  for (int j = 0; j < 8; ++j) v[j] = *reinterpret_cast<const float4*>(src + (long)(kt * 128 + kg * 8 + j) * J.N + n);
#pragma unroll
  for (int i = 0; i < 4; ++i) {
    float e[8];
#pragma unroll
    for (int j = 0; j < 8; ++j) e[j] = ((i == 0) ? v[j].x : (i == 1) ? v[j].y : (i == 2) ? v[j].z : v[j].w) * sc;
    uint2 pk; pk.x = pack4_f8(e[0], e[1], e[2], e[3]); pk.y = pack4_f8(e[4], e[5], e[6], e[7]);
    *reinterpret_cast<uint2*>(smem + (i * 32 + ng) * 144 + kg * 8) = pk;
  }
  __syncthreads();
#pragma unroll
  for (int u = 0; u < 2; ++u) {
    int q = tid + 512 * u;
    int nl = q >> 3, ch = q & 7;
    uint4 pk = *reinterpret_cast<const uint4*>(smem + ((nl & 3) * 32 + (nl >> 2)) * 144 + ch * 16);
    int nn = nt * 128 + nl;
    const int qq = nn >> J.rsh;
    long drow = (long)(qq >> J.sh2) * J.rs + (qq & ((1 << J.sh2) - 1)) * J.off2 + (nn & ((1 << J.rsh) - 1)) + J.off;
    *reinterpret_cast<uint4*>(dst + drow * J.K + kt * 128 + ch * 16) = pk;
  }
  __syncthreads();
}

DEV void phase_prep(const Params& p) {
  const int tid = otid(), nb = gridDim.x, bid = blockIdx.x;
  {
    float* zb = reinterpret_cast<float*>(smem);
    float* h1b = zb + 512;
    float* h2g = reinterpret_cast<float*>(p.ws + S_H2);
    const int w = tid >> 6, lane = tid & 63;
    for (int l0 = bid * 8; l0 < SEQ; l0 += nb * 8) {
      int l = l0 + w;
      float tt = (float)l / (float)(SEQ - 1);
      float ww = 6.283185307179586f * (float)l / (float)SEQ;
      float z = 0.f;
      if (lane == 0) z = tt;
      else if (lane <= 16) { float f = 1e-4f + (float)(lane - 1) * ((15.0f - 1e-4f) / 15.0f); z = cosf(f * ww); }
      else if (lane <= 32) { float f = 1e-4f + (float)(lane - 17) * ((15.0f - 1e-4f) / 15.0f); z = -sinf(f * ww); }
      zb[w * 64 + lane] = z;
      __syncthreads();
      float fr_ = p.hy_f_freq[lane];
      float a = p.hy_f_b1[lane];
      for (int k = 0; k < 33; ++k) a += zb[w * 64 + k] * p.hy_f_w1[k * 64 + lane];
      h1b[w * 64 + lane] = sinf(fr_ * a);
      __syncthreads();
      float a2 = p.hy_f_b2[lane];
      for (int k = 0; k < 64; ++k) a2 += h1b[w * 64 + k] * p.hy_f_w2[k * 64 + lane];
      h2g[l * 64 + lane] = sinf(fr_ * a2);
      __syncthreads();
    }
  }
  {
    float2* rt = reinterpret_cast<float2*>(p.ws + S_ROPE);
    for (int i = bid * 512 + tid; i < SEQ * 16; i += nb * 512) {
      const int l = i >> 4, k = i & 15;
      float sn, cs; sincosf((float)l * (1.0f / powf(10000.0f, (float)k / 16.0f)), &sn, &cs);
      rt[i] = make_float2(cs, sn);
    }
  }
  {
    u16* xb = reinterpret_cast<u16*>(p.ws + REG_X);
    const long n8 = (long)TOK * DM / 8;
    for (long i = (long)bid * 512 + tid; i < n8; i += (long)nb * 512) {
      float4 a = reinterpret_cast<const float4*>(p.x)[2 * i], b = reinterpret_cast<const float4*>(p.x)[2 * i + 1];
      uint4 pk; pk.x = pack2(a.x, a.y); pk.y = pack2(a.z, a.w); pk.z = pack2(b.x, b.y); pk.w = pack2(b.z, b.w);
      reinterpret_cast<uint4*>(xb)[i] = pk;
    }
    u16* pb = reinterpret_cast<u16*>(p.ws + REG_P);
    const long m8 = 2L * TOK * 256 / 8;
    for (long i = (long)bid * 512 + tid; i < m8; i += (long)nb * 512) {
      float4 a = reinterpret_cast<const float4*>(p.p)[2 * i], b = reinterpret_cast<const float4*>(p.p)[2 * i + 1];
      uint4 pk; pk.x = pack2(a.x, a.y); pk.y = pack2(a.z, a.w); pk.z = pack2(b.x, b.y); pk.w = pack2(b.z, b.w);
      reinterpret_cast<uint4*>(pb)[i] = pk;
    }
  }
  for (int t = bid; t < p.conv_total; t += nb) {
    int j = 0;
#pragma unroll 1
    for (int q = 1; q < NJOBS; ++q) if (t >= p.jobs[q].tile0 && p.jobs[q].ntiles > 0) j = q;
    if (p.jobs[j].f8) conv_tile_f8(p.jobs[j], t - p.jobs[j].tile0); else conv_tile(p.jobs[j], t - p.jobs[j].tile0);
  }
}

DEV void filter_b(const Params& p, int cpair) {
  const int tid = otid();
  float* w3s = reinterpret_cast<float*>(smem);
  float* red = w3s + 512;
  float* nrm = red + 32;
  float* hb = nrm + 4;
  const float* h2g = reinterpret_cast<const float*>(p.ws + S_H2);
  {
    int ci = tid >> 6, k = tid & 63;
    int o = ci >> 2, d = (ci >> 1) & 1, cc = ci & 1;
    w3s[ci * 64 + k] = p.hy_f_w3[k * 2048 + o * 1024 + d * 512 + 2 * cpair + cc];
  }
  __syncthreads();
  const float min_decay = logf(1e-2f) / 1.5f, max_decay = logf(1e-2f) / 0.3f;
#pragma unroll 1
  for (int i = 0; i < 4; ++i) {
    int l = tid + 512 * i;
    float h2[64];
#pragma unroll
    for (int k = 0; k < 16; ++k) {
      float4 v = *reinterpret_cast<const float4*>(h2g + l * 64 + k * 4);
      h2[4 * k] = v.x; h2[4 * k + 1] = v.y; h2[4 * k + 2] = v.z; h2[4 * k + 3] = v.w;
    }
    float tt = (float)l / (float)(SEQ - 1);
#pragma unroll 1
    for (int ci = 0; ci < 8; ++ci) {
      float a = 0.f;
#pragma unroll
      for (int k = 0; k < 64; ++k) a += h2[k] * w3s[ci * 64 + k];
      int cc = ci & 1;
      int c = 2 * cpair + cc;
      float delta = fabsf(min_decay + (float)c * ((max_decay - min_decay) / 511.0f));
      a *= expf(-tt * delta);
      hb[ci * 2048 + l] = a;
    }
  }
  __syncthreads();
  {
    float ss[4];
#pragma unroll
    for (int oc = 0; oc < 4; ++oc) {
      int o = oc >> 1, cc = oc & 1;
      float a = 0.f;
      for (int l = tid; l < 2048; l += 512) {
        float f = hb[(o * 4 + 0 + cc) * 2048 + l];
        float b = (l > 0) ? hb[(o * 4 + 2 + cc) * 2048 + l] : 0.f;
        a += f * f + b * b;
      }
      ss[oc] = wave_sum(a);
    }
    if ((tid & 63) == 0) {
#pragma unroll
      for (int q = 0; q < 4; ++q) red[(tid >> 6) * 4 + q] = ss[q];
    }
  }
  __syncthreads();
  if (tid < 4) {
    float s = 0.f;
    for (int w = 0; w < 8; ++w) s += red[w * 4 + tid];
    nrm[tid] = rsqrtf(s + 1e-12f);
  }
  __syncthreads();
  u16* Rg = reinterpret_cast<u16*>(p.ws + S_RG);
  for (int q = tid; q < 4 * 4096; q += 512) {
    int oc = q >> 12, qq = q & 4095;
    int o = oc >> 1, cc = oc & 1;
    float v;
    if (qq == 0) v = 0.f;
    else if (qq <= 2048) v = hb[(o * 4 + 0 * 2 + cc) * 2048 + (2048 - qq)];
    else v = hb[(o * 4 + 1 * 2 + cc) * 2048 + (qq - 2048)];
    v *= nrm[oc];
    Rg[((long)o * 512 + 2 * cpair + cc) * 4096 + qq] = f2bf(v);
  }
  __syncthreads();
}

DEV void phase_abin(const Params& p) {
  const int nb = gridDim.x;
  for (int c = blockIdx.x; c < 256; c += nb) filter_b(p, c);
  const u16* xb = reinterpret_cast<const u16*>(p.ws + REG_X);
  const u16* wt = reinterpret_cast<const u16*>(p.ws + W_ABIN);
  u16* qk = reinterpret_cast<u16*>(p.ws + REG_B);
  u16* vht = reinterpret_cast<u16*>(p.ws + REG_B + 33554432ull);
  gemm_phase<true, true, false>(1024, 64, 4, [&](const Unit& u, const char*& a, const char*& b) { a = (const char*)(xb) + (size_t)u.pm * 256 * (1024) * 2; b = (const char*)(wt) + (size_t)u.pn * 256 * (1024) * 2; },
      [&](Acc8& acc, const Unit& u, int wr, int wc, int fr, int fq) {
        const float sc = (u.pn < 2) ? 0.125f : 1.0f;
        u16* base = qk + (long)(u.pm * 256 + wr * 64 + fr) * 1024 + u.pn * 256 + wc * 32 + 8 * fq;
        E8_FOR {
          f32x4 v0 = acc[ai][bj][m][0], v1 = acc[ai][bj][m][1];
          uint4 pk;
          pk.x = cvt_pk_bf16(v0[0] * sc, v0[1] * sc); pk.y = cvt_pk_bf16(v0[2] * sc, v0[3] * sc);
          pk.z = cvt_pk_bf16(v1[0] * sc, v1[1] * sc); pk.w = cvt_pk_bf16(v1[2] * sc, v1[3] * sc);
          *reinterpret_cast<uint4*>(base + (ai * 128 + m * 16) * 1024 + bj * 128) = pk;
        }
      });
  gemm_phase<false, false, false>(1024, 64, 8, [&](const Unit& u, const char*& a, const char*& b) { a = (const char*)(xb) + (size_t)u.pm * 256 * (1024) * 2; b = (const char*)(wt + 1024 * 1024) + (size_t)u.pn * 256 * (1024) * 2; },
      [&](Acc8& acc, const Unit& u, int wr, int wc, int fr, int fq) {
        u16* base = vht + (long)(u.pn * 256 + wc * 32 + fr) * TOK + u.pm * 256 + wr * 64 + 4 * fq;
        E8_FOR {
#pragma unroll
          for (int n = 0; n < 2; ++n) {
            f32x4 v = acc[ai][bj][m][n];
            uint2 pk; pk.x = cvt_pk_bf16(v[0], v[1]); pk.y = cvt_pk_bf16(v[2], v[3]);
            *reinterpret_cast<uint2*>(base + (long)(bj * 128 + n * 16) * TOK + ai * 128 + m * 16) = pk;
          }
        }
      });
}

constexpr int NA_VST = 580;
constexpr int NA_V_OFF = 576 * 128;
DEV void na_pair(const Params& p, int u) {
  const int tid = otid(), lane = tid & 63, wid = tid >> 6, fr = lane & 15, fq = lane >> 4;
  const int rp = u & 15, h = (u >> 4) & 7, b = u >> 7;
  const int rbase = min(max(2 * rp - 4, 0), 24);
  const int nrows = (rbase == 24) ? 8 : 9;
  const u16* qk = reinterpret_cast<const u16*>(p.ws + REG_B);
  const u16* vht = reinterpret_cast<const u16*>(p.ws + REG_B + 33554432ull);
  u16* cat = reinterpret_cast<u16*>(p.ws + REG_A + 100663296ull);
  char* kl = smem;
  u16* vl = reinterpret_cast<u16*>(smem + NA_V_OFF);
  const long tok0 = (long)b * SEQ + rbase * 64;
  __syncthreads();
#pragma unroll
  for (int i = 0; i < 9; ++i) {
    const int q = tid + 512 * i, key = q >> 3, ch = q & 7;
    if (key < nrows * 64) {
      uint4 v = *reinterpret_cast<const uint4*>(qk + (tok0 + key) * 1024 + 512 + h * 64 + ch * 8);
      *reinterpret_cast<uint4*>(kl + key * 128 + ((ch ^ ((key >> 1) & 7)) << 4)) = v;
    }
  }
#pragma unroll
  for (int i = 0; i < 9; ++i) {
    const int q = tid + 512 * i, d = q / 72, ch = q % 72;
    if (ch < nrows * 8) {
      uint4 v = *reinterpret_cast<const uint4*>(vht + (long)(h * 64 + d) * TOK + tok0 + ch * 8);
      u16* dst = vl + d * NA_VST + ch * 8;
      *reinterpret_cast<uint2*>(dst) = make_uint2(v.x, v.y);
      *reinterpret_cast<uint2*>(dst + 4) = make_uint2(v.z, v.w);
    }
  }
  __syncthreads();
  const int g = wid & 3, r = 2 * rp + (wid >> 2);
  const int r0 = min(max(r - 4, 0), 24), ro = r0 - rbase, cs = min(max(16 * g - 8, 0), 32);
  const int c = 16 * g + fr;
  const long tokq = (long)b * SEQ + r * 64 + c;
  bf16x8 qf[2];
#pragma unroll
  for (int ks = 0; ks < 2; ++ks) qf[ks] = *reinterpret_cast<const bf16x8*>(qk + tokq * 1024 + h * 64 + ks * 32 + fq * 8);
  f32x4 s[16];
#pragma unroll
  for (int kt = 0; kt < 16; ++kt) {
    const int w = kt >> 1, half = kt & 1;
    const int key = (ro + w) * 64 + cs + 16 * half + fr;
    const int sw = (key >> 1) & 7;
    bf16x8 k0 = *reinterpret_cast<const bf16x8*>(kl + key * 128 + ((fq ^ sw) << 4));
    bf16x8 k1 = *reinterpret_cast<const bf16x8*>(kl + key * 128 + (((4 + fq) ^ sw) << 4));
    f32x4 a = {0.f, 0.f, 0.f, 0.f};
    a = __builtin_amdgcn_mfma_f32_16x16x32_bf16(k0, qf[0], a, 0, 0, 0);
    a = __builtin_amdgcn_mfma_f32_16x16x32_bf16(k1, qf[1], a, 0, 0, 0);
    s[kt] = a;
  }
  const int c0 = min(max(c - 8, 0), 48);
  const float* rpb = p.na_rpb + h * 15 * 31;
  float mx = -1e30f;
#pragma unroll
  for (int kt = 0; kt < 16; ++kt) {
    const int w = kt >> 1, half = kt & 1;
    const int dr = r0 + w - r + 7;
#pragma unroll
    for (int j = 0; j < 4; ++j) {
      int kc = cs + 16 * half + 4 * fq + j;
      bool valid = (kc >= c0) && (kc < c0 + 16);
      int dc = min(max(kc - c, -15), 15) + 15;
      float bias = rpb[dr * 31 + dc];
      float v = valid ? (s[kt][j] + bias) : -1e30f;
      s[kt][j] = v;
      mx = fmaxf(mx, v);
    }
  }
  mx = fmaxf(mx, __shfl_xor(mx, 16));
  mx = fmaxf(mx, __shfl_xor(mx, 32));
  float sum = 0.f;
#pragma unroll
  for (int kt = 0; kt < 16; ++kt)
#pragma unroll
    for (int j = 0; j < 4; ++j) { float e = __expf(s[kt][j] - mx); s[kt][j] = e; sum += e; }
  sum += __shfl_xor(sum, 16);
  sum += __shfl_xor(sum, 32);
  f32x4 o[4];
#pragma unroll
  for (int dt = 0; dt < 4; ++dt) o[dt] = f32x4{0.f, 0.f, 0.f, 0.f};
#pragma unroll
  for (int w = 0; w < 8; ++w) {
    union { bf16x8 v; unsigned u[4]; } pf;
    pf.u[0] = cvt_pk_bf16(s[2 * w][0], s[2 * w][1]); pf.u[1] = cvt_pk_bf16(s[2 * w][2], s[2 * w][3]);
    pf.u[2] = cvt_pk_bf16(s[2 * w + 1][0], s[2 * w + 1][1]); pf.u[3] = cvt_pk_bf16(s[2 * w + 1][2], s[2 * w + 1][3]);
#pragma unroll
    for (int dt = 0; dt < 4; ++dt) {
      const u16* vp = vl + (dt * 16 + fr) * NA_VST + (ro + w) * 64 + cs + 4 * fq;
      union { bf16x8 v; uint2 u[2]; } af;
      af.u[0] = *reinterpret_cast<const uint2*>(vp);
      af.u[1] = *reinterpret_cast<const uint2*>(vp + 16);
      o[dt] = __builtin_amdgcn_mfma_f32_16x16x32_bf16(af.v, pf.v, o[dt], 0, 0, 0);
    }
  }
  const float inv = 1.0f / sum;
#pragma unroll
  for (int dt = 0; dt < 4; ++dt) {
    uint2 pk; pk.x = pack2(o[dt][0] * inv, o[dt][1] * inv); pk.y = pack2(o[dt][2] * inv, o[dt][3] * inv);
    *reinterpret_cast<uint2*>(cat + tokq * 1024 + h * 64 + dt * 16 + 4 * fq) = pk;
  }
}

constexpr int UB_STRIDE = 2056;
constexpr int RC_STRIDE = 4120;
constexpr int HY_RC_OFF = 2 * NBATCH * UB_STRIDE * 2;
DEV float shortconv(const u16* hrow, const float* cw, float cb, int ch, int t) {
  float xm = (t > 0) ? bf2f(hrow[t - 1]) : 0.f;
  float x0 = bf2f(hrow[t]);
  float xp = (t < SEQ - 1) ? bf2f(hrow[t + 1]) : 0.f;
  return cb + xm * cw[ch] + x0 * cw[1536 + ch] + xp * cw[2 * 1536 + ch];
}
DEV void load_rc(const Params& p, int o, int c) {
  const int tid = otid();
  char* rc = smem + HY_RC_OFF;
  const u16* Rg = reinterpret_cast<const u16*>(p.ws + S_RG) + ((long)o * 512 + c) * 4096;
  const float skip = p.hy_skip[o * 512 + c];
  const int i0 = tid * 8;
  uint4 lo = *reinterpret_cast<const uint4*>(Rg + i0);
  uint4 hi = (tid < 511) ? *reinterpret_cast<const uint4*>(Rg + i0 + 8) : make_uint4(0u, 0u, 0u, 0u);
  unsigned w[8] = {lo.x, lo.y, lo.z, lo.w, hi.x, hi.y, hi.z, hi.w};
  if (tid == 256) w[0] = (w[0] & 0xffff0000u) | (unsigned)f2bf(bf2f((u16)(w[0] & 0xffffu)) + skip);
  if (tid == 255) w[4] = (w[4] & 0xffff0000u) | (unsigned)f2bf(bf2f((u16)(w[4] & 0xffffu)) + skip);
#pragma unroll
  for (int m = 0; m < 8; ++m) {
    uint4 o4;
    if (m & 1) {
      o4.x = __builtin_amdgcn_alignbyte(w[m / 2 + 1], w[m / 2], 2);
      o4.y = __builtin_amdgcn_alignbyte(w[m / 2 + 2], w[m / 2 + 1], 2);
      o4.z = __builtin_amdgcn_alignbyte(w[m / 2 + 3], w[m / 2 + 2], 2);
      o4.w = __builtin_amdgcn_alignbyte(w[m / 2 + 4], w[m / 2 + 3], 2);
    } else {
      o4.x = w[m / 2]; o4.y = w[m / 2 + 1]; o4.z = w[m / 2 + 2]; o4.w = w[m / 2 + 3];
    }
    *reinterpret_cast<uint4*>(rc + m * (RC_STRIDE * 2) + i0 * 2) = o4;
  }
}
DEV void hyena_conv(const u16* ub, f32x4 (&acc)[16]) {
  const int lane = otid() & 63, wid = __builtin_amdgcn_readfirstlane(otid() >> 6), fr = lane & 15, fq = lane >> 4;
  const int mcopy = (-wid) & 7;
  const u16* rbase = reinterpret_cast<const u16*>(smem + HY_RC_OFF) + mcopy * RC_STRIDE + (8 * fq - 8 * fr + 2048 - (wid + mcopy));
#pragma unroll
  for (int i = 0; i < 16; ++i) acc[i] = f32x4{0.f, 0.f, 0.f, 0.f};
  const u16* urow = ub + (fr & 7) * UB_STRIDE + fq * 8;
#pragma unroll 1
  for (int r = 0; r < 4; ++r) {
    bf16x8 Bf[16];
#pragma unroll
    for (int i = 0; i < 16; ++i) Bf[i] = *reinterpret_cast<const bf16x8*>(urow + (r + 4 * i) * 32);
    const u16* rk = rbase + 32 * r;
#pragma unroll
    for (int e = -15; e <= 15; ++e) {
      const bf16x8 af = *reinterpret_cast<const bf16x8*>(rk + 128 * e);
#pragma unroll
      for (int T = 0; T < 16; ++T) {
        const int i = e + T;
        if (i >= 0 && i < 16) acc[T] = __builtin_amdgcn_mfma_f32_16x16x32_bf16(af, Bf[i], acc[T], 0, 0, 0);
      }
    }
  }
}
DEV void shortconv_pass(const u16* __restrict__ hrow  , u16* ub, const float* cw, float cb, int ch) {
  const float w0 = cw[ch], w1 = cw[1536 + ch], w2 = cw[2 * 1536 + ch];
  for (int q = otid(); q < TOK / 8; q += 512) {
    const int i = q * 8, b = i >> 11, t = i & 2047;
    uint4 v = *reinterpret_cast<const uint4*>(hrow + i);
    float x[10];
    x[0] = (t > 0) ? bf2f(hrow[i - 1]) : 0.f;
    x[9] = (t + 8 < SEQ) ? bf2f(hrow[i + 8]) : 0.f;
    x[1] = __uint_as_float(v.x << 16); x[2] = __uint_as_float(v.x & 0xffff0000u);
    x[3] = __uint_as_float(v.y << 16); x[4] = __uint_as_float(v.y & 0xffff0000u);
    x[5] = __uint_as_float(v.z << 16); x[6] = __uint_as_float(v.z & 0xffff0000u);
    x[7] = __uint_as_float(v.w << 16); x[8] = __uint_as_float(v.w & 0xffff0000u);
    float y[8];
#pragma unroll
    for (int j = 0; j < 8; ++j) y[j] = cb + x[j] * w0 + x[j + 1] * w1 + x[j + 2] * w2;
    uint4 o4; o4.x = pack2(y[0], y[1]); o4.y = pack2(y[2], y[3]); o4.z = pack2(y[4], y[5]); o4.w = pack2(y[6], y[7]);
    *reinterpret_cast<uint4*>(ub + b * UB_STRIDE + t) = o4;
  }
}
DEV void hyena_unit(const Params& p, int c) {
  const int tid = otid(), lane = tid & 63, wid = tid >> 6, fr = lane & 15, fq = lane >> 4;
  u16* ubA = reinterpret_cast<u16*>(smem);
  u16* ubB = ubA + NBATCH * UB_STRIDE;
  const u16* hbt = reinterpret_cast<const u16*>(p.ws + REG_B + 33554432ull) + 512L * TOK;
  u16* zT = reinterpret_cast<u16*>(p.ws + REG_C);
  const float* cw = p.hy_conv_w;
  shortconv_pass(hbt + (long)c * TOK, ubA, cw, p.hy_conv_b[c], c);
  shortconv_pass(hbt + (long)(512 + c) * TOK, ubB, cw, p.hy_conv_b[512 + c], 512 + c);
  load_rc(p, 0, c);
  __syncthreads();
  f32x4 acc[16];
  hyena_conv(ubA, acc);
  if (fr < 8) {
#pragma unroll
    for (int T = 0; T < 16; ++T)
#pragma unroll
      for (int j = 0; j < 4; ++j) {
        const int t = 128 * T + wid + 8 * (4 * fq + j);
        u16* q = ubB + fr * UB_STRIDE + t;
        *q = f2bf(bf2f(*q) * acc[T][j]);
      }
  }
  __syncthreads();
  shortconv_pass(hbt + (long)(1024 + c) * TOK, ubA, cw, p.hy_conv_b[1024 + c], 1024 + c);
  load_rc(p, 1, c);
  __syncthreads();
  hyena_conv(ubB, acc);
  if (fr < 8) {
#pragma unroll
    for (int T = 0; T < 16; ++T)
#pragma unroll
      for (int j = 0; j < 4; ++j) {
        const int t = 128 * T + wid + 8 * (4 * fq + j);
        u16* q = ubA + fr * UB_STRIDE + t;
        *q = f2bf(bf2f(*q) * acc[T][j]);
      }
  }
  __syncthreads();
  for (int q = tid; q < TOK / 8; q += 512) {
    const int i = q * 8, b = i >> 11, t = i & 2047;
    *reinterpret_cast<uint4*>(zT + (long)c * TOK + i) = *reinterpret_cast<const uint4*>(ubA + b * UB_STRIDE + t);
  }
  __syncthreads();
}
DEV void phase_ztrans(const Params& p) {
  const int tid = otid();
  const u16* zT = reinterpret_cast<const u16*>(p.ws + REG_C);
  u16* cat = reinterpret_cast<u16*>(p.ws + REG_A + 100663296ull);
  u16* tile = reinterpret_cast<u16*>(smem);
  for (int tb = blockIdx.x; tb < TOK / 64; tb += gridDim.x) {
    __syncthreads();
    const u16* src = zT + (long)tid * TOK + tb * 64;
#pragma unroll
    for (int k = 0; k < 8; ++k) *reinterpret_cast<uint4*>(tile + tid * 72 + k * 8) = *reinterpret_cast<const uint4*>(src + k * 8);
    __syncthreads();
#pragma unroll
    for (int k = 0; k < 8; ++k) {
      const int q = tid + 512 * k;
      const int tk = q >> 6, ch8 = (q & 63) * 8;
      unsigned w[4];
#pragma unroll
      for (int j = 0; j < 4; ++j) w[j] = (unsigned)tile[(ch8 + 2 * j) * 72 + tk] | ((unsigned)tile[(ch8 + 2 * j + 1) * 72 + tk] << 16);
      *reinterpret_cast<uint4*>(cat + (long)(tb * 64 + tk) * 1024 + 512 + ch8) = make_uint4(w[0], w[1], w[2], w[3]);
    }
  }
}
DEV void phase_mix0(const Params& p) {
  const int nb = gridDim.x;
  for (int c = blockIdx.x; c < 512; c += nb) hyena_unit(p, c);
  for (int u = vstart(); u < 1024; u += nb) na_pair(p, u);
}

DEV void phase_outproj(const Params& p, const u16* A, const u16* wt) {
  u16* pre1 = reinterpret_cast<u16*>(p.ws + REG_C);
  const u16* xres = reinterpret_cast<const u16*>(p.ws + REG_X);
  gemm_phase<true, true, false>(1024, 64, 4, [&](const Unit& u, const char*& a, const char*& b) { a = (const char*)(A) + (size_t)u.pm * 256 * (1024) * 2; b = (const char*)(wt) + (size_t)u.pn * 256 * (1024) * 2; },
      [&](Acc8& acc, const Unit& u, int wr, int wc, int fr, int fq) {
        const long o0 = (long)(u.pm * 256 + wr * 64 + fr) * 1024 + u.pn * 256 + wc * 32 + 8 * fq;
        E8_FOR {
          const long o = o0 + (ai * 128 + m * 16) * 1024 + bj * 128;
          const uint4 xr = *reinterpret_cast<const uint4*>(xres + o);
          const float4 x0 = bf4_to_f4(make_uint2(xr.x, xr.y)), x1 = bf4_to_f4(make_uint2(xr.z, xr.w));
          f32x4 v0 = acc[ai][bj][m][0], v1 = acc[ai][bj][m][1];
          uint4 pk;
          pk.x = cvt_pk_bf16(DN_ALPHA * x0.x + v0[0], DN_ALPHA * x0.y + v0[1]); pk.y = cvt_pk_bf16(DN_ALPHA * x0.z + v0[2], DN_ALPHA * x0.w + v0[3]);
          pk.z = cvt_pk_bf16(DN_ALPHA * x1.x + v1[0], DN_ALPHA * x1.y + v1[1]); pk.w = cvt_pk_bf16(DN_ALPHA * x1.z + v1[2], DN_ALPHA * x1.w + v1[3]);
          *reinterpret_cast<uint4*>(pre1 + o) = pk;
        }
      });
}

DEV void phase_ln1_router(const Params& p, int layer) {
  const int tid = otid(), lane = tid & 63, wid = tid >> 6, nb = gridDim.x;
  float* wrT = reinterpret_cast<float*>(smem);
  const float* wr = p.moe_router + (long)layer * 1024 * 16;
  for (int i = tid; i < 16384; i += 512) { int c = i >> 4, e = i & 15; wrT[e * 1024 + c] = wr[i]; }
  __syncthreads();
  const u16* pre1 = reinterpret_cast<const u16*>(p.ws + REG_C);
  u16* x1 = reinterpret_cast<u16*>(p.ws + REG_D);
  unsigned char* x1q = reinterpret_cast<unsigned char*>(p.ws + REG_E);
  float* aff = reinterpret_cast<float*>(p.ws + S_AFF);
  const float* g = p.ln1_g + layer * 1024; const float* bb = p.ln1_b + layer * 1024;
  uint2 nx[4];
  {
    const int t0 = blockIdx.x * 8 + wid;
#pragma unroll
    for (int i = 0; i < 4; ++i) nx[i] = (t0 < TOK) ? *reinterpret_cast<const uint2*>(pre1 + (long)t0 * 1024 + i * 256 + lane * 4) : make_uint2(0u, 0u);
  }
  for (int tok = blockIdx.x * 8 + wid; tok < TOK; tok += nb * 8) {
    float4 v[4];
    float s = 0.f;
#pragma unroll
    for (int i = 0; i < 4; ++i) { v[i] = bf4_to_f4(nx[i]); s += v[i].x + v[i].y + v[i].z + v[i].w; }
    {
      const int tn = tok + nb * 8;
      if (tn < TOK) {
#pragma unroll
        for (int i = 0; i < 4; ++i) nx[i] = *reinterpret_cast<const uint2*>(pre1 + (long)tn * 1024 + i * 256 + lane * 4);
      }
    }
    float mu = wave_sum(s) * (1.0f / 1024.0f);
    float q = 0.f;
#pragma unroll
    for (int i = 0; i < 4; ++i) { v[i].x -= mu; v[i].y -= mu; v[i].z -= mu; v[i].w -= mu; q += v[i].x * v[i].x + v[i].y * v[i].y + v[i].z * v[i].z + v[i].w * v[i].w; }
    float rstd = rsqrtf(wave_sum(q) * (1.0f / 1024.0f) + LN_EPS);
    float4 y[4];
#pragma unroll
    for (int i = 0; i < 4; ++i) {
      int c = i * 256 + lane * 4;
      float4 gg = *reinterpret_cast<const float4*>(g + c), b4 = *reinterpret_cast<const float4*>(bb + c);
      y[i].x = v[i].x * rstd * gg.x + b4.x; y[i].y = v[i].y * rstd * gg.y + b4.y; y[i].z = v[i].z * rstd * gg.z + b4.z; y[i].w = v[i].w * rstd * gg.w + b4.w;
      { uint2 pk; pk.x = pack2(y[i].x, y[i].y); pk.y = pack2(y[i].z, y[i].w); *reinterpret_cast<uint2*>(x1 + (long)tok * 1024 + c) = pk; }
      *reinterpret_cast<unsigned*>(x1q + (long)tok * 1024 + c) = pack4_f8(y[i].x, y[i].y, y[i].z, y[i].w);
    }
    float lg[16];
#pragma unroll
    for (int e = 0; e < 16; ++e) {
      float a = 0.f;
#pragma unroll
      for (int i = 0; i < 4; ++i) {
        float4 w4 = *reinterpret_cast<const float4*>(wrT + e * 1024 + i * 256 + lane * 4);
        a += y[i].x * w4.x + y[i].y * w4.y + y[i].z * w4.z + y[i].w * w4.w;
      }
      lg[e] = a;
      if (e & 1) asm volatile("" ::: "memory");
    }
#pragma unroll
    for (int s_ = 0; s_ < 4; ++s_) {
      const int bit = 1 << s_;
      const bool up = (lane & bit) != 0;
#pragma unroll
      for (int i = 0; i < (8 >> s_); ++i) {
        float lo = lg[2 * i], hi = lg[2 * i + 1];
        float snd = up ? lo : hi;
        float rcv = __shfl_xor(snd, bit);
        lg[i] = (up ? hi : lo) + rcv;
      }
    }
    float mine = lg[0];
    mine += __shfl_xor(mine, 16);
    mine += __shfl_xor(mine, 32);
    float mx = mine;
#pragma unroll
    for (int o = 8; o > 0; o >>= 1) mx = fmaxf(mx, __shfl_xor(mx, o));
    float ex = expf(mine - mx);
    float den = ex;
#pragma unroll
    for (int o = 8; o > 0; o >>= 1) den += __shfl_xor(den, o);
    if (lane < 16) {
      int b = tok >> 11, l = tok & 2047;
      aff[((long)b * 16 + lane) * SEQ + l] = ex / den;
    }
  }
}

DEV void phase_topk(const Params& p) {
  const int tid = otid(), nb = gridDim.x, lane = tid & 63, wid = tid >> 6;
  unsigned* key = reinterpret_cast<unsigned*>(smem);
  int* rows = reinterpret_cast<int*>(smem + 8192);
  unsigned* hist = reinterpret_cast<unsigned*>(smem + 9216);
  unsigned* wsum = reinterpret_cast<unsigned*>(smem + 10240);
  unsigned* bc = reinterpret_cast<unsigned*>(smem + 10304);
  const float* aff = reinterpret_cast<const float*>(p.ws + S_AFF);
  float* gsel = reinterpret_cast<float*>(p.ws + S_GSEL);
  int* slot = reinterpret_cast<int*>(p.ws + S_SLOT);
  const unsigned char* x1q = reinterpret_cast<const unsigned char*>(p.ws + REG_E);
  unsigned char* Xe = reinterpret_cast<unsigned char*>(p.ws + REG_C);
  for (int be = blockIdx.x; be < NBATCH * NEXP; be += nb) {
    const int b = be >> 4, e = be & 15;
    __syncthreads();
    const float4 av = *reinterpret_cast<const float4*>(aff + (long)be * SEQ + tid * 4);
    const unsigned k0 = __float_as_uint(av.x), k1 = __float_as_uint(av.y), k2 = __float_as_uint(av.z), k3 = __float_as_uint(av.w);
    unsigned prefix = 0u, need = CAP;
#pragma unroll 1
    for (int shift = 24; shift >= 0; shift -= 8) {
      if (tid < 256) hist[tid] = 0u;
      __syncthreads();
      const unsigned hs = (shift == 24) ? 0u : (unsigned)(shift + 8);
      if (shift == 24 || (k0 >> hs) == prefix) atomicAdd(&hist[(k0 >> shift) & 255u], 1u);
      if (shift == 24 || (k1 >> hs) == prefix) atomicAdd(&hist[(k1 >> shift) & 255u], 1u);
      if (shift == 24 || (k2 >> hs) == prefix) atomicAdd(&hist[(k2 >> shift) & 255u], 1u);
      if (shift == 24 || (k3 >> hs) == prefix) atomicAdd(&hist[(k3 >> shift) & 255u], 1u);
      __syncthreads();
      if (wid == 0) {
        unsigned h0 = hist[4 * lane], h1 = hist[4 * lane + 1], h2 = hist[4 * lane + 2], h3 = hist[4 * lane + 3];
        unsigned tot = h0 + h1 + h2 + h3;
        unsigned suf = tot;
#pragma unroll
        for (int o = 1; o < 64; o <<= 1) { unsigned t = __shfl_down(suf, o); if (lane + o < 64) suf += t; }
        const unsigned above = suf - tot;
        int d = -1; unsigned nabove = 0u;
        unsigned c3 = above + h3, c2 = c3 + h2, c1 = c2 + h1, c0 = c1 + h0;
        if (above < need && c0 >= need) {
          if (c3 >= need) { d = 4 * lane + 3; nabove = above; }
          else if (c2 >= need) { d = 4 * lane + 2; nabove = c3; }
          else if (c1 >= need) { d = 4 * lane + 1; nabove = c2; }
          else { d = 4 * lane; nabove = c1; }
          bc[0] = (prefix << 8) | (unsigned)d;
          bc[1] = need - nabove;
        }
      }
      __syncthreads();
      prefix = bc[0]; need = bc[1];
    }
    const unsigned tau = prefix;
    const unsigned e0 = (k0 == tau), e1 = (k1 == tau), e2 = (k2 == tau), e3 = (k3 == tau);
    unsigned eqs = e0 + e1 + e2 + e3;
    unsigned inc = eqs;
#pragma unroll
    for (int o = 1; o < 64; o <<= 1) { unsigned t = __shfl_up(inc, o); if (lane >= o) inc += t; }
    if (lane == 63) wsum[wid] = inc;
    __syncthreads();
    unsigned base = 0u;
#pragma unroll
    for (int w = 0; w < 8; ++w) if (w < wid) base += wsum[w];
    unsigned eqb = base + inc - eqs;
    const unsigned s0 = (k0 > tau) || (e0 && eqb < need); eqb += e0;
    const unsigned s1 = (k1 > tau) || (e1 && eqb < need); eqb += e1;
    const unsigned s2 = (k2 > tau) || (e2 && eqb < need); eqb += e2;
    const unsigned s3 = (k3 > tau) || (e3 && eqb < need);
    const unsigned sels = s0 + s1 + s2 + s3;
    unsigned inc2 = sels;
#pragma unroll
    for (int o = 1; o < 64; o <<= 1) { unsigned t = __shfl_up(inc2, o); if (lane >= o) inc2 += t; }
    if (lane == 63) wsum[8 + wid] = inc2;
    __syncthreads();
    unsigned base2 = 0u;
#pragma unroll
    for (int w = 0; w < 8; ++w) if (w < wid) base2 += wsum[8 + w];
    unsigned sl = base2 + inc2 - sels;
    const int tok0 = tid * 4;
    int sv[4];
    sv[0] = s0 ? (int)sl : -1; sl += s0;
    sv[1] = s1 ? (int)sl : -1; sl += s1;
    sv[2] = s2 ? (int)sl : -1; sl += s2;
    sv[3] = s3 ? (int)sl : -1;
    const float avv[4] = {av.x, av.y, av.z, av.w};
#pragma unroll
    for (int j = 0; j < 4; ++j) {
      slot[((long)b * SEQ + tok0 + j) * 16 + e] = sv[j];
      if (sv[j] >= 0) { rows[sv[j]] = tok0 + j; gsel[be * CAP + sv[j]] = avv[j]; }
    }
    __syncthreads();
    for (int s = wid; s < CAP; s += 8) {
      const int t = rows[s];
      const uint4* src = reinterpret_cast<const uint4*>(x1q + ((long)b * SEQ + t) * 1024);
      uint4* dst = reinterpret_cast<uint4*>(Xe + ((long)(e * 8 + b) * CAP + s) * 1024);
      dst[lane] = src[lane];
    }
  }
}

DEV void phase_moe1(const Params& p, int layer) {
  const unsigned char* Xe = reinterpret_cast<const unsigned char*>(p.ws + REG_C);
  const unsigned char* wgu = reinterpret_cast<const unsigned char*>(p.ws + W_GU) + (long)layer * 16 * 4096 * 1024;
  unsigned char* H = reinterpret_cast<unsigned char*>(p.ws + REG_A);
  gemm_phase<true, true, true>(1024, 128, 16,
      [&](const Unit& u, const char*& a, const char*& b) { a = (const char*)Xe + (size_t)u.pm * 256 * 1024; b = (const char*)wgu + ((size_t)(u.pm >> 3) * 4096 + (size_t)u.pn * 256) * 1024; },
      [&](Acc8& acc, const Unit& u, int wr, int wc, int fr, int fq) {
        unsigned char* base = H + (long)(u.pm * 256 + wr * 64 + fr) * DFF + u.pn * 128 + wc * 32 + 8 * fq;
#pragma unroll
        for (int ai = 0; ai < 2; ++ai)
#pragma unroll
          for (int m = 0; m < 4; ++m) {
            float hv[8];
#pragma unroll
            for (int n = 0; n < 2; ++n)
#pragma unroll
              for (int j = 0; j < 4; ++j) {
                float gte = acc[ai][0][m][n][j] * 0.03125f, up = acc[ai][1][m][n][j] * 0.03125f;
                hv[n * 4 + j] = gte * fsigmoid(gte) * up;
              }
            uint2 pk; pk.x = pack4_f8(hv[0], hv[1], hv[2], hv[3]); pk.y = pack4_f8(hv[4], hv[5], hv[6], hv[7]);
            *reinterpret_cast<uint2*>(base + (ai * 128 + m * 16) * DFF) = pk;
          }
      });
}
DEV void phase_moe2(const Params& p, int layer) {
  const unsigned char* H = reinterpret_cast<const unsigned char*>(p.ws + REG_A);
  const unsigned char* wd = reinterpret_cast<const unsigned char*>(p.ws + W_DN) + (long)layer * 16 * 1024 * 2048;
  const float* gsel = reinterpret_cast<const float*>(p.ws + S_GSEL);
  u16* Ye = reinterpret_cast<u16*>(p.ws + REG_B);
  gemm_phase<true, true, true>(2048, 128, 4,
      [&](const Unit& u, const char*& a, const char*& b) { a = (const char*)H + (size_t)u.pm * 256 * 2048; b = (const char*)wd + ((size_t)(u.pm >> 3) * 1024 + (size_t)u.pn * 256) * 2048; },
      [&](Acc8& acc, const Unit& u, int wr, int wc, int fr, int fq) {
        const int e = u.pm >> 3, b = u.pm & 7;
        const float* gs = gsel + (b * 16 + e) * CAP + wr * 64 + fr;
        u16* base = Ye + (long)(u.pm * 256 + wr * 64 + fr) * 1024 + u.pn * 256 + wc * 32 + 8 * fq;
#pragma unroll
        for (int ai = 0; ai < 2; ++ai)
#pragma unroll
          for (int m = 0; m < 4; ++m) {
            const float g = gs[ai * 128 + m * 16] * 0.015625f;
#pragma unroll
            for (int bj = 0; bj < 2; ++bj) {
              f32x4 v0 = acc[ai][bj][m][0] * g, v1 = acc[ai][bj][m][1] * g;
              uint4 pk;
              pk.x = cvt_pk_bf16(v0[0], v0[1]); pk.y = cvt_pk_bf16(v0[2], v0[3]); pk.z = cvt_pk_bf16(v1[0], v1[1]); pk.w = cvt_pk_bf16(v1[2], v1[3]);
              *reinterpret_cast<uint4*>(base + (ai * 128 + m * 16) * 1024 + bj * 128) = pk;
            }
          }
      });
}
DEV void phase_ln2(const Params& p, int layer) {
  const int tid = otid(), lane = tid & 63, wid = tid >> 6, nb = gridDim.x;
  const u16* x1 = reinterpret_cast<const u16*>(p.ws + REG_D);
  const u16* Ye = reinterpret_cast<const u16*>(p.ws + REG_B);
  const int* slot = reinterpret_cast<const int*>(p.ws + S_SLOT);
  u16* x2b = reinterpret_cast<u16*>(p.ws + REG_A + 67108864ull);
  const float* g = p.ln2_g + layer * 1024; const float* bb = p.ln2_b + layer * 1024;
  uint2 nx[4]; int nslot = -1;
  {
    const int t0 = blockIdx.x * 8 + wid;
    if (t0 < TOK) {
#pragma unroll
      for (int i = 0; i < 4; ++i) nx[i] = *reinterpret_cast<const uint2*>(x1 + (long)t0 * 1024 + i * 256 + lane * 4);
      nslot = (lane < 16) ? slot[(long)t0 * 16 + lane] : -1;
    }
  }
  for (int tok = blockIdx.x * 8 + wid; tok < TOK; tok += nb * 8) {
    const int b = tok >> 11;
    float4 v[4];
#pragma unroll
    for (int i = 0; i < 4; ++i) {
      float4 t = bf4_to_f4(nx[i]);
      v[i].x = DN_ALPHA * t.x; v[i].y = DN_ALPHA * t.y; v[i].z = DN_ALPHA * t.z; v[i].w = DN_ALPHA * t.w;
    }
    int myslot = nslot;
    {
      const int tn = tok + nb * 8;
      if (tn < TOK) {
#pragma unroll
        for (int i = 0; i < 4; ++i) nx[i] = *reinterpret_cast<const uint2*>(x1 + (long)tn * 1024 + i * 256 + lane * 4);
        nslot = (lane < 16) ? slot[(long)tn * 16 + lane] : -1;
      }
    }
    unsigned mask = (unsigned)__ballot(myslot >= 0);
    while (mask) {
      const int e = __builtin_ctz(mask);
      mask &= mask - 1;
      const int sidx = __builtin_amdgcn_readlane(myslot, e);
      const u16* yr = Ye + ((long)(e * 8 + b) * CAP + sidx) * 1024;
      uint2 t[4];
#pragma unroll
      for (int i = 0; i < 4; ++i) t[i] = *reinterpret_cast<const uint2*>(yr + i * 256 + lane * 4);
#pragma unroll
      for (int i = 0; i < 4; ++i) {
        v[i].x += __uint_as_float(t[i].x << 16); v[i].y += __uint_as_float(t[i].x & 0xffff0000u);
        v[i].z += __uint_as_float(t[i].y << 16); v[i].w += __uint_as_float(t[i].y & 0xffff0000u);
      }
    }
    float s = 0.f;
#pragma unroll
    for (int i = 0; i < 4; ++i) s += v[i].x + v[i].y + v[i].z + v[i].w;
    float mu = wave_sum(s) * (1.0f / 1024.0f);
    float q = 0.f;
#pragma unroll
    for (int i = 0; i < 4; ++i) { v[i].x -= mu; v[i].y -= mu; v[i].z -= mu; v[i].w -= mu; q += v[i].x * v[i].x + v[i].y * v[i].y + v[i].z * v[i].z + v[i].w * v[i].w; }
    float rstd = rsqrtf(wave_sum(q) * (1.0f / 1024.0f) + LN_EPS);
#pragma unroll
    for (int i = 0; i < 4; ++i) {
      int c = i * 256 + lane * 4;
      float4 gg = *reinterpret_cast<const float4*>(g + c), b4 = *reinterpret_cast<const float4*>(bb + c);
      float4 y;
      y.x = v[i].x * rstd * gg.x + b4.x; y.y = v[i].y * rstd * gg.y + b4.y; y.z = v[i].z * rstd * gg.z + b4.z; y.w = v[i].w * rstd * gg.w + b4.w;
      uint2 pk; pk.x = pack2(y.x, y.y); pk.y = pack2(y.z, y.w);
      *reinterpret_cast<uint2*>(x2b + (long)tok * 1024 + c) = pk;
    }
  }
}
DEV void phase_ple(const Params& p, int layer, float* outf, u16* outb) {
  const u16* x2b = reinterpret_cast<const u16*>(p.ws + REG_A + 67108864ull);
  const u16* pb = reinterpret_cast<const u16*>(p.ws + REG_P) + (long)layer * TOK * 256;
  const u16* wg = reinterpret_cast<const u16*>(p.ws + W_PLEG) + (long)layer * 1024 * 1024;
  const u16* wp = reinterpret_cast<const u16*>(p.ws + W_PLEP) + (long)layer * 1024 * 256;
  u16* pp = reinterpret_cast<u16*>(p.ws + REG_C);
  gemm_phase<true, false, false>(256, 64, 4, [&](const Unit& u, const char*& a, const char*& b) { a = (const char*)(pb) + (size_t)u.pm * 256 * (256) * 2; b = (const char*)(wp) + (size_t)u.pn * 256 * (256) * 2; },
      [&](Acc8& acc, const Unit& u, int wr, int wc, int fr, int fq) {
        const long o0 = (long)(u.pm * 256 + wr * 64 + fr) * 1024 + u.pn * 256 + wc * 32 + 4 * fq;
        E8_FOR {
#pragma unroll
          for (int n = 0; n < 2; ++n)
          {
            f32x4 v = acc[ai][bj][m][n];
            uint2 pk; pk.x = cvt_pk_bf16(v[0], v[1]); pk.y = cvt_pk_bf16(v[2], v[3]);
            *reinterpret_cast<uint2*>(pp + o0 + (ai * 128 + m * 16) * 1024 + bj * 128 + n * 16) = pk;
          }
        }
      });
  gemm_phase<true, false, false>(1024, 64, 4, [&](const Unit& u, const char*& a, const char*& b) { a = (const char*)(x2b) + (size_t)u.pm * 256 * (1024) * 2; b = (const char*)(wg) + (size_t)u.pn * 256 * (1024) * 2; },
      [&](Acc8& acc, const Unit& u, int wr, int wc, int fr, int fq) {
        const long o0 = (long)(u.pm * 256 + wr * 64 + fr) * 1024 + u.pn * 256 + wc * 32 + 4 * fq;
        E8_FOR {
#pragma unroll
          for (int n = 0; n < 2; ++n) {
            const long o = o0 + (ai * 128 + m * 16) * 1024 + bj * 128 + n * 16;
            f32x4 a = acc[ai][bj][m][n];
            const float4 xq = bf4_to_f4(*reinterpret_cast<const uint2*>(x2b + o));
            f32x4 xv = {xq.x, xq.y, xq.z, xq.w};
            const uint2 pq = *reinterpret_cast<const uint2*>(pp + o);
            f32x4 pv = {__uint_as_float(pq.x << 16), __uint_as_float(pq.x & 0xffff0000u), __uint_as_float(pq.y << 16), __uint_as_float(pq.y & 0xffff0000u)};
            f32x4 r;
#pragma unroll
            for (int j = 0; j < 4; ++j) r[j] = xv[j] + pv[j] * fsigmoid(a[j]);
            if (outf) *reinterpret_cast<f32x4*>(outf + o) = r;
            if (outb) { uint2 pk; pk.x = cvt_pk_bf16(r[0], r[1]); pk.y = cvt_pk_bf16(r[2], r[3]); *reinterpret_cast<uint2*>(outb + o) = pk; }
          }
        }
      });
}
DEV void phase_mla_in(const Params& p) {
  const u16* xb = reinterpret_cast<const u16*>(p.ws + REG_X);
  const u16* wt = reinterpret_cast<const u16*>(p.ws + W_MLAIN);
  float* hm = reinterpret_cast<float*>(p.ws + REG_B);
  gemm_phase<true, false, false>(1024, 64, 3, [&](const Unit& u, const char*& a, const char*& b) { a = (const char*)(xb) + (size_t)u.pm * 256 * (1024) * 2; b = (const char*)(wt) + (size_t)u.pn * 256 * (1024) * 2; },
      [&](Acc8& acc, const Unit& u, int wr, int wc, int fr, int fq) {
        const long o0 = (long)(u.pm * 256 + wr * 64 + fr) * 768 + u.pn * 256 + wc * 32 + 4 * fq;
        E8_FOR {
#pragma unroll
          for (int n = 0; n < 2; ++n)
            *reinterpret_cast<f32x4*>(hm + o0 + (ai * 128 + m * 16) * 768 + bj * 128 + n * 16) = acc[ai][bj][m][n];
        }
      });
}
constexpr size_t MLA_Q = REG_A, MLA_K = REG_A + 50331648ull, MLA_VT = REG_A + 100663296ull;
constexpr size_t MLA_CQN = REG_B + 50331648ull, MLA_CKVN = MLA_CQN + 12582912ull, MLA_O = MLA_CKVN + 8388608ull;
DEV float rope_inv(int i) { return 1.0f / powf(10000.0f, (float)i / 16.0f); }
DEV void phase_mla_norm(const Params& p) {
  const int tid = otid(), lane = tid & 63, wid = tid >> 6, nb = gridDim.x;
  const float* hm = reinterpret_cast<const float*>(p.ws + REG_B);
  u16* cqn = reinterpret_cast<u16*>(p.ws + MLA_CQN);
  u16* ckvn = reinterpret_cast<u16*>(p.ws + MLA_CKVN);
  u16* Kb = reinterpret_cast<u16*>(p.ws + MLA_K);
  for (int tok = blockIdx.x * 8 + wid; tok < TOK; tok += nb * 8) {
    const float* row = hm + (long)tok * 768;
    float q[6], kv[4];
    float sq = 0.f, skv = 0.f;
#pragma unroll
    for (int i = 0; i < 6; ++i) { q[i] = row[i * 64 + lane]; sq += q[i] * q[i]; }
#pragma unroll
    for (int i = 0; i < 4; ++i) { kv[i] = row[384 + i * 64 + lane]; skv += kv[i] * kv[i]; }
    float rq = rsqrtf(wave_sum(sq) * (1.0f / 384.0f) + LN_EPS);
    float rkv = rsqrtf(wave_sum(skv) * (1.0f / 256.0f) + LN_EPS);
#pragma unroll
    for (int i = 0; i < 6; ++i) cqn[(long)tok * 384 + i * 64 + lane] = f2bf(q[i] * rq * p.mla_q_norm[i * 64 + lane]);
#pragma unroll
    for (int i = 0; i < 4; ++i) ckvn[(long)tok * 256 + i * 64 + lane] = f2bf(kv[i] * rkv * p.mla_kv_norm[i * 64 + lane]);
    const int b = tok >> 11, l = tok & 2047;
    float kr = (lane < 32) ? row[640 + lane] : 0.f;
    float x1 = __shfl(kr, lane & 15), x2 = __shfl(kr, (lane & 15) + 16);
    const float2 cssn = reinterpret_cast<const float2*>(p.ws + S_ROPE)[l * 16 + (lane & 15)];
    const float cs = cssn.x, sn = cssn.y;
    float r = (lane & 16) ? (x1 * sn + x2 * cs) : (x1 * cs - x2 * sn);
    u16 rb = f2bf(r);
    for (int hh = 0; hh < 16; hh += 2) {
      int h = hh + (lane >> 5);
      u16 val = (u16)__shfl((int)rb, lane & 31);
      Kb[(((long)b * 16 + h) * SEQ + l) * 96 + 64 + (lane & 31)] = val;
    }
  }
}
DEV void phase_mla_up(const Params& p) {
  const u16* cqn = reinterpret_cast<const u16*>(p.ws + MLA_CQN);
  const u16* ckvn = reinterpret_cast<const u16*>(p.ws + MLA_CKVN);
  const u16* wq = reinterpret_cast<const u16*>(p.ws + W_QUP);
  const u16* wkv = reinterpret_cast<const u16*>(p.ws + W_KVUP);
  u16* Qb = reinterpret_cast<u16*>(p.ws + MLA_Q);
  u16* Kb = reinterpret_cast<u16*>(p.ws + MLA_K);
  u16* VT = reinterpret_cast<u16*>(p.ws + MLA_VT);
  const float qscale = 0.10206207261596577f * 1.4426950408889634f;
  gemm_phase<true, false, false>(384, 64, 6, [&](const Unit& u, const char*& a, const char*& b) { a = (const char*)(cqn) + (size_t)u.pm * 256 * (384) * 2; b = (const char*)(wq) + (size_t)u.pn * 256 * (384) * 2; },
      [&](Acc8& acc, const Unit& u, int wr, int wc, int fr, int fq) {
#pragma unroll
        for (int bj = 0; bj < 2; ++bj) {
          const int c32 = (u.pn * 256 + bj * 128 + wc * 32) >> 5;
          const int h = c32 / 3, part = c32 % 3;
#pragma unroll
          for (int ai = 0; ai < 2; ++ai)
#pragma unroll
            for (int m = 0; m < 4; ++m) {
              const int tok = u.pm * 256 + ai * 128 + wr * 64 + m * 16 + fr;
              const int b = tok >> 11, l = tok & 2047;
              u16* qrow = Qb + (((long)b * 16 + h) * SEQ + l) * 96 + part * 32 + 4 * fq;
              f32x4 a0 = acc[ai][bj][m][0], a1 = acc[ai][bj][m][1];
              if (part == 2) {
#pragma unroll
                for (int j = 0; j < 4; ++j) {
                  const float2 cssn = reinterpret_cast<const float2*>(p.ws + S_ROPE)[l * 16 + 4 * fq + j];
                  const float cs = cssn.x, sn = cssn.y;
                  float r0 = a0[j] * cs - a1[j] * sn, r1 = a0[j] * sn + a1[j] * cs;
                  a0[j] = r0; a1[j] = r1;
                }
              }
              uint2 p0, p1;
              p0.x = cvt_pk_bf16(a0[0] * qscale, a0[1] * qscale); p0.y = cvt_pk_bf16(a0[2] * qscale, a0[3] * qscale);
              p1.x = cvt_pk_bf16(a1[0] * qscale, a1[1] * qscale); p1.y = cvt_pk_bf16(a1[2] * qscale, a1[3] * qscale);
              *reinterpret_cast<uint2*>(qrow) = p0;
              *reinterpret_cast<uint2*>(qrow + 16) = p1;
            }
        }
      });
  gemm_phase<true, true, false>(256, 64, 4, [&](const Unit& u, const char*& a, const char*& b) { a = (const char*)(ckvn) + (size_t)u.pm * 256 * (256) * 2; b = (const char*)(wkv) + (size_t)u.pn * 256 * (256) * 2; },
      [&](Acc8& acc, const Unit& u, int wr, int wc, int fr, int fq) {
        E8_FOR {
          const int tok = u.pm * 256 + ai * 128 + wr * 64 + m * 16 + fr;
          const int b = tok >> 11, l = tok & 2047;
          const int col = u.pn * 256 + bj * 128 + wc * 32 + 8 * fq;
          const int h = col >> 6, d = col & 63;
          f32x4 v0 = acc[ai][bj][m][0], v1 = acc[ai][bj][m][1];
          uint4 pk;
          pk.x = cvt_pk_bf16(v0[0], v0[1]); pk.y = cvt_pk_bf16(v0[2], v0[3]); pk.z = cvt_pk_bf16(v1[0], v1[1]); pk.w = cvt_pk_bf16(v1[2], v1[3]);
          *reinterpret_cast<uint4*>(Kb + (((long)b * 16 + h) * SEQ + l) * 96 + d) = pk;
        }
      });
  gemm_phase<false, false, false>(256, 64, 4, [&](const Unit& u, const char*& a, const char*& b) { a = (const char*)(ckvn) + (size_t)u.pm * 256 * (256) * 2; b = (const char*)(wkv + 1024 * 256) + (size_t)u.pn * 256 * (256) * 2; },
      [&](Acc8& acc, const Unit& u, int wr, int wc, int fr, int fq) {
        E8_FOR {
          const int tok = u.pm * 256 + ai * 128 + wr * 64 + m * 16 + 4 * fq;
          const int b = tok >> 11, l = tok & 2047;
#pragma unroll
          for (int n = 0; n < 2; ++n) {
            const int col = u.pn * 256 + bj * 128 + wc * 32 + n * 16 + fr;
            const int h = col >> 6, d = col & 63;
            f32x4 v = acc[ai][bj][m][n];
            uint2 pk; pk.x = cvt_pk_bf16(v[0], v[1]); pk.y = cvt_pk_bf16(v[2], v[3]);
            *reinterpret_cast<uint2*>(VT + (((long)b * 16 + h) * 64 + d) * SEQ + l) = pk;
          }
        }
      });
}
#ifndef ATT_THR
#define ATT_THR 8.0f
#endif
DEV int kswz(int key) { return (((key >> 3) & 3) << 2) | (key & 3); }
DEV void mla_attn_unit(const Params& p, int u) {
  const int tid = otid(), lane = tid & 63, wid = tid >> 6, fr = lane & 15, fq = lane >> 4;
  const int qb = u & 7, bh = u >> 3;
  const u16* Qb = reinterpret_cast<const u16*>(p.ws + MLA_Q) + (long)bh * SEQ * 96;
  const u16* Kb = reinterpret_cast<const u16*>(p.ws + MLA_K) + (long)bh * SEQ * 96;
  const u16* VT = reinterpret_cast<const u16*>(p.ws + MLA_VT) + (long)bh * 64 * SEQ;
  u16* O = reinterpret_cast<u16*>(p.ws + MLA_O);
  char* kl = smem;
  char* vl = smem + 32768;
  bf16x8 qf[2][3];
#pragma unroll
  for (int qt = 0; qt < 2; ++qt)
#pragma unroll
    for (int ks = 0; ks < 3; ++ks)
      qf[qt][ks] = *reinterpret_cast<const bf16x8*>(Qb + (long)(qb * 256 + wid * 32 + qt * 16 + fr) * 96 + ks * 32 + fq * 8);
  f32x4 o[4][2];
#pragma unroll
  for (int dt = 0; dt < 4; ++dt)
#pragma unroll
    for (int qt = 0; qt < 2; ++qt) o[dt][qt] = f32x4{0.f, 0.f, 0.f, 0.f};
  float mrun[2], lrun[2] = {0.f, 0.f}, rcur[2], rnxt[2] = {0.f, 0.f};
  const int kc0 = tid, kc1 = 512 + (tid & 255);
  const int vd = tid >> 3, vpart = tid & 7;
  const int kw0 = (kc0 / 12) * 256 + (((kc0 % 12) ^ kswz(kc0 / 12)) << 4);
  const int kw1 = (kc1 / 12) * 256 + (((kc1 % 12) ^ kswz(kc1 / 12)) << 4);
  const int vw = vd * 128 + ((vpart ^ ((vd >> 1) & 7)) << 4);
  struct Stg { uint4 k0, k1, v; };
  Stg sa, sb;
  sa.k1 = make_uint4(0, 0, 0, 0); sb.k1 = make_uint4(0, 0, 0, 0);
  auto gloadK = [&](Stg& r, int t) {
    const u16* kt = Kb + (long)t * 64 * 96;
    r.k0 = *reinterpret_cast<const uint4*>(kt + kc0 * 8);
    r.k1 = *reinterpret_cast<const uint4*>(kt + kc1 * 8);
  };
  auto gloadV = [&](Stg& r, int t) { r.v = *reinterpret_cast<const uint4*>(VT + (long)vd * SEQ + t * 64 + vpart * 8); };
  auto lstoreK = [&](const Stg& r, int buf) {
    *reinterpret_cast<uint4*>(kl + buf * 16384 + kw0) = r.k0;
    if (tid < 256) *reinterpret_cast<uint4*>(kl + buf * 16384 + kw1) = r.k1;
  };
  auto lstoreV = [&](const Stg& r, int buf) { *reinterpret_cast<uint4*>(vl + buf * 8192 + vw) = r.v; };
  const int krow = 8 * (fr >> 2) + (fr & 3);
  const int kf_ = kswz(krow);
  auto qk_tile = [&](const char* kd, f32x4 (&s)[4][2], const float (&ref)[2]) {
#pragma unroll
    for (int kt = 0; kt < 4; ++kt) {
      const int key = 32 * (kt >> 1) + 4 * (kt & 1) + krow;
      bf16x8 kf[3];
#pragma unroll
      for (int ks = 0; ks < 3; ++ks) kf[ks] = *reinterpret_cast<const bf16x8*>(kd + key * 256 + (((ks * 4 + fq) ^ kf_) << 4));
#pragma unroll
      for (int qt = 0; qt < 2; ++qt) {
        f32x4 a = {-ref[qt], -ref[qt], -ref[qt], -ref[qt]};
#pragma unroll
        for (int ks = 0; ks < 3; ++ks) a = __builtin_amdgcn_mfma_f32_16x16x32_bf16(kf[ks], qf[qt][ks], a, 0, 0, 0);
        s[kt][qt] = a;
      }
    }
  };
  __syncthreads();
  gloadK(sa, 0); gloadV(sa, 0); lstoreK(sa, 0); lstoreV(sa, 0);
  gloadK(sa, 1); lstoreK(sa, 1);
  gloadK(sa, 2); gloadV(sa, 1);
  __syncthreads();
  f32x4 sc[4][2], sn[4][2];
  {
    const float zero2[2] = {0.f, 0.f};
    qk_tile(kl, sc, zero2);
#pragma unroll
    for (int qt = 0; qt < 2; ++qt) {
      float tm = -1e30f;
#pragma unroll
      for (int kt = 0; kt < 4; ++kt)
#pragma unroll
        for (int j = 0; j < 4; ++j) tm = fmaxf(tm, sc[kt][qt][j]);
      tm = fmaxf(tm, __shfl_xor(tm, 16));
      tm = fmaxf(tm, __shfl_xor(tm, 32));
      mrun[qt] = tm; rcur[qt] = tm;
#pragma unroll
      for (int kt = 0; kt < 4; ++kt)
#pragma unroll
        for (int j = 0; j < 4; ++j) sc[kt][qt][j] -= tm;
    }
  }
  __syncthreads();
#pragma unroll 1
  for (int t2 = 0; t2 < 32; t2 += 2) {
    { const int t = t2, cur = 0;

    gloadK(sb, min(t + 3, 31));
    gloadV(sb, min(t + 2, 31));
    if (t + 1 < 32) { rnxt[0] = mrun[0]; rnxt[1] = mrun[1]; qk_tile(kl + (cur ^ 1) * 16384, sn, rnxt); }
    bf16x8 pf[2][2];
#pragma unroll
    for (int qt = 0; qt < 2; ++qt) {
      float lm = sc[0][qt][0];
#pragma unroll
      for (int kt = 0; kt < 4; ++kt)
#pragma unroll
        for (int j = 0; j < 4; ++j) lm = fmaxf(lm, sc[kt][qt][j]);
      const bool slow = (lm > ATT_THR) || (rcur[qt] != mrun[qt]);
      if (__any(slow)) {
        const float dl = rcur[qt] - mrun[qt];
        float tm = lm + dl;
        tm = fmaxf(tm, __shfl_xor(tm, 16));
        tm = fmaxf(tm, __shfl_xor(tm, 32));
        const float inc = fmaxf(tm, 0.f);
        const float alpha = __builtin_amdgcn_exp2f(-inc);
        mrun[qt] += inc;
        lrun[qt] *= alpha;
#pragma unroll
        for (int dt = 0; dt < 4; ++dt) { o[dt][qt][0] *= alpha; o[dt][qt][1] *= alpha; o[dt][qt][2] *= alpha; o[dt][qt][3] *= alpha; }
        const float sh = dl - inc;
#pragma unroll
        for (int kt = 0; kt < 4; ++kt)
#pragma unroll
          for (int j = 0; j < 4; ++j) sc[kt][qt][j] += sh;
      }
      float ls = 0.f;
#pragma unroll
      for (int kt = 0; kt < 4; ++kt)
#pragma unroll
        for (int j = 0; j < 4; ++j) { float e = __builtin_amdgcn_exp2f(sc[kt][qt][j]); sc[kt][qt][j] = e; ls += e; }
      lrun[qt] += ls;
#pragma unroll
      for (int k2 = 0; k2 < 2; ++k2) {
        union { bf16x8 v; unsigned u[4]; } t_;
        t_.u[0] = cvt_pk_bf16(sc[2 * k2][qt][0], sc[2 * k2][qt][1]); t_.u[1] = cvt_pk_bf16(sc[2 * k2][qt][2], sc[2 * k2][qt][3]);
        t_.u[2] = cvt_pk_bf16(sc[2 * k2 + 1][qt][0], sc[2 * k2 + 1][qt][1]); t_.u[3] = cvt_pk_bf16(sc[2 * k2 + 1][qt][2], sc[2 * k2 + 1][qt][3]);
        pf[k2][qt] = t_.v;
      }
    }
    const char* vdl = vl + cur * 8192;
#pragma unroll
    for (int k2 = 0; k2 < 2; ++k2)
#pragma unroll
      for (int dt = 0; dt < 4; ++dt) {
        const int dim = dt * 16 + fr;
        bf16x8 af = *reinterpret_cast<const bf16x8*>(vdl + dim * 128 + (((k2 * 4 + fq) ^ ((dim >> 1) & 7)) << 4));
#pragma unroll
        for (int qt = 0; qt < 2; ++qt) o[dt][qt] = __builtin_amdgcn_mfma_f32_16x16x32_bf16(af, pf[k2][qt], o[dt][qt], 0, 0, 0);
      }
    if (t + 2 < 32) lstoreK(sa, cur);
    if (t + 1 < 32) lstoreV(sa, cur ^ 1);
    __syncthreads();
#pragma unroll
    for (int kt = 0; kt < 4; ++kt)
#pragma unroll
      for (int qt = 0; qt < 2; ++qt) sc[kt][qt] = sn[kt][qt];
    rcur[0] = rnxt[0]; rcur[1] = rnxt[1];
      }
    { const int t = t2 + 1, cur = 1;

    gloadK(sa, min(t + 3, 31));
    gloadV(sa, min(t + 2, 31));
    if (t + 1 < 32) { rnxt[0] = mrun[0]; rnxt[1] = mrun[1]; qk_tile(kl + (cur ^ 1) * 16384, sn, rnxt); }
    bf16x8 pf[2][2];
#pragma unroll
    for (int qt = 0; qt < 2; ++qt) {
      float lm = sc[0][qt][0];
#pragma unroll
      for (int kt = 0; kt < 4; ++kt)
#pragma unroll
        for (int j = 0; j < 4; ++j) lm = fmaxf(lm, sc[kt][qt][j]);
      const bool slow = (lm > ATT_THR) || (rcur[qt] != mrun[qt]);
      if (__any(slow)) {
        const float dl = rcur[qt] - mrun[qt];
        float tm = lm + dl;
        tm = fmaxf(tm, __shfl_xor(tm, 16));
        tm = fmaxf(tm, __shfl_xor(tm, 32));
        const float inc = fmaxf(tm, 0.f);
        const float alpha = __builtin_amdgcn_exp2f(-inc);
        mrun[qt] += inc;
        lrun[qt] *= alpha;
#pragma unroll
        for (int dt = 0; dt < 4; ++dt) { o[dt][qt][0] *= alpha; o[dt][qt][1] *= alpha; o[dt][qt][2] *= alpha; o[dt][qt][3] *= alpha; }
        const float sh = dl - inc;
#pragma unroll
        for (int kt = 0; kt < 4; ++kt)
#pragma unroll
          for (int j = 0; j < 4; ++j) sc[kt][qt][j] += sh;
      }
      float ls = 0.f;
#pragma unroll
      for (int kt = 0; kt < 4; ++kt)
#pragma unroll
        for (int j = 0; j < 4; ++j) { float e = __builtin_amdgcn_exp2f(sc[kt][qt][j]); sc[kt][qt][j] = e; ls += e; }
      lrun[qt] += ls;
#pragma unroll
      for (int k2 = 0; k2 < 2; ++k2) {
        union { bf16x8 v; unsigned u[4]; } t_;
        t_.u[0] = cvt_pk_bf16(sc[2 * k2][qt][0], sc[2 * k2][qt][1]); t_.u[1] = cvt_pk_bf16(sc[2 * k2][qt][2], sc[2 * k2][qt][3]);
        t_.u[2] = cvt_pk_bf16(sc[2 * k2 + 1][qt][0], sc[2 * k2 + 1][qt][1]); t_.u[3] = cvt_pk_bf16(sc[2 * k2 + 1][qt][2], sc[2 * k2 + 1][qt][3]);
        pf[k2][qt] = t_.v;
      }
    }
    const char* vdl = vl + cur * 8192;
#pragma unroll
    for (int k2 = 0; k2 < 2; ++k2)
#pragma unroll
      for (int dt = 0; dt < 4; ++dt) {
        const int dim = dt * 16 + fr;
        bf16x8 af = *reinterpret_cast<const bf16x8*>(vdl + dim * 128 + (((k2 * 4 + fq) ^ ((dim >> 1) & 7)) << 4));
#pragma unroll
        for (int qt = 0; qt < 2; ++qt) o[dt][qt] = __builtin_amdgcn_mfma_f32_16x16x32_bf16(af, pf[k2][qt], o[dt][qt], 0, 0, 0);
      }
    if (t + 2 < 32) lstoreK(sb, cur);
    if (t + 1 < 32) lstoreV(sb, cur ^ 1);
    __syncthreads();
#pragma unroll
    for (int kt = 0; kt < 4; ++kt)
#pragma unroll
      for (int qt = 0; qt < 2; ++qt) sc[kt][qt] = sn[kt][qt];
    rcur[0] = rnxt[0]; rcur[1] = rnxt[1];
      }
  }
  const int b = bh >> 4, h = bh & 15;
#pragma unroll
  for (int qt = 0; qt < 2; ++qt) {
    float l = lrun[qt];
    l += __shfl_xor(l, 16);
    l += __shfl_xor(l, 32);
    const float inv = 1.0f / l;
    const long tok = (long)b * SEQ + qb * 256 + wid * 32 + qt * 16 + fr;
#pragma unroll
    for (int dt = 0; dt < 4; ++dt) {
      uint2 pk; pk.x = pack2(o[dt][qt][0] * inv, o[dt][qt][1] * inv); pk.y = pack2(o[dt][qt][2] * inv, o[dt][qt][3] * inv);
      *reinterpret_cast<uint2*>(O + tok * 1024 + h * 64 + dt * 16 + 4 * fq) = pk;
    }
  }
}
DEV void phase_mla_attn(const Params& p) {
  const int nb = gridDim.x;
  for (int u = vstart(); u < NBATCH * 16 * 8; u += nb) mla_attn_unit(p, u);
}

#ifndef ONLY
#define ONLY -1
#endif
#define PH(n, ...) if (ONLY < 0 || ONLY == n) { __VA_ARGS__; }
constexpr int LDS_BAR_OFF = 148480;
__global__ void __launch_bounds__(512) mega(Params p) {
  cg::grid_group grid = cg::this_grid();
  unsigned* barw = reinterpret_cast<unsigned*>(p.ws + S_BAR);
  if (blockIdx.x == 0) for (int i = threadIdx.x; i < XCD_BAR_WORDS; i += 512) barw[i] = 0u;
  if (threadIdx.x == 0) *reinterpret_cast<uint4*>(smem + LDS_BAR_OFF) = make_uint4(0u, 0u, 0u, 0u);
  PH(0, phase_prep(p));
  grid.sync();
  (void)xcd_barrier_post(barw, (volatile LAS unsigned*)(smem + LDS_BAR_OFF));
#define GSYNC() do { XcdBarrier xb_; xb_.bar = reinterpret_cast<unsigned*>(p.ws + S_BAR); xb_.x = xb_xcc_id(); xb_.st = (volatile LAS unsigned*)(smem + LDS_BAR_OFF); xcd_barrier(xb_); } while (0)
  PH(1, phase_abin(p)); GSYNC();
  PH(2, phase_mix0(p)); GSYNC();
  PH(2, phase_ztrans(p)); GSYNC();
  PH(3, phase_outproj(p, reinterpret_cast<const u16*>(p.ws + REG_A + 100663296ull), reinterpret_cast<const u16*>(p.ws + W_ABOUT))); GSYNC();
  for (int layer = 0; layer < 2; ++layer) {
    if (layer == 1) {
      PH(10, phase_mla_in(p)); GSYNC();
      PH(11, phase_mla_norm(p)); GSYNC();
      PH(12, phase_mla_up(p)); GSYNC();
      PH(13, phase_mla_attn(p)); GSYNC();
      PH(3, phase_outproj(p, reinterpret_cast<const u16*>(p.ws + MLA_O), reinterpret_cast<const u16*>(p.ws + W_MLAOUT))); GSYNC();
    }
    PH(4, phase_ln1_router(p, layer)); GSYNC();
    PH(5, phase_topk(p)); GSYNC();
    PH(6, phase_moe1(p, layer)); GSYNC();
    PH(7, phase_moe2(p, layer)); GSYNC();
    PH(8, phase_ln2(p, layer)); GSYNC();
    PH(9, phase_ple(p, layer, layer ? p.out : nullptr, layer ? nullptr : reinterpret_cast<u16*>(p.ws + REG_X)));
    if (layer == 0) GSYNC();
  }
}

static void add_job(Params& P, int& nj, int& tile, const float* src, u16* dst, int K, int N, int rsh, int rs, int off, int count, long sstride, long dstride, int f8 = 0, float fscale = 1.0f) {
  ConvJob& J = P.jobs[nj++];
  J.src = src; J.dst = dst; J.sstride = sstride; J.dstride = dstride; J.K = K; J.N = N; J.rs = rs; J.off = off; J.rsh = rsh;
  J.f8 = f8; J.fscale = fscale;
  if (f8) { J.ntn = N / 128; J.tpm = (K / 128) * J.ntn; } else { J.ntn = (N + 255) / 256; J.tpm = (K / 64) * J.ntn; }
  J.tile0 = tile; J.ntiles = J.tpm * count;
  tile += J.ntiles;
}

extern "C" void kernel_launch(void* const* d_in, const int* in_sizes, int n_in,
                              void* d_out, int out_size, void* d_ws, size_t ws_size,
                              hipStream_t stream) {
  constexpr size_t kDynLds = 148480 + 16;
  static int grid_blocks = 0;
  if (!grid_blocks) {
    int dev = 0, cus = 0, per_cu = 0;
    (void)hipGetDevice(&dev);
    (void)hipDeviceGetAttribute(&cus, hipDeviceAttributeMultiprocessorCount, dev);
    (void)hipFuncSetAttribute((const void*)mega, hipFuncAttributeMaxDynamicSharedMemorySize, (int)kDynLds);
    (void)hipOccupancyMaxActiveBlocksPerMultiprocessor(&per_cu, mega, 512, kDynLds);
    if (per_cu > 1) per_cu = 1;
    if (per_cu < 1) { fprintf(stderr, "occupancy query returned 0\n"); per_cu = 1; }
    grid_blocks = cus * per_cu;
    if (ws_size < WS_TOTAL) fprintf(stderr, "workspace too small: %zu < %zu\n", ws_size, (size_t)WS_TOTAL);
  }
  Params P;
  memset(&P, 0, sizeof(P));
  auto F = [&](int i) { return (const float*)d_in[i]; };
  char* ws = (char*)d_ws;
  P.x = F(0); P.p = F(1);
  P.na_rpb = F(3); P.hy_conv_w = F(4); P.hy_conv_b = F(5);
  P.hy_f_w1 = F(6); P.hy_f_b1 = F(7); P.hy_f_freq = F(8); P.hy_f_w2 = F(9); P.hy_f_b2 = F(10); P.hy_f_w3 = F(11); P.hy_skip = F(12);
  P.mla_q_norm = F(15); P.mla_kv_norm = F(17);
  P.ln1_g = F(20); P.ln1_b = F(21); P.ln2_g = F(22); P.ln2_b = F(23);
  P.moe_router = F(24);
  P.out = (float*)d_out; P.ws = ws;
  int nj = 0, tile = 0;
  add_job(P, nj, tile, F(2), (u16*)(ws + W_ABIN), 1024, 3072, 7, 128, 0, 1, 0, 0);
  add_job(P, nj, tile, F(13), (u16*)(ws + W_ABOUT), 1024, 1024, 7, 128, 0, 1, 0, 0);
  add_job(P, nj, tile, F(14), (u16*)(ws + W_MLAIN), 1024, 672, 7, 128, 0, 1, 0, 0);
  add_job(P, nj, tile, F(16), (u16*)(ws + W_QUP), 384, 1536, 7, 128, 0, 1, 0, 0);
  add_job(P, nj, tile, F(18), (u16*)(ws + W_KVUP), 256, 2048, 6, 64, 0, 1, 0, 0);
  P.jobs[nj - 1].sh2 = 1; P.jobs[nj - 1].off2 = 1024;
  add_job(P, nj, tile, F(19), (u16*)(ws + W_MLAOUT), 1024, 1024, 7, 128, 0, 1, 0, 0);
  add_job(P, nj, tile, F(28), (u16*)(ws + W_PLEG), 1024, 1024, 7, 128, 0, 2, 1024L * 1024, 1024L * 1024);
  add_job(P, nj, tile, F(29), (u16*)(ws + W_PLEP), 256, 1024, 7, 128, 0, 2, 256L * 1024, 1024L * 256);
  add_job(P, nj, tile, F(25), (u16*)(ws + W_GU), 1024, 2048, 7, 256, 0, 32, 1024L * 2048, 4096L * 1024, 1, 32.0f);
  add_job(P, nj, tile, F(26), (u16*)(ws + W_GU), 1024, 2048, 7, 256, 128, 32, 1024L * 2048, 4096L * 1024, 1, 32.0f);
  add_job(P, nj, tile, F(27), (u16*)(ws + W_DN), 2048, 1024, 7, 128, 0, 32, 2048L * 1024, 1024L * 2048, 1, 64.0f);
  P.conv_total = tile;
  void* args[] = {&P};
  hipError_t e = hipLaunchCooperativeKernel((void*)mega, dim3(grid_blocks), dim3(512), args, kDynLds, stream);
  if (e != hipSuccess) fprintf(stderr, "cooperative launch failed: %s (grid %d)\n", hipGetErrorString(e), grid_blocks);
}
```

```cpp
#include <hip/hip_runtime.h>
#include <hip/hip_bf16.h>
#include <hip/hip_cooperative_groups.h>
#include <cstdio>
#include <cstring>
namespace cg = cooperative_groups;

typedef unsigned short u16;
using bf16x8 = __attribute__((ext_vector_type(8))) short;
using bf16x4 = __attribute__((ext_vector_type(4))) short;
using f32x4 = __attribute__((ext_vector_type(4))) float;
#define DEV __device__ __forceinline__

constexpr int TOK = 16384, DM = 1024, SEQ = 2048, NBATCH = 8;
constexpr int NEXP = 16, CAP = 256, DFF = 2048;
constexpr float DN_ALPHA = 1.4142135623730951f;
constexpr float LN_EPS = 1e-5f;

constexpr size_t W_ABIN = 0;
constexpr size_t W_ABOUT = W_ABIN + 3072ull * 1024 * 2;
constexpr size_t W_MLAIN = W_ABOUT + 1024ull * 1024 * 2;
constexpr size_t W_QUP = W_MLAIN + 768ull * 1024 * 2;
constexpr size_t W_KVUP = W_QUP + 1536ull * 384 * 2;
constexpr size_t W_MLAOUT = W_KVUP + 2048ull * 256 * 2;
constexpr size_t W_PLEG = W_MLAOUT + 1024ull * 1024 * 2;
constexpr size_t W_PLEP = W_PLEG + 2 * 1024ull * 1024 * 2;
constexpr size_t W_GU = W_PLEP + 2 * 1024ull * 256 * 2;
constexpr size_t W_DN = W_GU + 2 * 16ull * 4096 * 1024 * 2;
constexpr size_t REG_A = W_DN + 2 * 16ull * 1024 * 2048 * 2;
constexpr size_t REG_B = REG_A + 134217728ull;
constexpr size_t REG_C = REG_B + 134217728ull;
constexpr size_t REG_D = REG_C + 67108864ull;
constexpr size_t REG_E = REG_D + 67108864ull;
constexpr size_t REG_G = REG_E + 33554432ull;
constexpr size_t REG_X = REG_G + 67108864ull;
constexpr size_t REG_P = REG_X + 33554432ull;
constexpr size_t S_AFF = REG_P + 16777216ull;
constexpr size_t S_IDX = S_AFF + 1048576ull;
constexpr size_t S_GSEL = S_IDX + 131072ull;
constexpr size_t S_SLOT = S_GSEL + 131072ull;
constexpr size_t S_H2 = S_SLOT + 1048576ull;
constexpr size_t S_RG = S_H2 + 524288ull;
constexpr size_t S_ROPE = S_RG + 8388608ull;
constexpr size_t S_BAR = S_ROPE + 262144ull;
constexpr size_t WS_TOTAL = S_BAR + 16384ull;

struct ConvJob {
  const float* src; u16* dst;
  long sstride, dstride;
  int K, N;
  int rs, off;
  int rsh, sh2, off2, f8;
  float fscale; int padk;
  int ntn;
  int tpm;
  int tile0, ntiles;
};
constexpr int NJOBS = 16;

struct Params {
  const float* x; const float* p;
  const float* na_rpb; const float* hy_conv_w; const float* hy_conv_b;
  const float* hy_f_w1; const float* hy_f_b1; const float* hy_f_freq; const float* hy_f_w2; const float* hy_f_b2;
  const float* hy_f_w3; const float* hy_skip;
  const float* mla_q_norm; const float* mla_kv_norm;
  const float* ln1_g; const float* ln1_b; const float* ln2_g; const float* ln2_b;
  const float* moe_router;
  float* out; char* ws;
  int conv_total; int conv_f8_first;
  ConvJob jobs[NJOBS];
};

extern __shared__ __attribute__((aligned(16))) char smem[];

typedef __bf16 bf16x2_t __attribute__((ext_vector_type(2)));
typedef float f32x2_t __attribute__((ext_vector_type(2)));
DEV unsigned cvt_pk_bf16(float lo, float hi) { f32x2_t f = {lo, hi}; bf16x2_t b = __builtin_convertvector(f, bf16x2_t); return __builtin_bit_cast(unsigned, b); }
DEV u16 f2bf(float f) { return (u16)(cvt_pk_bf16(f, 0.f) & 0xffffu); }
DEV float bf2f(u16 h) { return __uint_as_float(((unsigned)h) << 16); }
DEV unsigned pack2(float a, float b) { return cvt_pk_bf16(a, b); }
DEV unsigned pack4_f8(float a, float b, float c, float d) { int w = 0; w = __builtin_amdgcn_cvt_pk_fp8_f32(a, b, w, false); w = __builtin_amdgcn_cvt_pk_fp8_f32(c, d, w, true); return (unsigned)w; }
DEV float4 bf4_to_f4(uint2 t) { return make_float4(__uint_as_float(t.x << 16), __uint_as_float(t.x & 0xffff0000u), __uint_as_float(t.y << 16), __uint_as_float(t.y & 0xffff0000u)); }
DEV float fsigmoid(float x) { return __builtin_amdgcn_rcpf(1.0f + __builtin_amdgcn_exp2f(-1.4426950408889634f * x)); }
template <int CTRL> DEV float dpp_f(float v) { return __builtin_bit_cast(float, __builtin_amdgcn_update_dpp(0, __builtin_bit_cast(int, v), CTRL, 0xf, 0xf, true)); }
DEV float row_allsum(float v) { v += dpp_f<0xB1>(v); v += dpp_f<0x4E>(v); v += dpp_f<0x141>(v); v += dpp_f<0x140>(v); return v; }
DEV float row_allmax(float v) { v = fmaxf(v, dpp_f<0xB1>(v)); v = fmaxf(v, dpp_f<0x4E>(v)); v = fmaxf(v, dpp_f<0x141>(v)); v = fmaxf(v, dpp_f<0x140>(v)); return v; }
DEV float rdl(float v, int l) { return __builtin_bit_cast(float, __builtin_amdgcn_readlane(__builtin_bit_cast(int, v), l)); }
DEV float wave_sum(float v) { v = row_allsum(v); return (rdl(v, 0) + rdl(v, 16)) + (rdl(v, 32) + rdl(v, 48)); }
DEV int otid() { int t = threadIdx.x; asm volatile("" : "+v"(t)); return t; }
DEV int vstart() {
  int nb = gridDim.x, b = blockIdx.x;
  return (nb % 8 == 0) ? (b % 8) * (nb / 8) + b / 8 : b;
}


#define XB_TMO      128
#define XB_XCNT(j)  (256  + 64 * (j))
#define XB_XSUB(j)  (1280 + 64 * (j))
#define XB_XGEN(j)  (2304 + 64 * (j))
#define XB_TOP      3328
#define XB_TOPGEN   3392
#define XCD_BAR_WORDS 3456
#define XB_SPIN_CAP (1u << 18)
#define LAS __attribute__((address_space(3)))
DEV unsigned xb_ld(unsigned* p) { return __hip_atomic_load(p, __ATOMIC_RELAXED, __HIP_MEMORY_SCOPE_AGENT); }
DEV unsigned xb_add(unsigned* p, unsigned v) { return __hip_atomic_fetch_add(p, v, __ATOMIC_RELAXED, __HIP_MEMORY_SCOPE_AGENT); }
DEV unsigned xb_xcc_id() { return (unsigned)__builtin_amdgcn_s_getreg((3 << 11) | 20) & 0xFu; }
#define XB_SPIN(cond, bar) do { unsigned _sp = 0; while (cond) { __builtin_amdgcn_s_sleep(1); \
    if ((++_sp & 255u) == 0u) { if (xb_ld(&(bar)[XB_TMO])) break; if (_sp > XB_SPIN_CAP) { atomicAdd(&(bar)[XB_TMO], 1u); break; } } } } while (0)
struct XcdBarrier { unsigned* bar; unsigned x; volatile LAS unsigned* st; };
DEV XcdBarrier xcd_barrier_post(unsigned* bar, volatile LAS unsigned* st) {
  XcdBarrier b; b.bar = bar; b.x = xb_xcc_id(); b.st = st;
  if (threadIdx.x == 0) (void)xb_add(&bar[XB_XCNT(b.x)], 1u);
  return b;
}
DEV void xcd_barrier_complete(unsigned* bar, unsigned x, unsigned& nloc, unsigned& nx) {
  const unsigned G = gridDim.x * gridDim.y * gridDim.z;
  unsigned sum, cnt, mine, sp = 0u;
  for (;;) {
    sum = 0u; cnt = 0u; mine = 0u;
#pragma unroll
    for (unsigned j = 0; j < 16; ++j) { const unsigned c = xb_ld(&bar[XB_XCNT(j)]); sum += c; cnt += (c > 0u) ? 1u : 0u; mine = (j == x) ? c : mine; }
    if (sum == G) break;
    __builtin_amdgcn_s_sleep(1);
    if ((++sp & 255u) == 0u) { if (xb_ld(&bar[XB_TMO])) break; if (sp > XB_SPIN_CAP) { atomicAdd(&bar[XB_TMO], 1u); break; } }
  }
  nloc = mine > 0u ? mine : 1u; nx = cnt > 0u ? cnt : 1u;
}
DEV void xcd_barrier(const XcdBarrier& b) {
  asm volatile("s_waitcnt vmcnt(0)" ::: "memory");
  __syncthreads();
  if (threadIdx.x == 0) {
    unsigned* bar = b.bar;
    __builtin_amdgcn_s_waitcnt(0);
    unsigned nloc = b.st[0], nx = b.st[1];
    if (nloc == 0u) { xcd_barrier_complete(bar, b.x, nloc, nx); b.st[0] = nloc; b.st[1] = nx; }
    const unsigned old = xb_add(&bar[XB_XSUB(b.x)], 1u);
    const unsigned gen = old / nloc;
    if (old + 1u == (gen + 1u) * nloc) {
      __builtin_amdgcn_fence(__ATOMIC_RELEASE, "agent");
      asm volatile("s_waitcnt vmcnt(0)" ::: "memory");
      const unsigned og = xb_add(&bar[XB_TOP], 1u);
      const unsigned tg = og / nx;
      if (og + 1u == (tg + 1u) * nx) xb_add(&bar[XB_TOPGEN], 1u);
      else XB_SPIN(xb_ld(&bar[XB_TOPGEN]) == tg, bar);
      __builtin_amdgcn_fence(__ATOMIC_ACQUIRE, "agent");
      xb_add(&bar[XB_XGEN(b.x)], 1u);
      asm volatile("s_waitcnt vmcnt(0)" ::: "memory");
    } else {
      XB_SPIN(xb_ld(&bar[XB_XGEN(b.x)]) == gen, bar);
      __builtin_amdgcn_fence(__ATOMIC_ACQUIRE, "agent");
      asm volatile("s_waitcnt vmcnt(0)" ::: "memory");
    }
  }
  __syncthreads();
}

DEV int lds_byte(int r, int c) {
  int st = (r >> 4) * 2 + (c >> 5), rr = r & 15, cc = c & 31, ob = rr * 64 + cc * 2;
  return st * 1024 + (ob ^ (((ob >> 9) & 1) << 5));
}
DEV void stage_rc(int b, int& R, int& C) {
  int st = b / 1024, sb = b % 1024, swz = sb ^ (((sb >> 9) & 1) << 5);
  R = (st >> 1) * 16 + swz / 64; C = (st & 1) * 32 + (swz % 64) / 2;
}
#define GLDS16(g, l) __builtin_amdgcn_global_load_lds((const unsigned*)(g), (unsigned*)(l), 16, 0, 0)

typedef f32x4 Acc8[2][2][4][2];
constexpr int G8_BM = 256, G8_BK = 64, G8_HALF = 128, G8_HTB = G8_HALF * G8_BK * 2, G8_NXCD = 8, G8_WGM = 8;
DEV int perm32(int rho) { const int n = rho >> 4, i = rho & 15; return 8 * (i >> 2) + 4 * n + (i & 3); }
struct Unit { int pm, pn; };
DEV bool unit_next(int i, int nM, int nN, Unit& u) {
  const int nwg = nM * nN;
  const long L = (long)i * gridDim.x + blockIdx.x; if (L >= nwg) return false;
  int wgid = (int)L; { const int q = nwg / G8_NXCD, r = nwg % G8_NXCD, xcd = wgid % G8_NXCD, off = wgid / G8_NXCD; wgid = (xcd < r ? xcd * (q + 1) : r * (q + 1) + (xcd - r) * q) + off; }
  const int nig = G8_WGM * nN, gid = wgid / nig, fm = gid * G8_WGM, gsz = (nM - fm) < G8_WGM ? (nM - fm) : G8_WGM;
  u.pm = fm + ((wgid % nig) % gsz); u.pn = (wgid % nig) / gsz; return true;
}
typedef int v4i_t __attribute__((ext_vector_type(4)));
typedef int v8i_t __attribute__((ext_vector_type(8)));
template <bool TR, bool PERM, bool F8, class PF, class EF>
DEV void gemm_phase(const int K, const int nM, const int nN, PF ptrs, EF E) {
  LAS unsigned char* lds = (LAS unsigned char*)smem;
  const int tid = otid(), wid = __builtin_amdgcn_readfirstlane(tid >> 6), lane = tid & 63, wr = wid >> 2, wc = wid & 3, fr = lane & 15, fq = lane >> 4;
  const int Kb = F8 ? K : 2 * K;
  const int nt = Kb / 128;
  unsigned voffA[2], voffB[2];
#pragma unroll
  for (int i = 0; i < 2; ++i) { int R, C; stage_rc(tid * 16 + i * 8192, R, C); const int Rb = PERM ? ((R & ~31) + perm32(R & 31)) : R;
    voffA[i] = (unsigned)(R * Kb + C * 2); voffB[i] = (unsigned)(Rb * Kb + C * 2); }
  const size_t kstep = (size_t)(G8_BK * 2);
  const size_t hstep = (size_t)G8_HALF * Kb;
  const unsigned ldsw = (unsigned)wid * 1024u;
  const int aoff = lds_byte(wr * 64 + fr, fq * 8), boff = lds_byte(wc * 32 + fr, fq * 8);
#define PG8_SA(b, h) (((b) * 2 + (h)) * G8_HTB)
#define PG8_SB(b, h) ((4 + (b) * 2 + (h)) * G8_HTB)
#define PG8_STAGE(bufoff, gbase, voff) do { _Pragma("unroll") for (int _i = 0; _i < 2; ++_i) { unsigned _vo = (voff)[_i]; asm volatile("" : "+v"(_vo)); \
    __builtin_amdgcn_global_load_lds((const unsigned*)((const char*)(gbase) + _vo), (LAS unsigned*)(lds + (bufoff) + ldsw + _i * 8192), 16, 0, 0); } } while (0)
#define PG8_LD16(off) (*(const LAS v4i_t*)(lds + (off)))
#define PG8_LDA(dst, b, h) do { if constexpr (F8) { _Pragma("unroll") for (int m = 0; m < 4; ++m) dst##8[m] = __builtin_shufflevector(PG8_LD16(PG8_SA(b, h) + aoff + m * 2048), PG8_LD16(PG8_SA(b, h) + aoff + m * 2048 + 1024), 0, 1, 2, 3, 4, 5, 6, 7); } \
    else { _Pragma("unroll") for (int m = 0; m < 4; ++m) _Pragma("unroll") for (int k = 0; k < 2; ++k) dst[m][k] = *(const LAS bf16x8*)(lds + PG8_SA(b, h) + aoff + m * 2048 + k * 1024); } } while (0)
#define PG8_LDB(dst, b, h) do { if constexpr (F8) { _Pragma("unroll") for (int n = 0; n < 2; ++n) dst##8[n] = __builtin_shufflevector(PG8_LD16(PG8_SB(b, h) + boff + n * 2048), PG8_LD16(PG8_SB(b, h) + boff + n * 2048 + 1024), 0, 1, 2, 3, 4, 5, 6, 7); } \
    else { _Pragma("unroll") for (int n = 0; n < 2; ++n) _Pragma("unroll") for (int k = 0; k < 2; ++k) dst[n][k] = *(const LAS bf16x8*)(lds + PG8_SB(b, h) + boff + n * 2048 + k * 1024); } } while (0)
#define PG8_MMA(ai, bj, At, Bt) do { __builtin_amdgcn_s_setprio(1); \
    if constexpr (F8) { _Pragma("unroll") for (int m = 0; m < 4; ++m) _Pragma("unroll") for (int n = 0; n < 2; ++n) \
        { if constexpr (TR) asm volatile("v_mfma_f32_16x16x128_f8f6f4 %0, %1, %2, %0" : "+v"(acc[ai][bj][m][n]) : "v"(Bt##8[n]), "v"(At##8[m])); \
          else asm volatile("v_mfma_f32_16x16x128_f8f6f4 %0, %1, %2, %0" : "+v"(acc[ai][bj][m][n]) : "v"(At##8[m]), "v"(Bt##8[n])); } } \
    else { _Pragma("unroll") for (int m = 0; m < 4; ++m) _Pragma("unroll") for (int n = 0; n < 2; ++n) _Pragma("unroll") for (int k = 0; k < 2; ++k) \
    acc[ai][bj][m][n] = TR ? __builtin_amdgcn_mfma_f32_16x16x32_bf16(Bt[n][k], At[m][k], acc[ai][bj][m][n], 0, 0, 0) \
                           : __builtin_amdgcn_mfma_f32_16x16x32_bf16(At[m][k], Bt[n][k], acc[ai][bj][m][n], 0, 0, 0); } __builtin_amdgcn_s_setprio(0); } while (0)
#define PG8_WAIT_V(n) asm volatile("s_waitcnt vmcnt(" #n ")" ::: "memory")
#define PG8_WAIT_L(n) asm volatile("s_waitcnt lgkmcnt(" #n ")" ::: "memory")
#define PG8_BAR __builtin_amdgcn_s_barrier()
#define PG8_SCHED __builtin_amdgcn_sched_barrier(0)
  Unit cur, nxt; int ui = 0;
  if (!unit_next(0, nM, nN, cur)) return;
  Acc8 acc;
#pragma unroll
  for (int a = 0; a < 2; ++a)
#pragma unroll
    for (int b = 0; b < 2; ++b)
#pragma unroll
      for (int m = 0; m < 4; ++m)
#pragma unroll
        for (int n = 0; n < 2; ++n) acc[a][b][m][n] = f32x4{0.f, 0.f, 0.f, 0.f};
  bf16x8 At[4][2], B0[2][2], B1[2][2];
  v8i_t At8[4], B08[2], B18[2];
  const char* cA; const char* cB;
  ptrs(cur, cA, cB);
  PG8_STAGE(PG8_SB(0, 0), cB, voffB); PG8_STAGE(PG8_SA(0, 0), cA, voffA); PG8_STAGE(PG8_SB(0, 1), cB + hstep, voffB); PG8_STAGE(PG8_SA(0, 1), cA + hstep, voffA);
  if (wr == 1) PG8_BAR;
  PG8_WAIT_V(4); PG8_BAR;
  PG8_STAGE(PG8_SB(1, 0), cB + kstep, voffB); PG8_STAGE(PG8_SA(1, 0), cA + kstep, voffA); PG8_STAGE(PG8_SB(1, 1), cB + hstep + kstep, voffB);
  PG8_WAIT_V(6); PG8_BAR;
  for (;;) {
    const bool has_next = unit_next(ui + 1, nM, nN, nxt);
    const char* nA = cA; const char* nB = cB;
    if (has_next) ptrs(nxt, nA, nB);
#pragma unroll 1
    for (int t = 0; t < nt; t += 2) {
      const bool last = (t == nt - 2);
      const char* a1 = cA + (size_t)(t + 1) * kstep;
      const char* a2 = last ? nA : cA + (size_t)(t + 2) * kstep; const char* b2 = last ? nB : cB + (size_t)(t + 2) * kstep;
      const char* a3 = a2 + kstep; const char* b3 = b2 + kstep;
      PG8_LDB(B0, 0, 0); PG8_SCHED; PG8_LDA(At, 0, 0); PG8_STAGE(PG8_SA(1, 1), a1 + hstep, voffA);
      PG8_WAIT_L(8); PG8_BAR; PG8_WAIT_L(0); PG8_MMA(0, 0, At, B0); PG8_BAR; PG8_SCHED;
      PG8_LDB(B1, 0, 1); PG8_STAGE(PG8_SB(0, 0), b2, voffB);
      PG8_BAR; PG8_WAIT_L(0); PG8_MMA(0, 1, At, B1); PG8_BAR;
      PG8_LDA(At, 0, 1); PG8_STAGE(PG8_SA(0, 0), a2, voffA);
      PG8_BAR; PG8_WAIT_L(0); PG8_MMA(1, 0, At, B0); PG8_BAR; PG8_SCHED;
      PG8_STAGE(PG8_SB(0, 1), b2 + hstep, voffB);
      PG8_WAIT_V(6); PG8_BAR; PG8_MMA(1, 1, At, B1); PG8_BAR;
      PG8_LDB(B0, 1, 0); PG8_SCHED; PG8_LDA(At, 1, 0); PG8_STAGE(PG8_SA(0, 1), a2 + hstep, voffA);
      PG8_WAIT_L(8); PG8_BAR; PG8_WAIT_L(0); PG8_MMA(0, 0, At, B0); PG8_BAR; PG8_SCHED;
      PG8_LDB(B1, 1, 1); PG8_STAGE(PG8_SB(1, 0), b3, voffB);
      PG8_BAR; PG8_WAIT_L(0); PG8_MMA(0, 1, At, B1); PG8_BAR;
      PG8_LDA(At, 1, 1); PG8_STAGE(PG8_SA(1, 0), a3, voffA);
      PG8_BAR; PG8_WAIT_L(0); PG8_MMA(1, 0, At, B0); PG8_BAR; PG8_SCHED;
      PG8_STAGE(PG8_SB(1, 1), b3 + hstep, voffB);
      PG8_WAIT_V(6); PG8_BAR; PG8_MMA(1, 1, At, B1); PG8_BAR;
    }
    if constexpr (F8) asm volatile("s_nop 15\n\ts_nop 15" ::: "memory");
    { const int l2 = otid() & 63; E(acc, cur, wr, wc, l2 & 15, l2 >> 4); }
    if (!has_next) break;
#pragma unroll
    for (int a = 0; a < 2; ++a)
#pragma unroll
      for (int b = 0; b < 2; ++b)
#pragma unroll
        for (int m = 0; m < 4; ++m)
#pragma unroll
          for (int n = 0; n < 2; ++n) acc[a][b][m][n] = f32x4{0.f, 0.f, 0.f, 0.f};
    cur = nxt; cA = nA; cB = nB; ++ui;
  }
  PG8_WAIT_V(0);
  if (wr == 0) PG8_BAR;
  PG8_BAR;
#undef PG8_SA
#undef PG8_SB
#undef PG8_STAGE
#undef PG8_LDA
#undef PG8_LD16
#undef PG8_LDB
#undef PG8_MMA
#undef PG8_WAIT_V
#undef PG8_WAIT_L
#undef PG8_BAR
#undef PG8_SCHED
}
#define E8_FOR _Pragma("unroll") for (int ai = 0; ai < 2; ++ai) _Pragma("unroll") for (int m = 0; m < 4; ++m) _Pragma("unroll") for (int bj = 0; bj < 2; ++bj)

DEV void conv_tile(const ConvJob& J, int t) {
  const int tid = otid();
  int mat = t / J.tpm, tt = t % J.tpm;
  int kt = tt / J.ntn, nt = tt % J.ntn;
  const float* src = J.src + (long)mat * J.sstride;
  u16* dst = J.dst + (long)mat * J.dstride;
  const int kg = tid >> 6, ng = tid & 63;
  const int n = nt * 256 + ng * 4;
  float4 v[8];
#pragma unroll
  for (int j = 0; j < 8; ++j) {
    int k = kt * 64 + kg * 8 + j;
    if (n < J.N) v[j] = *reinterpret_cast<const float4*>(src + (long)k * J.N + n);
    else v[j] = make_float4(0.f, 0.f, 0.f, 0.f);
  }
#pragma unroll
  for (int i = 0; i < 4; ++i) {
    float e[8];
#pragma unroll
    for (int j = 0; j < 8; ++j) e[j] = (i == 0) ? v[j].x : (i == 1) ? v[j].y : (i == 2) ? v[j].z : v[j].w;
    uint4 pk;
    pk.x = pack2(e[0], e[1]); pk.y = pack2(e[2], e[3]); pk.z = pack2(e[4], e[5]); pk.w = pack2(e[6], e[7]);
    *reinterpret_cast<uint4*>(smem + (i * 64 + ng) * 144 + kg * 16) = pk;
  }
  __syncthreads();
#pragma unroll
  for (int u = 0; u < 4; ++u) {
    int q = tid + 512 * u;
    int nl = q >> 3, ch = q & 7;
    uint4 pk = *reinterpret_cast<const uint4*>(smem + ((nl & 3) * 64 + (nl >> 2)) * 144 + ch * 16);
    int nn = nt * 256 + nl;
    const int qq = nn >> J.rsh;
    long drow = (long)(qq >> J.sh2) * J.rs + (qq & ((1 << J.sh2) - 1)) * J.off2 + (nn & ((1 << J.rsh) - 1)) + J.off;
    *reinterpret_cast<uint4*>(dst + drow * J.K + kt * 64 + ch * 8) = pk;
  }
  __syncthreads();
}

struct F8Tile { const float* src; unsigned char* dst; int N, K, kt, nt, rsh, sh2, rs, off2, off; float sc; };
DEV void f8_decode(const Params& p, int t, F8Tile& T) {
  int j = 0;
#pragma unroll 1
  for (int q = 1; q < NJOBS; ++q) if (t >= p.jobs[q].tile0 && p.jobs[q].ntiles > 0) j = q;
  const ConvJob& J = p.jobs[j];
  const int tl = t - J.tile0;
  const int mat = tl / J.tpm, tt = tl % J.tpm;
  T.kt = tt / J.ntn; T.nt = tt % J.ntn;
  T.src = J.src + (long)mat * J.sstride;
  T.dst = reinterpret_cast<unsigned char*>(J.dst) + (long)mat * J.dstride;
  T.N = J.N; T.K = J.K; T.rsh = J.rsh; T.sh2 = J.sh2; T.rs = J.rs; T.off2 = J.off2; T.off = J.off; T.sc = J.fscale;
}
DEV void f8_load(const F8Tile& T, float4 (&v)[8]) {
  const int tid = otid(), kg = tid >> 5, ng = tid & 31;
  const float* s0 = T.src + (long)(T.kt * 128 + kg * 8) * T.N + T.nt * 128 + ng * 4;
#pragma unroll
  for (int j = 0; j < 8; ++j) v[j] = *reinterpret_cast<const float4*>(s0 + (long)j * T.N);
}
DEV void f8_emit(const F8Tile& T, const float4 (&v)[8], char* img) {
  const int tid = otid(), kg = tid >> 5, ng = tid & 31;
#pragma unroll
  for (int i = 0; i < 4; ++i) {
    float e[8];
#pragma unroll
    for (int j = 0; j < 8; ++j) e[j] = ((i == 0) ? v[j].x : (i == 1) ? v[j].y : (i == 2) ? v[j].z : v[j].w) * T.sc;
    uint2 pk; pk.x = pack4_f8(e[0], e[1], e[2], e[3]); pk.y = pack4_f8(e[4], e[5], e[6], e[7]);
    *reinterpret_cast<uint2*>(img + (i * 32 + ng) * 144 + kg * 8) = pk;
  }
  __syncthreads();
#pragma unroll
  for (int u = 0; u < 2; ++u) {
    int q = tid + 512 * u;
    int nl = q >> 3, ch = q & 7;
    uint4 pk = *reinterpret_cast<const uint4*>(img + ((nl & 3) * 32 + (nl >> 2)) * 144 + ch * 16);
    int nn = T.nt * 128 + nl;
    const int qq = nn >> T.rsh;
    long drow = (long)(qq >> T.sh2) * T.rs + (qq & ((1 << T.sh2) - 1)) * T.off2 + (nn & ((1 << T.rsh) - 1)) + T.off;
    *reinterpret_cast<uint4*>(T.dst + drow * T.K + T.kt * 128 + ch * 16) = pk;
  }
}
DEV void f8_stream(const Params& p, int first, int total) {
  const int nb = gridDim.x;
  int t = first + blockIdx.x;
  if (t >= total) return;
  float4 va[8], vb[8];
  F8Tile Ta, Tb;
  f8_decode(p, t, Ta); f8_load(Ta, va);
  __syncthreads();
  for (;;) {
    int tn = t + nb;
    f8_decode(p, min(tn, total - 1), Tb); f8_load(Tb, vb);
    f8_emit(Ta, va, smem);
    if (tn >= total) break;
    t = tn; tn = t + nb;
    f8_decode(p, min(tn, total - 1), Ta); f8_load(Ta, va);
    f8_emit(Tb, vb, smem + 18432);
    if (tn >= total) break;
    t = tn;
  }
  __syncthreads();
}

DEV void phase_prep(const Params& p) {
  const int tid = otid(), nb = gridDim.x, bid = blockIdx.x;
  {
    float* zb = reinterpret_cast<float*>(smem);
    float* h1b = zb + 512;
    float* h2g = reinterpret_cast<float*>(p.ws + S_H2);
    const int w = tid >> 6, lane = tid & 63;
    for (int l0 = bid * 8; l0 < SEQ; l0 += nb * 8) {
      int l = l0 + w;
      float tt = (float)l / (float)(SEQ - 1);
      float ww = 6.283185307179586f * (float)l / (float)SEQ;
      float z = 0.f;
      if (lane == 0) z = tt;
      else if (lane <= 16) { float f = 1e-4f + (float)(lane - 1) * ((15.0f - 1e-4f) / 15.0f); z = cosf(f * ww); }
      else if (lane <= 32) { float f = 1e-4f + (float)(lane - 17) * ((15.0f - 1e-4f) / 15.0f); z = -sinf(f * ww); }
      zb[w * 64 + lane] = z;
      __syncthreads();
      float fr_ = p.hy_f_freq[lane];
      float a = p.hy_f_b1[lane];
      for (int k = 0; k < 33; ++k) a += zb[w * 64 + k] * p.hy_f_w1[k * 64 + lane];
      h1b[w * 64 + lane] = sinf(fr_ * a);
      __syncthreads();
      float a2 = p.hy_f_b2[lane];
      for (int k = 0; k < 64; ++k) a2 += h1b[w * 64 + k] * p.hy_f_w2[k * 64 + lane];
      h2g[l * 64 + lane] = sinf(fr_ * a2);
      __syncthreads();
    }
  }
  {
    float2* rt = reinterpret_cast<float2*>(p.ws + S_ROPE);
    for (int i = bid * 512 + tid; i < SEQ * 16; i += nb * 512) {
      const int l = i >> 4, k = i & 15;
      float sn, cs; sincosf((float)l * (1.0f / powf(10000.0f, (float)k / 16.0f)), &sn, &cs);
      rt[i] = make_float2(cs, sn);
    }
  }
  {
    u16* xb = reinterpret_cast<u16*>(p.ws + REG_X);
    const long n8 = (long)TOK * DM / 8;
#pragma unroll 4
    for (long i = (long)bid * 512 + tid; i < n8; i += (long)nb * 512) {
      float4 a = reinterpret_cast<const float4*>(p.x)[2 * i], b = reinterpret_cast<const float4*>(p.x)[2 * i + 1];
      uint4 pk; pk.x = pack2(a.x, a.y); pk.y = pack2(a.z, a.w); pk.z = pack2(b.x, b.y); pk.w = pack2(b.z, b.w);
      reinterpret_cast<uint4*>(xb)[i] = pk;
    }
    u16* pb = reinterpret_cast<u16*>(p.ws + REG_P);
    const long m8 = 2L * TOK * 256 / 8;
#pragma unroll 4
    for (long i = (long)bid * 512 + tid; i < m8; i += (long)nb * 512) {
      float4 a = reinterpret_cast<const float4*>(p.p)[2 * i], b = reinterpret_cast<const float4*>(p.p)[2 * i + 1];
      uint4 pk; pk.x = pack2(a.x, a.y); pk.y = pack2(a.z, a.w); pk.z = pack2(b.x, b.y); pk.w = pack2(b.z, b.w);
      reinterpret_cast<uint4*>(pb)[i] = pk;
    }
  }
  for (int t = bid; t < p.conv_f8_first; t += nb) {
    int j = 0;
#pragma unroll 1
    for (int q = 1; q < NJOBS; ++q) if (t >= p.jobs[q].tile0 && p.jobs[q].ntiles > 0) j = q;
    conv_tile(p.jobs[j], t - p.jobs[j].tile0);
  }
  f8_stream(p, p.conv_f8_first, p.conv_total);
}

DEV void filter_b(const Params& p, int cpair) {
  const int tid = otid();
  float* w3s = reinterpret_cast<float*>(smem);
  float* red = w3s + 512;
  float* nrm = red + 32;
  float* hb = nrm + 4;
  const float* h2g = reinterpret_cast<const float*>(p.ws + S_H2);
  {
    int ci = tid >> 6, k = tid & 63;
    int o = ci >> 2, d = (ci >> 1) & 1, cc = ci & 1;
    w3s[ci * 64 + k] = p.hy_f_w3[k * 2048 + o * 1024 + d * 512 + 2 * cpair + cc];
  }
  __syncthreads();
  const float min_decay = logf(1e-2f) / 1.5f, max_decay = logf(1e-2f) / 0.3f;
#pragma unroll 1
  for (int i = 0; i < 4; ++i) {
    int l = tid + 512 * i;
    float h2[64];
#pragma unroll
    for (int k = 0; k < 16; ++k) {
      float4 v = *reinterpret_cast<const float4*>(h2g + l * 64 + k * 4);
      h2[4 * k] = v.x; h2[4 * k + 1] = v.y; h2[4 * k + 2] = v.z; h2[4 * k + 3] = v.w;
    }
    float tt = (float)l / (float)(SEQ - 1);
#pragma unroll 1
    for (int ci = 0; ci < 8; ++ci) {
      float a = 0.f;
#pragma unroll
      for (int k = 0; k < 64; ++k) a += h2[k] * w3s[ci * 64 + k];
      int cc = ci & 1;
      int c = 2 * cpair + cc;
      float delta = fabsf(min_decay + (float)c * ((max_decay - min_decay) / 511.0f));
      a *= expf(-tt * delta);
      hb[ci * 2048 + l] = a;
    }
  }
  __syncthreads();
  {
    float ss[4];
#pragma unroll
    for (int oc = 0; oc < 4; ++oc) {
      int o = oc >> 1, cc = oc & 1;
      float a = 0.f;
      for (int l = tid; l < 2048; l += 512) {
        float f = hb[(o * 4 + 0 + cc) * 2048 + l];
        float b = (l > 0) ? hb[(o * 4 + 2 + cc) * 2048 + l] : 0.f;
        a += f * f + b * b;
      }
      ss[oc] = wave_sum(a);
    }
    if ((tid & 63) == 0) {
#pragma unroll
      for (int q = 0; q < 4; ++q) red[(tid >> 6) * 4 + q] = ss[q];
    }
  }
  __syncthreads();
  if (tid < 4) {
    float s = 0.f;
    for (int w = 0; w < 8; ++w) s += red[w * 4 + tid];
    nrm[tid] = rsqrtf(s + 1e-12f);
  }
  __syncthreads();
  u16* Rg = reinterpret_cast<u16*>(p.ws + S_RG);
  for (int q = tid; q < 4 * 4096; q += 512) {
    int oc = q >> 12, qq = q & 4095;
    int o = oc >> 1, cc = oc & 1;
    float v;
    if (qq == 0) v = 0.f;
    else if (qq <= 2048) v = hb[(o * 4 + 0 * 2 + cc) * 2048 + (2048 - qq)];
    else v = hb[(o * 4 + 1 * 2 + cc) * 2048 + (qq - 2048)];
    v *= nrm[oc];
    Rg[((long)o * 512 + 2 * cpair + cc) * 4096 + qq] = f2bf(v);
  }
  __syncthreads();
}

DEV void phase_abin(const Params& p) {
  const int nb = gridDim.x;
  for (int c = blockIdx.x; c < 256; c += nb) filter_b(p, c);
  const u16* xb = reinterpret_cast<const u16*>(p.ws + REG_X);
  const u16* wt = reinterpret_cast<const u16*>(p.ws + W_ABIN);
  u16* qk = reinterpret_cast<u16*>(p.ws + REG_B);
  u16* vht = reinterpret_cast<u16*>(p.ws + REG_B + 33554432ull);
  gemm_phase<true, true, false>(1024, 64, 4, [&](const Unit& u, const char*& a, const char*& b) { a = (const char*)(xb) + (size_t)u.pm * 256 * (1024) * 2; b = (const char*)(wt) + (size_t)u.pn * 256 * (1024) * 2; },
      [&](Acc8& acc, const Unit& u, int wr, int wc, int fr, int fq) {
        const float sc = (u.pn < 2) ? 0.125f : 1.0f;
        u16* base = qk + (long)(u.pm * 256 + wr * 64 + fr) * 1024 + u.pn * 256 + wc * 32 + 8 * fq;
        E8_FOR {
          f32x4 v0 = acc[ai][bj][m][0], v1 = acc[ai][bj][m][1];
          uint4 pk;
          pk.x = cvt_pk_bf16(v0[0] * sc, v0[1] * sc); pk.y = cvt_pk_bf16(v0[2] * sc, v0[3] * sc);
          pk.z = cvt_pk_bf16(v1[0] * sc, v1[1] * sc); pk.w = cvt_pk_bf16(v1[2] * sc, v1[3] * sc);
          *reinterpret_cast<uint4*>(base + (ai * 128 + m * 16) * 1024 + bj * 128) = pk;
        }
      });
  gemm_phase<false, false, false>(1024, 64, 8, [&](const Unit& u, const char*& a, const char*& b) { a = (const char*)(xb) + (size_t)u.pm * 256 * (1024) * 2; b = (const char*)(wt + 1024 * 1024) + (size_t)u.pn * 256 * (1024) * 2; },
      [&](Acc8& acc, const Unit& u, int wr, int wc, int fr, int fq) {
        u16* base = vht + (long)(u.pn * 256 + wc * 32 + fr) * TOK + u.pm * 256 + wr * 64 + 4 * fq;
        E8_FOR {
#pragma unroll
          for (int n = 0; n < 2; ++n) {
            f32x4 v = acc[ai][bj][m][n];
            uint2 pk; pk.x = cvt_pk_bf16(v[0], v[1]); pk.y = cvt_pk_bf16(v[2], v[3]);
            *reinterpret_cast<uint2*>(base + (long)(bj * 128 + n * 16) * TOK + ai * 128 + m * 16) = pk;
          }
        }
      });
}

constexpr int NA_VST = 580;
constexpr int NA_V_OFF = 576 * 128;
DEV void na_pair(const Params& p, int u) {
  const int tid = otid(), lane = tid & 63, wid = tid >> 6, fr = lane & 15, fq = lane >> 4;
  const int rp = u & 15, h = (u >> 4) & 7, b = u >> 7;
  const int rbase = min(max(2 * rp - 4, 0), 24);
  const int nrows = (rbase == 24) ? 8 : 9;
  const u16* qk = reinterpret_cast<const u16*>(p.ws + REG_B);
  const u16* vht = reinterpret_cast<const u16*>(p.ws + REG_B + 33554432ull);
  u16* cat = reinterpret_cast<u16*>(p.ws + REG_A + 100663296ull);
  char* kl = smem;
  u16* vl = reinterpret_cast<u16*>(smem + NA_V_OFF);
  const long tok0 = (long)b * SEQ + rbase * 64;
  __syncthreads();
#pragma unroll
  for (int i = 0; i < 9; ++i) {
    const int q = tid + 512 * i, key = q >> 3, ch = q & 7;
    if (key < nrows * 64) {
      uint4 v = *reinterpret_cast<const uint4*>(qk + (tok0 + key) * 1024 + 512 + h * 64 + ch * 8);
      *reinterpret_cast<uint4*>(kl + key * 128 + ((ch ^ ((key >> 1) & 7)) << 4)) = v;
    }
  }
#pragma unroll
  for (int i = 0; i < 9; ++i) {
    const int q = tid + 512 * i, d = q / 72, ch = q % 72;
    if (ch < nrows * 8) {
      uint4 v = *reinterpret_cast<const uint4*>(vht + (long)(h * 64 + d) * TOK + tok0 + ch * 8);
      u16* dst = vl + d * NA_VST + ch * 8;
      *reinterpret_cast<uint2*>(dst) = make_uint2(v.x, v.y);
      *reinterpret_cast<uint2*>(dst + 4) = make_uint2(v.z, v.w);
    }
  }
  __syncthreads();
  const int g = wid & 3, r = 2 * rp + (wid >> 2);
  const int r0 = min(max(r - 4, 0), 24), ro = r0 - rbase, cs = min(max(16 * g - 8, 0), 32);
  const int c = 16 * g + fr;
  const long tokq = (long)b * SEQ + r * 64 + c;
  bf16x8 qf[2];
#pragma unroll
  for (int ks = 0; ks < 2; ++ks) qf[ks] = *reinterpret_cast<const bf16x8*>(qk + tokq * 1024 + h * 64 + ks * 32 + fq * 8);
  f32x4 s[16];
#pragma unroll
  for (int kt = 0; kt < 16; ++kt) {
    const int w = kt >> 1, half = kt & 1;
    const int key = (ro + w) * 64 + cs + 16 * half + fr;
    const int sw = (key >> 1) & 7;
    bf16x8 k0 = *reinterpret_cast<const bf16x8*>(kl + key * 128 + ((fq ^ sw) << 4));
    bf16x8 k1 = *reinterpret_cast<const bf16x8*>(kl + key * 128 + (((4 + fq) ^ sw) << 4));
    f32x4 a = {0.f, 0.f, 0.f, 0.f};
    a = __builtin_amdgcn_mfma_f32_16x16x32_bf16(k0, qf[0], a, 0, 0, 0);
    a = __builtin_amdgcn_mfma_f32_16x16x32_bf16(k1, qf[1], a, 0, 0, 0);
    s[kt] = a;
  }
  const int c0 = min(max(c - 8, 0), 48);
  const float* rpb = p.na_rpb + h * 15 * 31;
  float mx = -1e30f;
#pragma unroll
  for (int kt = 0; kt < 16; ++kt) {
    const int w = kt >> 1, half = kt & 1;
    const int dr = r0 + w - r + 7;
#pragma unroll
    for (int j = 0; j < 4; ++j) {
      int kc = cs + 16 * half + 4 * fq + j;
      bool valid = (kc >= c0) && (kc < c0 + 16);
      int dc = min(max(kc - c, -15), 15) + 15;
      float bias = rpb[dr * 31 + dc];
      float v = valid ? (s[kt][j] + bias) : -1e30f;
      s[kt][j] = v;
      mx = fmaxf(mx, v);
    }
  }
  mx = fmaxf(mx, __shfl_xor(mx, 16));
  mx = fmaxf(mx, __shfl_xor(mx, 32));
  float sum = 0.f;
#pragma unroll
  for (int kt = 0; kt < 16; ++kt)
#pragma unroll
    for (int j = 0; j < 4; ++j) { float e = __expf(s[kt][j] - mx); s[kt][j] = e; sum += e; }
  sum += __shfl_xor(sum, 16);
  sum += __shfl_xor(sum, 32);
  f32x4 o[4];
#pragma unroll
  for (int dt = 0; dt < 4; ++dt) o[dt] = f32x4{0.f, 0.f, 0.f, 0.f};
#pragma unroll
  for (int w = 0; w < 8; ++w) {
    union { bf16x8 v; unsigned u[4]; } pf;
    pf.u[0] = cvt_pk_bf16(s[2 * w][0], s[2 * w][1]); pf.u[1] = cvt_pk_bf16(s[2 * w][2], s[2 * w][3]);
    pf.u[2] = cvt_pk_bf16(s[2 * w + 1][0], s[2 * w + 1][1]); pf.u[3] = cvt_pk_bf16(s[2 * w + 1][2], s[2 * w + 1][3]);
#pragma unroll
    for (int dt = 0; dt < 4; ++dt) {
      const u16* vp = vl + (dt * 16 + fr) * NA_VST + (ro + w) * 64 + cs + 4 * fq;
      union { bf16x8 v; uint2 u[2]; } af;
      af.u[0] = *reinterpret_cast<const uint2*>(vp);
      af.u[1] = *reinterpret_cast<const uint2*>(vp + 16);
      o[dt] = __builtin_amdgcn_mfma_f32_16x16x32_bf16(af.v, pf.v, o[dt], 0, 0, 0);
    }
  }
  const float inv = 1.0f / sum;
#pragma unroll
  for (int dt = 0; dt < 4; ++dt) {
    uint2 pk; pk.x = pack2(o[dt][0] * inv, o[dt][1] * inv); pk.y = pack2(o[dt][2] * inv, o[dt][3] * inv);
    *reinterpret_cast<uint2*>(cat + tokq * 1024 + h * 64 + dt * 16 + 4 * fq) = pk;
  }
}

constexpr int UB_STRIDE = 2056;
constexpr int RC_STRIDE = 4120;
constexpr int HY_RC_OFF = 2 * NBATCH * UB_STRIDE * 2;
DEV float shortconv(const u16* hrow, const float* cw, float cb, int ch, int t) {
  float xm = (t > 0) ? bf2f(hrow[t - 1]) : 0.f;
  float x0 = bf2f(hrow[t]);
  float xp = (t < SEQ - 1) ? bf2f(hrow[t + 1]) : 0.f;
  return cb + xm * cw[ch] + x0 * cw[1536 + ch] + xp * cw[2 * 1536 + ch];
}
DEV void load_rc(const Params& p, int o, int c) {
  const int tid = otid();
  char* rc = smem + HY_RC_OFF;
  const u16* Rg = reinterpret_cast<const u16*>(p.ws + S_RG) + ((long)o * 512 + c) * 4096;
  const float skip = p.hy_skip[o * 512 + c];
  const int i0 = tid * 8;
  uint4 lo = *reinterpret_cast<const uint4*>(Rg + i0);
  uint4 hi = (tid < 511) ? *reinterpret_cast<const uint4*>(Rg + i0 + 8) : make_uint4(0u, 0u, 0u, 0u);
  unsigned w[8] = {lo.x, lo.y, lo.z, lo.w, hi.x, hi.y, hi.z, hi.w};
  if (tid == 256) w[0] = (w[0] & 0xffff0000u) | (unsigned)f2bf(bf2f((u16)(w[0] & 0xffffu)) + skip);
  if (tid == 255) w[4] = (w[4] & 0xffff0000u) | (unsigned)f2bf(bf2f((u16)(w[4] & 0xffffu)) + skip);
#pragma unroll
  for (int m = 0; m < 8; ++m) {
    uint4 o4;
    if (m & 1) {
      o4.x = __builtin_amdgcn_alignbyte(w[m / 2 + 1], w[m / 2], 2);
      o4.y = __builtin_amdgcn_alignbyte(w[m / 2 + 2], w[m / 2 + 1], 2);
      o4.z = __builtin_amdgcn_alignbyte(w[m / 2 + 3], w[m / 2 + 2], 2);
      o4.w = __builtin_amdgcn_alignbyte(w[m / 2 + 4], w[m / 2 + 3], 2);
    } else {
      o4.x = w[m / 2]; o4.y = w[m / 2 + 1]; o4.z = w[m / 2 + 2]; o4.w = w[m / 2 + 3];
    }
    *reinterpret_cast<uint4*>(rc + m * (RC_STRIDE * 2) + i0 * 2) = o4;
  }
}
DEV void hyena_conv(const u16* ub, f32x4 (&acc)[16]) {
  const int lane = otid() & 63, wid = __builtin_amdgcn_readfirstlane(otid() >> 6), fr = lane & 15, fq = lane >> 4;
  const int mcopy = (-wid) & 7;
  const u16* rbase = reinterpret_cast<const u16*>(smem + HY_RC_OFF) + mcopy * RC_STRIDE + (8 * fq - 8 * fr + 2048 - (wid + mcopy));
#pragma unroll
  for (int i = 0; i < 16; ++i) acc[i] = f32x4{0.f, 0.f, 0.f, 0.f};
  const u16* urow = ub + (fr & 7) * UB_STRIDE + fq * 8;
#pragma unroll 1
  for (int r = 0; r < 4; ++r) {
    bf16x8 Bf[16];
#pragma unroll
    for (int i = 0; i < 16; ++i) Bf[i] = *reinterpret_cast<const bf16x8*>(urow + (r + 4 * i) * 32);
    const u16* rk = rbase + 32 * r;
#pragma unroll
    for (int e = -15; e <= 15; ++e) {
      const bf16x8 af = *reinterpret_cast<const bf16x8*>(rk + 128 * e);
#pragma unroll
      for (int T = 0; T < 16; ++T) {
        const int i = e + T;
        if (i >= 0 && i < 16) acc[T] = __builtin_amdgcn_mfma_f32_16x16x32_bf16(af, Bf[i], acc[T], 0, 0, 0);
      }
    }
  }
}
DEV void shortconv_pass(const u16* __restrict__ hrow  , u16* ub, const float* cw, float cb, int ch) {
  const float w0 = cw[ch], w1 = cw[1536 + ch], w2 = cw[2 * 1536 + ch];
#pragma unroll
  for (int q4 = 0; q4 < TOK / 8 / 512; ++q4) {
    const int q = otid() + 512 * q4;
    const int i = q * 8, b = i >> 11, t = i & 2047;
    uint4 v = *reinterpret_cast<const uint4*>(hrow + i);
    float x[10];
    x[0] = (t > 0) ? bf2f(hrow[i - 1]) : 0.f;
    x[9] = (t + 8 < SEQ) ? bf2f(hrow[i + 8]) : 0.f;
    x[1] = __uint_as_float(v.x << 16); x[2] = __uint_as_float(v.x & 0xffff0000u);
    x[3] = __uint_as_float(v.y << 16); x[4] = __uint_as_float(v.y & 0xffff0000u);
    x[5] = __uint_as_float(v.z << 16); x[6] = __uint_as_float(v.z & 0xffff0000u);
    x[7] = __uint_as_float(v.w << 16); x[8] = __uint_as_float(v.w & 0xffff0000u);
    float y[8];
#pragma unroll
    for (int j = 0; j < 8; ++j) y[j] = cb + x[j] * w0 + x[j + 1] * w1 + x[j + 2] * w2;
    uint4 o4; o4.x = pack2(y[0], y[1]); o4.y = pack2(y[2], y[3]); o4.z = pack2(y[4], y[5]); o4.w = pack2(y[6], y[7]);
    *reinterpret_cast<uint4*>(ub + b * UB_STRIDE + t) = o4;
  }
}
DEV void hyena_unit(const Params& p, int c) {
  const int tid = otid(), lane = tid & 63, wid = tid >> 6, fr = lane & 15, fq = lane >> 4;
  u16* ubA = reinterpret_cast<u16*>(smem);
  u16* ubB = ubA + NBATCH * UB_STRIDE;
  const u16* hbt = reinterpret_cast<const u16*>(p.ws + REG_B + 33554432ull) + 512L * TOK;
  u16* zT = reinterpret_cast<u16*>(p.ws + REG_C);
  const float* cw = p.hy_conv_w;
  shortconv_pass(hbt + (long)c * TOK, ubA, cw, p.hy_conv_b[c], c);
  shortconv_pass(hbt + (long)(512 + c) * TOK, ubB, cw, p.hy_conv_b[512 + c], 512 + c);
  load_rc(p, 0, c);
  __syncthreads();
  f32x4 acc[16];
  hyena_conv(ubA, acc);
  if (fr < 8) {
#pragma unroll
    for (int T = 0; T < 16; ++T)
#pragma unroll
      for (int j = 0; j < 4; ++j) {
        const int t = 128 * T + wid + 8 * (4 * fq + j);
        u16* q = ubB + fr * UB_STRIDE + t;
        *q = f2bf(bf2f(*q) * acc[T][j]);
      }
  }
  __syncthreads();
  shortconv_pass(hbt + (long)(1024 + c) * TOK, ubA, cw, p.hy_conv_b[1024 + c], 1024 + c);
  load_rc(p, 1, c);
  __syncthreads();
  hyena_conv(ubB, acc);
  if (fr < 8) {
#pragma unroll
    for (int T = 0; T < 16; ++T)
#pragma unroll
      for (int j = 0; j < 4; ++j) {
        const int t = 128 * T + wid + 8 * (4 * fq + j);
        u16* q = ubA + fr * UB_STRIDE + t;
        *q = f2bf(bf2f(*q) * acc[T][j]);
      }
  }
  __syncthreads();
#pragma unroll
  for (int q4 = 0; q4 < TOK / 8 / 512; ++q4) {
    const int q = tid + 512 * q4;
    const int i = q * 8, b = i >> 11, t = i & 2047;
    *reinterpret_cast<uint4*>(zT + (long)c * TOK + i) = *reinterpret_cast<const uint4*>(ubA + b * UB_STRIDE + t);
  }
  __syncthreads();
}
DEV void phase_ztrans(const Params& p) {
  const int tid = otid();
  const u16* zT = reinterpret_cast<const u16*>(p.ws + REG_C);
  u16* cat = reinterpret_cast<u16*>(p.ws + REG_A + 100663296ull);
  u16* tile = reinterpret_cast<u16*>(smem);
  for (int tb = blockIdx.x; tb < TOK / 64; tb += gridDim.x) {
    __syncthreads();
    const u16* src = zT + (long)tid * TOK + tb * 64;
#pragma unroll
    for (int k = 0; k < 8; ++k) *reinterpret_cast<uint4*>(tile + tid * 72 + k * 8) = *reinterpret_cast<const uint4*>(src + k * 8);
    __syncthreads();
#pragma unroll
    for (int k = 0; k < 8; ++k) {
      const int q = tid + 512 * k;
      const int tk = q >> 6, ch8 = (q & 63) * 8;
      unsigned w[4];
#pragma unroll
      for (int j = 0; j < 4; ++j) w[j] = (unsigned)tile[(ch8 + 2 * j) * 72 + tk] | ((unsigned)tile[(ch8 + 2 * j + 1) * 72 + tk] << 16);
      *reinterpret_cast<uint4*>(cat + (long)(tb * 64 + tk) * 1024 + 512 + ch8) = make_uint4(w[0], w[1], w[2], w[3]);
    }
  }
}
DEV void phase_mix0(const Params& p) {
  const int nb = gridDim.x;
  for (int c = blockIdx.x; c < 512; c += nb) hyena_unit(p, c);
  for (int u = vstart(); u < 1024; u += nb) na_pair(p, u);
}

DEV void phase_outproj(const Params& p, const u16* A, const u16* wt) {
  u16* pre1 = reinterpret_cast<u16*>(p.ws + REG_C);
  const u16* xres = reinterpret_cast<const u16*>(p.ws + REG_X);
  gemm_phase<true, true, false>(1024, 64, 4, [&](const Unit& u, const char*& a, const char*& b) { a = (const char*)(A) + (size_t)u.pm * 256 * (1024) * 2; b = (const char*)(wt) + (size_t)u.pn * 256 * (1024) * 2; },
      [&](Acc8& acc, const Unit& u, int wr, int wc, int fr, int fq) {
        const long o0 = (long)(u.pm * 256 + wr * 64 + fr) * 1024 + u.pn * 256 + wc * 32 + 8 * fq;
        E8_FOR {
          const long o = o0 + (ai * 128 + m * 16) * 1024 + bj * 128;
          const uint4 xr = *reinterpret_cast<const uint4*>(xres + o);
          const float4 x0 = bf4_to_f4(make_uint2(xr.x, xr.y)), x1 = bf4_to_f4(make_uint2(xr.z, xr.w));
          f32x4 v0 = acc[ai][bj][m][0], v1 = acc[ai][bj][m][1];
          uint4 pk;
          pk.x = cvt_pk_bf16(DN_ALPHA * x0.x + v0[0], DN_ALPHA * x0.y + v0[1]); pk.y = cvt_pk_bf16(DN_ALPHA * x0.z + v0[2], DN_ALPHA * x0.w + v0[3]);
          pk.z = cvt_pk_bf16(DN_ALPHA * x1.x + v1[0], DN_ALPHA * x1.y + v1[1]); pk.w = cvt_pk_bf16(DN_ALPHA * x1.z + v1[2], DN_ALPHA * x1.w + v1[3]);
          *reinterpret_cast<uint4*>(pre1 + o) = pk;
        }
      });
}

DEV void phase_ln1_router(const Params& p, int layer) {
  const int tid = otid(), lane = tid & 63, wid = tid >> 6, nb = gridDim.x;
  float* wrT = reinterpret_cast<float*>(smem);
  const float* wr = p.moe_router + (long)layer * 1024 * 16;
  {
    float4 w4[8];
#pragma unroll
    for (int k = 0; k < 8; ++k) w4[k] = reinterpret_cast<const float4*>(wr)[tid + 512 * k];
#pragma unroll
    for (int k = 0; k < 8; ++k) {
      const int i = (tid + 512 * k) * 4, c = i >> 4, e = i & 15;
      wrT[e * 1024 + c] = w4[k].x; wrT[(e + 1) * 1024 + c] = w4[k].y; wrT[(e + 2) * 1024 + c] = w4[k].z; wrT[(e + 3) * 1024 + c] = w4[k].w;
    }
  }
  __syncthreads();
  const u16* pre1 = reinterpret_cast<const u16*>(p.ws + REG_C);
  u16* x1 = reinterpret_cast<u16*>(p.ws + REG_D);
  unsigned char* x1q = reinterpret_cast<unsigned char*>(p.ws + REG_E);
  float* aff = reinterpret_cast<float*>(p.ws + S_AFF);
  const float* g = p.ln1_g + layer * 1024; const float* bb = p.ln1_b + layer * 1024;
  uint2 nx[4];
  {
    const int t0 = blockIdx.x * 8 + wid;
#pragma unroll
    for (int i = 0; i < 4; ++i) nx[i] = (t0 < TOK) ? *reinterpret_cast<const uint2*>(pre1 + (long)t0 * 1024 + i * 256 + lane * 4) : make_uint2(0u, 0u);
  }
  float4 gg4[4], bb4[4];
#pragma unroll
  for (int i = 0; i < 4; ++i) { gg4[i] = *reinterpret_cast<const float4*>(g + i * 256 + lane * 4); bb4[i] = *reinterpret_cast<const float4*>(bb + i * 256 + lane * 4); }
  for (int tok = blockIdx.x * 8 + wid; tok < TOK; tok += nb * 8) {
    float4 v[4];
    float s = 0.f;
#pragma unroll
    for (int i = 0; i < 4; ++i) { v[i] = bf4_to_f4(nx[i]); s += v[i].x + v[i].y + v[i].z + v[i].w; }
    {
      const int tn = tok + nb * 8;
      if (tn < TOK) {
#pragma unroll
        for (int i = 0; i < 4; ++i) nx[i] = *reinterpret_cast<const uint2*>(pre1 + (long)tn * 1024 + i * 256 + lane * 4);
      }
    }
    float mu = wave_sum(s) * (1.0f / 1024.0f);
    float q = 0.f;
#pragma unroll
    for (int i = 0; i < 4; ++i) { v[i].x -= mu; v[i].y -= mu; v[i].z -= mu; v[i].w -= mu; q += v[i].x * v[i].x + v[i].y * v[i].y + v[i].z * v[i].z + v[i].w * v[i].w; }
    float rstd = rsqrtf(wave_sum(q) * (1.0f / 1024.0f) + LN_EPS);
    float4 y[4];
#pragma unroll
    for (int i = 0; i < 4; ++i) {
      int c = i * 256 + lane * 4;
      const float4 gg = gg4[i], b4 = bb4[i];
      y[i].x = v[i].x * rstd * gg.x + b4.x; y[i].y = v[i].y * rstd * gg.y + b4.y; y[i].z = v[i].z * rstd * gg.z + b4.z; y[i].w = v[i].w * rstd * gg.w + b4.w;
      { uint2 pk; pk.x = pack2(y[i].x, y[i].y); pk.y = pack2(y[i].z, y[i].w); *reinterpret_cast<uint2*>(x1 + (long)tok * 1024 + c) = pk; }
      *reinterpret_cast<unsigned*>(x1q + (long)tok * 1024 + c) = pack4_f8(y[i].x, y[i].y, y[i].z, y[i].w);
    }
    float lg[16];
#pragma unroll
    for (int e = 0; e < 16; ++e) {
      float a = 0.f;
#pragma unroll
      for (int i = 0; i < 4; ++i) {
        float4 w4 = *reinterpret_cast<const float4*>(wrT + e * 1024 + i * 256 + lane * 4);
        a += y[i].x * w4.x + y[i].y * w4.y + y[i].z * w4.z + y[i].w * w4.w;
      }
      lg[e] = a;
      if (e & 1) asm volatile("" ::: "memory");
    }
#define BFLY_STEP(S, CTRL, KB) { const bool up = (KB) != 0; _Pragma("unroll") for (int i = 0; i < (8 >> S); ++i) { \
      const float lo = lg[2 * i], hi = lg[2 * i + 1]; const float snd = up ? lo : hi; lg[i] = (up ? hi : lo) + dpp_f<CTRL>(snd); } }
    BFLY_STEP(0, 0xB1, (lane ^ (lane >> 2)) & 1)
    BFLY_STEP(1, 0x4E, ((lane >> 1) ^ (lane >> 2)) & 1)
    BFLY_STEP(2, 0x141, ((lane >> 2) ^ (lane >> 3)) & 1)
    BFLY_STEP(3, 0x140, (lane >> 3) & 1)
#undef BFLY_STEP
    float mine = lg[0];
    mine += __shfl_xor(mine, 16);
    mine += __shfl_xor(mine, 32);
    const float mx = row_allmax(mine);
    const float ex = expf(mine - mx);
    const float den = row_allsum(ex);
    if (lane < 16) {
      const int eown = ((lane ^ (lane >> 2)) & 1) | ((((lane >> 1) ^ (lane >> 2)) & 1) << 1) | ((((lane >> 2) ^ (lane >> 3)) & 1) << 2) | (((lane >> 3) & 1) << 3);
      int b = tok >> 11, l = tok & 2047;
      aff[((long)b * 16 + eown) * SEQ + l] = ex / den;
    }
  }
}

DEV void phase_topk(const Params& p) {
  const int tid = otid(), nb = gridDim.x, lane = tid & 63, wid = tid >> 6;
  unsigned* key = reinterpret_cast<unsigned*>(smem);
  int* rows = reinterpret_cast<int*>(smem + 8192);
  unsigned* hist = reinterpret_cast<unsigned*>(smem + 9216);
  unsigned* wsum = reinterpret_cast<unsigned*>(smem + 10240);
  unsigned* bc = reinterpret_cast<unsigned*>(smem + 10304);
  const float* aff = reinterpret_cast<const float*>(p.ws + S_AFF);
  float* gsel = reinterpret_cast<float*>(p.ws + S_GSEL);
  int* slot = reinterpret_cast<int*>(p.ws + S_SLOT);
  const unsigned char* x1q = reinterpret_cast<const unsigned char*>(p.ws + REG_E);
  unsigned char* Xe = reinterpret_cast<unsigned char*>(p.ws + REG_C);
  for (int be = blockIdx.x; be < NBATCH * NEXP; be += nb) {
    const int b = be >> 4, e = be & 15;
    __syncthreads();
    const float4 av = *reinterpret_cast<const float4*>(aff + (long)be * SEQ + tid * 4);
    const unsigned k0 = __float_as_uint(av.x), k1 = __float_as_uint(av.y), k2 = __float_as_uint(av.z), k3 = __float_as_uint(av.w);
    unsigned prefix = 0u, need = CAP;
#pragma unroll 1
    for (int shift = 24; shift >= 0; shift -= 8) {
      if (tid < 256) hist[tid] = 0u;
      __syncthreads();
      const unsigned hs = (shift == 24) ? 0u : (unsigned)(shift + 8);
      if (shift == 24 || (k0 >> hs) == prefix) atomicAdd(&hist[(k0 >> shift) & 255u], 1u);
      if (shift == 24 || (k1 >> hs) == prefix) atomicAdd(&hist[(k1 >> shift) & 255u], 1u);
      if (shift == 24 || (k2 >> hs) == prefix) atomicAdd(&hist[(k2 >> shift) & 255u], 1u);
      if (shift == 24 || (k3 >> hs) == prefix) atomicAdd(&hist[(k3 >> shift) & 255u], 1u);
      __syncthreads();
      if (wid == 0) {
        unsigned h0 = hist[4 * lane], h1 = hist[4 * lane + 1], h2 = hist[4 * lane + 2], h3 = hist[4 * lane + 3];
        unsigned tot = h0 + h1 + h2 + h3;
        unsigned suf = tot;
#pragma unroll
        for (int o = 1; o < 64; o <<= 1) { unsigned t = __shfl_down(suf, o); if (lane + o < 64) suf += t; }
        const unsigned above = suf - tot;
        int d = -1; unsigned nabove = 0u;
        unsigned c3 = above + h3, c2 = c3 + h2, c1 = c2 + h1, c0 = c1 + h0;
        if (above < need && c0 >= need) {
          if (c3 >= need) { d = 4 * lane + 3; nabove = above; }
          else if (c2 >= need) { d = 4 * lane + 2; nabove = c3; }
          else if (c1 >= need) { d = 4 * lane + 1; nabove = c2; }
          else { d = 4 * lane; nabove = c1; }
          bc[0] = (prefix << 8) | (unsigned)d;
          bc[1] = need - nabove;
        }
      }
      __syncthreads();
      prefix = bc[0]; need = bc[1];
    }
    const unsigned tau = prefix;
    const unsigned e0 = (k0 == tau), e1 = (k1 == tau), e2 = (k2 == tau), e3 = (k3 == tau);
    unsigned eqs = e0 + e1 + e2 + e3;
    unsigned inc = eqs;
#pragma unroll
    for (int o = 1; o < 64; o <<= 1) { unsigned t = __shfl_up(inc, o); if (lane >= o) inc += t; }
    if (lane == 63) wsum[wid] = inc;
    __syncthreads();
    unsigned base = 0u;
#pragma unroll
    for (int w = 0; w < 8; ++w) if (w < wid) base += wsum[w];
    unsigned eqb = base + inc - eqs;
    const unsigned s0 = (k0 > tau) || (e0 && eqb < need); eqb += e0;
    const unsigned s1 = (k1 > tau) || (e1 && eqb < need); eqb += e1;
    const unsigned s2 = (k2 > tau) || (e2 && eqb < need); eqb += e2;
    const unsigned s3 = (k3 > tau) || (e3 && eqb < need);
    const unsigned sels = s0 + s1 + s2 + s3;
    unsigned inc2 = sels;
#pragma unroll
    for (int o = 1; o < 64; o <<= 1) { unsigned t = __shfl_up(inc2, o); if (lane >= o) inc2 += t; }
    if (lane == 63) wsum[8 + wid] = inc2;
    __syncthreads();
    unsigned base2 = 0u;
#pragma unroll
    for (int w = 0; w < 8; ++w) if (w < wid) base2 += wsum[8 + w];
    unsigned sl = base2 + inc2 - sels;
    const int tok0 = tid * 4;
    int sv[4];
    sv[0] = s0 ? (int)sl : -1; sl += s0;
    sv[1] = s1 ? (int)sl : -1; sl += s1;
    sv[2] = s2 ? (int)sl : -1; sl += s2;
    sv[3] = s3 ? (int)sl : -1;
    const float avv[4] = {av.x, av.y, av.z, av.w};
#pragma unroll
    for (int j = 0; j < 4; ++j) {
      slot[((long)b * SEQ + tok0 + j) * 16 + e] = sv[j];
      if (sv[j] >= 0) { rows[sv[j]] = tok0 + j; gsel[be * CAP + sv[j]] = avv[j]; }
    }
    __syncthreads();
#pragma unroll 4
    for (int s = wid; s < CAP; s += 8) {
      const int t = rows[s];
      const uint4* src = reinterpret_cast<const uint4*>(x1q + ((long)b * SEQ + t) * 1024);
      uint4* dst = reinterpret_cast<uint4*>(Xe + ((long)(e * 8 + b) * CAP + s) * 1024);
      dst[lane] = src[lane];
    }
  }
}

DEV void phase_moe1(const Params& p, int layer) {
  const unsigned char* Xe = reinterpret_cast<const unsigned char*>(p.ws + REG_C);
  const unsigned char* wgu = reinterpret_cast<const unsigned char*>(p.ws + W_GU) + (long)layer * 16 * 4096 * 1024;
  unsigned char* H = reinterpret_cast<unsigned char*>(p.ws + REG_A);
  gemm_phase<true, true, true>(1024, 128, 16,
      [&](const Unit& u, const char*& a, const char*& b) { a = (const char*)Xe + (size_t)u.pm * 256 * 1024; b = (const char*)wgu + ((size_t)(u.pm >> 3) * 4096 + (size_t)u.pn * 256) * 1024; },
      [&](Acc8& acc, const Unit& u, int wr, int wc, int fr, int fq) {
        unsigned char* base = H + (long)(u.pm * 256 + wr * 64 + fr) * DFF + u.pn * 128 + wc * 32 + 8 * fq;
#pragma unroll
        for (int ai = 0; ai < 2; ++ai)
#pragma unroll
          for (int m = 0; m < 4; ++m) {
            float hv[8];
#pragma unroll
            for (int n = 0; n < 2; ++n)
#pragma unroll
              for (int j = 0; j < 4; ++j) {
                float gte = acc[ai][0][m][n][j] * 0.03125f, up = acc[ai][1][m][n][j] * 0.03125f;
                hv[n * 4 + j] = gte * fsigmoid(gte) * up;
              }
            uint2 pk; pk.x = pack4_f8(hv[0], hv[1], hv[2], hv[3]); pk.y = pack4_f8(hv[4], hv[5], hv[6], hv[7]);
            *reinterpret_cast<uint2*>(base + (ai * 128 + m * 16) * DFF) = pk;
          }
      });
}
DEV void phase_moe2(const Params& p, int layer) {
  const unsigned char* H = reinterpret_cast<const unsigned char*>(p.ws + REG_A);
  const unsigned char* wd = reinterpret_cast<const unsigned char*>(p.ws + W_DN) + (long)layer * 16 * 1024 * 2048;
  const float* gsel = reinterpret_cast<const float*>(p.ws + S_GSEL);
  u16* Ye = reinterpret_cast<u16*>(p.ws + REG_B);
  gemm_phase<true, true, true>(2048, 128, 4,
      [&](const Unit& u, const char*& a, const char*& b) { a = (const char*)H + (size_t)u.pm * 256 * 2048; b = (const char*)wd + ((size_t)(u.pm >> 3) * 1024 + (size_t)u.pn * 256) * 2048; },
      [&](Acc8& acc, const Unit& u, int wr, int wc, int fr, int fq) {
        const int e = u.pm >> 3, b = u.pm & 7;
        const float* gs = gsel + (b * 16 + e) * CAP + wr * 64 + fr;
        u16* base = Ye + (long)(u.pm * 256 + wr * 64 + fr) * 1024 + u.pn * 256 + wc * 32 + 8 * fq;
#pragma unroll
        for (int ai = 0; ai < 2; ++ai)
#pragma unroll
          for (int m = 0; m < 4; ++m) {
            const float g = gs[ai * 128 + m * 16] * 0.015625f;
#pragma unroll
            for (int bj = 0; bj < 2; ++bj) {
              f32x4 v0 = acc[ai][bj][m][0] * g, v1 = acc[ai][bj][m][1] * g;
              uint4 pk;
              pk.x = cvt_pk_bf16(v0[0], v0[1]); pk.y = cvt_pk_bf16(v0[2], v0[3]); pk.z = cvt_pk_bf16(v1[0], v1[1]); pk.w = cvt_pk_bf16(v1[2], v1[3]);
              *reinterpret_cast<uint4*>(base + (ai * 128 + m * 16) * 1024 + bj * 128) = pk;
            }
          }
      });
}
DEV void phase_ln2(const Params& p, int layer) {
  const int tid = otid(), lane = tid & 63, wid = tid >> 6, nb = gridDim.x;
  const u16* x1 = reinterpret_cast<const u16*>(p.ws + REG_D);
  const u16* Ye = reinterpret_cast<const u16*>(p.ws + REG_B);
  const int* slot = reinterpret_cast<const int*>(p.ws + S_SLOT);
  u16* x2b = reinterpret_cast<u16*>(p.ws + REG_A + 67108864ull);
  const float* g = p.ln2_g + layer * 1024; const float* bb = p.ln2_b + layer * 1024;
  uint2 nx[4]; int nslot = -1;
  {
    const int t0 = blockIdx.x * 8 + wid;
    if (t0 < TOK) {
#pragma unroll
      for (int i = 0; i < 4; ++i) nx[i] = *reinterpret_cast<const uint2*>(x1 + (long)t0 * 1024 + i * 256 + lane * 4);
      nslot = (lane < 16) ? slot[(long)t0 * 16 + lane] : -1;
    }
  }
  for (int tok = blockIdx.x * 8 + wid; tok < TOK; tok += nb * 8) {
    const int b = tok >> 11;
    float4 v[4];
#pragma unroll
    for (int i = 0; i < 4; ++i) {
      float4 t = bf4_to_f4(nx[i]);
      v[i].x = DN_ALPHA * t.x; v[i].y = DN_ALPHA * t.y; v[i].z = DN_ALPHA * t.z; v[i].w = DN_ALPHA * t.w;
    }
    int myslot = nslot;
    {
      const int tn = tok + nb * 8;
      if (tn < TOK) {
#pragma unroll
        for (int i = 0; i < 4; ++i) nx[i] = *reinterpret_cast<const uint2*>(x1 + (long)tn * 1024 + i * 256 + lane * 4);
        nslot = (lane < 16) ? slot[(long)tn * 16 + lane] : -1;
      }
    }
    unsigned mask = (unsigned)__ballot(myslot >= 0);
    while (mask) {
      const int e = __builtin_ctz(mask);
      mask &= mask - 1;
      const int sidx = __builtin_amdgcn_readlane(myslot, e);
      const u16* yr = Ye + ((long)(e * 8 + b) * CAP + sidx) * 1024;
      uint2 t[4];
#pragma unroll
      for (int i = 0; i < 4; ++i) t[i] = *reinterpret_cast<const uint2*>(yr + i * 256 + lane * 4);
#pragma unroll
      for (int i = 0; i < 4; ++i) {
        v[i].x += __uint_as_float(t[i].x << 16); v[i].y += __uint_as_float(t[i].x & 0xffff0000u);
        v[i].z += __uint_as_float(t[i].y << 16); v[i].w += __uint_as_float(t[i].y & 0xffff0000u);
      }
    }
    float s = 0.f;
#pragma unroll
    for (int i = 0; i < 4; ++i) s += v[i].x + v[i].y + v[i].z + v[i].w;
    float mu = wave_sum(s) * (1.0f / 1024.0f);
    float q = 0.f;
#pragma unroll
    for (int i = 0; i < 4; ++i) { v[i].x -= mu; v[i].y -= mu; v[i].z -= mu; v[i].w -= mu; q += v[i].x * v[i].x + v[i].y * v[i].y + v[i].z * v[i].z + v[i].w * v[i].w; }
    float rstd = rsqrtf(wave_sum(q) * (1.0f / 1024.0f) + LN_EPS);
#pragma unroll
    for (int i = 0; i < 4; ++i) {
      int c = i * 256 + lane * 4;
      float4 gg = *reinterpret_cast<const float4*>(g + c), b4 = *reinterpret_cast<const float4*>(bb + c);
      float4 y;
      y.x = v[i].x * rstd * gg.x + b4.x; y.y = v[i].y * rstd * gg.y + b4.y; y.z = v[i].z * rstd * gg.z + b4.z; y.w = v[i].w * rstd * gg.w + b4.w;
      uint2 pk; pk.x = pack2(y.x, y.y); pk.y = pack2(y.z, y.w);
      *reinterpret_cast<uint2*>(x2b + (long)tok * 1024 + c) = pk;
    }
  }
}
DEV void phase_ple(const Params& p, int layer, float* outf, u16* outb) {
  const u16* x2b = reinterpret_cast<const u16*>(p.ws + REG_A + 67108864ull);
  const u16* pb = reinterpret_cast<const u16*>(p.ws + REG_P) + (long)layer * TOK * 256;
  const u16* wg = reinterpret_cast<const u16*>(p.ws + W_PLEG) + (long)layer * 1024 * 1024;
  const u16* wp = reinterpret_cast<const u16*>(p.ws + W_PLEP) + (long)layer * 1024 * 256;
  u16* pp = reinterpret_cast<u16*>(p.ws + REG_C);
  gemm_phase<true, false, false>(256, 64, 4, [&](const Unit& u, const char*& a, const char*& b) { a = (const char*)(pb) + (size_t)u.pm * 256 * (256) * 2; b = (const char*)(wp) + (size_t)u.pn * 256 * (256) * 2; },
      [&](Acc8& acc, const Unit& u, int wr, int wc, int fr, int fq) {
        const long o0 = (long)(u.pm * 256 + wr * 64 + fr) * 1024 + u.pn * 256 + wc * 32 + 4 * fq;
        E8_FOR {
#pragma unroll
          for (int n = 0; n < 2; ++n)
          {
            f32x4 v = acc[ai][bj][m][n];
            uint2 pk; pk.x = cvt_pk_bf16(v[0], v[1]); pk.y = cvt_pk_bf16(v[2], v[3]);
            *reinterpret_cast<uint2*>(pp + o0 + (ai * 128 + m * 16) * 1024 + bj * 128 + n * 16) = pk;
          }
        }
      });
  gemm_phase<true, false, false>(1024, 64, 4, [&](const Unit& u, const char*& a, const char*& b) { a = (const char*)(x2b) + (size_t)u.pm * 256 * (1024) * 2; b = (const char*)(wg) + (size_t)u.pn * 256 * (1024) * 2; },
      [&](Acc8& acc, const Unit& u, int wr, int wc, int fr, int fq) {
        const long o0 = (long)(u.pm * 256 + wr * 64 + fr) * 1024 + u.pn * 256 + wc * 32 + 4 * fq;
        E8_FOR {
#pragma unroll
          for (int n = 0; n < 2; ++n) {
            const long o = o0 + (ai * 128 + m * 16) * 1024 + bj * 128 + n * 16;
            f32x4 a = acc[ai][bj][m][n];
            const float4 xq = bf4_to_f4(*reinterpret_cast<const uint2*>(x2b + o));
            f32x4 xv = {xq.x, xq.y, xq.z, xq.w};
            const uint2 pq = *reinterpret_cast<const uint2*>(pp + o);
            f32x4 pv = {__uint_as_float(pq.x << 16), __uint_as_float(pq.x & 0xffff0000u), __uint_as_float(pq.y << 16), __uint_as_float(pq.y & 0xffff0000u)};
            f32x4 r;
#pragma unroll
            for (int j = 0; j < 4; ++j) r[j] = xv[j] + pv[j] * fsigmoid(a[j]);
            if (outf) *reinterpret_cast<f32x4*>(outf + o) = r;
            if (outb) { uint2 pk; pk.x = cvt_pk_bf16(r[0], r[1]); pk.y = cvt_pk_bf16(r[2], r[3]); *reinterpret_cast<uint2*>(outb + o) = pk; }
          }
        }
      });
}
DEV void phase_mla_in(const Params& p) {
  const u16* xb = reinterpret_cast<const u16*>(p.ws + REG_X);
  const u16* wt = reinterpret_cast<const u16*>(p.ws + W_MLAIN);
  float* hm = reinterpret_cast<float*>(p.ws + REG_B);
  gemm_phase<true, false, false>(1024, 64, 3, [&](const Unit& u, const char*& a, const char*& b) { a = (const char*)(xb) + (size_t)u.pm * 256 * (1024) * 2; b = (const char*)(wt) + (size_t)u.pn * 256 * (1024) * 2; },
      [&](Acc8& acc, const Unit& u, int wr, int wc, int fr, int fq) {
        const long o0 = (long)(u.pm * 256 + wr * 64 + fr) * 768 + u.pn * 256 + wc * 32 + 4 * fq;
        E8_FOR {
#pragma unroll
          for (int n = 0; n < 2; ++n)
            *reinterpret_cast<f32x4*>(hm + o0 + (ai * 128 + m * 16) * 768 + bj * 128 + n * 16) = acc[ai][bj][m][n];
        }
      });
}
constexpr size_t MLA_Q = REG_A, MLA_K = REG_A + 50331648ull, MLA_VT = REG_A + 100663296ull;
constexpr size_t MLA_CQN = REG_B + 50331648ull, MLA_CKVN = MLA_CQN + 12582912ull, MLA_O = MLA_CKVN + 8388608ull;
DEV float rope_inv(int i) { return 1.0f / powf(10000.0f, (float)i / 16.0f); }
DEV void phase_mla_norm(const Params& p) {
  const int tid = otid(), lane = tid & 63, wid = tid >> 6, nb = gridDim.x;
  const float* hm = reinterpret_cast<const float*>(p.ws + REG_B);
  u16* cqn = reinterpret_cast<u16*>(p.ws + MLA_CQN);
  u16* ckvn = reinterpret_cast<u16*>(p.ws + MLA_CKVN);
  u16* Kb = reinterpret_cast<u16*>(p.ws + MLA_K);
  for (int tok = blockIdx.x * 8 + wid; tok < TOK; tok += nb * 8) {
    const float* row = hm + (long)tok * 768;
    float q[6], kv[4];
    float sq = 0.f, skv = 0.f;
#pragma unroll
    for (int i = 0; i < 6; ++i) { q[i] = row[i * 64 + lane]; sq += q[i] * q[i]; }
#pragma unroll
    for (int i = 0; i < 4; ++i) { kv[i] = row[384 + i * 64 + lane]; skv += kv[i] * kv[i]; }
    float rq = rsqrtf(wave_sum(sq) * (1.0f / 384.0f) + LN_EPS);
    float rkv = rsqrtf(wave_sum(skv) * (1.0f / 256.0f) + LN_EPS);
#pragma unroll
    for (int i = 0; i < 6; ++i) cqn[(long)tok * 384 + i * 64 + lane] = f2bf(q[i] * rq * p.mla_q_norm[i * 64 + lane]);
#pragma unroll
    for (int i = 0; i < 4; ++i) ckvn[(long)tok * 256 + i * 64 + lane] = f2bf(kv[i] * rkv * p.mla_kv_norm[i * 64 + lane]);
    const int b = tok >> 11, l = tok & 2047;
    float kr = (lane < 32) ? row[640 + lane] : 0.f;
    float x1 = __shfl(kr, lane & 15), x2 = __shfl(kr, (lane & 15) + 16);
    const float2 cssn = reinterpret_cast<const float2*>(p.ws + S_ROPE)[l * 16 + (lane & 15)];
    const float cs = cssn.x, sn = cssn.y;
    float r = (lane & 16) ? (x1 * sn + x2 * cs) : (x1 * cs - x2 * sn);
    u16 rb = f2bf(r);
    for (int hh = 0; hh < 16; hh += 2) {
      int h = hh + (lane >> 5);
      u16 val = (u16)__shfl((int)rb, lane & 31);
      Kb[(((long)b * 16 + h) * SEQ + l) * 96 + 64 + (lane & 31)] = val;
    }
  }
}
DEV void phase_mla_up(const Params& p) {
  const u16* cqn = reinterpret_cast<const u16*>(p.ws + MLA_CQN);
  const u16* ckvn = reinterpret_cast<const u16*>(p.ws + MLA_CKVN);
  const u16* wq = reinterpret_cast<const u16*>(p.ws + W_QUP);
  const u16* wkv = reinterpret_cast<const u16*>(p.ws + W_KVUP);
  u16* Qb = reinterpret_cast<u16*>(p.ws + MLA_Q);
  u16* Kb = reinterpret_cast<u16*>(p.ws + MLA_K);
  u16* VT = reinterpret_cast<u16*>(p.ws + MLA_VT);
  const float qscale = 0.10206207261596577f * 1.4426950408889634f;
  gemm_phase<true, false, false>(384, 64, 6, [&](const Unit& u, const char*& a, const char*& b) { a = (const char*)(cqn) + (size_t)u.pm * 256 * (384) * 2; b = (const char*)(wq) + (size_t)u.pn * 256 * (384) * 2; },
      [&](Acc8& acc, const Unit& u, int wr, int wc, int fr, int fq) {
#pragma unroll
        for (int bj = 0; bj < 2; ++bj) {
          const int c32 = (u.pn * 256 + bj * 128 + wc * 32) >> 5;
          const int h = c32 / 3, part = c32 % 3;
#pragma unroll
          for (int ai = 0; ai < 2; ++ai)
#pragma unroll
            for (int m = 0; m < 4; ++m) {
              const int tok = u.pm * 256 + ai * 128 + wr * 64 + m * 16 + fr;
              const int b = tok >> 11, l = tok & 2047;
              u16* qrow = Qb + (((long)b * 16 + h) * SEQ + l) * 96 + part * 32 + 4 * fq;
              f32x4 a0 = acc[ai][bj][m][0], a1 = acc[ai][bj][m][1];
              if (part == 2) {
#pragma unroll
                for (int j = 0; j < 4; ++j) {
                  const float2 cssn = reinterpret_cast<const float2*>(p.ws + S_ROPE)[l * 16 + 4 * fq + j];
                  const float cs = cssn.x, sn = cssn.y;
                  float r0 = a0[j] * cs - a1[j] * sn, r1 = a0[j] * sn + a1[j] * cs;
                  a0[j] = r0; a1[j] = r1;
                }
              }
              uint2 p0, p1;
              p0.x = cvt_pk_bf16(a0[0] * qscale, a0[1] * qscale); p0.y = cvt_pk_bf16(a0[2] * qscale, a0[3] * qscale);
              p1.x = cvt_pk_bf16(a1[0] * qscale, a1[1] * qscale); p1.y = cvt_pk_bf16(a1[2] * qscale, a1[3] * qscale);
              *reinterpret_cast<uint2*>(qrow) = p0;
              *reinterpret_cast<uint2*>(qrow + 16) = p1;
            }
        }
      });
  gemm_phase<true, true, false>(256, 64, 4, [&](const Unit& u, const char*& a, const char*& b) { a = (const char*)(ckvn) + (size_t)u.pm * 256 * (256) * 2; b = (const char*)(wkv) + (size_t)u.pn * 256 * (256) * 2; },
      [&](Acc8& acc, const Unit& u, int wr, int wc, int fr, int fq) {
        E8_FOR {
          const int tok = u.pm * 256 + ai * 128 + wr * 64 + m * 16 + fr;
          const int b = tok >> 11, l = tok & 2047;
          const int col = u.pn * 256 + bj * 128 + wc * 32 + 8 * fq;
          const int h = col >> 6, d = col & 63;
          f32x4 v0 = acc[ai][bj][m][0], v1 = acc[ai][bj][m][1];
          uint4 pk;
          pk.x = cvt_pk_bf16(v0[0], v0[1]); pk.y = cvt_pk_bf16(v0[2], v0[3]); pk.z = cvt_pk_bf16(v1[0], v1[1]); pk.w = cvt_pk_bf16(v1[2], v1[3]);
          *reinterpret_cast<uint4*>(Kb + (((long)b * 16 + h) * SEQ + l) * 96 + d) = pk;
        }
      });
  gemm_phase<false, false, false>(256, 64, 4, [&](const Unit& u, const char*& a, const char*& b) { a = (const char*)(ckvn) + (size_t)u.pm * 256 * (256) * 2; b = (const char*)(wkv + 1024 * 256) + (size_t)u.pn * 256 * (256) * 2; },
      [&](Acc8& acc, const Unit& u, int wr, int wc, int fr, int fq) {
        E8_FOR {
          const int tok = u.pm * 256 + ai * 128 + wr * 64 + m * 16 + 4 * fq;
          const int b = tok >> 11, l = tok & 2047;
#pragma unroll
          for (int n = 0; n < 2; ++n) {
            const int col = u.pn * 256 + bj * 128 + wc * 32 + n * 16 + fr;
            const int h = col >> 6, d = col & 63;
            f32x4 v = acc[ai][bj][m][n];
            uint2 pk; pk.x = cvt_pk_bf16(v[0], v[1]); pk.y = cvt_pk_bf16(v[2], v[3]);
            *reinterpret_cast<uint2*>(VT + (((long)b * 16 + h) * 64 + d) * SEQ + l) = pk;
          }
        }
      });
}
#ifndef ATT_THR
#define ATT_THR 8.0f
#endif
DEV int kswz(int key) { return (((key >> 3) & 3) << 2) | (key & 3); }
DEV void mla_attn_unit(const Params& p, int u) {
  const int tid = otid(), lane = tid & 63, wid = tid >> 6, fr = lane & 15, fq = lane >> 4;
  const int qb = u & 7, bh = u >> 3;
  const u16* Qb = reinterpret_cast<const u16*>(p.ws + MLA_Q) + (long)bh * SEQ * 96;
  const u16* Kb = reinterpret_cast<const u16*>(p.ws + MLA_K) + (long)bh * SEQ * 96;
  const u16* VT = reinterpret_cast<const u16*>(p.ws + MLA_VT) + (long)bh * 64 * SEQ;
  u16* O = reinterpret_cast<u16*>(p.ws + MLA_O);
  char* kl = smem;
  char* vl = smem + 32768;
  bf16x8 qf[2][3];
#pragma unroll
  for (int qt = 0; qt < 2; ++qt)
#pragma unroll
    for (int ks = 0; ks < 3; ++ks)
      qf[qt][ks] = *reinterpret_cast<const bf16x8*>(Qb + (long)(qb * 256 + wid * 32 + qt * 16 + fr) * 96 + ks * 32 + fq * 8);
  f32x4 o[4][2];
#pragma unroll
  for (int dt = 0; dt < 4; ++dt)
#pragma unroll
    for (int qt = 0; qt < 2; ++qt) o[dt][qt] = f32x4{0.f, 0.f, 0.f, 0.f};
  float mrun[2], lrun[2] = {0.f, 0.f}, rcur[2], rnxt[2] = {0.f, 0.f};
  const int kc0 = tid, kc1 = 512 + (tid & 255);
  const int vd = tid >> 3, vpart = tid & 7;
  const int kw0 = (kc0 / 12) * 256 + (((kc0 % 12) ^ kswz(kc0 / 12)) << 4);
  const int kw1 = (kc1 / 12) * 256 + (((kc1 % 12) ^ kswz(kc1 / 12)) << 4);
  const int vw = vd * 128 + ((vpart ^ ((vd >> 1) & 7)) << 4);
  struct Stg { uint4 k0, k1, v; };
  Stg sa, sb;
  sa.k1 = make_uint4(0, 0, 0, 0); sb.k1 = make_uint4(0, 0, 0, 0);
  auto gloadK = [&](Stg& r, int t) {
    const u16* kt = Kb + (long)t * 64 * 96;
    r.k0 = *reinterpret_cast<const uint4*>(kt + kc0 * 8);
    r.k1 = *reinterpret_cast<const uint4*>(kt + kc1 * 8);
  };
  auto gloadV = [&](Stg& r, int t) { r.v = *reinterpret_cast<const uint4*>(VT + (long)vd * SEQ + t * 64 + vpart * 8); };
  auto lstoreK = [&](const Stg& r, int buf) {
    *reinterpret_cast<uint4*>(kl + buf * 16384 + kw0) = r.k0;
    if (tid < 256) *reinterpret_cast<uint4*>(kl + buf * 16384 + kw1) = r.k1;
  };
  auto lstoreV = [&](const Stg& r, int buf) { *reinterpret_cast<uint4*>(vl + buf * 8192 + vw) = r.v; };
  const int krow = 8 * (fr >> 2) + (fr & 3);
  const int kf_ = kswz(krow);
  auto qk_tile = [&](const char* kd, f32x4 (&s)[4][2], const float (&ref)[2]) {
#pragma unroll
    for (int kt = 0; kt < 4; ++kt) {
      const int key = 32 * (kt >> 1) + 4 * (kt & 1) + krow;
      bf16x8 kf[3];
#pragma unroll
      for (int ks = 0; ks < 3; ++ks) kf[ks] = *reinterpret_cast<const bf16x8*>(kd + key * 256 + (((ks * 4 + fq) ^ kf_) << 4));
#pragma unroll
      for (int qt = 0; qt < 2; ++qt) {
        f32x4 a = {-ref[qt], -ref[qt], -ref[qt], -ref[qt]};
#pragma unroll
        for (int ks = 0; ks < 3; ++ks) a = __builtin_amdgcn_mfma_f32_16x16x32_bf16(kf[ks], qf[qt][ks], a, 0, 0, 0);
        s[kt][qt] = a;
      }
    }
  };
  __syncthreads();
  gloadK(sa, 0); gloadV(sa, 0); lstoreK(sa, 0); lstoreV(sa, 0);
  gloadK(sa, 1); lstoreK(sa, 1);
  gloadK(sa, 2); gloadV(sa, 1);
  __syncthreads();
  f32x4 sc[4][2], sn[4][2];
  {
    const float zero2[2] = {0.f, 0.f};
    qk_tile(kl, sc, zero2);
#pragma unroll
    for (int qt = 0; qt < 2; ++qt) {
      float tm = -1e30f;
#pragma unroll
      for (int kt = 0; kt < 4; ++kt)
#pragma unroll
        for (int j = 0; j < 4; ++j) tm = fmaxf(tm, sc[kt][qt][j]);
      tm = fmaxf(tm, __shfl_xor(tm, 16));
      tm = fmaxf(tm, __shfl_xor(tm, 32));
      mrun[qt] = tm; rcur[qt] = tm;
#pragma unroll
      for (int kt = 0; kt < 4; ++kt)
#pragma unroll
        for (int j = 0; j < 4; ++j) sc[kt][qt][j] -= tm;
    }
  }
  __syncthreads();
#pragma unroll 1
  for (int t2 = 0; t2 < 32; t2 += 2) {
    { const int t = t2, cur = 0;

    gloadK(sb, min(t + 3, 31));
    gloadV(sb, min(t + 2, 31));
    if (t + 1 < 32) { rnxt[0] = mrun[0]; rnxt[1] = mrun[1]; qk_tile(kl + (cur ^ 1) * 16384, sn, rnxt); }
    bf16x8 pf[2][2];
#pragma unroll
    for (int qt = 0; qt < 2; ++qt) {
      float lm = sc[0][qt][0];
#pragma unroll
      for (int kt = 0; kt < 4; ++kt)
#pragma unroll
        for (int j = 0; j < 4; ++j) lm = fmaxf(lm, sc[kt][qt][j]);
      const bool slow = (lm > ATT_THR) || (rcur[qt] != mrun[qt]);
      if (__any(slow)) {
        const float dl = rcur[qt] - mrun[qt];
        float tm = lm + dl;
        tm = fmaxf(tm, __shfl_xor(tm, 16));
        tm = fmaxf(tm, __shfl_xor(tm, 32));
        const float inc = fmaxf(tm, 0.f);
        const float alpha = __builtin_amdgcn_exp2f(-inc);
        mrun[qt] += inc;
        lrun[qt] *= alpha;
#pragma unroll
        for (int dt = 0; dt < 4; ++dt) { o[dt][qt][0] *= alpha; o[dt][qt][1] *= alpha; o[dt][qt][2] *= alpha; o[dt][qt][3] *= alpha; }
        const float sh = dl - inc;
#pragma unroll
        for (int kt = 0; kt < 4; ++kt)
#pragma unroll
          for (int j = 0; j < 4; ++j) sc[kt][qt][j] += sh;
      }
      float ls = 0.f;
#pragma unroll
      for (int kt = 0; kt < 4; ++kt)
#pragma unroll
        for (int j = 0; j < 4; ++j) { float e = __builtin_amdgcn_exp2f(sc[kt][qt][j]); sc[kt][qt][j] = e; ls += e; }
      lrun[qt] += ls;
#pragma unroll
      for (int k2 = 0; k2 < 2; ++k2) {
        union { bf16x8 v; unsigned u[4]; } t_;
        t_.u[0] = cvt_pk_bf16(sc[2 * k2][qt][0], sc[2 * k2][qt][1]); t_.u[1] = cvt_pk_bf16(sc[2 * k2][qt][2], sc[2 * k2][qt][3]);
        t_.u[2] = cvt_pk_bf16(sc[2 * k2 + 1][qt][0], sc[2 * k2 + 1][qt][1]); t_.u[3] = cvt_pk_bf16(sc[2 * k2 + 1][qt][2], sc[2 * k2 + 1][qt][3]);
        pf[k2][qt] = t_.v;
      }
    }
    const char* vdl = vl + cur * 8192;
    __builtin_amdgcn_s_setprio(1);
#pragma unroll
    for (int k2 = 0; k2 < 2; ++k2)
#pragma unroll
      for (int dt = 0; dt < 4; ++dt) {
        const int dim = dt * 16 + fr;
        bf16x8 af = *reinterpret_cast<const bf16x8*>(vdl + dim * 128 + (((k2 * 4 + fq) ^ ((dim >> 1) & 7)) << 4));
#pragma unroll
        for (int qt = 0; qt < 2; ++qt) o[dt][qt] = __builtin_amdgcn_mfma_f32_16x16x32_bf16(af, pf[k2][qt], o[dt][qt], 0, 0, 0);
      }
    __builtin_amdgcn_s_setprio(0);
    if (t + 2 < 32) lstoreK(sa, cur);
    if (t + 1 < 32) lstoreV(sa, cur ^ 1);
    __syncthreads();
#pragma unroll
    for (int kt = 0; kt < 4; ++kt)
#pragma unroll
      for (int qt = 0; qt < 2; ++qt) sc[kt][qt] = sn[kt][qt];
    rcur[0] = rnxt[0]; rcur[1] = rnxt[1];
      }
    { const int t = t2 + 1, cur = 1;

    gloadK(sa, min(t + 3, 31));
    gloadV(sa, min(t + 2, 31));
    if (t + 1 < 32) { rnxt[0] = mrun[0]; rnxt[1] = mrun[1]; qk_tile(kl + (cur ^ 1) * 16384, sn, rnxt); }
    bf16x8 pf[2][2];
#pragma unroll
    for (int qt = 0; qt < 2; ++qt) {
      float lm = sc[0][qt][0];
#pragma unroll
      for (int kt = 0; kt < 4; ++kt)
#pragma unroll
        for (int j = 0; j < 4; ++j) lm = fmaxf(lm, sc[kt][qt][j]);
      const bool slow = (lm > ATT_THR) || (rcur[qt] != mrun[qt]);
      if (__any(slow)) {
        const float dl = rcur[qt] - mrun[qt];
        float tm = lm + dl;
        tm = fmaxf(tm, __shfl_xor(tm, 16));
        tm = fmaxf(tm, __shfl_xor(tm, 32));
        const float inc = fmaxf(tm, 0.f);
        const float alpha = __builtin_amdgcn_exp2f(-inc);
        mrun[qt] += inc;
        lrun[qt] *= alpha;
#pragma unroll
        for (int dt = 0; dt < 4; ++dt) { o[dt][qt][0] *= alpha; o[dt][qt][1] *= alpha; o[dt][qt][2] *= alpha; o[dt][qt][3] *= alpha; }
        const float sh = dl - inc;
#pragma unroll
        for (int kt = 0; kt < 4; ++kt)
#pragma unroll
          for (int j = 0; j < 4; ++j) sc[kt][qt][j] += sh;
      }
      float ls = 0.f;
#pragma unroll
      for (int kt = 0; kt < 4; ++kt)
#pragma unroll
        for (int j = 0; j < 4; ++j) { float e = __builtin_amdgcn_exp2f(sc[kt][qt][j]); sc[kt][qt][j] = e; ls += e; }
      lrun[qt] += ls;
#pragma unroll
      for (int k2 = 0; k2 < 2; ++k2) {
        union { bf16x8 v; unsigned u[4]; } t_;
        t_.u[0] = cvt_pk_bf16(sc[2 * k2][qt][0], sc[2 * k2][qt][1]); t_.u[1] = cvt_pk_bf16(sc[2 * k2][qt][2], sc[2 * k2][qt][3]);
        t_.u[2] = cvt_pk_bf16(sc[2 * k2 + 1][qt][0], sc[2 * k2 + 1][qt][1]); t_.u[3] = cvt_pk_bf16(sc[2 * k2 + 1][qt][2], sc[2 * k2 + 1][qt][3]);
        pf[k2][qt] = t_.v;
      }
    }
    const char* vdl = vl + cur * 8192;
    __builtin_amdgcn_s_setprio(1);
#pragma unroll
    for (int k2 = 0; k2 < 2; ++k2)
#pragma unroll
      for (int dt = 0; dt < 4; ++dt) {
        const int dim = dt * 16 + fr;
        bf16x8 af = *reinterpret_cast<const bf16x8*>(vdl + dim * 128 + (((k2 * 4 + fq) ^ ((dim >> 1) & 7)) << 4));
#pragma unroll
        for (int qt = 0; qt < 2; ++qt) o[dt][qt] = __builtin_amdgcn_mfma_f32_16x16x32_bf16(af, pf[k2][qt], o[dt][qt], 0, 0, 0);
      }
    __builtin_amdgcn_s_setprio(0);
    if (t + 2 < 32) lstoreK(sb, cur);
    if (t + 1 < 32) lstoreV(sb, cur ^ 1);
    __syncthreads();
#pragma unroll
    for (int kt = 0; kt < 4; ++kt)
#pragma unroll
      for (int qt = 0; qt < 2; ++qt) sc[kt][qt] = sn[kt][qt];
    rcur[0] = rnxt[0]; rcur[1] = rnxt[1];
      }
  }
  const int b = bh >> 4, h = bh & 15;
#pragma unroll
  for (int qt = 0; qt < 2; ++qt) {
    float l = lrun[qt];
    l += __shfl_xor(l, 16);
    l += __shfl_xor(l, 32);
    const float inv = 1.0f / l;
    const long tok = (long)b * SEQ + qb * 256 + wid * 32 + qt * 16 + fr;
#pragma unroll
    for (int dt = 0; dt < 4; ++dt) {
      uint2 pk; pk.x = pack2(o[dt][qt][0] * inv, o[dt][qt][1] * inv); pk.y = pack2(o[dt][qt][2] * inv, o[dt][qt][3] * inv);
      *reinterpret_cast<uint2*>(O + tok * 1024 + h * 64 + dt * 16 + 4 * fq) = pk;
    }
  }
}
DEV void phase_mla_attn(const Params& p) {
  const int nb = gridDim.x;
  for (int u = vstart(); u < NBATCH * 16 * 8; u += nb) mla_attn_unit(p, u);
}

#ifndef ONLY
#define ONLY -1
#endif
#define PH(n, ...) if (ONLY < 0 || ONLY == n) { __VA_ARGS__; }
constexpr int LDS_BAR_OFF = 148480;
__global__ void __launch_bounds__(512) mega(Params p) {
  cg::grid_group grid = cg::this_grid();
  unsigned* barw = reinterpret_cast<unsigned*>(p.ws + S_BAR);
  if (blockIdx.x == 0) for (int i = threadIdx.x; i < XCD_BAR_WORDS; i += 512) barw[i] = 0u;
  if (threadIdx.x == 0) *reinterpret_cast<uint4*>(smem + LDS_BAR_OFF) = make_uint4(0u, 0u, 0u, 0u);
  PH(0, phase_prep(p));
  grid.sync();
  (void)xcd_barrier_post(barw, (volatile LAS unsigned*)(smem + LDS_BAR_OFF));
#define GSYNC() do { XcdBarrier xb_; xb_.bar = reinterpret_cast<unsigned*>(p.ws + S_BAR); xb_.x = xb_xcc_id(); xb_.st = (volatile LAS unsigned*)(smem + LDS_BAR_OFF); xcd_barrier(xb_); } while (0)
  PH(1, phase_abin(p)); GSYNC();
  PH(2, phase_mix0(p)); GSYNC();
  PH(2, phase_ztrans(p)); GSYNC();
  PH(3, phase_outproj(p, reinterpret_cast<const u16*>(p.ws + REG_A + 100663296ull), reinterpret_cast<const u16*>(p.ws + W_ABOUT))); GSYNC();
  for (int layer = 0; layer < 2; ++layer) {
    if (layer == 1) {
      PH(10, phase_mla_in(p)); GSYNC();
      PH(11, phase_mla_norm(p)); GSYNC();
      PH(12, phase_mla_up(p)); GSYNC();
      PH(13, phase_mla_attn(p)); GSYNC();
      PH(3, phase_outproj(p, reinterpret_cast<const u16*>(p.ws + MLA_O), reinterpret_cast<const u16*>(p.ws + W_MLAOUT))); GSYNC();
    }
    PH(4, phase_ln1_router(p, layer)); GSYNC();
    PH(5, phase_topk(p)); GSYNC();
    PH(6, phase_moe1(p, layer)); GSYNC();
    PH(7, phase_moe2(p, layer)); GSYNC();
    PH(8, phase_ln2(p, layer)); GSYNC();
    PH(9, phase_ple(p, layer, layer ? p.out : nullptr, layer ? nullptr : reinterpret_cast<u16*>(p.ws + REG_X)));
    if (layer == 0) GSYNC();
  }
}

static void add_job(Params& P, int& nj, int& tile, const float* src, u16* dst, int K, int N, int rsh, int rs, int off, int count, long sstride, long dstride, int f8 = 0, float fscale = 1.0f) {
  ConvJob& J = P.jobs[nj++];
  J.src = src; J.dst = dst; J.sstride = sstride; J.dstride = dstride; J.K = K; J.N = N; J.rs = rs; J.off = off; J.rsh = rsh;
  J.f8 = f8; J.fscale = fscale;
  if (f8) { J.ntn = N / 128; J.tpm = (K / 128) * J.ntn; } else { J.ntn = (N + 255) / 256; J.tpm = (K / 64) * J.ntn; }
  J.tile0 = tile; J.ntiles = J.tpm * count;
  tile += J.ntiles;
}

extern "C" void kernel_launch(void* const* d_in, const int* in_sizes, int n_in,
                              void* d_out, int out_size, void* d_ws, size_t ws_size,
                              hipStream_t stream) {
  constexpr size_t kDynLds = 148480 + 16;
  static int grid_blocks = 0;
  if (!grid_blocks) {
    int dev = 0, cus = 0, per_cu = 0;
    (void)hipGetDevice(&dev);
    (void)hipDeviceGetAttribute(&cus, hipDeviceAttributeMultiprocessorCount, dev);
    (void)hipFuncSetAttribute((const void*)mega, hipFuncAttributeMaxDynamicSharedMemorySize, (int)kDynLds);
    (void)hipOccupancyMaxActiveBlocksPerMultiprocessor(&per_cu, mega, 512, kDynLds);
    if (per_cu > 1) per_cu = 1;
    if (per_cu < 1) { fprintf(stderr, "occupancy query returned 0\n"); per_cu = 1; }
    grid_blocks = cus * per_cu;
    if (ws_size < WS_TOTAL) fprintf(stderr, "workspace too small: %zu < %zu\n", ws_size, (size_t)WS_TOTAL);
  }
  Params P;
  memset(&P, 0, sizeof(P));
  auto F = [&](int i) { return (const float*)d_in[i]; };
  char* ws = (char*)d_ws;
  P.x = F(0); P.p = F(1);
  P.na_rpb = F(3); P.hy_conv_w = F(4); P.hy_conv_b = F(5);
  P.hy_f_w1 = F(6); P.hy_f_b1 = F(7); P.hy_f_freq = F(8); P.hy_f_w2 = F(9); P.hy_f_b2 = F(10); P.hy_f_w3 = F(11); P.hy_skip = F(12);
  P.mla_q_norm = F(15); P.mla_kv_norm = F(17);
  P.ln1_g = F(20); P.ln1_b = F(21); P.ln2_g = F(22); P.ln2_b = F(23);
  P.moe_router = F(24);
  P.out = (float*)d_out; P.ws = ws;
  int nj = 0, tile = 0;
  add_job(P, nj, tile, F(2), (u16*)(ws + W_ABIN), 1024, 3072, 7, 128, 0, 1, 0, 0);
  add_job(P, nj, tile, F(13), (u16*)(ws + W_ABOUT), 1024, 1024, 7, 128, 0, 1, 0, 0);
  add_job(P, nj, tile, F(14), (u16*)(ws + W_MLAIN), 1024, 672, 7, 128, 0, 1, 0, 0);
  add_job(P, nj, tile, F(16), (u16*)(ws + W_QUP), 384, 1536, 7, 128, 0, 1, 0, 0);
  add_job(P, nj, tile, F(18), (u16*)(ws + W_KVUP), 256, 2048, 6, 64, 0, 1, 0, 0);
  P.jobs[nj - 1].sh2 = 1; P.jobs[nj - 1].off2 = 1024;
  add_job(P, nj, tile, F(19), (u16*)(ws + W_MLAOUT), 1024, 1024, 7, 128, 0, 1, 0, 0);
  add_job(P, nj, tile, F(28), (u16*)(ws + W_PLEG), 1024, 1024, 7, 128, 0, 2, 1024L * 1024, 1024L * 1024);
  add_job(P, nj, tile, F(29), (u16*)(ws + W_PLEP), 256, 1024, 7, 128, 0, 2, 256L * 1024, 1024L * 256);
  P.conv_f8_first = tile;
  add_job(P, nj, tile, F(25), (u16*)(ws + W_GU), 1024, 2048, 7, 256, 0, 32, 1024L * 2048, 4096L * 1024, 1, 32.0f);
  add_job(P, nj, tile, F(26), (u16*)(ws + W_GU), 1024, 2048, 7, 256, 128, 32, 1024L * 2048, 4096L * 1024, 1, 32.0f);
  add_job(P, nj, tile, F(27), (u16*)(ws + W_DN), 2048, 1024, 7, 128, 0, 32, 2048L * 1024, 1024L * 2048, 1, 64.0f);
  P.conv_total = tile;
  void* args[] = {&P};
  hipError_t e = hipLaunchCooperativeKernel((void*)mega, dim3(grid_blocks), dim3(512), args, kDynLds, stream);
  if (e != hipSuccess) fprintf(stderr, "cooperative launch failed: %s (grid %d)\n", hipGetErrorString(e), grid_blocks);
}
```

```cpp
#include <hip/hip_runtime.h>
#include <hip/hip_bf16.h>
#include <hip/hip_cooperative_groups.h>
#include <cstdio>
#include <cstring>
namespace cg = cooperative_groups;

typedef unsigned short u16;
using bf16x8 = __attribute__((ext_vector_type(8))) short;
using bf16x4 = __attribute__((ext_vector_type(4))) short;
using f32x4 = __attribute__((ext_vector_type(4))) float;
#define DEV __device__ __forceinline__

constexpr int TOK = 16384, DM = 1024, SEQ = 2048, NBATCH = 8;
constexpr int NEXP = 16, CAP = 256, DFF = 2048;
constexpr float DN_ALPHA = 1.4142135623730951f;
constexpr float LN_EPS = 1e-5f;

constexpr size_t W_ABIN = 0;
constexpr size_t W_ABOUT = W_ABIN + 3072ull * 1024 * 2;
constexpr size_t W_MLAIN = W_ABOUT + 1024ull * 1024 * 2;
constexpr size_t W_QUP = W_MLAIN + 768ull * 1024 * 2;
constexpr size_t W_KVUP = W_QUP + 1536ull * 384 * 2;
constexpr size_t W_MLAOUT = W_KVUP + 2048ull * 256 * 2;
constexpr size_t W_PLEG = W_MLAOUT + 1024ull * 1024 * 2;
constexpr size_t W_PLEP = W_PLEG + 2 * 1024ull * 1024 * 2;
constexpr size_t W_GU = W_PLEP + 2 * 1024ull * 256 * 2;
constexpr size_t W_DN = W_GU + 2 * 16ull * 4096 * 1024 * 2;
constexpr size_t REG_A = W_DN + 2 * 16ull * 1024 * 2048 * 2;
constexpr size_t REG_B = REG_A + 134217728ull;
constexpr size_t REG_C = REG_B + 134217728ull;
constexpr size_t REG_D = REG_C + 67108864ull;
constexpr size_t REG_E = REG_D + 67108864ull;
constexpr size_t REG_G = REG_E + 33554432ull;
constexpr size_t REG_X = REG_G + 67108864ull;
constexpr size_t REG_P = REG_X + 33554432ull;
constexpr size_t S_AFF = REG_P + 16777216ull;
constexpr size_t S_IDX = S_AFF + 1048576ull;
constexpr size_t S_GSEL = S_IDX + 131072ull;
constexpr size_t S_SLOT = S_GSEL + 131072ull;
constexpr size_t S_H2 = S_SLOT + 1048576ull;
constexpr size_t S_RG = S_H2 + 524288ull;
constexpr size_t S_ROPE = S_RG + 8388608ull;
constexpr size_t S_BAR = S_ROPE + 262144ull;
constexpr size_t WS_TOTAL = S_BAR + 16384ull;

struct ConvJob {
  const float* src; u16* dst;
  long sstride, dstride;
  int K, N;
  int rs, off;
  int rsh, sh2, off2, f8;
  float fscale; int padk;
  int ntn;
  int tpm;
  int tile0, ntiles;
};
constexpr int NJOBS = 16;

struct Params {
  const float* x; const float* p;
  const float* na_rpb; const float* hy_conv_w; const float* hy_conv_b;
  const float* hy_f_w1; const float* hy_f_b1; const float* hy_f_freq; const float* hy_f_w2; const float* hy_f_b2;
  const float* hy_f_w3; const float* hy_skip;
  const float* mla_q_norm; const float* mla_kv_norm;
  const float* ln1_g; const float* ln1_b; const float* ln2_g; const float* ln2_b;
  const float* moe_router;
  float* out; char* ws;
  int conv_total; int conv_f8_first;
  ConvJob jobs[NJOBS];
};

extern __shared__ __attribute__((aligned(16))) char smem[];

typedef __bf16 bf16x2_t __attribute__((ext_vector_type(2)));
typedef float f32x2_t __attribute__((ext_vector_type(2)));
DEV unsigned cvt_pk_bf16(float lo, float hi) { f32x2_t f = {lo, hi}; bf16x2_t b = __builtin_convertvector(f, bf16x2_t); return __builtin_bit_cast(unsigned, b); }
DEV u16 f2bf(float f) { return (u16)(cvt_pk_bf16(f, 0.f) & 0xffffu); }
DEV float bf2f(u16 h) { return __uint_as_float(((unsigned)h) << 16); }
DEV unsigned pack2(float a, float b) { return cvt_pk_bf16(a, b); }
DEV unsigned pack4_f8(float a, float b, float c, float d) { int w = 0; w = __builtin_amdgcn_cvt_pk_fp8_f32(a, b, w, false); w = __builtin_amdgcn_cvt_pk_fp8_f32(c, d, w, true); return (unsigned)w; }
DEV float4 bf4_to_f4(uint2 t) { return make_float4(__uint_as_float(t.x << 16), __uint_as_float(t.x & 0xffff0000u), __uint_as_float(t.y << 16), __uint_as_float(t.y & 0xffff0000u)); }
DEV float fsigmoid(float x) { return __builtin_amdgcn_rcpf(1.0f + __builtin_amdgcn_exp2f(-1.4426950408889634f * x)); }
template <int CTRL> DEV float dpp_f(float v) { return __builtin_bit_cast(float, __builtin_amdgcn_update_dpp(0, __builtin_bit_cast(int, v), CTRL, 0xf, 0xf, true)); }
DEV float row_allsum(float v) { v += dpp_f<0xB1>(v); v += dpp_f<0x4E>(v); v += dpp_f<0x141>(v); v += dpp_f<0x140>(v); return v; }
DEV float row_allmax(float v) { v = fmaxf(v, dpp_f<0xB1>(v)); v = fmaxf(v, dpp_f<0x4E>(v)); v = fmaxf(v, dpp_f<0x141>(v)); v = fmaxf(v, dpp_f<0x140>(v)); return v; }
DEV float rdl(float v, int l) { return __builtin_bit_cast(float, __builtin_amdgcn_readlane(__builtin_bit_cast(int, v), l)); }
DEV float wave_sum(float v) { v = row_allsum(v); return (rdl(v, 0) + rdl(v, 16)) + (rdl(v, 32) + rdl(v, 48)); }
DEV int otid() { int t = threadIdx.x; asm volatile("" : "+v"(t)); return t; }
DEV int vstart() {
  int nb = gridDim.x, b = blockIdx.x;
  return (nb % 8 == 0) ? (b % 8) * (nb / 8) + b / 8 : b;
}


#define XB_TMO      128
#define XB_XCNT(j)  (256  + 64 * (j))
#define XB_XSUB(j)  (1280 + 64 * (j))
#define XB_XGEN(j)  (2304 + 64 * (j))
#define XB_TOP      3328
#define XB_TOPGEN   3392
#define XCD_BAR_WORDS 3456
#define XB_SPIN_CAP (1u << 18)
#define LAS __attribute__((address_space(3)))
DEV unsigned xb_ld(unsigned* p) { return __hip_atomic_load(p, __ATOMIC_RELAXED, __HIP_MEMORY_SCOPE_AGENT); }
DEV unsigned xb_add(unsigned* p, unsigned v) { return __hip_atomic_fetch_add(p, v, __ATOMIC_RELAXED, __HIP_MEMORY_SCOPE_AGENT); }
DEV unsigned xb_xcc_id() { return (unsigned)__builtin_amdgcn_s_getreg((3 << 11) | 20) & 0xFu; }
#define XB_SPIN(cond, bar) do { unsigned _sp = 0; while (cond) { __builtin_amdgcn_s_sleep(1); \
    if ((++_sp & 255u) == 0u) { if (xb_ld(&(bar)[XB_TMO])) break; if (_sp > XB_SPIN_CAP) { atomicAdd(&(bar)[XB_TMO], 1u); break; } } } } while (0)
struct XcdBarrier { unsigned* bar; unsigned x; volatile LAS unsigned* st; };
DEV XcdBarrier xcd_barrier_post(unsigned* bar, volatile LAS unsigned* st) {
  XcdBarrier b; b.bar = bar; b.x = xb_xcc_id(); b.st = st;
  if (threadIdx.x == 0) (void)xb_add(&bar[XB_XCNT(b.x)], 1u);
  return b;
}
DEV void xcd_barrier_complete(unsigned* bar, unsigned x, unsigned& nloc, unsigned& nx) {
  const unsigned G = gridDim.x * gridDim.y * gridDim.z;
  unsigned sum, cnt, mine, sp = 0u;
  for (;;) {
    sum = 0u; cnt = 0u; mine = 0u;
#pragma unroll
    for (unsigned j = 0; j < 16; ++j) { const unsigned c = xb_ld(&bar[XB_XCNT(j)]); sum += c; cnt += (c > 0u) ? 1u : 0u; mine = (j == x) ? c : mine; }
    if (sum == G) break;
    __builtin_amdgcn_s_sleep(1);
    if ((++sp & 255u) == 0u) { if (xb_ld(&bar[XB_TMO])) break; if (sp > XB_SPIN_CAP) { atomicAdd(&bar[XB_TMO], 1u); break; } }
  }
  nloc = mine > 0u ? mine : 1u; nx = cnt > 0u ? cnt : 1u;
}
DEV void xcd_barrier(const XcdBarrier& b) {
  asm volatile("s_waitcnt vmcnt(0)" ::: "memory");
  __syncthreads();
  if (threadIdx.x == 0) {
    unsigned* bar = b.bar;
    __builtin_amdgcn_s_waitcnt(0);
    unsigned nloc = b.st[0], nx = b.st[1];
    if (nloc == 0u) { xcd_barrier_complete(bar, b.x, nloc, nx); b.st[0] = nloc; b.st[1] = nx; }
    const unsigned old = xb_add(&bar[XB_XSUB(b.x)], 1u);
    const unsigned gen = old / nloc;
    if (old + 1u == (gen + 1u) * nloc) {
      __builtin_amdgcn_fence(__ATOMIC_RELEASE, "agent");
      asm volatile("s_waitcnt vmcnt(0)" ::: "memory");
      const unsigned og = xb_add(&bar[XB_TOP], 1u);
      const unsigned tg = og / nx;
      if (og + 1u == (tg + 1u) * nx) xb_add(&bar[XB_TOPGEN], 1u);
      else XB_SPIN(xb_ld(&bar[XB_TOPGEN]) == tg, bar);
      __builtin_amdgcn_fence(__ATOMIC_ACQUIRE, "agent");
      xb_add(&bar[XB_XGEN(b.x)], 1u);
      asm volatile("s_waitcnt vmcnt(0)" ::: "memory");
    } else {
      XB_SPIN(xb_ld(&bar[XB_XGEN(b.x)]) == gen, bar);
      __builtin_amdgcn_fence(__ATOMIC_ACQUIRE, "agent");
      asm volatile("s_waitcnt vmcnt(0)" ::: "memory");
    }
  }
  __syncthreads();
}

DEV int lds_byte(int r, int c) {
  int st = (r >> 4) * 2 + (c >> 5), rr = r & 15, cc = c & 31, ob = rr * 64 + cc * 2;
  return st * 1024 + (ob ^ (((ob >> 9) & 1) << 5));
}
DEV void stage_rc(int b, int& R, int& C) {
  int st = b / 1024, sb = b % 1024, swz = sb ^ (((sb >> 9) & 1) << 5);
  R = (st >> 1) * 16 + swz / 64; C = (st & 1) * 32 + (swz % 64) / 2;
}
#define GLDS16(g, l) __builtin_amdgcn_global_load_lds((const unsigned*)(g), (unsigned*)(l), 16, 0, 0)

typedef f32x4 Acc8[2][2][4][2];
constexpr int G8_BM = 256, G8_BK = 64, G8_HALF = 128, G8_HTB = G8_HALF * G8_BK * 2, G8_NXCD = 8, G8_WGM = 8;
DEV int perm32(int rho) { const int n = rho >> 4, i = rho & 15; return 8 * (i >> 2) + 4 * n + (i & 3); }
struct Unit { int pm, pn; };
DEV bool unit_next(int i, int nM, int nN, Unit& u) {
  const int nwg = nM * nN;
  const long L = (long)i * gridDim.x + blockIdx.x; if (L >= nwg) return false;
  int wgid = (int)L; { const int q = nwg / G8_NXCD, r = nwg % G8_NXCD, xcd = wgid % G8_NXCD, off = wgid / G8_NXCD; wgid = (xcd < r ? xcd * (q + 1) : r * (q + 1) + (xcd - r) * q) + off; }
  const int nig = G8_WGM * nN, gid = wgid / nig, fm = gid * G8_WGM, gsz = (nM - fm) < G8_WGM ? (nM - fm) : G8_WGM;
  u.pm = fm + ((wgid % nig) % gsz); u.pn = (wgid % nig) / gsz; return true;
}
typedef int v4i_t __attribute__((ext_vector_type(4)));
typedef int v8i_t __attribute__((ext_vector_type(8)));
template <bool TR, bool PERM, bool F8, class PF, class EF>
DEV void gemm_phase(const int K, const int nM, const int nN, PF ptrs, EF E) {
  LAS unsigned char* lds = (LAS unsigned char*)smem;
  const int tid = otid(), wid = __builtin_amdgcn_readfirstlane(tid >> 6), lane = tid & 63, wr = wid >> 2, wc = wid & 3, fr = lane & 15, fq = lane >> 4;
  const int Kb = F8 ? K : 2 * K;
  const int nt = Kb / 128;
  unsigned voffA[2], voffB[2];
#pragma unroll
  for (int i = 0; i < 2; ++i) { int R, C; stage_rc(tid * 16 + i * 8192, R, C); const int Rb = PERM ? ((R & ~31) + perm32(R & 31)) : R;
    voffA[i] = (unsigned)(R * Kb + C * 2); voffB[i] = (unsigned)(Rb * Kb + C * 2); }
  const size_t kstep = (size_t)(G8_BK * 2);
  const size_t hstep = (size_t)G8_HALF * Kb;
  const unsigned ldsw = (unsigned)wid * 1024u;
  const int aoff = lds_byte(wr * 64 + fr, fq * 8), boff = lds_byte(wc * 32 + fr, fq * 8);
#define PG8_SA(b, h) (((b) * 2 + (h)) * G8_HTB)
#define PG8_SB(b, h) ((4 + (b) * 2 + (h)) * G8_HTB)
#define PG8_STAGE(bufoff, gbase, voff) do { _Pragma("unroll") for (int _i = 0; _i < 2; ++_i) { unsigned _vo = (voff)[_i]; asm volatile("" : "+v"(_vo)); \
    __builtin_amdgcn_global_load_lds((const unsigned*)((const char*)(gbase) + _vo), (LAS unsigned*)(lds + (bufoff) + ldsw + _i * 8192), 16, 0, 0); } } while (0)
#define PG8_LD16(off) (*(const LAS v4i_t*)(lds + (off)))
#define PG8_LDA(dst, b, h) do { if constexpr (F8) { _Pragma("unroll") for (int m = 0; m < 4; ++m) dst##8[m] = __builtin_shufflevector(PG8_LD16(PG8_SA(b, h) + aoff + m * 2048), PG8_LD16(PG8_SA(b, h) + aoff + m * 2048 + 1024), 0, 1, 2, 3, 4, 5, 6, 7); } \
    else { _Pragma("unroll") for (int m = 0; m < 4; ++m) _Pragma("unroll") for (int k = 0; k < 2; ++k) dst[m][k] = *(const LAS bf16x8*)(lds + PG8_SA(b, h) + aoff + m * 2048 + k * 1024); } } while (0)
#define PG8_LDB(dst, b, h) do { if constexpr (F8) { _Pragma("unroll") for (int n = 0; n < 2; ++n) dst##8[n] = __builtin_shufflevector(PG8_LD16(PG8_SB(b, h) + boff + n * 2048), PG8_LD16(PG8_SB(b, h) + boff + n * 2048 + 1024), 0, 1, 2, 3, 4, 5, 6, 7); } \
    else { _Pragma("unroll") for (int n = 0; n < 2; ++n) _Pragma("unroll") for (int k = 0; k < 2; ++k) dst[n][k] = *(const LAS bf16x8*)(lds + PG8_SB(b, h) + boff + n * 2048 + k * 1024); } } while (0)
#define PG8_MMA(ai, bj, At, Bt) do { __builtin_amdgcn_s_setprio(1); \
    if constexpr (F8) { _Pragma("unroll") for (int m = 0; m < 4; ++m) _Pragma("unroll") for (int n = 0; n < 2; ++n) \
        { if constexpr (TR) asm volatile("v_mfma_f32_16x16x128_f8f6f4 %0, %1, %2, %0" : "+v"(acc[ai][bj][m][n]) : "v"(Bt##8[n]), "v"(At##8[m])); \
          else asm volatile("v_mfma_f32_16x16x128_f8f6f4 %0, %1, %2, %0" : "+v"(acc[ai][bj][m][n]) : "v"(At##8[m]), "v"(Bt##8[n])); } } \
    else { _Pragma("unroll") for (int m = 0; m < 4; ++m) _Pragma("unroll") for (int n = 0; n < 2; ++n) _Pragma("unroll") for (int k = 0; k < 2; ++k) \
    acc[ai][bj][m][n] = TR ? __builtin_amdgcn_mfma_f32_16x16x32_bf16(Bt[n][k], At[m][k], acc[ai][bj][m][n], 0, 0, 0) \
                           : __builtin_amdgcn_mfma_f32_16x16x32_bf16(At[m][k], Bt[n][k], acc[ai][bj][m][n], 0, 0, 0); } __builtin_amdgcn_s_setprio(0); } while (0)
#define PG8_WAIT_V(n) asm volatile("s_waitcnt vmcnt(" #n ")" ::: "memory")
#define PG8_WAIT_L(n) asm volatile("s_waitcnt lgkmcnt(" #n ")" ::: "memory")
#define PG8_BAR __builtin_amdgcn_s_barrier()
#define PG8_SCHED __builtin_amdgcn_sched_barrier(0)
  Unit cur, nxt; int ui = 0;
  if (!unit_next(0, nM, nN, cur)) return;
  Acc8 acc;
#pragma unroll
  for (int a = 0; a < 2; ++a)
#pragma unroll
    for (int b = 0; b < 2; ++b)
#pragma unroll
      for (int m = 0; m < 4; ++m)
#pragma unroll
        for (int n = 0; n < 2; ++n) acc[a][b][m][n] = f32x4{0.f, 0.f, 0.f, 0.f};
  bf16x8 At[4][2], B0[2][2], B1[2][2];
  v8i_t At8[4], B08[2], B18[2];
  const char* cA; const char* cB;
  ptrs(cur, cA, cB);
  PG8_STAGE(PG8_SB(0, 0), cB, voffB); PG8_STAGE(PG8_SA(0, 0), cA, voffA); PG8_STAGE(PG8_SB(0, 1), cB + hstep, voffB); PG8_STAGE(PG8_SA(0, 1), cA + hstep, voffA);
  if (wr == 1) PG8_BAR;
  PG8_WAIT_V(4); PG8_BAR;
  PG8_STAGE(PG8_SB(1, 0), cB + kstep, voffB); PG8_STAGE(PG8_SA(1, 0), cA + kstep, voffA); PG8_STAGE(PG8_SB(1, 1), cB + hstep + kstep, voffB);
  PG8_WAIT_V(6); PG8_BAR;
  for (;;) {
    const bool has_next = unit_next(ui + 1, nM, nN, nxt);
    const char* nA = cA; const char* nB = cB;
    if (has_next) ptrs(nxt, nA, nB);
#pragma unroll 1
    for (int t = 0; t < nt; t += 2) {
      const bool last = (t == nt - 2);
      const char* a1 = cA + (size_t)(t + 1) * kstep;
      const char* a2 = last ? nA : cA + (size_t)(t + 2) * kstep; const char* b2 = last ? nB : cB + (size_t)(t + 2) * kstep;
      const char* a3 = a2 + kstep; const char* b3 = b2 + kstep;
      PG8_LDB(B0, 0, 0); PG8_SCHED; PG8_LDA(At, 0, 0); PG8_STAGE(PG8_SA(1, 1), a1 + hstep, voffA);
      PG8_WAIT_L(8); PG8_BAR; PG8_WAIT_L(0); PG8_MMA(0, 0, At, B0); PG8_BAR; PG8_SCHED;
      PG8_LDB(B1, 0, 1); PG8_STAGE(PG8_SB(0, 0), b2, voffB);
      PG8_BAR; PG8_WAIT_L(0); PG8_MMA(0, 1, At, B1); PG8_BAR;
      PG8_LDA(At, 0, 1); PG8_STAGE(PG8_SA(0, 0), a2, voffA);
      PG8_BAR; PG8_WAIT_L(0); PG8_MMA(1, 0, At, B0); PG8_BAR; PG8_SCHED;
      PG8_STAGE(PG8_SB(0, 1), b2 + hstep, voffB);
      PG8_WAIT_V(6); PG8_BAR; PG8_MMA(1, 1, At, B1); PG8_BAR;
      PG8_LDB(B0, 1, 0); PG8_SCHED; PG8_LDA(At, 1, 0); PG8_STAGE(PG8_SA(0, 1), a2 + hstep, voffA);
      PG8_WAIT_L(8); PG8_BAR; PG8_WAIT_L(0); PG8_MMA(0, 0, At, B0); PG8_BAR; PG8_SCHED;
      PG8_LDB(B1, 1, 1); PG8_STAGE(PG8_SB(1, 0), b3, voffB);
      PG8_BAR; PG8_WAIT_L(0); PG8_MMA(0, 1, At, B1); PG8_BAR;
      PG8_LDA(At, 1, 1); PG8_STAGE(PG8_SA(1, 0), a3, voffA);
      PG8_BAR; PG8_WAIT_L(0); PG8_MMA(1, 0, At, B0); PG8_BAR; PG8_SCHED;
      PG8_STAGE(PG8_SB(1, 1), b3 + hstep, voffB);
      PG8_WAIT_V(6); PG8_BAR; PG8_MMA(1, 1, At, B1); PG8_BAR;
    }
    if constexpr (F8) asm volatile("s_nop 15\n\ts_nop 15" ::: "memory");
    { const int l2 = otid() & 63; E(acc, cur, wr, wc, l2 & 15, l2 >> 4); }
    if (!has_next) break;
#pragma unroll
    for (int a = 0; a < 2; ++a)
#pragma unroll
      for (int b = 0; b < 2; ++b)
#pragma unroll
        for (int m = 0; m < 4; ++m)
#pragma unroll
          for (int n = 0; n < 2; ++n) acc[a][b][m][n] = f32x4{0.f, 0.f, 0.f, 0.f};
    cur = nxt; cA = nA; cB = nB; ++ui;
  }
  PG8_WAIT_V(0);
  if (wr == 0) PG8_BAR;
  PG8_BAR;
#undef PG8_SA
#undef PG8_SB
#undef PG8_STAGE
#undef PG8_LDA
#undef PG8_LD16
#undef PG8_LDB
#undef PG8_MMA
#undef PG8_WAIT_V
#undef PG8_WAIT_L
#undef PG8_BAR
#undef PG8_SCHED
}
#define E8_FOR _Pragma("unroll") for (int ai = 0; ai < 2; ++ai) _Pragma("unroll") for (int m = 0; m < 4; ++m) _Pragma("unroll") for (int bj = 0; bj < 2; ++bj)

DEV void conv_tile(const ConvJob& J, int t) {
  const int tid = otid();
  int mat = t / J.tpm, tt = t % J.tpm;
  int kt = tt / J.ntn, nt = tt % J.ntn;
  const float* src = J.src + (long)mat * J.sstride;
  u16* dst = J.dst + (long)mat * J.dstride;
  const int kg = tid >> 6, ng = tid & 63;
  const int n = nt * 256 + ng * 4;
  float4 v[8];
#pragma unroll
  for (int j = 0; j < 8; ++j) {
    int k = kt * 64 + kg * 8 + j;
    if (n < J.N) { const f32x4 t_ = __builtin_nontemporal_load(reinterpret_cast<const f32x4*>(src + (long)k * J.N + n)); v[j] = make_float4(t_[0], t_[1], t_[2], t_[3]); }
    else v[j] = make_float4(0.f, 0.f, 0.f, 0.f);
  }
#pragma unroll
  for (int i = 0; i < 4; ++i) {
    float e[8];
#pragma unroll
    for (int j = 0; j < 8; ++j) e[j] = (i == 0) ? v[j].x : (i == 1) ? v[j].y : (i == 2) ? v[j].z : v[j].w;
    uint4 pk;
    pk.x = pack2(e[0], e[1]); pk.y = pack2(e[2], e[3]); pk.z = pack2(e[4], e[5]); pk.w = pack2(e[6], e[7]);
    *reinterpret_cast<uint4*>(smem + (i * 64 + ng) * 144 + kg * 16) = pk;
  }
  __syncthreads();
#pragma unroll
  for (int u = 0; u < 4; ++u) {
    int q = tid + 512 * u;
    int nl = q >> 3, ch = q & 7;
    uint4 pk = *reinterpret_cast<const uint4*>(smem + ((nl & 3) * 64 + (nl >> 2)) * 144 + ch * 16);
    int nn = nt * 256 + nl;
    const int qq = nn >> J.rsh;
    long drow = (long)(qq >> J.sh2) * J.rs + (qq & ((1 << J.sh2) - 1)) * J.off2 + (nn & ((1 << J.rsh) - 1)) + J.off;
    *reinterpret_cast<uint4*>(dst + drow * J.K + kt * 64 + ch * 8) = pk;
  }
  __syncthreads();
}

struct F8Tile { const float* src; unsigned char* dst; int N, K, kt, nt, rsh, sh2, rs, off2, off; float sc; };
DEV void f8_decode(const Params& p, int t, F8Tile& T) {
  int j = 0;
#pragma unroll 1
  for (int q = 1; q < NJOBS; ++q) if (t >= p.jobs[q].tile0 && p.jobs[q].ntiles > 0) j = q;
  const ConvJob& J = p.jobs[j];
  const int tl = t - J.tile0;
  const int mat = tl / J.tpm, tt = tl % J.tpm;
  T.kt = tt / J.ntn; T.nt = tt % J.ntn;
  T.src = J.src + (long)mat * J.sstride;
  T.dst = reinterpret_cast<unsigned char*>(J.dst) + (long)mat * J.dstride;
  T.N = J.N; T.K = J.K; T.rsh = J.rsh; T.sh2 = J.sh2; T.rs = J.rs; T.off2 = J.off2; T.off = J.off; T.sc = J.fscale;
}
DEV void f8_load(const F8Tile& T, float4 (&v)[8]) {
  const int tid = otid(), kg = tid >> 5, ng = tid & 31;
  const float* s0 = T.src + (long)(T.kt * 128 + kg * 8) * T.N + T.nt * 128 + ng * 4;
#pragma unroll
  for (int j = 0; j < 8; ++j) { const f32x4 t_ = __builtin_nontemporal_load(reinterpret_cast<const f32x4*>(s0 + (long)j * T.N)); v[j] = make_float4(t_[0], t_[1], t_[2], t_[3]); }
}
DEV void f8_emit(const F8Tile& T, const float4 (&v)[8], char* img) {
  const int tid = otid(), kg = tid >> 5, ng = tid & 31;
#pragma unroll
  for (int i = 0; i < 4; ++i) {
    float e[8];
#pragma unroll
    for (int j = 0; j < 8; ++j) e[j] = ((i == 0) ? v[j].x : (i == 1) ? v[j].y : (i == 2) ? v[j].z : v[j].w) * T.sc;
    uint2 pk; pk.x = pack4_f8(e[0], e[1], e[2], e[3]); pk.y = pack4_f8(e[4], e[5], e[6], e[7]);
    *reinterpret_cast<uint2*>(img + (i * 32 + ng) * 144 + kg * 8) = pk;
  }
  __syncthreads();
#pragma unroll
  for (int u = 0; u < 2; ++u) {
    int q = tid + 512 * u;
    int nl = q >> 3, ch = q & 7;
    uint4 pk = *reinterpret_cast<const uint4*>(img + ((nl & 3) * 32 + (nl >> 2)) * 144 + ch * 16);
    int nn = T.nt * 128 + nl;
    const int qq = nn >> T.rsh;
    long drow = (long)(qq >> T.sh2) * T.rs + (qq & ((1 << T.sh2) - 1)) * T.off2 + (nn & ((1 << T.rsh) - 1)) + T.off;
    *reinterpret_cast<uint4*>(T.dst + drow * T.K + T.kt * 128 + ch * 16) = pk;
  }
}
DEV void f8_stream(const Params& p, int first, int total) {
  const int nb = gridDim.x;
  int t = first + blockIdx.x;
  if (t >= total) return;
  float4 va[8], vb[8];
  F8Tile Ta, Tb;
  f8_decode(p, t, Ta); f8_load(Ta, va);
  __syncthreads();
  for (;;) {
    int tn = t + nb;
    f8_decode(p, min(tn, total - 1), Tb); f8_load(Tb, vb);
    f8_emit(Ta, va, smem);
    if (tn >= total) break;
    t = tn; tn = t + nb;
    f8_decode(p, min(tn, total - 1), Ta); f8_load(Ta, va);
    f8_emit(Tb, vb, smem + 18432);
    if (tn >= total) break;
    t = tn;
  }
  __syncthreads();
}

DEV void phase_prep(const Params& p) {
  const int tid = otid(), nb = gridDim.x, bid = blockIdx.x;
  {
    float* zb = reinterpret_cast<float*>(smem);
    float* h1b = zb + 512;
    float* h2g = reinterpret_cast<float*>(p.ws + S_H2);
    const int w = tid >> 6, lane = tid & 63;
    for (int l0 = bid * 8; l0 < SEQ; l0 += nb * 8) {
      int l = l0 + w;
      float tt = (float)l / (float)(SEQ - 1);
      float ww = 6.283185307179586f * (float)l / (float)SEQ;
      float z = 0.f;
      if (lane == 0) z = tt;
      else if (lane <= 16) { float f = 1e-4f + (float)(lane - 1) * ((15.0f - 1e-4f) / 15.0f); z = cosf(f * ww); }
      else if (lane <= 32) { float f = 1e-4f + (float)(lane - 17) * ((15.0f - 1e-4f) / 15.0f); z = -sinf(f * ww); }
      zb[w * 64 + lane] = z;
      __syncthreads();
      float fr_ = p.hy_f_freq[lane];
      float a = p.hy_f_b1[lane];
      for (int k = 0; k < 33; ++k) a += zb[w * 64 + k] * p.hy_f_w1[k * 64 + lane];
      h1b[w * 64 + lane] = sinf(fr_ * a);
      __syncthreads();
      float a2 = p.hy_f_b2[lane];
      for (int k = 0; k < 64; ++k) a2 += h1b[w * 64 + k] * p.hy_f_w2[k * 64 + lane];
      h2g[l * 64 + lane] = sinf(fr_ * a2);
      __syncthreads();
    }
  }
  {
    float2* rt = reinterpret_cast<float2*>(p.ws + S_ROPE);
    for (int i = bid * 512 + tid; i < SEQ * 16; i += nb * 512) {
      const int l = i >> 4, k = i & 15;
      float sn, cs; sincosf((float)l * (1.0f / powf(10000.0f, (float)k / 16.0f)), &sn, &cs);
      rt[i] = make_float2(cs, sn);
    }
  }
  {
    u16* xb = reinterpret_cast<u16*>(p.ws + REG_X);
    const long n8 = (long)TOK * DM / 8;
#pragma unroll 4
    for (long i = (long)bid * 512 + tid; i < n8; i += (long)nb * 512) {
      const f32x4 a_ = __builtin_nontemporal_load(reinterpret_cast<const f32x4*>(p.x) + 2 * i), b_ = __builtin_nontemporal_load(reinterpret_cast<const f32x4*>(p.x) + 2 * i + 1);
      const float4 a = make_float4(a_[0], a_[1], a_[2], a_[3]), b = make_float4(b_[0], b_[1], b_[2], b_[3]);
      uint4 pk; pk.x = pack2(a.x, a.y); pk.y = pack2(a.z, a.w); pk.z = pack2(b.x, b.y); pk.w = pack2(b.z, b.w);
      reinterpret_cast<uint4*>(xb)[i] = pk;
    }
    u16* pb = reinterpret_cast<u16*>(p.ws + REG_P);
    const long m8 = 2L * TOK * 256 / 8;
#pragma unroll 4
    for (long i = (long)bid * 512 + tid; i < m8; i += (long)nb * 512) {
      const f32x4 a_ = __builtin_nontemporal_load(reinterpret_cast<const f32x4*>(p.p) + 2 * i), b_ = __builtin_nontemporal_load(reinterpret_cast<const f32x4*>(p.p) + 2 * i + 1);
      const float4 a = make_float4(a_[0], a_[1], a_[2], a_[3]), b = make_float4(b_[0], b_[1], b_[2], b_[3]);
      uint4 pk; pk.x = pack2(a.x, a.y); pk.y = pack2(a.z, a.w); pk.z = pack2(b.x, b.y); pk.w = pack2(b.z, b.w);
      reinterpret_cast<uint4*>(pb)[i] = pk;
    }
  }
  for (int t = bid; t < p.conv_f8_first; t += nb) {
    int j = 0;
#pragma unroll 1
    for (int q = 1; q < NJOBS; ++q) if (t >= p.jobs[q].tile0 && p.jobs[q].ntiles > 0) j = q;
    conv_tile(p.jobs[j], t - p.jobs[j].tile0);
  }
  f8_stream(p, p.conv_f8_first, p.conv_total);
}

DEV void filter_b(const Params& p, int cpair) {
  const int tid = otid();
  float* w3s = reinterpret_cast<float*>(smem);
  float* red = w3s + 512;
  float* nrm = red + 32;
  float* hb = nrm + 4;
  const float* h2g = reinterpret_cast<const float*>(p.ws + S_H2);
  {
    int ci = tid >> 6, k = tid & 63;
    int o = ci >> 2, d = (ci >> 1) & 1, cc = ci & 1;
    w3s[ci * 64 + k] = p.hy_f_w3[k * 2048 + o * 1024 + d * 512 + 2 * cpair + cc];
  }
  __syncthreads();
  const float min_decay = logf(1e-2f) / 1.5f, max_decay = logf(1e-2f) / 0.3f;
#pragma unroll 1
  for (int i = 0; i < 4; ++i) {
    int l = tid + 512 * i;
    float h2[64];
#pragma unroll
    for (int k = 0; k < 16; ++k) {
      float4 v = *reinterpret_cast<const float4*>(h2g + l * 64 + k * 4);
      h2[4 * k] = v.x; h2[4 * k + 1] = v.y; h2[4 * k + 2] = v.z; h2[4 * k + 3] = v.w;
    }
    float tt = (float)l / (float)(SEQ - 1);
#pragma unroll 1
    for (int ci = 0; ci < 8; ++ci) {
      float a = 0.f;
#pragma unroll
      for (int k = 0; k < 64; ++k) a += h2[k] * w3s[ci * 64 + k];
      int cc = ci & 1;
      int c = 2 * cpair + cc;
      float delta = fabsf(min_decay + (float)c * ((max_decay - min_decay) / 511.0f));
      a *= expf(-tt * delta);
      hb[ci * 2048 + l] = a;
    }
  }
  __syncthreads();
  {
    float ss[4];
#pragma unroll
    for (int oc = 0; oc < 4; ++oc) {
      int o = oc >> 1, cc = oc & 1;
      float a = 0.f;
      for (int l = tid; l < 2048; l += 512) {
        float f = hb[(o * 4 + 0 + cc) * 2048 + l];
        float b = (l > 0) ? hb[(o * 4 + 2 + cc) * 2048 + l] : 0.f;
        a += f * f + b * b;
      }
      ss[oc] = wave_sum(a);
    }
    if ((tid & 63) == 0) {
#pragma unroll
      for (int q = 0; q < 4; ++q) red[(tid >> 6) * 4 + q] = ss[q];
    }
  }
  __syncthreads();
  if (tid < 4) {
    float s = 0.f;
    for (int w = 0; w < 8; ++w) s += red[w * 4 + tid];
    nrm[tid] = rsqrtf(s + 1e-12f);
  }
  __syncthreads();
  u16* Rg = reinterpret_cast<u16*>(p.ws + S_RG);
  for (int q = tid; q < 4 * 4096; q += 512) {
    int oc = q >> 12, qq = q & 4095;
    int o = oc >> 1, cc = oc & 1;
    float v;
    if (qq == 0) v = 0.f;
    else if (qq <= 2048) v = hb[(o * 4 + 0 * 2 + cc) * 2048 + (2048 - qq)];
    else v = hb[(o * 4 + 1 * 2 + cc) * 2048 + (qq - 2048)];
    v *= nrm[oc];
    Rg[((long)o * 512 + 2 * cpair + cc) * 4096 + qq] = f2bf(v);
  }
  __syncthreads();
}

DEV void phase_abin(const Params& p) {
  const int nb = gridDim.x;
  for (int c = blockIdx.x; c < 256; c += nb) filter_b(p, c);
  const u16* xb = reinterpret_cast<const u16*>(p.ws + REG_X);
  const u16* wt = reinterpret_cast<const u16*>(p.ws + W_ABIN);
  u16* qk = reinterpret_cast<u16*>(p.ws + REG_B);
  u16* vht = reinterpret_cast<u16*>(p.ws + REG_B + 33554432ull);
  gemm_phase<true, true, false>(1024, 64, 4, [&](const Unit& u, const char*& a, const char*& b) { a = (const char*)(xb) + (size_t)u.pm * 256 * (1024) * 2; b = (const char*)(wt) + (size_t)u.pn * 256 * (1024) * 2; },
      [&](Acc8& acc, const Unit& u, int wr, int wc, int fr, int fq) {
        const float sc = (u.pn < 2) ? 0.125f : 1.0f;
        u16* base = qk + (long)(u.pm * 256 + wr * 64 + fr) * 1024 + u.pn * 256 + wc * 32 + 8 * fq;
        E8_FOR {
          f32x4 v0 = acc[ai][bj][m][0], v1 = acc[ai][bj][m][1];
          uint4 pk;
          pk.x = cvt_pk_bf16(v0[0] * sc, v0[1] * sc); pk.y = cvt_pk_bf16(v0[2] * sc, v0[3] * sc);
          pk.z = cvt_pk_bf16(v1[0] * sc, v1[1] * sc); pk.w = cvt_pk_bf16(v1[2] * sc, v1[3] * sc);
          *reinterpret_cast<uint4*>(base + (ai * 128 + m * 16) * 1024 + bj * 128) = pk;
        }
      });
  gemm_phase<false, false, false>(1024, 64, 8, [&](const Unit& u, const char*& a, const char*& b) { a = (const char*)(xb) + (size_t)u.pm * 256 * (1024) * 2; b = (const char*)(wt + 1024 * 1024) + (size_t)u.pn * 256 * (1024) * 2; },
      [&](Acc8& acc, const Unit& u, int wr, int wc, int fr, int fq) {
        u16* base = vht + (long)(u.pn * 256 + wc * 32 + fr) * TOK + u.pm * 256 + wr * 64 + 4 * fq;
        E8_FOR {
#pragma unroll
          for (int n = 0; n < 2; ++n) {
            f32x4 v = acc[ai][bj][m][n];
            uint2 pk; pk.x = cvt_pk_bf16(v[0], v[1]); pk.y = cvt_pk_bf16(v[2], v[3]);
            *reinterpret_cast<uint2*>(base + (long)(bj * 128 + n * 16) * TOK + ai * 128 + m * 16) = pk;
          }
        }
      });
}

constexpr int NA_VST = 580;
constexpr int NA_V_OFF = 576 * 128;
DEV void na_pair(const Params& p, int u) {
  const int tid = otid(), lane = tid & 63, wid = tid >> 6, fr = lane & 15, fq = lane >> 4;
  const int rp = u & 15, h = (u >> 4) & 7, b = u >> 7;
  const int rbase = min(max(2 * rp - 4, 0), 24);
  const int nrows = (rbase == 24) ? 8 : 9;
  const u16* qk = reinterpret_cast<const u16*>(p.ws + REG_B);
  const u16* vht = reinterpret_cast<const u16*>(p.ws + REG_B + 33554432ull);
  u16* cat = reinterpret_cast<u16*>(p.ws + REG_A + 100663296ull);
  char* kl = smem;
  u16* vl = reinterpret_cast<u16*>(smem + NA_V_OFF);
  const long tok0 = (long)b * SEQ + rbase * 64;
  __syncthreads();
#pragma unroll
  for (int i = 0; i < 9; ++i) {
    const int q = tid + 512 * i, key = q >> 3, ch = q & 7;
    if (key < nrows * 64) {
      uint4 v = *reinterpret_cast<const uint4*>(qk + (tok0 + key) * 1024 + 512 + h * 64 + ch * 8);
      *reinterpret_cast<uint4*>(kl + key * 128 + ((ch ^ ((key >> 1) & 7)) << 4)) = v;
    }
  }
#pragma unroll
  for (int i = 0; i < 9; ++i) {
    const int q = tid + 512 * i, d = q / 72, ch = q % 72;
    if (ch < nrows * 8) {
      uint4 v = *reinterpret_cast<const uint4*>(vht + (long)(h * 64 + d) * TOK + tok0 + ch * 8);
      u16* dst = vl + d * NA_VST + ch * 8;
      *reinterpret_cast<uint2*>(dst) = make_uint2(v.x, v.y);
      *reinterpret_cast<uint2*>(dst + 4) = make_uint2(v.z, v.w);
    }
  }
  __syncthreads();
  const int g = wid & 3, r = 2 * rp + (wid >> 2);
  const int r0 = min(max(r - 4, 0), 24), ro = r0 - rbase, cs = min(max(16 * g - 8, 0), 32);
  const int c = 16 * g + fr;
  const long tokq = (long)b * SEQ + r * 64 + c;
  bf16x8 qf[2];
#pragma unroll
  for (int ks = 0; ks < 2; ++ks) qf[ks] = *reinterpret_cast<const bf16x8*>(qk + tokq * 1024 + h * 64 + ks * 32 + fq * 8);
  f32x4 s[16];
#pragma unroll
  for (int kt = 0; kt < 16; ++kt) {
    const int w = kt >> 1, half = kt & 1;
    const int key = (ro + w) * 64 + cs + 16 * half + fr;
    const int sw = (key >> 1) & 7;
    bf16x8 k0 = *reinterpret_cast<const bf16x8*>(kl + key * 128 + ((fq ^ sw) << 4));
    bf16x8 k1 = *reinterpret_cast<const bf16x8*>(kl + key * 128 + (((4 + fq) ^ sw) << 4));
    f32x4 a = {0.f, 0.f, 0.f, 0.f};
    a = __builtin_amdgcn_mfma_f32_16x16x32_bf16(k0, qf[0], a, 0, 0, 0);
    a = __builtin_amdgcn_mfma_f32_16x16x32_bf16(k1, qf[1], a, 0, 0, 0);
    s[kt] = a;
  }
  const int c0 = min(max(c - 8, 0), 48);
  const float* rpb = p.na_rpb + h * 15 * 31;
  float mx = -1e30f;
#pragma unroll
  for (int kt = 0; kt < 16; ++kt) {
    const int w = kt >> 1, half = kt & 1;
    const int dr = r0 + w - r + 7;
#pragma unroll
    for (int j = 0; j < 4; ++j) {
      int kc = cs + 16 * half + 4 * fq + j;
      bool valid = (kc >= c0) && (kc < c0 + 16);
      int dc = min(max(kc - c, -15), 15) + 15;
      float bias = rpb[dr * 31 + dc];
      float v = valid ? (s[kt][j] + bias) : -1e30f;
      s[kt][j] = v;
      mx = fmaxf(mx, v);
    }
  }
  mx = fmaxf(mx, __shfl_xor(mx, 16));
  mx = fmaxf(mx, __shfl_xor(mx, 32));
  float sum = 0.f;
#pragma unroll
  for (int kt = 0; kt < 16; ++kt)
#pragma unroll
    for (int j = 0; j < 4; ++j) { float e = __expf(s[kt][j] - mx); s[kt][j] = e; sum += e; }
  sum += __shfl_xor(sum, 16);
  sum += __shfl_xor(sum, 32);
  f32x4 o[4];
#pragma unroll
  for (int dt = 0; dt < 4; ++dt) o[dt] = f32x4{0.f, 0.f, 0.f, 0.f};
#pragma unroll
  for (int w = 0; w < 8; ++w) {
    union { bf16x8 v; unsigned u[4]; } pf;
    pf.u[0] = cvt_pk_bf16(s[2 * w][0], s[2 * w][1]); pf.u[1] = cvt_pk_bf16(s[2 * w][2], s[2 * w][3]);
    pf.u[2] = cvt_pk_bf16(s[2 * w + 1][0], s[2 * w + 1][1]); pf.u[3] = cvt_pk_bf16(s[2 * w + 1][2], s[2 * w + 1][3]);
#pragma unroll
    for (int dt = 0; dt < 4; ++dt) {
      const u16* vp = vl + (dt * 16 + fr) * NA_VST + (ro + w) * 64 + cs + 4 * fq;
      union { bf16x8 v; uint2 u[2]; } af;
      af.u[0] = *reinterpret_cast<const uint2*>(vp);
      af.u[1] = *reinterpret_cast<const uint2*>(vp + 16);
      o[dt] = __builtin_amdgcn_mfma_f32_16x16x32_bf16(af.v, pf.v, o[dt], 0, 0, 0);
    }
  }
  const float inv = 1.0f / sum;
#pragma unroll
  for (int dt = 0; dt < 4; ++dt) {
    uint2 pk; pk.x = pack2(o[dt][0] * inv, o[dt][1] * inv); pk.y = pack2(o[dt][2] * inv, o[dt][3] * inv);
    *reinterpret_cast<uint2*>(cat + tokq * 1024 + h * 64 + dt * 16 + 4 * fq) = pk;
  }
}

constexpr int UB_STRIDE = 2056;
constexpr int RC_STRIDE = 4120;
constexpr int HY_RC_OFF = 2 * NBATCH * UB_STRIDE * 2;
DEV float shortconv(const u16* hrow, const float* cw, float cb, int ch, int t) {
  float xm = (t > 0) ? bf2f(hrow[t - 1]) : 0.f;
  float x0 = bf2f(hrow[t]);
  float xp = (t < SEQ - 1) ? bf2f(hrow[t + 1]) : 0.f;
  return cb + xm * cw[ch] + x0 * cw[1536 + ch] + xp * cw[2 * 1536 + ch];
}
DEV void load_rc(const Params& p, int o, int c) {
  const int tid = otid();
  char* rc = smem + HY_RC_OFF;
  const u16* Rg = reinterpret_cast<const u16*>(p.ws + S_RG) + ((long)o * 512 + c) * 4096;
  const float skip = p.hy_skip[o * 512 + c];
  const int i0 = tid * 8;
  uint4 lo = *reinterpret_cast<const uint4*>(Rg + i0);
  uint4 hi = (tid < 511) ? *reinterpret_cast<const uint4*>(Rg + i0 + 8) : make_uint4(0u, 0u, 0u, 0u);
  unsigned w[8] = {lo.x, lo.y, lo.z, lo.w, hi.x, hi.y, hi.z, hi.w};
  if (tid == 256) w[0] = (w[0] & 0xffff0000u) | (unsigned)f2bf(bf2f((u16)(w[0] & 0xffffu)) + skip);
  if (tid == 255) w[4] = (w[4] & 0xffff0000u) | (unsigned)f2bf(bf2f((u16)(w[4] & 0xffffu)) + skip);
#pragma unroll
  for (int m = 0; m < 8; ++m) {
    uint4 o4;
    if (m & 1) {
      o4.x = __builtin_amdgcn_alignbyte(w[m / 2 + 1], w[m / 2], 2);
      o4.y = __builtin_amdgcn_alignbyte(w[m / 2 + 2], w[m / 2 + 1], 2);
      o4.z = __builtin_amdgcn_alignbyte(w[m / 2 + 3], w[m / 2 + 2], 2);
      o4.w = __builtin_amdgcn_alignbyte(w[m / 2 + 4], w[m / 2 + 3], 2);
    } else {
      o4.x = w[m / 2]; o4.y = w[m / 2 + 1]; o4.z = w[m / 2 + 2]; o4.w = w[m / 2 + 3];
    }
    *reinterpret_cast<uint4*>(rc + m * (RC_STRIDE * 2) + i0 * 2) = o4;
  }
}
DEV void hyena_conv(const u16* ub, f32x4 (&acc)[16]) {
  const int lane = otid() & 63, wid = __builtin_amdgcn_readfirstlane(otid() >> 6), fr = lane & 15, fq = lane >> 4;
  const int mcopy = (-wid) & 7;
  const u16* rbase = reinterpret_cast<const u16*>(smem + HY_RC_OFF) + mcopy * RC_STRIDE + (8 * fq - 8 * fr + 2048 - (wid + mcopy));
#pragma unroll
  for (int i = 0; i < 16; ++i) acc[i] = f32x4{0.f, 0.f, 0.f, 0.f};
  const u16* urow = ub + (fr & 7) * UB_STRIDE + fq * 8;
#pragma unroll 1
  for (int r = 0; r < 4; ++r) {
    bf16x8 Bf[16];
#pragma unroll
    for (int i = 0; i < 16; ++i) Bf[i] = *reinterpret_cast<const bf16x8*>(urow + (r + 4 * i) * 32);
    const u16* rk = rbase + 32 * r;
#pragma unroll
    for (int e = -15; e <= 15; ++e) {
      const bf16x8 af = *reinterpret_cast<const bf16x8*>(rk + 128 * e);
#pragma unroll
      for (int T = 0; T < 16; ++T) {
        const int i = e + T;
        if (i >= 0 && i < 16) acc[T] = __builtin_amdgcn_mfma_f32_16x16x32_bf16(af, Bf[i], acc[T], 0, 0, 0);
      }
    }
  }
}
DEV void shortconv_pass(const u16* __restrict__ hrow  , u16* ub, const float* cw, float cb, int ch) {
  const float w0 = cw[ch], w1 = cw[1536 + ch], w2 = cw[2 * 1536 + ch];
#pragma unroll
  for (int q4 = 0; q4 < TOK / 8 / 512; ++q4) {
    const int q = otid() + 512 * q4;
    const int i = q * 8, b = i >> 11, t = i & 2047;
    uint4 v = *reinterpret_cast<const uint4*>(hrow + i);
    float x[10];
    x[0] = (t > 0) ? bf2f(hrow[i - 1]) : 0.f;
    x[9] = (t + 8 < SEQ) ? bf2f(hrow[i + 8]) : 0.f;
    x[1] = __uint_as_float(v.x << 16); x[2] = __uint_as_float(v.x & 0xffff0000u);
    x[3] = __uint_as_float(v.y << 16); x[4] = __uint_as_float(v.y & 0xffff0000u);
    x[5] = __uint_as_float(v.z << 16); x[6] = __uint_as_float(v.z & 0xffff0000u);
    x[7] = __uint_as_float(v.w << 16); x[8] = __uint_as_float(v.w & 0xffff0000u);
    float y[8];
#pragma unroll
    for (int j = 0; j < 8; ++j) y[j] = cb + x[j] * w0 + x[j + 1] * w1 + x[j + 2] * w2;
    uint4 o4; o4.x = pack2(y[0], y[1]); o4.y = pack2(y[2], y[3]); o4.z = pack2(y[4], y[5]); o4.w = pack2(y[6], y[7]);
    *reinterpret_cast<uint4*>(ub + b * UB_STRIDE + t) = o4;
  }
}
DEV void hyena_unit(const Params& p, int c) {
  const int tid = otid(), lane = tid & 63, wid = tid >> 6, fr = lane & 15, fq = lane >> 4;
  u16* ubA = reinterpret_cast<u16*>(smem);
  u16* ubB = ubA + NBATCH * UB_STRIDE;
  const u16* hbt = reinterpret_cast<const u16*>(p.ws + REG_B + 33554432ull) + 512L * TOK;
  u16* zT = reinterpret_cast<u16*>(p.ws + REG_C);
  const float* cw = p.hy_conv_w;
  shortconv_pass(hbt + (long)c * TOK, ubA, cw, p.hy_conv_b[c], c);
  shortconv_pass(hbt + (long)(512 + c) * TOK, ubB, cw, p.hy_conv_b[512 + c], 512 + c);
  load_rc(p, 0, c);
  __syncthreads();
  f32x4 acc[16];
  hyena_conv(ubA, acc);
  if (fr < 8) {
#pragma unroll
    for (int T = 0; T < 16; ++T)
#pragma unroll
      for (int j = 0; j < 4; ++j) {
        const int t = 128 * T + wid + 8 * (4 * fq + j);
        u16* q = ubB + fr * UB_STRIDE + t;
        *q = f2bf(bf2f(*q) * acc[T][j]);
      }
  }
  __syncthreads();
  shortconv_pass(hbt + (long)(1024 + c) * TOK, ubA, cw, p.hy_conv_b[1024 + c], 1024 + c);
  load_rc(p, 1, c);
  __syncthreads();
  hyena_conv(ubB, acc);
  if (fr < 8) {
#pragma unroll
    for (int T = 0; T < 16; ++T)
#pragma unroll
      for (int j = 0; j < 4; ++j) {
        const int t = 128 * T + wid + 8 * (4 * fq + j);
        u16* q = ubA + fr * UB_STRIDE + t;
        *q = f2bf(bf2f(*q) * acc[T][j]);
      }
  }
  __syncthreads();
#pragma unroll
  for (int q4 = 0; q4 < TOK / 8 / 512; ++q4) {
    const int q = tid + 512 * q4;
    const int i = q * 8, b = i >> 11, t = i & 2047;
    *reinterpret_cast<uint4*>(zT + (long)c * TOK + i) = *reinterpret_cast<const uint4*>(ubA + b * UB_STRIDE + t);
  }
  __syncthreads();
}
DEV void phase_ztrans(const Params& p) {
  const int tid = otid();
  const u16* zT = reinterpret_cast<const u16*>(p.ws + REG_C);
  u16* cat = reinterpret_cast<u16*>(p.ws + REG_A + 100663296ull);
  u16* tile = reinterpret_cast<u16*>(smem);
  for (int tb = blockIdx.x; tb < TOK / 64; tb += gridDim.x) {
    __syncthreads();
    const u16* src = zT + (long)tid * TOK + tb * 64;
#pragma unroll
    for (int k = 0; k < 8; ++k) *reinterpret_cast<uint4*>(tile + tid * 72 + k * 8) = *reinterpret_cast<const uint4*>(src + k * 8);
    __syncthreads();
#pragma unroll
    for (int k = 0; k < 8; ++k) {
      const int q = tid + 512 * k;
      const int tk = q >> 6, ch8 = (q & 63) * 8;
      unsigned w[4];
#pragma unroll
      for (int j = 0; j < 4; ++j) w[j] = (unsigned)tile[(ch8 + 2 * j) * 72 + tk] | ((unsigned)tile[(ch8 + 2 * j + 1) * 72 + tk] << 16);
      *reinterpret_cast<uint4*>(cat + (long)(tb * 64 + tk) * 1024 + 512 + ch8) = make_uint4(w[0], w[1], w[2], w[3]);
    }
  }
}
DEV void phase_mix0(const Params& p) {
  const int nb = gridDim.x;
  for (int c = blockIdx.x; c < 512; c += nb) hyena_unit(p, c);
  for (int u = vstart(); u < 1024; u += nb) na_pair(p, u);
}

DEV void phase_outproj(const Params& p, const u16* A, const u16* wt) {
  u16* pre1 = reinterpret_cast<u16*>(p.ws + REG_C);
  const u16* xres = reinterpret_cast<const u16*>(p.ws + REG_X);
  gemm_phase<true, true, false>(1024, 64, 4, [&](const Unit& u, const char*& a, const char*& b) { a = (const char*)(A) + (size_t)u.pm * 256 * (1024) * 2; b = (const char*)(wt) + (size_t)u.pn * 256 * (1024) * 2; },
      [&](Acc8& acc, const Unit& u, int wr, int wc, int fr, int fq) {
        const long o0 = (long)(u.pm * 256 + wr * 64 + fr) * 1024 + u.pn * 256 + wc * 32 + 8 * fq;
        E8_FOR {
          const long o = o0 + (ai * 128 + m * 16) * 1024 + bj * 128;
          const uint4 xr = *reinterpret_cast<const uint4*>(xres + o);
          const float4 x0 = bf4_to_f4(make_uint2(xr.x, xr.y)), x1 = bf4_to_f4(make_uint2(xr.z, xr.w));
          f32x4 v0 = acc[ai][bj][m][0], v1 = acc[ai][bj][m][1];
          uint4 pk;
          pk.x = cvt_pk_bf16(DN_ALPHA * x0.x + v0[0], DN_ALPHA * x0.y + v0[1]); pk.y = cvt_pk_bf16(DN_ALPHA * x0.z + v0[2], DN_ALPHA * x0.w + v0[3]);
          pk.z = cvt_pk_bf16(DN_ALPHA * x1.x + v1[0], DN_ALPHA * x1.y + v1[1]); pk.w = cvt_pk_bf16(DN_ALPHA * x1.z + v1[2], DN_ALPHA * x1.w + v1[3]);
          *reinterpret_cast<uint4*>(pre1 + o) = pk;
        }
      });
}

DEV void phase_ln1_router(const Params& p, int layer) {
  const int tid = otid(), lane = tid & 63, wid = tid >> 6, nb = gridDim.x;
  float* wrT = reinterpret_cast<float*>(smem);
  const float* wr = p.moe_router + (long)layer * 1024 * 16;
  {
    float4 w4[8];
#pragma unroll
    for (int k = 0; k < 8; ++k) w4[k] = reinterpret_cast<const float4*>(wr)[tid + 512 * k];
#pragma unroll
    for (int k = 0; k < 8; ++k) {
      const int i = (tid + 512 * k) * 4, c = i >> 4, e = i & 15;
      wrT[e * 1024 + c] = w4[k].x; wrT[(e + 1) * 1024 + c] = w4[k].y; wrT[(e + 2) * 1024 + c] = w4[k].z; wrT[(e + 3) * 1024 + c] = w4[k].w;
    }
  }
  __syncthreads();
  const u16* pre1 = reinterpret_cast<const u16*>(p.ws + REG_C);
  u16* x1 = reinterpret_cast<u16*>(p.ws + REG_D);
  unsigned char* x1q = reinterpret_cast<unsigned char*>(p.ws + REG_E);
  float* aff = reinterpret_cast<float*>(p.ws + S_AFF);
  const float* g = p.ln1_g + layer * 1024; const float* bb = p.ln1_b + layer * 1024;
  uint2 nx[4];
  {
    const int t0 = blockIdx.x * 8 + wid;
#pragma unroll
    for (int i = 0; i < 4; ++i) nx[i] = (t0 < TOK) ? *reinterpret_cast<const uint2*>(pre1 + (long)t0 * 1024 + i * 256 + lane * 4) : make_uint2(0u, 0u);
  }
  float4 gg4[4], bb4[4];
#pragma unroll
  for (int i = 0; i < 4; ++i) { gg4[i] = *reinterpret_cast<const float4*>(g + i * 256 + lane * 4); bb4[i] = *reinterpret_cast<const float4*>(bb + i * 256 + lane * 4); }
  for (int tok = blockIdx.x * 8 + wid; tok < TOK; tok += nb * 8) {
    float4 v[4];
    float s = 0.f;
#pragma unroll
    for (int i = 0; i < 4; ++i) { v[i] = bf4_to_f4(nx[i]); s += v[i].x + v[i].y + v[i].z + v[i].w; }
    {
      const int tn = tok + nb * 8;
      if (tn < TOK) {
#pragma unroll
        for (int i = 0; i < 4; ++i) nx[i] = *reinterpret_cast<const uint2*>(pre1 + (long)tn * 1024 + i * 256 + lane * 4);
      }
    }
    float mu = wave_sum(s) * (1.0f / 1024.0f);
    float q = 0.f;
#pragma unroll
    for (int i = 0; i < 4; ++i) { v[i].x -= mu; v[i].y -= mu; v[i].z -= mu; v[i].w -= mu; q += v[i].x * v[i].x + v[i].y * v[i].y + v[i].z * v[i].z + v[i].w * v[i].w; }
    float rstd = rsqrtf(wave_sum(q) * (1.0f / 1024.0f) + LN_EPS);
    float4 y[4];
#pragma unroll
    for (int i = 0; i < 4; ++i) {
      int c = i * 256 + lane * 4;
      const float4 gg = gg4[i], b4 = bb4[i];
      y[i].x = v[i].x * rstd * gg.x + b4.x; y[i].y = v[i].y * rstd * gg.y + b4.y; y[i].z = v[i].z * rstd * gg.z + b4.z; y[i].w = v[i].w * rstd * gg.w + b4.w;
      { uint2 pk; pk.x = pack2(y[i].x, y[i].y); pk.y = pack2(y[i].z, y[i].w); *reinterpret_cast<uint2*>(x1 + (long)tok * 1024 + c) = pk; }
      *reinterpret_cast<unsigned*>(x1q + (long)tok * 1024 + c) = pack4_f8(y[i].x, y[i].y, y[i].z, y[i].w);
    }
    float lg[16];
#pragma unroll
    for (int e = 0; e < 16; ++e) {
      float a = 0.f;
#pragma unroll
      for (int i = 0; i < 4; ++i) {
        float4 w4 = *reinterpret_cast<const float4*>(wrT + e * 1024 + i * 256 + lane * 4);
        a += y[i].x * w4.x + y[i].y * w4.y + y[i].z * w4.z + y[i].w * w4.w;
      }
      lg[e] = a;
      if (e & 1) asm volatile("" ::: "memory");
    }
#define BFLY_STEP(S, CTRL, KB) { const bool up = (KB) != 0; _Pragma("unroll") for (int i = 0; i < (8 >> S); ++i) { \
      const float lo = lg[2 * i], hi = lg[2 * i + 1]; const float snd = up ? lo : hi; lg[i] = (up ? hi : lo) + dpp_f<CTRL>(snd); } }
    BFLY_STEP(0, 0xB1, (lane ^ (lane >> 2)) & 1)
    BFLY_STEP(1, 0x4E, ((lane >> 1) ^ (lane >> 2)) & 1)
    BFLY_STEP(2, 0x141, ((lane >> 2) ^ (lane >> 3)) & 1)
    BFLY_STEP(3, 0x140, (lane >> 3) & 1)
#undef BFLY_STEP
    float mine = lg[0];
    mine += __shfl_xor(mine, 16);
    mine += __shfl_xor(mine, 32);
    const float mx = row_allmax(mine);
    const float ex = expf(mine - mx);
    const float den = row_allsum(ex);
    if (lane < 16) {
      const int eown = ((lane ^ (lane >> 2)) & 1) | ((((lane >> 1) ^ (lane >> 2)) & 1) << 1) | ((((lane >> 2) ^ (lane >> 3)) & 1) << 2) | (((lane >> 3) & 1) << 3);
      int b = tok >> 11, l = tok & 2047;
      aff[((long)b * 16 + eown) * SEQ + l] = ex / den;
    }
  }
}

DEV void phase_topk(const Params& p) {
  const int tid = otid(), nb = gridDim.x, lane = tid & 63, wid = tid >> 6;
  unsigned* key = reinterpret_cast<unsigned*>(smem);
  int* rows = reinterpret_cast<int*>(smem + 8192);
  unsigned* hist = reinterpret_cast<unsigned*>(smem + 9216);
  unsigned* wsum = reinterpret_cast<unsigned*>(smem + 10240);
  unsigned* bc = reinterpret_cast<unsigned*>(smem + 10304);
  const float* aff = reinterpret_cast<const float*>(p.ws + S_AFF);
  float* gsel = reinterpret_cast<float*>(p.ws + S_GSEL);
  int* slot = reinterpret_cast<int*>(p.ws + S_SLOT);
  const unsigned char* x1q = reinterpret_cast<const unsigned char*>(p.ws + REG_E);
  unsigned char* Xe = reinterpret_cast<unsigned char*>(p.ws + REG_C);
  for (int be = blockIdx.x; be < NBATCH * NEXP; be += nb) {
    const int b = be >> 4, e = be & 15;
    __syncthreads();
    const float4 av = *reinterpret_cast<const float4*>(aff + (long)be * SEQ + tid * 4);
    const unsigned k0 = __float_as_uint(av.x), k1 = __float_as_uint(av.y), k2 = __float_as_uint(av.z), k3 = __float_as_uint(av.w);
    unsigned prefix = 0u, need = CAP;
#pragma unroll 1
    for (int shift = 24; shift >= 0; shift -= 8) {
      if (tid < 256) hist[tid] = 0u;
      __syncthreads();
      const unsigned hs = (shift == 24) ? 0u : (unsigned)(shift + 8);
      if (shift == 24 || (k0 >> hs) == prefix) atomicAdd(&hist[(k0 >> shift) & 255u], 1u);
      if (shift == 24 || (k1 >> hs) == prefix) atomicAdd(&hist[(k1 >> shift) & 255u], 1u);
      if (shift == 24 || (k2 >> hs) == prefix) atomicAdd(&hist[(k2 >> shift) & 255u], 1u);
      if (shift == 24 || (k3 >> hs) == prefix) atomicAdd(&hist[(k3 >> shift) & 255u], 1u);
      __syncthreads();
      if (wid == 0) {
        unsigned h0 = hist[4 * lane], h1 = hist[4 * lane + 1], h2 = hist[4 * lane + 2], h3 = hist[4 * lane + 3];
        unsigned tot = h0 + h1 + h2 + h3;
        unsigned suf = tot;
#pragma unroll
        for (int o = 1; o < 64; o <<= 1) { unsigned t = __shfl_down(suf, o); if (lane + o < 64) suf += t; }
        const unsigned above = suf - tot;
        int d = -1; unsigned nabove = 0u;
        unsigned c3 = above + h3, c2 = c3 + h2, c1 = c2 + h1, c0 = c1 + h0;
        if (above < need && c0 >= need) {
          if (c3 >= need) { d = 4 * lane + 3; nabove = above; }
          else if (c2 >= need) { d = 4 * lane + 2; nabove = c3; }
          else if (c1 >= need) { d = 4 * lane + 1; nabove = c2; }
          else { d = 4 * lane; nabove = c1; }
          bc[0] = (prefix << 8) | (unsigned)d;
          bc[1] = need - nabove;
        }
      }
      __syncthreads();
      prefix = bc[0]; need = bc[1];
    }
    const unsigned tau = prefix;
    const unsigned e0 = (k0 == tau), e1 = (k1 == tau), e2 = (k2 == tau), e3 = (k3 == tau);
    unsigned eqs = e0 + e1 + e2 + e3;
    unsigned inc = eqs;
#pragma unroll
    for (int o = 1; o < 64; o <<= 1) { unsigned t = __shfl_up(inc, o); if (lane >= o) inc += t; }
    if (lane == 63) wsum[wid] = inc;
    __syncthreads();
    unsigned base = 0u;
#pragma unroll
    for (int w = 0; w < 8; ++w) if (w < wid) base += wsum[w];
    unsigned eqb = base + inc - eqs;
    const unsigned s0 = (k0 > tau) || (e0 && eqb < need); eqb += e0;
    const unsigned s1 = (k1 > tau) || (e1 && eqb < need); eqb += e1;
    const unsigned s2 = (k2 > tau) || (e2 && eqb < need); eqb += e2;
    const unsigned s3 = (k3 > tau) || (e3 && eqb < need);
    const unsigned sels = s0 + s1 + s2 + s3;
    unsigned inc2 = sels;
#pragma unroll
    for (int o = 1; o < 64; o <<= 1) { unsigned t = __shfl_up(inc2, o); if (lane >= o) inc2 += t; }
    if (lane == 63) wsum[8 + wid] = inc2;
    __syncthreads();
    unsigned base2 = 0u;
#pragma unroll
    for (int w = 0; w < 8; ++w) if (w < wid) base2 += wsum[8 + w];
    unsigned sl = base2 + inc2 - sels;
    const int tok0 = tid * 4;
    int sv[4];
    sv[0] = s0 ? (int)sl : -1; sl += s0;
    sv[1] = s1 ? (int)sl : -1; sl += s1;
    sv[2] = s2 ? (int)sl : -1; sl += s2;
    sv[3] = s3 ? (int)sl : -1;
    const float avv[4] = {av.x, av.y, av.z, av.w};
#pragma unroll
    for (int j = 0; j < 4; ++j) {
      slot[((long)b * SEQ + tok0 + j) * 16 + e] = sv[j];
      if (sv[j] >= 0) { rows[sv[j]] = tok0 + j; gsel[be * CAP + sv[j]] = avv[j]; }
    }
    __syncthreads();
#pragma unroll 4
    for (int s = wid; s < CAP; s += 8) {
      const int t = rows[s];
      const uint4* src = reinterpret_cast<const uint4*>(x1q + ((long)b * SEQ + t) * 1024);
      uint4* dst = reinterpret_cast<uint4*>(Xe + ((long)(e * 8 + b) * CAP + s) * 1024);
      dst[lane] = src[lane];
    }
  }
}

DEV void phase_moe1(const Params& p, int layer) {
  const unsigned char* Xe = reinterpret_cast<const unsigned char*>(p.ws + REG_C);
  const unsigned char* wgu = reinterpret_cast<const unsigned char*>(p.ws + W_GU) + (long)layer * 16 * 4096 * 1024;
  unsigned char* H = reinterpret_cast<unsigned char*>(p.ws + REG_A);
  gemm_phase<true, true, true>(1024, 128, 16,
      [&](const Unit& u, const char*& a, const char*& b) { a = (const char*)Xe + (size_t)u.pm * 256 * 1024; b = (const char*)wgu + ((size_t)(u.pm >> 3) * 4096 + (size_t)u.pn * 256) * 1024; },
      [&](Acc8& acc, const Unit& u, int wr, int wc, int fr, int fq) {
        unsigned char* base = H + (long)(u.pm * 256 + wr * 64 + fr) * DFF + u.pn * 128 + wc * 32 + 8 * fq;
#pragma unroll
        for (int ai = 0; ai < 2; ++ai)
#pragma unroll
          for (int m = 0; m < 4; ++m) {
            float hv[8];
#pragma unroll
            for (int n = 0; n < 2; ++n)
#pragma unroll
              for (int j = 0; j < 4; ++j) {
                float gte = acc[ai][0][m][n][j] * 0.03125f, up = acc[ai][1][m][n][j] * 0.03125f;
                hv[n * 4 + j] = gte * fsigmoid(gte) * up;
              }
            uint2 pk; pk.x = pack4_f8(hv[0], hv[1], hv[2], hv[3]); pk.y = pack4_f8(hv[4], hv[5], hv[6], hv[7]);
            *reinterpret_cast<uint2*>(base + (ai * 128 + m * 16) * DFF) = pk;
          }
      });
}
DEV void phase_moe2(const Params& p, int layer) {
  const unsigned char* H = reinterpret_cast<const unsigned char*>(p.ws + REG_A);
  const unsigned char* wd = reinterpret_cast<const unsigned char*>(p.ws + W_DN) + (long)layer * 16 * 1024 * 2048;
  const float* gsel = reinterpret_cast<const float*>(p.ws + S_GSEL);
  u16* Ye = reinterpret_cast<u16*>(p.ws + REG_B);
  gemm_phase<true, true, true>(2048, 128, 4,
      [&](const Unit& u, const char*& a, const char*& b) { a = (const char*)H + (size_t)u.pm * 256 * 2048; b = (const char*)wd + ((size_t)(u.pm >> 3) * 1024 + (size_t)u.pn * 256) * 2048; },
      [&](Acc8& acc, const Unit& u, int wr, int wc, int fr, int fq) {
        const int e = u.pm >> 3, b = u.pm & 7;
        const float* gs = gsel + (b * 16 + e) * CAP + wr * 64 + fr;
        u16* base = Ye + (long)(u.pm * 256 + wr * 64 + fr) * 1024 + u.pn * 256 + wc * 32 + 8 * fq;
#pragma unroll
        for (int ai = 0; ai < 2; ++ai)
#pragma unroll
          for (int m = 0; m < 4; ++m) {
            const float g = gs[ai * 128 + m * 16] * 0.015625f;
#pragma unroll
            for (int bj = 0; bj < 2; ++bj) {
              f32x4 v0 = acc[ai][bj][m][0] * g, v1 = acc[ai][bj][m][1] * g;
              uint4 pk;
              pk.x = cvt_pk_bf16(v0[0], v0[1]); pk.y = cvt_pk_bf16(v0[2], v0[3]); pk.z = cvt_pk_bf16(v1[0], v1[1]); pk.w = cvt_pk_bf16(v1[2], v1[3]);
              *reinterpret_cast<uint4*>(base + (ai * 128 + m * 16) * 1024 + bj * 128) = pk;
            }
          }
      });
}
DEV void phase_ln2(const Params& p, int layer) {
  const int tid = otid(), lane = tid & 63, wid = tid >> 6, nb = gridDim.x;
  const u16* x1 = reinterpret_cast<const u16*>(p.ws + REG_D);
  const u16* Ye = reinterpret_cast<const u16*>(p.ws + REG_B);
  const int* slot = reinterpret_cast<const int*>(p.ws + S_SLOT);
  u16* x2b = reinterpret_cast<u16*>(p.ws + REG_A + 67108864ull);
  const float* g = p.ln2_g + layer * 1024; const float* bb = p.ln2_b + layer * 1024;
  uint2 nx[4]; int nslot = -1;
  {
    const int t0 = blockIdx.x * 8 + wid;
    if (t0 < TOK) {
#pragma unroll
      for (int i = 0; i < 4; ++i) nx[i] = *reinterpret_cast<const uint2*>(x1 + (long)t0 * 1024 + i * 256 + lane * 4);
      nslot = (lane < 16) ? slot[(long)t0 * 16 + lane] : -1;
    }
  }
  for (int tok = blockIdx.x * 8 + wid; tok < TOK; tok += nb * 8) {
    const int b = tok >> 11;
    float4 v[4];
#pragma unroll
    for (int i = 0; i < 4; ++i) {
      float4 t = bf4_to_f4(nx[i]);
      v[i].x = DN_ALPHA * t.x; v[i].y = DN_ALPHA * t.y; v[i].z = DN_ALPHA * t.z; v[i].w = DN_ALPHA * t.w;
    }
    int myslot = nslot;
    {
      const int tn = tok + nb * 8;
      if (tn < TOK) {
#pragma unroll
        for (int i = 0; i < 4; ++i) nx[i] = *reinterpret_cast<const uint2*>(x1 + (long)tn * 1024 + i * 256 + lane * 4);
        nslot = (lane < 16) ? slot[(long)tn * 16 + lane] : -1;
      }
    }
    unsigned mask = (unsigned)__ballot(myslot >= 0);
    while (mask) {
      const int e = __builtin_ctz(mask);
      mask &= mask - 1;
      const int sidx = __builtin_amdgcn_readlane(myslot, e);
      const u16* yr = Ye + ((long)(e * 8 + b) * CAP + sidx) * 1024;
      uint2 t[4];
#pragma unroll
      for (int i = 0; i < 4; ++i) t[i] = *reinterpret_cast<const uint2*>(yr + i * 256 + lane * 4);
#pragma unroll
      for (int i = 0; i < 4; ++i) {
        v[i].x += __uint_as_float(t[i].x << 16); v[i].y += __uint_as_float(t[i].x & 0xffff0000u);
        v[i].z += __uint_as_float(t[i].y << 16); v[i].w += __uint_as_float(t[i].y & 0xffff0000u);
      }
    }
    float s = 0.f;
#pragma unroll
    for (int i = 0; i < 4; ++i) s += v[i].x + v[i].y + v[i].z + v[i].w;
    float mu = wave_sum(s) * (1.0f / 1024.0f);
    float q = 0.f;
#pragma unroll
    for (int i = 0; i < 4; ++i) { v[i].x -= mu; v[i].y -= mu; v[i].z -= mu; v[i].w -= mu; q += v[i].x * v[i].x + v[i].y * v[i].y + v[i].z * v[i].z + v[i].w * v[i].w; }
    float rstd = rsqrtf(wave_sum(q) * (1.0f / 1024.0f) + LN_EPS);
#pragma unroll
    for (int i = 0; i < 4; ++i) {
      int c = i * 256 + lane * 4;
      float4 gg = *reinterpret_cast<const float4*>(g + c), b4 = *reinterpret_cast<const float4*>(bb + c);
      float4 y;
      y.x = v[i].x * rstd * gg.x + b4.x; y.y = v[i].y * rstd * gg.y + b4.y; y.z = v[i].z * rstd * gg.z + b4.z; y.w = v[i].w * rstd * gg.w + b4.w;
      uint2 pk; pk.x = pack2(y.x, y.y); pk.y = pack2(y.z, y.w);
      *reinterpret_cast<uint2*>(x2b + (long)tok * 1024 + c) = pk;
    }
  }
}
DEV void phase_ple(const Params& p, int layer, float* outf, u16* outb) {
  const u16* x2b = reinterpret_cast<const u16*>(p.ws + REG_A + 67108864ull);
  const u16* pb = reinterpret_cast<const u16*>(p.ws + REG_P) + (long)layer * TOK * 256;
  const u16* wg = reinterpret_cast<const u16*>(p.ws + W_PLEG) + (long)layer * 1024 * 1024;
  const u16* wp = reinterpret_cast<const u16*>(p.ws + W_PLEP) + (long)layer * 1024 * 256;
  u16* pp = reinterpret_cast<u16*>(p.ws + REG_C);
  gemm_phase<true, false, false>(256, 64, 4, [&](const Unit& u, const char*& a, const char*& b) { a = (const char*)(pb) + (size_t)u.pm * 256 * (256) * 2; b = (const char*)(wp) + (size_t)u.pn * 256 * (256) * 2; },
      [&](Acc8& acc, const Unit& u, int wr, int wc, int fr, int fq) {
        const long o0 = (long)(u.pm * 256 + wr * 64 + fr) * 1024 + u.pn * 256 + wc * 32 + 4 * fq;
        E8_FOR {
#pragma unroll
          for (int n = 0; n < 2; ++n)
          {
            f32x4 v = acc[ai][bj][m][n];
            uint2 pk; pk.x = cvt_pk_bf16(v[0], v[1]); pk.y = cvt_pk_bf16(v[2], v[3]);
            *reinterpret_cast<uint2*>(pp + o0 + (ai * 128 + m * 16) * 1024 + bj * 128 + n * 16) = pk;
          }
        }
      });
  gemm_phase<true, false, false>(1024, 64, 4, [&](const Unit& u, const char*& a, const char*& b) { a = (const char*)(x2b) + (size_t)u.pm * 256 * (1024) * 2; b = (const char*)(wg) + (size_t)u.pn * 256 * (1024) * 2; },
      [&](Acc8& acc, const Unit& u, int wr, int wc, int fr, int fq) {
        const long o0 = (long)(u.pm * 256 + wr * 64 + fr) * 1024 + u.pn * 256 + wc * 32 + 4 * fq;
        E8_FOR {
#pragma unroll
          for (int n = 0; n < 2; ++n) {
            const long o = o0 + (ai * 128 + m * 16) * 1024 + bj * 128 + n * 16;
            f32x4 a = acc[ai][bj][m][n];
            const float4 xq = bf4_to_f4(*reinterpret_cast<const uint2*>(x2b + o));
            f32x4 xv = {xq.x, xq.y, xq.z, xq.w};
            const uint2 pq = *reinterpret_cast<const uint2*>(pp + o);
            f32x4 pv = {__uint_as_float(pq.x << 16), __uint_as_float(pq.x & 0xffff0000u), __uint_as_float(pq.y << 16), __uint_as_float(pq.y & 0xffff0000u)};
            f32x4 r;
#pragma unroll
            for (int j = 0; j < 4; ++j) r[j] = xv[j] + pv[j] * fsigmoid(a[j]);
            if (outf) *reinterpret_cast<f32x4*>(outf + o) = r;
            if (outb) { uint2 pk; pk.x = cvt_pk_bf16(r[0], r[1]); pk.y = cvt_pk_bf16(r[2], r[3]); *reinterpret_cast<uint2*>(outb + o) = pk; }
          }
        }
      });
}
DEV void phase_mla_in(const Params& p) {
  const u16* xb = reinterpret_cast<const u16*>(p.ws + REG_X);
  const u16* wt = reinterpret_cast<const u16*>(p.ws + W_MLAIN);
  float* hm = reinterpret_cast<float*>(p.ws + REG_B);
  gemm_phase<true, false, false>(1024, 64, 3, [&](const Unit& u, const char*& a, const char*& b) { a = (const char*)(xb) + (size_t)u.pm * 256 * (1024) * 2; b = (const char*)(wt) + (size_t)u.pn * 256 * (1024) * 2; },
      [&](Acc8& acc, const Unit& u, int wr, int wc, int fr, int fq) {
        const long o0 = (long)(u.pm * 256 + wr * 64 + fr) * 768 + u.pn * 256 + wc * 32 + 4 * fq;
        E8_FOR {
#pragma unroll
          for (int n = 0; n < 2; ++n)
            *reinterpret_cast<f32x4*>(hm + o0 + (ai * 128 + m * 16) * 768 + bj * 128 + n * 16) = acc[ai][bj][m][n];
        }
      });
}
constexpr size_t MLA_Q = REG_A, MLA_K = REG_A + 50331648ull, MLA_VT = REG_A + 100663296ull;
constexpr size_t MLA_CQN = REG_B + 50331648ull, MLA_CKVN = MLA_CQN + 12582912ull, MLA_O = MLA_CKVN + 8388608ull;
DEV float rope_inv(int i) { return 1.0f / powf(10000.0f, (float)i / 16.0f); }
DEV void phase_mla_norm(const Params& p) {
  const int tid = otid(), lane = tid & 63, wid = tid >> 6, nb = gridDim.x;
  const float* hm = reinterpret_cast<const float*>(p.ws + REG_B);
  u16* cqn = reinterpret_cast<u16*>(p.ws + MLA_CQN);
  u16* ckvn = reinterpret_cast<u16*>(p.ws + MLA_CKVN);
  u16* Kb = reinterpret_cast<u16*>(p.ws + MLA_K);
  for (int tok = blockIdx.x * 8 + wid; tok < TOK; tok += nb * 8) {
    const float* row = hm + (long)tok * 768;
    float q[6], kv[4];
    float sq = 0.f, skv = 0.f;
#pragma unroll
    for (int i = 0; i < 6; ++i) { q[i] = row[i * 64 + lane]; sq += q[i] * q[i]; }
#pragma unroll
    for (int i = 0; i < 4; ++i) { kv[i] = row[384 + i * 64 + lane]; skv += kv[i] * kv[i]; }
    float rq = rsqrtf(wave_sum(sq) * (1.0f / 384.0f) + LN_EPS);
    float rkv = rsqrtf(wave_sum(skv) * (1.0f / 256.0f) + LN_EPS);
#pragma unroll
    for (int i = 0; i < 6; ++i) cqn[(long)tok * 384 + i * 64 + lane] = f2bf(q[i] * rq * p.mla_q_norm[i * 64 + lane]);
#pragma unroll
    for (int i = 0; i < 4; ++i) ckvn[(long)tok * 256 + i * 64 + lane] = f2bf(kv[i] * rkv * p.mla_kv_norm[i * 64 + lane]);
    const int b = tok >> 11, l = tok & 2047;
    float kr = (lane < 32) ? row[640 + lane] : 0.f;
    float x1 = __shfl(kr, lane & 15), x2 = __shfl(kr, (lane & 15) + 16);
    const float2 cssn = reinterpret_cast<const float2*>(p.ws + S_ROPE)[l * 16 + (lane & 15)];
    const float cs = cssn.x, sn = cssn.y;
    float r = (lane & 16) ? (x1 * sn + x2 * cs) : (x1 * cs - x2 * sn);
    u16 rb = f2bf(r);
    for (int hh = 0; hh < 16; hh += 2) {
      int h = hh + (lane >> 5);
      u16 val = (u16)__shfl((int)rb, lane & 31);
      Kb[(((long)b * 16 + h) * SEQ + l) * 96 + 64 + (lane & 31)] = val;
    }
  }
}
DEV void phase_mla_up(const Params& p) {
  const u16* cqn = reinterpret_cast<const u16*>(p.ws + MLA_CQN);
  const u16* ckvn = reinterpret_cast<const u16*>(p.ws + MLA_CKVN);
  const u16* wq = reinterpret_cast<const u16*>(p.ws + W_QUP);
  const u16* wkv = reinterpret_cast<const u16*>(p.ws + W_KVUP);
  u16* Qb = reinterpret_cast<u16*>(p.ws + MLA_Q);
  u16* Kb = reinterpret_cast<u16*>(p.ws + MLA_K);
  u16* VT = reinterpret_cast<u16*>(p.ws + MLA_VT);
  const float qscale = 0.10206207261596577f * 1.4426950408889634f;
  gemm_phase<true, false, false>(384, 64, 6, [&](const Unit& u, const char*& a, const char*& b) { a = (const char*)(cqn) + (size_t)u.pm * 256 * (384) * 2; b = (const char*)(wq) + (size_t)u.pn * 256 * (384) * 2; },
      [&](Acc8& acc, const Unit& u, int wr, int wc, int fr, int fq) {
#pragma unroll
        for (int bj = 0; bj < 2; ++bj) {
          const int c32 = (u.pn * 256 + bj * 128 + wc * 32) >> 5;
          const int h = c32 / 3, part = c32 % 3;
#pragma unroll
          for (int ai = 0; ai < 2; ++ai)
#pragma unroll
            for (int m = 0; m < 4; ++m) {
              const int tok = u.pm * 256 + ai * 128 + wr * 64 + m * 16 + fr;
              const int b = tok >> 11, l = tok & 2047;
              u16* qrow = Qb + (((long)b * 16 + h) * SEQ + l) * 96 + part * 32 + 4 * fq;
              f32x4 a0 = acc[ai][bj][m][0], a1 = acc[ai][bj][m][1];
              if (part == 2) {
#pragma unroll
                for (int j = 0; j < 4; ++j) {
                  const float2 cssn = reinterpret_cast<const float2*>(p.ws + S_ROPE)[l * 16 + 4 * fq + j];
                  const float cs = cssn.x, sn = cssn.y;
                  float r0 = a0[j] * cs - a1[j] * sn, r1 = a0[j] * sn + a1[j] * cs;
                  a0[j] = r0; a1[j] = r1;
                }
              }
              uint2 p0, p1;
              p0.x = cvt_pk_bf16(a0[0] * qscale, a0[1] * qscale); p0.y = cvt_pk_bf16(a0[2] * qscale, a0[3] * qscale);
              p1.x = cvt_pk_bf16(a1[0] * qscale, a1[1] * qscale); p1.y = cvt_pk_bf16(a1[2] * qscale, a1[3] * qscale);
              *reinterpret_cast<uint2*>(qrow) = p0;
              *reinterpret_cast<uint2*>(qrow + 16) = p1;
            }
        }
      });
  gemm_phase<true, true, false>(256, 64, 4, [&](const Unit& u, const char*& a, const char*& b) { a = (const char*)(ckvn) + (size_t)u.pm * 256 * (256) * 2; b = (const char*)(wkv) + (size_t)u.pn * 256 * (256) * 2; },
      [&](Acc8& acc, const Unit& u, int wr, int wc, int fr, int fq) {
        E8_FOR {
          const int tok = u.pm * 256 + ai * 128 + wr * 64 + m * 16 + fr;
          const int b = tok >> 11, l = tok & 2047;
          const int col = u.pn * 256 + bj * 128 + wc * 32 + 8 * fq;
          const int h = col >> 6, d = col & 63;
          f32x4 v0 = acc[ai][bj][m][0], v1 = acc[ai][bj][m][1];
          uint4 pk;
          pk.x = cvt_pk_bf16(v0[0], v0[1]); pk.y = cvt_pk_bf16(v0[2], v0[3]); pk.z = cvt_pk_bf16(v1[0], v1[1]); pk.w = cvt_pk_bf16(v1[2], v1[3]);
          *reinterpret_cast<uint4*>(Kb + (((long)b * 16 + h) * SEQ + l) * 96 + d) = pk;
        }
      });
  gemm_phase<false, false, false>(256, 64, 4, [&](const Unit& u, const char*& a, const char*& b) { a = (const char*)(ckvn) + (size_t)u.pm * 256 * (256) * 2; b = (const char*)(wkv + 1024 * 256) + (size_t)u.pn * 256 * (256) * 2; },
      [&](Acc8& acc, const Unit& u, int wr, int wc, int fr, int fq) {
        E8_FOR {
          const int tok = u.pm * 256 + ai * 128 + wr * 64 + m * 16 + 4 * fq;
          const int b = tok >> 11, l = tok & 2047;
#pragma unroll
          for (int n = 0; n < 2; ++n) {
            const int col = u.pn * 256 + bj * 128 + wc * 32 + n * 16 + fr;
            const int h = col >> 6, d = col & 63;
            f32x4 v = acc[ai][bj][m][n];
            uint2 pk; pk.x = cvt_pk_bf16(v[0], v[1]); pk.y = cvt_pk_bf16(v[2], v[3]);
            *reinterpret_cast<uint2*>(VT + (((long)b * 16 + h) * 64 + d) * SEQ + l) = pk;
          }
        }
      });
}
#ifndef ATT_THR
#define ATT_THR 8.0f
#endif
DEV int kswz(int key) { return (((key >> 3) & 3) << 2) | (key & 3); }
DEV void mla_attn_unit(const Params& p, int u) {
  const int tid = otid(), lane = tid & 63, wid = tid >> 6, fr = lane & 15, fq = lane >> 4;
  const int qb = u & 7, bh = u >> 3;
  const u16* Qb = reinterpret_cast<const u16*>(p.ws + MLA_Q) + (long)bh * SEQ * 96;
  const u16* Kb = reinterpret_cast<const u16*>(p.ws + MLA_K) + (long)bh * SEQ * 96;
  const u16* VT = reinterpret_cast<const u16*>(p.ws + MLA_VT) + (long)bh * 64 * SEQ;
  u16* O = reinterpret_cast<u16*>(p.ws + MLA_O);
  char* kl = smem;
  char* vl = smem + 32768;
  bf16x8 qf[2][3];
#pragma unroll
  for (int qt = 0; qt < 2; ++qt)
#pragma unroll
    for (int ks = 0; ks < 3; ++ks)
      qf[qt][ks] = *reinterpret_cast<const bf16x8*>(Qb + (long)(qb * 256 + wid * 32 + qt * 16 + fr) * 96 + ks * 32 + fq * 8);
  f32x4 o[4][2];
#pragma unroll
  for (int dt = 0; dt < 4; ++dt)
#pragma unroll
    for (int qt = 0; qt < 2; ++qt) o[dt][qt] = f32x4{0.f, 0.f, 0.f, 0.f};
  float mrun[2], lrun[2] = {0.f, 0.f}, rcur[2], rnxt[2] = {0.f, 0.f};
  const int kc0 = tid, kc1 = 512 + (tid & 255);
  const int vd = tid >> 3, vpart = tid & 7;
  const int kw0 = (kc0 / 12) * 256 + (((kc0 % 12) ^ kswz(kc0 / 12)) << 4);
  const int kw1 = (kc1 / 12) * 256 + (((kc1 % 12) ^ kswz(kc1 / 12)) << 4);
  const int vw = vd * 128 + ((vpart ^ ((vd >> 1) & 7)) << 4);
  struct Stg { uint4 k0, k1, v; };
  Stg sa, sb;
  sa.k1 = make_uint4(0, 0, 0, 0); sb.k1 = make_uint4(0, 0, 0, 0);
  auto gloadK = [&](Stg& r, int t) {
    const u16* kt = Kb + (long)t * 64 * 96;
    r.k0 = *reinterpret_cast<const uint4*>(kt + kc0 * 8);
    r.k1 = *reinterpret_cast<const uint4*>(kt + kc1 * 8);
  };
  auto gloadV = [&](Stg& r, int t) { r.v = *reinterpret_cast<const uint4*>(VT + (long)vd * SEQ + t * 64 + vpart * 8); };
  auto lstoreK = [&](const Stg& r, int buf) {
    *reinterpret_cast<uint4*>(kl + buf * 16384 + kw0) = r.k0;
    if (tid < 256) *reinterpret_cast<uint4*>(kl + buf * 16384 + kw1) = r.k1;
  };
  auto lstoreV = [&](const Stg& r, int buf) { *reinterpret_cast<uint4*>(vl + buf * 8192 + vw) = r.v; };
  const int krow = 8 * (fr >> 2) + (fr & 3);
  const int kf_ = kswz(krow);
  auto qk_tile = [&](const char* kd, f32x4 (&s)[4][2], const float (&ref)[2]) {
#pragma unroll
    for (int kt = 0; kt < 4; ++kt) {
      const int key = 32 * (kt >> 1) + 4 * (kt & 1) + krow;
      bf16x8 kf[3];
#pragma unroll
      for (int ks = 0; ks < 3; ++ks) kf[ks] = *reinterpret_cast<const bf16x8*>(kd + key * 256 + (((ks * 4 + fq) ^ kf_) << 4));
#pragma unroll
      for (int qt = 0; qt < 2; ++qt) {
        f32x4 a = {-ref[qt], -ref[qt], -ref[qt], -ref[qt]};
#pragma unroll
        for (int ks = 0; ks < 3; ++ks) a = __builtin_amdgcn_mfma_f32_16x16x32_bf16(kf[ks], qf[qt][ks], a, 0, 0, 0);
        s[kt][qt] = a;
      }
    }
  };
  __syncthreads();
  gloadK(sa, 0); gloadV(sa, 0); lstoreK(sa, 0); lstoreV(sa, 0);
  gloadK(sa, 1); lstoreK(sa, 1);
  gloadK(sa, 2); gloadV(sa, 1);
  __syncthreads();
  f32x4 sc[4][2], sn[4][2];
  {
    const float zero2[2] = {0.f, 0.f};
    qk_tile(kl, sc, zero2);
#pragma unroll
    for (int qt = 0; qt < 2; ++qt) {
      float tm = -1e30f;
#pragma unroll
      for (int kt = 0; kt < 4; ++kt)
#pragma unroll
        for (int j = 0; j < 4; ++j) tm = fmaxf(tm, sc[kt][qt][j]);
      tm = fmaxf(tm, __shfl_xor(tm, 16));
      tm = fmaxf(tm, __shfl_xor(tm, 32));
      mrun[qt] = tm; rcur[qt] = tm;
#pragma unroll
      for (int kt = 0; kt < 4; ++kt)
#pragma unroll
        for (int j = 0; j < 4; ++j) sc[kt][qt][j] -= tm;
    }
  }
  __syncthreads();
#pragma unroll 1
  for (int t2 = 0; t2 < 32; t2 += 2) {
    { const int t = t2, cur = 0;

    gloadK(sb, min(t + 3, 31));
    gloadV(sb, min(t + 2, 31));
    if (t + 1 < 32) { rnxt[0] = mrun[0]; rnxt[1] = mrun[1]; qk_tile(kl + (cur ^ 1) * 16384, sn, rnxt); }
    bf16x8 pf[2][2];
#pragma unroll
    for (int qt = 0; qt < 2; ++qt) {
      float lm = sc[0][qt][0];
#pragma unroll
      for (int kt = 0; kt < 4; ++kt)
#pragma unroll
        for (int j = 0; j < 4; ++j) lm = fmaxf(lm, sc[kt][qt][j]);
      const bool slow = (lm > ATT_THR) || (rcur[qt] != mrun[qt]);
      if (__any(slow)) {
        const float dl = rcur[qt] - mrun[qt];
        float tm = lm + dl;
        tm = fmaxf(tm, __shfl_xor(tm, 16));
        tm = fmaxf(tm, __shfl_xor(tm, 32));
        const float inc = fmaxf(tm, 0.f);
        const float alpha = __builtin_amdgcn_exp2f(-inc);
        mrun[qt] += inc;
        lrun[qt] *= alpha;
#pragma unroll
        for (int dt = 0; dt < 4; ++dt) { o[dt][qt][0] *= alpha; o[dt][qt][1] *= alpha; o[dt][qt][2] *= alpha; o[dt][qt][3] *= alpha; }
        const float sh = dl - inc;
#pragma unroll
        for (int kt = 0; kt < 4; ++kt)
#pragma unroll
          for (int j = 0; j < 4; ++j) sc[kt][qt][j] += sh;
      }
      float ls = 0.f;
#pragma unroll
      for (int kt = 0; kt < 4; ++kt)
#pragma unroll
        for (int j = 0; j < 4; ++j) { float e = __builtin_amdgcn_exp2f(sc[kt][qt][j]); sc[kt][qt][j] = e; ls += e; }
      lrun[qt] += ls;
#pragma unroll
      for (int k2 = 0; k2 < 2; ++k2) {
        union { bf16x8 v; unsigned u[4]; } t_;
        t_.u[0] = cvt_pk_bf16(sc[2 * k2][qt][0], sc[2 * k2][qt][1]); t_.u[1] = cvt_pk_bf16(sc[2 * k2][qt][2], sc[2 * k2][qt][3]);
        t_.u[2] = cvt_pk_bf16(sc[2 * k2 + 1][qt][0], sc[2 * k2 + 1][qt][1]); t_.u[3] = cvt_pk_bf16(sc[2 * k2 + 1][qt][2], sc[2 * k2 + 1][qt][3]);
        pf[k2][qt] = t_.v;
      }
    }
    const char* vdl = vl + cur * 8192;
    __builtin_amdgcn_s_setprio(1);
#pragma unroll
    for (int k2 = 0; k2 < 2; ++k2)
#pragma unroll
      for (int dt = 0; dt < 4; ++dt) {
        const int dim = dt * 16 + fr;
        bf16x8 af = *reinterpret_cast<const bf16x8*>(vdl + dim * 128 + (((k2 * 4 + fq) ^ ((dim >> 1) & 7)) << 4));
#pragma unroll
        for (int qt = 0; qt < 2; ++qt) o[dt][qt] = __builtin_amdgcn_mfma_f32_16x16x32_bf16(af, pf[k2][qt], o[dt][qt], 0, 0, 0);
      }
    __builtin_amdgcn_s_setprio(0);
    if (t + 2 < 32) lstoreK(sa, cur);
    if (t + 1 < 32) lstoreV(sa, cur ^ 1);
    __syncthreads();
#pragma unroll
    for (int kt = 0; kt < 4; ++kt)
#pragma unroll
      for (int qt = 0; qt < 2; ++qt) sc[kt][qt] = sn[kt][qt];
    rcur[0] = rnxt[0]; rcur[1] = rnxt[1];
      }
    { const int t = t2 + 1, cur = 1;

    gloadK(sa, min(t + 3, 31));
    gloadV(sa, min(t + 2, 31));
    if (t + 1 < 32) { rnxt[0] = mrun[0]; rnxt[1] = mrun[1]; qk_tile(kl + (cur ^ 1) * 16384, sn, rnxt); }
    bf16x8 pf[2][2];
#pragma unroll
    for (int qt = 0; qt < 2; ++qt) {
      float lm = sc[0][qt][0];
#pragma unroll
      for (int kt = 0; kt < 4; ++kt)
#pragma unroll
        for (int j = 0; j < 4; ++j) lm = fmaxf(lm, sc[kt][qt][j]);
      const bool slow = (lm > ATT_THR) || (rcur[qt] != mrun[qt]);
      if (__any(slow)) {
        const float dl = rcur[qt] - mrun[qt];
        float tm = lm + dl;
        tm = fmaxf(tm, __shfl_xor(tm, 16));
        tm = fmaxf(tm, __shfl_xor(tm, 32));
        const float inc = fmaxf(tm, 0.f);
        const float alpha = __builtin_amdgcn_exp2f(-inc);
        mrun[qt] += inc;
        lrun[qt] *= alpha;
#pragma unroll
        for (int dt = 0; dt < 4; ++dt) { o[dt][qt][0] *= alpha; o[dt][qt][1] *= alpha; o[dt][qt][2] *= alpha; o[dt][qt][3] *= alpha; }
        const float sh = dl - inc;
#pragma unroll
        for (int kt = 0; kt < 4; ++kt)
#pragma unroll
          for (int j = 0; j < 4; ++j) sc[kt][qt][j] += sh;
      }
      float ls = 0.f;
#pragma unroll
      for (int kt = 0; kt < 4; ++kt)
#pragma unroll
        for (int j = 0; j < 4; ++j) { float e = __builtin_amdgcn_exp2f(sc[kt][qt][j]); sc[kt][qt][j] = e; ls += e; }
      lrun[qt] += ls;
#pragma unroll
      for (int k2 = 0; k2 < 2; ++k2) {
        union { bf16x8 v; unsigned u[4]; } t_;
        t_.u[0] = cvt_pk_bf16(sc[2 * k2][qt][0], sc[2 * k2][qt][1]); t_.u[1] = cvt_pk_bf16(sc[2 * k2][qt][2], sc[2 * k2][qt][3]);
        t_.u[2] = cvt_pk_bf16(sc[2 * k2 + 1][qt][0], sc[2 * k2 + 1][qt][1]); t_.u[3] = cvt_pk_bf16(sc[2 * k2 + 1][qt][2], sc[2 * k2 + 1][qt][3]);
        pf[k2][qt] = t_.v;
      }
    }
    const char* vdl = vl + cur * 8192;
    __builtin_amdgcn_s_setprio(1);
#pragma unroll
    for (int k2 = 0; k2 < 2; ++k2)
#pragma unroll
      for (int dt = 0; dt < 4; ++dt) {
        const int dim = dt * 16 + fr;
        bf16x8 af = *reinterpret_cast<const bf16x8*>(vdl + dim * 128 + (((k2 * 4 + fq) ^ ((dim >> 1) & 7)) << 4));
#pragma unroll
        for (int qt = 0; qt < 2; ++qt) o[dt][qt] = __builtin_amdgcn_mfma_f32_16x16x32_bf16(af, pf[k2][qt], o[dt][qt], 0, 0, 0);
      }
    __builtin_amdgcn_s_setprio(0);
    if (t + 2 < 32) lstoreK(sb, cur);
    if (t + 1 < 32) lstoreV(sb, cur ^ 1);
    __syncthreads();
#pragma unroll
    for (int kt = 0; kt < 4; ++kt)
#pragma unroll
      for (int qt = 0; qt < 2; ++qt) sc[kt][qt] = sn[kt][qt];
    rcur[0] = rnxt[0]; rcur[1] = rnxt[1];
      }
  }
  const int b = bh >> 4, h = bh & 15;
#pragma unroll
  for (int qt = 0; qt < 2; ++qt) {
    float l = lrun[qt];
    l += __shfl_xor(l, 16);
    l += __shfl_xor(l, 32);
    const float inv = 1.0f / l;
    const long tok = (long)b * SEQ + qb * 256 + wid * 32 + qt * 16 + fr;
#pragma unroll
    for (int dt = 0; dt < 4; ++dt) {
      uint2 pk; pk.x = pack2(o[dt][qt][0] * inv, o[dt][qt][1] * inv); pk.y = pack2(o[dt][qt][2] * inv, o[dt][qt][3] * inv);
      *reinterpret_cast<uint2*>(O + tok * 1024 + h * 64 + dt * 16 + 4 * fq) = pk;
    }
  }
}
DEV void phase_mla_attn(const Params& p) {
  const int nb = gridDim.x;
  for (int u = vstart(); u < NBATCH * 16 * 8; u += nb) mla_attn_unit(p, u);
}

#ifndef ONLY
#define ONLY -1
#endif
#define PH(n, ...) if (ONLY < 0 || ONLY == n) { __VA_ARGS__; }
constexpr int LDS_BAR_OFF = 148480;
__global__ void __launch_bounds__(512) mega(Params p) {
  cg::grid_group grid = cg::this_grid();
  unsigned* barw = reinterpret_cast<unsigned*>(p.ws + S_BAR);
  if (blockIdx.x == 0) for (int i = threadIdx.x; i < XCD_BAR_WORDS; i += 512) barw[i] = 0u;
  if (threadIdx.x == 0) *reinterpret_cast<uint4*>(smem + LDS_BAR_OFF) = make_uint4(0u, 0u, 0u, 0u);
  PH(0, phase_prep(p));
  grid.sync();
  (void)xcd_barrier_post(barw, (volatile LAS unsigned*)(smem + LDS_BAR_OFF));
#define GSYNC() do { XcdBarrier xb_; xb_.bar = reinterpret_cast<unsigned*>(p.ws + S_BAR); xb_.x = xb_xcc_id(); xb_.st = (volatile LAS unsigned*)(smem + LDS_BAR_OFF); xcd_barrier(xb_); } while (0)
  PH(1, phase_abin(p)); GSYNC();
  PH(2, phase_mix0(p)); GSYNC();
  PH(2, phase_ztrans(p)); GSYNC();
  PH(3, phase_outproj(p, reinterpret_cast<const u16*>(p.ws + REG_A + 100663296ull), reinterpret_cast<const u16*>(p.ws + W_ABOUT))); GSYNC();
  for (int layer = 0; layer < 2; ++layer) {
    if (layer == 1) {
      PH(10, phase_mla_in(p)); GSYNC();
      PH(11, phase_mla_norm(p)); GSYNC();
      PH(12, phase_mla_up(p)); GSYNC();
      PH(13, phase_mla_attn(p)); GSYNC();
      PH(3, phase_outproj(p, reinterpret_cast<const u16*>(p.ws + MLA_O), reinterpret_cast<const u16*>(p.ws + W_MLAOUT))); GSYNC();
    }
    PH(4, phase_ln1_router(p, layer)); GSYNC();
    PH(5, phase_topk(p)); GSYNC();
    PH(6, phase_moe1(p, layer)); GSYNC();
    PH(7, phase_moe2(p, layer)); GSYNC();
    PH(8, phase_ln2(p, layer)); GSYNC();
    PH(9, phase_ple(p, layer, layer ? p.out : nullptr, layer ? nullptr : reinterpret_cast<u16*>(p.ws + REG_X)));
    if (layer == 0) GSYNC();
  }
}

static void add_job(Params& P, int& nj, int& tile, const float* src, u16* dst, int K, int N, int rsh, int rs, int off, int count, long sstride, long dstride, int f8 = 0, float fscale = 1.0f) {
  ConvJob& J = P.jobs[nj++];
  J.src = src; J.dst = dst; J.sstride = sstride; J.dstride = dstride; J.K = K; J.N = N; J.rs = rs; J.off = off; J.rsh = rsh;
  J.f8 = f8; J.fscale = fscale;
  if (f8) { J.ntn = N / 128; J.tpm = (K / 128) * J.ntn; } else { J.ntn = (N + 255) / 256; J.tpm = (K / 64) * J.ntn; }
  J.tile0 = tile; J.ntiles = J.tpm * count;
  tile += J.ntiles;
}

extern "C" void kernel_launch(void* const* d_in, const int* in_sizes, int n_in,
                              void* d_out, int out_size, void* d_ws, size_t ws_size,
                              hipStream_t stream) {
  constexpr size_t kDynLds = 148480 + 16;
  static int grid_blocks = 0;
  if (!grid_blocks) {
    int dev = 0, cus = 0, per_cu = 0;
    (void)hipGetDevice(&dev);
    (void)hipDeviceGetAttribute(&cus, hipDeviceAttributeMultiprocessorCount, dev);
    (void)hipFuncSetAttribute((const void*)mega, hipFuncAttributeMaxDynamicSharedMemorySize, (int)kDynLds);
    (void)hipOccupancyMaxActiveBlocksPerMultiprocessor(&per_cu, mega, 512, kDynLds);
    if (per_cu > 1) per_cu = 1;
    if (per_cu < 1) { fprintf(stderr, "occupancy query returned 0\n"); per_cu = 1; }
    grid_blocks = cus * per_cu;
    if (ws_size < WS_TOTAL) fprintf(stderr, "workspace too small: %zu < %zu\n", ws_size, (size_t)WS_TOTAL);
  }
  Params P;
  memset(&P, 0, sizeof(P));
  auto F = [&](int i) { return (const float*)d_in[i]; };
  char* ws = (char*)d_ws;
  P.x = F(0); P.p = F(1);
  P.na_rpb = F(3); P.hy_conv_w = F(4); P.hy_conv_b = F(5);
  P.hy_f_w1 = F(6); P.hy_f_b1 = F(7); P.hy_f_freq = F(8); P.hy_f_w2 = F(9); P.hy_f_b2 = F(10); P.hy_f_w3 = F(11); P.hy_skip = F(12);
  P.mla_q_norm = F(15); P.mla_kv_norm = F(17);
  P.ln1_g = F(20); P.ln1_b = F(21); P.ln2_g = F(22); P.ln2_b = F(23);
  P.moe_router = F(24);
  P.out = (float*)d_out; P.ws = ws;
  int nj = 0, tile = 0;
  add_job(P, nj, tile, F(2), (u16*)(ws + W_ABIN), 1024, 3072, 7, 128, 0, 1, 0, 0);
  add_job(P, nj, tile, F(13), (u16*)(ws + W_ABOUT), 1024, 1024, 7, 128, 0, 1, 0, 0);
  add_job(P, nj, tile, F(14), (u16*)(ws + W_MLAIN), 1024, 672, 7, 128, 0, 1, 0, 0);
  add_job(P, nj, tile, F(16), (u16*)(ws + W_QUP), 384, 1536, 7, 128, 0, 1, 0, 0);
  add_job(P, nj, tile, F(18), (u16*)(ws + W_KVUP), 256, 2048, 6, 64, 0, 1, 0, 0);
  P.jobs[nj - 1].sh2 = 1; P.jobs[nj - 1].off2 = 1024;
  add_job(P, nj, tile, F(19), (u16*)(ws + W_MLAOUT), 1024, 1024, 7, 128, 0, 1, 0, 0);
  add_job(P, nj, tile, F(28), (u16*)(ws + W_PLEG), 1024, 1024, 7, 128, 0, 2, 1024L * 1024, 1024L * 1024);
  add_job(P, nj, tile, F(29), (u16*)(ws + W_PLEP), 256, 1024, 7, 128, 0, 2, 256L * 1024, 1024L * 256);
  P.conv_f8_first = tile;
  add_job(P, nj, tile, F(25), (u16*)(ws + W_GU), 1024, 2048, 7, 256, 0, 32, 1024L * 2048, 4096L * 1024, 1, 32.0f);
  add_job(P, nj, tile, F(26), (u16*)(ws + W_GU), 1024, 2048, 7, 256, 128, 32, 1024L * 2048, 4096L * 1024, 1, 32.0f);
  add_job(P, nj, tile, F(27), (u16*)(ws + W_DN), 2048, 1024, 7, 128, 0, 32, 2048L * 1024, 1024L * 2048, 1, 64.0f);
  P.conv_total = tile;
  void* args[] = {&P};
  hipError_t e = hipLaunchCooperativeKernel((void*)mega, dim3(grid_blocks), dim3(512), args, kDynLds, stream);
  if (e != hipSuccess) fprintf(stderr, "cooperative launch failed: %s (grid %d)\n", hipGetErrorString(e), grid_blocks);
}
```

```cpp
#include <hip/hip_runtime.h>
#include <hip/hip_bf16.h>
#include <hip/hip_cooperative_groups.h>
#include <cstdio>
#include <cstring>
namespace cg = cooperative_groups;

typedef unsigned short u16;
using bf16x8 = __attribute__((ext_vector_type(8))) short;
using bf16x4 = __attribute__((ext_vector_type(4))) short;
using f32x4 = __attribute__((ext_vector_type(4))) float;
#define DEV __device__ __forceinline__

constexpr int TOK = 16384, DM = 1024, SEQ = 2048, NBATCH = 8;
constexpr int NEXP = 16, CAP = 256, DFF = 2048;
constexpr float DN_ALPHA = 1.4142135623730951f;
constexpr float LN_EPS = 1e-5f;

constexpr size_t W_ABIN = 0;
constexpr size_t W_ABOUT = W_ABIN + 3072ull * 1024 * 2;
constexpr size_t W_MLAIN = W_ABOUT + 1024ull * 1024 * 2;
constexpr size_t W_QUP = W_MLAIN + 768ull * 1024 * 2;
constexpr size_t W_KVUP = W_QUP + 1536ull * 384 * 2;
constexpr size_t W_MLAOUT = W_KVUP + 2048ull * 256 * 2;
constexpr size_t W_PLEG = W_MLAOUT + 1024ull * 1024 * 2;
constexpr size_t W_PLEP = W_PLEG + 2 * 1024ull * 1024 * 2;
constexpr size_t W_GU = W_PLEP + 2 * 1024ull * 256 * 2;
constexpr size_t W_DN = W_GU + 2 * 16ull * 4096 * 1024 * 2;
constexpr size_t REG_A = W_DN + 2 * 16ull * 1024 * 2048 * 2;
constexpr size_t REG_B = REG_A + 134217728ull;
constexpr size_t REG_C = REG_B + 134217728ull;
constexpr size_t REG_D = REG_C + 67108864ull;
constexpr size_t REG_E = REG_D + 67108864ull;
constexpr size_t REG_G = REG_E + 33554432ull;
constexpr size_t REG_X = REG_G + 67108864ull;
constexpr size_t REG_P = REG_X + 33554432ull;
constexpr size_t S_AFF = REG_P + 16777216ull;
constexpr size_t S_IDX = S_AFF + 1048576ull;
constexpr size_t S_GSEL = S_IDX + 131072ull;
constexpr size_t S_SLOT = S_GSEL + 131072ull;
constexpr size_t S_H2 = S_SLOT + 1048576ull;
constexpr size_t S_RG = S_H2 + 524288ull;
constexpr size_t S_ROPE = S_RG + 8388608ull;
constexpr size_t S_BAR = S_ROPE + 262144ull;
constexpr size_t WS_TOTAL = S_BAR + 16384ull;

struct ConvJob {
  const float* src; u16* dst;
  long sstride, dstride;
  int K, N;
  int rs, off;
  int rsh, sh2, off2, f8;
  float fscale; int padk;
  int ntn;
  int tpm;
  int tile0, ntiles;
};
constexpr int NJOBS = 16;

struct Params {
  const float* x; const float* p;
  const float* na_rpb; const float* hy_conv_w; const float* hy_conv_b;
  const float* hy_f_w1; const float* hy_f_b1; const float* hy_f_freq; const float* hy_f_w2; const float* hy_f_b2;
  const float* hy_f_w3; const float* hy_skip;
  const float* mla_q_norm; const float* mla_kv_norm;
  const float* ln1_g; const float* ln1_b; const float* ln2_g; const float* ln2_b;
  const float* moe_router;
  float* out; char* ws;
  int conv_total; int conv_f8_first;
  ConvJob jobs[NJOBS];
};

extern __shared__ __attribute__((aligned(16))) char smem[];

typedef __bf16 bf16x2_t __attribute__((ext_vector_type(2)));
typedef float f32x2_t __attribute__((ext_vector_type(2)));
DEV unsigned cvt_pk_bf16(float lo, float hi) { f32x2_t f = {lo, hi}; bf16x2_t b = __builtin_convertvector(f, bf16x2_t); return __builtin_bit_cast(unsigned, b); }
DEV u16 f2bf(float f) { return (u16)(cvt_pk_bf16(f, 0.f) & 0xffffu); }
DEV float bf2f(u16 h) { return __uint_as_float(((unsigned)h) << 16); }
DEV unsigned pack2(float a, float b) { return cvt_pk_bf16(a, b); }
DEV unsigned pack4_f8(float a, float b, float c, float d) { int w = 0; w = __builtin_amdgcn_cvt_pk_fp8_f32(a, b, w, false); w = __builtin_amdgcn_cvt_pk_fp8_f32(c, d, w, true); return (unsigned)w; }
DEV float4 bf4_to_f4(uint2 t) { return make_float4(__uint_as_float(t.x << 16), __uint_as_float(t.x & 0xffff0000u), __uint_as_float(t.y << 16), __uint_as_float(t.y & 0xffff0000u)); }
DEV float fsigmoid(float x) { return __builtin_amdgcn_rcpf(1.0f + __builtin_amdgcn_exp2f(-1.4426950408889634f * x)); }
template <int CTRL> DEV float dpp_f(float v) { return __builtin_bit_cast(float, __builtin_amdgcn_update_dpp(0, __builtin_bit_cast(int, v), CTRL, 0xf, 0xf, true)); }
DEV float row_allsum(float v) { v += dpp_f<0xB1>(v); v += dpp_f<0x4E>(v); v += dpp_f<0x141>(v); v += dpp_f<0x140>(v); return v; }
DEV float row_allmax(float v) { v = fmaxf(v, dpp_f<0xB1>(v)); v = fmaxf(v, dpp_f<0x4E>(v)); v = fmaxf(v, dpp_f<0x141>(v)); v = fmaxf(v, dpp_f<0x140>(v)); return v; }
DEV float rdl(float v, int l) { return __builtin_bit_cast(float, __builtin_amdgcn_readlane(__builtin_bit_cast(int, v), l)); }
DEV float wave_sum(float v) { v = row_allsum(v); return (rdl(v, 0) + rdl(v, 16)) + (rdl(v, 32) + rdl(v, 48)); }
DEV int otid() { int t = threadIdx.x; asm volatile("" : "+v"(t)); return t; }
DEV int vstart() {
  int nb = gridDim.x, b = blockIdx.x;
  return (nb % 8 == 0) ? (b % 8) * (nb / 8) + b / 8 : b;
}


#define XB_TMO      128
#define XB_XCNT(j)  (256  + 64 * (j))
#define XB_XSUB(j)  (1280 + 64 * (j))
#define XB_XGEN(j)  (2304 + 64 * (j))
#define XB_TOP      3328
#define XB_TOPGEN   3392
#define XCD_BAR_WORDS 3456
#define XB_SPIN_CAP (1u << 18)
#define LAS __attribute__((address_space(3)))
DEV unsigned xb_ld(unsigned* p) { return __hip_atomic_load(p, __ATOMIC_RELAXED, __HIP_MEMORY_SCOPE_AGENT); }
DEV unsigned xb_add(unsigned* p, unsigned v) { return __hip_atomic_fetch_add(p, v, __ATOMIC_RELAXED, __HIP_MEMORY_SCOPE_AGENT); }
DEV unsigned xb_xcc_id() { return (unsigned)__builtin_amdgcn_s_getreg((3 << 11) | 20) & 0xFu; }
#define XB_SPIN(cond, bar) do { unsigned _sp = 0; while (cond) { __builtin_amdgcn_s_sleep(1); \
    if ((++_sp & 255u) == 0u) { if (xb_ld(&(bar)[XB_TMO])) break; if (_sp > XB_SPIN_CAP) { atomicAdd(&(bar)[XB_TMO], 1u); break; } } } } while (0)
struct XcdBarrier { unsigned* bar; unsigned x; volatile LAS unsigned* st; };
DEV XcdBarrier xcd_barrier_post(unsigned* bar, volatile LAS unsigned* st) {
  XcdBarrier b; b.bar = bar; b.x = xb_xcc_id(); b.st = st;
  if (threadIdx.x == 0) (void)xb_add(&bar[XB_XCNT(b.x)], 1u);
  return b;
}
DEV void xcd_barrier_complete(unsigned* bar, unsigned x, unsigned& nloc, unsigned& nx) {
  const unsigned G = gridDim.x * gridDim.y * gridDim.z;
  unsigned sum, cnt, mine, sp = 0u;
  for (;;) {
    sum = 0u; cnt = 0u; mine = 0u;
#pragma unroll
    for (unsigned j = 0; j < 16; ++j) { const unsigned c = xb_ld(&bar[XB_XCNT(j)]); sum += c; cnt += (c > 0u) ? 1u : 0u; mine = (j == x) ? c : mine; }
    if (sum == G) break;
    __builtin_amdgcn_s_sleep(1);
    if ((++sp & 255u) == 0u) { if (xb_ld(&bar[XB_TMO])) break; if (sp > XB_SPIN_CAP) { atomicAdd(&bar[XB_TMO], 1u); break; } }
  }
  nloc = mine > 0u ? mine : 1u; nx = cnt > 0u ? cnt : 1u;
}
DEV void xcd_barrier(const XcdBarrier& b) {
  asm volatile("s_waitcnt vmcnt(0)" ::: "memory");
  __syncthreads();
  if (threadIdx.x == 0) {
    unsigned* bar = b.bar;
    __builtin_amdgcn_s_waitcnt(0);
    unsigned nloc = b.st[0], nx = b.st[1];
    if (nloc == 0u) { xcd_barrier_complete(bar, b.x, nloc, nx); b.st[0] = nloc; b.st[1] = nx; }
    const unsigned old = xb_add(&bar[XB_XSUB(b.x)], 1u);
    const unsigned gen = old / nloc;
    if (old + 1u == (gen + 1u) * nloc) {
      __builtin_amdgcn_fence(__ATOMIC_RELEASE, "agent");
      asm volatile("s_waitcnt vmcnt(0)" ::: "memory");
      const unsigned og = xb_add(&bar[XB_TOP], 1u);
      const unsigned tg = og / nx;
      if (og + 1u == (tg + 1u) * nx) xb_add(&bar[XB_TOPGEN], 1u);
      else XB_SPIN(xb_ld(&bar[XB_TOPGEN]) == tg, bar);
      __builtin_amdgcn_fence(__ATOMIC_ACQUIRE, "agent");
      xb_add(&bar[XB_XGEN(b.x)], 1u);
      asm volatile("s_waitcnt vmcnt(0)" ::: "memory");
    } else {
      XB_SPIN(xb_ld(&bar[XB_XGEN(b.x)]) == gen, bar);
      __builtin_amdgcn_fence(__ATOMIC_ACQUIRE, "agent");
      asm volatile("s_waitcnt vmcnt(0)" ::: "memory");
    }
  }
  __syncthreads();
}

DEV int lds_byte(int r, int c) {
  int st = (r >> 4) * 2 + (c >> 5), rr = r & 15, cc = c & 31, ob = rr * 64 + cc * 2;
  return st * 1024 + (ob ^ (((ob >> 9) & 1) << 5));
}
DEV void stage_rc(int b, int& R, int& C) {
  int st = b / 1024, sb = b % 1024, swz = sb ^ (((sb >> 9) & 1) << 5);
  R = (st >> 1) * 16 + swz / 64; C = (st & 1) * 32 + (swz % 64) / 2;
}
#define GLDS16(g, l) __builtin_amdgcn_global_load_lds((const unsigned*)(g), (unsigned*)(l), 16, 0, 0)

typedef f32x4 Acc8[2][2][4][2];
constexpr int G8_BM = 256, G8_BK = 64, G8_HALF = 128, G8_HTB = G8_HALF * G8_BK * 2, G8_NXCD = 8, G8_WGM = 8;
DEV int perm32(int rho) { const int n = rho >> 4, i = rho & 15; return 8 * (i >> 2) + 4 * n + (i & 3); }
struct Unit { int pm, pn; };
DEV bool unit_next(int i, int nM, int nN, Unit& u) {
  const int nwg = nM * nN;
  const long L = (long)i * gridDim.x + blockIdx.x; if (L >= nwg) return false;
  int wgid = (int)L; { const int q = nwg / G8_NXCD, r = nwg % G8_NXCD, xcd = wgid % G8_NXCD, off = wgid / G8_NXCD; wgid = (xcd < r ? xcd * (q + 1) : r * (q + 1) + (xcd - r) * q) + off; }
  const int nig = G8_WGM * nN, gid = wgid / nig, fm = gid * G8_WGM, gsz = (nM - fm) < G8_WGM ? (nM - fm) : G8_WGM;
  u.pm = fm + ((wgid % nig) % gsz); u.pn = (wgid % nig) / gsz; return true;
}
typedef int v4i_t __attribute__((ext_vector_type(4)));
typedef int v8i_t __attribute__((ext_vector_type(8)));
template <bool TR, bool PERM, bool F8, class PF, class EF>
DEV void gemm_phase(const int K, const int nM, const int nN, PF ptrs, EF E) {
  LAS unsigned char* lds = (LAS unsigned char*)smem;
  const int tid = otid(), wid = __builtin_amdgcn_readfirstlane(tid >> 6), lane = tid & 63, wr = wid >> 2, wc = wid & 3, fr = lane & 15, fq = lane >> 4;
  const int Kb = F8 ? K : 2 * K;
  const int nt = Kb / 128;
  unsigned voffA[2], voffB[2];
#pragma unroll
  for (int i = 0; i < 2; ++i) { int R, C; stage_rc(tid * 16 + i * 8192, R, C); const int Rb = PERM ? ((R & ~31) + perm32(R & 31)) : R;
    voffA[i] = (unsigned)(R * Kb + C * 2); voffB[i] = (unsigned)(Rb * Kb + C * 2); }
  const size_t kstep = (size_t)(G8_BK * 2);
  const size_t hstep = (size_t)G8_HALF * Kb;
  const unsigned ldsw = (unsigned)wid * 1024u;
  const int aoff = lds_byte(wr * 64 + fr, fq * 8), boff = lds_byte(wc * 32 + fr, fq * 8);
#define PG8_SA(b, h) (((b) * 2 + (h)) * G8_HTB)
#define PG8_SB(b, h) ((4 + (b) * 2 + (h)) * G8_HTB)
#define PG8_STAGE(bufoff, gbase, voff) do { _Pragma("unroll") for (int _i = 0; _i < 2; ++_i) { unsigned _vo = (voff)[_i]; asm volatile("" : "+v"(_vo)); \
    __builtin_amdgcn_global_load_lds((const unsigned*)((const char*)(gbase) + _vo), (LAS unsigned*)(lds + (bufoff) + ldsw + _i * 8192), 16, 0, 0); } } while (0)
#define PG8_LD16(off) (*(const LAS v4i_t*)(lds + (off)))
#define PG8_LDA(dst, b, h) do { if constexpr (F8) { _Pragma("unroll") for (int m = 0; m < 4; ++m) dst##8[m] = __builtin_shufflevector(PG8_LD16(PG8_SA(b, h) + aoff + m * 2048), PG8_LD16(PG8_SA(b, h) + aoff + m * 2048 + 1024), 0, 1, 2, 3, 4, 5, 6, 7); } \
    else { _Pragma("unroll") for (int m = 0; m < 4; ++m) _Pragma("unroll") for (int k = 0; k < 2; ++k) dst[m][k] = *(const LAS bf16x8*)(lds + PG8_SA(b, h) + aoff + m * 2048 + k * 1024); } } while (0)
#define PG8_LDB(dst, b, h) do { if constexpr (F8) { _Pragma("unroll") for (int n = 0; n < 2; ++n) dst##8[n] = __builtin_shufflevector(PG8_LD16(PG8_SB(b, h) + boff + n * 2048), PG8_LD16(PG8_SB(b, h) + boff + n * 2048 + 1024), 0, 1, 2, 3, 4, 5, 6, 7); } \
    else { _Pragma("unroll") for (int n = 0; n < 2; ++n) _Pragma("unroll") for (int k = 0; k < 2; ++k) dst[n][k] = *(const LAS bf16x8*)(lds + PG8_SB(b, h) + boff + n * 2048 + k * 1024); } } while (0)
#define PG8_MMA(ai, bj, At, Bt) do { __builtin_amdgcn_s_setprio(1); \
    if constexpr (F8) { _Pragma("unroll") for (int m = 0; m < 4; ++m) _Pragma("unroll") for (int n = 0; n < 2; ++n) \
        { if constexpr (TR) asm volatile("v_mfma_f32_16x16x128_f8f6f4 %0, %1, %2, %0" : "+v"(acc[ai][bj][m][n]) : "v"(Bt##8[n]), "v"(At##8[m])); \
          else asm volatile("v_mfma_f32_16x16x128_f8f6f4 %0, %1, %2, %0" : "+v"(acc[ai][bj][m][n]) : "v"(At##8[m]), "v"(Bt##8[n])); } } \
    else { _Pragma("unroll") for (int m = 0; m < 4; ++m) _Pragma("unroll") for (int n = 0; n < 2; ++n) _Pragma("unroll") for (int k = 0; k < 2; ++k) \
    acc[ai][bj][m][n] = TR ? __builtin_amdgcn_mfma_f32_16x16x32_bf16(Bt[n][k], At[m][k], acc[ai][bj][m][n], 0, 0, 0) \
                           : __builtin_amdgcn_mfma_f32_16x16x32_bf16(At[m][k], Bt[n][k], acc[ai][bj][m][n], 0, 0, 0); } __builtin_amdgcn_s_setprio(0); } while (0)
#define PG8_WAIT_V(n) asm volatile("s_waitcnt vmcnt(" #n ")" ::: "memory")
#define PG8_WAIT_L(n) asm volatile("s_waitcnt lgkmcnt(" #n ")" ::: "memory")
#define PG8_BAR __builtin_amdgcn_s_barrier()
#define PG8_SCHED __builtin_amdgcn_sched_barrier(0)
  Unit cur, nxt; int ui = 0;
  if (!unit_next(0, nM, nN, cur)) return;
  Acc8 acc;
#pragma unroll
  for (int a = 0; a < 2; ++a)
#pragma unroll
    for (int b = 0; b < 2; ++b)
#pragma unroll
      for (int m = 0; m < 4; ++m)
#pragma unroll
        for (int n = 0; n < 2; ++n) acc[a][b][m][n] = f32x4{0.f, 0.f, 0.f, 0.f};
  bf16x8 At[4][2], B0[2][2], B1[2][2];
  v8i_t At8[4], B08[2], B18[2];
  const char* cA; const char* cB;
  ptrs(cur, cA, cB);
  PG8_STAGE(PG8_SB(0, 0), cB, voffB); PG8_STAGE(PG8_SA(0, 0), cA, voffA); PG8_STAGE(PG8_SB(0, 1), cB + hstep, voffB); PG8_STAGE(PG8_SA(0, 1), cA + hstep, voffA);
  if (wr == 1) PG8_BAR;
  PG8_WAIT_V(4); PG8_BAR;
  PG8_STAGE(PG8_SB(1, 0), cB + kstep, voffB); PG8_STAGE(PG8_SA(1, 0), cA + kstep, voffA); PG8_STAGE(PG8_SB(1, 1), cB + hstep + kstep, voffB);
  PG8_WAIT_V(6); PG8_BAR;
  for (;;) {
    const bool has_next = unit_next(ui + 1, nM, nN, nxt);
    const char* nA = cA; const char* nB = cB;
    if (has_next) ptrs(nxt, nA, nB);
#pragma unroll 1
    for (int t = 0; t < nt; t += 2) {
      const bool last = (t == nt - 2);
      const char* a1 = cA + (size_t)(t + 1) * kstep;
      const char* a2 = last ? nA : cA + (size_t)(t + 2) * kstep; const char* b2 = last ? nB : cB + (size_t)(t + 2) * kstep;
      const char* a3 = a2 + kstep; const char* b3 = b2 + kstep;
      PG8_LDB(B0, 0, 0); PG8_SCHED; PG8_LDA(At, 0, 0); PG8_STAGE(PG8_SA(1, 1), a1 + hstep, voffA);
      PG8_WAIT_L(8); PG8_BAR; PG8_WAIT_L(0); PG8_MMA(0, 0, At, B0); PG8_BAR; PG8_SCHED;
      PG8_LDB(B1, 0, 1); PG8_STAGE(PG8_SB(0, 0), b2, voffB);
      PG8_BAR; PG8_WAIT_L(0); PG8_MMA(0, 1, At, B1); PG8_BAR;
      PG8_LDA(At, 0, 1); PG8_STAGE(PG8_SA(0, 0), a2, voffA);
      PG8_BAR; PG8_WAIT_L(0); PG8_MMA(1, 0, At, B0); PG8_BAR; PG8_SCHED;
      PG8_STAGE(PG8_SB(0, 1), b2 + hstep, voffB);
      PG8_WAIT_V(6); PG8_BAR; PG8_MMA(1, 1, At, B1); PG8_BAR;
      PG8_LDB(B0, 1, 0); PG8_SCHED; PG8_LDA(At, 1, 0); PG8_STAGE(PG8_SA(0, 1), a2 + hstep, voffA);
      PG8_WAIT_L(8); PG8_BAR; PG8_WAIT_L(0); PG8_MMA(0, 0, At, B0); PG8_BAR; PG8_SCHED;
      PG8_LDB(B1, 1, 1); PG8_STAGE(PG8_SB(1, 0), b3, voffB);
      PG8_BAR; PG8_WAIT_L(0); PG8_MMA(0, 1, At, B1); PG8_BAR;
      PG8_LDA(At, 1, 1); PG8_STAGE(PG8_SA(1, 0), a3, voffA);
      PG8_BAR; PG8_WAIT_L(0); PG8_MMA(1, 0, At, B0); PG8_BAR; PG8_SCHED;
      PG8_STAGE(PG8_SB(1, 1), b3 + hstep, voffB);
      PG8_WAIT_V(6); PG8_BAR; PG8_MMA(1, 1, At, B1); PG8_BAR;
    }
    if constexpr (F8) asm volatile("s_nop 15\n\ts_nop 15" ::: "memory");
    { const int l2 = otid() & 63; E(acc, cur, wr, wc, l2 & 15, l2 >> 4); }
    if (!has_next) break;
#pragma unroll
    for (int a = 0; a < 2; ++a)
#pragma unroll
      for (int b = 0; b < 2; ++b)
#pragma unroll
        for (int m = 0; m < 4; ++m)
#pragma unroll
          for (int n = 0; n < 2; ++n) acc[a][b][m][n] = f32x4{0.f, 0.f, 0.f, 0.f};
    cur = nxt; cA = nA; cB = nB; ++ui;
  }
  PG8_WAIT_V(0);
  if (wr == 0) PG8_BAR;
  PG8_BAR;
#undef PG8_SA
#undef PG8_SB
#undef PG8_STAGE
#undef PG8_LDA
#undef PG8_LD16
#undef PG8_LDB
#undef PG8_MMA
#undef PG8_WAIT_V
#undef PG8_WAIT_L
#undef PG8_BAR
#undef PG8_SCHED
}
#define E8_FOR _Pragma("unroll") for (int ai = 0; ai < 2; ++ai) _Pragma("unroll") for (int m = 0; m < 4; ++m) _Pragma("unroll") for (int bj = 0; bj < 2; ++bj)

DEV void conv_tile(const ConvJob& J, int t) {
  const int tid = otid();
  int mat = t / J.tpm, tt = t % J.tpm;
  int kt = tt / J.ntn, nt = tt % J.ntn;
  const float* src = J.src + (long)mat * J.sstride;
  u16* dst = J.dst + (long)mat * J.dstride;
  const int kg = tid >> 6, ng = tid & 63;
  const int n = nt * 256 + ng * 4;
  float4 v[8];
#pragma unroll
  for (int j = 0; j < 8; ++j) {
    int k = kt * 64 + kg * 8 + j;
    if (n < J.N) { const f32x4 t_ = __builtin_nontemporal_load(reinterpret_cast<const f32x4*>(src + (long)k * J.N + n)); v[j] = make_float4(t_[0], t_[1], t_[2], t_[3]); }
    else v[j] = make_float4(0.f, 0.f, 0.f, 0.f);
  }
#pragma unroll
  for (int i = 0; i < 4; ++i) {
    float e[8];
#pragma unroll
    for (int j = 0; j < 8; ++j) e[j] = (i == 0) ? v[j].x : (i == 1) ? v[j].y : (i == 2) ? v[j].z : v[j].w;
    uint4 pk;
    pk.x = pack2(e[0], e[1]); pk.y = pack2(e[2], e[3]); pk.z = pack2(e[4], e[5]); pk.w = pack2(e[6], e[7]);
    *reinterpret_cast<uint4*>(smem + (i * 64 + ng) * 144 + kg * 16) = pk;
  }
  __syncthreads();
#pragma unroll
  for (int u = 0; u < 4; ++u) {
    int q = tid + 512 * u;
    int nl = q >> 3, ch = q & 7;
    uint4 pk = *reinterpret_cast<const uint4*>(smem + ((nl & 3) * 64 + (nl >> 2)) * 144 + ch * 16);
    int nn = nt * 256 + nl;
    const int qq = nn >> J.rsh;
    long drow = (long)(qq >> J.sh2) * J.rs + (qq & ((1 << J.sh2) - 1)) * J.off2 + (nn & ((1 << J.rsh) - 1)) + J.off;
    *reinterpret_cast<uint4*>(dst + drow * J.K + kt * 64 + ch * 8) = pk;
  }
  __syncthreads();
}

struct F8Tile { const float* src; unsigned char* dst; int N, K, kt, nt, rsh, sh2, rs, off2, off; float sc; };
DEV void f8_decode(const Params& p, int t, F8Tile& T) {
  int j = 0;
#pragma unroll 1
  for (int q = 1; q < NJOBS; ++q) if (t >= p.jobs[q].tile0 && p.jobs[q].ntiles > 0) j = q;
  const ConvJob& J = p.jobs[j];
  const int tl = t - J.tile0;
  const int mat = tl / J.tpm, tt = tl % J.tpm;
  T.kt = tt / J.ntn; T.nt = tt % J.ntn;
  T.src = J.src + (long)mat * J.sstride;
  T.dst = reinterpret_cast<unsigned char*>(J.dst) + (long)mat * J.dstride;
  T.N = J.N; T.K = J.K; T.rsh = J.rsh; T.sh2 = J.sh2; T.rs = J.rs; T.off2 = J.off2; T.off = J.off; T.sc = J.fscale;
}
DEV void f8_load(const F8Tile& T, float4 (&v)[8]) {
  const int tid = otid(), kg = tid >> 5, ng = tid & 31;
  const float* s0 = T.src + (long)(T.kt * 128 + kg * 8) * T.N + T.nt * 128 + ng * 4;
#pragma unroll
  for (int j = 0; j < 8; ++j) { const f32x4 t_ = __builtin_nontemporal_load(reinterpret_cast<const f32x4*>(s0 + (long)j * T.N)); v[j] = make_float4(t_[0], t_[1], t_[2], t_[3]); }
}
DEV void f8_emit(const F8Tile& T, const float4 (&v)[8], char* img) {
  const int tid = otid(), kg = tid >> 5, ng = tid & 31;
#pragma unroll
  for (int i = 0; i < 4; ++i) {
    float e[8];
#pragma unroll
    for (int j = 0; j < 8; ++j) e[j] = ((i == 0) ? v[j].x : (i == 1) ? v[j].y : (i == 2) ? v[j].z : v[j].w) * T.sc;
    uint2 pk; pk.x = pack4_f8(e[0], e[1], e[2], e[3]); pk.y = pack4_f8(e[4], e[5], e[6], e[7]);
    *reinterpret_cast<uint2*>(img + (i * 32 + ng) * 144 + kg * 8) = pk;
  }
  __syncthreads();
#pragma unroll
  for (int u = 0; u < 2; ++u) {
    int q = tid + 512 * u;
    int nl = q >> 3, ch = q & 7;
    uint4 pk = *reinterpret_cast<const uint4*>(img + ((nl & 3) * 32 + (nl >> 2)) * 144 + ch * 16);
    int nn = T.nt * 128 + nl;
    const int qq = nn >> T.rsh;
    long drow = (long)(qq >> T.sh2) * T.rs + (qq & ((1 << T.sh2) - 1)) * T.off2 + (nn & ((1 << T.rsh) - 1)) + T.off;
    *reinterpret_cast<uint4*>(T.dst + drow * T.K + T.kt * 128 + ch * 16) = pk;
  }
}
DEV void f8_stream(const Params& p, int first, int total) {
  const int nb = gridDim.x;
  int t = first + blockIdx.x;
  if (t >= total) return;
  float4 va[8], vb[8];
  F8Tile Ta, Tb;
  f8_decode(p, t, Ta); f8_load(Ta, va);
  __syncthreads();
  for (;;) {
    int tn = t + nb;
    f8_decode(p, min(tn, total - 1), Tb); f8_load(Tb, vb);
    f8_emit(Ta, va, smem);
    if (tn >= total) break;
    t = tn; tn = t + nb;
    f8_decode(p, min(tn, total - 1), Ta); f8_load(Ta, va);
    f8_emit(Tb, vb, smem + 18432);
    if (tn >= total) break;
    t = tn;
  }
  __syncthreads();
}

DEV void phase_prep(const Params& p) {
  const int tid = otid(), nb = gridDim.x, bid = blockIdx.x;
  {
    float* zb = reinterpret_cast<float*>(smem);
    float* h1b = zb + 512;
    float* h2g = reinterpret_cast<float*>(p.ws + S_H2);
    const int w = tid >> 6, lane = tid & 63;
    for (int l0 = bid * 8; l0 < SEQ; l0 += nb * 8) {
      int l = l0 + w;
      float tt = (float)l / (float)(SEQ - 1);
      float ww = 6.283185307179586f * (float)l / (float)SEQ;
      float z = 0.f;
      if (lane == 0) z = tt;
      else if (lane <= 16) { float f = 1e-4f + (float)(lane - 1) * ((15.0f - 1e-4f) / 15.0f); z = cosf(f * ww); }
      else if (lane <= 32) { float f = 1e-4f + (float)(lane - 17) * ((15.0f - 1e-4f) / 15.0f); z = -sinf(f * ww); }
      zb[w * 64 + lane] = z;
      __syncthreads();
      float fr_ = p.hy_f_freq[lane];
      float a = p.hy_f_b1[lane];
      for (int k = 0; k < 33; ++k) a += zb[w * 64 + k] * p.hy_f_w1[k * 64 + lane];
      h1b[w * 64 + lane] = sinf(fr_ * a);
      __syncthreads();
      float a2 = p.hy_f_b2[lane];
      for (int k = 0; k < 64; ++k) a2 += h1b[w * 64 + k] * p.hy_f_w2[k * 64 + lane];
      h2g[l * 64 + lane] = sinf(fr_ * a2);
      __syncthreads();
    }
  }
  {
    float2* rt = reinterpret_cast<float2*>(p.ws + S_ROPE);
    for (int i = bid * 512 + tid; i < SEQ * 16; i += nb * 512) {
      const int l = i >> 4, k = i & 15;
      float sn, cs; sincosf((float)l * (1.0f / powf(10000.0f, (float)k / 16.0f)), &sn, &cs);
      rt[i] = make_float2(cs, sn);
    }
  }
  {
    u16* xb = reinterpret_cast<u16*>(p.ws + REG_X);
    const long n8 = (long)TOK * DM / 8;
#pragma unroll 4
    for (long i = (long)bid * 512 + tid; i < n8; i += (long)nb * 512) {
      const f32x4 a_ = __builtin_nontemporal_load(reinterpret_cast<const f32x4*>(p.x) + 2 * i), b_ = __builtin_nontemporal_load(reinterpret_cast<const f32x4*>(p.x) + 2 * i + 1);
      const float4 a = make_float4(a_[0], a_[1], a_[2], a_[3]), b = make_float4(b_[0], b_[1], b_[2], b_[3]);
      uint4 pk; pk.x = pack2(a.x, a.y); pk.y = pack2(a.z, a.w); pk.z = pack2(b.x, b.y); pk.w = pack2(b.z, b.w);
      reinterpret_cast<uint4*>(xb)[i] = pk;
    }
    u16* pb = reinterpret_cast<u16*>(p.ws + REG_P);
    const long m8 = 2L * TOK * 256 / 8;
#pragma unroll 4
    for (long i = (long)bid * 512 + tid; i < m8; i += (long)nb * 512) {
      const f32x4 a_ = __builtin_nontemporal_load(reinterpret_cast<const f32x4*>(p.p) + 2 * i), b_ = __builtin_nontemporal_load(reinterpret_cast<const f32x4*>(p.p) + 2 * i + 1);
      const float4 a = make_float4(a_[0], a_[1], a_[2], a_[3]), b = make_float4(b_[0], b_[1], b_[2], b_[3]);
      uint4 pk; pk.x = pack2(a.x, a.y); pk.y = pack2(a.z, a.w); pk.z = pack2(b.x, b.y); pk.w = pack2(b.z, b.w);
      reinterpret_cast<uint4*>(pb)[i] = pk;
    }
  }
  for (int t = bid; t < p.conv_f8_first; t += nb) {
    int j = 0;
#pragma unroll 1
    for (int q = 1; q < NJOBS; ++q) if (t >= p.jobs[q].tile0 && p.jobs[q].ntiles > 0) j = q;
    conv_tile(p.jobs[j], t - p.jobs[j].tile0);
  }
  f8_stream(p, p.conv_f8_first, p.conv_total);
}

DEV void filter_b(const Params& p, int cpair) {
  const int tid = otid();
  float* w3s = reinterpret_cast<float*>(smem);
  float* red = w3s + 512;
  float* nrm = red + 32;
  float* hb = nrm + 4;
  const float* h2g = reinterpret_cast<const float*>(p.ws + S_H2);
  {
    int ci = tid >> 6, k = tid & 63;
    int o = ci >> 2, d = (ci >> 1) & 1, cc = ci & 1;
    w3s[ci * 64 + k] = p.hy_f_w3[k * 2048 + o * 1024 + d * 512 + 2 * cpair + cc];
  }
  __syncthreads();
  const float min_decay = logf(1e-2f) / 1.5f, max_decay = logf(1e-2f) / 0.3f;
#pragma unroll 1
  for (int i = 0; i < 4; ++i) {
    int l = tid + 512 * i;
    float h2[64];
#pragma unroll
    for (int k = 0; k < 16; ++k) {
      float4 v = *reinterpret_cast<const float4*>(h2g + l * 64 + k * 4);
      h2[4 * k] = v.x; h2[4 * k + 1] = v.y; h2[4 * k + 2] = v.z; h2[4 * k + 3] = v.w;
    }
    float tt = (float)l / (float)(SEQ - 1);
#pragma unroll 1
    for (int ci = 0; ci < 8; ++ci) {
      float a = 0.f;
#pragma unroll
      for (int k = 0; k < 64; ++k) a += h2[k] * w3s[ci * 64 + k];
      int cc = ci & 1;
      int c = 2 * cpair + cc;
      float delta = fabsf(min_decay + (float)c * ((max_decay - min_decay) / 511.0f));
      a *= expf(-tt * delta);
      hb[ci * 2048 + l] = a;
    }
  }
  __syncthreads();
  {
    float ss[4];
#pragma unroll
    for (int oc = 0; oc < 4; ++oc) {
      int o = oc >> 1, cc = oc & 1;
      float a = 0.f;
      for (int l = tid; l < 2048; l += 512) {
        float f = hb[(o * 4 + 0 + cc) * 2048 + l];
        float b = (l > 0) ? hb[(o * 4 + 2 + cc) * 2048 + l] : 0.f;
        a += f * f + b * b;
      }
      ss[oc] = wave_sum(a);
    }
    if ((tid & 63) == 0) {
#pragma unroll
      for (int q = 0; q < 4; ++q) red[(tid >> 6) * 4 + q] = ss[q];
    }
  }
  __syncthreads();
  if (tid < 4) {
    float s = 0.f;
    for (int w = 0; w < 8; ++w) s += red[w * 4 + tid];
    nrm[tid] = rsqrtf(s + 1e-12f);
  }
  __syncthreads();
  u16* Rg = reinterpret_cast<u16*>(p.ws + S_RG);
  for (int q = tid; q < 4 * 4096; q += 512) {
    int oc = q >> 12, qq = q & 4095;
    int o = oc >> 1, cc = oc & 1;
    float v;
    if (qq == 0) v = 0.f;
    else if (qq <= 2048) v = hb[(o * 4 + 0 * 2 + cc) * 2048 + (2048 - qq)];
    else v = hb[(o * 4 + 1 * 2 + cc) * 2048 + (qq - 2048)];
    v *= nrm[oc];
    Rg[((long)o * 512 + 2 * cpair + cc) * 4096 + qq] = f2bf(v);
  }
  __syncthreads();
}

DEV void phase_abin(const Params& p) {
  const int nb = gridDim.x;
  for (int c = blockIdx.x; c < 256; c += nb) filter_b(p, c);
  const u16* xb = reinterpret_cast<const u16*>(p.ws + REG_X);
  const u16* wt = reinterpret_cast<const u16*>(p.ws + W_ABIN);
  u16* qk = reinterpret_cast<u16*>(p.ws + REG_B);
  u16* vht = reinterpret_cast<u16*>(p.ws + REG_B + 33554432ull);
  gemm_phase<true, true, false>(1024, 64, 4, [&](const Unit& u, const char*& a, const char*& b) { a = (const char*)(xb) + (size_t)u.pm * 256 * (1024) * 2; b = (const char*)(wt) + (size_t)u.pn * 256 * (1024) * 2; },
      [&](Acc8& acc, const Unit& u, int wr, int wc, int fr, int fq) {
        const float sc = (u.pn < 2) ? 0.125f : 1.0f;
        u16* base = qk + (long)(u.pm * 256 + wr * 64 + fr) * 1024 + u.pn * 256 + wc * 32 + 8 * fq;
        E8_FOR {
          f32x4 v0 = acc[ai][bj][m][0], v1 = acc[ai][bj][m][1];
          uint4 pk;
          pk.x = cvt_pk_bf16(v0[0] * sc, v0[1] * sc); pk.y = cvt_pk_bf16(v0[2] * sc, v0[3] * sc);
          pk.z = cvt_pk_bf16(v1[0] * sc, v1[1] * sc); pk.w = cvt_pk_bf16(v1[2] * sc, v1[3] * sc);
          *reinterpret_cast<uint4*>(base + (ai * 128 + m * 16) * 1024 + bj * 128) = pk;
        }
      });
  gemm_phase<false, false, false>(1024, 64, 8, [&](const Unit& u, const char*& a, const char*& b) { a = (const char*)(xb) + (size_t)u.pm * 256 * (1024) * 2; b = (const char*)(wt + 1024 * 1024) + (size_t)u.pn * 256 * (1024) * 2; },
      [&](Acc8& acc, const Unit& u, int wr, int wc, int fr, int fq) {
        u16* base = vht + (long)(u.pn * 256 + wc * 32 + fr) * TOK + u.pm * 256 + wr * 64 + 4 * fq;
        E8_FOR {
#pragma unroll
          for (int n = 0; n < 2; ++n) {
            f32x4 v = acc[ai][bj][m][n];
            uint2 pk; pk.x = cvt_pk_bf16(v[0], v[1]); pk.y = cvt_pk_bf16(v[2], v[3]);
            *reinterpret_cast<uint2*>(base + (long)(bj * 128 + n * 16) * TOK + ai * 128 + m * 16) = pk;
          }
        }
      });
}

constexpr int NA_VST = 580;
constexpr int NA_V_OFF = 576 * 128;
DEV void na_pair(const Params& p, int u) {
  const int tid = otid(), lane = tid & 63, wid = tid >> 6, fr = lane & 15, fq = lane >> 4;
  const int rp = u & 15, h = (u >> 4) & 7, b = u >> 7;
  const int rbase = min(max(2 * rp - 4, 0), 24);
  const int nrows = (rbase == 24) ? 8 : 9;
  const u16* qk = reinterpret_cast<const u16*>(p.ws + REG_B);
  const u16* vht = reinterpret_cast<const u16*>(p.ws + REG_B + 33554432ull);
  u16* cat = reinterpret_cast<u16*>(p.ws + REG_A + 100663296ull);
  char* kl = smem;
  u16* vl = reinterpret_cast<u16*>(smem + NA_V_OFF);
  const long tok0 = (long)b * SEQ + rbase * 64;
  __syncthreads();
#pragma unroll
  for (int i = 0; i < 9; ++i) {
    const int q = tid + 512 * i, key = q >> 3, ch = q & 7;
    if (key < nrows * 64) {
      uint4 v = *reinterpret_cast<const uint4*>(qk + (tok0 + key) * 1024 + 512 + h * 64 + ch * 8);
      *reinterpret_cast<uint4*>(kl + key * 128 + ((ch ^ ((key >> 1) & 7)) << 4)) = v;
    }
  }
#pragma unroll
  for (int i = 0; i < 9; ++i) {
    const int q = tid + 512 * i, d = q / 72, ch = q % 72;
    if (ch < nrows * 8) {
      uint4 v = *reinterpret_cast<const uint4*>(vht + (long)(h * 64 + d) * TOK + tok0 + ch * 8);
      u16* dst = vl + d * NA_VST + ch * 8;
      *reinterpret_cast<uint2*>(dst) = make_uint2(v.x, v.y);
      *reinterpret_cast<uint2*>(dst + 4) = make_uint2(v.z, v.w);
    }
  }
  __syncthreads();
  const int g = wid & 3, r = 2 * rp + (wid >> 2);
  const int r0 = min(max(r - 4, 0), 24), ro = r0 - rbase, cs = min(max(16 * g - 8, 0), 32);
  const int c = 16 * g + fr;
  const long tokq = (long)b * SEQ + r * 64 + c;
  bf16x8 qf[2];
#pragma unroll
  for (int ks = 0; ks < 2; ++ks) qf[ks] = *reinterpret_cast<const bf16x8*>(qk + tokq * 1024 + h * 64 + ks * 32 + fq * 8);
  f32x4 s[16];
#pragma unroll
  for (int kt = 0; kt < 16; ++kt) {
    const int w = kt >> 1, half = kt & 1;
    const int key = (ro + w) * 64 + cs + 16 * half + fr;
    const int sw = (key >> 1) & 7;
    bf16x8 k0 = *reinterpret_cast<const bf16x8*>(kl + key * 128 + ((fq ^ sw) << 4));
    bf16x8 k1 = *reinterpret_cast<const bf16x8*>(kl + key * 128 + (((4 + fq) ^ sw) << 4));
    f32x4 a = {0.f, 0.f, 0.f, 0.f};
    a = __builtin_amdgcn_mfma_f32_16x16x32_bf16(k0, qf[0], a, 0, 0, 0);
    a = __builtin_amdgcn_mfma_f32_16x16x32_bf16(k1, qf[1], a, 0, 0, 0);
    s[kt] = a;
  }
  const int c0 = min(max(c - 8, 0), 48);
  const float* rpb = p.na_rpb + h * 15 * 31;
  float mx = -1e30f;
#pragma unroll
  for (int kt = 0; kt < 16; ++kt) {
    const int w = kt >> 1, half = kt & 1;
    const int dr = r0 + w - r + 7;
#pragma unroll
    for (int j = 0; j < 4; ++j) {
      int kc = cs + 16 * half + 4 * fq + j;
      bool valid = (kc >= c0) && (kc < c0 + 16);
      int dc = min(max(kc - c, -15), 15) + 15;
      float bias = rpb[dr * 31 + dc];
      float v = valid ? (s[kt][j] + bias) : -1e30f;
      s[kt][j] = v;
      mx = fmaxf(mx, v);
    }
  }
  mx = fmaxf(mx, __shfl_xor(mx, 16));
  mx = fmaxf(mx, __shfl_xor(mx, 32));
  float sum = 0.f;
#pragma unroll
  for (int kt = 0; kt < 16; ++kt)
#pragma unroll
    for (int j = 0; j < 4; ++j) { float e = __expf(s[kt][j] - mx); s[kt][j] = e; sum += e; }
  sum += __shfl_xor(sum, 16);
  sum += __shfl_xor(sum, 32);
  f32x4 o[4];
#pragma unroll
  for (int dt = 0; dt < 4; ++dt) o[dt] = f32x4{0.f, 0.f, 0.f, 0.f};
#pragma unroll
  for (int w = 0; w < 8; ++w) {
    union { bf16x8 v; unsigned u[4]; } pf;
    pf.u[0] = cvt_pk_bf16(s[2 * w][0], s[2 * w][1]); pf.u[1] = cvt_pk_bf16(s[2 * w][2], s[2 * w][3]);
    pf.u[2] = cvt_pk_bf16(s[2 * w + 1][0], s[2 * w + 1][1]); pf.u[3] = cvt_pk_bf16(s[2 * w + 1][2], s[2 * w + 1][3]);
#pragma unroll
    for (int dt = 0; dt < 4; ++dt) {
      const u16* vp = vl + (dt * 16 + fr) * NA_VST + (ro + w) * 64 + cs + 4 * fq;
      union { bf16x8 v; uint2 u[2]; } af;
      af.u[0] = *reinterpret_cast<const uint2*>(vp);
      af.u[1] = *reinterpret_cast<const uint2*>(vp + 16);
      o[dt] = __builtin_amdgcn_mfma_f32_16x16x32_bf16(af.v, pf.v, o[dt], 0, 0, 0);
    }
  }
  const float inv = 1.0f / sum;
#pragma unroll
  for (int dt = 0; dt < 4; ++dt) {
    uint2 pk; pk.x = pack2(o[dt][0] * inv, o[dt][1] * inv); pk.y = pack2(o[dt][2] * inv, o[dt][3] * inv);
    *reinterpret_cast<uint2*>(cat + tokq * 1024 + h * 64 + dt * 16 + 4 * fq) = pk;
  }
}

constexpr int UB_STRIDE = 2056;
constexpr int RC_STRIDE = 4120;
constexpr int HY_RC_OFF = 2 * NBATCH * UB_STRIDE * 2;
DEV float shortconv(const u16* hrow, const float* cw, float cb, int ch, int t) {
  float xm = (t > 0) ? bf2f(hrow[t - 1]) : 0.f;
  float x0 = bf2f(hrow[t]);
  float xp = (t < SEQ - 1) ? bf2f(hrow[t + 1]) : 0.f;
  return cb + xm * cw[ch] + x0 * cw[1536 + ch] + xp * cw[2 * 1536 + ch];
}
DEV void load_rc(const Params& p, int o, int c) {
  const int tid = otid();
  char* rc = smem + HY_RC_OFF;
  const u16* Rg = reinterpret_cast<const u16*>(p.ws + S_RG) + ((long)o * 512 + c) * 4096;
  const float skip = p.hy_skip[o * 512 + c];
  const int i0 = tid * 8;
  uint4 lo = *reinterpret_cast<const uint4*>(Rg + i0);
  uint4 hi = (tid < 511) ? *reinterpret_cast<const uint4*>(Rg + i0 + 8) : make_uint4(0u, 0u, 0u, 0u);
  unsigned w[8] = {lo.x, lo.y, lo.z, lo.w, hi.x, hi.y, hi.z, hi.w};
  if (tid == 256) w[0] = (w[0] & 0xffff0000u) | (unsigned)f2bf(bf2f((u16)(w[0] & 0xffffu)) + skip);
  if (tid == 255) w[4] = (w[4] & 0xffff0000u) | (unsigned)f2bf(bf2f((u16)(w[4] & 0xffffu)) + skip);
#pragma unroll
  for (int m = 0; m < 8; ++m) {
    uint4 o4;
    if (m & 1) {
      o4.x = __builtin_amdgcn_alignbyte(w[m / 2 + 1], w[m / 2], 2);
      o4.y = __builtin_amdgcn_alignbyte(w[m / 2 + 2], w[m / 2 + 1], 2);
      o4.z = __builtin_amdgcn_alignbyte(w[m / 2 + 3], w[m / 2 + 2], 2);
      o4.w = __builtin_amdgcn_alignbyte(w[m / 2 + 4], w[m / 2 + 3], 2);
    } else {
      o4.x = w[m / 2]; o4.y = w[m / 2 + 1]; o4.z = w[m / 2 + 2]; o4.w = w[m / 2 + 3];
    }
    *reinterpret_cast<uint4*>(rc + m * (RC_STRIDE * 2) + i0 * 2) = o4;
  }
}
DEV void hyena_conv(const u16* ub, f32x4 (&acc)[16]) {
  const int lane = otid() & 63, wid = __builtin_amdgcn_readfirstlane(otid() >> 6), fr = lane & 15, fq = lane >> 4;
  const int mcopy = (-wid) & 7;
  const u16* rbase = reinterpret_cast<const u16*>(smem + HY_RC_OFF) + mcopy * RC_STRIDE + (8 * fq - 8 * fr + 2048 - (wid + mcopy));
#pragma unroll
  for (int i = 0; i < 16; ++i) acc[i] = f32x4{0.f, 0.f, 0.f, 0.f};
  const u16* urow = ub + (fr & 7) * UB_STRIDE + fq * 8;
#pragma unroll 1
  for (int r = 0; r < 4; ++r) {
    bf16x8 Bf[16];
#pragma unroll
    for (int i = 0; i < 16; ++i) Bf[i] = *reinterpret_cast<const bf16x8*>(urow + (r + 4 * i) * 32);
    const u16* rk = rbase + 32 * r;
#pragma unroll
    for (int e = -15; e <= 15; ++e) {
      const bf16x8 af = *reinterpret_cast<const bf16x8*>(rk + 128 * e);
#pragma unroll
      for (int T = 0; T < 16; ++T) {
        const int i = e + T;
        if (i >= 0 && i < 16) acc[T] = __builtin_amdgcn_mfma_f32_16x16x32_bf16(af, Bf[i], acc[T], 0, 0, 0);
      }
    }
  }
}
DEV void shortconv_pass(const u16* __restrict__ hrow  , u16* ub, const float* cw, float cb, int ch) {
  const float w0 = cw[ch], w1 = cw[1536 + ch], w2 = cw[2 * 1536 + ch];
#pragma unroll
  for (int q4 = 0; q4 < TOK / 8 / 512; ++q4) {
    const int q = otid() + 512 * q4;
    const int i = q * 8, b = i >> 11, t = i & 2047;
    uint4 v = *reinterpret_cast<const uint4*>(hrow + i);
    float x[10];
    x[0] = (t > 0) ? bf2f(hrow[i - 1]) : 0.f;
    x[9] = (t + 8 < SEQ) ? bf2f(hrow[i + 8]) : 0.f;
    x[1] = __uint_as_float(v.x << 16); x[2] = __uint_as_float(v.x & 0xffff0000u);
    x[3] = __uint_as_float(v.y << 16); x[4] = __uint_as_float(v.y & 0xffff0000u);
    x[5] = __uint_as_float(v.z << 16); x[6] = __uint_as_float(v.z & 0xffff0000u);
    x[7] = __uint_as_float(v.w << 16); x[8] = __uint_as_float(v.w & 0xffff0000u);
    float y[8];
#pragma unroll
    for (int j = 0; j < 8; ++j) y[j] = cb + x[j] * w0 + x[j + 1] * w1 + x[j + 2] * w2;
    uint4 o4; o4.x = pack2(y[0], y[1]); o4.y = pack2(y[2], y[3]); o4.z = pack2(y[4], y[5]); o4.w = pack2(y[6], y[7]);
    *reinterpret_cast<uint4*>(ub + b * UB_STRIDE + t) = o4;
  }
}
DEV void hyena_unit(const Params& p, int c) {
  const int tid = otid(), lane = tid & 63, wid = tid >> 6, fr = lane & 15, fq = lane >> 4;
  u16* ubA = reinterpret_cast<u16*>(smem);
  u16* ubB = ubA + NBATCH * UB_STRIDE;
  const u16* hbt = reinterpret_cast<const u16*>(p.ws + REG_B + 33554432ull) + 512L * TOK;
  u16* zT = reinterpret_cast<u16*>(p.ws + REG_C);
  const float* cw = p.hy_conv_w;
  shortconv_pass(hbt + (long)c * TOK, ubA, cw, p.hy_conv_b[c], c);
  shortconv_pass(hbt + (long)(512 + c) * TOK, ubB, cw, p.hy_conv_b[512 + c], 512 + c);
  load_rc(p, 0, c);
  __syncthreads();
  f32x4 acc[16];
  hyena_conv(ubA, acc);
  if (fr < 8) {
#pragma unroll
    for (int T = 0; T < 16; ++T)
#pragma unroll
      for (int j = 0; j < 4; ++j) {
        const int t = 128 * T + wid + 8 * (4 * fq + j);
        u16* q = ubB + fr * UB_STRIDE + t;
        *q = f2bf(bf2f(*q) * acc[T][j]);
      }
  }
  __syncthreads();
  shortconv_pass(hbt + (long)(1024 + c) * TOK, ubA, cw, p.hy_conv_b[1024 + c], 1024 + c);
  load_rc(p, 1, c);
  __syncthreads();
  hyena_conv(ubB, acc);
  if (fr < 8) {
#pragma unroll
    for (int T = 0; T < 16; ++T)
#pragma unroll
      for (int j = 0; j < 4; ++j) {
        const int t = 128 * T + wid + 8 * (4 * fq + j);
        u16* q = ubA + fr * UB_STRIDE + t;
        *q = f2bf(bf2f(*q) * acc[T][j]);
      }
  }
  __syncthreads();
#pragma unroll
  for (int q4 = 0; q4 < TOK / 8 / 512; ++q4) {
    const int q = tid + 512 * q4;
    const int i = q * 8, b = i >> 11, t = i & 2047;
    *reinterpret_cast<uint4*>(zT + (long)c * TOK + i) = *reinterpret_cast<const uint4*>(ubA + b * UB_STRIDE + t);
  }
  __syncthreads();
}
DEV void phase_ztrans(const Params& p) {
  const int tid = otid();
  const u16* zT = reinterpret_cast<const u16*>(p.ws + REG_C);
  u16* cat = reinterpret_cast<u16*>(p.ws + REG_A + 100663296ull);
  u16* tile = reinterpret_cast<u16*>(smem);
  for (int tb = blockIdx.x; tb < TOK / 64; tb += gridDim.x) {
    __syncthreads();
    const u16* src = zT + (long)tid * TOK + tb * 64;
#pragma unroll
    for (int k = 0; k < 8; ++k) *reinterpret_cast<uint4*>(tile + tid * 72 + k * 8) = *reinterpret_cast<const uint4*>(src + k * 8);
    __syncthreads();
#pragma unroll
    for (int k = 0; k < 8; ++k) {
      const int q = tid + 512 * k;
      const int tk = q >> 6, ch8 = (q & 63) * 8;
      unsigned w[4];
#pragma unroll
      for (int j = 0; j < 4; ++j) w[j] = (unsigned)tile[(ch8 + 2 * j) * 72 + tk] | ((unsigned)tile[(ch8 + 2 * j + 1) * 72 + tk] << 16);
      *reinterpret_cast<uint4*>(cat + (long)(tb * 64 + tk) * 1024 + 512 + ch8) = make_uint4(w[0], w[1], w[2], w[3]);
    }
  }
}
DEV void phase_mix0(const Params& p) {
  const int nb = gridDim.x;
  for (int c = blockIdx.x; c < 512; c += nb) hyena_unit(p, c);
  for (int u = vstart(); u < 1024; u += nb) na_pair(p, u);
}

DEV void phase_outproj(const Params& p, const u16* A, const u16* wt) {
  u16* pre1 = reinterpret_cast<u16*>(p.ws + REG_C);
  const u16* xres = reinterpret_cast<const u16*>(p.ws + REG_X);
  gemm_phase<true, true, false>(1024, 64, 4, [&](const Unit& u, const char*& a, const char*& b) { a = (const char*)(A) + (size_t)u.pm * 256 * (1024) * 2; b = (const char*)(wt) + (size_t)u.pn * 256 * (1024) * 2; },
      [&](Acc8& acc, const Unit& u, int wr, int wc, int fr, int fq) {
        const long o0 = (long)(u.pm * 256 + wr * 64 + fr) * 1024 + u.pn * 256 + wc * 32 + 8 * fq;
        E8_FOR {
          const long o = o0 + (ai * 128 + m * 16) * 1024 + bj * 128;
          const uint4 xr = *reinterpret_cast<const uint4*>(xres + o);
          const float4 x0 = bf4_to_f4(make_uint2(xr.x, xr.y)), x1 = bf4_to_f4(make_uint2(xr.z, xr.w));
          f32x4 v0 = acc[ai][bj][m][0], v1 = acc[ai][bj][m][1];
          uint4 pk;
          pk.x = cvt_pk_bf16(DN_ALPHA * x0.x + v0[0], DN_ALPHA * x0.y + v0[1]); pk.y = cvt_pk_bf16(DN_ALPHA * x0.z + v0[2], DN_ALPHA * x0.w + v0[3]);
          pk.z = cvt_pk_bf16(DN_ALPHA * x1.x + v1[0], DN_ALPHA * x1.y + v1[1]); pk.w = cvt_pk_bf16(DN_ALPHA * x1.z + v1[2], DN_ALPHA * x1.w + v1[3]);
          *reinterpret_cast<uint4*>(pre1 + o) = pk;
        }
      });
}

DEV void phase_ln1_router(const Params& p, int layer) {
  const int tid = otid(), lane = tid & 63, wid = tid >> 6, nb = gridDim.x;
  float* wrT = reinterpret_cast<float*>(smem);
  const float* wr = p.moe_router + (long)layer * 1024 * 16;
  {
    float4 w4[8];
#pragma unroll
    for (int k = 0; k < 8; ++k) w4[k] = reinterpret_cast<const float4*>(wr)[tid + 512 * k];
#pragma unroll
    for (int k = 0; k < 8; ++k) {
      const int i = (tid + 512 * k) * 4, c = i >> 4, e = i & 15;
      wrT[e * 1024 + c] = w4[k].x; wrT[(e + 1) * 1024 + c] = w4[k].y; wrT[(e + 2) * 1024 + c] = w4[k].z; wrT[(e + 3) * 1024 + c] = w4[k].w;
    }
  }
  __syncthreads();
  const u16* pre1 = reinterpret_cast<const u16*>(p.ws + REG_C);
  u16* x1 = reinterpret_cast<u16*>(p.ws + REG_D);
  unsigned char* x1q = reinterpret_cast<unsigned char*>(p.ws + REG_E);
  float* aff = reinterpret_cast<float*>(p.ws + S_AFF);
  const float* g = p.ln1_g + layer * 1024; const float* bb = p.ln1_b + layer * 1024;
  uint2 nx[4];
  {
    const int t0 = blockIdx.x * 8 + wid;
#pragma unroll
    for (int i = 0; i < 4; ++i) nx[i] = (t0 < TOK) ? *reinterpret_cast<const uint2*>(pre1 + (long)t0 * 1024 + i * 256 + lane * 4) : make_uint2(0u, 0u);
  }
  float4 gg4[4], bb4[4];
#pragma unroll
  for (int i = 0; i < 4; ++i) { gg4[i] = *reinterpret_cast<const float4*>(g + i * 256 + lane * 4); bb4[i] = *reinterpret_cast<const float4*>(bb + i * 256 + lane * 4); }
  for (int tok = blockIdx.x * 8 + wid; tok < TOK; tok += nb * 8) {
    float4 v[4];
    float s = 0.f;
#pragma unroll
    for (int i = 0; i < 4; ++i) { v[i] = bf4_to_f4(nx[i]); s += v[i].x + v[i].y + v[i].z + v[i].w; }
    {
      const int tn = tok + nb * 8;
      if (tn < TOK) {
#pragma unroll
        for (int i = 0; i < 4; ++i) nx[i] = *reinterpret_cast<const uint2*>(pre1 + (long)tn * 1024 + i * 256 + lane * 4);
      }
    }
    float mu = wave_sum(s) * (1.0f / 1024.0f);
    float q = 0.f;
#pragma unroll
    for (int i = 0; i < 4; ++i) { v[i].x -= mu; v[i].y -= mu; v[i].z -= mu; v[i].w -= mu; q += v[i].x * v[i].x + v[i].y * v[i].y + v[i].z * v[i].z + v[i].w * v[i].w; }
    float rstd = rsqrtf(wave_sum(q) * (1.0f / 1024.0f) + LN_EPS);
    float4 y[4];
#pragma unroll
    for (int i = 0; i < 4; ++i) {
      int c = i * 256 + lane * 4;
      const float4 gg = gg4[i], b4 = bb4[i];
      y[i].x = v[i].x * rstd * gg.x + b4.x; y[i].y = v[i].y * rstd * gg.y + b4.y; y[i].z = v[i].z * rstd * gg.z + b4.z; y[i].w = v[i].w * rstd * gg.w + b4.w;
      { uint2 pk; pk.x = pack2(y[i].x, y[i].y); pk.y = pack2(y[i].z, y[i].w); *reinterpret_cast<uint2*>(x1 + (long)tok * 1024 + c) = pk; }
      *reinterpret_cast<unsigned*>(x1q + (long)tok * 1024 + c) = pack4_f8(y[i].x, y[i].y, y[i].z, y[i].w);
    }
    float lg[16];
#pragma unroll
    for (int e = 0; e < 16; ++e) {
      float a = 0.f;
#pragma unroll
      for (int i = 0; i < 4; ++i) {
        float4 w4 = *reinterpret_cast<const float4*>(wrT + e * 1024 + i * 256 + lane * 4);
        a += y[i].x * w4.x + y[i].y * w4.y + y[i].z * w4.z + y[i].w * w4.w;
      }
      lg[e] = a;
      if ((e & 3) == 3) asm volatile("" ::: "memory");
    }
#define BFLY_STEP(S, CTRL, KB) { const bool up = (KB) != 0; _Pragma("unroll") for (int i = 0; i < (8 >> S); ++i) { \
      const float lo = lg[2 * i], hi = lg[2 * i + 1]; const float snd = up ? lo : hi; lg[i] = (up ? hi : lo) + dpp_f<CTRL>(snd); } }
    BFLY_STEP(0, 0xB1, (lane ^ (lane >> 2)) & 1)
    BFLY_STEP(1, 0x4E, ((lane >> 1) ^ (lane >> 2)) & 1)
    BFLY_STEP(2, 0x141, ((lane >> 2) ^ (lane >> 3)) & 1)
    BFLY_STEP(3, 0x140, (lane >> 3) & 1)
#undef BFLY_STEP
    float mine = lg[0];
    mine += __shfl_xor(mine, 16);
    mine += __shfl_xor(mine, 32);
    const float mx = row_allmax(mine);
    const float ex = expf(mine - mx);
    const float den = row_allsum(ex);
    if (lane < 16) {
      const int eown = ((lane ^ (lane >> 2)) & 1) | ((((lane >> 1) ^ (lane >> 2)) & 1) << 1) | ((((lane >> 2) ^ (lane >> 3)) & 1) << 2) | (((lane >> 3) & 1) << 3);
      int b = tok >> 11, l = tok & 2047;
      aff[((long)b * 16 + eown) * SEQ + l] = ex / den;
    }
  }
}

DEV void phase_topk(const Params& p) {
  const int tid = otid(), nb = gridDim.x, lane = tid & 63, wid = tid >> 6;
  unsigned* key = reinterpret_cast<unsigned*>(smem);
  int* rows = reinterpret_cast<int*>(smem + 8192);
  unsigned* hist = reinterpret_cast<unsigned*>(smem + 9216);
  unsigned* wsum = reinterpret_cast<unsigned*>(smem + 10240);
  unsigned* bc = reinterpret_cast<unsigned*>(smem + 10304);
  const float* aff = reinterpret_cast<const float*>(p.ws + S_AFF);
  float* gsel = reinterpret_cast<float*>(p.ws + S_GSEL);
  int* slot = reinterpret_cast<int*>(p.ws + S_SLOT);
  const unsigned char* x1q = reinterpret_cast<const unsigned char*>(p.ws + REG_E);
  unsigned char* Xe = reinterpret_cast<unsigned char*>(p.ws + REG_C);
  for (int be = blockIdx.x; be < NBATCH * NEXP; be += nb) {
    const int b = be >> 4, e = be & 15;
    __syncthreads();
    const float4 av = *reinterpret_cast<const float4*>(aff + (long)be * SEQ + tid * 4);
    const unsigned k0 = __float_as_uint(av.x), k1 = __float_as_uint(av.y), k2 = __float_as_uint(av.z), k3 = __float_as_uint(av.w);
    unsigned prefix = 0u, need = CAP;
#pragma unroll 1
    for (int shift = 24; shift >= 0; shift -= 8) {
      if (tid < 256) hist[tid] = 0u;
      __syncthreads();
      const unsigned hs = (shift == 24) ? 0u : (unsigned)(shift + 8);
      if (shift == 24 || (k0 >> hs) == prefix) atomicAdd(&hist[(k0 >> shift) & 255u], 1u);
      if (shift == 24 || (k1 >> hs) == prefix) atomicAdd(&hist[(k1 >> shift) & 255u], 1u);
      if (shift == 24 || (k2 >> hs) == prefix) atomicAdd(&hist[(k2 >> shift) & 255u], 1u);
      if (shift == 24 || (k3 >> hs) == prefix) atomicAdd(&hist[(k3 >> shift) & 255u], 1u);
      __syncthreads();
      if (wid == 0) {
        unsigned h0 = hist[4 * lane], h1 = hist[4 * lane + 1], h2 = hist[4 * lane + 2], h3 = hist[4 * lane + 3];
        unsigned tot = h0 + h1 + h2 + h3;
        unsigned suf = tot;
#pragma unroll
        for (int o = 1; o < 64; o <<= 1) { unsigned t = __shfl_down(suf, o); if (lane + o < 64) suf += t; }
        const unsigned above = suf - tot;
        int d = -1; unsigned nabove = 0u;
        unsigned c3 = above + h3, c2 = c3 + h2, c1 = c2 + h1, c0 = c1 + h0;
        if (above < need && c0 >= need) {
          if (c3 >= need) { d = 4 * lane + 3; nabove = above; }
          else if (c2 >= need) { d = 4 * lane + 2; nabove = c3; }
          else if (c1 >= need) { d = 4 * lane + 1; nabove = c2; }
          else { d = 4 * lane; nabove = c1; }
          bc[0] = (prefix << 8) | (unsigned)d;
          bc[1] = need - nabove;
        }
      }
      __syncthreads();
      prefix = bc[0]; need = bc[1];
    }
    const unsigned tau = prefix;
    const unsigned e0 = (k0 == tau), e1 = (k1 == tau), e2 = (k2 == tau), e3 = (k3 == tau);
    unsigned eqs = e0 + e1 + e2 + e3;
    unsigned inc = eqs;
#pragma unroll
    for (int o = 1; o < 64; o <<= 1) { unsigned t = __shfl_up(inc, o); if (lane >= o) inc += t; }
    if (lane == 63) wsum[wid] = inc;
    __syncthreads();
    unsigned base = 0u;
#pragma unroll
    for (int w = 0; w < 8; ++w) if (w < wid) base += wsum[w];
    unsigned eqb = base + inc - eqs;
    const unsigned s0 = (k0 > tau) || (e0 && eqb < need); eqb += e0;
    const unsigned s1 = (k1 > tau) || (e1 && eqb < need); eqb += e1;
    const unsigned s2 = (k2 > tau) || (e2 && eqb < need); eqb += e2;
    const unsigned s3 = (k3 > tau) || (e3 && eqb < need);
    const unsigned sels = s0 + s1 + s2 + s3;
    unsigned inc2 = sels;
#pragma unroll
    for (int o = 1; o < 64; o <<= 1) { unsigned t = __shfl_up(inc2, o); if (lane >= o) inc2 += t; }
    if (lane == 63) wsum[8 + wid] = inc2;
    __syncthreads();
    unsigned base2 = 0u;
#pragma unroll
    for (int w = 0; w < 8; ++w) if (w < wid) base2 += wsum[8 + w];
    unsigned sl = base2 + inc2 - sels;
    const int tok0 = tid * 4;
    int sv[4];
    sv[0] = s0 ? (int)sl : -1; sl += s0;
    sv[1] = s1 ? (int)sl : -1; sl += s1;
    sv[2] = s2 ? (int)sl : -1; sl += s2;
    sv[3] = s3 ? (int)sl : -1;
    const float avv[4] = {av.x, av.y, av.z, av.w};
#pragma unroll
    for (int j = 0; j < 4; ++j) {
      slot[((long)b * SEQ + tok0 + j) * 16 + e] = sv[j];
      if (sv[j] >= 0) { rows[sv[j]] = tok0 + j; gsel[be * CAP + sv[j]] = avv[j]; }
    }
    __syncthreads();
#pragma unroll 4
    for (int s = wid; s < CAP; s += 8) {
      const int t = rows[s];
      const uint4* src = reinterpret_cast<const uint4*>(x1q + ((long)b * SEQ + t) * 1024);
      uint4* dst = reinterpret_cast<uint4*>(Xe + ((long)(e * 8 + b) * CAP + s) * 1024);
      dst[lane] = src[lane];
    }
  }
}

DEV void phase_moe1(const Params& p, int layer) {
  const unsigned char* Xe = reinterpret_cast<const unsigned char*>(p.ws + REG_C);
  const unsigned char* wgu = reinterpret_cast<const unsigned char*>(p.ws + W_GU) + (long)layer * 16 * 4096 * 1024;
  unsigned char* H = reinterpret_cast<unsigned char*>(p.ws + REG_A);
  gemm_phase<true, true, true>(1024, 128, 16,
      [&](const Unit& u, const char*& a, const char*& b) { a = (const char*)Xe + (size_t)u.pm * 256 * 1024; b = (const char*)wgu + ((size_t)(u.pm >> 3) * 4096 + (size_t)u.pn * 256) * 1024; },
      [&](Acc8& acc, const Unit& u, int wr, int wc, int fr, int fq) {
        unsigned char* base = H + (long)(u.pm * 256 + wr * 64 + fr) * DFF + u.pn * 128 + wc * 32 + 8 * fq;
#pragma unroll
        for (int ai = 0; ai < 2; ++ai)
#pragma unroll
          for (int m = 0; m < 4; ++m) {
            float hv[8];
#pragma unroll
            for (int n = 0; n < 2; ++n)
#pragma unroll
              for (int j = 0; j < 4; ++j) {
                float gte = acc[ai][0][m][n][j] * 0.03125f, up = acc[ai][1][m][n][j] * 0.03125f;
                hv[n * 4 + j] = gte * fsigmoid(gte) * up;
              }
            uint2 pk; pk.x = pack4_f8(hv[0], hv[1], hv[2], hv[3]); pk.y = pack4_f8(hv[4], hv[5], hv[6], hv[7]);
            *reinterpret_cast<uint2*>(base + (ai * 128 + m * 16) * DFF) = pk;
          }
      });
}
DEV void phase_moe2(const Params& p, int layer) {
  const unsigned char* H = reinterpret_cast<const unsigned char*>(p.ws + REG_A);
  const unsigned char* wd = reinterpret_cast<const unsigned char*>(p.ws + W_DN) + (long)layer * 16 * 1024 * 2048;
  const float* gsel = reinterpret_cast<const float*>(p.ws + S_GSEL);
  u16* Ye = reinterpret_cast<u16*>(p.ws + REG_B);
  gemm_phase<true, true, true>(2048, 128, 4,
      [&](const Unit& u, const char*& a, const char*& b) { a = (const char*)H + (size_t)u.pm * 256 * 2048; b = (const char*)wd + ((size_t)(u.pm >> 3) * 1024 + (size_t)u.pn * 256) * 2048; },
      [&](Acc8& acc, const Unit& u, int wr, int wc, int fr, int fq) {
        const int e = u.pm >> 3, b = u.pm & 7;
        const float* gs = gsel + (b * 16 + e) * CAP + wr * 64 + fr;
        u16* base = Ye + (long)(u.pm * 256 + wr * 64 + fr) * 1024 + u.pn * 256 + wc * 32 + 8 * fq;
#pragma unroll
        for (int ai = 0; ai < 2; ++ai)
#pragma unroll
          for (int m = 0; m < 4; ++m) {
            const float g = gs[ai * 128 + m * 16] * 0.015625f;
#pragma unroll
            for (int bj = 0; bj < 2; ++bj) {
              f32x4 v0 = acc[ai][bj][m][0] * g, v1 = acc[ai][bj][m][1] * g;
              uint4 pk;
              pk.x = cvt_pk_bf16(v0[0], v0[1]); pk.y = cvt_pk_bf16(v0[2], v0[3]); pk.z = cvt_pk_bf16(v1[0], v1[1]); pk.w = cvt_pk_bf16(v1[2], v1[3]);
              *reinterpret_cast<uint4*>(base + (ai * 128 + m * 16) * 1024 + bj * 128) = pk;
            }
          }
      });
}
DEV void phase_ln2(const Params& p, int layer) {
  const int tid = otid(), lane = tid & 63, wid = tid >> 6, nb = gridDim.x;
  const u16* x1 = reinterpret_cast<const u16*>(p.ws + REG_D);
  const u16* Ye = reinterpret_cast<const u16*>(p.ws + REG_B);
  const int* slot = reinterpret_cast<const int*>(p.ws + S_SLOT);
  u16* x2b = reinterpret_cast<u16*>(p.ws + REG_A + 67108864ull);
  const float* g = p.ln2_g + layer * 1024; const float* bb = p.ln2_b + layer * 1024;
  uint2 nx[4]; int nslot = -1;
  {
    const int t0 = blockIdx.x * 8 + wid;
    if (t0 < TOK) {
#pragma unroll
      for (int i = 0; i < 4; ++i) nx[i] = *reinterpret_cast<const uint2*>(x1 + (long)t0 * 1024 + i * 256 + lane * 4);
      nslot = (lane < 16) ? slot[(long)t0 * 16 + lane] : -1;
    }
  }
  for (int tok = blockIdx.x * 8 + wid; tok < TOK; tok += nb * 8) {
    const int b = tok >> 11;
    float4 v[4];
#pragma unroll
    for (int i = 0; i < 4; ++i) {
      float4 t = bf4_to_f4(nx[i]);
      v[i].x = DN_ALPHA * t.x; v[i].y = DN_ALPHA * t.y; v[i].z = DN_ALPHA * t.z; v[i].w = DN_ALPHA * t.w;
    }
    int myslot = nslot;
    {
      const int tn = tok + nb * 8;
      if (tn < TOK) {
#pragma unroll
        for (int i = 0; i < 4; ++i) nx[i] = *reinterpret_cast<const uint2*>(x1 + (long)tn * 1024 + i * 256 + lane * 4);
        nslot = (lane < 16) ? slot[(long)tn * 16 + lane] : -1;
      }
    }
    unsigned mask = (unsigned)__ballot(myslot >= 0);
    while (mask) {
      const int e = __builtin_ctz(mask);
      mask &= mask - 1;
      const int sidx = __builtin_amdgcn_readlane(myslot, e);
      const u16* yr = Ye + ((long)(e * 8 + b) * CAP + sidx) * 1024;
      uint2 t[4];
#pragma unroll
      for (int i = 0; i < 4; ++i) t[i] = *reinterpret_cast<const uint2*>(yr + i * 256 + lane * 4);
#pragma unroll
      for (int i = 0; i < 4; ++i) {
        v[i].x += __uint_as_float(t[i].x << 16); v[i].y += __uint_as_float(t[i].x & 0xffff0000u);
        v[i].z += __uint_as_float(t[i].y << 16); v[i].w += __uint_as_float(t[i].y & 0xffff0000u);
      }
    }
    float s = 0.f;
#pragma unroll
    for (int i = 0; i < 4; ++i) s += v[i].x + v[i].y + v[i].z + v[i].w;
    float mu = wave_sum(s) * (1.0f / 1024.0f);
    float q = 0.f;
#pragma unroll
    for (int i = 0; i < 4; ++i) { v[i].x -= mu; v[i].y -= mu; v[i].z -= mu; v[i].w -= mu; q += v[i].x * v[i].x + v[i].y * v[i].y + v[i].z * v[i].z + v[i].w * v[i].w; }
    float rstd = rsqrtf(wave_sum(q) * (1.0f / 1024.0f) + LN_EPS);
#pragma unroll
    for (int i = 0; i < 4; ++i) {
      int c = i * 256 + lane * 4;
      float4 gg = *reinterpret_cast<const float4*>(g + c), b4 = *reinterpret_cast<const float4*>(bb + c);
      float4 y;
      y.x = v[i].x * rstd * gg.x + b4.x; y.y = v[i].y * rstd * gg.y + b4.y; y.z = v[i].z * rstd * gg.z + b4.z; y.w = v[i].w * rstd * gg.w + b4.w;
      uint2 pk; pk.x = pack2(y.x, y.y); pk.y = pack2(y.z, y.w);
      *reinterpret_cast<uint2*>(x2b + (long)tok * 1024 + c) = pk;
    }
  }
}
DEV void phase_ple(const Params& p, int layer, float* outf, u16* outb) {
  const u16* x2b = reinterpret_cast<const u16*>(p.ws + REG_A + 67108864ull);
  const u16* pb = reinterpret_cast<const u16*>(p.ws + REG_P) + (long)layer * TOK * 256;
  const u16* wg = reinterpret_cast<const u16*>(p.ws + W_PLEG) + (long)layer * 1024 * 1024;
  const u16* wp = reinterpret_cast<const u16*>(p.ws + W_PLEP) + (long)layer * 1024 * 256;
  u16* pp = reinterpret_cast<u16*>(p.ws + REG_C);
  gemm_phase<true, false, false>(256, 64, 4, [&](const Unit& u, const char*& a, const char*& b) { a = (const char*)(pb) + (size_t)u.pm * 256 * (256) * 2; b = (const char*)(wp) + (size_t)u.pn * 256 * (256) * 2; },
      [&](Acc8& acc, const Unit& u, int wr, int wc, int fr, int fq) {
        const long o0 = (long)(u.pm * 256 + wr * 64 + fr) * 1024 + u.pn * 256 + wc * 32 + 4 * fq;
        E8_FOR {
#pragma unroll
          for (int n = 0; n < 2; ++n)
          {
            f32x4 v = acc[ai][bj][m][n];
            uint2 pk; pk.x = cvt_pk_bf16(v[0], v[1]); pk.y = cvt_pk_bf16(v[2], v[3]);
            *reinterpret_cast<uint2*>(pp + o0 + (ai * 128 + m * 16) * 1024 + bj * 128 + n * 16) = pk;
          }
        }
      });
  gemm_phase<true, false, false>(1024, 64, 4, [&](const Unit& u, const char*& a, const char*& b) { a = (const char*)(x2b) + (size_t)u.pm * 256 * (1024) * 2; b = (const char*)(wg) + (size_t)u.pn * 256 * (1024) * 2; },
      [&](Acc8& acc, const Unit& u, int wr, int wc, int fr, int fq) {
        const long o0 = (long)(u.pm * 256 + wr * 64 + fr) * 1024 + u.pn * 256 + wc * 32 + 4 * fq;
        E8_FOR {
#pragma unroll
          for (int n = 0; n < 2; ++n) {
            const long o = o0 + (ai * 128 + m * 16) * 1024 + bj * 128 + n * 16;
            f32x4 a = acc[ai][bj][m][n];
            const float4 xq = bf4_to_f4(*reinterpret_cast<const uint2*>(x2b + o));
            f32x4 xv = {xq.x, xq.y, xq.z, xq.w};
            const uint2 pq = *reinterpret_cast<const uint2*>(pp + o);
            f32x4 pv = {__uint_as_float(pq.x << 16), __uint_as_float(pq.x & 0xffff0000u), __uint_as_float(pq.y << 16), __uint_as_float(pq.y & 0xffff0000u)};
            f32x4 r;
#pragma unroll
            for (int j = 0; j < 4; ++j) r[j] = xv[j] + pv[j] * fsigmoid(a[j]);
            if (outf) *reinterpret_cast<f32x4*>(outf + o) = r;
            if (outb) { uint2 pk; pk.x = cvt_pk_bf16(r[0], r[1]); pk.y = cvt_pk_bf16(r[2], r[3]); *reinterpret_cast<uint2*>(outb + o) = pk; }
          }
        }
      });
}
DEV void phase_mla_in(const Params& p) {
  const u16* xb = reinterpret_cast<const u16*>(p.ws + REG_X);
  const u16* wt = reinterpret_cast<const u16*>(p.ws + W_MLAIN);
  float* hm = reinterpret_cast<float*>(p.ws + REG_B);
  gemm_phase<true, false, false>(1024, 64, 3, [&](const Unit& u, const char*& a, const char*& b) { a = (const char*)(xb) + (size_t)u.pm * 256 * (1024) * 2; b = (const char*)(wt) + (size_t)u.pn * 256 * (1024) * 2; },
      [&](Acc8& acc, const Unit& u, int wr, int wc, int fr, int fq) {
        const long o0 = (long)(u.pm * 256 + wr * 64 + fr) * 768 + u.pn * 256 + wc * 32 + 4 * fq;
        E8_FOR {
#pragma unroll
          for (int n = 0; n < 2; ++n)
            *reinterpret_cast<f32x4*>(hm + o0 + (ai * 128 + m * 16) * 768 + bj * 128 + n * 16) = acc[ai][bj][m][n];
        }
      });
}
constexpr size_t MLA_Q = REG_A, MLA_K = REG_A + 50331648ull, MLA_VT = REG_A + 100663296ull;
constexpr size_t MLA_CQN = REG_B + 50331648ull, MLA_CKVN = MLA_CQN + 12582912ull, MLA_O = MLA_CKVN + 8388608ull;
DEV float rope_inv(int i) { return 1.0f / powf(10000.0f, (float)i / 16.0f); }
DEV void phase_mla_norm(const Params& p) {
  const int tid = otid(), lane = tid & 63, wid = tid >> 6, nb = gridDim.x;
  const float* hm = reinterpret_cast<const float*>(p.ws + REG_B);
  u16* cqn = reinterpret_cast<u16*>(p.ws + MLA_CQN);
  u16* ckvn = reinterpret_cast<u16*>(p.ws + MLA_CKVN);
  u16* Kb = reinterpret_cast<u16*>(p.ws + MLA_K);
  for (int tok = blockIdx.x * 8 + wid; tok < TOK; tok += nb * 8) {
    const float* row = hm + (long)tok * 768;
    float q[6], kv[4];
    float sq = 0.f, skv = 0.f;
#pragma unroll
    for (int i = 0; i < 6; ++i) { q[i] = row[i * 64 + lane]; sq += q[i] * q[i]; }
#pragma unroll
    for (int i = 0; i < 4; ++i) { kv[i] = row[384 + i * 64 + lane]; skv += kv[i] * kv[i]; }
    float rq = rsqrtf(wave_sum(sq) * (1.0f / 384.0f) + LN_EPS);
    float rkv = rsqrtf(wave_sum(skv) * (1.0f / 256.0f) + LN_EPS);
#pragma unroll
    for (int i = 0; i < 6; ++i) cqn[(long)tok * 384 + i * 64 + lane] = f2bf(q[i] * rq * p.mla_q_norm[i * 64 + lane]);
#pragma unroll
    for (int i = 0; i < 4; ++i) ckvn[(long)tok * 256 + i * 64 + lane] = f2bf(kv[i] * rkv * p.mla_kv_norm[i * 64 + lane]);
    const int b = tok >> 11, l = tok & 2047;
    float kr = (lane < 32) ? row[640 + lane] : 0.f;
    float x1 = __shfl(kr, lane & 15), x2 = __shfl(kr, (lane & 15) + 16);
    const float2 cssn = reinterpret_cast<const float2*>(p.ws + S_ROPE)[l * 16 + (lane & 15)];
    const float cs = cssn.x, sn = cssn.y;
    float r = (lane & 16) ? (x1 * sn + x2 * cs) : (x1 * cs - x2 * sn);
    u16 rb = f2bf(r);
    for (int hh = 0; hh < 16; hh += 2) {
      int h = hh + (lane >> 5);
      u16 val = (u16)__shfl((int)rb, lane & 31);
      Kb[(((long)b * 16 + h) * SEQ + l) * 96 + 64 + (lane & 31)] = val;
    }
  }
}
DEV void phase_mla_up(const Params& p) {
  const u16* cqn = reinterpret_cast<const u16*>(p.ws + MLA_CQN);
  const u16* ckvn = reinterpret_cast<const u16*>(p.ws + MLA_CKVN);
  const u16* wq = reinterpret_cast<const u16*>(p.ws + W_QUP);
  const u16* wkv = reinterpret_cast<const u16*>(p.ws + W_KVUP);
  u16* Qb = reinterpret_cast<u16*>(p.ws + MLA_Q);
  u16* Kb = reinterpret_cast<u16*>(p.ws + MLA_K);
  u16* VT = reinterpret_cast<u16*>(p.ws + MLA_VT);
  const float qscale = 0.10206207261596577f * 1.4426950408889634f;
  gemm_phase<true, false, false>(384, 64, 6, [&](const Unit& u, const char*& a, const char*& b) { a = (const char*)(cqn) + (size_t)u.pm * 256 * (384) * 2; b = (const char*)(wq) + (size_t)u.pn * 256 * (384) * 2; },
      [&](Acc8& acc, const Unit& u, int wr, int wc, int fr, int fq) {
#pragma unroll
        for (int bj = 0; bj < 2; ++bj) {
          const int c32 = (u.pn * 256 + bj * 128 + wc * 32) >> 5;
          const int h = c32 / 3, part = c32 % 3;
#pragma unroll
          for (int ai = 0; ai < 2; ++ai)
#pragma unroll
            for (int m = 0; m < 4; ++m) {
              const int tok = u.pm * 256 + ai * 128 + wr * 64 + m * 16 + fr;
              const int b = tok >> 11, l = tok & 2047;
              u16* qrow = Qb + (((long)b * 16 + h) * SEQ + l) * 96 + part * 32 + 4 * fq;
              f32x4 a0 = acc[ai][bj][m][0], a1 = acc[ai][bj][m][1];
              if (part == 2) {
#pragma unroll
                for (int j = 0; j < 4; ++j) {
                  const float2 cssn = reinterpret_cast<const float2*>(p.ws + S_ROPE)[l * 16 + 4 * fq + j];
                  const float cs = cssn.x, sn = cssn.y;
                  float r0 = a0[j] * cs - a1[j] * sn, r1 = a0[j] * sn + a1[j] * cs;
                  a0[j] = r0; a1[j] = r1;
                }
              }
              uint2 p0, p1;
              p0.x = cvt_pk_bf16(a0[0] * qscale, a0[1] * qscale); p0.y = cvt_pk_bf16(a0[2] * qscale, a0[3] * qscale);
              p1.x = cvt_pk_bf16(a1[0] * qscale, a1[1] * qscale); p1.y = cvt_pk_bf16(a1[2] * qscale, a1[3] * qscale);
              *reinterpret_cast<uint2*>(qrow) = p0;
              *reinterpret_cast<uint2*>(qrow + 16) = p1;
            }
        }
      });
  gemm_phase<true, true, false>(256, 64, 4, [&](const Unit& u, const char*& a, const char*& b) { a = (const char*)(ckvn) + (size_t)u.pm * 256 * (256) * 2; b = (const char*)(wkv) + (size_t)u.pn * 256 * (256) * 2; },
      [&](Acc8& acc, const Unit& u, int wr, int wc, int fr, int fq) {
        E8_FOR {
          const int tok = u.pm * 256 + ai * 128 + wr * 64 + m * 16 + fr;
          const int b = tok >> 11, l = tok & 2047;
          const int col = u.pn * 256 + bj * 128 + wc * 32 + 8 * fq;
          const int h = col >> 6, d = col & 63;
          f32x4 v0 = acc[ai][bj][m][0], v1 = acc[ai][bj][m][1];
          uint4 pk;
          pk.x = cvt_pk_bf16(v0[0], v0[1]); pk.y = cvt_pk_bf16(v0[2], v0[3]); pk.z = cvt_pk_bf16(v1[0], v1[1]); pk.w = cvt_pk_bf16(v1[2], v1[3]);
          *reinterpret_cast<uint4*>(Kb + (((long)b * 16 + h) * SEQ + l) * 96 + d) = pk;
        }
      });
  gemm_phase<false, false, false>(256, 64, 4, [&](const Unit& u, const char*& a, const char*& b) { a = (const char*)(ckvn) + (size_t)u.pm * 256 * (256) * 2; b = (const char*)(wkv + 1024 * 256) + (size_t)u.pn * 256 * (256) * 2; },
      [&](Acc8& acc, const Unit& u, int wr, int wc, int fr, int fq) {
        E8_FOR {
          const int tok = u.pm * 256 + ai * 128 + wr * 64 + m * 16 + 4 * fq;
          const int b = tok >> 11, l = tok & 2047;
#pragma unroll
          for (int n = 0; n < 2; ++n) {
            const int col = u.pn * 256 + bj * 128 + wc * 32 + n * 16 + fr;
            const int h = col >> 6, d = col & 63;
            f32x4 v = acc[ai][bj][m][n];
            uint2 pk; pk.x = cvt_pk_bf16(v[0], v[1]); pk.y = cvt_pk_bf16(v[2], v[3]);
            *reinterpret_cast<uint2*>(VT + (((long)b * 16 + h) * 64 + d) * SEQ + l) = pk;
          }
        }
      });
}
#ifndef ATT_THR
#define ATT_THR 8.0f
#endif
DEV int kswz(int key) { return (((key >> 3) & 3) << 2) | (key & 3); }
DEV void mla_attn_unit(const Params& p, int u) {
  const int tid = otid(), lane = tid & 63, wid = tid >> 6, fr = lane & 15, fq = lane >> 4;
  const int qb = u & 7, bh = u >> 3;
  const u16* Qb = reinterpret_cast<const u16*>(p.ws + MLA_Q) + (long)bh * SEQ * 96;
  const u16* Kb = reinterpret_cast<const u16*>(p.ws + MLA_K) + (long)bh * SEQ * 96;
  const u16* VT = reinterpret_cast<const u16*>(p.ws + MLA_VT) + (long)bh * 64 * SEQ;
  u16* O = reinterpret_cast<u16*>(p.ws + MLA_O);
  char* kl = smem;
  char* vl = smem + 32768;
  bf16x8 qf[2][3];
#pragma unroll
  for (int qt = 0; qt < 2; ++qt)
#pragma unroll
    for (int ks = 0; ks < 3; ++ks)
      qf[qt][ks] = *reinterpret_cast<const bf16x8*>(Qb + (long)(qb * 256 + wid * 32 + qt * 16 + fr) * 96 + ks * 32 + fq * 8);
  f32x4 o[4][2];
#pragma unroll
  for (int dt = 0; dt < 4; ++dt)
#pragma unroll
    for (int qt = 0; qt < 2; ++qt) o[dt][qt] = f32x4{0.f, 0.f, 0.f, 0.f};
  float mrun[2], lrun[2] = {0.f, 0.f}, rcur[2], rnxt[2] = {0.f, 0.f};
  const int kc0 = tid, kc1 = 512 + (tid & 255);
  const int vd = tid >> 3, vpart = tid & 7;
  const int kw0 = (kc0 / 12) * 256 + (((kc0 % 12) ^ kswz(kc0 / 12)) << 4);
  const int kw1 = (kc1 / 12) * 256 + (((kc1 % 12) ^ kswz(kc1 / 12)) << 4);
  const int vw = vd * 128 + ((vpart ^ ((vd >> 1) & 7)) << 4);
  struct Stg { uint4 k0, k1, v; };
  Stg sa, sb;
  sa.k1 = make_uint4(0, 0, 0, 0); sb.k1 = make_uint4(0, 0, 0, 0);
  auto gloadK = [&](Stg& r, int t) {
    const u16* kt = Kb + (long)t * 64 * 96;
    r.k0 = *reinterpret_cast<const uint4*>(kt + kc0 * 8);
    r.k1 = *reinterpret_cast<const uint4*>(kt + kc1 * 8);
  };
  auto gloadV = [&](Stg& r, int t) { r.v = *reinterpret_cast<const uint4*>(VT + (long)vd * SEQ + t * 64 + vpart * 8); };
  auto lstoreK = [&](const Stg& r, int buf) {
    *reinterpret_cast<uint4*>(kl + buf * 16384 + kw0) = r.k0;
    if (tid < 256) *reinterpret_cast<uint4*>(kl + buf * 16384 + kw1) = r.k1;
  };
  auto lstoreV = [&](const Stg& r, int buf) { *reinterpret_cast<uint4*>(vl + buf * 8192 + vw) = r.v; };
  const int krow = 8 * (fr >> 2) + (fr & 3);
  const int kf_ = kswz(krow);
  auto qk_tile = [&](const char* kd, f32x4 (&s)[4][2], const float (&ref)[2]) {
#pragma unroll
    for (int kt = 0; kt < 4; ++kt) {
      const int key = 32 * (kt >> 1) + 4 * (kt & 1) + krow;
      bf16x8 kf[3];
#pragma unroll
      for (int ks = 0; ks < 3; ++ks) kf[ks] = *reinterpret_cast<const bf16x8*>(kd + key * 256 + (((ks * 4 + fq) ^ kf_) << 4));
#pragma unroll
      for (int qt = 0; qt < 2; ++qt) {
        f32x4 a = {-ref[qt], -ref[qt], -ref[qt], -ref[qt]};
#pragma unroll
        for (int ks = 0; ks < 3; ++ks) a = __builtin_amdgcn_mfma_f32_16x16x32_bf16(kf[ks], qf[qt][ks], a, 0, 0, 0);
        s[kt][qt] = a;
      }
    }
  };
  __syncthreads();
  gloadK(sa, 0); gloadV(sa, 0); lstoreK(sa, 0); lstoreV(sa, 0);
  gloadK(sa, 1); lstoreK(sa, 1);
  gloadK(sa, 2); gloadV(sa, 1);
  __syncthreads();
  f32x4 sc[4][2], sn[4][2];
  {
    const float zero2[2] = {0.f, 0.f};
    qk_tile(kl, sc, zero2);
#pragma unroll
    for (int qt = 0; qt < 2; ++qt) {
      float tm = -1e30f;
#pragma unroll
      for (int kt = 0; kt < 4; ++kt)
#pragma unroll
        for (int j = 0; j < 4; ++j) tm = fmaxf(tm, sc[kt][qt][j]);
      tm = fmaxf(tm, __shfl_xor(tm, 16));
      tm = fmaxf(tm, __shfl_xor(tm, 32));
      mrun[qt] = tm; rcur[qt] = tm;
#pragma unroll
      for (int kt = 0; kt < 4; ++kt)
#pragma unroll
        for (int j = 0; j < 4; ++j) sc[kt][qt][j] -= tm;
    }
  }
  __syncthreads();
  if (__builtin_amdgcn_readfirstlane(wid) >= 4) __builtin_amdgcn_s_setprio(1);
#pragma unroll 1
  for (int t2 = 0; t2 < 32; t2 += 2) {
    { const int t = t2, cur = 0;

    gloadK(sb, min(t + 3, 31));
    gloadV(sb, min(t + 2, 31));
    if (t + 1 < 32) { rnxt[0] = mrun[0]; rnxt[1] = mrun[1]; qk_tile(kl + (cur ^ 1) * 16384, sn, rnxt); }
    bf16x8 pf[2][2];
#pragma unroll
    for (int qt = 0; qt < 2; ++qt) {
      float lm = sc[0][qt][0];
#pragma unroll
      for (int kt = 0; kt < 4; ++kt)
#pragma unroll
        for (int j = 0; j < 4; ++j) lm = fmaxf(lm, sc[kt][qt][j]);
      const bool slow = (lm > ATT_THR) || (rcur[qt] != mrun[qt]);
      if (__any(slow)) {
        const float dl = rcur[qt] - mrun[qt];
        float tm = lm + dl;
        tm = fmaxf(tm, __shfl_xor(tm, 16));
        tm = fmaxf(tm, __shfl_xor(tm, 32));
        const float inc = fmaxf(tm, 0.f);
        const float alpha = __builtin_amdgcn_exp2f(-inc);
        mrun[qt] += inc;
        lrun[qt] *= alpha;
#pragma unroll
        for (int dt = 0; dt < 4; ++dt) { o[dt][qt][0] *= alpha; o[dt][qt][1] *= alpha; o[dt][qt][2] *= alpha; o[dt][qt][3] *= alpha; }
        const float sh = dl - inc;
#pragma unroll
        for (int kt = 0; kt < 4; ++kt)
#pragma unroll
          for (int j = 0; j < 4; ++j) sc[kt][qt][j] += sh;
      }
      float ls = 0.f;
#pragma unroll
      for (int kt = 0; kt < 4; ++kt)
#pragma unroll
        for (int j = 0; j < 4; ++j) { float e = __builtin_amdgcn_exp2f(sc[kt][qt][j]); sc[kt][qt][j] = e; ls += e; }
      lrun[qt] += ls;
#pragma unroll
      for (int k2 = 0; k2 < 2; ++k2) {
        union { bf16x8 v; unsigned u[4]; } t_;
        t_.u[0] = cvt_pk_bf16(sc[2 * k2][qt][0], sc[2 * k2][qt][1]); t_.u[1] = cvt_pk_bf16(sc[2 * k2][qt][2], sc[2 * k2][qt][3]);
        t_.u[2] = cvt_pk_bf16(sc[2 * k2 + 1][qt][0], sc[2 * k2 + 1][qt][1]); t_.u[3] = cvt_pk_bf16(sc[2 * k2 + 1][qt][2], sc[2 * k2 + 1][qt][3]);
        pf[k2][qt] = t_.v;
      }
    }
    const char* vdl = vl + cur * 8192;
#pragma unroll
    for (int k2 = 0; k2 < 2; ++k2)
#pragma unroll
      for (int dt = 0; dt < 4; ++dt) {
        const int dim = dt * 16 + fr;
        bf16x8 af = *reinterpret_cast<const bf16x8*>(vdl + dim * 128 + (((k2 * 4 + fq) ^ ((dim >> 1) & 7)) << 4));
#pragma unroll
        for (int qt = 0; qt < 2; ++qt) o[dt][qt] = __builtin_amdgcn_mfma_f32_16x16x32_bf16(af, pf[k2][qt], o[dt][qt], 0, 0, 0);
      }
    if (t + 2 < 32) lstoreK(sa, cur);
    if (t + 1 < 32) lstoreV(sa, cur ^ 1);
    __syncthreads();
#pragma unroll
    for (int kt = 0; kt < 4; ++kt)
#pragma unroll
      for (int qt = 0; qt < 2; ++qt) sc[kt][qt] = sn[kt][qt];
    rcur[0] = rnxt[0]; rcur[1] = rnxt[1];
      }
    { const int t = t2 + 1, cur = 1;

    gloadK(sa, min(t + 3, 31));
    gloadV(sa, min(t + 2, 31));
    if (t + 1 < 32) { rnxt[0] = mrun[0]; rnxt[1] = mrun[1]; qk_tile(kl + (cur ^ 1) * 16384, sn, rnxt); }
    bf16x8 pf[2][2];
#pragma unroll
    for (int qt = 0; qt < 2; ++qt) {
      float lm = sc[0][qt][0];
#pragma unroll
      for (int kt = 0; kt < 4; ++kt)
#pragma unroll
        for (int j = 0; j < 4; ++j) lm = fmaxf(lm, sc[kt][qt][j]);
      const bool slow = (lm > ATT_THR) || (rcur[qt] != mrun[qt]);
      if (__any(slow)) {
        const float dl = rcur[qt] - mrun[qt];
        float tm = lm + dl;
        tm = fmaxf(tm, __shfl_xor(tm, 16));
        tm = fmaxf(tm, __shfl_xor(tm, 32));
        const float inc = fmaxf(tm, 0.f);
        const float alpha = __builtin_amdgcn_exp2f(-inc);
        mrun[qt] += inc;
        lrun[qt] *= alpha;
#pragma unroll
        for (int dt = 0; dt < 4; ++dt) { o[dt][qt][0] *= alpha; o[dt][qt][1] *= alpha; o[dt][qt][2] *= alpha; o[dt][qt][3] *= alpha; }
        const float sh = dl - inc;
#pragma unroll
        for (int kt = 0; kt < 4; ++kt)
#pragma unroll
          for (int j = 0; j < 4; ++j) sc[kt][qt][j] += sh;
      }
      float ls = 0.f;
#pragma unroll
      for (int kt = 0; kt < 4; ++kt)
#pragma unroll
        for (int j = 0; j < 4; ++j) { float e = __builtin_amdgcn_exp2f(sc[kt][qt][j]); sc[kt][qt][j] = e; ls += e; }
      lrun[qt] += ls;
#pragma unroll
      for (int k2 = 0; k2 < 2; ++k2) {
        union { bf16x8 v; unsigned u[4]; } t_;
        t_.u[0] = cvt_pk_bf16(sc[2 * k2][qt][0], sc[2 * k2][qt][1]); t_.u[1] = cvt_pk_bf16(sc[2 * k2][qt][2], sc[2 * k2][qt][3]);
        t_.u[2] = cvt_pk_bf16(sc[2 * k2 + 1][qt][0], sc[2 * k2 + 1][qt][1]); t_.u[3] = cvt_pk_bf16(sc[2 * k2 + 1][qt][2], sc[2 * k2 + 1][qt][3]);
        pf[k2][qt] = t_.v;
      }
    }
    const char* vdl = vl + cur * 8192;
#pragma unroll
    for (int k2 = 0; k2 < 2; ++k2)
#pragma unroll
      for (int dt = 0; dt < 4; ++dt) {
        const int dim = dt * 16 + fr;
        bf16x8 af = *reinterpret_cast<const bf16x8*>(vdl + dim * 128 + (((k2 * 4 + fq) ^ ((dim >> 1) & 7)) << 4));
#pragma unroll
        for (int qt = 0; qt < 2; ++qt) o[dt][qt] = __builtin_amdgcn_mfma_f32_16x16x32_bf16(af, pf[k2][qt], o[dt][qt], 0, 0, 0);
      }
    if (t + 2 < 32) lstoreK(sb, cur);
    if (t + 1 < 32) lstoreV(sb, cur ^ 1);
    __syncthreads();
#pragma unroll
    for (int kt = 0; kt < 4; ++kt)
#pragma unroll
      for (int qt = 0; qt < 2; ++qt) sc[kt][qt] = sn[kt][qt];
    rcur[0] = rnxt[0]; rcur[1] = rnxt[1];
      }
  }
  __builtin_amdgcn_s_setprio(0);
  const int b = bh >> 4, h = bh & 15;
#pragma unroll
  for (int qt = 0; qt < 2; ++qt) {
    float l = lrun[qt];
    l += __shfl_xor(l, 16);
    l += __shfl_xor(l, 32);
    const float inv = 1.0f / l;
    const long tok = (long)b * SEQ + qb * 256 + wid * 32 + qt * 16 + fr;
#pragma unroll
    for (int dt = 0; dt < 4; ++dt) {
      uint2 pk; pk.x = pack2(o[dt][qt][0] * inv, o[dt][qt][1] * inv); pk.y = pack2(o[dt][qt][2] * inv, o[dt][qt][3] * inv);
      *reinterpret_cast<uint2*>(O + tok * 1024 + h * 64 + dt * 16 + 4 * fq) = pk;
    }
  }
}
DEV void phase_mla_attn(const Params& p) {
  const int nb = gridDim.x;
  for (int u = vstart(); u < NBATCH * 16 * 8; u += nb) mla_attn_unit(p, u);
}

#ifndef ONLY
#define ONLY -1
#endif
#define PH(n, ...) if (ONLY < 0 || ONLY == n) { __VA_ARGS__; }
constexpr int LDS_BAR_OFF = 148480;
__global__ void __launch_bounds__(512) mega(Params p) {
  cg::grid_group grid = cg::this_grid();
  unsigned* barw = reinterpret_cast<unsigned*>(p.ws + S_BAR);
  if (blockIdx.x == 0) for (int i = threadIdx.x; i < XCD_BAR_WORDS; i += 512) barw[i] = 0u;
  if (threadIdx.x == 0) *reinterpret_cast<uint4*>(smem + LDS_BAR_OFF) = make_uint4(0u, 0u, 0u, 0u);
  PH(0, phase_prep(p));
  grid.sync();
  (void)xcd_barrier_post(barw, (volatile LAS unsigned*)(smem + LDS_BAR_OFF));
#define GSYNC() do { XcdBarrier xb_; xb_.bar = reinterpret_cast<unsigned*>(p.ws + S_BAR); xb_.x = xb_xcc_id(); xb_.st = (volatile LAS unsigned*)(smem + LDS_BAR_OFF); xcd_barrier(xb_); } while (0)
  PH(1, phase_abin(p)); GSYNC();
  PH(2, phase_mix0(p)); GSYNC();
  PH(2, phase_ztrans(p)); GSYNC();
  PH(3, phase_outproj(p, reinterpret_cast<const u16*>(p.ws + REG_A + 100663296ull), reinterpret_cast<const u16*>(p.ws + W_ABOUT))); GSYNC();
  for (int layer = 0; layer < 2; ++layer) {
    if (layer == 1) {
      PH(10, phase_mla_in(p)); GSYNC();
      PH(11, phase_mla_norm(p)); GSYNC();
      PH(12, phase_mla_up(p)); GSYNC();
      PH(13, phase_mla_attn(p)); GSYNC();
      PH(3, phase_outproj(p, reinterpret_cast<const u16*>(p.ws + MLA_O), reinterpret_cast<const u16*>(p.ws + W_MLAOUT))); GSYNC();
    }
    PH(4, phase_ln1_router(p, layer)); GSYNC();
    PH(5, phase_topk(p)); GSYNC();
    PH(6, phase_moe1(p, layer)); GSYNC();
    PH(7, phase_moe2(p, layer)); GSYNC();
    PH(8, phase_ln2(p, layer)); GSYNC();
    PH(9, phase_ple(p, layer, layer ? p.out : nullptr, layer ? nullptr : reinterpret_cast<u16*>(p.ws + REG_X)));
    if (layer == 0) GSYNC();
  }
}

static void add_job(Params& P, int& nj, int& tile, const float* src, u16* dst, int K, int N, int rsh, int rs, int off, int count, long sstride, long dstride, int f8 = 0, float fscale = 1.0f) {
  ConvJob& J = P.jobs[nj++];
  J.src = src; J.dst = dst; J.sstride = sstride; J.dstride = dstride; J.K = K; J.N = N; J.rs = rs; J.off = off; J.rsh = rsh;
  J.f8 = f8; J.fscale = fscale;
  if (f8) { J.ntn = N / 128; J.tpm = (K / 128) * J.ntn; } else { J.ntn = (N + 255) / 256; J.tpm = (K / 64) * J.ntn; }
  J.tile0 = tile; J.ntiles = J.tpm * count;
  tile += J.ntiles;
}

extern "C" void kernel_launch(void* const* d_in, const int* in_sizes, int n_in,
                              void* d_out, int out_size, void* d_ws, size_t ws_size,
                              hipStream_t stream) {
  constexpr size_t kDynLds = 148480 + 16;
  static int grid_blocks = 0;
  if (!grid_blocks) {
    int dev = 0, cus = 0, per_cu = 0;
    (void)hipGetDevice(&dev);
    (void)hipDeviceGetAttribute(&cus, hipDeviceAttributeMultiprocessorCount, dev);
    (void)hipFuncSetAttribute((const void*)mega, hipFuncAttributeMaxDynamicSharedMemorySize, (int)kDynLds);
    (void)hipOccupancyMaxActiveBlocksPerMultiprocessor(&per_cu, mega, 512, kDynLds);
    if (per_cu > 1) per_cu = 1;
    if (per_cu < 1) { fprintf(stderr, "occupancy query returned 0\n"); per_cu = 1; }
    grid_blocks = cus * per_cu;
    if (ws_size < WS_TOTAL) fprintf(stderr, "workspace too small: %zu < %zu\n", ws_size, (size_t)WS_TOTAL);
  }
  Params P;
  memset(&P, 0, sizeof(P));
  auto F = [&](int i) { return (const float*)d_in[i]; };
  char* ws = (char*)d_ws;
  P.x = F(0); P.p = F(1);
  P.na_rpb = F(3); P.hy_conv_w = F(4); P.hy_conv_b = F(5);
  P.hy_f_w1 = F(6); P.hy_f_b1 = F(7); P.hy_f_freq = F(8); P.hy_f_w2 = F(9); P.hy_f_b2 = F(10); P.hy_f_w3 = F(11); P.hy_skip = F(12);
  P.mla_q_norm = F(15); P.mla_kv_norm = F(17);
  P.ln1_g = F(20); P.ln1_b = F(21); P.ln2_g = F(22); P.ln2_b = F(23);
  P.moe_router = F(24);
  P.out = (float*)d_out; P.ws = ws;
  int nj = 0, tile = 0;
  add_job(P, nj, tile, F(2), (u16*)(ws + W_ABIN), 1024, 3072, 7, 128, 0, 1, 0, 0);
  add_job(P, nj, tile, F(13), (u16*)(ws + W_ABOUT), 1024, 1024, 7, 128, 0, 1, 0, 0);
  add_job(P, nj, tile, F(14), (u16*)(ws + W_MLAIN), 1024, 672, 7, 128, 0, 1, 0, 0);
  add_job(P, nj, tile, F(16), (u16*)(ws + W_QUP), 384, 1536, 7, 128, 0, 1, 0, 0);
  add_job(P, nj, tile, F(18), (u16*)(ws + W_KVUP), 256, 2048, 6, 64, 0, 1, 0, 0);
  P.jobs[nj - 1].sh2 = 1; P.jobs[nj - 1].off2 = 1024;
  add_job(P, nj, tile, F(19), (u16*)(ws + W_MLAOUT), 1024, 1024, 7, 128, 0, 1, 0, 0);
  add_job(P, nj, tile, F(28), (u16*)(ws + W_PLEG), 1024, 1024, 7, 128, 0, 2, 1024L * 1024, 1024L * 1024);
  add_job(P, nj, tile, F(29), (u16*)(ws + W_PLEP), 256, 1024, 7, 128, 0, 2, 256L * 1024, 1024L * 256);
  P.conv_f8_first = tile;
  add_job(P, nj, tile, F(25), (u16*)(ws + W_GU), 1024, 2048, 7, 256, 0, 32, 1024L * 2048, 4096L * 1024, 1, 32.0f);
  add_job(P, nj, tile, F(26), (u16*)(ws + W_GU), 1024, 2048, 7, 256, 128, 32, 1024L * 2048, 4096L * 1024, 1, 32.0f);
  add_job(P, nj, tile, F(27), (u16*)(ws + W_DN), 2048, 1024, 7, 128, 0, 32, 2048L * 1024, 1024L * 2048, 1, 64.0f);
  P.conv_total = tile;
  void* args[] = {&P};
  hipError_t e = hipLaunchCooperativeKernel((void*)mega, dim3(grid_blocks), dim3(512), args, kDynLds, stream);
  if (e != hipSuccess) fprintf(stderr, "cooperative launch failed: %s (grid %d)\n", hipGetErrorString(e), grid_blocks);
}
```
